# Optimizing an MI355X kernel written in HIP

```python
import math
import jax, jax.numpy as jnp
from jax import lax
import numpy as np

D_MODEL = 2048
BATCH = 1
SEQ = 16384
DEPTH = 4

CHUNK = 64
Q_BLOCK = 128
MIX_WIDTH = D_MODEL
DIFF_WIDTH = MIX_WIDTH // 2
RWKV_WIDTH = MIX_WIDTH - DIFF_WIDTH
DIFF_V_DIM = 128
DIFF_QK_DIM = DIFF_V_DIM // 2
DIFF_HEADS = DIFF_WIDTH // DIFF_V_DIM
DIFF_QK_W = DIFF_HEADS * 2 * DIFF_QK_DIM
DIFF_V_W = DIFF_HEADS * DIFF_V_DIM
RWKV_HEAD_DIM = 64
RWKV_HEADS = RWKV_WIDTH // RWKV_HEAD_DIM
DECAY_LORA = 64
AAA_LORA = 64
MV_LORA = 32
GATE_LORA = 160
RWKV_SHIFT_WIDTH = 3 * RWKV_WIDTH + DECAY_LORA + AAA_LORA + GATE_LORA
PROJ_WIDTH = 2 * DIFF_QK_W + DIFF_V_W + RWKV_SHIFT_WIDTH
D_FF = 4 * D_MODEL
RMS_EPS = 1e-6
RWKV_GN_EPS = 64e-5
NEG_INF = -1e30

kernel_name = "hybrid_diffattn_rwkv7_sqrelu_trunk"


def rms_norm(x, g, eps=RMS_EPS):
    xf = x.astype(jnp.float32)
    y = xf * lax.rsqrt(jnp.mean(xf * xf, axis=-1, keepdims=True) + eps)
    return (y * g.astype(jnp.float32)).astype(x.dtype)


def alibi_slopes(n):
    return jnp.asarray([2.0 ** (-8.0 * (i + 1) / n) for i in range(n)], jnp.float32)


def token_shift(p, mu):
    prev = jnp.pad(p, ((0, 0), (1, 0), (0, 0)))[:, :-1]
    return p + (prev - p) * mu


def diff_attention(q, k, v, lam, slopes):
    B, T, H, _, DK = q.shape
    nb = T // Q_BLOCK
    scale = 1.0 / math.sqrt(DK)
    q_blocks = jnp.moveaxis(q.reshape(B, nb, Q_BLOCK, H, 2, DK), 1, 0)
    k_pos = jnp.arange(T)

    def one_block(args):
        q_blk, blk = args
        q_pos = blk * Q_BLOCK + jnp.arange(Q_BLOCK)
        s = jnp.einsum('bqhcd,bkhcd->bhcqk', q_blk, k) * scale
        dist = jnp.abs(q_pos[:, None] - k_pos[None, :]).astype(jnp.float32)
        allowed = (k_pos[None, :] // CHUNK) <= (q_pos[:, None] // CHUNK)
        s = s - slopes[None, :, None, None, None] * dist
        s = jnp.where(allowed, s, NEG_INF)
        p = jax.nn.softmax(s, axis=-1)
        attn = p[:, :, 0] - lam * p[:, :, 1]
        return jnp.einsum('bhqk,bkhd->bqhd', attn, v)

    out = lax.map(one_block, (q_blocks, jnp.arange(nb)))
    return jnp.moveaxis(out, 0, 1).reshape(B, T, H, v.shape[-1])


def rwkv7_scan(r, w, k, v, a, b):
    B, T, H, N = r.shape

    def step(S, inp):
        r_t, w_t, k_t, v_t, a_t, b_t = inp
        sa = jnp.einsum('bhij,bhj->bhi', S, a_t)
        S = S * w_t[:, :, None, :] + sa[..., None] * b_t[:, :, None, :] + v_t[..., None] * k_t[:, :, None, :]
        y = jnp.einsum('bhij,bhj->bhi', S, r_t)
        return S, y

    xs = tuple(jnp.moveaxis(t, 1, 0) for t in (r, w, k, v, a, b))
    S0 = jnp.zeros((B, H, N, N), jnp.float32)
    _, ys = lax.scan(step, S0, xs)
    return jnp.moveaxis(ys, 0, 1)


def setup_inputs(seed: int = 0) -> dict:
    key = jax.random.key(seed)
    ks = jax.random.split(key, 26)
    f = jnp.float32
    L = DEPTH

    def nrm(k, shape, scale):
        return jax.random.normal(k, shape, f) * scale

    return {
        "x": nrm(ks[0], (BATCH, SEQ, D_MODEL), 1.0),
        "norm_mix": 1.0 + nrm(ks[1], (L, D_MODEL), 0.02),
        "norm_mlp": 1.0 + nrm(ks[2], (L, D_MODEL), 0.02),
        "w_in": nrm(ks[3], (L, D_MODEL, PROJ_WIDTH), D_MODEL ** -0.5),
        "w_out": nrm(ks[4], (L, MIX_WIDTH, D_MODEL), MIX_WIDTH ** -0.5),
        "qk_norm_q": 1.0 + nrm(ks[5], (L, 2, DIFF_QK_DIM), 0.02),
        "qk_norm_k": 1.0 + nrm(ks[6], (L, 2, DIFF_QK_DIM), 0.02),
        "diff_lambda_q": nrm(ks[7], (L, 2, DIFF_QK_DIM), 0.1),
        "diff_lambda_k": nrm(ks[8], (L, 2, DIFF_QK_DIM), 0.1),
        "diff_subln": 1.0 + nrm(ks[9], (L, DIFF_V_DIM), 0.02),
        "rwkv_mu": jax.random.uniform(ks[10], (L, RWKV_SHIFT_WIDTH), f, 0.0, 1.0),
        "rwkv_w0": -0.5 + nrm(ks[11], (L, RWKV_WIDTH), 0.5),
        "rwkv_w2": nrm(ks[12], (L, DECAY_LORA, RWKV_WIDTH), 0.5 * DECAY_LORA ** -0.5),
        "rwkv_a0": nrm(ks[13], (L, RWKV_WIDTH), 0.1),
        "rwkv_a2": nrm(ks[14], (L, AAA_LORA, RWKV_WIDTH), 0.5 * AAA_LORA ** -0.5),
        "rwkv_g2": nrm(ks[15], (L, GATE_LORA, RWKV_WIDTH), GATE_LORA ** -0.5),
        "rwkv_k_k": 0.85 + nrm(ks[16], (L, RWKV_WIDTH), 0.05),
        "rwkv_k_a": 1.0 + nrm(ks[17], (L, RWKV_WIDTH), 0.05),
        "rwkv_r_k": nrm(ks[18], (L, RWKV_HEADS, RWKV_HEAD_DIM), 0.1),
        "rwkv_ln_w": 1.0 + nrm(ks[19], (L, RWKV_WIDTH), 0.02),
        "rwkv_ln_b": nrm(ks[20], (L, RWKV_WIDTH), 0.02),
        "rwkv_v0": nrm(ks[21], (L - 1, RWKV_WIDTH), 0.5),
        "rwkv_v1": nrm(ks[22], (L - 1, RWKV_WIDTH, MV_LORA), RWKV_WIDTH ** -0.5),
        "rwkv_v2": nrm(ks[23], (L - 1, MV_LORA, RWKV_WIDTH), 0.5 * MV_LORA ** -0.5),
        "mlp_up": nrm(ks[24], (L, D_MODEL, D_FF), D_MODEL ** -0.5),
        "mlp_down": nrm(ks[25], (L, D_FF, D_MODEL), D_FF ** -0.5),
    }


def reference(x, norm_mix, norm_mlp, w_in, w_out, qk_norm_q, qk_norm_k, diff_lambda_q,
              diff_lambda_k, diff_subln, rwkv_mu, rwkv_w0, rwkv_w2, rwkv_a0, rwkv_a2, rwkv_g2,
              rwkv_k_k, rwkv_k_a, rwkv_r_k, rwkv_ln_w, rwkv_ln_b, rwkv_v0, rwkv_v1, rwkv_v2,
              mlp_up, mlp_down):
    B, T, _ = x.shape
    f32 = jnp.float32
    slopes = alibi_slopes(DIFF_HEADS)
    v_first = None
    for l in range(DEPTH):
        h = rms_norm(x, norm_mix[l])
        proj = jnp.einsum('btd,de->bte', h, w_in[l])
        q_d, k_d, v_d, rw = jnp.split(
            proj, [DIFF_QK_W, 2 * DIFF_QK_W, 2 * DIFF_QK_W + DIFF_V_W], axis=-1)

        q_d = rms_norm(q_d.reshape(B, T, DIFF_HEADS, 2, DIFF_QK_DIM), qk_norm_q[l]).astype(f32)
        k_d = rms_norm(k_d.reshape(B, T, DIFF_HEADS, 2, DIFF_QK_DIM), qk_norm_k[l]).astype(f32)
        v_d = v_d.reshape(B, T, DIFF_HEADS, DIFF_V_DIM).astype(f32)
        lam_init = 0.8 - 0.6 * math.exp(-0.3 * l)
        lq = diff_lambda_q[l].astype(f32)
        lk = diff_lambda_k[l].astype(f32)
        lam = jnp.exp(jnp.sum(lq[0] * lk[0])) - jnp.exp(jnp.sum(lq[1] * lk[1])) + lam_init
        a_out = diff_attention(q_d, k_d, v_d, lam, slopes)
        a_out = rms_norm(a_out, diff_subln[l]) * (1.0 - lam_init)
        a_out = a_out.reshape(B, T, DIFF_WIDTH).astype(x.dtype)

        rw = token_shift(rw, rwkv_mu[l])
        r, kr, vr, lat_w, lat_a, lat_g = jnp.split(
            rw, [RWKV_WIDTH, 2 * RWKV_WIDTH, 3 * RWKV_WIDTH,
                 3 * RWKV_WIDTH + DECAY_LORA, 3 * RWKV_WIDTH + DECAY_LORA + AAA_LORA], axis=-1)
        w_log = -jax.nn.softplus(-(rwkv_w0[l] + jnp.tanh(lat_w) @ rwkv_w2[l])) - 0.5
        decay = jnp.exp(-jnp.exp(w_log.astype(f32)))
        if l == 0:
            v_first = vr
        else:
            v_gate = jax.nn.sigmoid(rwkv_v0[l - 1] + (vr @ rwkv_v1[l - 1]) @ rwkv_v2[l - 1])
            vr = vr + (v_first - vr) * v_gate
        a_rate = jax.nn.sigmoid(rwkv_a0[l] + lat_a @ rwkv_a2[l])
        g = jax.nn.sigmoid(lat_g) @ rwkv_g2[l]
        heads = (B, T, RWKV_HEADS, RWKV_HEAD_DIM)
        kk = (kr * rwkv_k_k[l]).astype(f32).reshape(heads)
        kk = kk / jnp.maximum(jnp.sqrt(jnp.sum(kk * kk, axis=-1, keepdims=True)), 1e-12)
        a_h = a_rate.astype(f32).reshape(heads)
        k_mod = (kr * (1.0 + (a_rate - 1.0) * rwkv_k_a[l])).astype(f32).reshape(heads)
        r_h = r.astype(f32).reshape(heads)
        v_h = vr.astype(f32).reshape(heads)
        y = rwkv7_scan(r_h, decay.reshape(heads), k_mod, v_h, -kk, kk * a_h)
        mean = jnp.mean(y, axis=-1, keepdims=True)
        var = jnp.mean(jnp.square(y - mean), axis=-1, keepdims=True)
        y = ((y - mean) * lax.rsqrt(var + RWKV_GN_EPS)).reshape(B, T, RWKV_WIDTH)
        y = y * rwkv_ln_w[l].astype(f32) + rwkv_ln_b[l].astype(f32)
        bonus = jnp.sum(r_h * k_mod * rwkv_r_k[l].astype(f32), axis=-1, keepdims=True) * v_h
        y = (y + bonus.reshape(B, T, RWKV_WIDTH)).astype(x.dtype) * g

        mixed = jnp.concatenate([a_out, y], axis=-1)
        x = x + jnp.einsum('bte,ed->btd', mixed, w_out[l])

        h2 = rms_norm(x, norm_mlp[l])
        u = jnp.square(jax.nn.relu(jnp.einsum('btd,df->btf', h2, mlp_up[l])))
        x = x + jnp.einsum('btf,fd->btd', u, mlp_down[l])
    return x
```

```cpp
#include <hip/hip_runtime.h>
#include <cstdio>
#include <cstdint>
#include <cmath>
namespace pg8 {
#define PG8_LAS __attribute__((address_space(3)))
typedef unsigned short bf16_t;
typedef short bf16x8 __attribute__((ext_vector_type(8)));
typedef float f32x4 __attribute__((ext_vector_type(4)));
typedef unsigned u32x4 __attribute__((ext_vector_type(4)));
constexpr int BM = 256, BK = 64, HALF = 128, HTB = HALF * BK * 2  , STAGE_BYTES = 8 * HTB, NXCD = 8, WGM = 8;

__host__ __device__ __forceinline__ int lds_byte(int r, int c) { const int st = (r >> 4) * 2 + (c >> 5), rr = r & 15, cc = c & 31, ob = rr * 64 + cc * 2; return st * 1024 + (ob ^ (((ob >> 9) & 1) << 5)); }
__host__ __device__ __forceinline__ void stage_rc(int b, int& R, int& C) { const int st = b / 1024, sb = b % 1024, swz = sb ^ (((sb >> 9) & 1) << 5); R = (st >> 1) * 16 + swz / 64; C = (st & 1) * 32 + (swz % 64) / 2; }
__host__ __device__ __forceinline__ int perm32(int rho) { const int n = rho >> 4, i = rho & 15; return 8 * (i >> 2) + 4 * n + (i & 3); }

struct Unit { int pm, pn; };
struct Gemm { const bf16_t* A; const bf16_t* Bt; int M, N, K, pad_; };

struct StaticOrder {
    int nM, nN, nwg, G, c;
    __host__ __device__ void init(int M, int N, int G_, int c_) { nM = M / BM; nN = N / BM; nwg = nM * nN; G = G_; c = c_; }
    __host__ __device__ bool next(int i, Unit& u) const {
        const long L = (long)i * G + c; if (L >= nwg) return false;
        int wgid = (int)L; { const int q = nwg / NXCD, r = nwg % NXCD, xcd = wgid % NXCD, off = wgid / NXCD; wgid = (xcd < r ? xcd * (q + 1) : r * (q + 1) + (xcd - r) * q) + off; }
        const int nig = WGM * nN, gid = wgid / nig, fm = gid * WGM, gsz = (nM - fm) < WGM ? (nM - fm) : WGM;
        u.pm = fm + ((wgid % nig) % gsz); u.pn = (wgid % nig) / gsz; return true;
    }
    __device__ __forceinline__ void a_ready(const Unit&) const {}
    __device__ __forceinline__ void done(const Unit&) const {}
};

__device__ __forceinline__ unsigned cvt_pk_bf16(float lo, float hi) { unsigned r; asm volatile("v_cvt_pk_bf16_f32 %0, %1, %2" : "=v"(r) : "v"(lo), "v"(hi)); return r; }
typedef float f32x2 __attribute__((ext_vector_type(2)));
struct EpiIn {
    static constexpr bool PERM = true, AFTER_DRAIN = false;
    const float* rinv; bf16_t* q; bf16_t* k; bf16_t* v; bf16_t* rw; const float* gq; const float* gk;
    __device__ __forceinline__ void operator()(const f32x4 (&acc)[2][2][4][2], const Unit& u, int wr, int wc, int fr, int fq) const {
        const int pn = u.pn;
        const int row0 = u.pm * BM + wr * 64 + fr;
        if (pn < 8) {
            const float* g = (pn < 4 ? gq : gk) + (wc & 1) * 64 + 8 * fq;
            f32x4 gv[2][2];
#pragma unroll
            for (int bj = 0; bj < 2; ++bj)
#pragma unroll
                for (int n = 0; n < 2; ++n) gv[bj][n] = *(const f32x4*)(g + 32 * bj + 4 * n);
            bf16_t* base = (pn < 4 ? q : k) + (pn & 3) * 256 + 64 * wc + 8 * fq;
#pragma unroll
            for (int ai = 0; ai < 2; ++ai)
#pragma unroll
                for (int m = 0; m < 4; ++m) {
                    const int row = row0 + ai * HALF + m * 16; const float ri = rinv[row];
                    f32x4 vv[2][2]; float ss = 0.f;
#pragma unroll
                    for (int bj = 0; bj < 2; ++bj)
#pragma unroll
                        for (int n = 0; n < 2; ++n) { vv[bj][n] = acc[ai][bj][m][n] * ri; const f32x4 t = vv[bj][n]; ss += (t[0] * t[0] + t[1] * t[1]) + (t[2] * t[2] + t[3] * t[3]); }
                    ss += __shfl_xor(ss, 16); ss += __shfl_xor(ss, 32);
                    const float rq = 1.0f / sqrtf(ss * (1.0f / 64.0f) + 1e-6f);
#pragma unroll
                    for (int bj = 0; bj < 2; ++bj) { const f32x4 a = vv[bj][0] * rq * gv[bj][0], b = vv[bj][1] * rq * gv[bj][1];
                        u32x4 w; w.x = cvt_pk_bf16(a[0], a[1]); w.y = cvt_pk_bf16(a[2], a[3]); w.z = cvt_pk_bf16(b[0], b[1]); w.w = cvt_pk_bf16(b[2], b[3]);
                        *(u32x4*)(base + (size_t)row * 1024 + 32 * bj) = w; }
                }
        } else {
            bf16_t* base; int ld;
            if (pn < 12) { base = v + (pn - 8) * 256 + 64 * wc + 8 * fq; ld = 1024; } else { base = rw + (pn - 12) * 256 + 64 * wc + 8 * fq; ld = 3584; }
#pragma unroll
            for (int ai = 0; ai < 2; ++ai)
#pragma unroll
                for (int m = 0; m < 4; ++m) {
                    const int row = row0 + ai * HALF + m * 16; const float ri = rinv[row];
#pragma unroll
                    for (int bj = 0; bj < 2; ++bj) { const f32x4 a = acc[ai][bj][m][0] * ri, b = acc[ai][bj][m][1] * ri;
                        u32x4 w; w.x = cvt_pk_bf16(a[0], a[1]); w.y = cvt_pk_bf16(a[2], a[3]); w.z = cvt_pk_bf16(b[0], b[1]); w.w = cvt_pk_bf16(b[2], b[3]);
                        *(u32x4*)(base + (size_t)row * ld + 32 * bj) = w; }
                }
        }
    }
};
struct EpiRes {
    static constexpr bool PERM = true, AFTER_DRAIN = false;
    float* x; int ldc; int pad_;
    __device__ __forceinline__ void operator()(const f32x4 (&acc)[2][2][4][2], const Unit& u, int wr, int wc, int fr, int fq) const {
        const int row0 = u.pm * BM + wr * 64 + fr, col0 = u.pn * BM + wc * 32 + 8 * fq;
#pragma unroll
        for (int ai = 0; ai < 2; ++ai)
#pragma unroll
            for (int m = 0; m < 4; ++m) { float* rowp = x + (size_t)(row0 + ai * HALF + m * 16) * ldc + col0;
#pragma unroll
                for (int bj = 0; bj < 2; ++bj) { f32x4* p = (f32x4*)(rowp + bj * HALF); const f32x4 o0 = p[0], o1 = p[1]; p[0] = o0 + acc[ai][bj][m][0]; p[1] = o1 + acc[ai][bj][m][1]; } }
    }
};
struct EpiUp {
    static constexpr bool PERM = true, AFTER_DRAIN = false;
    const float* rinv; bf16_t* o; int ldc; int pad_;
    __device__ __forceinline__ void operator()(const f32x4 (&acc)[2][2][4][2], const Unit& u, int wr, int wc, int fr, int fq) const {
        const int row0 = u.pm * BM + wr * 64 + fr, col0 = u.pn * BM + wc * 32 + 8 * fq;
#pragma unroll
        for (int ai = 0; ai < 2; ++ai)
#pragma unroll
            for (int m = 0; m < 4; ++m) { const int row = row0 + ai * HALF + m * 16; const float ri = rinv[row]; bf16_t* rowp = o + (size_t)row * ldc + col0;
#pragma unroll
                for (int bj = 0; bj < 2; ++bj) { f32x4 a = acc[ai][bj][m][0] * ri, b = acc[ai][bj][m][1] * ri;
#pragma unroll
                    for (int e = 0; e < 4; ++e) { a[e] = a[e] > 0.f ? a[e] * a[e] : 0.f; b[e] = b[e] > 0.f ? b[e] * b[e] : 0.f; }
                    u32x4 w; w.x = cvt_pk_bf16(a[0], a[1]); w.y = cvt_pk_bf16(a[2], a[3]); w.z = cvt_pk_bf16(b[0], b[1]); w.w = cvt_pk_bf16(b[2], b[3]);
                    *(u32x4*)(rowp + bj * HALF) = w; } }
    }
};
template <class Epi, class Sched, bool ALIGN_EPI = false, bool SP2 = false>
__device__ __forceinline__ void gemm_phase(PG8_LAS unsigned char* lds, const Gemm g, const Sched& S, const Epi& E) {
    const int tid = threadIdx.x, wid = __builtin_amdgcn_readfirstlane(tid >> 6), lane = tid & 63, wr = wid >> 2, wc = wid & 3, fr = lane & 15, fq = lane >> 4;
    const int K = g.K, nt = K / BK;
    unsigned voffA[2], voffB[2];
#pragma unroll
    for (int i = 0; i < 2; ++i) { int R, C; stage_rc(tid * 16 + i * 8192, R, C); const int Rb = Epi::PERM ? ((R & ~31) + perm32(R & 31)) : R;
        voffA[i] = (unsigned)(R * K + C) * 2u; voffB[i] = (unsigned)(Rb * K + C) * 2u; }
    const size_t kstep = (size_t)(BK * 2);
    const size_t hstep = (size_t)HALF * K * 2;
    const size_t tstep = 2 * hstep;
    const unsigned ldsw = (unsigned)wid * 1024u;
    const int aoff = lds_byte(wr * 64 + fr, fq * 8), boff = lds_byte(wc * 32 + fr, fq * 8);
#define PG8_SA(b, h) (((b) * 2 + (h)) * HTB)
#define PG8_SB(b, h) ((4 + (b) * 2 + (h)) * HTB)
#define PG8_STAGE(bufoff, gbase, voff) do { _Pragma("unroll") for (int _i = 0; _i < 2; ++_i) \
        __builtin_amdgcn_global_load_lds((const unsigned*)((const char*)(gbase) + (voff)[_i]), (PG8_LAS unsigned*)(lds + (bufoff) + ldsw + _i * 8192), 16, 0, 0); } while (0)
#define PG8_LDA(dst, b, h) do { _Pragma("unroll") for (int m = 0; m < 4; ++m) _Pragma("unroll") for (int k = 0; k < 2; ++k) dst[m][k] = *(const PG8_LAS bf16x8*)(lds + PG8_SA(b, h) + aoff + m * 2048 + k * 1024); } while (0)
#define PG8_LDB(dst, b, h) do { _Pragma("unroll") for (int n = 0; n < 2; ++n) _Pragma("unroll") for (int k = 0; k < 2; ++k) dst[n][k] = *(const PG8_LAS bf16x8*)(lds + PG8_SB(b, h) + boff + n * 2048 + k * 1024); } while (0)
#define PG8_MMA(ai, bj, At, Bt) do { __builtin_amdgcn_s_setprio(1); _Pragma("unroll") for (int m = 0; m < 4; ++m) _Pragma("unroll") for (int n = 0; n < 2; ++n) _Pragma("unroll") for (int k = 0; k < 2; ++k) \
        acc[ai][bj][m][n] = __builtin_amdgcn_mfma_f32_16x16x32_bf16(Bt[n][k], At[m][k], acc[ai][bj][m][n], 0, 0, 0); __builtin_amdgcn_s_setprio(0); } while (0)
#define PG8_WAIT_V(n) asm volatile("s_waitcnt vmcnt(" #n ")" ::: "memory")
#define PG8_WAIT_L(n) asm volatile("s_waitcnt lgkmcnt(" #n ")" ::: "memory")
#define PG8_BAR __builtin_amdgcn_s_barrier()
#define PG8_SCHED __builtin_amdgcn_sched_barrier(0)
    Unit cur, nxt; int ui = 0;
    if (!S.next(0, cur)) return;
    f32x4 acc[2][2][4][2];
#pragma unroll
    for (int a = 0; a < 2; ++a)
#pragma unroll
        for (int b = 0; b < 2; ++b)
#pragma unroll
            for (int m = 0; m < 4; ++m)
#pragma unroll
                for (int n = 0; n < 2; ++n) acc[a][b][m][n] = (f32x4){0.f, 0.f, 0.f, 0.f};
    bf16x8 At[4][2], B0[2][2], B1[2][2];
    const char* cA = (const char*)g.A + (size_t)cur.pm * tstep; const char* cB = (const char*)g.Bt + (size_t)cur.pn * tstep;
    S.a_ready(cur);
    if constexpr (SP2) {
        PG8_STAGE(PG8_SB(0, 0), cB, voffB); PG8_STAGE(PG8_SB(0, 1), cB + hstep, voffB); PG8_STAGE(PG8_SA(0, 0), cA, voffA); PG8_STAGE(PG8_SA(0, 1), cA + hstep, voffA);
        if (wr == 1) PG8_BAR;
        PG8_WAIT_V(2); PG8_BAR;
        PG8_STAGE(PG8_SB(1, 0), cB + kstep, voffB); PG8_STAGE(PG8_SA(1, 0), cA + kstep, voffA); PG8_STAGE(PG8_SB(1, 1), cB + hstep + kstep, voffB);
        PG8_WAIT_V(6); PG8_BAR;
    } else {
        PG8_STAGE(PG8_SB(0, 0), cB, voffB); PG8_STAGE(PG8_SA(0, 0), cA, voffA); PG8_STAGE(PG8_SB(0, 1), cB + hstep, voffB); PG8_STAGE(PG8_SA(0, 1), cA + hstep, voffA);
        if (wr == 1) PG8_BAR;
        PG8_WAIT_V(4); PG8_BAR;
        PG8_STAGE(PG8_SB(1, 0), cB + kstep, voffB); PG8_STAGE(PG8_SA(1, 0), cA + kstep, voffA); PG8_STAGE(PG8_SB(1, 1), cB + hstep + kstep, voffB);
        PG8_WAIT_V(6); PG8_BAR;
    }
    for (;;) {
        const bool has_next = S.next(ui + 1, nxt);
        const char* nA = has_next ? (const char*)g.A + (size_t)nxt.pm * tstep : cA; const char* nB = has_next ? (const char*)g.Bt + (size_t)nxt.pn * tstep : cB;
        for (int t = 0; t < nt; t += 2) {
            const bool last = (t == nt - 2);
            const char* a1 = cA + (size_t)(t + 1) * kstep;
            const char* a2 = last ? nA : cA + (size_t)(t + 2) * kstep; const char* b2 = last ? nB : cB + (size_t)(t + 2) * kstep;
            const char* a3 = a2 + kstep; const char* b3 = b2 + kstep;
            if (last && has_next) S.a_ready(nxt);
            if constexpr (SP2) {
            PG8_LDB(B0, 0, 0); PG8_LDB(B1, 0, 1); PG8_SCHED; PG8_LDA(At, 0, 0); PG8_STAGE(PG8_SA(1, 1), a1 + hstep, voffA);
            PG8_WAIT_V(8); PG8_WAIT_L(0); PG8_BAR; PG8_MMA(0, 0, At, B0); PG8_MMA(0, 1, At, B1); PG8_BAR; PG8_SCHED;
            PG8_LDA(At, 0, 1); PG8_STAGE(PG8_SB(0, 0), b2, voffB); PG8_STAGE(PG8_SB(0, 1), b2 + hstep, voffB); PG8_STAGE(PG8_SA(0, 0), a2, voffA);
            PG8_WAIT_V(8); PG8_WAIT_L(0); PG8_BAR; PG8_MMA(1, 0, At, B0); PG8_MMA(1, 1, At, B1); PG8_BAR; PG8_SCHED;
            PG8_LDB(B0, 1, 0); PG8_LDB(B1, 1, 1); PG8_SCHED; PG8_LDA(At, 1, 0); PG8_STAGE(PG8_SA(0, 1), a2 + hstep, voffA);
            PG8_WAIT_V(8); PG8_WAIT_L(0); PG8_BAR; PG8_MMA(0, 0, At, B0); PG8_MMA(0, 1, At, B1); PG8_BAR; PG8_SCHED;
            PG8_LDA(At, 1, 1); PG8_STAGE(PG8_SB(1, 0), b3, voffB); PG8_STAGE(PG8_SB(1, 1), b3 + hstep, voffB); PG8_STAGE(PG8_SA(1, 0), a3, voffA);
            PG8_WAIT_V(8); PG8_WAIT_L(0); PG8_BAR; PG8_MMA(1, 0, At, B0); PG8_MMA(1, 1, At, B1); PG8_BAR; PG8_SCHED;
            } else {
            PG8_LDB(B0, 0, 0); PG8_SCHED; PG8_LDA(At, 0, 0); PG8_STAGE(PG8_SA(1, 1), a1 + hstep, voffA);
            PG8_WAIT_L(8); PG8_BAR; PG8_WAIT_L(0); PG8_MMA(0, 0, At, B0); PG8_BAR; PG8_SCHED;
            PG8_LDB(B1, 0, 1); PG8_STAGE(PG8_SB(0, 0), b2, voffB);
            PG8_BAR; PG8_WAIT_L(0); PG8_MMA(0, 1, At, B1); PG8_BAR;
            PG8_LDA(At, 0, 1); PG8_STAGE(PG8_SA(0, 0), a2, voffA);
            PG8_BAR; PG8_WAIT_L(0); PG8_MMA(1, 0, At, B0); PG8_BAR; PG8_SCHED;
            PG8_STAGE(PG8_SB(0, 1), b2 + hstep, voffB);
            PG8_WAIT_V(6); PG8_BAR; PG8_MMA(1, 1, At, B1); PG8_BAR;
            PG8_LDB(B0, 1, 0); PG8_SCHED; PG8_LDA(At, 1, 0); PG8_STAGE(PG8_SA(0, 1), a2 + hstep, voffA);
            PG8_WAIT_L(8); PG8_BAR; PG8_WAIT_L(0); PG8_MMA(0, 0, At, B0); PG8_BAR; PG8_SCHED;
            PG8_LDB(B1, 1, 1); PG8_STAGE(PG8_SB(1, 0), b3, voffB);
            PG8_BAR; PG8_WAIT_L(0); PG8_MMA(0, 1, At, B1); PG8_BAR;
            PG8_LDA(At, 1, 1); PG8_STAGE(PG8_SA(1, 0), a3, voffA);
            PG8_BAR; PG8_WAIT_L(0); PG8_MMA(1, 0, At, B0); PG8_BAR; PG8_SCHED;
            PG8_STAGE(PG8_SB(1, 1), b3 + hstep, voffB);
            PG8_WAIT_V(6); PG8_BAR; PG8_MMA(1, 1, At, B1); PG8_BAR;
            }
        }
        if constexpr (ALIGN_EPI) { if (wr == 0) PG8_BAR; }
        if constexpr (!Epi::AFTER_DRAIN) { E(acc, cur, wr, wc, fr, fq); S.done(cur); }
        if (!has_next) break;
#pragma unroll
        for (int a = 0; a < 2; ++a)
#pragma unroll
            for (int b = 0; b < 2; ++b)
#pragma unroll
                for (int m = 0; m < 4; ++m)
#pragma unroll
                    for (int n = 0; n < 2; ++n) acc[a][b][m][n] = (f32x4){0.f, 0.f, 0.f, 0.f};
        cur = nxt; cA = nA; cB = nB; ++ui;
        if constexpr (ALIGN_EPI) { if (wr == 1) PG8_BAR; }
    }
    PG8_WAIT_V(0);
    if constexpr (!ALIGN_EPI) { if (wr == 0) PG8_BAR; }
    PG8_BAR;
    if constexpr (Epi::AFTER_DRAIN) { E.fused(acc, cur, wr, wc, fr, fq, lds, wid, lane); S.done(cur); }
#undef PG8_SA
#undef PG8_SB
#undef PG8_STAGE
#undef PG8_LDA
#undef PG8_LDB
#undef PG8_MMA
#undef PG8_WAIT_V
#undef PG8_WAIT_L
#undef PG8_BAR
#undef PG8_SCHED
}
}

constexpr int T_ = 16384, DM = 2048, NL = 4, PW = 6432, NIN = 6656, RWP = 3584, DFF = 8192, RW_ = 1024;
constexpr float RMS_EPS = 1e-6f, GN_EPS = 64e-5f;
typedef unsigned short bf16;
typedef float f32x4 __attribute__((ext_vector_type(4)));
typedef unsigned u32x4 __attribute__((ext_vector_type(4)));
typedef unsigned u32x2 __attribute__((ext_vector_type(2)));

__device__ __forceinline__ unsigned f2bf(float f) { unsigned u = __builtin_bit_cast(unsigned, f); return (u + 0x7fffu + ((u >> 16) & 1u)) >> 16; }
__device__ __forceinline__ float bf2f(unsigned short b) { return __builtin_bit_cast(float, (unsigned)b << 16); }
__device__ __forceinline__ float bflo(unsigned w) { return __builtin_bit_cast(float, w << 16); }
__device__ __forceinline__ float bfhi(unsigned w) { return __builtin_bit_cast(float, w & 0xffff0000u); }
__device__ __forceinline__ float sigmoidf_(float x) { return 1.0f / (1.0f + __expf(-x)); }

template <int CTRL, int ROWMASK> __device__ __forceinline__ float dppf(float v) {
    return __builtin_bit_cast(float, __builtin_amdgcn_update_dpp(0, __builtin_bit_cast(int, v), CTRL, ROWMASK, 0xF, false));
}
__device__ __forceinline__ float wave_sum(float v) {
    v += dppf<0xB1, 0xF>(v); v += dppf<0x4E, 0xF>(v); v += dppf<0x141, 0xF>(v); v += dppf<0x140, 0xF>(v);
    v += dppf<0x142, 0xA>(v); v += dppf<0x143, 0xC>(v);
    return __builtin_bit_cast(float, __builtin_amdgcn_readlane(__builtin_bit_cast(int, v), 63));
}

template <bool PERMIN> __global__ void __launch_bounds__(256) k_convw(const float* __restrict__ src, bf16* __restrict__ dst, const float* __restrict__ g, int K, int N, int Nd) {
    __shared__ float tile[64][65];
    const int k0 = blockIdx.x * 64, c0 = blockIdx.y * 64, tid = threadIdx.x;
    for (int i = tid; i < 64 * 64; i += 256) {
        const int kk = i >> 6, cc = i & 63, cp = c0 + cc;
        int col = cp;
        if (PERMIN) { const int lo = cp & 255, bj = lo >> 7, wc = (lo >> 5) & 3, j = lo & 31; col = (cp & ~255) + 64 * wc + 32 * bj + j; }
        float v = 0.f;
        if (col < N) { v = src[(size_t)(k0 + kk) * N + col]; if (g) v *= g[k0 + kk]; }
        tile[kk][cc] = v;
    }
    __syncthreads();
    for (int i = tid; i < 64 * 64; i += 256) {
        const int cc = i >> 6, kk = i & 63;
        dst[(size_t)(c0 + cc) * K + k0 + kk] = (bf16)f2bf(tile[kk][cc]);
    }
}

__global__ void __launch_bounds__(256) k_rownorm(const float* __restrict__ src, float* __restrict__ copy, bf16* __restrict__ xb, float* __restrict__ rinv) {
    const int row = blockIdx.x * 4 + (threadIdx.x >> 6), lane = threadIdx.x & 63;
    const f32x4* s = (const f32x4*)(src + (size_t)row * DM);
    float ss = 0.f;
#pragma unroll
    for (int j = 0; j < 8; ++j) { const f32x4 v = s[lane + 64 * j]; ss += (v[0] * v[0] + v[1] * v[1]) + (v[2] * v[2] + v[3] * v[3]);
        if (copy) ((f32x4*)(copy + (size_t)row * DM))[lane + 64 * j] = v;
        u32x2 w; w.x = f2bf(v[0]) | (f2bf(v[1]) << 16); w.y = f2bf(v[2]) | (f2bf(v[3]) << 16);
        ((u32x2*)(xb + (size_t)row * DM))[lane + 64 * j] = w; }
    ss = wave_sum(ss);
    if (lane == 0) rinv[row] = 1.0f / sqrtf(ss * (1.0f / DM) + RMS_EPS);
}

template <class Epi> __global__ void __launch_bounds__(512, 2) k_gemm(pg8::Gemm g, Epi E) {
    extern __shared__ __attribute__((aligned(16))) unsigned char lds[];
    pg8::StaticOrder S; S.init(g.M, g.N, (int)gridDim.x, (int)blockIdx.x);
    pg8::gemm_phase<Epi, pg8::StaticOrder, true, true>((PG8_LAS unsigned char*)lds, g, S, E);
}

struct PrepArgs {
    const bf16* rw; const float* mu; const float* w0; const float* w2; const float* a0; const float* a2; const float* g2; const float* k_k; const float* k_a;
    const float* v0; const float* v1; const float* v2; float* vfirst; float* SR; float* SW; float* SK; float* SV; float* SA; float* SB; float* G; int layer; int pad_;
};
__device__ __forceinline__ float rwshift(const bf16* rw, const float* mu, int t, int col) {
    const float p = bf2f(rw[(size_t)t * RWP + col]); const float pp = t > 0 ? bf2f(rw[(size_t)(t - 1) * RWP + col]) : 0.f;
    return p + mu[col] * (pp - p);
}
__global__ void __launch_bounds__(256) k_rwkv_prep(PrepArgs A) {
    extern __shared__ __attribute__((aligned(16))) unsigned char lds_raw[];
    float* lat_w = (float*)lds_raw;
    float* lat_a = lat_w + 16 * 64;
    float* lat_g = lat_a + 16 * 64;
    float* vlat = lat_g + 16 * 160;
    float* vr_s = vlat + 16 * 32;
    const int tid = threadIdx.x, t0 = blockIdx.x * 16, c4 = 4 * tid;
    for (int idx = tid; idx < 16 * 288; idx += 256) {
        const int tok = idx / 288, j = idx % 288; const float s = rwshift(A.rw, A.mu, t0 + tok, 3072 + j);
        if (j < 64) lat_w[tok * 64 + j] = tanhf(s); else if (j < 128) lat_a[tok * 64 + j - 64] = s; else lat_g[tok * 160 + j - 128] = sigmoidf_(s);
    }
    for (int tok = 0; tok < 16; ++tok)
#pragma unroll
        for (int e = 0; e < 4; ++e) vr_s[tok * 1024 + c4 + e] = rwshift(A.rw, A.mu, t0 + tok, 2048 + c4 + e);
    __syncthreads();
    if (A.layer > 0) {
        const int o = tid & 31, tg = tid >> 5; float a0 = 0.f, a1 = 0.f;
        for (int c = 0; c < 1024; ++c) { const float w = A.v1[c * 32 + o]; a0 += vr_s[tg * 1024 + c] * w; a1 += vr_s[(tg + 8) * 1024 + c] * w; }
        vlat[tg * 32 + o] = a0; vlat[(tg + 8) * 32 + o] = a1;
    }
    __syncthreads();
    f32x4 acc[16], ar[16];
#pragma unroll
    for (int tok = 0; tok < 16; ++tok) acc[tok] = (f32x4){0.f, 0.f, 0.f, 0.f};
    for (int i = 0; i < 64; ++i) { const f32x4 w = *(const f32x4*)(A.w2 + (size_t)i * 1024 + c4);
#pragma unroll
        for (int tok = 0; tok < 16; ++tok) acc[tok] += w * lat_w[tok * 64 + i]; }
    { const f32x4 w0 = *(const f32x4*)(A.w0 + c4);
#pragma unroll
      for (int tok = 0; tok < 16; ++tok) { f32x4 o;
#pragma unroll
        for (int e = 0; e < 4; ++e) { const float z = -(w0[e] + acc[tok][e]); const float sp = fmaxf(z, 0.f) + log1pf(__expf(-fabsf(z))); const float wl = -sp - 0.5f; o[e] = __expf(-__expf(wl)); }
        *(f32x4*)(A.SW + (size_t)(t0 + tok) * 1024 + c4) = o; } }
#pragma unroll
    for (int tok = 0; tok < 16; ++tok) acc[tok] = (f32x4){0.f, 0.f, 0.f, 0.f};
    for (int i = 0; i < 64; ++i) { const f32x4 w = *(const f32x4*)(A.a2 + (size_t)i * 1024 + c4);
#pragma unroll
        for (int tok = 0; tok < 16; ++tok) acc[tok] += w * lat_a[tok * 64 + i]; }
    { const f32x4 a0 = *(const f32x4*)(A.a0 + c4);
#pragma unroll
      for (int tok = 0; tok < 16; ++tok)
#pragma unroll
        for (int e = 0; e < 4; ++e) ar[tok][e] = sigmoidf_(a0[e] + acc[tok][e]); }
    { const f32x4 kkw = *(const f32x4*)(A.k_k + c4), kaw = *(const f32x4*)(A.k_a + c4);
      for (int tok = 0; tok < 16; ++tok) { f32x4 kr, kkv; float ss = 0.f;
#pragma unroll
        for (int e = 0; e < 4; ++e) { kr[e] = rwshift(A.rw, A.mu, t0 + tok, 1024 + c4 + e); kkv[e] = kr[e] * kkw[e]; ss += kkv[e] * kkv[e]; }
        ss += __shfl_xor(ss, 1); ss += __shfl_xor(ss, 2); ss += __shfl_xor(ss, 4); ss += __shfl_xor(ss, 8);
        const float inv = 1.0f / fmaxf(sqrtf(ss), 1e-12f); f32x4 oa, ob, ok;
#pragma unroll
        for (int e = 0; e < 4; ++e) { const float kk = kkv[e] * inv; oa[e] = -kk; ob[e] = kk * ar[tok][e]; ok[e] = kr[e] * (1.0f + (ar[tok][e] - 1.0f) * kaw[e]); }
        const size_t off = (size_t)(t0 + tok) * 1024 + c4;
        *(f32x4*)(A.SA + off) = oa; *(f32x4*)(A.SB + off) = ob; *(f32x4*)(A.SK + off) = ok; } }
#pragma unroll
    for (int tok = 0; tok < 16; ++tok) acc[tok] = (f32x4){0.f, 0.f, 0.f, 0.f};
    for (int i = 0; i < 160; ++i) { const f32x4 w = *(const f32x4*)(A.g2 + (size_t)i * 1024 + c4);
#pragma unroll
        for (int tok = 0; tok < 16; ++tok) acc[tok] += w * lat_g[tok * 160 + i]; }
#pragma unroll
    for (int tok = 0; tok < 16; ++tok) *(f32x4*)(A.G + (size_t)(t0 + tok) * 1024 + c4) = acc[tok];
    if (A.layer == 0) {
        for (int tok = 0; tok < 16; ++tok) { const f32x4 vr = *(const f32x4*)(vr_s + tok * 1024 + c4); const size_t off = (size_t)(t0 + tok) * 1024 + c4;
            *(f32x4*)(A.vfirst + off) = vr; *(f32x4*)(A.SV + off) = vr; }
    } else {
#pragma unroll
        for (int tok = 0; tok < 16; ++tok) acc[tok] = (f32x4){0.f, 0.f, 0.f, 0.f};
        for (int i = 0; i < 32; ++i) { const f32x4 w = *(const f32x4*)(A.v2 + (size_t)i * 1024 + c4);
#pragma unroll
            for (int tok = 0; tok < 16; ++tok) acc[tok] += w * vlat[tok * 32 + i]; }
        const f32x4 v0 = *(const f32x4*)(A.v0 + c4);
#pragma unroll
        for (int tok = 0; tok < 16; ++tok) { const f32x4 vr = *(const f32x4*)(vr_s + tok * 1024 + c4); const size_t off = (size_t)(t0 + tok) * 1024 + c4; const f32x4 vf = *(const f32x4*)(A.vfirst + off); f32x4 o;
#pragma unroll
            for (int e = 0; e < 4; ++e) { const float gt = sigmoidf_(v0[e] + acc[tok][e]); o[e] = vr[e] + (vf[e] - vr[e]) * gt; }
            *(f32x4*)(A.SV + off) = o; }
    }
    for (int tok = 0; tok < 16; ++tok) { f32x4 o;
#pragma unroll
        for (int e = 0; e < 4; ++e) o[e] = rwshift(A.rw, A.mu, t0 + tok, c4 + e);
        *(f32x4*)(A.SR + (size_t)(t0 + tok) * 1024 + c4) = o; }
}

__global__ void __launch_bounds__(256) k_rwkv_scan(const float* __restrict__ SR, const float* __restrict__ SW, const float* __restrict__ SK, const float* __restrict__ SV,
                                                   const float* __restrict__ SA, const float* __restrict__ SB, float* __restrict__ Y) {
    const int gw = blockIdx.x * 4 + (threadIdx.x >> 6), lane = threadIdx.x & 63, h = gw >> 6, i = gw & 63;
    const size_t base = (size_t)h * 64 + lane, vb = (size_t)h * 64 + i;
    float S = 0.f;
    for (int t = 0; t < T_; t += 4) {
        float r[4], w[4], k[4], a[4], b[4], v[4];
#pragma unroll
        for (int s = 0; s < 4; ++s) { const size_t o = (size_t)(t + s) * 1024 + base; r[s] = SR[o]; w[s] = SW[o]; k[s] = SK[o]; a[s] = SA[o]; b[s] = SB[o]; v[s] = SV[(size_t)(t + s) * 1024 + vb]; }
#pragma unroll
        for (int s = 0; s < 4; ++s) {
            const float sa = wave_sum(S * a[s]);
            S = S * w[s] + sa * b[s] + v[s] * k[s];
            const float y = wave_sum(S * r[s]);
            if (lane == 0) Y[(size_t)(t + s) * 1024 + vb] = y;
        }
    }
}
__global__ void __launch_bounds__(256) k_rwkv_out(const float* __restrict__ Y, const float* __restrict__ SR, const float* __restrict__ SK, const float* __restrict__ SV, const float* __restrict__ G,
                                                  const float* __restrict__ ln_w, const float* __restrict__ ln_b, const float* __restrict__ r_k, bf16* __restrict__ mixed) {
    const int gw = blockIdx.x * 4 + (threadIdx.x >> 6), lane = threadIdx.x & 63, t = gw >> 4, h = gw & 15, c = h * 64 + lane;
    const size_t o = (size_t)t * 1024 + c;
    const float y = Y[o]; const float mean = wave_sum(y) * (1.0f / 64.0f); const float d = y - mean; const float var = wave_sum(d * d) * (1.0f / 64.0f);
    float yn = d * (1.0f / sqrtf(var + GN_EPS)); yn = yn * ln_w[c] + ln_b[c];
    const float bonus = wave_sum(SR[o] * SK[o] * r_k[c]) * SV[o];
    mixed[(size_t)t * DM + 1024 + c] = (bf16)f2bf((yn + bonus) * G[o]);
}

__global__ void __launch_bounds__(256) k_attn_simple(const bf16* __restrict__ Q, const bf16* __restrict__ K, const bf16* __restrict__ V, bf16* __restrict__ mixed, float* __restrict__ stash,
                                                     const float* __restrict__ lq, const float* __restrict__ lk, const float* __restrict__ subln, float lam_init) {
    const int unit = (gridDim.x - 1 - blockIdx.x) * 4 + (threadIdx.x >> 6), lane = threadIdx.x & 63;
    const int h = unit & 7, rg = unit >> 3, qi = lane & 31, half = lane >> 5, t = rg * 32 + qi, qc = t >> 6;
    const float slope = exp2f(-(float)(h + 1));
    const float l0 = wave_sum(lq[lane] * lk[lane]), l1 = wave_sum(lq[64 + lane] * lk[64 + lane]);
    const float lam = __expf(l0) - __expf(l1) + lam_init;
    float* st = stash + ((size_t)t * 8 + h) * 128 + half * 64;
    for (int c = 0; c < 2; ++c) {
        float qf[64], o[64];
        { const u32x4* qp = (const u32x4*)(Q + (size_t)t * 1024 + h * 128 + c * 64);
#pragma unroll
          for (int i = 0; i < 8; ++i) { const u32x4 w = qp[i];
#pragma unroll
              for (int e = 0; e < 4; ++e) { qf[8 * i + 2 * e] = bflo(w[e]) * 0.125f; qf[8 * i + 2 * e + 1] = bfhi(w[e]) * 0.125f; } } }
#pragma unroll
        for (int d = 0; d < 64; ++d) o[d] = 0.f;
        float m = -1e30f, l = 0.f;
        const int nk = (qc + 1) * 64;
        for (int kv0 = 0; kv0 < nk; kv0 += 8) {
            float s[8]; float mx = -1e30f;
#pragma unroll
            for (int j = 0; j < 8; ++j) {
                const u32x4* kp = (const u32x4*)(K + (size_t)(kv0 + j) * 1024 + h * 128 + c * 64);
                float a0 = 0.f, a1 = 0.f;
#pragma unroll
                for (int i = 0; i < 8; ++i) { const u32x4 w = kp[i];
#pragma unroll
                    for (int e = 0; e < 4; ++e) { a0 += qf[8 * i + 2 * e] * bflo(w[e]); a1 += qf[8 * i + 2 * e + 1] * bfhi(w[e]); } }
                const int dist = t - (kv0 + j);
                s[j] = (a0 + a1) - slope * (float)(dist < 0 ? -dist : dist);
                mx = fmaxf(mx, s[j]);
            }
            const float mn = fmaxf(m, mx), alpha = __expf(m - mn);
            l *= alpha;
#pragma unroll
            for (int d = 0; d < 64; ++d) o[d] *= alpha;
            m = mn;
#pragma unroll
            for (int j = 0; j < 8; ++j) {
                const float p = __expf(s[j] - mn); l += p;
                const u32x4* vp = (const u32x4*)(V + (size_t)(kv0 + j) * 1024 + h * 128 + half * 64);
#pragma unroll
                for (int i = 0; i < 8; ++i) { const u32x4 w = vp[i];
#pragma unroll
                    for (int e = 0; e < 4; ++e) { o[8 * i + 2 * e] += p * bflo(w[e]); o[8 * i + 2 * e + 1] += p * bfhi(w[e]); } }
            }
        }
        const float il = 1.0f / l;
        if (c == 0) {
#pragma unroll
            for (int d = 0; d < 64; d += 4) *(f32x4*)(st + d) = (f32x4){o[d] * il, o[d + 1] * il, o[d + 2] * il, o[d + 3] * il};
        } else {
            float ss = 0.f;
#pragma unroll
            for (int d = 0; d < 64; d += 4) { const f32x4 a = *(const f32x4*)(st + d);
#pragma unroll
                for (int e = 0; e < 4; ++e) { o[d + e] = a[e] - lam * (o[d + e] * il); ss += o[d + e] * o[d + e]; } }
            ss += __shfl_xor(ss, 32);
            const float rn = (1.0f / sqrtf(ss * (1.0f / 128.0f) + RMS_EPS)) * (1.0f - lam_init);
            bf16* op = mixed + (size_t)t * DM + h * 128 + half * 64; const float* gp = subln + half * 64;
#pragma unroll
            for (int d = 0; d < 64; d += 8) { u32x4 w;
#pragma unroll
                for (int e = 0; e < 4; ++e) w[e] = f2bf(o[d + 2 * e] * rn * gp[d + 2 * e]) | (f2bf(o[d + 2 * e + 1] * rn * gp[d + 2 * e + 1]) << 16);
                *(u32x4*)(op + d) = w; }
        }
    }
}

constexpr size_t MiB = 1u << 20;
constexpr size_t WS_RINV = 1 * MiB, WS_WIN = 2 * MiB, WS_WOUT = 28 * MiB, WS_WUP = 36 * MiB, WS_WDOWN = 68 * MiB, WS_XB = 100 * MiB, WS_Q = 164 * MiB, WS_K = 196 * MiB, WS_V = 228 * MiB,
                 WS_RW = 260 * MiB, WS_MIXED = 372 * MiB, WS_U = 164 * MiB, WS_VFIRST = 436 * MiB, WS_SR = 500 * MiB, WS_SW = 564 * MiB, WS_SK = 628 * MiB, WS_SV = 692 * MiB, WS_SA = 756 * MiB,
                 WS_SB = 820 * MiB, WS_G = 884 * MiB, WS_Y = 948 * MiB, WS_STASH = 500 * MiB, WS_END = 1012 * MiB;
constexpr int GEMM_LDS = 131072;

extern "C" void kernel_launch(void* const* d_in, const int* in_sizes, int n_in, void* d_out, int out_size, void* d_ws, size_t ws_size, hipStream_t stream) {
    static int ok = 0;
    if (ok == 0) {
        ok = 1;
        if (n_in != 26 || ws_size < WS_END || out_size != T_ * DM) { fprintf(stderr, "kernel_launch: unexpected shapes (n_in %d ws %zu out %d)\n", n_in, ws_size, out_size); ok = -1; }
        if (hipFuncSetAttribute((const void*)k_gemm<pg8::EpiIn>, hipFuncAttributeMaxDynamicSharedMemorySize, GEMM_LDS) != hipSuccess) ok = -1;
        if (hipFuncSetAttribute((const void*)k_gemm<pg8::EpiRes>, hipFuncAttributeMaxDynamicSharedMemorySize, GEMM_LDS) != hipSuccess) ok = -1;
        if (hipFuncSetAttribute((const void*)k_gemm<pg8::EpiUp>, hipFuncAttributeMaxDynamicSharedMemorySize, GEMM_LDS) != hipSuccess) ok = -1;
        if (hipFuncSetAttribute((const void*)k_rwkv_prep, hipFuncAttributeMaxDynamicSharedMemorySize, 96 * 1024) != hipSuccess) ok = -1;
    }
    if (ok < 0) return;
    const float* const* in = (const float* const*)d_in;
    unsigned char* ws = (unsigned char*)d_ws; float* x = (float*)d_out;
    float* rinv = (float*)(ws + WS_RINV);
    bf16 *wt_in = (bf16*)(ws + WS_WIN), *wt_out = (bf16*)(ws + WS_WOUT), *wt_up = (bf16*)(ws + WS_WUP), *wt_down = (bf16*)(ws + WS_WDOWN), *xb = (bf16*)(ws + WS_XB), *qb = (bf16*)(ws + WS_Q), *kb = (bf16*)(ws + WS_K),
         *vb = (bf16*)(ws + WS_V), *rwb = (bf16*)(ws + WS_RW), *mixed = (bf16*)(ws + WS_MIXED), *ub = (bf16*)(ws + WS_U);
    float *vfirst = (float*)(ws + WS_VFIRST), *SR = (float*)(ws + WS_SR), *SW = (float*)(ws + WS_SW), *SK = (float*)(ws + WS_SK), *SV = (float*)(ws + WS_SV), *SA = (float*)(ws + WS_SA), *SB = (float*)(ws + WS_SB),
          *G = (float*)(ws + WS_G), *Y = (float*)(ws + WS_Y), *stash = (float*)(ws + WS_STASH);
    for (int l = 0; l < NL; ++l) {
        k_convw<true><<<dim3(DM / 64, NIN / 64), 256, 0, stream>>>(in[3] + (size_t)l * DM * PW, wt_in, in[1] + (size_t)l * DM, DM, PW, NIN);
        k_convw<false><<<dim3(DM / 64, DM / 64), 256, 0, stream>>>(in[4] + (size_t)l * DM * DM, wt_out, nullptr, DM, DM, DM);
        k_convw<false><<<dim3(DM / 64, DFF / 64), 256, 0, stream>>>(in[24] + (size_t)l * DM * DFF, wt_up, in[2] + (size_t)l * DM, DM, DFF, DFF);
        k_convw<false><<<dim3(DFF / 64, DM / 64), 256, 0, stream>>>(in[25] + (size_t)l * DFF * DM, wt_down, nullptr, DFF, DM, DM);
        k_rownorm<<<T_ / 4, 256, 0, stream>>>(l == 0 ? in[0] : x, l == 0 ? x : nullptr, xb, rinv);
        { pg8::Gemm g{xb, wt_in, T_, NIN, DM, 0}; pg8::EpiIn E{}; E.rinv = rinv; E.q = qb; E.k = kb; E.v = vb; E.rw = rwb; E.gq = in[5] + l * 128; E.gk = in[6] + l * 128;
          k_gemm<pg8::EpiIn><<<256, 512, GEMM_LDS, stream>>>(g, E); }
        { PrepArgs A{}; A.rw = rwb; A.mu = in[10] + (size_t)l * 3360; A.w0 = in[11] + l * 1024; A.w2 = in[12] + (size_t)l * 64 * 1024; A.a0 = in[13] + l * 1024; A.a2 = in[14] + (size_t)l * 64 * 1024;
          A.g2 = in[15] + (size_t)l * 160 * 1024; A.k_k = in[16] + l * 1024; A.k_a = in[17] + l * 1024;
          A.v0 = l > 0 ? in[21] + (l - 1) * 1024 : nullptr; A.v1 = l > 0 ? in[22] + (size_t)(l - 1) * 1024 * 32 : nullptr; A.v2 = l > 0 ? in[23] + (size_t)(l - 1) * 32 * 1024 : nullptr;
          A.vfirst = vfirst; A.SR = SR; A.SW = SW; A.SK = SK; A.SV = SV; A.SA = SA; A.SB = SB; A.G = G; A.layer = l;
          k_rwkv_prep<<<T_ / 16, 256, (16 * 64 * 2 + 16 * 160 + 16 * 32 + 16 * 1024) * 4, stream>>>(A); }
        k_rwkv_scan<<<256, 256, 0, stream>>>(SR, SW, SK, SV, SA, SB, Y);
        k_rwkv_out<<<T_ * 16 / 4, 256, 0, stream>>>(Y, SR, SK, SV, G, in[19] + l * 1024, in[20] + l * 1024, in[18] + l * 1024, mixed);
        { const float lam_init = (float)(0.8 - 0.6 * exp(-0.3 * (double)l));
          k_attn_simple<<<1024, 256, 0, stream>>>(qb, kb, vb, mixed, stash, in[7] + l * 128, in[8] + l * 128, in[9] + l * 128, lam_init); }
        { pg8::Gemm g{mixed, wt_out, T_, DM, DM, 0}; pg8::EpiRes E{}; E.x = x; E.ldc = DM; k_gemm<pg8::EpiRes><<<256, 512, GEMM_LDS, stream>>>(g, E); }
        k_rownorm<<<T_ / 4, 256, 0, stream>>>(x, nullptr, xb, rinv);
        { pg8::Gemm g{xb, wt_up, T_, DFF, DM, 0}; pg8::EpiUp E{}; E.rinv = rinv; E.o = ub; E.ldc = DFF; k_gemm<pg8::EpiUp><<<256, 512, GEMM_LDS, stream>>>(g, E); }
        { pg8::Gemm g{ub, wt_down, T_, DM, DFF, 0}; pg8::EpiRes E{}; E.x = x; E.ldc = DM; k_gemm<pg8::EpiRes><<<256, 512, GEMM_LDS, stream>>>(g, E); }
    }
}
```

```cpp
#include <hip/hip_runtime.h>
#include <cstdio>
#include <cstdint>
#include <cmath>
namespace pg8 {
#define PG8_LAS __attribute__((address_space(3)))
typedef unsigned short bf16_t;
typedef short bf16x8 __attribute__((ext_vector_type(8)));
typedef float f32x4 __attribute__((ext_vector_type(4)));
typedef unsigned u32x4 __attribute__((ext_vector_type(4)));
constexpr int BM = 256, BK = 64, HALF = 128, HTB = HALF * BK * 2  , STAGE_BYTES = 8 * HTB, NXCD = 8, WGM = 8;

__host__ __device__ __forceinline__ int lds_byte(int r, int c) { const int st = (r >> 4) * 2 + (c >> 5), rr = r & 15, cc = c & 31, ob = rr * 64 + cc * 2; return st * 1024 + (ob ^ (((ob >> 9) & 1) << 5)); }
__host__ __device__ __forceinline__ void stage_rc(int b, int& R, int& C) { const int st = b / 1024, sb = b % 1024, swz = sb ^ (((sb >> 9) & 1) << 5); R = (st >> 1) * 16 + swz / 64; C = (st & 1) * 32 + (swz % 64) / 2; }
__host__ __device__ __forceinline__ int perm32(int rho) { const int n = rho >> 4, i = rho & 15; return 8 * (i >> 2) + 4 * n + (i & 3); }

struct Unit { int pm, pn; };
struct Gemm { const bf16_t* A; const bf16_t* Bt; int M, N, K, pad_; };

struct StaticOrder {
    int nM, nN, nwg, G, c;
    __host__ __device__ void init(int M, int N, int G_, int c_) { nM = M / BM; nN = N / BM; nwg = nM * nN; G = G_; c = c_; }
    __host__ __device__ bool next(int i, Unit& u) const {
        const long L = (long)i * G + c; if (L >= nwg) return false;
        int wgid = (int)L; { const int q = nwg / NXCD, r = nwg % NXCD, xcd = wgid % NXCD, off = wgid / NXCD; wgid = (xcd < r ? xcd * (q + 1) : r * (q + 1) + (xcd - r) * q) + off; }
        const int nig = WGM * nN, gid = wgid / nig, fm = gid * WGM, gsz = (nM - fm) < WGM ? (nM - fm) : WGM;
        u.pm = fm + ((wgid % nig) % gsz); u.pn = (wgid % nig) / gsz; return true;
    }
    __device__ __forceinline__ void a_ready(const Unit&) const {}
    __device__ __forceinline__ void done(const Unit&) const {}
};

__device__ __forceinline__ unsigned cvt_pk_bf16(float lo, float hi) { unsigned r; asm volatile("v_cvt_pk_bf16_f32 %0, %1, %2" : "=v"(r) : "v"(lo), "v"(hi)); return r; }
typedef float f32x2 __attribute__((ext_vector_type(2)));
struct EpiIn {
    static constexpr bool PERM = true, AFTER_DRAIN = false;
    const float* rinv; bf16_t* q; bf16_t* k; bf16_t* v; bf16_t* rw; const float* gq; const float* gk;
    __device__ __forceinline__ void operator()(const f32x4 (&acc)[2][2][4][2], const Unit& u, int wr, int wc, int fr, int fq) const {
        const int pn = u.pn;
        const int row0 = u.pm * BM + wr * 64 + fr;
        if (pn < 8) {
            const float* g = (pn < 4 ? gq : gk) + (wc & 1) * 64 + 8 * fq;
            f32x4 gv[2][2];
#pragma unroll
            for (int bj = 0; bj < 2; ++bj)
#pragma unroll
                for (int n = 0; n < 2; ++n) gv[bj][n] = *(const f32x4*)(g + 32 * bj + 4 * n);
            bf16_t* base = (pn < 4 ? q : k) + (pn & 3) * 256 + 64 * wc + 8 * fq;
#pragma unroll
            for (int ai = 0; ai < 2; ++ai)
#pragma unroll
                for (int m = 0; m < 4; ++m) {
                    const int row = row0 + ai * HALF + m * 16; const float ri = rinv[row];
                    f32x4 vv[2][2]; float ss = 0.f;
#pragma unroll
                    for (int bj = 0; bj < 2; ++bj)
#pragma unroll
                        for (int n = 0; n < 2; ++n) { vv[bj][n] = acc[ai][bj][m][n] * ri; const f32x4 t = vv[bj][n]; ss += (t[0] * t[0] + t[1] * t[1]) + (t[2] * t[2] + t[3] * t[3]); }
                    ss += __shfl_xor(ss, 16); ss += __shfl_xor(ss, 32);
                    const float rq = 1.0f / sqrtf(ss * (1.0f / 64.0f) + 1e-6f);
#pragma unroll
                    for (int bj = 0; bj < 2; ++bj) { const f32x4 a = vv[bj][0] * rq * gv[bj][0], b = vv[bj][1] * rq * gv[bj][1];
                        u32x4 w; w.x = cvt_pk_bf16(a[0], a[1]); w.y = cvt_pk_bf16(a[2], a[3]); w.z = cvt_pk_bf16(b[0], b[1]); w.w = cvt_pk_bf16(b[2], b[3]);
                        *(u32x4*)(base + (size_t)row * 1024 + 32 * bj) = w; }
                }
        } else {
            bf16_t* base; int ld;
            if (pn < 12) { base = v + (pn - 8) * 256 + 64 * wc + 8 * fq; ld = 1024; } else { base = rw + (pn - 12) * 256 + 64 * wc + 8 * fq; ld = 3584; }
#pragma unroll
            for (int ai = 0; ai < 2; ++ai)
#pragma unroll
                for (int m = 0; m < 4; ++m) {
                    const int row = row0 + ai * HALF + m * 16; const float ri = rinv[row];
#pragma unroll
                    for (int bj = 0; bj < 2; ++bj) { const f32x4 a = acc[ai][bj][m][0] * ri, b = acc[ai][bj][m][1] * ri;
                        u32x4 w; w.x = cvt_pk_bf16(a[0], a[1]); w.y = cvt_pk_bf16(a[2], a[3]); w.z = cvt_pk_bf16(b[0], b[1]); w.w = cvt_pk_bf16(b[2], b[3]);
                        *(u32x4*)(base + (size_t)row * ld + 32 * bj) = w; }
                }
        }
    }
};
struct EpiRes {
    static constexpr bool PERM = true, AFTER_DRAIN = false;
    float* x; int ldc; int pad_;
    __device__ __forceinline__ void operator()(const f32x4 (&acc)[2][2][4][2], const Unit& u, int wr, int wc, int fr, int fq) const {
        const int row0 = u.pm * BM + wr * 64 + fr, col0 = u.pn * BM + wc * 32 + 8 * fq;
#pragma unroll
        for (int ai = 0; ai < 2; ++ai)
#pragma unroll
            for (int m = 0; m < 4; ++m) { float* rowp = x + (size_t)(row0 + ai * HALF + m * 16) * ldc + col0;
#pragma unroll
                for (int bj = 0; bj < 2; ++bj) { f32x4* p = (f32x4*)(rowp + bj * HALF); const f32x4 o0 = p[0], o1 = p[1]; p[0] = o0 + acc[ai][bj][m][0]; p[1] = o1 + acc[ai][bj][m][1]; } }
    }
};
struct EpiUp {
    static constexpr bool PERM = true, AFTER_DRAIN = false;
    const float* rinv; bf16_t* o; int ldc; int pad_;
    __device__ __forceinline__ void operator()(const f32x4 (&acc)[2][2][4][2], const Unit& u, int wr, int wc, int fr, int fq) const {
        const int row0 = u.pm * BM + wr * 64 + fr, col0 = u.pn * BM + wc * 32 + 8 * fq;
#pragma unroll
        for (int ai = 0; ai < 2; ++ai)
#pragma unroll
            for (int m = 0; m < 4; ++m) { const int row = row0 + ai * HALF + m * 16; const float ri = rinv[row]; bf16_t* rowp = o + (size_t)row * ldc + col0;
#pragma unroll
                for (int bj = 0; bj < 2; ++bj) { f32x4 a = acc[ai][bj][m][0] * ri, b = acc[ai][bj][m][1] * ri;
#pragma unroll
                    for (int e = 0; e < 4; ++e) { a[e] = a[e] > 0.f ? a[e] * a[e] : 0.f; b[e] = b[e] > 0.f ? b[e] * b[e] : 0.f; }
                    u32x4 w; w.x = cvt_pk_bf16(a[0], a[1]); w.y = cvt_pk_bf16(a[2], a[3]); w.z = cvt_pk_bf16(b[0], b[1]); w.w = cvt_pk_bf16(b[2], b[3]);
                    *(u32x4*)(rowp + bj * HALF) = w; } }
    }
};
template <class Epi, class Sched, bool ALIGN_EPI = false, bool SP2 = false>
__device__ __forceinline__ void gemm_phase(PG8_LAS unsigned char* lds, const Gemm g, const Sched& S, const Epi& E) {
    const int tid = threadIdx.x, wid = __builtin_amdgcn_readfirstlane(tid >> 6), lane = tid & 63, wr = wid >> 2, wc = wid & 3, fr = lane & 15, fq = lane >> 4;
    const int K = g.K, nt = K / BK;
    unsigned voffA[2], voffB[2];
#pragma unroll
    for (int i = 0; i < 2; ++i) { int R, C; stage_rc(tid * 16 + i * 8192, R, C); const int Rb = Epi::PERM ? ((R & ~31) + perm32(R & 31)) : R;
        voffA[i] = (unsigned)(R * K + C) * 2u; voffB[i] = (unsigned)(Rb * K + C) * 2u; }
    const size_t kstep = (size_t)(BK * 2);
    const size_t hstep = (size_t)HALF * K * 2;
    const size_t tstep = 2 * hstep;
    const unsigned ldsw = (unsigned)wid * 1024u;
    const int aoff = lds_byte(wr * 64 + fr, fq * 8), boff = lds_byte(wc * 32 + fr, fq * 8);
#define PG8_SA(b, h) (((b) * 2 + (h)) * HTB)
#define PG8_SB(b, h) ((4 + (b) * 2 + (h)) * HTB)
#define PG8_STAGE(bufoff, gbase, voff) do { _Pragma("unroll") for (int _i = 0; _i < 2; ++_i) \
        __builtin_amdgcn_global_load_lds((const unsigned*)((const char*)(gbase) + (voff)[_i]), (PG8_LAS unsigned*)(lds + (bufoff) + ldsw + _i * 8192), 16, 0, 0); } while (0)
#define PG8_LDA(dst, b, h) do { _Pragma("unroll") for (int m = 0; m < 4; ++m) _Pragma("unroll") for (int k = 0; k < 2; ++k) dst[m][k] = *(const PG8_LAS bf16x8*)(lds + PG8_SA(b, h) + aoff + m * 2048 + k * 1024); } while (0)
#define PG8_LDB(dst, b, h) do { _Pragma("unroll") for (int n = 0; n < 2; ++n) _Pragma("unroll") for (int k = 0; k < 2; ++k) dst[n][k] = *(const PG8_LAS bf16x8*)(lds + PG8_SB(b, h) + boff + n * 2048 + k * 1024); } while (0)
#define PG8_MMA(ai, bj, At, Bt) do { __builtin_amdgcn_s_setprio(1); _Pragma("unroll") for (int m = 0; m < 4; ++m) _Pragma("unroll") for (int n = 0; n < 2; ++n) _Pragma("unroll") for (int k = 0; k < 2; ++k) \
        acc[ai][bj][m][n] = __builtin_amdgcn_mfma_f32_16x16x32_bf16(Bt[n][k], At[m][k], acc[ai][bj][m][n], 0, 0, 0); __builtin_amdgcn_s_setprio(0); } while (0)
#define PG8_WAIT_V(n) asm volatile("s_waitcnt vmcnt(" #n ")" ::: "memory")
#define PG8_WAIT_L(n) asm volatile("s_waitcnt lgkmcnt(" #n ")" ::: "memory")
#define PG8_BAR __builtin_amdgcn_s_barrier()
#define PG8_SCHED __builtin_amdgcn_sched_barrier(0)
    Unit cur, nxt; int ui = 0;
    if (!S.next(0, cur)) return;
    f32x4 acc[2][2][4][2];
#pragma unroll
    for (int a = 0; a < 2; ++a)
#pragma unroll
        for (int b = 0; b < 2; ++b)
#pragma unroll
            for (int m = 0; m < 4; ++m)
#pragma unroll
                for (int n = 0; n < 2; ++n) acc[a][b][m][n] = (f32x4){0.f, 0.f, 0.f, 0.f};
    bf16x8 At[4][2], B0[2][2], B1[2][2];
    const char* cA = (const char*)g.A + (size_t)cur.pm * tstep; const char* cB = (const char*)g.Bt + (size_t)cur.pn * tstep;
    S.a_ready(cur);
    if constexpr (SP2) {
        PG8_STAGE(PG8_SB(0, 0), cB, voffB); PG8_STAGE(PG8_SB(0, 1), cB + hstep, voffB); PG8_STAGE(PG8_SA(0, 0), cA, voffA); PG8_STAGE(PG8_SA(0, 1), cA + hstep, voffA);
        if (wr == 1) PG8_BAR;
        PG8_WAIT_V(2); PG8_BAR;
        PG8_STAGE(PG8_SB(1, 0), cB + kstep, voffB); PG8_STAGE(PG8_SA(1, 0), cA + kstep, voffA); PG8_STAGE(PG8_SB(1, 1), cB + hstep + kstep, voffB);
        PG8_WAIT_V(6); PG8_BAR;
    } else {
        PG8_STAGE(PG8_SB(0, 0), cB, voffB); PG8_STAGE(PG8_SA(0, 0), cA, voffA); PG8_STAGE(PG8_SB(0, 1), cB + hstep, voffB); PG8_STAGE(PG8_SA(0, 1), cA + hstep, voffA);
        if (wr == 1) PG8_BAR;
        PG8_WAIT_V(4); PG8_BAR;
        PG8_STAGE(PG8_SB(1, 0), cB + kstep, voffB); PG8_STAGE(PG8_SA(1, 0), cA + kstep, voffA); PG8_STAGE(PG8_SB(1, 1), cB + hstep + kstep, voffB);
        PG8_WAIT_V(6); PG8_BAR;
    }
    for (;;) {
        const bool has_next = S.next(ui + 1, nxt);
        const char* nA = has_next ? (const char*)g.A + (size_t)nxt.pm * tstep : cA; const char* nB = has_next ? (const char*)g.Bt + (size_t)nxt.pn * tstep : cB;
        for (int t = 0; t < nt; t += 2) {
            const bool last = (t == nt - 2);
            const char* a1 = cA + (size_t)(t + 1) * kstep;
            const char* a2 = last ? nA : cA + (size_t)(t + 2) * kstep; const char* b2 = last ? nB : cB + (size_t)(t + 2) * kstep;
            const char* a3 = a2 + kstep; const char* b3 = b2 + kstep;
            if (last && has_next) S.a_ready(nxt);
            if constexpr (SP2) {
            PG8_LDB(B0, 0, 0); PG8_LDB(B1, 0, 1); PG8_SCHED; PG8_LDA(At, 0, 0); PG8_STAGE(PG8_SA(1, 1), a1 + hstep, voffA);
            PG8_WAIT_V(8); PG8_WAIT_L(0); PG8_BAR; PG8_MMA(0, 0, At, B0); PG8_MMA(0, 1, At, B1); PG8_BAR; PG8_SCHED;
            PG8_LDA(At, 0, 1); PG8_STAGE(PG8_SB(0, 0), b2, voffB); PG8_STAGE(PG8_SB(0, 1), b2 + hstep, voffB); PG8_STAGE(PG8_SA(0, 0), a2, voffA);
            PG8_WAIT_V(8); PG8_WAIT_L(0); PG8_BAR; PG8_MMA(1, 0, At, B0); PG8_MMA(1, 1, At, B1); PG8_BAR; PG8_SCHED;
            PG8_LDB(B0, 1, 0); PG8_LDB(B1, 1, 1); PG8_SCHED; PG8_LDA(At, 1, 0); PG8_STAGE(PG8_SA(0, 1), a2 + hstep, voffA);
            PG8_WAIT_V(8); PG8_WAIT_L(0); PG8_BAR; PG8_MMA(0, 0, At, B0); PG8_MMA(0, 1, At, B1); PG8_BAR; PG8_SCHED;
            PG8_LDA(At, 1, 1); PG8_STAGE(PG8_SB(1, 0), b3, voffB); PG8_STAGE(PG8_SB(1, 1), b3 + hstep, voffB); PG8_STAGE(PG8_SA(1, 0), a3, voffA);
            PG8_WAIT_V(8); PG8_WAIT_L(0); PG8_BAR; PG8_MMA(1, 0, At, B0); PG8_MMA(1, 1, At, B1); PG8_BAR; PG8_SCHED;
            } else {
            PG8_LDB(B0, 0, 0); PG8_SCHED; PG8_LDA(At, 0, 0); PG8_STAGE(PG8_SA(1, 1), a1 + hstep, voffA);
            PG8_WAIT_L(8); PG8_BAR; PG8_WAIT_L(0); PG8_MMA(0, 0, At, B0); PG8_BAR; PG8_SCHED;
            PG8_LDB(B1, 0, 1); PG8_STAGE(PG8_SB(0, 0), b2, voffB);
            PG8_BAR; PG8_WAIT_L(0); PG8_MMA(0, 1, At, B1); PG8_BAR;
            PG8_LDA(At, 0, 1); PG8_STAGE(PG8_SA(0, 0), a2, voffA);
            PG8_BAR; PG8_WAIT_L(0); PG8_MMA(1, 0, At, B0); PG8_BAR; PG8_SCHED;
            PG8_STAGE(PG8_SB(0, 1), b2 + hstep, voffB);
            PG8_WAIT_V(6); PG8_BAR; PG8_MMA(1, 1, At, B1); PG8_BAR;
            PG8_LDB(B0, 1, 0); PG8_SCHED; PG8_LDA(At, 1, 0); PG8_STAGE(PG8_SA(0, 1), a2 + hstep, voffA);
            PG8_WAIT_L(8); PG8_BAR; PG8_WAIT_L(0); PG8_MMA(0, 0, At, B0); PG8_BAR; PG8_SCHED;
            PG8_LDB(B1, 1, 1); PG8_STAGE(PG8_SB(1, 0), b3, voffB);
            PG8_BAR; PG8_WAIT_L(0); PG8_MMA(0, 1, At, B1); PG8_BAR;
            PG8_LDA(At, 1, 1); PG8_STAGE(PG8_SA(1, 0), a3, voffA);
            PG8_BAR; PG8_WAIT_L(0); PG8_MMA(1, 0, At, B0); PG8_BAR; PG8_SCHED;
            PG8_STAGE(PG8_SB(1, 1), b3 + hstep, voffB);
            PG8_WAIT_V(6); PG8_BAR; PG8_MMA(1, 1, At, B1); PG8_BAR;
            }
        }
        if constexpr (ALIGN_EPI) { if (wr == 0) PG8_BAR; }
        if constexpr (!Epi::AFTER_DRAIN) { E(acc, cur, wr, wc, fr, fq); S.done(cur); }
        if (!has_next) break;
#pragma unroll
        for (int a = 0; a < 2; ++a)
#pragma unroll
            for (int b = 0; b < 2; ++b)
#pragma unroll
                for (int m = 0; m < 4; ++m)
#pragma unroll
                    for (int n = 0; n < 2; ++n) acc[a][b][m][n] = (f32x4){0.f, 0.f, 0.f, 0.f};
        cur = nxt; cA = nA; cB = nB; ++ui;
        if constexpr (ALIGN_EPI) { if (wr == 1) PG8_BAR; }
    }
    PG8_WAIT_V(0);
    if constexpr (!ALIGN_EPI) { if (wr == 0) PG8_BAR; }
    PG8_BAR;
    if constexpr (Epi::AFTER_DRAIN) { E.fused(acc, cur, wr, wc, fr, fq, lds, wid, lane); S.done(cur); }
#undef PG8_SA
#undef PG8_SB
#undef PG8_STAGE
#undef PG8_LDA
#undef PG8_LDB
#undef PG8_MMA
#undef PG8_WAIT_V
#undef PG8_WAIT_L
#undef PG8_BAR
#undef PG8_SCHED
}
}

constexpr int T_ = 16384, DM = 2048, NL = 4, PW = 6432, NIN = 6656, RWP = 3584, DFF = 8192, RW_ = 1024;
constexpr float RMS_EPS = 1e-6f, GN_EPS = 64e-5f;
typedef unsigned short bf16;
typedef float f32x4 __attribute__((ext_vector_type(4)));
typedef unsigned u32x4 __attribute__((ext_vector_type(4)));
typedef unsigned u32x2 __attribute__((ext_vector_type(2)));

__device__ __forceinline__ unsigned f2bf(float f) { unsigned u = __builtin_bit_cast(unsigned, f); return (u + 0x7fffu + ((u >> 16) & 1u)) >> 16; }
__device__ __forceinline__ float bf2f(unsigned short b) { return __builtin_bit_cast(float, (unsigned)b << 16); }
__device__ __forceinline__ float bflo(unsigned w) { return __builtin_bit_cast(float, w << 16); }
__device__ __forceinline__ float bfhi(unsigned w) { return __builtin_bit_cast(float, w & 0xffff0000u); }
__device__ __forceinline__ float sigmoidf_(float x) { return 1.0f / (1.0f + __expf(-x)); }

template <int CTRL, int ROWMASK> __device__ __forceinline__ float dppf(float v) {
    return __builtin_bit_cast(float, __builtin_amdgcn_update_dpp(0, __builtin_bit_cast(int, v), CTRL, ROWMASK, 0xF, false));
}
__device__ __forceinline__ float wave_sum(float v) {
    v += dppf<0xB1, 0xF>(v); v += dppf<0x4E, 0xF>(v); v += dppf<0x141, 0xF>(v); v += dppf<0x140, 0xF>(v);
    v += dppf<0x142, 0xA>(v); v += dppf<0x143, 0xC>(v);
    return __builtin_bit_cast(float, __builtin_amdgcn_readlane(__builtin_bit_cast(int, v), 63));
}

template <bool PERMIN> __global__ void __launch_bounds__(256) k_convw(const float* __restrict__ src, bf16* __restrict__ dst, const float* __restrict__ g, int K, int N, int Nd) {
    __shared__ float tile[64][65];
    const int k0 = blockIdx.x * 64, c0 = blockIdx.y * 64, tid = threadIdx.x;
    for (int i = tid; i < 64 * 64; i += 256) {
        const int kk = i >> 6, cc = i & 63, cp = c0 + cc;
        int col = cp;
        if (PERMIN) { const int lo = cp & 255, bj = lo >> 7, wc = (lo >> 5) & 3, j = lo & 31; col = (cp & ~255) + 64 * wc + 32 * bj + j; }
        float v = 0.f;
        if (col < N) { v = src[(size_t)(k0 + kk) * N + col]; if (g) v *= g[k0 + kk]; }
        tile[kk][cc] = v;
    }
    __syncthreads();
    for (int i = tid; i < 64 * 64; i += 256) {
        const int cc = i >> 6, kk = i & 63;
        dst[(size_t)(c0 + cc) * K + k0 + kk] = (bf16)f2bf(tile[kk][cc]);
    }
}

__global__ void __launch_bounds__(256) k_rownorm(const float* __restrict__ src, float* __restrict__ copy, bf16* __restrict__ xb, float* __restrict__ rinv) {
    const int row = blockIdx.x * 4 + (threadIdx.x >> 6), lane = threadIdx.x & 63;
    const f32x4* s = (const f32x4*)(src + (size_t)row * DM);
    float ss = 0.f;
#pragma unroll
    for (int j = 0; j < 8; ++j) { const f32x4 v = s[lane + 64 * j]; ss += (v[0] * v[0] + v[1] * v[1]) + (v[2] * v[2] + v[3] * v[3]);
        if (copy) ((f32x4*)(copy + (size_t)row * DM))[lane + 64 * j] = v;
        u32x2 w; w.x = f2bf(v[0]) | (f2bf(v[1]) << 16); w.y = f2bf(v[2]) | (f2bf(v[3]) << 16);
        ((u32x2*)(xb + (size_t)row * DM))[lane + 64 * j] = w; }
    ss = wave_sum(ss);
    if (lane == 0) rinv[row] = 1.0f / sqrtf(ss * (1.0f / DM) + RMS_EPS);
}

template <class Epi> __global__ void __launch_bounds__(512, 2) k_gemm(pg8::Gemm g, Epi E) {
    extern __shared__ __attribute__((aligned(16))) unsigned char lds[];
    pg8::StaticOrder S; S.init(g.M, g.N, (int)gridDim.x, (int)blockIdx.x);
    pg8::gemm_phase<Epi, pg8::StaticOrder, true, true>((PG8_LAS unsigned char*)lds, g, S, E);
}

struct PrepArgs {
    const bf16* rw; const float* mu; const float* w0; const float* w2; const float* a0; const float* a2; const float* g2; const float* k_k; const float* k_a;
    const float* v0; const float* v1; const float* v2; float* vfirst; float* SR; float* SW; float* SK; float* SV; float* SA; float* SB; float* G; int layer; int pad_;
};
__device__ __forceinline__ float rwshift(const bf16* rw, const float* mu, int t, int col) {
    const float p = bf2f(rw[(size_t)t * RWP + col]); const float pp = t > 0 ? bf2f(rw[(size_t)(t - 1) * RWP + col]) : 0.f;
    return p + mu[col] * (pp - p);
}
__global__ void __launch_bounds__(256) k_rwkv_prep(PrepArgs A) {
    extern __shared__ __attribute__((aligned(16))) unsigned char lds_raw[];
    float* lat_w = (float*)lds_raw;
    float* lat_a = lat_w + 16 * 64;
    float* lat_g = lat_a + 16 * 64;
    float* vlat = lat_g + 16 * 160;
    float* vr_s = vlat + 16 * 32;
    const int tid = threadIdx.x, t0 = blockIdx.x * 16, c4 = 4 * tid;
    for (int idx = tid; idx < 16 * 288; idx += 256) {
        const int tok = idx / 288, j = idx % 288; const float s = rwshift(A.rw, A.mu, t0 + tok, 3072 + j);
        if (j < 64) lat_w[tok * 64 + j] = tanhf(s); else if (j < 128) lat_a[tok * 64 + j - 64] = s; else lat_g[tok * 160 + j - 128] = sigmoidf_(s);
    }
    for (int tok = 0; tok < 16; ++tok)
#pragma unroll
        for (int e = 0; e < 4; ++e) vr_s[tok * 1024 + c4 + e] = rwshift(A.rw, A.mu, t0 + tok, 2048 + c4 + e);
    __syncthreads();
    if (A.layer > 0) {
        const int o = tid & 31, tg = tid >> 5; float a0 = 0.f, a1 = 0.f;
        for (int c = 0; c < 1024; ++c) { const float w = A.v1[c * 32 + o]; a0 += vr_s[tg * 1024 + c] * w; a1 += vr_s[(tg + 8) * 1024 + c] * w; }
        vlat[tg * 32 + o] = a0; vlat[(tg + 8) * 32 + o] = a1;
    }
    __syncthreads();
    f32x4 acc[16], ar[16];
#pragma unroll
    for (int tok = 0; tok < 16; ++tok) acc[tok] = (f32x4){0.f, 0.f, 0.f, 0.f};
    for (int i = 0; i < 64; ++i) { const f32x4 w = *(const f32x4*)(A.w2 + (size_t)i * 1024 + c4);
#pragma unroll
        for (int tok = 0; tok < 16; ++tok) acc[tok] += w * lat_w[tok * 64 + i]; }
    { const f32x4 w0 = *(const f32x4*)(A.w0 + c4);
#pragma unroll
      for (int tok = 0; tok < 16; ++tok) { f32x4 o;
#pragma unroll
        for (int e = 0; e < 4; ++e) { const float z = -(w0[e] + acc[tok][e]); const float sp = fmaxf(z, 0.f) + log1pf(__expf(-fabsf(z))); const float wl = -sp - 0.5f; o[e] = __expf(-__expf(wl)); }
        *(f32x4*)(A.SW + (size_t)(t0 + tok) * 1024 + c4) = o; } }
#pragma unroll
    for (int tok = 0; tok < 16; ++tok) acc[tok] = (f32x4){0.f, 0.f, 0.f, 0.f};
    for (int i = 0; i < 64; ++i) { const f32x4 w = *(const f32x4*)(A.a2 + (size_t)i * 1024 + c4);
#pragma unroll
        for (int tok = 0; tok < 16; ++tok) acc[tok] += w * lat_a[tok * 64 + i]; }
    { const f32x4 a0 = *(const f32x4*)(A.a0 + c4);
#pragma unroll
      for (int tok = 0; tok < 16; ++tok)
#pragma unroll
        for (int e = 0; e < 4; ++e) ar[tok][e] = sigmoidf_(a0[e] + acc[tok][e]); }
    { const f32x4 kkw = *(const f32x4*)(A.k_k + c4), kaw = *(const f32x4*)(A.k_a + c4);
      for (int tok = 0; tok < 16; ++tok) { f32x4 kr, kkv; float ss = 0.f;
#pragma unroll
        for (int e = 0; e < 4; ++e) { kr[e] = rwshift(A.rw, A.mu, t0 + tok, 1024 + c4 + e); kkv[e] = kr[e] * kkw[e]; ss += kkv[e] * kkv[e]; }
        ss += __shfl_xor(ss, 1); ss += __shfl_xor(ss, 2); ss += __shfl_xor(ss, 4); ss += __shfl_xor(ss, 8);
        const float inv = 1.0f / fmaxf(sqrtf(ss), 1e-12f); f32x4 oa, ob, ok;
#pragma unroll
        for (int e = 0; e < 4; ++e) { const float kk = kkv[e] * inv; oa[e] = -kk; ob[e] = kk * ar[tok][e]; ok[e] = kr[e] * (1.0f + (ar[tok][e] - 1.0f) * kaw[e]); }
        const size_t off = (size_t)(t0 + tok) * 1024 + c4;
        *(f32x4*)(A.SA + off) = oa; *(f32x4*)(A.SB + off) = ob; *(f32x4*)(A.SK + off) = ok; } }
#pragma unroll
    for (int tok = 0; tok < 16; ++tok) acc[tok] = (f32x4){0.f, 0.f, 0.f, 0.f};
    for (int i = 0; i < 160; ++i) { const f32x4 w = *(const f32x4*)(A.g2 + (size_t)i * 1024 + c4);
#pragma unroll
        for (int tok = 0; tok < 16; ++tok) acc[tok] += w * lat_g[tok * 160 + i]; }
#pragma unroll
    for (int tok = 0; tok < 16; ++tok) *(f32x4*)(A.G + (size_t)(t0 + tok) * 1024 + c4) = acc[tok];
    if (A.layer == 0) {
        for (int tok = 0; tok < 16; ++tok) { const f32x4 vr = *(const f32x4*)(vr_s + tok * 1024 + c4); const size_t off = (size_t)(t0 + tok) * 1024 + c4;
            *(f32x4*)(A.vfirst + off) = vr; *(f32x4*)(A.SV + off) = vr; }
    } else {
#pragma unroll
        for (int tok = 0; tok < 16; ++tok) acc[tok] = (f32x4){0.f, 0.f, 0.f, 0.f};
        for (int i = 0; i < 32; ++i) { const f32x4 w = *(const f32x4*)(A.v2 + (size_t)i * 1024 + c4);
#pragma unroll
            for (int tok = 0; tok < 16; ++tok) acc[tok] += w * vlat[tok * 32 + i]; }
        const f32x4 v0 = *(const f32x4*)(A.v0 + c4);
#pragma unroll
        for (int tok = 0; tok < 16; ++tok) { const f32x4 vr = *(const f32x4*)(vr_s + tok * 1024 + c4); const size_t off = (size_t)(t0 + tok) * 1024 + c4; const f32x4 vf = *(const f32x4*)(A.vfirst + off); f32x4 o;
#pragma unroll
            for (int e = 0; e < 4; ++e) { const float gt = sigmoidf_(v0[e] + acc[tok][e]); o[e] = vr[e] + (vf[e] - vr[e]) * gt; }
            *(f32x4*)(A.SV + off) = o; }
    }
    for (int tok = 0; tok < 16; ++tok) { f32x4 o;
#pragma unroll
        for (int e = 0; e < 4; ++e) o[e] = rwshift(A.rw, A.mu, t0 + tok, c4 + e);
        *(f32x4*)(A.SR + (size_t)(t0 + tok) * 1024 + c4) = o; }
}

__global__ void __launch_bounds__(256) k_rwkv_scan(const float* __restrict__ SR, const float* __restrict__ SW, const float* __restrict__ SK, const float* __restrict__ SV,
                                                   const float* __restrict__ SA, const float* __restrict__ SB, float* __restrict__ Y) {
    const int gw = blockIdx.x * 4 + (threadIdx.x >> 6), lane = threadIdx.x & 63, h = gw >> 6, i = gw & 63;
    const size_t base = (size_t)h * 64 + lane, vb = (size_t)h * 64 + i;
    float S = 0.f;
    for (int t = 0; t < T_; t += 4) {
        float r[4], w[4], k[4], a[4], b[4], v[4];
#pragma unroll
        for (int s = 0; s < 4; ++s) { const size_t o = (size_t)(t + s) * 1024 + base; r[s] = SR[o]; w[s] = SW[o]; k[s] = SK[o]; a[s] = SA[o]; b[s] = SB[o]; v[s] = SV[(size_t)(t + s) * 1024 + vb]; }
#pragma unroll
        for (int s = 0; s < 4; ++s) {
            const float sa = wave_sum(S * a[s]);
            S = S * w[s] + sa * b[s] + v[s] * k[s];
            const float y = wave_sum(S * r[s]);
            if (lane == 0) Y[(size_t)(t + s) * 1024 + vb] = y;
        }
    }
}
__global__ void __launch_bounds__(256) k_rwkv_out(const float* __restrict__ Y, const float* __restrict__ SR, const float* __restrict__ SK, const float* __restrict__ SV, const float* __restrict__ G,
                                                  const float* __restrict__ ln_w, const float* __restrict__ ln_b, const float* __restrict__ r_k, bf16* __restrict__ mixed) {
    const int gw = blockIdx.x * 4 + (threadIdx.x >> 6), lane = threadIdx.x & 63, t = gw >> 4, h = gw & 15, c = h * 64 + lane;
    const size_t o = (size_t)t * 1024 + c;
    const float y = Y[o]; const float mean = wave_sum(y) * (1.0f / 64.0f); const float d = y - mean; const float var = wave_sum(d * d) * (1.0f / 64.0f);
    float yn = d * (1.0f / sqrtf(var + GN_EPS)); yn = yn * ln_w[c] + ln_b[c];
    const float bonus = wave_sum(SR[o] * SK[o] * r_k[c]) * SV[o];
    mixed[(size_t)t * DM + 1024 + c] = (bf16)f2bf((yn + bonus) * G[o]);
}


namespace att {
typedef short bf16x8 __attribute__((ext_vector_type(8)));
typedef short s16x4 __attribute__((ext_vector_type(4)));
typedef float f32x16 __attribute__((ext_vector_type(16)));
typedef float f32x2_t __attribute__((ext_vector_type(2)));
typedef __bf16 bf16x2_t __attribute__((ext_vector_type(2)));
typedef __attribute__((address_space(3))) const unsigned char* lds_cptr;
typedef short v4i16_t __attribute__((ext_vector_type(4)));
constexpr int KSLOT = 8192, VSLOT = 16384, LDS_K = 0, LDS_V = 2 * KSLOT, LDS_BYTES = 2 * KSLOT + 2 * VSLOT;
constexpr float LOG2E = 1.4426950408889634f, C2 = 0.125f * LOG2E;
__device__ __forceinline__ int crow(int r, int hi) { return (r & 3) + 8 * (r >> 2) + 4 * hi; }
__device__ __forceinline__ void glds16(const void* gsrc, unsigned lds_dst) { unsigned keep;
    asm volatile("s_mov_b32 %0, m0\n\ts_mov_b32 m0, %2\n\ts_nop 0\n\tglobal_load_lds_dwordx4 %1, off\n\ts_mov_b32 m0, %0" : "=&s"(keep) : "v"(gsrc), "s"(lds_dst) : "memory"); }
__device__ __forceinline__ unsigned cvtpk(float lo, float hi) { f32x2_t v = {lo, hi}; bf16x2_t b = __builtin_convertvector(v, bf16x2_t); return __builtin_bit_cast(unsigned, b); }
__device__ __forceinline__ s16x4 vtr(lds_cptr p) { return __builtin_bit_cast(s16x4, __builtin_amdgcn_ds_read_tr16_b64_v4i16((__attribute__((address_space(3))) v4i16_t*)p)); }
__device__ __forceinline__ float swap_max(float m) { auto rr = __builtin_amdgcn_permlane32_swap(__float_as_uint(m), __float_as_uint(m), false, false); return fmaxf(__uint_as_float(rr[0]), __uint_as_float(rr[1])); }
__device__ __forceinline__ float swap_sum(float m) { auto rr = __builtin_amdgcn_permlane32_swap(__float_as_uint(m), __float_as_uint(m), false, false); return __uint_as_float(rr[0]) + __uint_as_float(rr[1]); }
#define ATT_WAIT_BAR() asm volatile("s_waitcnt vmcnt(0) lgkmcnt(0)\n\ts_barrier" ::: "memory")

struct Args { const bf16* Q; const bf16* K; const bf16* V; bf16* mixed; float* stash; const float* lq; const float* lk; const float* subln; float lam_init; int pad_; };

__device__ __forceinline__ void attn_unit(__attribute__((address_space(3))) unsigned char* lds, const Args& A, int h, int qb, float lam, float* stash_blk) {
    const int tid = threadIdx.x, lane = tid & 63, r32 = lane & 31, hi = lane >> 5; const int wid = __builtin_amdgcn_readfirstlane(tid >> 6);
    const int q0 = qb * 256 + wid * 32, qc = q0 >> 6, NT = 4 * qb + 4;
    const float slope2 = exp2f(-(float)(h + 1)) * LOG2E;
    const unsigned lds0 = (unsigned)(uintptr_t)lds;
    const lds_cptr kp0 = (lds_cptr)lds + LDS_K + hi * 1024 + r32 * 16;
    const lds_cptr vp0 = (lds_cptr)lds + LDS_V + ((lane >> 4) & 1) * 32 + (lane & 3) * 8 + (4 * hi + ((lane & 15) >> 2)) * 64;
    const bf16* vsrc = A.V + (size_t)(16 * (wid & 3) + (lane >> 2)) * 1024 + h * 128 + (wid >> 2) * 32 + (lane & 3) * 8;
    const unsigned kdst = lds0 + LDS_K + wid * 1024, vdst = lds0 + LDS_V + (wid >> 2) * 4096 + (wid & 3) * 1024;
    const int qrel = (q0 & 63) + r32;
    float* st = stash_blk + tid * 64;
#pragma unroll 1
    for (int c = 0; c < 2; ++c) {
        const bf16* ksrc = A.K + (size_t)lane * 1024 + h * 128 + c * 64 + wid * 8;
        bf16x8 qr[4];
        { const bf16* qp = A.Q + (size_t)(q0 + r32) * 1024 + h * 128 + c * 64 + hi * 8;
#pragma unroll
          for (int d0 = 0; d0 < 4; ++d0) qr[d0] = *(const bf16x8*)(qp + d0 * 16); }
        f32x16 oT[4];
#pragma unroll
        for (int d0 = 0; d0 < 4; ++d0)
#pragma unroll
            for (int r = 0; r < 16; ++r) oT[d0][r] = 0.f;
        float l = 0.f, mu = 0.f;
        glds16(ksrc, (unsigned)__builtin_amdgcn_readfirstlane(kdst)); glds16(vsrc, (unsigned)__builtin_amdgcn_readfirstlane(vdst)); glds16(vsrc + 64, (unsigned)__builtin_amdgcn_readfirstlane(vdst + 8192));
        ATT_WAIT_BAR();
#pragma unroll 1
        for (int t = 0; t < NT; ++t) {
            const int sl = t & 1;
            if (t + 1 < NT) { const size_t go = (size_t)(t + 1) * 64 * 1024; const unsigned so = (unsigned)(sl ^ 1);
                glds16(ksrc + go, (unsigned)__builtin_amdgcn_readfirstlane(kdst + so * KSLOT)); glds16(vsrc + go, (unsigned)__builtin_amdgcn_readfirstlane(vdst + so * VSLOT));
                glds16(vsrc + go + 64, (unsigned)__builtin_amdgcn_readfirstlane(vdst + so * VSLOT + 8192)); }
            if (t <= qc) {
                const bool diag = (t == qc);
                f32x16 p0, p1;
                const float sc = slope2 * (1.0f / C2), base0 = (float)(4 * hi) * sc - mu * (1.0f / C2), base1 = base0 + 32.0f * sc;
                if (!diag) {
#pragma unroll
                    for (int r = 0; r < 16; ++r) { const float kr = (float)((r & 3) + 8 * (r >> 2)); p0[r] = __builtin_fmaf(kr, sc, base0); p1[r] = __builtin_fmaf(kr, sc, base1); }
                } else {
                    const float q2 = (float)(2 * qrel - 8 * hi);
#pragma unroll
                    for (int r = 0; r < 16; ++r) { const float kr = (float)((r & 3) + 8 * (r >> 2));
                        p0[r] = __builtin_fmaf(fminf(kr, q2 - kr) , sc, base0); p1[r] = __builtin_fmaf(fminf(kr, q2 - 64.0f - kr), sc, base1); }
                }
                const lds_cptr kp = kp0 + sl * KSLOT;
#pragma unroll
                for (int d0 = 0; d0 < 4; ++d0) {
                    const bf16x8 k0 = *(const __attribute__((address_space(3))) bf16x8*)(kp + d0 * 2048), k1 = *(const __attribute__((address_space(3))) bf16x8*)(kp + d0 * 2048 + 512);
                    p0 = __builtin_amdgcn_mfma_f32_32x32x16_bf16(k0, qr[d0], p0, 0, 0, 0);
                    p1 = __builtin_amdgcn_mfma_f32_32x32x16_bf16(k1, qr[d0], p1, 0, 0, 0);
                }
                float rm = fmaxf(p0[0], p1[0]);
#pragma unroll
                for (int r = 1; r < 16; ++r) rm = fmaxf(rm, fmaxf(p0[r], p1[r]));
                rm = swap_max(rm);
                const float dl = (t == 0) ? C2 * rm : fmaxf(C2 * rm, 0.f);
                if (__any(dl != 0.f)) { const float f = __builtin_amdgcn_exp2f(-dl); l *= f;
#pragma unroll
                    for (int d0 = 0; d0 < 4; ++d0)
#pragma unroll
                        for (int r = 0; r < 16; ++r) oT[d0][r] *= f; }
                mu += dl;
                float ls = 0.f;
#pragma unroll
                for (int r = 0; r < 16; ++r) { p0[r] = __builtin_amdgcn_exp2f(p0[r] * C2 - dl); p1[r] = __builtin_amdgcn_exp2f(p1[r] * C2 - dl); ls += p0[r] + p1[r]; }
                l += ls;
                bf16x8 pw[4];
#pragma unroll
                for (int s = 0; s < 4; ++s) { u32x4 w;
#pragma unroll
                    for (int e = 0; e < 4; ++e) { const int r = 8 * (s & 1) + 2 * e; w[e] = (s < 2) ? cvtpk(p0[r], p0[r + 1]) : cvtpk(p1[r], p1[r + 1]); }
                    pw[s] = __builtin_bit_cast(bf16x8, w); }
                const lds_cptr vp = vp0 + sl * VSLOT;
#pragma unroll
                for (int d0 = 0; d0 < 4; ++d0) {
#pragma unroll
                    for (int s = 0; s < 4; ++s) { const s16x4 lo = vtr(vp + d0 * 4096 + s * 1024), hh = vtr(vp + d0 * 4096 + s * 1024 + 512);
                        const bf16x8 vf = (bf16x8){lo[0], lo[1], lo[2], lo[3], hh[0], hh[1], hh[2], hh[3]};
                        oT[d0] = __builtin_amdgcn_mfma_f32_32x32x16_bf16(vf, pw[s], oT[d0], 0, 0, 0); }
                    __builtin_amdgcn_sched_barrier(0); }
                mu -= 64.0f * slope2;
            }
            ATT_WAIT_BAR();
        }
        const float il = 1.0f / swap_sum(l);
        if (c == 0) {
#pragma unroll
            for (int d0 = 0; d0 < 4; ++d0)
#pragma unroll
                for (int r = 0; r < 16; r += 4) *(f32x4*)(st + d0 * 16 + r) = (f32x4){oT[d0][r] * il, oT[d0][r + 1] * il, oT[d0][r + 2] * il, oT[d0][r + 3] * il};
        } else {
            float ss = 0.f;
#pragma unroll
            for (int d0 = 0; d0 < 4; ++d0)
#pragma unroll
                for (int r = 0; r < 16; r += 4) { const f32x4 sv = *(const f32x4*)(st + d0 * 16 + r);
#pragma unroll
                    for (int e = 0; e < 4; ++e) { const float v = sv[e] - lam * (oT[d0][r + e] * il); oT[d0][r + e] = v; ss += v * v; } }
            ss = swap_sum(ss);
            const float rn = (1.0f / sqrtf(ss * (1.0f / 128.0f) + RMS_EPS)) * (1.0f - A.lam_init);
            bf16* op = A.mixed + (size_t)(q0 + r32) * DM + h * 128;
#pragma unroll
            for (int d0 = 0; d0 < 4; ++d0)
#pragma unroll
                for (int g4 = 0; g4 < 4; ++g4) { const int d = 32 * d0 + 8 * g4 + 4 * hi; const f32x4 gg = *(const f32x4*)(A.subln + d);
                    u32x2 w; w.x = cvtpk(oT[d0][4 * g4] * rn * gg[0], oT[d0][4 * g4 + 1] * rn * gg[1]); w.y = cvtpk(oT[d0][4 * g4 + 2] * rn * gg[2], oT[d0][4 * g4 + 3] * rn * gg[3]);
                    *(u32x2*)(op + d) = w; }
        }
    }
}
__device__ __forceinline__ void attn_phase(__attribute__((address_space(3))) unsigned char* lds, const Args& A, int blk, int nblk) {
    const int lane = threadIdx.x & 63;
    const float l0 = wave_sum(A.lq[lane] * A.lk[lane]), l1 = wave_sum(A.lq[64 + lane] * A.lk[64 + lane]);
    const float lam = __expf(l0) - __expf(l1) + A.lam_init;
    float* stash_blk = A.stash + (size_t)blk * (64 * 512);
    for (int u = blk; u < 512; u += nblk) {
        const int b = u & 255, second = u >> 8, h = b & 7, s = b >> 3, qb = second ? s : 63 - s;
        attn_unit(lds, A, h, qb, lam, stash_blk);
    }
}
}
__global__ void __launch_bounds__(512, 2) k_attn(att::Args A) {
    extern __shared__ __attribute__((aligned(16))) unsigned char lds[];
    att::attn_phase((__attribute__((address_space(3))) unsigned char*)lds, A, (int)blockIdx.x, (int)gridDim.x);
}

constexpr size_t MiB = 1u << 20;
constexpr size_t WS_RINV = 1 * MiB, WS_WIN = 2 * MiB, WS_WOUT = 28 * MiB, WS_WUP = 36 * MiB, WS_WDOWN = 68 * MiB, WS_XB = 100 * MiB, WS_Q = 164 * MiB, WS_K = 196 * MiB, WS_V = 228 * MiB,
                 WS_RW = 260 * MiB, WS_MIXED = 372 * MiB, WS_U = 164 * MiB, WS_VFIRST = 436 * MiB, WS_SR = 500 * MiB, WS_SW = 564 * MiB, WS_SK = 628 * MiB, WS_SV = 692 * MiB, WS_SA = 756 * MiB,
                 WS_SB = 820 * MiB, WS_G = 884 * MiB, WS_Y = 948 * MiB, WS_STASH = 500 * MiB, WS_END = 1012 * MiB;
constexpr int GEMM_LDS = 131072;

extern "C" void kernel_launch(void* const* d_in, const int* in_sizes, int n_in, void* d_out, int out_size, void* d_ws, size_t ws_size, hipStream_t stream) {
    static int ok = 0;
    if (ok == 0) {
        ok = 1;
        if (n_in != 26 || ws_size < WS_END || out_size != T_ * DM) { fprintf(stderr, "kernel_launch: unexpected shapes (n_in %d ws %zu out %d)\n", n_in, ws_size, out_size); ok = -1; }
        if (hipFuncSetAttribute((const void*)k_gemm<pg8::EpiIn>, hipFuncAttributeMaxDynamicSharedMemorySize, GEMM_LDS) != hipSuccess) ok = -1;
        if (hipFuncSetAttribute((const void*)k_gemm<pg8::EpiRes>, hipFuncAttributeMaxDynamicSharedMemorySize, GEMM_LDS) != hipSuccess) ok = -1;
        if (hipFuncSetAttribute((const void*)k_gemm<pg8::EpiUp>, hipFuncAttributeMaxDynamicSharedMemorySize, GEMM_LDS) != hipSuccess) ok = -1;
        if (hipFuncSetAttribute((const void*)k_rwkv_prep, hipFuncAttributeMaxDynamicSharedMemorySize, 96 * 1024) != hipSuccess) ok = -1;
    }
    if (ok < 0) return;
    const float* const* in = (const float* const*)d_in;
    unsigned char* ws = (unsigned char*)d_ws; float* x = (float*)d_out;
    float* rinv = (float*)(ws + WS_RINV);
    bf16 *wt_in = (bf16*)(ws + WS_WIN), *wt_out = (bf16*)(ws + WS_WOUT), *wt_up = (bf16*)(ws + WS_WUP), *wt_down = (bf16*)(ws + WS_WDOWN), *xb = (bf16*)(ws + WS_XB), *qb = (bf16*)(ws + WS_Q), *kb = (bf16*)(ws + WS_K),
         *vb = (bf16*)(ws + WS_V), *rwb = (bf16*)(ws + WS_RW), *mixed = (bf16*)(ws + WS_MIXED), *ub = (bf16*)(ws + WS_U);
    float *vfirst = (float*)(ws + WS_VFIRST), *SR = (float*)(ws + WS_SR), *SW = (float*)(ws + WS_SW), *SK = (float*)(ws + WS_SK), *SV = (float*)(ws + WS_SV), *SA = (float*)(ws + WS_SA), *SB = (float*)(ws + WS_SB),
          *G = (float*)(ws + WS_G), *Y = (float*)(ws + WS_Y), *stash = (float*)(ws + WS_STASH);
    for (int l = 0; l < NL; ++l) {
        k_convw<true><<<dim3(DM / 64, NIN / 64), 256, 0, stream>>>(in[3] + (size_t)l * DM * PW, wt_in, in[1] + (size_t)l * DM, DM, PW, NIN);
        k_convw<false><<<dim3(DM / 64, DM / 64), 256, 0, stream>>>(in[4] + (size_t)l * DM * DM, wt_out, nullptr, DM, DM, DM);
        k_convw<false><<<dim3(DM / 64, DFF / 64), 256, 0, stream>>>(in[24] + (size_t)l * DM * DFF, wt_up, in[2] + (size_t)l * DM, DM, DFF, DFF);
        k_convw<false><<<dim3(DFF / 64, DM / 64), 256, 0, stream>>>(in[25] + (size_t)l * DFF * DM, wt_down, nullptr, DFF, DM, DM);
        k_rownorm<<<T_ / 4, 256, 0, stream>>>(l == 0 ? in[0] : x, l == 0 ? x : nullptr, xb, rinv);
        { pg8::Gemm g{xb, wt_in, T_, NIN, DM, 0}; pg8::EpiIn E{}; E.rinv = rinv; E.q = qb; E.k = kb; E.v = vb; E.rw = rwb; E.gq = in[5] + l * 128; E.gk = in[6] + l * 128;
          k_gemm<pg8::EpiIn><<<256, 512, GEMM_LDS, stream>>>(g, E); }
        { PrepArgs A{}; A.rw = rwb; A.mu = in[10] + (size_t)l * 3360; A.w0 = in[11] + l * 1024; A.w2 = in[12] + (size_t)l * 64 * 1024; A.a0 = in[13] + l * 1024; A.a2 = in[14] + (size_t)l * 64 * 1024;
          A.g2 = in[15] + (size_t)l * 160 * 1024; A.k_k = in[16] + l * 1024; A.k_a = in[17] + l * 1024;
          A.v0 = l > 0 ? in[21] + (l - 1) * 1024 : nullptr; A.v1 = l > 0 ? in[22] + (size_t)(l - 1) * 1024 * 32 : nullptr; A.v2 = l > 0 ? in[23] + (size_t)(l - 1) * 32 * 1024 : nullptr;
          A.vfirst = vfirst; A.SR = SR; A.SW = SW; A.SK = SK; A.SV = SV; A.SA = SA; A.SB = SB; A.G = G; A.layer = l;
          k_rwkv_prep<<<T_ / 16, 256, (16 * 64 * 2 + 16 * 160 + 16 * 32 + 16 * 1024) * 4, stream>>>(A); }
        k_rwkv_scan<<<256, 256, 0, stream>>>(SR, SW, SK, SV, SA, SB, Y);
        k_rwkv_out<<<T_ * 16 / 4, 256, 0, stream>>>(Y, SR, SK, SV, G, in[19] + l * 1024, in[20] + l * 1024, in[18] + l * 1024, mixed);
        { const float lam_init = (float)(0.8 - 0.6 * exp(-0.3 * (double)l));
          att::Args A{}; A.Q = qb; A.K = kb; A.V = vb; A.mixed = mixed; A.stash = stash; A.lq = in[7] + l * 128; A.lk = in[8] + l * 128; A.subln = in[9] + l * 128; A.lam_init = lam_init;
          k_attn<<<256, 512, att::LDS_BYTES, stream>>>(A); }
        { pg8::Gemm g{mixed, wt_out, T_, DM, DM, 0}; pg8::EpiRes E{}; E.x = x; E.ldc = DM; k_gemm<pg8::EpiRes><<<256, 512, GEMM_LDS, stream>>>(g, E); }
        k_rownorm<<<T_ / 4, 256, 0, stream>>>(x, nullptr, xb, rinv);
        { pg8::Gemm g{xb, wt_up, T_, DFF, DM, 0}; pg8::EpiUp E{}; E.rinv = rinv; E.o = ub; E.ldc = DFF; k_gemm<pg8::EpiUp><<<256, 512, GEMM_LDS, stream>>>(g, E); }
        { pg8::Gemm g{ub, wt_down, T_, DM, DFF, 0}; pg8::EpiRes E{}; E.x = x; E.ldc = DM; k_gemm<pg8::EpiRes><<<256, 512, GEMM_LDS, stream>>>(g, E); }
    }
}
```

```cpp
#include <hip/hip_runtime.h>
#include <cstdio>
#include <cstdint>
#include <cstring>
#include <cmath>

constexpr int T_ = 16384, DM = 2048, NL = 4, PW = 6432, NIN = 6656, RWP = 3584, DFF = 8192, RW_ = 1024;
constexpr float RMS_EPS = 1e-6f, GN_EPS = 64e-5f;
typedef unsigned short bf16;
typedef float f32x4 __attribute__((ext_vector_type(4)));
typedef unsigned u32x4 __attribute__((ext_vector_type(4)));
typedef unsigned u32x2 __attribute__((ext_vector_type(2)));
#define LAS __attribute__((address_space(3)))

__device__ __forceinline__ unsigned f2bf(float f) { unsigned u = __builtin_bit_cast(unsigned, f); return (u + 0x7fffu + ((u >> 16) & 1u)) >> 16; }
__device__ __forceinline__ float bf2f(unsigned short b) { return __builtin_bit_cast(float, (unsigned)b << 16); }
__device__ __forceinline__ float bflo(unsigned w) { return __builtin_bit_cast(float, w << 16); }
__device__ __forceinline__ float bfhi(unsigned w) { return __builtin_bit_cast(float, w & 0xffff0000u); }
__device__ __forceinline__ float sigmoidf_(float x) { return 1.0f / (1.0f + __expf(-x)); }

template <int CTRL, int ROWMASK> __device__ __forceinline__ float dppf(float v) {
    return __builtin_bit_cast(float, __builtin_amdgcn_update_dpp(0, __builtin_bit_cast(int, v), CTRL, ROWMASK, 0xF, false));
}
__device__ __forceinline__ float wave_sum(float v) {
    v += dppf<0xB1, 0xF>(v); v += dppf<0x4E, 0xF>(v); v += dppf<0x141, 0xF>(v); v += dppf<0x140, 0xF>(v);
    v += dppf<0x142, 0xA>(v); v += dppf<0x143, 0xC>(v);
    return __builtin_bit_cast(float, __builtin_amdgcn_readlane(__builtin_bit_cast(int, v), 63));
}
__device__ __forceinline__ int opq_tid() { int t = (int)threadIdx.x; asm volatile("" : "+v"(t)); return t; }
namespace pg8 {
#define PG8_LAS __attribute__((address_space(3)))
typedef unsigned short bf16_t;
typedef short bf16x8 __attribute__((ext_vector_type(8)));
typedef float f32x4 __attribute__((ext_vector_type(4)));
typedef unsigned u32x4 __attribute__((ext_vector_type(4)));
constexpr int BM = 256, BK = 64, HALF = 128, HTB = HALF * BK * 2  , STAGE_BYTES = 8 * HTB, NXCD = 8, WGM = 8;

__host__ __device__ __forceinline__ int lds_byte(int r, int c) { const int st = (r >> 4) * 2 + (c >> 5), rr = r & 15, cc = c & 31, ob = rr * 64 + cc * 2; return st * 1024 + (ob ^ (((ob >> 9) & 1) << 5)); }
__host__ __device__ __forceinline__ void stage_rc(int b, int& R, int& C) { const int st = b / 1024, sb = b % 1024, swz = sb ^ (((sb >> 9) & 1) << 5); R = (st >> 1) * 16 + swz / 64; C = (st & 1) * 32 + (swz % 64) / 2; }
__host__ __device__ __forceinline__ int perm32(int rho) { const int n = rho >> 4, i = rho & 15; return 8 * (i >> 2) + 4 * n + (i & 3); }

struct Unit { int pm, pn; };
struct Gemm { const bf16_t* A; const bf16_t* Bt; int M, N, K, pad_; };

struct StaticOrder {
    int nM, nN, nwg, G, c;
    __host__ __device__ void init(int M, int N, int G_, int c_) { nM = M / BM; nN = N / BM; nwg = nM * nN; G = G_; c = c_; }
    __host__ __device__ bool next(int i, Unit& u) const {
        const long L = (long)i * G + c; if (L >= nwg) return false;
        int wgid = (int)L; { const int q = nwg / NXCD, r = nwg % NXCD, xcd = wgid % NXCD, off = wgid / NXCD; wgid = (xcd < r ? xcd * (q + 1) : r * (q + 1) + (xcd - r) * q) + off; }
        const int nig = WGM * nN, gid = wgid / nig, fm = gid * WGM, gsz = (nM - fm) < WGM ? (nM - fm) : WGM;
        u.pm = fm + ((wgid % nig) % gsz); u.pn = (wgid % nig) / gsz; return true;
    }
    __device__ __forceinline__ void a_ready(const Unit&) const {}
    __device__ __forceinline__ void done(const Unit&) const {}
};

__device__ __forceinline__ unsigned cvt_pk_bf16(float lo, float hi) { unsigned r; asm volatile("v_cvt_pk_bf16_f32 %0, %1, %2" : "=v"(r) : "v"(lo), "v"(hi)); return r; }
typedef float f32x2 __attribute__((ext_vector_type(2)));
struct EpiIn {
    static constexpr bool PERM = true, AFTER_DRAIN = false;
    const float* rinv; bf16_t* q; bf16_t* k; bf16_t* v; bf16_t* rw; const float* gq; const float* gk;
    __device__ __forceinline__ void operator()(const f32x4 (&acc)[2][2][4][2], const Unit& u, int wr, int wc, int fr, int fq) const {
        const int pn = u.pn;
        const int row0 = u.pm * BM + wr * 64 + fr;
        if (pn < 8) {
            const float* g = (pn < 4 ? gq : gk) + (wc & 1) * 64 + 8 * fq;
            f32x4 gv[2][2];
#pragma unroll
            for (int bj = 0; bj < 2; ++bj)
#pragma unroll
                for (int n = 0; n < 2; ++n) gv[bj][n] = *(const f32x4*)(g + 32 * bj + 4 * n);
            bf16_t* base = (pn < 4 ? q : k) + (pn & 3) * 256 + 64 * wc + 8 * fq;
#pragma unroll
            for (int ai = 0; ai < 2; ++ai)
#pragma unroll
                for (int m = 0; m < 4; ++m) {
                    const int row = row0 + ai * HALF + m * 16; const float ri = rinv[row];
                    f32x4 vv[2][2]; float ss = 0.f;
#pragma unroll
                    for (int bj = 0; bj < 2; ++bj)
#pragma unroll
                        for (int n = 0; n < 2; ++n) { vv[bj][n] = acc[ai][bj][m][n] * ri; const f32x4 t = vv[bj][n]; ss += (t[0] * t[0] + t[1] * t[1]) + (t[2] * t[2] + t[3] * t[3]); }
                    ss += __shfl_xor(ss, 16); ss += __shfl_xor(ss, 32);
                    const float rq = 1.0f / sqrtf(ss * (1.0f / 64.0f) + 1e-6f);
#pragma unroll
                    for (int bj = 0; bj < 2; ++bj) { const f32x4 a = vv[bj][0] * rq * gv[bj][0], b = vv[bj][1] * rq * gv[bj][1];
                        u32x4 w; w.x = cvt_pk_bf16(a[0], a[1]); w.y = cvt_pk_bf16(a[2], a[3]); w.z = cvt_pk_bf16(b[0], b[1]); w.w = cvt_pk_bf16(b[2], b[3]);
                        *(u32x4*)(base + (size_t)row * 1024 + 32 * bj) = w; }
                }
        } else {
            bf16_t* base; int ld;
            if (pn < 12) { base = v + (pn - 8) * 256 + 64 * wc + 8 * fq; ld = 1024; } else { base = rw + (pn - 12) * 256 + 64 * wc + 8 * fq; ld = 3584; }
#pragma unroll
            for (int ai = 0; ai < 2; ++ai)
#pragma unroll
                for (int m = 0; m < 4; ++m) {
                    const int row = row0 + ai * HALF + m * 16; const float ri = rinv[row];
#pragma unroll
                    for (int bj = 0; bj < 2; ++bj) { const f32x4 a = acc[ai][bj][m][0] * ri, b = acc[ai][bj][m][1] * ri;
                        u32x4 w; w.x = cvt_pk_bf16(a[0], a[1]); w.y = cvt_pk_bf16(a[2], a[3]); w.z = cvt_pk_bf16(b[0], b[1]); w.w = cvt_pk_bf16(b[2], b[3]);
                        *(u32x4*)(base + (size_t)row * ld + 32 * bj) = w; }
                }
        }
    }
};
struct EpiRes {
    static constexpr bool PERM = true, AFTER_DRAIN = false;
    float* x; int ldc; int pad_;
    __device__ __forceinline__ void operator()(const f32x4 (&acc)[2][2][4][2], const Unit& u, int wr, int wc, int fr, int fq) const {
        const int row0 = u.pm * BM + wr * 64 + fr, col0 = u.pn * BM + wc * 32 + 8 * fq;
#pragma unroll
        for (int ai = 0; ai < 2; ++ai)
#pragma unroll
            for (int m = 0; m < 4; ++m) { float* rowp = x + (size_t)(row0 + ai * HALF + m * 16) * ldc + col0;
#pragma unroll
                for (int bj = 0; bj < 2; ++bj) { f32x4* p = (f32x4*)(rowp + bj * HALF); const f32x4 o0 = p[0], o1 = p[1]; p[0] = o0 + acc[ai][bj][m][0]; p[1] = o1 + acc[ai][bj][m][1]; } }
    }
};
struct EpiUp {
    static constexpr bool PERM = true, AFTER_DRAIN = false;
    const float* rinv; bf16_t* o; int ldc; int pad_;
    __device__ __forceinline__ void operator()(const f32x4 (&acc)[2][2][4][2], const Unit& u, int wr, int wc, int fr, int fq) const {
        const int row0 = u.pm * BM + wr * 64 + fr, col0 = u.pn * BM + wc * 32 + 8 * fq;
#pragma unroll
        for (int ai = 0; ai < 2; ++ai)
#pragma unroll
            for (int m = 0; m < 4; ++m) { const int row = row0 + ai * HALF + m * 16; const float ri = rinv[row]; bf16_t* rowp = o + (size_t)row * ldc + col0;
#pragma unroll
                for (int bj = 0; bj < 2; ++bj) { f32x4 a = acc[ai][bj][m][0] * ri, b = acc[ai][bj][m][1] * ri;
#pragma unroll
                    for (int e = 0; e < 4; ++e) { a[e] = a[e] > 0.f ? a[e] * a[e] : 0.f; b[e] = b[e] > 0.f ? b[e] * b[e] : 0.f; }
                    u32x4 w; w.x = cvt_pk_bf16(a[0], a[1]); w.y = cvt_pk_bf16(a[2], a[3]); w.z = cvt_pk_bf16(b[0], b[1]); w.w = cvt_pk_bf16(b[2], b[3]);
                    *(u32x4*)(rowp + bj * HALF) = w; } }
    }
};
template <class Epi, class Sched, bool ALIGN_EPI = false, bool SP2 = false>
__device__ __forceinline__ void gemm_phase(PG8_LAS unsigned char* lds, const Gemm g, const Sched& S, const Epi& E) {
    const int tid = opq_tid(), wid = __builtin_amdgcn_readfirstlane(tid >> 6), lane = tid & 63, wr = wid >> 2, wc = wid & 3, fr = lane & 15, fq = lane >> 4;
    const int K = g.K, nt = K / BK;
    unsigned voffA[2], voffB[2];
#pragma unroll
    for (int i = 0; i < 2; ++i) { int R, C; stage_rc(tid * 16 + i * 8192, R, C); const int Rb = Epi::PERM ? ((R & ~31) + perm32(R & 31)) : R;
        voffA[i] = (unsigned)(R * K + C) * 2u; voffB[i] = (unsigned)(Rb * K + C) * 2u; }
    const size_t kstep = (size_t)(BK * 2);
    const size_t hstep = (size_t)HALF * K * 2;
    const size_t tstep = 2 * hstep;
    const unsigned ldsw = (unsigned)wid * 1024u;
    const int aoff = lds_byte(wr * 64 + fr, fq * 8), boff = lds_byte(wc * 32 + fr, fq * 8);
#define PG8_SA(b, h) (((b) * 2 + (h)) * HTB)
#define PG8_SB(b, h) ((4 + (b) * 2 + (h)) * HTB)
#define PG8_STAGE(bufoff, gbase, voff) do { _Pragma("unroll") for (int _i = 0; _i < 2; ++_i) \
        __builtin_amdgcn_global_load_lds((const unsigned*)((const char*)(gbase) + (voff)[_i]), (PG8_LAS unsigned*)(lds + (bufoff) + ldsw + _i * 8192), 16, 0, 0); } while (0)
#define PG8_LDA(dst, b, h) do { _Pragma("unroll") for (int m = 0; m < 4; ++m) _Pragma("unroll") for (int k = 0; k < 2; ++k) dst[m][k] = *(const PG8_LAS bf16x8*)(lds + PG8_SA(b, h) + aoff + m * 2048 + k * 1024); } while (0)
#define PG8_LDB(dst, b, h) do { _Pragma("unroll") for (int n = 0; n < 2; ++n) _Pragma("unroll") for (int k = 0; k < 2; ++k) dst[n][k] = *(const PG8_LAS bf16x8*)(lds + PG8_SB(b, h) + boff + n * 2048 + k * 1024); } while (0)
#define PG8_MMA(ai, bj, At, Bt) do { __builtin_amdgcn_s_setprio(1); _Pragma("unroll") for (int m = 0; m < 4; ++m) _Pragma("unroll") for (int n = 0; n < 2; ++n) _Pragma("unroll") for (int k = 0; k < 2; ++k) \
        acc[ai][bj][m][n] = __builtin_amdgcn_mfma_f32_16x16x32_bf16(Bt[n][k], At[m][k], acc[ai][bj][m][n], 0, 0, 0); __builtin_amdgcn_s_setprio(0); } while (0)
#define PG8_WAIT_V(n) asm volatile("s_waitcnt vmcnt(" #n ")" ::: "memory")
#define PG8_WAIT_L(n) asm volatile("s_waitcnt lgkmcnt(" #n ")" ::: "memory")
#define PG8_BAR __builtin_amdgcn_s_barrier()
#define PG8_SCHED __builtin_amdgcn_sched_barrier(0)
    Unit cur, nxt; int ui = 0;
    if (!S.next(0, cur)) return;
    f32x4 acc[2][2][4][2];
#pragma unroll
    for (int a = 0; a < 2; ++a)
#pragma unroll
        for (int b = 0; b < 2; ++b)
#pragma unroll
            for (int m = 0; m < 4; ++m)
#pragma unroll
                for (int n = 0; n < 2; ++n) acc[a][b][m][n] = (f32x4){0.f, 0.f, 0.f, 0.f};
    bf16x8 At[4][2], B0[2][2], B1[2][2];
    const char* cA = (const char*)g.A + (size_t)cur.pm * tstep; const char* cB = (const char*)g.Bt + (size_t)cur.pn * tstep;
    S.a_ready(cur);
    if constexpr (SP2) {
        PG8_STAGE(PG8_SB(0, 0), cB, voffB); PG8_STAGE(PG8_SB(0, 1), cB + hstep, voffB); PG8_STAGE(PG8_SA(0, 0), cA, voffA); PG8_STAGE(PG8_SA(0, 1), cA + hstep, voffA);
        if (wr == 1) PG8_BAR;
        PG8_WAIT_V(2); PG8_BAR;
        PG8_STAGE(PG8_SB(1, 0), cB + kstep, voffB); PG8_STAGE(PG8_SA(1, 0), cA + kstep, voffA); PG8_STAGE(PG8_SB(1, 1), cB + hstep + kstep, voffB);
        PG8_WAIT_V(6); PG8_BAR;
    } else {
        PG8_STAGE(PG8_SB(0, 0), cB, voffB); PG8_STAGE(PG8_SA(0, 0), cA, voffA); PG8_STAGE(PG8_SB(0, 1), cB + hstep, voffB); PG8_STAGE(PG8_SA(0, 1), cA + hstep, voffA);
        if (wr == 1) PG8_BAR;
        PG8_WAIT_V(4); PG8_BAR;
        PG8_STAGE(PG8_SB(1, 0), cB + kstep, voffB); PG8_STAGE(PG8_SA(1, 0), cA + kstep, voffA); PG8_STAGE(PG8_SB(1, 1), cB + hstep + kstep, voffB);
        PG8_WAIT_V(6); PG8_BAR;
    }
    for (;;) {
        const bool has_next = S.next(ui + 1, nxt);
        const char* nA = has_next ? (const char*)g.A + (size_t)nxt.pm * tstep : cA; const char* nB = has_next ? (const char*)g.Bt + (size_t)nxt.pn * tstep : cB;
        for (int t = 0; t < nt; t += 2) {
            const bool last = (t == nt - 2);
            const char* a1 = cA + (size_t)(t + 1) * kstep;
            const char* a2 = last ? nA : cA + (size_t)(t + 2) * kstep; const char* b2 = last ? nB : cB + (size_t)(t + 2) * kstep;
            const char* a3 = a2 + kstep; const char* b3 = b2 + kstep;
            if (last && has_next) S.a_ready(nxt);
            if constexpr (SP2) {
            PG8_LDB(B0, 0, 0); PG8_LDB(B1, 0, 1); PG8_SCHED; PG8_LDA(At, 0, 0); PG8_STAGE(PG8_SA(1, 1), a1 + hstep, voffA);
            PG8_WAIT_V(8); PG8_WAIT_L(0); PG8_BAR; PG8_MMA(0, 0, At, B0); PG8_MMA(0, 1, At, B1); PG8_BAR; PG8_SCHED;
            PG8_LDA(At, 0, 1); PG8_STAGE(PG8_SB(0, 0), b2, voffB); PG8_STAGE(PG8_SB(0, 1), b2 + hstep, voffB); PG8_STAGE(PG8_SA(0, 0), a2, voffA);
            PG8_WAIT_V(8); PG8_WAIT_L(0); PG8_BAR; PG8_MMA(1, 0, At, B0); PG8_MMA(1, 1, At, B1); PG8_BAR; PG8_SCHED;
            PG8_LDB(B0, 1, 0); PG8_LDB(B1, 1, 1); PG8_SCHED; PG8_LDA(At, 1, 0); PG8_STAGE(PG8_SA(0, 1), a2 + hstep, voffA);
            PG8_WAIT_V(8); PG8_WAIT_L(0); PG8_BAR; PG8_MMA(0, 0, At, B0); PG8_MMA(0, 1, At, B1); PG8_BAR; PG8_SCHED;
            PG8_LDA(At, 1, 1); PG8_STAGE(PG8_SB(1, 0), b3, voffB); PG8_STAGE(PG8_SB(1, 1), b3 + hstep, voffB); PG8_STAGE(PG8_SA(1, 0), a3, voffA);
            PG8_WAIT_V(8); PG8_WAIT_L(0); PG8_BAR; PG8_MMA(1, 0, At, B0); PG8_MMA(1, 1, At, B1); PG8_BAR; PG8_SCHED;
            } else {
            PG8_LDB(B0, 0, 0); PG8_SCHED; PG8_LDA(At, 0, 0); PG8_STAGE(PG8_SA(1, 1), a1 + hstep, voffA);
            PG8_WAIT_L(8); PG8_BAR; PG8_WAIT_L(0); PG8_MMA(0, 0, At, B0); PG8_BAR; PG8_SCHED;
            PG8_LDB(B1, 0, 1); PG8_STAGE(PG8_SB(0, 0), b2, voffB);
            PG8_BAR; PG8_WAIT_L(0); PG8_MMA(0, 1, At, B1); PG8_BAR;
            PG8_LDA(At, 0, 1); PG8_STAGE(PG8_SA(0, 0), a2, voffA);
            PG8_BAR; PG8_WAIT_L(0); PG8_MMA(1, 0, At, B0); PG8_BAR; PG8_SCHED;
            PG8_STAGE(PG8_SB(0, 1), b2 + hstep, voffB);
            PG8_WAIT_V(6); PG8_BAR; PG8_MMA(1, 1, At, B1); PG8_BAR;
            PG8_LDB(B0, 1, 0); PG8_SCHED; PG8_LDA(At, 1, 0); PG8_STAGE(PG8_SA(0, 1), a2 + hstep, voffA);
            PG8_WAIT_L(8); PG8_BAR; PG8_WAIT_L(0); PG8_MMA(0, 0, At, B0); PG8_BAR; PG8_SCHED;
            PG8_LDB(B1, 1, 1); PG8_STAGE(PG8_SB(1, 0), b3, voffB);
            PG8_BAR; PG8_WAIT_L(0); PG8_MMA(0, 1, At, B1); PG8_BAR;
            PG8_LDA(At, 1, 1); PG8_STAGE(PG8_SA(1, 0), a3, voffA);
            PG8_BAR; PG8_WAIT_L(0); PG8_MMA(1, 0, At, B0); PG8_BAR; PG8_SCHED;
            PG8_STAGE(PG8_SB(1, 1), b3 + hstep, voffB);
            PG8_WAIT_V(6); PG8_BAR; PG8_MMA(1, 1, At, B1); PG8_BAR;
            }
        }
        if constexpr (ALIGN_EPI) { if (wr == 0) PG8_BAR; }
        if constexpr (!Epi::AFTER_DRAIN) { E(acc, cur, wr, wc, fr, fq); S.done(cur); }
        if (!has_next) break;
#pragma unroll
        for (int a = 0; a < 2; ++a)
#pragma unroll
            for (int b = 0; b < 2; ++b)
#pragma unroll
                for (int m = 0; m < 4; ++m)
#pragma unroll
                    for (int n = 0; n < 2; ++n) acc[a][b][m][n] = (f32x4){0.f, 0.f, 0.f, 0.f};
        cur = nxt; cA = nA; cB = nB; ++ui;
        if constexpr (ALIGN_EPI) { if (wr == 1) PG8_BAR; }
    }
    PG8_WAIT_V(0);
    if constexpr (!ALIGN_EPI) { if (wr == 0) PG8_BAR; }
    PG8_BAR;
    if constexpr (Epi::AFTER_DRAIN) { E.fused(acc, cur, wr, wc, fr, fq, lds, wid, lane); S.done(cur); }
#undef PG8_SA
#undef PG8_SB
#undef PG8_STAGE
#undef PG8_LDA
#undef PG8_LDB
#undef PG8_MMA
#undef PG8_WAIT_V
#undef PG8_WAIT_L
#undef PG8_BAR
#undef PG8_SCHED
}
}

namespace att {
typedef short bf16x8 __attribute__((ext_vector_type(8)));
typedef short s16x4 __attribute__((ext_vector_type(4)));
typedef float f32x16 __attribute__((ext_vector_type(16)));
typedef float f32x2_t __attribute__((ext_vector_type(2)));
typedef __bf16 bf16x2_t __attribute__((ext_vector_type(2)));
typedef __attribute__((address_space(3))) const unsigned char* lds_cptr;
typedef short v4i16_t __attribute__((ext_vector_type(4)));
constexpr int KSLOT = 8192, VSLOT = 16384, LDS_K = 0, LDS_V = 2 * KSLOT, LDS_BYTES = 2 * KSLOT + 2 * VSLOT;
constexpr float LOG2E = 1.4426950408889634f, C2 = 0.125f * LOG2E;
__device__ __forceinline__ int crow(int r, int hi) { return (r & 3) + 8 * (r >> 2) + 4 * hi; }
__device__ __forceinline__ void glds16(const void* gsrc, unsigned lds_dst) { unsigned keep;
    asm volatile("s_mov_b32 %0, m0\n\ts_mov_b32 m0, %2\n\ts_nop 0\n\tglobal_load_lds_dwordx4 %1, off\n\ts_mov_b32 m0, %0" : "=&s"(keep) : "v"(gsrc), "s"(lds_dst) : "memory"); }
__device__ __forceinline__ unsigned cvtpk(float lo, float hi) { f32x2_t v = {lo, hi}; bf16x2_t b = __builtin_convertvector(v, bf16x2_t); return __builtin_bit_cast(unsigned, b); }
__device__ __forceinline__ s16x4 vtr(lds_cptr p) { return __builtin_bit_cast(s16x4, __builtin_amdgcn_ds_read_tr16_b64_v4i16((__attribute__((address_space(3))) v4i16_t*)p)); }
__device__ __forceinline__ float swap_max(float m) { auto rr = __builtin_amdgcn_permlane32_swap(__float_as_uint(m), __float_as_uint(m), false, false); return fmaxf(__uint_as_float(rr[0]), __uint_as_float(rr[1])); }
__device__ __forceinline__ float swap_sum(float m) { auto rr = __builtin_amdgcn_permlane32_swap(__float_as_uint(m), __float_as_uint(m), false, false); return __uint_as_float(rr[0]) + __uint_as_float(rr[1]); }
#define ATT_WAIT_BAR() asm volatile("s_waitcnt vmcnt(0) lgkmcnt(0)\n\ts_barrier" ::: "memory")

struct Args { const bf16* Q; const bf16* K; const bf16* V; bf16* mixed; float* stash; const float* lq; const float* lk; const float* subln; float lam_init; int pad_; };

__device__ __forceinline__ void attn_unit(__attribute__((address_space(3))) unsigned char* lds, const Args& A, int h, int qb, float lam, float* stash_blk) {
    const int tid = opq_tid(), lane = tid & 63, r32 = lane & 31, hi = lane >> 5; const int wid = __builtin_amdgcn_readfirstlane(tid >> 6);
    const int q0 = qb * 256 + wid * 32, qc = q0 >> 6, NT = 4 * qb + 4;
    const float slope2 = exp2f(-(float)(h + 1)) * LOG2E;
    const unsigned lds0 = (unsigned)(uintptr_t)lds;
    const lds_cptr kp0 = (lds_cptr)lds + LDS_K + hi * 1024 + r32 * 16;
    const lds_cptr vp0 = (lds_cptr)lds + LDS_V + ((lane >> 4) & 1) * 32 + (lane & 3) * 8 + (4 * hi + ((lane & 15) >> 2)) * 64;
    const bf16* vsrc = A.V + (size_t)(16 * (wid & 3) + (lane >> 2)) * 1024 + h * 128 + (wid >> 2) * 32 + (lane & 3) * 8;
    const unsigned kdst = lds0 + LDS_K + wid * 1024, vdst = lds0 + LDS_V + (wid >> 2) * 4096 + (wid & 3) * 1024;
    const int qrel = (q0 & 63) + r32;
    float* st = stash_blk + tid * 64;
#pragma unroll 1
    for (int c = 0; c < 2; ++c) {
        const bf16* ksrc = A.K + (size_t)lane * 1024 + h * 128 + c * 64 + wid * 8;
        bf16x8 qr[4];
        { const bf16* qp = A.Q + (size_t)(q0 + r32) * 1024 + h * 128 + c * 64 + hi * 8;
#pragma unroll
          for (int d0 = 0; d0 < 4; ++d0) qr[d0] = *(const bf16x8*)(qp + d0 * 16); }
        f32x16 oT[4];
#pragma unroll
        for (int d0 = 0; d0 < 4; ++d0)
#pragma unroll
            for (int r = 0; r < 16; ++r) oT[d0][r] = 0.f;
        float l = 0.f, mu = 0.f;
        glds16(ksrc, (unsigned)__builtin_amdgcn_readfirstlane(kdst)); glds16(vsrc, (unsigned)__builtin_amdgcn_readfirstlane(vdst)); glds16(vsrc + 64, (unsigned)__builtin_amdgcn_readfirstlane(vdst + 8192));
        ATT_WAIT_BAR();
#pragma unroll 1
        for (int t = 0; t < NT; ++t) {
            const int sl = t & 1;
            if (t + 1 < NT) { const size_t go = (size_t)(t + 1) * 64 * 1024; const unsigned so = (unsigned)(sl ^ 1);
                glds16(ksrc + go, (unsigned)__builtin_amdgcn_readfirstlane(kdst + so * KSLOT)); glds16(vsrc + go, (unsigned)__builtin_amdgcn_readfirstlane(vdst + so * VSLOT));
                glds16(vsrc + go + 64, (unsigned)__builtin_amdgcn_readfirstlane(vdst + so * VSLOT + 8192)); }
            if (t <= qc) {
                const bool diag = (t == qc);
                f32x16 p0, p1;
                const float sc = slope2 * (1.0f / C2), base0 = (float)(4 * hi) * sc - mu * (1.0f / C2), base1 = base0 + 32.0f * sc;
                if (!diag) {
#pragma unroll
                    for (int r = 0; r < 16; ++r) { const float kr = (float)((r & 3) + 8 * (r >> 2)); p0[r] = __builtin_fmaf(kr, sc, base0); p1[r] = __builtin_fmaf(kr, sc, base1); }
                } else {
                    const float q2 = (float)(2 * qrel - 8 * hi);
#pragma unroll
                    for (int r = 0; r < 16; ++r) { const float kr = (float)((r & 3) + 8 * (r >> 2));
                        p0[r] = __builtin_fmaf(fminf(kr, q2 - kr) , sc, base0); p1[r] = __builtin_fmaf(fminf(kr, q2 - 64.0f - kr), sc, base1); }
                }
                const lds_cptr kp = kp0 + sl * KSLOT;
#pragma unroll
                for (int d0 = 0; d0 < 4; ++d0) {
                    const bf16x8 k0 = *(const __attribute__((address_space(3))) bf16x8*)(kp + d0 * 2048), k1 = *(const __attribute__((address_space(3))) bf16x8*)(kp + d0 * 2048 + 512);
                    p0 = __builtin_amdgcn_mfma_f32_32x32x16_bf16(k0, qr[d0], p0, 0, 0, 0);
                    p1 = __builtin_amdgcn_mfma_f32_32x32x16_bf16(k1, qr[d0], p1, 0, 0, 0);
                }
                float rm = fmaxf(p0[0], p1[0]);
#pragma unroll
                for (int r = 1; r < 16; ++r) rm = fmaxf(rm, fmaxf(p0[r], p1[r]));
                rm = swap_max(rm);
                const float dl = (t == 0) ? C2 * rm : fmaxf(C2 * rm, 0.f);
                if (__any(dl != 0.f)) { const float f = __builtin_amdgcn_exp2f(-dl); l *= f;
#pragma unroll
                    for (int d0 = 0; d0 < 4; ++d0)
#pragma unroll
                        for (int r = 0; r < 16; ++r) oT[d0][r] *= f; }
                mu += dl;
                float ls = 0.f;
#pragma unroll
                for (int r = 0; r < 16; ++r) { p0[r] = __builtin_amdgcn_exp2f(p0[r] * C2 - dl); p1[r] = __builtin_amdgcn_exp2f(p1[r] * C2 - dl); ls += p0[r] + p1[r]; }
                l += ls;
                bf16x8 pw[4];
#pragma unroll
                for (int s = 0; s < 4; ++s) { u32x4 w;
#pragma unroll
                    for (int e = 0; e < 4; ++e) { const int r = 8 * (s & 1) + 2 * e; w[e] = (s < 2) ? cvtpk(p0[r], p0[r + 1]) : cvtpk(p1[r], p1[r + 1]); }
                    pw[s] = __builtin_bit_cast(bf16x8, w); }
                const lds_cptr vp = vp0 + sl * VSLOT;
#pragma unroll
                for (int d0 = 0; d0 < 4; ++d0) {
#pragma unroll
                    for (int s = 0; s < 4; ++s) { const s16x4 lo = vtr(vp + d0 * 4096 + s * 1024), hh = vtr(vp + d0 * 4096 + s * 1024 + 512);
                        const bf16x8 vf = (bf16x8){lo[0], lo[1], lo[2], lo[3], hh[0], hh[1], hh[2], hh[3]};
                        oT[d0] = __builtin_amdgcn_mfma_f32_32x32x16_bf16(vf, pw[s], oT[d0], 0, 0, 0); }
                    __builtin_amdgcn_sched_barrier(0); }
                mu -= 64.0f * slope2;
            }
            ATT_WAIT_BAR();
        }
        const float il = 1.0f / swap_sum(l);
        if (c == 0) {
#pragma unroll
            for (int d0 = 0; d0 < 4; ++d0)
#pragma unroll
                for (int r = 0; r < 16; r += 4) *(f32x4*)(st + d0 * 16 + r) = (f32x4){oT[d0][r] * il, oT[d0][r + 1] * il, oT[d0][r + 2] * il, oT[d0][r + 3] * il};
        } else {
            float ss = 0.f;
#pragma unroll
            for (int d0 = 0; d0 < 4; ++d0)
#pragma unroll
                for (int r = 0; r < 16; r += 4) { const f32x4 sv = *(const f32x4*)(st + d0 * 16 + r);
#pragma unroll
                    for (int e = 0; e < 4; ++e) { const float v = sv[e] - lam * (oT[d0][r + e] * il); oT[d0][r + e] = v; ss += v * v; } }
            ss = swap_sum(ss);
            const float rn = (1.0f / sqrtf(ss * (1.0f / 128.0f) + RMS_EPS)) * (1.0f - A.lam_init);
            bf16* op = A.mixed + (size_t)(q0 + r32) * DM + h * 128;
#pragma unroll
            for (int d0 = 0; d0 < 4; ++d0)
#pragma unroll
                for (int g4 = 0; g4 < 4; ++g4) { const int d = 32 * d0 + 8 * g4 + 4 * hi; const f32x4 gg = *(const f32x4*)(A.subln + d);
                    u32x2 w; w.x = cvtpk(oT[d0][4 * g4] * rn * gg[0], oT[d0][4 * g4 + 1] * rn * gg[1]); w.y = cvtpk(oT[d0][4 * g4 + 2] * rn * gg[2], oT[d0][4 * g4 + 3] * rn * gg[3]);
                    *(u32x2*)(op + d) = w; }
        }
    }
}
__device__ __forceinline__ void attn_phase(__attribute__((address_space(3))) unsigned char* lds, const Args& A, int blk, int nblk) {
    const int lane = opq_tid() & 63;
    const float l0 = wave_sum(A.lq[lane] * A.lk[lane]), l1 = wave_sum(A.lq[64 + lane] * A.lk[64 + lane]);
    const float lam = __expf(l0) - __expf(l1) + A.lam_init;
    float* stash_blk = A.stash + (size_t)blk * (64 * 512);
    for (int u = blk; u < 512; u += nblk) {
        const int b = u & 255, second = u >> 8, h = b & 7, s = b >> 3, qb = second ? s : 63 - s;
        attn_unit(lds, A, h, qb, lam, stash_blk);
    }
}
}
#define XB_TMO      128
#define XB_XCNT(j)  (256  + 64 * (j))
#define XB_XSUB(j)  (1280 + 64 * (j))
#define XB_XGEN(j)  (2304 + 64 * (j))
#define XB_TOP      3328
#define XB_TOPGEN   3392
#define XCD_BAR_WORDS 3456
#define XB_SPIN_CAP (1u << 22)

__device__ __forceinline__ unsigned xb_ld(unsigned* p)              { return __hip_atomic_load(p, __ATOMIC_RELAXED, __HIP_MEMORY_SCOPE_AGENT); }
__device__ __forceinline__ unsigned xb_add(unsigned* p, unsigned v) { return __hip_atomic_fetch_add(p, v, __ATOMIC_RELAXED, __HIP_MEMORY_SCOPE_AGENT); }
__device__ __forceinline__ unsigned xb_xcc_id() { return (unsigned)__builtin_amdgcn_s_getreg((3 << 11) | 20) & 0xFu; }
#define XB_SPIN(cond, bar) do { unsigned _sp = 0; while (cond) { __builtin_amdgcn_s_sleep(1); \
    if ((++_sp & 255u) == 0u) { if (xb_ld(&(bar)[XB_TMO])) break; if (_sp > XB_SPIN_CAP) { atomicAdd(&(bar)[XB_TMO], 1u); break; } } } } while (0)

struct XcdBarrier {
    unsigned* bar; unsigned x;
    volatile LAS unsigned* st;
};

__device__ __forceinline__ XcdBarrier xcd_barrier_post(unsigned* bar, volatile LAS unsigned* st) {
    XcdBarrier b; b.bar = bar; b.x = xb_xcc_id(); b.st = st;
    if (threadIdx.x == 0) (void)xb_add(&bar[XB_XCNT(b.x)], 1u);
    return b;
}
__device__ __forceinline__ void xcd_barrier_complete(unsigned* bar, unsigned x, unsigned& nloc, unsigned& nx) {
    const unsigned G = gridDim.x * gridDim.y * gridDim.z;
    unsigned sum, cnt, mine, sp = 0u;
    for (;;) {
        sum = 0u; cnt = 0u; mine = 0u;
#pragma unroll
        for (unsigned j = 0; j < 16; ++j) { const unsigned c = xb_ld(&bar[XB_XCNT(j)]); sum += c; cnt += (c > 0u) ? 1u : 0u; mine = (j == x) ? c : mine; }
        if (sum == G) break;
        __builtin_amdgcn_s_sleep(1);
        if ((++sp & 255u) == 0u) { if (xb_ld(&bar[XB_TMO])) break; if (sp > XB_SPIN_CAP) { atomicAdd(&bar[XB_TMO], 1u); break; } }
    }
    nloc = mine > 0u ? mine : 1u; nx = cnt > 0u ? cnt : 1u;
}

__device__ __forceinline__ void xcd_barrier(const XcdBarrier& b) {
    asm volatile("s_waitcnt vmcnt(0)" ::: "memory");
    __syncthreads();
    if (threadIdx.x == 0) {
        unsigned* bar = b.bar;
        __builtin_amdgcn_s_waitcnt(0);
        unsigned nloc = b.st[0], nx = b.st[1];
        if (nloc == 0u) { xcd_barrier_complete(bar, b.x, nloc, nx); b.st[0] = nloc; b.st[1] = nx; }
        const unsigned old = xb_add(&bar[XB_XSUB(b.x)], 1u);
        const unsigned gen = old / nloc;
        if (old + 1u == (gen + 1u) * nloc) {
            __builtin_amdgcn_fence(__ATOMIC_RELEASE, "agent");
            asm volatile("s_waitcnt vmcnt(0)" ::: "memory");
            const unsigned og = xb_add(&bar[XB_TOP], 1u);
            const unsigned tg = og / nx;
            if (og + 1u == (tg + 1u) * nx) xb_add(&bar[XB_TOPGEN], 1u);
            else XB_SPIN(xb_ld(&bar[XB_TOPGEN]) == tg, bar);
            __builtin_amdgcn_fence(__ATOMIC_ACQUIRE, "agent");
            xb_add(&bar[XB_XGEN(b.x)], 1u);
            asm volatile("s_waitcnt vmcnt(0)" ::: "memory");
        } else {
            XB_SPIN(xb_ld(&bar[XB_XGEN(b.x)]) == gen, bar);
            __builtin_amdgcn_fence(__ATOMIC_ACQUIRE, "agent");
            asm volatile("s_waitcnt vmcnt(0)" ::: "memory");
        }
    }
    __syncthreads();
}

constexpr size_t MiB = 1u << 20;
constexpr size_t WS_CTL = 0, CTL_ZERO_BYTES = 64 * 1024, WS_RINV = 1 * MiB, WS_WIN = 2 * MiB, WS_WOUT = 28 * MiB, WS_WUP = 36 * MiB, WS_WDOWN = 68 * MiB, WS_XB = 100 * MiB, WS_Q = 164 * MiB, WS_K = 196 * MiB,
                 WS_V = 228 * MiB, WS_RW = 260 * MiB, WS_MIXED = 372 * MiB, WS_U = 164 * MiB, WS_VFIRST = 436 * MiB, WS_SR = 500 * MiB, WS_SW = 564 * MiB, WS_SK = 628 * MiB, WS_SV = 692 * MiB,
                 WS_SA = 756 * MiB, WS_SB = 820 * MiB, WS_G = 884 * MiB, WS_Y = 948 * MiB, WS_END = 1012 * MiB;
constexpr int CW_BAR = 1024;
constexpr int RING_BYTES = 131072, MISC_OFF = RING_BYTES + 320, LDS_BYTES = 147456;

struct Args { const float* in[26]; float* out; unsigned char* ws; int ph_lo, ph_hi; float lam_init[4]; };

template <bool PERMIN> __device__ __forceinline__ void convw_tile(LAS float* tile, const float* __restrict__ src, bf16* __restrict__ dst, const float* __restrict__ g, int K, int N, int item, int nkb) {
    const int k0 = (item % nkb) * 64, c0 = (item / nkb) * 64, tid = opq_tid();
    for (int i = tid; i < 64 * 64; i += 512) {
        const int kk = i >> 6, cc = i & 63, cp = c0 + cc; int col = cp;
        if (PERMIN) { const int lo = cp & 255, bj = lo >> 7, wc = (lo >> 5) & 3, j = lo & 31; col = (cp & ~255) + 64 * wc + 32 * bj + j; }
        float v = 0.f;
        if (col < N) { v = src[(size_t)(k0 + kk) * N + col]; if (g) v *= g[k0 + kk]; }
        tile[kk * 65 + cc] = v;
    }
    __syncthreads();
    for (int i = tid; i < 64 * 32; i += 512) {
        const int cc = i >> 5, kp = (i & 31) * 2;
        *(unsigned*)(dst + (size_t)(c0 + cc) * K + k0 + kp) = f2bf(tile[kp * 65 + cc]) | (f2bf(tile[(kp + 1) * 65 + cc]) << 16);
    }
    __syncthreads();
}
__device__ __forceinline__ void ph_convw(LAS unsigned char* lds, const __attribute__((address_space(4))) Args* a, int l, int blk, int nblk) {
    LAS float* tile = (LAS float*)lds; unsigned char* ws = a->ws;
    constexpr int I_IN = (DM / 64) * (NIN / 64), I_OUT = (DM / 64) * (DM / 64), I_UP = (DM / 64) * (DFF / 64), I_DN = (DFF / 64) * (DM / 64);
    for (int it = blk; it < I_IN + I_OUT + I_UP + I_DN; it += nblk) {
        int r = it;
        if (r < I_IN) { convw_tile<true>(tile, a->in[3] + (size_t)l * DM * PW, (bf16*)(ws + WS_WIN), a->in[1] + (size_t)l * DM, DM, PW, r, DM / 64); continue; } r -= I_IN;
        if (r < I_OUT) { convw_tile<false>(tile, a->in[4] + (size_t)l * DM * DM, (bf16*)(ws + WS_WOUT), nullptr, DM, DM, r, DM / 64); continue; } r -= I_OUT;
        if (r < I_UP) { convw_tile<false>(tile, a->in[24] + (size_t)l * DM * DFF, (bf16*)(ws + WS_WUP), a->in[2] + (size_t)l * DM, DM, DFF, r, DM / 64); continue; } r -= I_UP;
        convw_tile<false>(tile, a->in[25] + (size_t)l * DFF * DM, (bf16*)(ws + WS_WDOWN), nullptr, DFF, DM, r, DFF / 64);
    }
}
__device__ __forceinline__ void ph_rownorm(const float* __restrict__ src, float* __restrict__ copy, bf16* __restrict__ xb, float* __restrict__ rinv, int blk, int nblk) {
    const int tid_ = opq_tid(), lane = tid_ & 63, gw = blk * 8 + (tid_ >> 6), ngw = nblk * 8;
    for (int row = gw; row < T_; row += ngw) {
        const f32x4* s = (const f32x4*)(src + (size_t)row * DM);
        float ss = 0.f;
#pragma unroll
        for (int j = 0; j < 8; ++j) { const f32x4 v = s[lane + 64 * j]; ss += (v[0] * v[0] + v[1] * v[1]) + (v[2] * v[2] + v[3] * v[3]);
            if (copy) ((f32x4*)(copy + (size_t)row * DM))[lane + 64 * j] = v;
            u32x2 w; w.x = f2bf(v[0]) | (f2bf(v[1]) << 16); w.y = f2bf(v[2]) | (f2bf(v[3]) << 16);
            ((u32x2*)(xb + (size_t)row * DM))[lane + 64 * j] = w; }
        ss = wave_sum(ss);
        if (lane == 0) rinv[row] = 1.0f / sqrtf(ss * (1.0f / DM) + RMS_EPS);
    }
}

struct PrepArgs {
    const bf16* rw; const float* mu; const float* w0; const float* w2; const float* a0; const float* a2; const float* g2; const float* k_k; const float* k_a;
    const float* v0; const float* v1; const float* v2; float* vfirst; float* SR; float* SW; float* SK; float* SV; float* SA; float* SB; float* G; int layer;
};
__device__ __forceinline__ float rwshift(const bf16* rw, const float* mu, int t, int col) {
    const float p = bf2f(rw[(size_t)t * RWP + col]); const float pp = t > 0 ? bf2f(rw[(size_t)(t - 1) * RWP + col]) : 0.f;
    return p + mu[col] * (pp - p);
}
constexpr int PT = 8, PREP_LDS = PT * (64 + 64 + 160 + 32 + 1024) * 4;
__device__ __forceinline__ void ph_prep(LAS unsigned char* lds, const PrepArgs& A, int blk, int nblk) {
    const int tid_ = opq_tid(), half = tid_ >> 8, tid = tid_ & 255, c4 = 4 * tid;
    LAS float* lat_w = (LAS float*)(lds + half * PREP_LDS);
    LAS float* lat_a = lat_w + PT * 64;
    LAS float* lat_g = lat_a + PT * 64;
    LAS float* vlat = lat_g + PT * 160;
    LAS float* vr_s = vlat + PT * 32;
    for (int g0 = blk * 2; g0 < T_ / PT; g0 += nblk * 2) {
        const int t0 = (g0 + half) * PT;
        for (int idx = tid; idx < PT * 288; idx += 256) {
            const int tok = idx / 288, j = idx % 288; const float s = rwshift(A.rw, A.mu, t0 + tok, 3072 + j);
            if (j < 64) lat_w[tok * 64 + j] = tanhf(s); else if (j < 128) lat_a[tok * 64 + j - 64] = s; else lat_g[tok * 160 + j - 128] = sigmoidf_(s);
        }
        for (int tok = 0; tok < PT; ++tok)
#pragma unroll
            for (int e = 0; e < 4; ++e) vr_s[tok * 1024 + c4 + e] = rwshift(A.rw, A.mu, t0 + tok, 2048 + c4 + e);
        __syncthreads();
        if (A.layer > 0) {
            const int o = tid & 31, tg = tid >> 5; float a0 = 0.f;
#pragma unroll 4
            for (int c = 0; c < 1024; ++c) a0 += vr_s[tg * 1024 + c] * A.v1[c * 32 + o];
            vlat[tg * 32 + o] = a0;
        }
        __syncthreads();
        f32x4 acc[PT], ar[PT];
#pragma unroll
        for (int tok = 0; tok < PT; ++tok) acc[tok] = (f32x4){0.f, 0.f, 0.f, 0.f};
#pragma unroll 2
        for (int i = 0; i < 64; ++i) { const f32x4 w = *(const f32x4*)(A.w2 + (size_t)i * 1024 + c4);
#pragma unroll
            for (int tok = 0; tok < PT; ++tok) acc[tok] += w * lat_w[tok * 64 + i]; }
        { const f32x4 w0 = *(const f32x4*)(A.w0 + c4);
#pragma unroll
          for (int tok = 0; tok < PT; ++tok) { f32x4 o;
#pragma unroll
            for (int e = 0; e < 4; ++e) { const float z = -(w0[e] + acc[tok][e]); const float sp = fmaxf(z, 0.f) + log1pf(__expf(-fabsf(z))); const float wl = -sp - 0.5f; o[e] = __expf(-__expf(wl)); }
            *(f32x4*)(A.SW + (size_t)(t0 + tok) * 1024 + c4) = o; } }
#pragma unroll
        for (int tok = 0; tok < PT; ++tok) acc[tok] = (f32x4){0.f, 0.f, 0.f, 0.f};
#pragma unroll 2
        for (int i = 0; i < 64; ++i) { const f32x4 w = *(const f32x4*)(A.a2 + (size_t)i * 1024 + c4);
#pragma unroll
            for (int tok = 0; tok < PT; ++tok) acc[tok] += w * lat_a[tok * 64 + i]; }
        { const f32x4 a0 = *(const f32x4*)(A.a0 + c4);
#pragma unroll
          for (int tok = 0; tok < PT; ++tok)
#pragma unroll
            for (int e = 0; e < 4; ++e) ar[tok][e] = sigmoidf_(a0[e] + acc[tok][e]); }
        { const f32x4 kkw = *(const f32x4*)(A.k_k + c4), kaw = *(const f32x4*)(A.k_a + c4);
#pragma unroll
          for (int tok = 0; tok < PT; ++tok) { f32x4 kr, kkv; float ss = 0.f;
#pragma unroll
            for (int e = 0; e < 4; ++e) { kr[e] = rwshift(A.rw, A.mu, t0 + tok, 1024 + c4 + e); kkv[e] = kr[e] * kkw[e]; ss += kkv[e] * kkv[e]; }
            ss += __shfl_xor(ss, 1); ss += __shfl_xor(ss, 2); ss += __shfl_xor(ss, 4); ss += __shfl_xor(ss, 8);
            const float inv = 1.0f / fmaxf(sqrtf(ss), 1e-12f); f32x4 oa, ob, ok;
#pragma unroll
            for (int e = 0; e < 4; ++e) { const float kk = kkv[e] * inv; oa[e] = -kk; ob[e] = kk * ar[tok][e]; ok[e] = kr[e] * (1.0f + (ar[tok][e] - 1.0f) * kaw[e]); }
            const size_t off = (size_t)(t0 + tok) * 1024 + c4;
            *(f32x4*)(A.SA + off) = oa; *(f32x4*)(A.SB + off) = ob; *(f32x4*)(A.SK + off) = ok; } }
#pragma unroll
        for (int tok = 0; tok < PT; ++tok) acc[tok] = (f32x4){0.f, 0.f, 0.f, 0.f};
#pragma unroll 2
        for (int i = 0; i < 160; ++i) { const f32x4 w = *(const f32x4*)(A.g2 + (size_t)i * 1024 + c4);
#pragma unroll
            for (int tok = 0; tok < PT; ++tok) acc[tok] += w * lat_g[tok * 160 + i]; }
#pragma unroll
        for (int tok = 0; tok < PT; ++tok) *(f32x4*)(A.G + (size_t)(t0 + tok) * 1024 + c4) = acc[tok];
        if (A.layer == 0) {
            for (int tok = 0; tok < PT; ++tok) { const f32x4 vr = *(const LAS f32x4*)(vr_s + tok * 1024 + c4); const size_t off = (size_t)(t0 + tok) * 1024 + c4;
                *(f32x4*)(A.vfirst + off) = vr; *(f32x4*)(A.SV + off) = vr; }
        } else {
#pragma unroll
            for (int tok = 0; tok < PT; ++tok) acc[tok] = (f32x4){0.f, 0.f, 0.f, 0.f};
    #pragma unroll 2
        for (int i = 0; i < 32; ++i) { const f32x4 w = *(const f32x4*)(A.v2 + (size_t)i * 1024 + c4);
#pragma unroll
                for (int tok = 0; tok < PT; ++tok) acc[tok] += w * vlat[tok * 32 + i]; }
            const f32x4 v0 = *(const f32x4*)(A.v0 + c4);
#pragma unroll
            for (int tok = 0; tok < PT; ++tok) { const f32x4 vr = *(const LAS f32x4*)(vr_s + tok * 1024 + c4); const size_t off = (size_t)(t0 + tok) * 1024 + c4; const f32x4 vf = *(const f32x4*)(A.vfirst + off); f32x4 o;
#pragma unroll
                for (int e = 0; e < 4; ++e) { const float gt = sigmoidf_(v0[e] + acc[tok][e]); o[e] = vr[e] + (vf[e] - vr[e]) * gt; }
                *(f32x4*)(A.SV + off) = o; }
        }
        for (int tok = 0; tok < PT; ++tok) { f32x4 o;
#pragma unroll
            for (int e = 0; e < 4; ++e) o[e] = rwshift(A.rw, A.mu, t0 + tok, c4 + e);
            *(f32x4*)(A.SR + (size_t)(t0 + tok) * 1024 + c4) = o; }
        __syncthreads();
    }
}
__device__ __forceinline__ void ph_scan(const float* __restrict__ SR, const float* __restrict__ SW, const float* __restrict__ SK, const float* __restrict__ SV,
                                        const float* __restrict__ SA, const float* __restrict__ SB, float* __restrict__ Y, int blk, int nblk) {
    const int tid_ = opq_tid(), lane = tid_ & 63;
    for (int gw = blk * 8 + (tid_ >> 6); gw < 1024; gw += nblk * 8) {
        const int h = gw >> 6, i = gw & 63;
        const size_t base = (size_t)h * 64 + lane, vb = (size_t)h * 64 + i;
        float S = 0.f;
        for (int t = 0; t < T_; t += 4) {
            float r[4], w[4], k[4], a[4], b[4], v[4];
#pragma unroll
            for (int s = 0; s < 4; ++s) { const size_t o = (size_t)(t + s) * 1024 + base; r[s] = SR[o]; w[s] = SW[o]; k[s] = SK[o]; a[s] = SA[o]; b[s] = SB[o]; v[s] = SV[(size_t)(t + s) * 1024 + vb]; }
#pragma unroll
            for (int s = 0; s < 4; ++s) {
                const float sa = wave_sum(S * a[s]);
                S = S * w[s] + sa * b[s] + v[s] * k[s];
                const float y = wave_sum(S * r[s]);
                if (lane == 0) Y[(size_t)(t + s) * 1024 + vb] = y;
            }
        }
    }
}
__device__ __forceinline__ void ph_rwkv_out(const float* __restrict__ Y, const float* __restrict__ SR, const float* __restrict__ SK, const float* __restrict__ SV, const float* __restrict__ G,
                                            const float* __restrict__ ln_w, const float* __restrict__ ln_b, const float* __restrict__ r_k, bf16* __restrict__ mixed, int blk, int nblk) {
    const int tid_ = opq_tid(), lane = tid_ & 63;
    for (int gw = blk * 8 + (tid_ >> 6); gw < T_ * 16; gw += nblk * 8) {
        const int t = gw >> 4, h = gw & 15, c = h * 64 + lane;
        const size_t o = (size_t)t * 1024 + c;
        const float y = Y[o]; const float mean = wave_sum(y) * (1.0f / 64.0f); const float d = y - mean; const float var = wave_sum(d * d) * (1.0f / 64.0f);
        float yn = d * (1.0f / sqrtf(var + GN_EPS)); yn = yn * ln_w[c] + ln_b[c];
        const float bonus = wave_sum(SR[o] * SK[o] * r_k[c]) * SV[o];
        mixed[(size_t)t * DM + 1024 + c] = (bf16)f2bf((yn + bonus) * G[o]);
    }
}

constexpr int NPH = 9;
typedef const __attribute__((address_space(4))) Args* CArgs;
__device__ __forceinline__ CArgs kargs() { CArgs p = (CArgs)__builtin_amdgcn_kernarg_segment_ptr(); asm volatile("" : "+s"(p)); return p; }
__global__ void __launch_bounds__(512, 2) fwd(Args args_unused) {
    extern __shared__ __attribute__((aligned(16))) unsigned char lds_raw[];
    LAS unsigned char* lds = (LAS unsigned char*)lds_raw;
    volatile LAS unsigned* MISC = (volatile LAS unsigned*)(lds + MISC_OFF);
    const int blk = (int)blockIdx.x, nblk = (int)gridDim.x;
    if (threadIdx.x < 32) MISC[threadIdx.x] = 0u;
    __syncthreads();
    int lo, hi; XcdBarrier bar;
    { CArgs ap = kargs(); lo = ap->ph_lo; hi = ap->ph_hi; unsigned* bw = (unsigned*)(ap->ws + WS_CTL) + CW_BAR; bar.bar = bw; bar.x = 0; bar.st = nullptr;
      if (hi - lo > 1) bar = xcd_barrier_post(bw, MISC + 8); }
#define IN(k) (lo <= (k) && (k) < hi)
#define SEAM(k) do { if (IN(k) && IN((k) + 1)) xcd_barrier(bar); } while (0)
#define WSP(T, off) ((T*)(ws + (off)))
#pragma unroll 1
    for (int l = 0; l < NL; ++l) {
        const int pb = l * NPH;
        if (IN(pb + 0)) {
            CArgs ap = kargs(); unsigned char* ws = ap->ws;
            ph_convw(lds, ap, l, blk, nblk);
            ph_rownorm(l == 0 ? ap->in[0] : ap->out, l == 0 ? ap->out : nullptr, WSP(bf16, WS_XB), WSP(float, WS_RINV), blk, nblk);
        }
        SEAM(pb + 0);
        if (IN(pb + 1)) {
            CArgs ap = kargs(); unsigned char* ws = ap->ws;
            pg8::Gemm g{WSP(bf16, WS_XB), WSP(bf16, WS_WIN), T_, NIN, DM, 0}; pg8::StaticOrder S; S.init(T_, NIN, nblk, blk);
            pg8::EpiIn E{WSP(float, WS_RINV), WSP(bf16, WS_Q), WSP(bf16, WS_K), WSP(bf16, WS_V), WSP(bf16, WS_RW), ap->in[5] + l * 128, ap->in[6] + l * 128};
            pg8::gemm_phase<pg8::EpiIn, pg8::StaticOrder, true, true>(lds, g, S, E);
        }
        SEAM(pb + 1);
        if (IN(pb + 2)) {
            CArgs ap = kargs(); unsigned char* ws = ap->ws;
            PrepArgs A; A.rw = WSP(bf16, WS_RW); A.mu = ap->in[10] + (size_t)l * 3360; A.w0 = ap->in[11] + l * 1024; A.w2 = ap->in[12] + (size_t)l * 64 * 1024; A.a0 = ap->in[13] + l * 1024; A.a2 = ap->in[14] + (size_t)l * 64 * 1024;
            A.g2 = ap->in[15] + (size_t)l * 160 * 1024; A.k_k = ap->in[16] + l * 1024; A.k_a = ap->in[17] + l * 1024;
            const int lm = l > 0 ? l - 1 : 0;
            A.v0 = ap->in[21] + lm * 1024; A.v1 = ap->in[22] + (size_t)lm * 1024 * 32; A.v2 = ap->in[23] + (size_t)lm * 32 * 1024;
            A.vfirst = WSP(float, WS_VFIRST); A.SR = WSP(float, WS_SR); A.SW = WSP(float, WS_SW); A.SK = WSP(float, WS_SK); A.SV = WSP(float, WS_SV); A.SA = WSP(float, WS_SA); A.SB = WSP(float, WS_SB); A.G = WSP(float, WS_G); A.layer = l;
            ph_prep(lds, A, blk, nblk);
        }
        SEAM(pb + 2);
        if (IN(pb + 3)) { CArgs ap = kargs(); unsigned char* ws = ap->ws;
            ph_scan(WSP(float, WS_SR), WSP(float, WS_SW), WSP(float, WS_SK), WSP(float, WS_SV), WSP(float, WS_SA), WSP(float, WS_SB), WSP(float, WS_Y), blk, nblk); }
        SEAM(pb + 3);
        if (IN(pb + 4)) {
            CArgs ap = kargs(); unsigned char* ws = ap->ws;
            ph_rwkv_out(WSP(float, WS_Y), WSP(float, WS_SR), WSP(float, WS_SK), WSP(float, WS_SV), WSP(float, WS_G), ap->in[19] + l * 1024, ap->in[20] + l * 1024, ap->in[18] + l * 1024, WSP(bf16, WS_MIXED), blk, nblk);
            att::Args A; A.Q = WSP(bf16, WS_Q); A.K = WSP(bf16, WS_K); A.V = WSP(bf16, WS_V); A.mixed = WSP(bf16, WS_MIXED); A.stash = WSP(float, WS_XB); A.lq = ap->in[7] + l * 128; A.lk = ap->in[8] + l * 128; A.subln = ap->in[9] + l * 128;
            A.lam_init = ap->lam_init[l]; A.pad_ = 0;
            att::attn_phase(lds, A, blk, nblk);
        }
        SEAM(pb + 4);
        if (IN(pb + 5)) {
            CArgs ap = kargs(); unsigned char* ws = ap->ws;
            pg8::Gemm g{WSP(bf16, WS_MIXED), WSP(bf16, WS_WOUT), T_, DM, DM, 0}; pg8::StaticOrder S; S.init(T_, DM, nblk, blk);
            pg8::EpiRes E{ap->out, DM, 0};
            pg8::gemm_phase<pg8::EpiRes, pg8::StaticOrder, true, true>(lds, g, S, E);
        }
        SEAM(pb + 5);
        if (IN(pb + 6)) { CArgs ap = kargs(); unsigned char* ws = ap->ws; ph_rownorm(ap->out, nullptr, WSP(bf16, WS_XB), WSP(float, WS_RINV), blk, nblk); }
        SEAM(pb + 6);
        if (IN(pb + 7)) {
            CArgs ap = kargs(); unsigned char* ws = ap->ws;
            pg8::Gemm g{WSP(bf16, WS_XB), WSP(bf16, WS_WUP), T_, DFF, DM, 0}; pg8::StaticOrder S; S.init(T_, DFF, nblk, blk);
            pg8::EpiUp E{WSP(float, WS_RINV), WSP(bf16, WS_U), DFF, 0};
            pg8::gemm_phase<pg8::EpiUp, pg8::StaticOrder, true, true>(lds, g, S, E);
        }
        SEAM(pb + 7);
        if (IN(pb + 8)) {
            CArgs ap = kargs(); unsigned char* ws = ap->ws;
            pg8::Gemm g{WSP(bf16, WS_U), WSP(bf16, WS_WDOWN), T_, DM, DFF, 0}; pg8::StaticOrder S; S.init(T_, DM, nblk, blk);
            pg8::EpiRes E{ap->out, DM, 0};
            pg8::gemm_phase<pg8::EpiRes, pg8::StaticOrder, true, true>(lds, g, S, E);
        }
        SEAM(pb + 8);
    }
#undef IN
#undef SEAM
#undef WSP
}

#ifndef MK_PER_PHASE
#define MK_PER_PHASE 0
#endif
extern "C" void kernel_launch(void* const* d_in, const int* in_sizes, int n_in, void* d_out, int out_size, void* d_ws, size_t ws_size, hipStream_t stream) {
    static int grid = 0;
    if (grid == 0) {
        grid = -1;
        if (n_in != 26 || ws_size < WS_END || out_size != T_ * DM) { fprintf(stderr, "kernel_launch: unexpected shapes (n_in %d ws %zu out %d)\n", n_in, ws_size, out_size); return; }
        int dev = 0, cus = 0, per_cu = 0;
        if (hipGetDevice(&dev) != hipSuccess || hipDeviceGetAttribute(&cus, hipDeviceAttributeMultiprocessorCount, dev) != hipSuccess) return;
        if (hipFuncSetAttribute((const void*)fwd, hipFuncAttributeMaxDynamicSharedMemorySize, LDS_BYTES) != hipSuccess) return;
        if (hipOccupancyMaxActiveBlocksPerMultiprocessor(&per_cu, (const void*)fwd, 512, LDS_BYTES) != hipSuccess || per_cu < 1) { fprintf(stderr, "kernel_launch: occupancy query says %d\n", per_cu); (void)hipGetLastError(); return; }
        grid = cus;
    }
    if (grid < 0) return;
    if (hipMemsetAsync((char*)d_ws + WS_CTL, 0, CTL_ZERO_BYTES, stream) != hipSuccess) return;
    Args a;
    memset(&a, 0, sizeof(a));
    for (int i = 0; i < 26; ++i) a.in[i] = (const float*)d_in[i];
    a.out = (float*)d_out; a.ws = (unsigned char*)d_ws;
    for (int l = 0; l < NL; ++l) a.lam_init[l] = (float)(0.8 - 0.6 * exp(-0.3 * (double)l));
    const int nph = NL * NPH;
#if MK_PER_PHASE
    for (int p = 0; p < nph; ++p) { a.ph_lo = p; a.ph_hi = p + 1; hipLaunchKernelGGL(fwd, dim3(grid), dim3(512), LDS_BYTES, stream, a); }
#else
    a.ph_lo = 0; a.ph_hi = nph; hipLaunchKernelGGL(fwd, dim3(grid), dim3(512), LDS_BYTES, stream, a);
#endif
}
```

```cpp
#include <hip/hip_runtime.h>
#include <cstdio>
#include <cstdint>
#include <cstring>
#include <cmath>

constexpr int T_ = 16384, DM = 2048, NL = 4, PW = 6432, NIN = 6656, RWP = 3584, DFF = 8192, RW_ = 1024;
constexpr float RMS_EPS = 1e-6f, GN_EPS = 64e-5f;
typedef unsigned short bf16;
typedef float f32x4 __attribute__((ext_vector_type(4)));
typedef unsigned u32x4 __attribute__((ext_vector_type(4)));
typedef unsigned u32x2 __attribute__((ext_vector_type(2)));
#define LAS __attribute__((address_space(3)))

__device__ __forceinline__ unsigned f2bf(float f) { unsigned u = __builtin_bit_cast(unsigned, f); return (u + 0x7fffu + ((u >> 16) & 1u)) >> 16; }
__device__ __forceinline__ float bf2f(unsigned short b) { return __builtin_bit_cast(float, (unsigned)b << 16); }
__device__ __forceinline__ float bflo(unsigned w) { return __builtin_bit_cast(float, w << 16); }
__device__ __forceinline__ float bfhi(unsigned w) { return __builtin_bit_cast(float, w & 0xffff0000u); }
__device__ __forceinline__ float sigmoidf_(float x) { return 1.0f / (1.0f + __expf(-x)); }

template <int CTRL, int ROWMASK> __device__ __forceinline__ float dppf(float v) {
    return __builtin_bit_cast(float, __builtin_amdgcn_update_dpp(0, __builtin_bit_cast(int, v), CTRL, ROWMASK, 0xF, false));
}
__device__ __forceinline__ float wave_sum(float v) {
    v += dppf<0xB1, 0xF>(v); v += dppf<0x4E, 0xF>(v); v += dppf<0x141, 0xF>(v); v += dppf<0x140, 0xF>(v);
    v += dppf<0x142, 0xA>(v); v += dppf<0x143, 0xC>(v);
    return __builtin_bit_cast(float, __builtin_amdgcn_readlane(__builtin_bit_cast(int, v), 63));
}
__device__ __forceinline__ int opq_tid() { int t = (int)threadIdx.x; asm volatile("" : "+v"(t)); return t; }
namespace pg8 {
#define PG8_LAS __attribute__((address_space(3)))
typedef unsigned short bf16_t;
typedef short bf16x8 __attribute__((ext_vector_type(8)));
typedef float f32x4 __attribute__((ext_vector_type(4)));
typedef unsigned u32x4 __attribute__((ext_vector_type(4)));
constexpr int BM = 256, BK = 64, HALF = 128, HTB = HALF * BK * 2  , STAGE_BYTES = 8 * HTB, NXCD = 8, WGM = 8;

__host__ __device__ __forceinline__ int lds_byte(int r, int c) { const int st = (r >> 4) * 2 + (c >> 5), rr = r & 15, cc = c & 31, ob = rr * 64 + cc * 2; return st * 1024 + (ob ^ (((ob >> 9) & 1) << 5)); }
__host__ __device__ __forceinline__ void stage_rc(int b, int& R, int& C) { const int st = b / 1024, sb = b % 1024, swz = sb ^ (((sb >> 9) & 1) << 5); R = (st >> 1) * 16 + swz / 64; C = (st & 1) * 32 + (swz % 64) / 2; }
__host__ __device__ __forceinline__ int perm32(int rho) { const int n = rho >> 4, i = rho & 15; return 8 * (i >> 2) + 4 * n + (i & 3); }

struct Unit { int pm, pn; };
struct Gemm { const bf16_t* A; const bf16_t* Bt; int M, N, K, pad_; };

struct StaticOrder {
    int nM, nN, nwg, G, c;
    __host__ __device__ void init(int M, int N, int G_, int c_) { nM = M / BM; nN = N / BM; nwg = nM * nN; G = G_; c = c_; }
    __host__ __device__ bool next(int i, Unit& u) const {
        const long L = (long)i * G + c; if (L >= nwg) return false;
        int wgid = (int)L; { const int q = nwg / NXCD, r = nwg % NXCD, xcd = wgid % NXCD, off = wgid / NXCD; wgid = (xcd < r ? xcd * (q + 1) : r * (q + 1) + (xcd - r) * q) + off; }
        const int nig = WGM * nN, gid = wgid / nig, fm = gid * WGM, gsz = (nM - fm) < WGM ? (nM - fm) : WGM;
        u.pm = fm + ((wgid % nig) % gsz); u.pn = (wgid % nig) / gsz; return true;
    }
    __device__ __forceinline__ void a_ready(const Unit&) const {}
    __device__ __forceinline__ void done(const Unit&) const {}
};

__device__ __forceinline__ unsigned cvt_pk_bf16(float lo, float hi) { unsigned r; asm volatile("v_cvt_pk_bf16_f32 %0, %1, %2" : "=v"(r) : "v"(lo), "v"(hi)); return r; }
typedef float f32x2 __attribute__((ext_vector_type(2)));
struct EpiIn {
    static constexpr bool PERM = true, AFTER_DRAIN = false;
    const float* rinv; bf16_t* q; bf16_t* k; bf16_t* v; bf16_t* rw; const float* gq; const float* gk;
    __device__ __forceinline__ void operator()(const f32x4 (&acc)[2][2][4][2], const Unit& u, int wr, int wc, int fr, int fq) const {
        const int pn = u.pn;
        const int row0 = u.pm * BM + wr * 64 + fr;
        if (pn < 8) {
            const float* g = (pn < 4 ? gq : gk) + (wc & 1) * 64 + 8 * fq;
            f32x4 gv[2][2];
#pragma unroll
            for (int bj = 0; bj < 2; ++bj)
#pragma unroll
                for (int n = 0; n < 2; ++n) gv[bj][n] = *(const f32x4*)(g + 32 * bj + 4 * n);
            bf16_t* base = (pn < 4 ? q : k) + (pn & 3) * 256 + 64 * wc + 8 * fq;
#pragma unroll
            for (int ai = 0; ai < 2; ++ai)
#pragma unroll
                for (int m = 0; m < 4; ++m) {
                    const int row = row0 + ai * HALF + m * 16; const float ri = rinv[row];
                    f32x4 vv[2][2]; float ss = 0.f;
#pragma unroll
                    for (int bj = 0; bj < 2; ++bj)
#pragma unroll
                        for (int n = 0; n < 2; ++n) { vv[bj][n] = acc[ai][bj][m][n] * ri; const f32x4 t = vv[bj][n]; ss += (t[0] * t[0] + t[1] * t[1]) + (t[2] * t[2] + t[3] * t[3]); }
                    ss += __shfl_xor(ss, 16); ss += __shfl_xor(ss, 32);
                    const float rq = 1.0f / sqrtf(ss * (1.0f / 64.0f) + 1e-6f);
#pragma unroll
                    for (int bj = 0; bj < 2; ++bj) { const f32x4 a = vv[bj][0] * rq * gv[bj][0], b = vv[bj][1] * rq * gv[bj][1];
                        u32x4 w; w.x = cvt_pk_bf16(a[0], a[1]); w.y = cvt_pk_bf16(a[2], a[3]); w.z = cvt_pk_bf16(b[0], b[1]); w.w = cvt_pk_bf16(b[2], b[3]);
                        *(u32x4*)(base + (size_t)row * 1024 + 32 * bj) = w; }
                }
        } else {
            bf16_t* base; int ld;
            if (pn < 12) { base = v + (pn - 8) * 256 + 64 * wc + 8 * fq; ld = 1024; } else { base = rw + (pn - 12) * 256 + 64 * wc + 8 * fq; ld = 3584; }
#pragma unroll
            for (int ai = 0; ai < 2; ++ai)
#pragma unroll
                for (int m = 0; m < 4; ++m) {
                    const int row = row0 + ai * HALF + m * 16; const float ri = rinv[row];
#pragma unroll
                    for (int bj = 0; bj < 2; ++bj) { const f32x4 a = acc[ai][bj][m][0] * ri, b = acc[ai][bj][m][1] * ri;
                        u32x4 w; w.x = cvt_pk_bf16(a[0], a[1]); w.y = cvt_pk_bf16(a[2], a[3]); w.z = cvt_pk_bf16(b[0], b[1]); w.w = cvt_pk_bf16(b[2], b[3]);
                        *(u32x4*)(base + (size_t)row * ld + 32 * bj) = w; }
                }
        }
    }
};
struct EpiRes {
    static constexpr bool PERM = true, AFTER_DRAIN = false;
    float* x; int ldc; int pad_;
    __device__ __forceinline__ void operator()(const f32x4 (&acc)[2][2][4][2], const Unit& u, int wr, int wc, int fr, int fq) const {
        const int row0 = u.pm * BM + wr * 64 + fr, col0 = u.pn * BM + wc * 32 + 8 * fq;
#pragma unroll
        for (int ai = 0; ai < 2; ++ai)
#pragma unroll
            for (int m = 0; m < 4; ++m) { float* rowp = x + (size_t)(row0 + ai * HALF + m * 16) * ldc + col0;
#pragma unroll
                for (int bj = 0; bj < 2; ++bj) { f32x4* p = (f32x4*)(rowp + bj * HALF); const f32x4 o0 = p[0], o1 = p[1]; p[0] = o0 + acc[ai][bj][m][0]; p[1] = o1 + acc[ai][bj][m][1]; } }
    }
};
struct EpiUp {
    static constexpr bool PERM = true, AFTER_DRAIN = false;
    const float* rinv; bf16_t* o; int ldc; int pad_;
    __device__ __forceinline__ void operator()(const f32x4 (&acc)[2][2][4][2], const Unit& u, int wr, int wc, int fr, int fq) const {
        const int row0 = u.pm * BM + wr * 64 + fr, col0 = u.pn * BM + wc * 32 + 8 * fq;
#pragma unroll
        for (int ai = 0; ai < 2; ++ai)
#pragma unroll
            for (int m = 0; m < 4; ++m) { const int row = row0 + ai * HALF + m * 16; const float ri = rinv[row]; bf16_t* rowp = o + (size_t)row * ldc + col0;
#pragma unroll
                for (int bj = 0; bj < 2; ++bj) { f32x4 a = acc[ai][bj][m][0] * ri, b = acc[ai][bj][m][1] * ri;
#pragma unroll
                    for (int e = 0; e < 4; ++e) { a[e] = a[e] > 0.f ? a[e] * a[e] : 0.f; b[e] = b[e] > 0.f ? b[e] * b[e] : 0.f; }
                    u32x4 w; w.x = cvt_pk_bf16(a[0], a[1]); w.y = cvt_pk_bf16(a[2], a[3]); w.z = cvt_pk_bf16(b[0], b[1]); w.w = cvt_pk_bf16(b[2], b[3]);
                    *(u32x4*)(rowp + bj * HALF) = w; } }
    }
};
template <class Epi, class Sched, bool ALIGN_EPI = false, bool SP2 = false>
__device__ __forceinline__ void gemm_phase(PG8_LAS unsigned char* lds, const Gemm g, const Sched& S, const Epi& E) {
    const int tid = opq_tid(), wid = __builtin_amdgcn_readfirstlane(tid >> 6), lane = tid & 63, wr = wid >> 2, wc = wid & 3, fr = lane & 15, fq = lane >> 4;
    const int K = g.K, nt = K / BK;
    unsigned voffA[2], voffB[2];
#pragma unroll
    for (int i = 0; i < 2; ++i) { int R, C; stage_rc(tid * 16 + i * 8192, R, C); const int Rb = Epi::PERM ? ((R & ~31) + perm32(R & 31)) : R;
        voffA[i] = (unsigned)(R * K + C) * 2u; voffB[i] = (unsigned)(Rb * K + C) * 2u; }
    const size_t kstep = (size_t)(BK * 2);
    const size_t hstep = (size_t)HALF * K * 2;
    const size_t tstep = 2 * hstep;
    const unsigned ldsw = (unsigned)wid * 1024u;
    const int aoff = lds_byte(wr * 64 + fr, fq * 8), boff = lds_byte(wc * 32 + fr, fq * 8);
#define PG8_SA(b, h) (((b) * 2 + (h)) * HTB)
#define PG8_SB(b, h) ((4 + (b) * 2 + (h)) * HTB)
#define PG8_STAGE(bufoff, gbase, voff) do { _Pragma("unroll") for (int _i = 0; _i < 2; ++_i) \
        __builtin_amdgcn_global_load_lds((const unsigned*)((const char*)(gbase) + (voff)[_i]), (PG8_LAS unsigned*)(lds + (bufoff) + ldsw + _i * 8192), 16, 0, 0); } while (0)
#define PG8_LDA(dst, b, h) do { _Pragma("unroll") for (int m = 0; m < 4; ++m) _Pragma("unroll") for (int k = 0; k < 2; ++k) dst[m][k] = *(const PG8_LAS bf16x8*)(lds + PG8_SA(b, h) + aoff + m * 2048 + k * 1024); } while (0)
#define PG8_LDB(dst, b, h) do { _Pragma("unroll") for (int n = 0; n < 2; ++n) _Pragma("unroll") for (int k = 0; k < 2; ++k) dst[n][k] = *(const PG8_LAS bf16x8*)(lds + PG8_SB(b, h) + boff + n * 2048 + k * 1024); } while (0)
#define PG8_MMA(ai, bj, At, Bt) do { __builtin_amdgcn_s_setprio(1); _Pragma("unroll") for (int m = 0; m < 4; ++m) _Pragma("unroll") for (int n = 0; n < 2; ++n) _Pragma("unroll") for (int k = 0; k < 2; ++k) \
        acc[ai][bj][m][n] = __builtin_amdgcn_mfma_f32_16x16x32_bf16(Bt[n][k], At[m][k], acc[ai][bj][m][n], 0, 0, 0); __builtin_amdgcn_s_setprio(0); } while (0)
#define PG8_WAIT_V(n) asm volatile("s_waitcnt vmcnt(" #n ")" ::: "memory")
#define PG8_WAIT_L(n) asm volatile("s_waitcnt lgkmcnt(" #n ")" ::: "memory")
#define PG8_BAR __builtin_amdgcn_s_barrier()
#define PG8_SCHED __builtin_amdgcn_sched_barrier(0)
    Unit cur, nxt; int ui = 0;
    if (!S.next(0, cur)) return;
    f32x4 acc[2][2][4][2];
#pragma unroll
    for (int a = 0; a < 2; ++a)
#pragma unroll
        for (int b = 0; b < 2; ++b)
#pragma unroll
            for (int m = 0; m < 4; ++m)
#pragma unroll
                for (int n = 0; n < 2; ++n) acc[a][b][m][n] = (f32x4){0.f, 0.f, 0.f, 0.f};
    bf16x8 At[4][2], B0[2][2], B1[2][2];
    const char* cA = (const char*)g.A + (size_t)cur.pm * tstep; const char* cB = (const char*)g.Bt + (size_t)cur.pn * tstep;
    S.a_ready(cur);
    if constexpr (SP2) {
        PG8_STAGE(PG8_SB(0, 0), cB, voffB); PG8_STAGE(PG8_SB(0, 1), cB + hstep, voffB); PG8_STAGE(PG8_SA(0, 0), cA, voffA); PG8_STAGE(PG8_SA(0, 1), cA + hstep, voffA);
        if (wr == 1) PG8_BAR;
        PG8_WAIT_V(2); PG8_BAR;
        PG8_STAGE(PG8_SB(1, 0), cB + kstep, voffB); PG8_STAGE(PG8_SA(1, 0), cA + kstep, voffA); PG8_STAGE(PG8_SB(1, 1), cB + hstep + kstep, voffB);
        PG8_WAIT_V(6); PG8_BAR;
    } else {
        PG8_STAGE(PG8_SB(0, 0), cB, voffB); PG8_STAGE(PG8_SA(0, 0), cA, voffA); PG8_STAGE(PG8_SB(0, 1), cB + hstep, voffB); PG8_STAGE(PG8_SA(0, 1), cA + hstep, voffA);
        if (wr == 1) PG8_BAR;
        PG8_WAIT_V(4); PG8_BAR;
        PG8_STAGE(PG8_SB(1, 0), cB + kstep, voffB); PG8_STAGE(PG8_SA(1, 0), cA + kstep, voffA); PG8_STAGE(PG8_SB(1, 1), cB + hstep + kstep, voffB);
        PG8_WAIT_V(6); PG8_BAR;
    }
    for (;;) {
        const bool has_next = S.next(ui + 1, nxt);
        const char* nA = has_next ? (const char*)g.A + (size_t)nxt.pm * tstep : cA; const char* nB = has_next ? (const char*)g.Bt + (size_t)nxt.pn * tstep : cB;
        for (int t = 0; t < nt; t += 2) {
            const bool last = (t == nt - 2);
            const char* a1 = cA + (size_t)(t + 1) * kstep;
            const char* a2 = last ? nA : cA + (size_t)(t + 2) * kstep; const char* b2 = last ? nB : cB + (size_t)(t + 2) * kstep;
            const char* a3 = a2 + kstep; const char* b3 = b2 + kstep;
            if (last && has_next) S.a_ready(nxt);
            if constexpr (SP2) {
            PG8_LDB(B0, 0, 0); PG8_LDB(B1, 0, 1); PG8_SCHED; PG8_LDA(At, 0, 0); PG8_STAGE(PG8_SA(1, 1), a1 + hstep, voffA);
            PG8_WAIT_V(8); PG8_WAIT_L(0); PG8_BAR; PG8_MMA(0, 0, At, B0); PG8_MMA(0, 1, At, B1); PG8_BAR; PG8_SCHED;
            PG8_LDA(At, 0, 1); PG8_STAGE(PG8_SB(0, 0), b2, voffB); PG8_STAGE(PG8_SB(0, 1), b2 + hstep, voffB); PG8_STAGE(PG8_SA(0, 0), a2, voffA);
            PG8_WAIT_V(8); PG8_WAIT_L(0); PG8_BAR; PG8_MMA(1, 0, At, B0); PG8_MMA(1, 1, At, B1); PG8_BAR; PG8_SCHED;
            PG8_LDB(B0, 1, 0); PG8_LDB(B1, 1, 1); PG8_SCHED; PG8_LDA(At, 1, 0); PG8_STAGE(PG8_SA(0, 1), a2 + hstep, voffA);
            PG8_WAIT_V(8); PG8_WAIT_L(0); PG8_BAR; PG8_MMA(0, 0, At, B0); PG8_MMA(0, 1, At, B1); PG8_BAR; PG8_SCHED;
            PG8_LDA(At, 1, 1); PG8_STAGE(PG8_SB(1, 0), b3, voffB); PG8_STAGE(PG8_SB(1, 1), b3 + hstep, voffB); PG8_STAGE(PG8_SA(1, 0), a3, voffA);
            PG8_WAIT_V(8); PG8_WAIT_L(0); PG8_BAR; PG8_MMA(1, 0, At, B0); PG8_MMA(1, 1, At, B1); PG8_BAR; PG8_SCHED;
            } else {
            PG8_LDB(B0, 0, 0); PG8_SCHED; PG8_LDA(At, 0, 0); PG8_STAGE(PG8_SA(1, 1), a1 + hstep, voffA);
            PG8_WAIT_L(8); PG8_BAR; PG8_WAIT_L(0); PG8_MMA(0, 0, At, B0); PG8_BAR; PG8_SCHED;
            PG8_LDB(B1, 0, 1); PG8_STAGE(PG8_SB(0, 0), b2, voffB);
            PG8_BAR; PG8_WAIT_L(0); PG8_MMA(0, 1, At, B1); PG8_BAR;
            PG8_LDA(At, 0, 1); PG8_STAGE(PG8_SA(0, 0), a2, voffA);
            PG8_BAR; PG8_WAIT_L(0); PG8_MMA(1, 0, At, B0); PG8_BAR; PG8_SCHED;
            PG8_STAGE(PG8_SB(0, 1), b2 + hstep, voffB);
            PG8_WAIT_V(6); PG8_BAR; PG8_MMA(1, 1, At, B1); PG8_BAR;
            PG8_LDB(B0, 1, 0); PG8_SCHED; PG8_LDA(At, 1, 0); PG8_STAGE(PG8_SA(0, 1), a2 + hstep, voffA);
            PG8_WAIT_L(8); PG8_BAR; PG8_WAIT_L(0); PG8_MMA(0, 0, At, B0); PG8_BAR; PG8_SCHED;
            PG8_LDB(B1, 1, 1); PG8_STAGE(PG8_SB(1, 0), b3, voffB);
            PG8_BAR; PG8_WAIT_L(0); PG8_MMA(0, 1, At, B1); PG8_BAR;
            PG8_LDA(At, 1, 1); PG8_STAGE(PG8_SA(1, 0), a3, voffA);
            PG8_BAR; PG8_WAIT_L(0); PG8_MMA(1, 0, At, B0); PG8_BAR; PG8_SCHED;
            PG8_STAGE(PG8_SB(1, 1), b3 + hstep, voffB);
            PG8_WAIT_V(6); PG8_BAR; PG8_MMA(1, 1, At, B1); PG8_BAR;
            }
        }
        if constexpr (ALIGN_EPI) { if (wr == 0) PG8_BAR; }
        if constexpr (!Epi::AFTER_DRAIN) { E(acc, cur, wr, wc, fr, fq); S.done(cur); }
        if (!has_next) break;
#pragma unroll
        for (int a = 0; a < 2; ++a)
#pragma unroll
            for (int b = 0; b < 2; ++b)
#pragma unroll
                for (int m = 0; m < 4; ++m)
#pragma unroll
                    for (int n = 0; n < 2; ++n) acc[a][b][m][n] = (f32x4){0.f, 0.f, 0.f, 0.f};
        cur = nxt; cA = nA; cB = nB; ++ui;
        if constexpr (ALIGN_EPI) { if (wr == 1) PG8_BAR; }
    }
    PG8_WAIT_V(0);
    if constexpr (!ALIGN_EPI) { if (wr == 0) PG8_BAR; }
    PG8_BAR;
    if constexpr (Epi::AFTER_DRAIN) { E.fused(acc, cur, wr, wc, fr, fq, lds, wid, lane); S.done(cur); }
#undef PG8_SA
#undef PG8_SB
#undef PG8_STAGE
#undef PG8_LDA
#undef PG8_LDB
#undef PG8_MMA
#undef PG8_WAIT_V
#undef PG8_WAIT_L
#undef PG8_BAR
#undef PG8_SCHED
}
}

namespace att {
typedef short bf16x8 __attribute__((ext_vector_type(8)));
typedef short s16x4 __attribute__((ext_vector_type(4)));
typedef float f32x16 __attribute__((ext_vector_type(16)));
typedef float f32x2_t __attribute__((ext_vector_type(2)));
typedef __bf16 bf16x2_t __attribute__((ext_vector_type(2)));
typedef __attribute__((address_space(3))) const unsigned char* lds_cptr;
typedef short v4i16_t __attribute__((ext_vector_type(4)));
constexpr int KSLOT = 8192, VSLOT = 16384, LDS_K = 0, LDS_V = 2 * KSLOT, LDS_BYTES = 2 * KSLOT + 2 * VSLOT;
constexpr float LOG2E = 1.4426950408889634f, C2 = 0.125f * LOG2E;
__device__ __forceinline__ int crow(int r, int hi) { return (r & 3) + 8 * (r >> 2) + 4 * hi; }
__device__ __forceinline__ void glds16(const void* gsrc, unsigned lds_dst) { unsigned keep;
    asm volatile("s_mov_b32 %0, m0\n\ts_mov_b32 m0, %2\n\ts_nop 0\n\tglobal_load_lds_dwordx4 %1, off\n\ts_mov_b32 m0, %0" : "=&s"(keep) : "v"(gsrc), "s"(lds_dst) : "memory"); }
__device__ __forceinline__ unsigned cvtpk(float lo, float hi) { f32x2_t v = {lo, hi}; bf16x2_t b = __builtin_convertvector(v, bf16x2_t); return __builtin_bit_cast(unsigned, b); }
__device__ __forceinline__ s16x4 vtr(lds_cptr p) { return __builtin_bit_cast(s16x4, __builtin_amdgcn_ds_read_tr16_b64_v4i16((__attribute__((address_space(3))) v4i16_t*)p)); }
__device__ __forceinline__ float swap_max(float m) { auto rr = __builtin_amdgcn_permlane32_swap(__float_as_uint(m), __float_as_uint(m), false, false); return fmaxf(__uint_as_float(rr[0]), __uint_as_float(rr[1])); }
__device__ __forceinline__ float swap_sum(float m) { auto rr = __builtin_amdgcn_permlane32_swap(__float_as_uint(m), __float_as_uint(m), false, false); return __uint_as_float(rr[0]) + __uint_as_float(rr[1]); }
#define ATT_WAIT_BAR() asm volatile("s_waitcnt vmcnt(0) lgkmcnt(0)\n\ts_barrier" ::: "memory")

struct Args { const bf16* Q; const bf16* K; const bf16* V; bf16* mixed; float* stash; const float* lq; const float* lk; const float* subln; float lam_init; int pad_; };

__device__ __forceinline__ void attn_unit(__attribute__((address_space(3))) unsigned char* lds, const Args& A, int h, int qb, float lam, float* stash_blk) {
    const int tid = opq_tid(), lane = tid & 63, r32 = lane & 31, hi = lane >> 5; const int wid = __builtin_amdgcn_readfirstlane(tid >> 6);
    const int q0 = qb * 256 + wid * 32, qc = q0 >> 6, NT = 4 * qb + 4;
    const float slope2 = exp2f(-(float)(h + 1)) * LOG2E;
    const unsigned lds0 = (unsigned)(uintptr_t)lds;
    const lds_cptr kp0 = (lds_cptr)lds + LDS_K + hi * 1024 + r32 * 16;
    const lds_cptr vp0 = (lds_cptr)lds + LDS_V + ((lane >> 4) & 1) * 32 + (lane & 3) * 8 + (4 * hi + ((lane & 15) >> 2)) * 64;
    const bf16* vsrc = A.V + (size_t)(16 * (wid & 3) + (lane >> 2)) * 1024 + h * 128 + (wid >> 2) * 32 + (lane & 3) * 8;
    const unsigned kdst = lds0 + LDS_K + wid * 1024, vdst = lds0 + LDS_V + (wid >> 2) * 4096 + (wid & 3) * 1024;
    const int qrel = (q0 & 63) + r32;
    float* st = stash_blk + tid * 64;
#pragma unroll 1
    for (int c = 0; c < 2; ++c) {
        const bf16* ksrc = A.K + (size_t)lane * 1024 + h * 128 + c * 64 + wid * 8;
        bf16x8 qr[4];
        { const bf16* qp = A.Q + (size_t)(q0 + r32) * 1024 + h * 128 + c * 64 + hi * 8;
#pragma unroll
          for (int d0 = 0; d0 < 4; ++d0) qr[d0] = *(const bf16x8*)(qp + d0 * 16); }
        f32x16 oT[4];
#pragma unroll
        for (int d0 = 0; d0 < 4; ++d0)
#pragma unroll
            for (int r = 0; r < 16; ++r) oT[d0][r] = 0.f;
        float l = 0.f, mu = 0.f;
        glds16(ksrc, (unsigned)__builtin_amdgcn_readfirstlane(kdst)); glds16(vsrc, (unsigned)__builtin_amdgcn_readfirstlane(vdst)); glds16(vsrc + 64, (unsigned)__builtin_amdgcn_readfirstlane(vdst + 8192));
        ATT_WAIT_BAR();
#pragma unroll 1
        for (int t = 0; t < NT; ++t) {
            const int sl = t & 1;
            if (t + 1 < NT) { const size_t go = (size_t)(t + 1) * 64 * 1024; const unsigned so = (unsigned)(sl ^ 1);
                glds16(ksrc + go, (unsigned)__builtin_amdgcn_readfirstlane(kdst + so * KSLOT)); glds16(vsrc + go, (unsigned)__builtin_amdgcn_readfirstlane(vdst + so * VSLOT));
                glds16(vsrc + go + 64, (unsigned)__builtin_amdgcn_readfirstlane(vdst + so * VSLOT + 8192)); }
            if (t <= qc) {
                const bool diag = (t == qc);
                f32x16 p0, p1;
                const float sc = slope2 * (1.0f / C2), base0 = (float)(4 * hi) * sc - mu * (1.0f / C2), base1 = base0 + 32.0f * sc;
                if (!diag) {
#pragma unroll
                    for (int r = 0; r < 16; ++r) { const float kr = (float)((r & 3) + 8 * (r >> 2)); p0[r] = __builtin_fmaf(kr, sc, base0); p1[r] = __builtin_fmaf(kr, sc, base1); }
                } else {
                    const float q2 = (float)(2 * qrel - 8 * hi);
#pragma unroll
                    for (int r = 0; r < 16; ++r) { const float kr = (float)((r & 3) + 8 * (r >> 2));
                        p0[r] = __builtin_fmaf(fminf(kr, q2 - kr) , sc, base0); p1[r] = __builtin_fmaf(fminf(kr, q2 - 64.0f - kr), sc, base1); }
                }
                const lds_cptr kp = kp0 + sl * KSLOT;
#pragma unroll
                for (int d0 = 0; d0 < 4; ++d0) {
                    const bf16x8 k0 = *(const __attribute__((address_space(3))) bf16x8*)(kp + d0 * 2048), k1 = *(const __attribute__((address_space(3))) bf16x8*)(kp + d0 * 2048 + 512);
                    p0 = __builtin_amdgcn_mfma_f32_32x32x16_bf16(k0, qr[d0], p0, 0, 0, 0);
                    p1 = __builtin_amdgcn_mfma_f32_32x32x16_bf16(k1, qr[d0], p1, 0, 0, 0);
                }
                float rm = fmaxf(p0[0], p1[0]);
#pragma unroll
                for (int r = 1; r < 16; ++r) rm = fmaxf(rm, fmaxf(p0[r], p1[r]));
                rm = swap_max(rm);
                const float dl = (t == 0) ? C2 * rm : fmaxf(C2 * rm, 0.f);
                if (__any(dl != 0.f)) { const float f = __builtin_amdgcn_exp2f(-dl); l *= f;
#pragma unroll
                    for (int d0 = 0; d0 < 4; ++d0)
#pragma unroll
                        for (int r = 0; r < 16; ++r) oT[d0][r] *= f; }
                mu += dl;
                float ls = 0.f;
#pragma unroll
                for (int r = 0; r < 16; ++r) { p0[r] = __builtin_amdgcn_exp2f(p0[r] * C2 - dl); p1[r] = __builtin_amdgcn_exp2f(p1[r] * C2 - dl); ls += p0[r] + p1[r]; }
                l += ls;
                bf16x8 pw[4];
#pragma unroll
                for (int s = 0; s < 4; ++s) { u32x4 w;
#pragma unroll
                    for (int e = 0; e < 4; ++e) { const int r = 8 * (s & 1) + 2 * e; w[e] = (s < 2) ? cvtpk(p0[r], p0[r + 1]) : cvtpk(p1[r], p1[r + 1]); }
                    pw[s] = __builtin_bit_cast(bf16x8, w); }
                const lds_cptr vp = vp0 + sl * VSLOT;
#pragma unroll
                for (int d0 = 0; d0 < 4; ++d0) {
#pragma unroll
                    for (int s = 0; s < 4; ++s) { const s16x4 lo = vtr(vp + d0 * 4096 + s * 1024), hh = vtr(vp + d0 * 4096 + s * 1024 + 512);
                        const bf16x8 vf = (bf16x8){lo[0], lo[1], lo[2], lo[3], hh[0], hh[1], hh[2], hh[3]};
                        oT[d0] = __builtin_amdgcn_mfma_f32_32x32x16_bf16(vf, pw[s], oT[d0], 0, 0, 0); }
                    __builtin_amdgcn_sched_barrier(0); }
                mu -= 64.0f * slope2;
            }
            ATT_WAIT_BAR();
        }
        const float il = 1.0f / swap_sum(l);
        if (c == 0) {
#pragma unroll
            for (int d0 = 0; d0 < 4; ++d0)
#pragma unroll
                for (int r = 0; r < 16; r += 4) *(f32x4*)(st + d0 * 16 + r) = (f32x4){oT[d0][r] * il, oT[d0][r + 1] * il, oT[d0][r + 2] * il, oT[d0][r + 3] * il};
        } else {
            float ss = 0.f;
#pragma unroll
            for (int d0 = 0; d0 < 4; ++d0)
#pragma unroll
                for (int r = 0; r < 16; r += 4) { const f32x4 sv = *(const f32x4*)(st + d0 * 16 + r);
#pragma unroll
                    for (int e = 0; e < 4; ++e) { const float v = sv[e] - lam * (oT[d0][r + e] * il); oT[d0][r + e] = v; ss += v * v; } }
            ss = swap_sum(ss);
            const float rn = (1.0f / sqrtf(ss * (1.0f / 128.0f) + RMS_EPS)) * (1.0f - A.lam_init);
            bf16* op = A.mixed + (size_t)(q0 + r32) * DM + h * 128;
#pragma unroll
            for (int d0 = 0; d0 < 4; ++d0)
#pragma unroll
                for (int g4 = 0; g4 < 4; ++g4) { const int d = 32 * d0 + 8 * g4 + 4 * hi; const f32x4 gg = *(const f32x4*)(A.subln + d);
                    u32x2 w; w.x = cvtpk(oT[d0][4 * g4] * rn * gg[0], oT[d0][4 * g4 + 1] * rn * gg[1]); w.y = cvtpk(oT[d0][4 * g4 + 2] * rn * gg[2], oT[d0][4 * g4 + 3] * rn * gg[3]);
                    *(u32x2*)(op + d) = w; }
        }
    }
}
__device__ __forceinline__ void attn_phase(__attribute__((address_space(3))) unsigned char* lds, const Args& A, int blk, int nblk) {
    const int lane = opq_tid() & 63;
    const float l0 = wave_sum(A.lq[lane] * A.lk[lane]), l1 = wave_sum(A.lq[64 + lane] * A.lk[64 + lane]);
    const float lam = __expf(l0) - __expf(l1) + A.lam_init;
    float* stash_blk = A.stash + (size_t)blk * (64 * 512);
    for (int u = blk; u < 512; u += nblk) {
        const int b = u & 255, second = u >> 8, h = b & 7, s = b >> 3, qb = second ? s : 63 - s;
        attn_unit(lds, A, h, qb, lam, stash_blk);
    }
}
}

namespace rk {
typedef short bf16x8 __attribute__((ext_vector_type(8)));
typedef short s16x4 __attribute__((ext_vector_type(4)));
typedef short v4i16_t __attribute__((ext_vector_type(4)));
typedef const LAS unsigned char* lcp;
constexpr int ST = 72, MATB = 64 * ST * 2, NST = 68;
constexpr int O_AT = 0, O_RT = MATB, O_BT = 2 * MATB, O_KT = 3 * MATB, O_VV = 4 * MATB, O_AAK = 5 * MATB, O_ARB = 6 * MATB, O_ARK = 7 * MATB, O_NN = 8 * MATB, O_GG = O_NN + 64 * NST * 4,
              O_U0T = O_GG + 64 * NST * 4, O_SEG = O_U0T + MATB, O_GL = O_SEG + 2048, O_END = O_GL + 256, O_WT = O_AAK;
static_assert(O_END <= 131072, "stage-1 LDS map");
__device__ __forceinline__ f32x4 mfma16(bf16x8 a, bf16x8 b, f32x4 c) { return __builtin_amdgcn_mfma_f32_16x16x32_bf16(a, b, c, 0, 0, 0); }
__device__ __forceinline__ s16x4 vtr(lcp p) { return __builtin_bit_cast(s16x4, __builtin_amdgcn_ds_read_tr16_b64_v4i16((LAS v4i16_t*)p)); }
__device__ __forceinline__ bf16x8 frag(lcp m, int row0, int ks, int lane) { return *(const LAS bf16x8*)(m + ((row0 + (lane & 15)) * ST + 32 * ks + 8 * (lane >> 4)) * 2); }
__device__ __forceinline__ bf16x8 tfrag(lcp m, int c0, int ks, int lane) {
    const int i = lane & 15, q = i >> 2, p = i & 3, k0 = 32 * ks + 8 * (lane >> 4);
    const s16x4 lo = vtr(m + ((k0 + q) * ST + c0 + 4 * p) * 2), hi = vtr(m + ((k0 + 4 + q) * ST + c0 + 4 * p) * 2);
    return (bf16x8){lo[0], lo[1], lo[2], lo[3], hi[0], hi[1], hi[2], hi[3]};
}
__device__ __forceinline__ unsigned pk(float a, float b) { return f2bf(a) | (f2bf(b) << 16); }
#define RK_BAR() do { asm volatile("s_waitcnt vmcnt(0) lgkmcnt(0)" ::: "memory"); __builtin_amdgcn_s_barrier(); asm volatile("" ::: "memory"); } while (0)


template <int T> struct SolveRow {
    static __device__ __forceinline__ void load(f32x4 (&buf)[16], LAS unsigned char* lds) {
#pragma unroll
        for (int s4 = 0; s4 < 16; ++s4) if (s4 * 4 < T + 1) buf[s4] = *(const LAS f32x4*)(lds + ((T + 1) * NST + 4 * s4) * 4);
    }
    static __device__ __forceinline__ void run(float (&x)[64], f32x4 (&cur)[16], f32x4 (&nxt)[16], LAS unsigned char* lds) {
        if constexpr (T + 1 < 64) load(nxt, lds);
        asm volatile("" ::: "memory"); __builtin_amdgcn_sched_barrier(0);
        float acc = x[T];
#pragma unroll
        for (int s4 = 0; s4 < 16; ++s4)
#pragma unroll
            for (int e = 0; e < 4; ++e) if (4 * s4 + e < T) acc = __builtin_fmaf(cur[s4][e], x[4 * s4 + e], acc);
        x[T] = acc;
        asm volatile("" : "+v"(x[T]) :: "memory"); __builtin_amdgcn_sched_barrier(0);
        if constexpr (T + 1 < 64) SolveRow<T + 1>::run(x, nxt, cur, lds);
    }
};

struct S1Args { const float* SR; const float* SW; const float* SK; const float* SV; const float* SA; const float* SB; bf16* PG; float* QT; bf16* RP; float* Y0; };

__device__ __forceinline__ void stage1_unit(LAS unsigned char* lds, const S1Args& A, int c, int h) {
    const int tid = opq_tid(), lane = tid & 63, wid = __builtin_amdgcn_readfirstlane(tid >> 6), rq = lane >> 4, l15 = lane & 15;
    const int t0 = c * 64, u = c * 16 + h;
    LAS float* SEG = (LAS float*)(lds + O_SEG); LAS float* GL = (LAS float*)(lds + O_GL);
    {
        const int j = lane; float lw[8], cum[8];
        const size_t g0 = (size_t)(t0 + 8 * wid) * 1024 + h * 64 + j;
#pragma unroll
        for (int e = 0; e < 8; ++e) lw[e] = __logf(A.SW[g0 + (size_t)e * 1024]);
        cum[0] = lw[0];
#pragma unroll
        for (int e = 1; e < 8; ++e) cum[e] = cum[e - 1] + lw[e];
        SEG[wid * 64 + j] = cum[7];
        RK_BAR();
        float off = 0.f, tot = 0.f;
#pragma unroll
        for (int s = 0; s < 8; ++s) { const float v = SEG[s * 64 + j]; off += (s < wid) ? v : 0.f; tot += v; }
        if (wid == 0) GL[j] = __expf(tot);
#pragma unroll
        for (int e = 0; e < 8; ++e) {
            const float cm = cum[e] + off, g = __expf(cm), gi = __expf(-cm), gp = __expf(cm - lw[e]);
            const size_t gi_ = g0 + (size_t)e * 1024; const int o = ((8 * wid + e) * ST + j) * 2;
            *(LAS unsigned short*)(lds + O_AT + o) = (unsigned short)f2bf(A.SA[gi_] * gp);
            *(LAS unsigned short*)(lds + O_BT + o) = (unsigned short)f2bf(A.SB[gi_] * gi);
            *(LAS unsigned short*)(lds + O_KT + o) = (unsigned short)f2bf(A.SK[gi_] * gi);
            *(LAS unsigned short*)(lds + O_RT + o) = (unsigned short)f2bf(A.SR[gi_] * g);
            *(LAS unsigned short*)(lds + O_VV + o) = (unsigned short)f2bf(A.SV[gi_]);
        }
        RK_BAR();
    }
    const int b0 = wid >> 1;
    {
        const bf16x8 bA0 = frag(lds + O_BT, 16 * b0, 0, lane), bA1 = frag(lds + O_BT, 16 * b0, 1, lane), kA0 = frag(lds + O_KT, 16 * b0, 0, lane), kA1 = frag(lds + O_KT, 16 * b0, 1, lane);
#pragma unroll
        for (int tt = 0; tt < 2; ++tt) {
            const int tb = 2 * (wid & 1) + tt;
            const bf16x8 aB0 = frag(lds + O_AT, 16 * tb, 0, lane), aB1 = frag(lds + O_AT, 16 * tb, 1, lane), rB0 = frag(lds + O_RT, 16 * tb, 0, lane), rB1 = frag(lds + O_RT, 16 * tb, 1, lane);
            const f32x4 z = {0.f, 0.f, 0.f, 0.f};
            f32x4 ab = mfma16(bA1, aB1, mfma16(bA0, aB0, z)), ak = mfma16(kA1, aB1, mfma16(kA0, aB0, z)), rb = mfma16(bA1, rB1, mfma16(bA0, rB0, z)), rk_ = mfma16(kA1, rB1, mfma16(kA0, rB0, z));
            const int tcol = 16 * tb + l15, srow = 16 * b0 + 4 * rq;
#pragma unroll
            for (int e = 0; e < 4; ++e) { const bool st = tcol > srow + e, le = tcol >= srow + e; ab[e] = st ? ab[e] : 0.f; ak[e] = st ? ak[e] : 0.f; rb[e] = le ? rb[e] : 0.f; rk_[e] = le ? rk_[e] : 0.f; }
            *(LAS f32x4*)(lds + O_NN + (tcol * NST + srow) * 4) = ab;
            const int o = (tcol * ST + srow) * 2;
            *(LAS u32x2*)(lds + O_AAK + o) = (u32x2){pk(ak[0], ak[1]), pk(ak[2], ak[3])};
            *(LAS u32x2*)(lds + O_ARB + o) = (u32x2){pk(rb[0], rb[1]), pk(rb[2], rb[3])};
            *(LAS u32x2*)(lds + O_ARK + o) = (u32x2){pk(rk_[0], rk_[1]), pk(rk_[2], rk_[3])};
        }
        RK_BAR();
    }
    {
        const bf16x8 vA0 = tfrag(lds + O_VV, 16 * b0, 0, lane), vA1 = tfrag(lds + O_VV, 16 * b0, 1, lane);
#pragma unroll
        for (int tt = 0; tt < 2; ++tt) {
            const int tb = 2 * (wid & 1) + tt;
            const f32x4 z = {0.f, 0.f, 0.f, 0.f};
            const f32x4 g = mfma16(vA1, frag(lds + O_AAK, 16 * tb, 1, lane), mfma16(vA0, frag(lds + O_AAK, 16 * tb, 0, lane), z));
            *(LAS f32x4*)(lds + O_GG + ((16 * tb + l15) * NST + 16 * b0 + 4 * rq) * 4) = g;
        }
        RK_BAR();
    }
    if (wid < 2) {
        float x[64];
        if (wid == 0) {
#pragma unroll
            for (int t = 0; t < 64; ++t) x[t] = bf2f(*(const LAS unsigned short*)(lds + O_AT + (t * ST + lane) * 2));
        } else {
#pragma unroll
            for (int t = 0; t < 64; ++t) x[t] = *(const LAS float*)(lds + O_GG + (t * NST + lane) * 4);
        }
        f32x4 na[16], nb[16];
        LAS unsigned char* nn = lds + O_NN; asm volatile("" : "+v"(nn));
        SolveRow<0>::load(na, nn);
        SolveRow<1>::run(x, na, nb, nn);
        LAS unsigned char* dst = lds + (wid == 0 ? O_WT : O_U0T) + lane * ST * 2;
#pragma unroll
        for (int i = 0; i < 8; ++i) *(LAS u32x4*)(dst + i * 16) = (u32x4){pk(x[8 * i], x[8 * i + 1]), pk(x[8 * i + 2], x[8 * i + 3]), pk(x[8 * i + 4], x[8 * i + 5]), pk(x[8 * i + 6], x[8 * i + 7])};
    }
    RK_BAR();
    {
        const bf16x8 wA0 = frag(lds + O_WT, 16 * b0, 0, lane), wA1 = frag(lds + O_WT, 16 * b0, 1, lane);
        const bf16x8 uA0 = frag(lds + O_U0T, 16 * b0, 0, lane), uA1 = frag(lds + O_U0T, 16 * b0, 1, lane);
        const bf16x8 vA0 = tfrag(lds + O_VV, 16 * b0, 0, lane), vA1 = tfrag(lds + O_VV, 16 * b0, 1, lane);
        const bf16x8 bA0 = tfrag(lds + O_BT, 16 * b0, 0, lane), bA1 = tfrag(lds + O_BT, 16 * b0, 1, lane);
        const bf16x8 kA0 = tfrag(lds + O_KT, 16 * b0, 0, lane), kA1 = tfrag(lds + O_KT, 16 * b0, 1, lane);
        const f32x4 glr = *(const LAS f32x4*)(lds + O_GL + (16 * b0 + 4 * rq) * 4);
#pragma unroll
        for (int tt = 0; tt < 2; ++tt) {
            const int nb = 2 * (wid & 1) + tt, col = 16 * nb + l15, row = 16 * b0 + 4 * rq;
            const f32x4 z = {0.f, 0.f, 0.f, 0.f};
            const bf16x8 rbB0 = frag(lds + O_ARB, 16 * nb, 0, lane), rbB1 = frag(lds + O_ARB, 16 * nb, 1, lane), rkB0 = frag(lds + O_ARK, 16 * nb, 0, lane), rkB1 = frag(lds + O_ARK, 16 * nb, 1, lane);
            { f32x4 d = mfma16(wA1, rbB1, mfma16(wA0, rbB0, z)); const u32x2 rt = *(const LAS u32x2*)(lds + O_RT + (col * ST + row) * 2);
              d[0] += bflo(rt.x); d[1] += bfhi(rt.x); d[2] += bflo(rt.y); d[3] += bfhi(rt.y);
              *(u32x2*)(A.RP + (size_t)(t0 + col) * 1024 + h * 64 + row) = (u32x2){pk(d[0], d[1]), pk(d[2], d[3])}; }
            { const f32x4 d = mfma16(vA1, rkB1, mfma16(vA0, rkB0, mfma16(uA1, rbB1, mfma16(uA0, rbB0, z))));
              *(f32x4*)(A.Y0 + (size_t)(t0 + col) * 1024 + h * 64 + row) = d; }
            { const bf16x8 bB0 = tfrag(lds + O_BT, 16 * nb, 0, lane), bB1 = tfrag(lds + O_BT, 16 * nb, 1, lane);
              f32x4 d = mfma16(wA1, bB1, mfma16(wA0, bB0, z)); const float gj = GL[col];
#pragma unroll
              for (int e = 0; e < 4; ++e) d[e] = gj * (d[e] + ((row + e) == col ? 1.f : 0.f));
              *(u32x2*)(A.PG + (size_t)u * 4096 + col * 64 + row) = (u32x2){pk(d[0], d[1]), pk(d[2], d[3])}; }
            { const bf16x8 uB0 = frag(lds + O_U0T, 16 * nb, 0, lane), uB1 = frag(lds + O_U0T, 16 * nb, 1, lane), vB0 = tfrag(lds + O_VV, 16 * nb, 0, lane), vB1 = tfrag(lds + O_VV, 16 * nb, 1, lane);
              f32x4 d = mfma16(kA1, vB1, mfma16(kA0, vB0, mfma16(bA1, uB1, mfma16(bA0, uB0, z))));
              d = d * glr;
              *(f32x4*)(A.QT + (size_t)u * 4096 + col * 64 + row) = d; }
        }
    }
    RK_BAR();
}
__device__ __forceinline__ void ph_stage1(LAS unsigned char* lds, const S1Args& A, int blk, int nblk) {
    for (int u = blk; u < 4096; u += nblk) stage1_unit(lds, A, u >> 4, u & 15);
}

__device__ __forceinline__ void chain_wave(const bf16* __restrict__ PG, const float* __restrict__ QT, bf16* __restrict__ H0T, int h, int ig, int lane) {
    const int fr = lane & 15, fq = lane >> 4;
    f32x4 H[4];
#pragma unroll
    for (int m = 0; m < 4; ++m) H[m] = (f32x4){0.f, 0.f, 0.f, 0.f};
    for (int c = 0; c < 256; ++c) {
        const size_t u = (size_t)c * 16 + h;
        const bf16* P = PG + u * 4096; const float* Q = QT + u * 4096 + (16 * ig + fr) * 64 + 4 * fq; bf16* Ho = H0T + u * 4096 + (16 * ig + fr) * 64 + 4 * fq;
        u32x2 a[4][2][2]; f32x4 cq[4];
#pragma unroll
        for (int m = 0; m < 4; ++m) { cq[m] = *(const f32x4*)(Q + 16 * m);
#pragma unroll
            for (int kb = 0; kb < 2; ++kb) { a[m][kb][0] = *(const u32x2*)(P + (16 * m + fr) * 64 + 32 * kb + 4 * fq); a[m][kb][1] = *(const u32x2*)(P + (16 * m + fr) * 64 + 32 * kb + 16 + 4 * fq); } }
        u32x4 bw[2];
#pragma unroll
        for (int m = 0; m < 4; ++m) { const u32x2 w = {pk(H[m][0], H[m][1]), pk(H[m][2], H[m][3])}; *(u32x2*)(Ho + 16 * m) = w; bw[m >> 1][2 * (m & 1)] = w.x; bw[m >> 1][2 * (m & 1) + 1] = w.y; }
#pragma unroll
        for (int m = 0; m < 4; ++m) {
            f32x4 d = cq[m];
#pragma unroll
            for (int kb = 0; kb < 2; ++kb) { const u32x4 aw = {a[m][kb][0].x, a[m][kb][0].y, a[m][kb][1].x, a[m][kb][1].y};
                d = mfma16(__builtin_bit_cast(bf16x8, aw), __builtin_bit_cast(bf16x8, bw[kb]), d); }
            H[m] = d;
        }
    }
}
__device__ __forceinline__ void ph_chain(const bf16* PG, const float* QT, bf16* H0T, int blk, int nblk) {
    const int tid = opq_tid(), lane = tid & 63;
    for (int gw = blk * 8 + (tid >> 6); gw < 64; gw += nblk * 8) chain_wave(PG, QT, H0T, gw >> 2, gw & 3, lane);
}

struct S3Args { const bf16* H0T; const bf16* RP; const float* Y0; const float* SR; const float* SK; const float* SV; const float* G; const float* ln_w; const float* ln_b; const float* r_k; bf16* mixed; };
__device__ __forceinline__ void ph_stage3(const S3Args& A, int blk, int nblk) {
    const int tid = opq_tid(), lane = tid & 63, fr = lane & 15, fq = lane >> 4;
    for (int it = blk * 8 + (tid >> 6); it < 4096 * 4; it += nblk * 8) {
        const int u = it >> 2, tb = it & 3, c = u >> 4, h = u & 15, t = 64 * c + 16 * tb + fr;
        const bf16* Hp = A.H0T + (size_t)u * 4096 + fr * 64 + 8 * fq; const bf16* Rp = A.RP + (size_t)t * 1024 + h * 64 + 8 * fq;
        const bf16x8 r0 = *(const bf16x8*)Rp, r1 = *(const bf16x8*)(Rp + 32);
        f32x4 y[4];
#pragma unroll
        for (int ib = 0; ib < 4; ++ib) { const f32x4 y0 = *(const f32x4*)(A.Y0 + (size_t)t * 1024 + h * 64 + 16 * ib + 4 * fq);
            y[ib] = mfma16(*(const bf16x8*)(Hp + ib * 1024 + 32), r1, mfma16(*(const bf16x8*)(Hp + ib * 1024), r0, y0)); }
        float s = 0.f;
#pragma unroll
        for (int ib = 0; ib < 4; ++ib) s += (y[ib][0] + y[ib][1]) + (y[ib][2] + y[ib][3]);
        s += __shfl_xor(s, 16); s += __shfl_xor(s, 32);
        const float mean = s * (1.0f / 64.0f); float q = 0.f;
#pragma unroll
        for (int ib = 0; ib < 4; ++ib)
#pragma unroll
            for (int e = 0; e < 4; ++e) { const float d = y[ib][e] - mean; y[ib][e] = d; q += d * d; }
        q += __shfl_xor(q, 16); q += __shfl_xor(q, 32);
        const float rstd = 1.0f / sqrtf(q * (1.0f / 64.0f) + GN_EPS);
        float bs = 0.f;
        { const float* rp = A.SR + (size_t)t * 1024 + h * 64 + 16 * fq; const float* kp = A.SK + (size_t)t * 1024 + h * 64 + 16 * fq; const float* rk = A.r_k + h * 64 + 16 * fq;
#pragma unroll
          for (int i = 0; i < 4; ++i) { const f32x4 a = *(const f32x4*)(rp + 4 * i), b = *(const f32x4*)(kp + 4 * i), w = *(const f32x4*)(rk + 4 * i); bs += (a[0] * b[0] * w[0] + a[1] * b[1] * w[1]) + (a[2] * b[2] * w[2] + a[3] * b[3] * w[3]); } }
        bs += __shfl_xor(bs, 16); bs += __shfl_xor(bs, 32);
#pragma unroll
        for (int ib = 0; ib < 4; ++ib) { const int ch = h * 64 + 16 * ib + 4 * fq; const size_t o = (size_t)t * 1024 + ch;
            const f32x4 lw = *(const f32x4*)(A.ln_w + ch), lb = *(const f32x4*)(A.ln_b + ch), vv = *(const f32x4*)(A.SV + o), gg = *(const f32x4*)(A.G + o); f32x4 r;
#pragma unroll
            for (int e = 0; e < 4; ++e) r[e] = (y[ib][e] * rstd * lw[e] + lb[e] + bs * vv[e]) * gg[e];
            *(u32x2*)(A.mixed + (size_t)t * DM + 1024 + ch) = (u32x2){pk(r[0], r[1]), pk(r[2], r[3])}; }
    }
}
}
#define XB_TMO      128
#define XB_XCNT(j)  (256  + 64 * (j))
#define XB_XSUB(j)  (1280 + 64 * (j))
#define XB_XGEN(j)  (2304 + 64 * (j))
#define XB_TOP      3328
#define XB_TOPGEN   3392
#define XCD_BAR_WORDS 3456
#define XB_SPIN_CAP (1u << 22)

__device__ __forceinline__ unsigned xb_ld(unsigned* p)              { return __hip_atomic_load(p, __ATOMIC_RELAXED, __HIP_MEMORY_SCOPE_AGENT); }
__device__ __forceinline__ unsigned xb_add(unsigned* p, unsigned v) { return __hip_atomic_fetch_add(p, v, __ATOMIC_RELAXED, __HIP_MEMORY_SCOPE_AGENT); }
__device__ __forceinline__ unsigned xb_xcc_id() { return (unsigned)__builtin_amdgcn_s_getreg((3 << 11) | 20) & 0xFu; }
#define XB_SPIN(cond, bar) do { unsigned _sp = 0; while (cond) { __builtin_amdgcn_s_sleep(1); \
    if ((++_sp & 255u) == 0u) { if (xb_ld(&(bar)[XB_TMO])) break; if (_sp > XB_SPIN_CAP) { atomicAdd(&(bar)[XB_TMO], 1u); break; } } } } while (0)

struct XcdBarrier {
    unsigned* bar; unsigned x;
    volatile LAS unsigned* st;
};

__device__ __forceinline__ XcdBarrier xcd_barrier_post(unsigned* bar, volatile LAS unsigned* st) {
    XcdBarrier b; b.bar = bar; b.x = xb_xcc_id(); b.st = st;
    if (threadIdx.x == 0) (void)xb_add(&bar[XB_XCNT(b.x)], 1u);
    return b;
}
__device__ __forceinline__ void xcd_barrier_complete(unsigned* bar, unsigned x, unsigned& nloc, unsigned& nx) {
    const unsigned G = gridDim.x * gridDim.y * gridDim.z;
    unsigned sum, cnt, mine, sp = 0u;
    for (;;) {
        sum = 0u; cnt = 0u; mine = 0u;
#pragma unroll
        for (unsigned j = 0; j < 16; ++j) { const unsigned c = xb_ld(&bar[XB_XCNT(j)]); sum += c; cnt += (c > 0u) ? 1u : 0u; mine = (j == x) ? c : mine; }
        if (sum == G) break;
        __builtin_amdgcn_s_sleep(1);
        if ((++sp & 255u) == 0u) { if (xb_ld(&bar[XB_TMO])) break; if (sp > XB_SPIN_CAP) { atomicAdd(&bar[XB_TMO], 1u); break; } }
    }
    nloc = mine > 0u ? mine : 1u; nx = cnt > 0u ? cnt : 1u;
}

__device__ __forceinline__ void xcd_barrier(const XcdBarrier& b) {
    asm volatile("s_waitcnt vmcnt(0)" ::: "memory");
    __syncthreads();
    if (threadIdx.x == 0) {
        unsigned* bar = b.bar;
        __builtin_amdgcn_s_waitcnt(0);
        unsigned nloc = b.st[0], nx = b.st[1];
        if (nloc == 0u) { xcd_barrier_complete(bar, b.x, nloc, nx); b.st[0] = nloc; b.st[1] = nx; }
        const unsigned old = xb_add(&bar[XB_XSUB(b.x)], 1u);
        const unsigned gen = old / nloc;
        if (old + 1u == (gen + 1u) * nloc) {
            __builtin_amdgcn_fence(__ATOMIC_RELEASE, "agent");
            asm volatile("s_waitcnt vmcnt(0)" ::: "memory");
            const unsigned og = xb_add(&bar[XB_TOP], 1u);
            const unsigned tg = og / nx;
            if (og + 1u == (tg + 1u) * nx) xb_add(&bar[XB_TOPGEN], 1u);
            else XB_SPIN(xb_ld(&bar[XB_TOPGEN]) == tg, bar);
            __builtin_amdgcn_fence(__ATOMIC_ACQUIRE, "agent");
            xb_add(&bar[XB_XGEN(b.x)], 1u);
            asm volatile("s_waitcnt vmcnt(0)" ::: "memory");
        } else {
            XB_SPIN(xb_ld(&bar[XB_XGEN(b.x)]) == gen, bar);
            __builtin_amdgcn_fence(__ATOMIC_ACQUIRE, "agent");
            asm volatile("s_waitcnt vmcnt(0)" ::: "memory");
        }
    }
    __syncthreads();
}

constexpr size_t MiB = 1u << 20;
constexpr size_t WS_CTL = 0, CTL_ZERO_BYTES = 64 * 1024, WS_RINV = 1 * MiB, WS_WIN = 2 * MiB, WS_WOUT = 28 * MiB, WS_WUP = 36 * MiB, WS_WDOWN = 68 * MiB, WS_XB = 100 * MiB, WS_Q = 164 * MiB, WS_K = 196 * MiB,
                 WS_V = 228 * MiB, WS_RW = 260 * MiB, WS_MIXED = 372 * MiB, WS_U = 164 * MiB, WS_VFIRST = 436 * MiB, WS_SR = 500 * MiB, WS_SW = 564 * MiB, WS_SK = 628 * MiB, WS_SV = 692 * MiB,
                 WS_SA = 756 * MiB, WS_SB = 820 * MiB, WS_G = 884 * MiB, WS_Y = 948 * MiB, WS_END = 1012 * MiB;
constexpr int CW_BAR = 1024;
constexpr int RING_BYTES = 131072, MISC_OFF = RING_BYTES + 320, LDS_BYTES = 147456;

struct Args { const float* in[26]; float* out; unsigned char* ws; int ph_lo, ph_hi; float lam_init[4]; };

template <bool PERMIN> __device__ __forceinline__ void convw_tile(LAS float* tile, const float* __restrict__ src, bf16* __restrict__ dst, const float* __restrict__ g, int K, int N, int item, int nkb) {
    const int k0 = (item % nkb) * 64, c0 = (item / nkb) * 64, tid = opq_tid();
    for (int i = tid; i < 64 * 64; i += 512) {
        const int kk = i >> 6, cc = i & 63, cp = c0 + cc; int col = cp;
        if (PERMIN) { const int lo = cp & 255, bj = lo >> 7, wc = (lo >> 5) & 3, j = lo & 31; col = (cp & ~255) + 64 * wc + 32 * bj + j; }
        float v = 0.f;
        if (col < N) { v = src[(size_t)(k0 + kk) * N + col]; if (g) v *= g[k0 + kk]; }
        tile[kk * 65 + cc] = v;
    }
    __syncthreads();
    for (int i = tid; i < 64 * 32; i += 512) {
        const int cc = i >> 5, kp = (i & 31) * 2;
        *(unsigned*)(dst + (size_t)(c0 + cc) * K + k0 + kp) = f2bf(tile[kp * 65 + cc]) | (f2bf(tile[(kp + 1) * 65 + cc]) << 16);
    }
    __syncthreads();
}
__device__ __forceinline__ void ph_convw(LAS unsigned char* lds, const __attribute__((address_space(4))) Args* a, int l, int blk, int nblk) {
    LAS float* tile = (LAS float*)lds; unsigned char* ws = a->ws;
    constexpr int I_IN = (DM / 64) * (NIN / 64), I_OUT = (DM / 64) * (DM / 64), I_UP = (DM / 64) * (DFF / 64), I_DN = (DFF / 64) * (DM / 64);
    for (int it = blk; it < I_IN + I_OUT + I_UP + I_DN; it += nblk) {
        int r = it;
        if (r < I_IN) { convw_tile<true>(tile, a->in[3] + (size_t)l * DM * PW, (bf16*)(ws + WS_WIN), a->in[1] + (size_t)l * DM, DM, PW, r, DM / 64); continue; } r -= I_IN;
        if (r < I_OUT) { convw_tile<false>(tile, a->in[4] + (size_t)l * DM * DM, (bf16*)(ws + WS_WOUT), nullptr, DM, DM, r, DM / 64); continue; } r -= I_OUT;
        if (r < I_UP) { convw_tile<false>(tile, a->in[24] + (size_t)l * DM * DFF, (bf16*)(ws + WS_WUP), a->in[2] + (size_t)l * DM, DM, DFF, r, DM / 64); continue; } r -= I_UP;
        convw_tile<false>(tile, a->in[25] + (size_t)l * DFF * DM, (bf16*)(ws + WS_WDOWN), nullptr, DFF, DM, r, DFF / 64);
    }
}
__device__ __forceinline__ void ph_rownorm(const float* __restrict__ src, float* __restrict__ copy, bf16* __restrict__ xb, float* __restrict__ rinv, int blk, int nblk) {
    const int tid_ = opq_tid(), lane = tid_ & 63, gw = blk * 8 + (tid_ >> 6), ngw = nblk * 8;
    for (int row = gw; row < T_; row += ngw) {
        const f32x4* s = (const f32x4*)(src + (size_t)row * DM);
        float ss = 0.f;
#pragma unroll
        for (int j = 0; j < 8; ++j) { const f32x4 v = s[lane + 64 * j]; ss += (v[0] * v[0] + v[1] * v[1]) + (v[2] * v[2] + v[3] * v[3]);
            if (copy) ((f32x4*)(copy + (size_t)row * DM))[lane + 64 * j] = v;
            u32x2 w; w.x = f2bf(v[0]) | (f2bf(v[1]) << 16); w.y = f2bf(v[2]) | (f2bf(v[3]) << 16);
            ((u32x2*)(xb + (size_t)row * DM))[lane + 64 * j] = w; }
        ss = wave_sum(ss);
        if (lane == 0) rinv[row] = 1.0f / sqrtf(ss * (1.0f / DM) + RMS_EPS);
    }
}

struct PrepArgs {
    const bf16* rw; const float* mu; const float* w0; const float* w2; const float* a0; const float* a2; const float* g2; const float* k_k; const float* k_a;
    const float* v0; const float* v1; const float* v2; float* vfirst; float* SR; float* SW; float* SK; float* SV; float* SA; float* SB; float* G; int layer;
};
__device__ __forceinline__ float rwshift(const bf16* rw, const float* mu, int t, int col) {
    const float p = bf2f(rw[(size_t)t * RWP + col]); const float pp = t > 0 ? bf2f(rw[(size_t)(t - 1) * RWP + col]) : 0.f;
    return p + mu[col] * (pp - p);
}
constexpr int PT = 8, PREP_LDS = PT * (64 + 64 + 160 + 32 + 1024) * 4;
__device__ __forceinline__ void ph_prep(LAS unsigned char* lds, const PrepArgs& A, int blk, int nblk) {
    const int tid_ = opq_tid(), half = tid_ >> 8, tid = tid_ & 255, c4 = 4 * tid;
    LAS float* lat_w = (LAS float*)(lds + half * PREP_LDS);
    LAS float* lat_a = lat_w + PT * 64;
    LAS float* lat_g = lat_a + PT * 64;
    LAS float* vlat = lat_g + PT * 160;
    LAS float* vr_s = vlat + PT * 32;
    for (int g0 = blk * 2; g0 < T_ / PT; g0 += nblk * 2) {
        const int t0 = (g0 + half) * PT;
        for (int idx = tid; idx < PT * 288; idx += 256) {
            const int tok = idx / 288, j = idx % 288; const float s = rwshift(A.rw, A.mu, t0 + tok, 3072 + j);
            if (j < 64) lat_w[tok * 64 + j] = tanhf(s); else if (j < 128) lat_a[tok * 64 + j - 64] = s; else lat_g[tok * 160 + j - 128] = sigmoidf_(s);
        }
        for (int tok = 0; tok < PT; ++tok)
#pragma unroll
            for (int e = 0; e < 4; ++e) vr_s[tok * 1024 + c4 + e] = rwshift(A.rw, A.mu, t0 + tok, 2048 + c4 + e);
        __syncthreads();
        if (A.layer > 0) {
            const int o = tid & 31, tg = tid >> 5; float a0 = 0.f;
#pragma unroll 4
            for (int c = 0; c < 1024; ++c) a0 += vr_s[tg * 1024 + c] * A.v1[c * 32 + o];
            vlat[tg * 32 + o] = a0;
        }
        __syncthreads();
        f32x4 acc[PT], ar[PT];
#pragma unroll
        for (int tok = 0; tok < PT; ++tok) acc[tok] = (f32x4){0.f, 0.f, 0.f, 0.f};
#pragma unroll 2
        for (int i = 0; i < 64; ++i) { const f32x4 w = *(const f32x4*)(A.w2 + (size_t)i * 1024 + c4);
#pragma unroll
            for (int tok = 0; tok < PT; ++tok) acc[tok] += w * lat_w[tok * 64 + i]; }
        { const f32x4 w0 = *(const f32x4*)(A.w0 + c4);
#pragma unroll
          for (int tok = 0; tok < PT; ++tok) { f32x4 o;
#pragma unroll
            for (int e = 0; e < 4; ++e) { const float z = -(w0[e] + acc[tok][e]); const float sp = fmaxf(z, 0.f) + log1pf(__expf(-fabsf(z))); const float wl = -sp - 0.5f; o[e] = __expf(-__expf(wl)); }
            *(f32x4*)(A.SW + (size_t)(t0 + tok) * 1024 + c4) = o; } }
#pragma unroll
        for (int tok = 0; tok < PT; ++tok) acc[tok] = (f32x4){0.f, 0.f, 0.f, 0.f};
#pragma unroll 2
        for (int i = 0; i < 64; ++i) { const f32x4 w = *(const f32x4*)(A.a2 + (size_t)i * 1024 + c4);
#pragma unroll
            for (int tok = 0; tok < PT; ++tok) acc[tok] += w * lat_a[tok * 64 + i]; }
        { const f32x4 a0 = *(const f32x4*)(A.a0 + c4);
#pragma unroll
          for (int tok = 0; tok < PT; ++tok)
#pragma unroll
            for (int e = 0; e < 4; ++e) ar[tok][e] = sigmoidf_(a0[e] + acc[tok][e]); }
        { const f32x4 kkw = *(const f32x4*)(A.k_k + c4), kaw = *(const f32x4*)(A.k_a + c4);
#pragma unroll
          for (int tok = 0; tok < PT; ++tok) { f32x4 kr, kkv; float ss = 0.f;
#pragma unroll
            for (int e = 0; e < 4; ++e) { kr[e] = rwshift(A.rw, A.mu, t0 + tok, 1024 + c4 + e); kkv[e] = kr[e] * kkw[e]; ss += kkv[e] * kkv[e]; }
            ss += __shfl_xor(ss, 1); ss += __shfl_xor(ss, 2); ss += __shfl_xor(ss, 4); ss += __shfl_xor(ss, 8);
            const float inv = 1.0f / fmaxf(sqrtf(ss), 1e-12f); f32x4 oa, ob, ok;
#pragma unroll
            for (int e = 0; e < 4; ++e) { const float kk = kkv[e] * inv; oa[e] = -kk; ob[e] = kk * ar[tok][e]; ok[e] = kr[e] * (1.0f + (ar[tok][e] - 1.0f) * kaw[e]); }
            const size_t off = (size_t)(t0 + tok) * 1024 + c4;
            *(f32x4*)(A.SA + off) = oa; *(f32x4*)(A.SB + off) = ob; *(f32x4*)(A.SK + off) = ok; } }
#pragma unroll
        for (int tok = 0; tok < PT; ++tok) acc[tok] = (f32x4){0.f, 0.f, 0.f, 0.f};
#pragma unroll 2
        for (int i = 0; i < 160; ++i) { const f32x4 w = *(const f32x4*)(A.g2 + (size_t)i * 1024 + c4);
#pragma unroll
            for (int tok = 0; tok < PT; ++tok) acc[tok] += w * lat_g[tok * 160 + i]; }
#pragma unroll
        for (int tok = 0; tok < PT; ++tok) *(f32x4*)(A.G + (size_t)(t0 + tok) * 1024 + c4) = acc[tok];
        if (A.layer == 0) {
            for (int tok = 0; tok < PT; ++tok) { const f32x4 vr = *(const LAS f32x4*)(vr_s + tok * 1024 + c4); const size_t off = (size_t)(t0 + tok) * 1024 + c4;
                *(f32x4*)(A.vfirst + off) = vr; *(f32x4*)(A.SV + off) = vr; }
        } else {
#pragma unroll
            for (int tok = 0; tok < PT; ++tok) acc[tok] = (f32x4){0.f, 0.f, 0.f, 0.f};
    #pragma unroll 2
        for (int i = 0; i < 32; ++i) { const f32x4 w = *(const f32x4*)(A.v2 + (size_t)i * 1024 + c4);
#pragma unroll
                for (int tok = 0; tok < PT; ++tok) acc[tok] += w * vlat[tok * 32 + i]; }
            const f32x4 v0 = *(const f32x4*)(A.v0 + c4);
#pragma unroll
            for (int tok = 0; tok < PT; ++tok) { const f32x4 vr = *(const LAS f32x4*)(vr_s + tok * 1024 + c4); const size_t off = (size_t)(t0 + tok) * 1024 + c4; const f32x4 vf = *(const f32x4*)(A.vfirst + off); f32x4 o;
#pragma unroll
                for (int e = 0; e < 4; ++e) { const float gt = sigmoidf_(v0[e] + acc[tok][e]); o[e] = vr[e] + (vf[e] - vr[e]) * gt; }
                *(f32x4*)(A.SV + off) = o; }
        }
        for (int tok = 0; tok < PT; ++tok) { f32x4 o;
#pragma unroll
            for (int e = 0; e < 4; ++e) o[e] = rwshift(A.rw, A.mu, t0 + tok, c4 + e);
            *(f32x4*)(A.SR + (size_t)(t0 + tok) * 1024 + c4) = o; }
        __syncthreads();
    }
}
constexpr int NPH = 11;
typedef const __attribute__((address_space(4))) Args* CArgs;
__device__ __forceinline__ CArgs kargs() { CArgs p = (CArgs)__builtin_amdgcn_kernarg_segment_ptr(); asm volatile("" : "+s"(p)); return p; }
__global__ void __launch_bounds__(512, 2) fwd(Args args_unused) {
    extern __shared__ __attribute__((aligned(16))) unsigned char lds_raw[];
    LAS unsigned char* lds = (LAS unsigned char*)lds_raw;
    volatile LAS unsigned* MISC = (volatile LAS unsigned*)(lds + MISC_OFF);
    const int blk = (int)blockIdx.x, nblk = (int)gridDim.x;
    if (threadIdx.x < 32) MISC[threadIdx.x] = 0u;
    __syncthreads();
    int lo, hi; XcdBarrier bar;
    { CArgs ap = kargs(); lo = ap->ph_lo; hi = ap->ph_hi; unsigned* bw = (unsigned*)(ap->ws + WS_CTL) + CW_BAR; bar.bar = bw; bar.x = 0; bar.st = nullptr;
      if (hi - lo > 1) bar = xcd_barrier_post(bw, MISC + 8); }
#define IN(k) (lo <= (k) && (k) < hi)
#define SEAM(k) do { if (IN(k) && IN((k) + 1)) xcd_barrier(bar); } while (0)
#define WSP(T, off) ((T*)(ws + (off)))
#pragma unroll 1
    for (int l = 0; l < NL; ++l) {
        const int pb = l * NPH;
        if (IN(pb + 0)) {
            CArgs ap = kargs(); unsigned char* ws = ap->ws;
            ph_convw(lds, ap, l, blk, nblk);
            ph_rownorm(l == 0 ? ap->in[0] : ap->out, l == 0 ? ap->out : nullptr, WSP(bf16, WS_XB), WSP(float, WS_RINV), blk, nblk);
        }
        SEAM(pb + 0);
        if (IN(pb + 1)) {
            CArgs ap = kargs(); unsigned char* ws = ap->ws;
            pg8::Gemm g{WSP(bf16, WS_XB), WSP(bf16, WS_WIN), T_, NIN, DM, 0}; pg8::StaticOrder S; S.init(T_, NIN, nblk, blk);
            pg8::EpiIn E{WSP(float, WS_RINV), WSP(bf16, WS_Q), WSP(bf16, WS_K), WSP(bf16, WS_V), WSP(bf16, WS_RW), ap->in[5] + l * 128, ap->in[6] + l * 128};
            pg8::gemm_phase<pg8::EpiIn, pg8::StaticOrder, true, true>(lds, g, S, E);
        }
        SEAM(pb + 1);
        if (IN(pb + 2)) {
            CArgs ap = kargs(); unsigned char* ws = ap->ws;
            att::Args A; A.Q = WSP(bf16, WS_Q); A.K = WSP(bf16, WS_K); A.V = WSP(bf16, WS_V); A.mixed = WSP(bf16, WS_MIXED); A.stash = WSP(float, WS_XB); A.lq = ap->in[7] + l * 128; A.lk = ap->in[8] + l * 128; A.subln = ap->in[9] + l * 128;
            A.lam_init = ap->lam_init[l]; A.pad_ = 0;
            att::attn_phase(lds, A, blk, nblk);
        }
        SEAM(pb + 2);
        if (IN(pb + 3)) {
            CArgs ap = kargs(); unsigned char* ws = ap->ws;
            PrepArgs A; A.rw = WSP(bf16, WS_RW); A.mu = ap->in[10] + (size_t)l * 3360; A.w0 = ap->in[11] + l * 1024; A.w2 = ap->in[12] + (size_t)l * 64 * 1024; A.a0 = ap->in[13] + l * 1024; A.a2 = ap->in[14] + (size_t)l * 64 * 1024;
            A.g2 = ap->in[15] + (size_t)l * 160 * 1024; A.k_k = ap->in[16] + l * 1024; A.k_a = ap->in[17] + l * 1024;
            const int lm = l > 0 ? l - 1 : 0;
            A.v0 = ap->in[21] + lm * 1024; A.v1 = ap->in[22] + (size_t)lm * 1024 * 32; A.v2 = ap->in[23] + (size_t)lm * 32 * 1024;
            A.vfirst = WSP(float, WS_VFIRST); A.SR = WSP(float, WS_SR); A.SW = WSP(float, WS_SW); A.SK = WSP(float, WS_SK); A.SV = WSP(float, WS_SV); A.SA = WSP(float, WS_SA); A.SB = WSP(float, WS_SB); A.G = WSP(float, WS_G); A.layer = l;
            ph_prep(lds, A, blk, nblk);
        }
        SEAM(pb + 3);
        if (IN(pb + 4)) {
            CArgs ap = kargs(); unsigned char* ws = ap->ws;
            rk::S1Args A{WSP(float, WS_SR), WSP(float, WS_SW), WSP(float, WS_SK), WSP(float, WS_SV), WSP(float, WS_SA), WSP(float, WS_SB), WSP(bf16, WS_Q), WSP(float, WS_XB), WSP(bf16, WS_K), WSP(float, WS_Y)};
            rk::ph_stage1(lds, A, blk, nblk);
        }
        SEAM(pb + 4);
        if (IN(pb + 5)) { CArgs ap = kargs(); unsigned char* ws = ap->ws; rk::ph_chain(WSP(bf16, WS_Q), WSP(float, WS_XB), WSP(bf16, WS_V), blk, nblk); }
        SEAM(pb + 5);
        if (IN(pb + 6)) {
            CArgs ap = kargs(); unsigned char* ws = ap->ws;
            rk::S3Args A{WSP(bf16, WS_V), WSP(bf16, WS_K), WSP(float, WS_Y), WSP(float, WS_SR), WSP(float, WS_SK), WSP(float, WS_SV), WSP(float, WS_G), ap->in[19] + l * 1024, ap->in[20] + l * 1024, ap->in[18] + l * 1024, WSP(bf16, WS_MIXED)};
            rk::ph_stage3(A, blk, nblk);
        }
        SEAM(pb + 6);
        if (IN(pb + 7)) {
            CArgs ap = kargs(); unsigned char* ws = ap->ws;
            pg8::Gemm g{WSP(bf16, WS_MIXED), WSP(bf16, WS_WOUT), T_, DM, DM, 0}; pg8::StaticOrder S; S.init(T_, DM, nblk, blk);
            pg8::EpiRes E{ap->out, DM, 0};
            pg8::gemm_phase<pg8::EpiRes, pg8::StaticOrder, true, true>(lds, g, S, E);
        }
        SEAM(pb + 7);
        if (IN(pb + 8)) { CArgs ap = kargs(); unsigned char* ws = ap->ws; ph_rownorm(ap->out, nullptr, WSP(bf16, WS_XB), WSP(float, WS_RINV), blk, nblk); }
        SEAM(pb + 8);
        if (IN(pb + 9)) {
            CArgs ap = kargs(); unsigned char* ws = ap->ws;
            pg8::Gemm g{WSP(bf16, WS_XB), WSP(bf16, WS_WUP), T_, DFF, DM, 0}; pg8::StaticOrder S; S.init(T_, DFF, nblk, blk);
            pg8::EpiUp E{WSP(float, WS_RINV), WSP(bf16, WS_U), DFF, 0};
            pg8::gemm_phase<pg8::EpiUp, pg8::StaticOrder, true, true>(lds, g, S, E);
        }
        SEAM(pb + 9);
        if (IN(pb + 10)) {
            CArgs ap = kargs(); unsigned char* ws = ap->ws;
            pg8::Gemm g{WSP(bf16, WS_U), WSP(bf16, WS_WDOWN), T_, DM, DFF, 0}; pg8::StaticOrder S; S.init(T_, DM, nblk, blk);
            pg8::EpiRes E{ap->out, DM, 0};
            pg8::gemm_phase<pg8::EpiRes, pg8::StaticOrder, true, true>(lds, g, S, E);
        }
        SEAM(pb + 10);
    }
#undef IN
#undef SEAM
#undef WSP
}

#ifndef MK_PER_PHASE
#define MK_PER_PHASE 0
#endif
extern "C" void kernel_launch(void* const* d_in, const int* in_sizes, int n_in, void* d_out, int out_size, void* d_ws, size_t ws_size, hipStream_t stream) {
    static int grid = 0;
    if (grid == 0) {
        grid = -1;
        if (n_in != 26 || ws_size < WS_END || out_size != T_ * DM) { fprintf(stderr, "kernel_launch: unexpected shapes (n_in %d ws %zu out %d)\n", n_in, ws_size, out_size); return; }
        int dev = 0, cus = 0, per_cu = 0;
        if (hipGetDevice(&dev) != hipSuccess || hipDeviceGetAttribute(&cus, hipDeviceAttributeMultiprocessorCount, dev) != hipSuccess) return;
        if (hipFuncSetAttribute((const void*)fwd, hipFuncAttributeMaxDynamicSharedMemorySize, LDS_BYTES) != hipSuccess) return;
        if (hipOccupancyMaxActiveBlocksPerMultiprocessor(&per_cu, (const void*)fwd, 512, LDS_BYTES) != hipSuccess || per_cu < 1) { fprintf(stderr, "kernel_launch: occupancy query says %d\n", per_cu); (void)hipGetLastError(); return; }
        grid = cus;
    }
    if (grid < 0) return;
    if (hipMemsetAsync((char*)d_ws + WS_CTL, 0, CTL_ZERO_BYTES, stream) != hipSuccess) return;
    Args a;
    memset(&a, 0, sizeof(a));
    for (int i = 0; i < 26; ++i) a.in[i] = (const float*)d_in[i];
    a.out = (float*)d_out; a.ws = (unsigned char*)d_ws;
    for (int l = 0; l < NL; ++l) a.lam_init[l] = (float)(0.8 - 0.6 * exp(-0.3 * (double)l));
    const int nph = NL * NPH;
#if MK_PER_PHASE
    for (int p = 0; p < nph; ++p) { a.ph_lo = p; a.ph_hi = p + 1; hipLaunchKernelGGL(fwd, dim3(grid), dim3(512), LDS_BYTES, stream, a); }
#else
    a.ph_lo = 0; a.ph_hi = nph; hipLaunchKernelGGL(fwd, dim3(grid), dim3(512), LDS_BYTES, stream, a);
#endif
}
```

```cpp
#include <hip/hip_runtime.h>
#include <cstdio>
#include <cstdint>
#include <cstring>
#include <cmath>

constexpr int T_ = 16384, DM = 2048, NL = 4, PW = 6432, NIN = 6656, RWP = 3584, DFF = 8192, RW_ = 1024;
constexpr float RMS_EPS = 1e-6f, GN_EPS = 64e-5f;
typedef unsigned short bf16;
typedef float f32x4 __attribute__((ext_vector_type(4)));
typedef unsigned u32x4 __attribute__((ext_vector_type(4)));
typedef unsigned u32x2 __attribute__((ext_vector_type(2)));
#define LAS __attribute__((address_space(3)))

__device__ __forceinline__ unsigned f2bf(float f) { unsigned u = __builtin_bit_cast(unsigned, f); return (u + 0x7fffu + ((u >> 16) & 1u)) >> 16; }
__device__ __forceinline__ float bf2f(unsigned short b) { return __builtin_bit_cast(float, (unsigned)b << 16); }
__device__ __forceinline__ float bflo(unsigned w) { return __builtin_bit_cast(float, w << 16); }
__device__ __forceinline__ float bfhi(unsigned w) { return __builtin_bit_cast(float, w & 0xffff0000u); }
__device__ __forceinline__ float sigmoidf_(float x) { return 1.0f / (1.0f + __expf(-x)); }

template <int CTRL, int ROWMASK> __device__ __forceinline__ float dppf(float v) {
    return __builtin_bit_cast(float, __builtin_amdgcn_update_dpp(0, __builtin_bit_cast(int, v), CTRL, ROWMASK, 0xF, false));
}
__device__ __forceinline__ float wave_sum(float v) {
    v += dppf<0xB1, 0xF>(v); v += dppf<0x4E, 0xF>(v); v += dppf<0x141, 0xF>(v); v += dppf<0x140, 0xF>(v);
    v += dppf<0x142, 0xA>(v); v += dppf<0x143, 0xC>(v);
    return __builtin_bit_cast(float, __builtin_amdgcn_readlane(__builtin_bit_cast(int, v), 63));
}
__device__ __forceinline__ int opq_tid() { int t = (int)threadIdx.x; asm volatile("" : "+v"(t)); return t; }
namespace pg8 {
#define PG8_LAS __attribute__((address_space(3)))
typedef unsigned short bf16_t;
typedef short bf16x8 __attribute__((ext_vector_type(8)));
typedef float f32x4 __attribute__((ext_vector_type(4)));
typedef unsigned u32x4 __attribute__((ext_vector_type(4)));
constexpr int BM = 256, BK = 64, HALF = 128, HTB = HALF * BK * 2  , STAGE_BYTES = 8 * HTB, NXCD = 8, WGM = 8;

__host__ __device__ __forceinline__ int lds_byte(int r, int c) { const int st = (r >> 4) * 2 + (c >> 5), rr = r & 15, cc = c & 31, ob = rr * 64 + cc * 2; return st * 1024 + (ob ^ (((ob >> 9) & 1) << 5)); }
__host__ __device__ __forceinline__ void stage_rc(int b, int& R, int& C) { const int st = b / 1024, sb = b % 1024, swz = sb ^ (((sb >> 9) & 1) << 5); R = (st >> 1) * 16 + swz / 64; C = (st & 1) * 32 + (swz % 64) / 2; }
__host__ __device__ __forceinline__ int perm32(int rho) { const int n = rho >> 4, i = rho & 15; return 8 * (i >> 2) + 4 * n + (i & 3); }

struct Unit { int pm, pn; };
struct Gemm { const bf16_t* A; const bf16_t* Bt; int M, N, K, pad_; };

struct StaticOrder {
    int nM, nN, nwg, G, c;
    __host__ __device__ void init(int M, int N, int G_, int c_) { nM = M / BM; nN = N / BM; nwg = nM * nN; G = G_; c = c_; }
    __host__ __device__ bool next(int i, Unit& u) const {
        const long L = (long)i * G + c; if (L >= nwg) return false;
        int wgid = (int)L; { const int q = nwg / NXCD, r = nwg % NXCD, xcd = wgid % NXCD, off = wgid / NXCD; wgid = (xcd < r ? xcd * (q + 1) : r * (q + 1) + (xcd - r) * q) + off; }
        const int nig = WGM * nN, gid = wgid / nig, fm = gid * WGM, gsz = (nM - fm) < WGM ? (nM - fm) : WGM;
        u.pm = fm + ((wgid % nig) % gsz); u.pn = (wgid % nig) / gsz; return true;
    }
    __device__ __forceinline__ void a_ready(const Unit&) const {}
    __device__ __forceinline__ void done(const Unit&) const {}
};

__device__ __forceinline__ unsigned cvt_pk_bf16(float lo, float hi) { unsigned r; asm volatile("v_cvt_pk_bf16_f32 %0, %1, %2" : "=v"(r) : "v"(lo), "v"(hi)); return r; }
typedef float f32x2 __attribute__((ext_vector_type(2)));
struct EpiIn {
    static constexpr bool PERM = true, AFTER_DRAIN = false;
    const float* rinv; bf16_t* q; bf16_t* k; bf16_t* v; bf16_t* rw; const float* gq; const float* gk;
    __device__ __forceinline__ void operator()(const f32x4 (&acc)[2][2][4][2], const Unit& u, int wr, int wc, int fr, int fq) const {
        const int pn = u.pn;
        const int row0 = u.pm * BM + wr * 64 + fr;
        if (pn < 8) {
            const float* g = (pn < 4 ? gq : gk) + (wc & 1) * 64 + 8 * fq;
            f32x4 gv[2][2];
#pragma unroll
            for (int bj = 0; bj < 2; ++bj)
#pragma unroll
                for (int n = 0; n < 2; ++n) gv[bj][n] = *(const f32x4*)(g + 32 * bj + 4 * n);
            bf16_t* base = (pn < 4 ? q : k) + (pn & 3) * 256 + 64 * wc + 8 * fq;
#pragma unroll
            for (int ai = 0; ai < 2; ++ai)
#pragma unroll
                for (int m = 0; m < 4; ++m) {
                    const int row = row0 + ai * HALF + m * 16; const float ri = rinv[row];
                    f32x4 vv[2][2]; float ss = 0.f;
#pragma unroll
                    for (int bj = 0; bj < 2; ++bj)
#pragma unroll
                        for (int n = 0; n < 2; ++n) { vv[bj][n] = acc[ai][bj][m][n] * ri; const f32x4 t = vv[bj][n]; ss += (t[0] * t[0] + t[1] * t[1]) + (t[2] * t[2] + t[3] * t[3]); }
                    ss += __shfl_xor(ss, 16); ss += __shfl_xor(ss, 32);
                    const float rq = 1.0f / sqrtf(ss * (1.0f / 64.0f) + 1e-6f);
#pragma unroll
                    for (int bj = 0; bj < 2; ++bj) { const f32x4 a = vv[bj][0] * rq * gv[bj][0], b = vv[bj][1] * rq * gv[bj][1];
                        u32x4 w; w.x = cvt_pk_bf16(a[0], a[1]); w.y = cvt_pk_bf16(a[2], a[3]); w.z = cvt_pk_bf16(b[0], b[1]); w.w = cvt_pk_bf16(b[2], b[3]);
                        *(u32x4*)(base + (size_t)row * 1024 + 32 * bj) = w; }
                }
        } else {
            bf16_t* base; int ld;
            if (pn < 12) { base = v + (pn - 8) * 256 + 64 * wc + 8 * fq; ld = 1024; } else { base = rw + (pn - 12) * 256 + 64 * wc + 8 * fq; ld = 3584; }
#pragma unroll
            for (int ai = 0; ai < 2; ++ai)
#pragma unroll
                for (int m = 0; m < 4; ++m) {
                    const int row = row0 + ai * HALF + m * 16; const float ri = rinv[row];
#pragma unroll
                    for (int bj = 0; bj < 2; ++bj) { const f32x4 a = acc[ai][bj][m][0] * ri, b = acc[ai][bj][m][1] * ri;
                        u32x4 w; w.x = cvt_pk_bf16(a[0], a[1]); w.y = cvt_pk_bf16(a[2], a[3]); w.z = cvt_pk_bf16(b[0], b[1]); w.w = cvt_pk_bf16(b[2], b[3]);
                        *(u32x4*)(base + (size_t)row * ld + 32 * bj) = w; }
                }
        }
    }
};
struct EpiRes {
    static constexpr bool PERM = true, AFTER_DRAIN = false;
    float* x; int ldc; int pad_;
    __device__ __forceinline__ void operator()(const f32x4 (&acc)[2][2][4][2], const Unit& u, int wr, int wc, int fr, int fq) const {
        const int row0 = u.pm * BM + wr * 64 + fr, col0 = u.pn * BM + wc * 32 + 8 * fq;
#pragma unroll
        for (int ai = 0; ai < 2; ++ai)
#pragma unroll
            for (int m = 0; m < 4; ++m) { float* rowp = x + (size_t)(row0 + ai * HALF + m * 16) * ldc + col0;
#pragma unroll
                for (int bj = 0; bj < 2; ++bj) { f32x4* p = (f32x4*)(rowp + bj * HALF); const f32x4 o0 = p[0], o1 = p[1]; p[0] = o0 + acc[ai][bj][m][0]; p[1] = o1 + acc[ai][bj][m][1]; } }
    }
};
struct EpiUp {
    static constexpr bool PERM = true, AFTER_DRAIN = false;
    const float* rinv; bf16_t* o; int ldc; int pad_;
    __device__ __forceinline__ void operator()(const f32x4 (&acc)[2][2][4][2], const Unit& u, int wr, int wc, int fr, int fq) const {
        const int row0 = u.pm * BM + wr * 64 + fr, col0 = u.pn * BM + wc * 32 + 8 * fq;
#pragma unroll
        for (int ai = 0; ai < 2; ++ai)
#pragma unroll
            for (int m = 0; m < 4; ++m) { const int row = row0 + ai * HALF + m * 16; const float ri = rinv[row]; bf16_t* rowp = o + (size_t)row * ldc + col0;
#pragma unroll
                for (int bj = 0; bj < 2; ++bj) { f32x4 a = acc[ai][bj][m][0] * ri, b = acc[ai][bj][m][1] * ri;
#pragma unroll
                    for (int e = 0; e < 4; ++e) { a[e] = a[e] > 0.f ? a[e] * a[e] : 0.f; b[e] = b[e] > 0.f ? b[e] * b[e] : 0.f; }
                    u32x4 w; w.x = cvt_pk_bf16(a[0], a[1]); w.y = cvt_pk_bf16(a[2], a[3]); w.z = cvt_pk_bf16(b[0], b[1]); w.w = cvt_pk_bf16(b[2], b[3]);
                    *(u32x4*)(rowp + bj * HALF) = w; } }
    }
};
template <class Epi, class Sched, bool ALIGN_EPI = false, bool SP2 = false>
__device__ __forceinline__ void gemm_phase(PG8_LAS unsigned char* lds, const Gemm g, const Sched& S, const Epi& E) {
    const int tid = opq_tid(), wid = __builtin_amdgcn_readfirstlane(tid >> 6), lane = tid & 63, wr = wid >> 2, wc = wid & 3, fr = lane & 15, fq = lane >> 4;
    const int K = g.K, nt = K / BK;
    unsigned voffA[2], voffB[2];
#pragma unroll
    for (int i = 0; i < 2; ++i) { int R, C; stage_rc(tid * 16 + i * 8192, R, C); const int Rb = Epi::PERM ? ((R & ~31) + perm32(R & 31)) : R;
        voffA[i] = (unsigned)(R * K + C) * 2u; voffB[i] = (unsigned)(Rb * K + C) * 2u; }
    const size_t kstep = (size_t)(BK * 2);
    const size_t hstep = (size_t)HALF * K * 2;
    const size_t tstep = 2 * hstep;
    const unsigned ldsw = (unsigned)wid * 1024u;
    const int aoff = lds_byte(wr * 64 + fr, fq * 8), boff = lds_byte(wc * 32 + fr, fq * 8);
#define PG8_SA(b, h) (((b) * 2 + (h)) * HTB)
#define PG8_SB(b, h) ((4 + (b) * 2 + (h)) * HTB)
#define PG8_STAGE(bufoff, gbase, voff) do { _Pragma("unroll") for (int _i = 0; _i < 2; ++_i) \
        __builtin_amdgcn_global_load_lds((const unsigned*)((const char*)(gbase) + (voff)[_i]), (PG8_LAS unsigned*)(lds + (bufoff) + ldsw + _i * 8192), 16, 0, 0); } while (0)
#define PG8_LDA(dst, b, h) do { _Pragma("unroll") for (int m = 0; m < 4; ++m) _Pragma("unroll") for (int k = 0; k < 2; ++k) dst[m][k] = *(const PG8_LAS bf16x8*)(lds + PG8_SA(b, h) + aoff + m * 2048 + k * 1024); } while (0)
#define PG8_LDB(dst, b, h) do { _Pragma("unroll") for (int n = 0; n < 2; ++n) _Pragma("unroll") for (int k = 0; k < 2; ++k) dst[n][k] = *(const PG8_LAS bf16x8*)(lds + PG8_SB(b, h) + boff + n * 2048 + k * 1024); } while (0)
#define PG8_MMA(ai, bj, At, Bt) do { __builtin_amdgcn_s_setprio(1); _Pragma("unroll") for (int m = 0; m < 4; ++m) _Pragma("unroll") for (int n = 0; n < 2; ++n) _Pragma("unroll") for (int k = 0; k < 2; ++k) \
        acc[ai][bj][m][n] = __builtin_amdgcn_mfma_f32_16x16x32_bf16(Bt[n][k], At[m][k], acc[ai][bj][m][n], 0, 0, 0); __builtin_amdgcn_s_setprio(0); } while (0)
#define PG8_WAIT_V(n) asm volatile("s_waitcnt vmcnt(" #n ")" ::: "memory")
#define PG8_WAIT_L(n) asm volatile("s_waitcnt lgkmcnt(" #n ")" ::: "memory")
#define PG8_BAR __builtin_amdgcn_s_barrier()
#define PG8_SCHED __builtin_amdgcn_sched_barrier(0)
    Unit cur, nxt; int ui = 0;
    if (!S.next(0, cur)) return;
    f32x4 acc[2][2][4][2];
#pragma unroll
    for (int a = 0; a < 2; ++a)
#pragma unroll
        for (int b = 0; b < 2; ++b)
#pragma unroll
            for (int m = 0; m < 4; ++m)
#pragma unroll
                for (int n = 0; n < 2; ++n) acc[a][b][m][n] = (f32x4){0.f, 0.f, 0.f, 0.f};
    bf16x8 At[4][2], B0[2][2], B1[2][2];
    const char* cA = (const char*)g.A + (size_t)cur.pm * tstep; const char* cB = (const char*)g.Bt + (size_t)cur.pn * tstep;
    S.a_ready(cur);
    if constexpr (SP2) {
        PG8_STAGE(PG8_SB(0, 0), cB, voffB); PG8_STAGE(PG8_SB(0, 1), cB + hstep, voffB); PG8_STAGE(PG8_SA(0, 0), cA, voffA); PG8_STAGE(PG8_SA(0, 1), cA + hstep, voffA);
        if (wr == 1) PG8_BAR;
        PG8_WAIT_V(2); PG8_BAR;
        PG8_STAGE(PG8_SB(1, 0), cB + kstep, voffB); PG8_STAGE(PG8_SA(1, 0), cA + kstep, voffA); PG8_STAGE(PG8_SB(1, 1), cB + hstep + kstep, voffB);
        PG8_WAIT_V(6); PG8_BAR;
    } else {
        PG8_STAGE(PG8_SB(0, 0), cB, voffB); PG8_STAGE(PG8_SA(0, 0), cA, voffA); PG8_STAGE(PG8_SB(0, 1), cB + hstep, voffB); PG8_STAGE(PG8_SA(0, 1), cA + hstep, voffA);
        if (wr == 1) PG8_BAR;
        PG8_WAIT_V(4); PG8_BAR;
        PG8_STAGE(PG8_SB(1, 0), cB + kstep, voffB); PG8_STAGE(PG8_SA(1, 0), cA + kstep, voffA); PG8_STAGE(PG8_SB(1, 1), cB + hstep + kstep, voffB);
        PG8_WAIT_V(6); PG8_BAR;
    }
    for (;;) {
        const bool has_next = S.next(ui + 1, nxt);
        const char* nA = has_next ? (const char*)g.A + (size_t)nxt.pm * tstep : cA; const char* nB = has_next ? (const char*)g.Bt + (size_t)nxt.pn * tstep : cB;
        for (int t = 0; t < nt; t += 2) {
            const bool last = (t == nt - 2);
            const char* a1 = cA + (size_t)(t + 1) * kstep;
            const char* a2 = last ? nA : cA + (size_t)(t + 2) * kstep; const char* b2 = last ? nB : cB + (size_t)(t + 2) * kstep;
            const char* a3 = a2 + kstep; const char* b3 = b2 + kstep;
            if (last && has_next) S.a_ready(nxt);
            if constexpr (SP2) {
            PG8_LDB(B0, 0, 0); PG8_LDB(B1, 0, 1); PG8_SCHED; PG8_LDA(At, 0, 0); PG8_STAGE(PG8_SA(1, 1), a1 + hstep, voffA);
            PG8_WAIT_V(8); PG8_WAIT_L(0); PG8_BAR; PG8_MMA(0, 0, At, B0); PG8_MMA(0, 1, At, B1); PG8_BAR; PG8_SCHED;
            PG8_LDA(At, 0, 1); PG8_STAGE(PG8_SB(0, 0), b2, voffB); PG8_STAGE(PG8_SB(0, 1), b2 + hstep, voffB); PG8_STAGE(PG8_SA(0, 0), a2, voffA);
            PG8_WAIT_V(8); PG8_WAIT_L(0); PG8_BAR; PG8_MMA(1, 0, At, B0); PG8_MMA(1, 1, At, B1); PG8_BAR; PG8_SCHED;
            PG8_LDB(B0, 1, 0); PG8_LDB(B1, 1, 1); PG8_SCHED; PG8_LDA(At, 1, 0); PG8_STAGE(PG8_SA(0, 1), a2 + hstep, voffA);
            PG8_WAIT_V(8); PG8_WAIT_L(0); PG8_BAR; PG8_MMA(0, 0, At, B0); PG8_MMA(0, 1, At, B1); PG8_BAR; PG8_SCHED;
            PG8_LDA(At, 1, 1); PG8_STAGE(PG8_SB(1, 0), b3, voffB); PG8_STAGE(PG8_SB(1, 1), b3 + hstep, voffB); PG8_STAGE(PG8_SA(1, 0), a3, voffA);
            PG8_WAIT_V(8); PG8_WAIT_L(0); PG8_BAR; PG8_MMA(1, 0, At, B0); PG8_MMA(1, 1, At, B1); PG8_BAR; PG8_SCHED;
            } else {
            PG8_LDB(B0, 0, 0); PG8_SCHED; PG8_LDA(At, 0, 0); PG8_STAGE(PG8_SA(1, 1), a1 + hstep, voffA);
            PG8_WAIT_L(8); PG8_BAR; PG8_WAIT_L(0); PG8_MMA(0, 0, At, B0); PG8_BAR; PG8_SCHED;
            PG8_LDB(B1, 0, 1); PG8_STAGE(PG8_SB(0, 0), b2, voffB);
            PG8_BAR; PG8_WAIT_L(0); PG8_MMA(0, 1, At, B1); PG8_BAR;
            PG8_LDA(At, 0, 1); PG8_STAGE(PG8_SA(0, 0), a2, voffA);
            PG8_BAR; PG8_WAIT_L(0); PG8_MMA(1, 0, At, B0); PG8_BAR; PG8_SCHED;
            PG8_STAGE(PG8_SB(0, 1), b2 + hstep, voffB);
            PG8_WAIT_V(6); PG8_BAR; PG8_MMA(1, 1, At, B1); PG8_BAR;
            PG8_LDB(B0, 1, 0); PG8_SCHED; PG8_LDA(At, 1, 0); PG8_STAGE(PG8_SA(0, 1), a2 + hstep, voffA);
            PG8_WAIT_L(8); PG8_BAR; PG8_WAIT_L(0); PG8_MMA(0, 0, At, B0); PG8_BAR; PG8_SCHED;
            PG8_LDB(B1, 1, 1); PG8_STAGE(PG8_SB(1, 0), b3, voffB);
            PG8_BAR; PG8_WAIT_L(0); PG8_MMA(0, 1, At, B1); PG8_BAR;
            PG8_LDA(At, 1, 1); PG8_STAGE(PG8_SA(1, 0), a3, voffA);
            PG8_BAR; PG8_WAIT_L(0); PG8_MMA(1, 0, At, B0); PG8_BAR; PG8_SCHED;
            PG8_STAGE(PG8_SB(1, 1), b3 + hstep, voffB);
            PG8_WAIT_V(6); PG8_BAR; PG8_MMA(1, 1, At, B1); PG8_BAR;
            }
        }
        if constexpr (ALIGN_EPI) { if (wr == 0) PG8_BAR; }
        if constexpr (!Epi::AFTER_DRAIN) { E(acc, cur, wr, wc, fr, fq); S.done(cur); }
        if (!has_next) break;
#pragma unroll
        for (int a = 0; a < 2; ++a)
#pragma unroll
            for (int b = 0; b < 2; ++b)
#pragma unroll
                for (int m = 0; m < 4; ++m)
#pragma unroll
                    for (int n = 0; n < 2; ++n) acc[a][b][m][n] = (f32x4){0.f, 0.f, 0.f, 0.f};
        cur = nxt; cA = nA; cB = nB; ++ui;
        if constexpr (ALIGN_EPI) { if (wr == 1) PG8_BAR; }
    }
    PG8_WAIT_V(0);
    if constexpr (!ALIGN_EPI) { if (wr == 0) PG8_BAR; }
    PG8_BAR;
    if constexpr (Epi::AFTER_DRAIN) { E.fused(acc, cur, wr, wc, fr, fq, lds, wid, lane); S.done(cur); }
#undef PG8_SA
#undef PG8_SB
#undef PG8_STAGE
#undef PG8_LDA
#undef PG8_LDB
#undef PG8_MMA
#undef PG8_WAIT_V
#undef PG8_WAIT_L
#undef PG8_BAR
#undef PG8_SCHED
}
}

namespace att {
typedef short bf16x8 __attribute__((ext_vector_type(8)));
typedef short s16x4 __attribute__((ext_vector_type(4)));
typedef float f32x16 __attribute__((ext_vector_type(16)));
typedef float f32x2_t __attribute__((ext_vector_type(2)));
typedef __bf16 bf16x2_t __attribute__((ext_vector_type(2)));
typedef __attribute__((address_space(3))) const unsigned char* lds_cptr;
typedef short v4i16_t __attribute__((ext_vector_type(4)));
constexpr int KSLOT = 8192, VSLOT = 16384, LDS_K = 0, LDS_V = 2 * KSLOT, LDS_BYTES = 2 * KSLOT + 2 * VSLOT;
constexpr float LOG2E = 1.4426950408889634f, C2 = 0.125f * LOG2E;
__device__ __forceinline__ int crow(int r, int hi) { return (r & 3) + 8 * (r >> 2) + 4 * hi; }
__device__ __forceinline__ void glds16(const void* gsrc, unsigned lds_dst) { unsigned keep;
    asm volatile("s_mov_b32 %0, m0\n\ts_mov_b32 m0, %2\n\ts_nop 0\n\tglobal_load_lds_dwordx4 %1, off\n\ts_mov_b32 m0, %0" : "=&s"(keep) : "v"(gsrc), "s"(lds_dst) : "memory"); }
__device__ __forceinline__ unsigned cvtpk(float lo, float hi) { f32x2_t v = {lo, hi}; bf16x2_t b = __builtin_convertvector(v, bf16x2_t); return __builtin_bit_cast(unsigned, b); }
__device__ __forceinline__ s16x4 vtr(lds_cptr p) { return __builtin_bit_cast(s16x4, __builtin_amdgcn_ds_read_tr16_b64_v4i16((__attribute__((address_space(3))) v4i16_t*)p)); }
__device__ __forceinline__ float swap_max(float m) { auto rr = __builtin_amdgcn_permlane32_swap(__float_as_uint(m), __float_as_uint(m), false, false); return fmaxf(__uint_as_float(rr[0]), __uint_as_float(rr[1])); }
__device__ __forceinline__ float swap_sum(float m) { auto rr = __builtin_amdgcn_permlane32_swap(__float_as_uint(m), __float_as_uint(m), false, false); return __uint_as_float(rr[0]) + __uint_as_float(rr[1]); }
#define ATT_WAIT_BAR() asm volatile("s_waitcnt vmcnt(0) lgkmcnt(0)\n\ts_barrier" ::: "memory")

struct Args { const bf16* Q; const bf16* K; const bf16* V; bf16* mixed; float* stash; const float* lq; const float* lk; const float* subln; float lam_init; int pad_; };

__device__ __forceinline__ void attn_unit(__attribute__((address_space(3))) unsigned char* lds, const Args& A, int h, int qb, float lam, float* stash_blk) {
    const int tid = opq_tid(), lane = tid & 63, r32 = lane & 31, hi = lane >> 5; const int wid = __builtin_amdgcn_readfirstlane(tid >> 6);
    const int q0 = qb * 256 + wid * 32, qc = q0 >> 6, NT = 4 * qb + 4;
    const float slope2 = exp2f(-(float)(h + 1)) * LOG2E;
    const unsigned lds0 = (unsigned)(uintptr_t)lds;
    const lds_cptr kp0 = (lds_cptr)lds + LDS_K + hi * 1024 + r32 * 16;
    const lds_cptr vp0 = (lds_cptr)lds + LDS_V + ((lane >> 4) & 1) * 32 + (lane & 3) * 8 + (4 * hi + ((lane & 15) >> 2)) * 64;
    const bf16* vsrc = A.V + (size_t)(16 * (wid & 3) + (lane >> 2)) * 1024 + h * 128 + (wid >> 2) * 32 + (lane & 3) * 8;
    const unsigned kdst = lds0 + LDS_K + wid * 1024, vdst = lds0 + LDS_V + (wid >> 2) * 4096 + (wid & 3) * 1024;
    const int qrel = (q0 & 63) + r32;
    float* st = stash_blk + tid * 64;
#pragma unroll 1
    for (int c = 0; c < 2; ++c) {
        const bf16* ksrc = A.K + (size_t)lane * 1024 + h * 128 + c * 64 + wid * 8;
        bf16x8 qr[4];
        { const bf16* qp = A.Q + (size_t)(q0 + r32) * 1024 + h * 128 + c * 64 + hi * 8;
#pragma unroll
          for (int d0 = 0; d0 < 4; ++d0) qr[d0] = *(const bf16x8*)(qp + d0 * 16); }
        f32x16 oT[4];
#pragma unroll
        for (int d0 = 0; d0 < 4; ++d0)
#pragma unroll
            for (int r = 0; r < 16; ++r) oT[d0][r] = 0.f;
        float l = 0.f, mu = 0.f;
        glds16(ksrc, (unsigned)__builtin_amdgcn_readfirstlane(kdst)); glds16(vsrc, (unsigned)__builtin_amdgcn_readfirstlane(vdst)); glds16(vsrc + 64, (unsigned)__builtin_amdgcn_readfirstlane(vdst + 8192));
        ATT_WAIT_BAR();
#pragma unroll 1
        for (int t = 0; t < NT; ++t) {
            const int sl = t & 1;
            if (t + 1 < NT) { const size_t go = (size_t)(t + 1) * 64 * 1024; const unsigned so = (unsigned)(sl ^ 1);
                glds16(ksrc + go, (unsigned)__builtin_amdgcn_readfirstlane(kdst + so * KSLOT)); glds16(vsrc + go, (unsigned)__builtin_amdgcn_readfirstlane(vdst + so * VSLOT));
                glds16(vsrc + go + 64, (unsigned)__builtin_amdgcn_readfirstlane(vdst + so * VSLOT + 8192)); }
            if (t <= qc) {
                const bool diag = (t == qc);
                f32x16 p0, p1;
                const float sc = slope2 * (1.0f / C2), base0 = (float)(4 * hi) * sc - mu * (1.0f / C2), base1 = base0 + 32.0f * sc;
                if (!diag) {
#pragma unroll
                    for (int r = 0; r < 16; ++r) { const float kr = (float)((r & 3) + 8 * (r >> 2)); p0[r] = __builtin_fmaf(kr, sc, base0); p1[r] = __builtin_fmaf(kr, sc, base1); }
                } else {
                    const float q2 = (float)(2 * qrel - 8 * hi);
#pragma unroll
                    for (int r = 0; r < 16; ++r) { const float kr = (float)((r & 3) + 8 * (r >> 2));
                        p0[r] = __builtin_fmaf(fminf(kr, q2 - kr) , sc, base0); p1[r] = __builtin_fmaf(fminf(kr, q2 - 64.0f - kr), sc, base1); }
                }
                const lds_cptr kp = kp0 + sl * KSLOT;
#pragma unroll
                for (int d0 = 0; d0 < 4; ++d0) {
                    const bf16x8 k0 = *(const __attribute__((address_space(3))) bf16x8*)(kp + d0 * 2048), k1 = *(const __attribute__((address_space(3))) bf16x8*)(kp + d0 * 2048 + 512);
                    p0 = __builtin_amdgcn_mfma_f32_32x32x16_bf16(k0, qr[d0], p0, 0, 0, 0);
                    p1 = __builtin_amdgcn_mfma_f32_32x32x16_bf16(k1, qr[d0], p1, 0, 0, 0);
                }
                float rm = fmaxf(p0[0], p1[0]);
#pragma unroll
                for (int r = 1; r < 16; ++r) rm = fmaxf(rm, fmaxf(p0[r], p1[r]));
                rm = swap_max(rm);
                const float dl = (t == 0) ? C2 * rm : fmaxf(C2 * rm, 0.f);
                if (__any(dl != 0.f)) { const float f = __builtin_amdgcn_exp2f(-dl); l *= f;
#pragma unroll
                    for (int d0 = 0; d0 < 4; ++d0)
#pragma unroll
                        for (int r = 0; r < 16; ++r) oT[d0][r] *= f; }
                mu += dl;
                float ls = 0.f;
#pragma unroll
                for (int r = 0; r < 16; ++r) { p0[r] = __builtin_amdgcn_exp2f(p0[r] * C2 - dl); p1[r] = __builtin_amdgcn_exp2f(p1[r] * C2 - dl); ls += p0[r] + p1[r]; }
                l += ls;
                bf16x8 pw[4];
#pragma unroll
                for (int s = 0; s < 4; ++s) { u32x4 w;
#pragma unroll
                    for (int e = 0; e < 4; ++e) { const int r = 8 * (s & 1) + 2 * e; w[e] = (s < 2) ? cvtpk(p0[r], p0[r + 1]) : cvtpk(p1[r], p1[r + 1]); }
                    pw[s] = __builtin_bit_cast(bf16x8, w); }
                const lds_cptr vp = vp0 + sl * VSLOT;
#pragma unroll
                for (int d0 = 0; d0 < 4; ++d0) {
#pragma unroll
                    for (int s = 0; s < 4; ++s) { const s16x4 lo = vtr(vp + d0 * 4096 + s * 1024), hh = vtr(vp + d0 * 4096 + s * 1024 + 512);
                        const bf16x8 vf = (bf16x8){lo[0], lo[1], lo[2], lo[3], hh[0], hh[1], hh[2], hh[3]};
                        oT[d0] = __builtin_amdgcn_mfma_f32_32x32x16_bf16(vf, pw[s], oT[d0], 0, 0, 0); }
                    __builtin_amdgcn_sched_barrier(0); }
                mu -= 64.0f * slope2;
            }
            ATT_WAIT_BAR();
        }
        const float il = 1.0f / swap_sum(l);
        if (c == 0) {
#pragma unroll
            for (int d0 = 0; d0 < 4; ++d0)
#pragma unroll
                for (int r = 0; r < 16; r += 4) *(f32x4*)(st + d0 * 16 + r) = (f32x4){oT[d0][r] * il, oT[d0][r + 1] * il, oT[d0][r + 2] * il, oT[d0][r + 3] * il};
        } else {
            float ss = 0.f;
#pragma unroll
            for (int d0 = 0; d0 < 4; ++d0)
#pragma unroll
                for (int r = 0; r < 16; r += 4) { const f32x4 sv = *(const f32x4*)(st + d0 * 16 + r);
#pragma unroll
                    for (int e = 0; e < 4; ++e) { const float v = sv[e] - lam * (oT[d0][r + e] * il); oT[d0][r + e] = v; ss += v * v; } }
            ss = swap_sum(ss);
            const float rn = (1.0f / sqrtf(ss * (1.0f / 128.0f) + RMS_EPS)) * (1.0f - A.lam_init);
            bf16* op = A.mixed + (size_t)(q0 + r32) * DM + h * 128;
#pragma unroll
            for (int d0 = 0; d0 < 4; ++d0)
#pragma unroll
                for (int g4 = 0; g4 < 4; ++g4) { const int d = 32 * d0 + 8 * g4 + 4 * hi; const f32x4 gg = *(const f32x4*)(A.subln + d);
                    u32x2 w; w.x = cvtpk(oT[d0][4 * g4] * rn * gg[0], oT[d0][4 * g4 + 1] * rn * gg[1]); w.y = cvtpk(oT[d0][4 * g4 + 2] * rn * gg[2], oT[d0][4 * g4 + 3] * rn * gg[3]);
                    *(u32x2*)(op + d) = w; }
        }
    }
}
__device__ __forceinline__ void attn_phase(__attribute__((address_space(3))) unsigned char* lds, const Args& A, int blk, int nblk) {
    const int lane = opq_tid() & 63;
    const float l0 = wave_sum(A.lq[lane] * A.lk[lane]), l1 = wave_sum(A.lq[64 + lane] * A.lk[64 + lane]);
    const float lam = __expf(l0) - __expf(l1) + A.lam_init;
    float* stash_blk = A.stash + (size_t)blk * (64 * 512);
    for (int u = blk; u < 512; u += nblk) {
        const int b = u & 255, second = u >> 8, h = b & 7, s = b >> 3, qb = second ? s : 63 - s;
        attn_unit(lds, A, h, qb, lam, stash_blk);
    }
}
}

namespace rk {
typedef short bf16x8 __attribute__((ext_vector_type(8)));
typedef short s16x4 __attribute__((ext_vector_type(4)));
typedef short v4i16_t __attribute__((ext_vector_type(4)));
typedef const LAS unsigned char* lcp;
constexpr int ST = 72, MATB = 64 * ST * 2, NST = 68, SLG = 168, SVL = 40;
constexpr int O_AT = 0, O_RT = MATB, O_BT = 2 * MATB, O_KT = 3 * MATB, O_VV = 4 * MATB, O_AAK = 5 * MATB, O_ARB = 6 * MATB, O_ARK = 7 * MATB, O_NN = 8 * MATB, O_GG = O_NN + 64 * NST * 4,
              O_U0T = O_GG, O_WT = O_AAK, O_G2 = O_AAK  , O_VG = O_ARK  , O_SEG = O_GG + 64 * NST * 4, O_GL = O_SEG + 2048,
              O_LW = O_GL + 256, O_LA = O_LW + MATB, O_LG = O_LA + MATB, O_VL = O_LG + 64 * SLG * 2, O_END = O_VL + 64 * SVL * 2;
static_assert(64 * NST * 4 <= 2 * MATB && O_END <= 156000, "stage-1 LDS map");
__device__ __forceinline__ f32x4 mfma16(bf16x8 a, bf16x8 b, f32x4 c) { return __builtin_amdgcn_mfma_f32_16x16x32_bf16(a, b, c, 0, 0, 0); }
__device__ __forceinline__ s16x4 vtr(lcp p) { return __builtin_bit_cast(s16x4, __builtin_amdgcn_ds_read_tr16_b64_v4i16((LAS v4i16_t*)p)); }
__device__ __forceinline__ bf16x8 frag(lcp m, int row0, int ks, int lane, int st = ST) { return *(const LAS bf16x8*)(m + ((row0 + (lane & 15)) * st + 32 * ks + 8 * (lane >> 4)) * 2); }
__device__ __forceinline__ bf16x8 tfrag(lcp m, int c0, int ks, int lane) {
    const int i = lane & 15, q = i >> 2, p = i & 3, k0 = 32 * ks + 8 * (lane >> 4);
    const s16x4 lo = vtr(m + ((k0 + q) * ST + c0 + 4 * p) * 2), hi = vtr(m + ((k0 + 4 + q) * ST + c0 + 4 * p) * 2);
    return (bf16x8){lo[0], lo[1], lo[2], lo[3], hi[0], hi[1], hi[2], hi[3]};
}
__device__ __forceinline__ unsigned pk(float a, float b) { return f2bf(a) | (f2bf(b) << 16); }
#define RK_BAR() do { asm volatile("s_waitcnt vmcnt(0) lgkmcnt(0)" ::: "memory"); __builtin_amdgcn_s_barrier(); asm volatile("" ::: "memory"); } while (0)


template <int T> struct SolveRow {
    static __device__ __forceinline__ void load(f32x4 (&buf)[16], LAS unsigned char* lds) {
#pragma unroll
        for (int s4 = 0; s4 < 16; ++s4) if (s4 * 4 < T + 1) buf[s4] = *(const LAS f32x4*)(lds + ((T + 1) * NST + 4 * s4) * 4);
    }
    static __device__ __forceinline__ void run(float (&x)[64], f32x4 (&cur)[16], f32x4 (&nxt)[16], LAS unsigned char* lds) {
        if constexpr (T + 1 < 64) load(nxt, lds);
        asm volatile("" ::: "memory"); __builtin_amdgcn_sched_barrier(0);
        float acc = x[T];
#pragma unroll
        for (int s4 = 0; s4 < 16; ++s4)
#pragma unroll
            for (int e = 0; e < 4; ++e) if (4 * s4 + e < T) acc = __builtin_fmaf(cur[s4][e], x[4 * s4 + e], acc);
        x[T] = acc;
        asm volatile("" : "+v"(x[T]) :: "memory"); __builtin_amdgcn_sched_barrier(0);
        if constexpr (T + 1 < 64) SolveRow<T + 1>::run(x, nxt, cur, lds);
    }
};

struct S1Args {
    const bf16* rw; const float* mu; const float* w0; const float* a0; const float* v0; const float* k_k; const float* k_a; const float* r_k;
    const bf16* w2t; const bf16* a2t; const bf16* g2t; const bf16* v2t;
    bf16* vfirst; bf16* BV; bf16* GB; bf16* PG; float* QT; bf16* RP; float* Y0; int layer; int pad_;
};
__device__ __forceinline__ float ldbf(const bf16* p) { return bf2f(*p); }

__device__ __forceinline__ void stage1_latents(LAS unsigned char* lds, const S1Args& A, int t0) {
    const int tid = opq_tid();
    for (int idx = tid; idx < 64 * 320; idx += 512) {
        const int tok = idx / 320, col = idx % 320, t = t0 + tok;
        const bf16* p = A.rw + (size_t)t * RWP + 3072 + col;
        const float cur = ldbf(p);
        if (col < 288) {
            const float prev = t > 0 ? ldbf(p - RWP) : 0.f, sft = cur + A.mu[3072 + col] * (prev - cur);
            if (col < 64) *(LAS unsigned short*)(lds + O_LW + (tok * ST + col) * 2) = (unsigned short)f2bf(tanhf(sft));
            else if (col < 128) *(LAS unsigned short*)(lds + O_LA + (tok * ST + col - 64) * 2) = (unsigned short)f2bf(sft);
            else *(LAS unsigned short*)(lds + O_LG + (tok * SLG + col - 128) * 2) = (unsigned short)f2bf(sigmoidf_(sft));
        } else {
            const float x2 = t > 0 ? ldbf(p - RWP + 32) : 0.f;
            *(LAS unsigned short*)(lds + O_VL + (tok * SVL + col - 288) * 2) = (unsigned short)f2bf(cur + x2);
        }
    }
}

__device__ __forceinline__ void stage1_unit(LAS unsigned char* lds, const S1Args& A, int c, int h) {
    const int tid = opq_tid(), lane = tid & 63, wid = __builtin_amdgcn_readfirstlane(tid >> 6), rq = lane >> 4, l15 = lane & 15;
    const int t0 = c * 64, u = c * 16 + h;
    const int b0 = wid >> 1;
    LAS float* SEG = (LAS float*)(lds + O_SEG); LAS float* GL = (LAS float*)(lds + O_GL);
    {
        const bf16x8 lw0 = frag(lds + O_LW, 16 * b0, 0, lane), lw1 = frag(lds + O_LW, 16 * b0, 1, lane), la0 = frag(lds + O_LA, 16 * b0, 0, lane), la1 = frag(lds + O_LA, 16 * b0, 1, lane);
        const bf16x8 lv0 = frag(lds + O_VL, 16 * b0, 0, lane, SVL);
        bf16x8 lg[5];
#pragma unroll
        for (int ks = 0; ks < 5; ++ks) lg[ks] = frag(lds + O_LG, 16 * b0, ks, lane, SLG);
#pragma unroll
        for (int cc = 0; cc < 2; ++cc) {
            const int cb = 2 * (wid & 1) + cc, jl = 16 * cb + l15, ch = h * 64 + jl;
            const f32x4 z = {0.f, 0.f, 0.f, 0.f};
            const bf16* pw = A.w2t + (size_t)ch * 64 + 8 * rq; const bf16* pa = A.a2t + (size_t)ch * 64 + 8 * rq; const bf16* pg = A.g2t + (size_t)ch * 160 + 8 * rq; const bf16* pv = A.v2t + (size_t)ch * 32 + 8 * rq;
            const f32x4 zw = mfma16(lw1, *(const bf16x8*)(pw + 32), mfma16(lw0, *(const bf16x8*)pw, z));
            const f32x4 za = mfma16(la1, *(const bf16x8*)(pa + 32), mfma16(la0, *(const bf16x8*)pa, z));
            f32x4 zg = z;
#pragma unroll
            for (int ks = 0; ks < 5; ++ks) zg = mfma16(lg[ks], *(const bf16x8*)(pg + 32 * ks), zg);
            const f32x4 zv = mfma16(lv0, *(const bf16x8*)pv, z);
            const float w0c = A.w0[ch], a0c = A.a0[ch], v0c = A.v0[ch];
#pragma unroll
            for (int e = 0; e < 4; ++e) {
                const int t = 16 * b0 + 4 * rq + e;
                const float zz = -(w0c + zw[e]), sp = fmaxf(zz, 0.f) + log1pf(__expf(-fabsf(zz))), wl = -sp - 0.5f;
                *(LAS float*)(lds + O_NN + (t * NST + jl) * 4) = -__expf(wl);
                *(LAS float*)(lds + O_GG + (t * NST + jl) * 4) = sigmoidf_(a0c + za[e]);
                *(LAS float*)(lds + O_G2 + (t * NST + jl) * 4) = zg[e];
                *(LAS unsigned short*)(lds + O_VG + (t * ST + jl) * 2) = (unsigned short)f2bf(sigmoidf_(v0c + zv[e]));
            }
        }
        RK_BAR();
    }
    {
        const int j = lane, ch = h * 64 + j; float lw[8], cum[8], va[8], vb[8], vk[8], vr_[8], vv[8];
        const float mur = A.mu[ch], muk = A.mu[1024 + ch], muv = A.mu[2048 + ch], kkw = A.k_k[ch], kaw = A.k_a[ch], rkw = A.r_k[ch];
        const int tf = t0 + 8 * wid;
        const bf16* rp = A.rw + (size_t)tf * RWP + ch;
        float pr = 0.f, pk_ = 0.f, pv = 0.f;
        if (tf > 0) { pr = ldbf(rp - RWP); pk_ = ldbf(rp - RWP + 1024); pv = ldbf(rp - RWP + 2048); }
#pragma unroll
        for (int e = 0; e < 8; ++e) {
            const float cr = ldbf(rp + (size_t)e * RWP), ck = ldbf(rp + (size_t)e * RWP + 1024), cv = ldbf(rp + (size_t)e * RWP + 2048);
            const float r = cr + mur * (pr - cr), kr = ck + muk * (pk_ - ck), vr = cv + muv * (pv - cv);
            pr = cr; pk_ = ck; pv = cv;
            const int tl = 8 * wid + e;
            lw[e] = *(const LAS float*)(lds + O_NN + (tl * NST + j) * 4);
            const float ar = *(const LAS float*)(lds + O_GG + (tl * NST + j) * 4), g = *(const LAS float*)(lds + O_G2 + (tl * NST + j) * 4);
            const float vg = bf2f(*(const LAS unsigned short*)(lds + O_VG + (tl * ST + j) * 2));
            const float kkv = kr * kkw, ss = wave_sum(kkv * kkv), kk = kkv * (1.0f / fmaxf(sqrtf(ss), 1e-12f));
            va[e] = -kk; vb[e] = kk * ar; vk[e] = kr * (1.0f + (ar - 1.0f) * kaw); vr_[e] = r;
            const size_t go = (size_t)(tf + e) * 1024 + ch;
            float v;
            if (A.layer == 0) { v = vr; A.vfirst[go] = (bf16)f2bf(vr); } else { v = vr + (bf2f(A.vfirst[go]) - vr) * vg; }
            vv[e] = v;
            const float bonus = wave_sum(r * vk[e] * rkw);
            A.BV[go] = (bf16)f2bf(bonus * v); A.GB[go] = (bf16)f2bf(g);
        }
        cum[0] = lw[0];
#pragma unroll
        for (int e = 1; e < 8; ++e) cum[e] = cum[e - 1] + lw[e];
        SEG[wid * 64 + j] = cum[7];
        RK_BAR();
        float off = 0.f, tot = 0.f;
#pragma unroll
        for (int s = 0; s < 8; ++s) { const float v = SEG[s * 64 + j]; off += (s < wid) ? v : 0.f; tot += v; }
        if (wid == 0) GL[j] = __expf(tot);
#pragma unroll
        for (int e = 0; e < 8; ++e) {
            const float cm = cum[e] + off, g = __expf(cm), gi = __expf(-cm), gp = __expf(cm - lw[e]);
            const int o = ((8 * wid + e) * ST + j) * 2;
            *(LAS unsigned short*)(lds + O_AT + o) = (unsigned short)f2bf(va[e] * gp);
            *(LAS unsigned short*)(lds + O_BT + o) = (unsigned short)f2bf(vb[e] * gi);
            *(LAS unsigned short*)(lds + O_KT + o) = (unsigned short)f2bf(vk[e] * gi);
            *(LAS unsigned short*)(lds + O_RT + o) = (unsigned short)f2bf(vr_[e] * g);
            *(LAS unsigned short*)(lds + O_VV + o) = (unsigned short)f2bf(vv[e]);
        }
        RK_BAR();
    }
    {
        const bf16x8 bA0 = frag(lds + O_BT, 16 * b0, 0, lane), bA1 = frag(lds + O_BT, 16 * b0, 1, lane), kA0 = frag(lds + O_KT, 16 * b0, 0, lane), kA1 = frag(lds + O_KT, 16 * b0, 1, lane);
#pragma unroll
        for (int tt = 0; tt < 2; ++tt) {
            const int tb = 2 * (wid & 1) + tt;
            const bf16x8 aB0 = frag(lds + O_AT, 16 * tb, 0, lane), aB1 = frag(lds + O_AT, 16 * tb, 1, lane), rB0 = frag(lds + O_RT, 16 * tb, 0, lane), rB1 = frag(lds + O_RT, 16 * tb, 1, lane);
            const f32x4 z = {0.f, 0.f, 0.f, 0.f};
            f32x4 ab = mfma16(bA1, aB1, mfma16(bA0, aB0, z)), ak = mfma16(kA1, aB1, mfma16(kA0, aB0, z)), rb = mfma16(bA1, rB1, mfma16(bA0, rB0, z)), rk_ = mfma16(kA1, rB1, mfma16(kA0, rB0, z));
            const int tcol = 16 * tb + l15, srow = 16 * b0 + 4 * rq;
#pragma unroll
            for (int e = 0; e < 4; ++e) { const bool st = tcol > srow + e, le = tcol >= srow + e; ab[e] = st ? ab[e] : 0.f; ak[e] = st ? ak[e] : 0.f; rb[e] = le ? rb[e] : 0.f; rk_[e] = le ? rk_[e] : 0.f; }
            *(LAS f32x4*)(lds + O_NN + (tcol * NST + srow) * 4) = ab;
            const int o = (tcol * ST + srow) * 2;
            *(LAS u32x2*)(lds + O_AAK + o) = (u32x2){pk(ak[0], ak[1]), pk(ak[2], ak[3])};
            *(LAS u32x2*)(lds + O_ARB + o) = (u32x2){pk(rb[0], rb[1]), pk(rb[2], rb[3])};
            *(LAS u32x2*)(lds + O_ARK + o) = (u32x2){pk(rk_[0], rk_[1]), pk(rk_[2], rk_[3])};
        }
        RK_BAR();
    }
    {
        const bf16x8 vA0 = tfrag(lds + O_VV, 16 * b0, 0, lane), vA1 = tfrag(lds + O_VV, 16 * b0, 1, lane);
#pragma unroll
        for (int tt = 0; tt < 2; ++tt) {
            const int tb = 2 * (wid & 1) + tt;
            const f32x4 z = {0.f, 0.f, 0.f, 0.f};
            const f32x4 g = mfma16(vA1, frag(lds + O_AAK, 16 * tb, 1, lane), mfma16(vA0, frag(lds + O_AAK, 16 * tb, 0, lane), z));
            *(LAS f32x4*)(lds + O_GG + ((16 * tb + l15) * NST + 16 * b0 + 4 * rq) * 4) = g;
        }
        RK_BAR();
    }
    if (wid < 2) {
        float x[64];
        if (wid == 0) {
#pragma unroll
            for (int t = 0; t < 64; ++t) x[t] = bf2f(*(const LAS unsigned short*)(lds + O_AT + (t * ST + lane) * 2));
        } else {
#pragma unroll
            for (int t = 0; t < 64; ++t) x[t] = *(const LAS float*)(lds + O_GG + (t * NST + lane) * 4);
        }
        f32x4 na[16], nb[16];
        LAS unsigned char* nn = lds + O_NN; asm volatile("" : "+v"(nn));
        SolveRow<0>::load(na, nn);
        SolveRow<1>::run(x, na, nb, nn);
        LAS unsigned char* dst = lds + (wid == 0 ? O_WT : O_U0T) + lane * ST * 2;
#pragma unroll
        for (int i = 0; i < 8; ++i) *(LAS u32x4*)(dst + i * 16) = (u32x4){pk(x[8 * i], x[8 * i + 1]), pk(x[8 * i + 2], x[8 * i + 3]), pk(x[8 * i + 4], x[8 * i + 5]), pk(x[8 * i + 6], x[8 * i + 7])};
    }
    RK_BAR();
    {
        const bf16x8 wA0 = frag(lds + O_WT, 16 * b0, 0, lane), wA1 = frag(lds + O_WT, 16 * b0, 1, lane);
        const bf16x8 uA0 = frag(lds + O_U0T, 16 * b0, 0, lane), uA1 = frag(lds + O_U0T, 16 * b0, 1, lane);
        const bf16x8 vA0 = tfrag(lds + O_VV, 16 * b0, 0, lane), vA1 = tfrag(lds + O_VV, 16 * b0, 1, lane);
        const bf16x8 bA0 = tfrag(lds + O_BT, 16 * b0, 0, lane), bA1 = tfrag(lds + O_BT, 16 * b0, 1, lane);
        const bf16x8 kA0 = tfrag(lds + O_KT, 16 * b0, 0, lane), kA1 = tfrag(lds + O_KT, 16 * b0, 1, lane);
        const f32x4 glr = *(const LAS f32x4*)(lds + O_GL + (16 * b0 + 4 * rq) * 4);
#pragma unroll
        for (int tt = 0; tt < 2; ++tt) {
            const int nb = 2 * (wid & 1) + tt, col = 16 * nb + l15, row = 16 * b0 + 4 * rq;
            const f32x4 z = {0.f, 0.f, 0.f, 0.f};
            const bf16x8 rbB0 = frag(lds + O_ARB, 16 * nb, 0, lane), rbB1 = frag(lds + O_ARB, 16 * nb, 1, lane), rkB0 = frag(lds + O_ARK, 16 * nb, 0, lane), rkB1 = frag(lds + O_ARK, 16 * nb, 1, lane);
            { f32x4 d = mfma16(wA1, rbB1, mfma16(wA0, rbB0, z)); const u32x2 rt = *(const LAS u32x2*)(lds + O_RT + (col * ST + row) * 2);
              d[0] += bflo(rt.x); d[1] += bfhi(rt.x); d[2] += bflo(rt.y); d[3] += bfhi(rt.y);
              *(u32x2*)(A.RP + (size_t)(t0 + col) * 1024 + h * 64 + row) = (u32x2){pk(d[0], d[1]), pk(d[2], d[3])}; }
            { const f32x4 d = mfma16(vA1, rkB1, mfma16(vA0, rkB0, mfma16(uA1, rbB1, mfma16(uA0, rbB0, z))));
              *(f32x4*)(A.Y0 + (size_t)(t0 + col) * 1024 + h * 64 + row) = d; }
            { const bf16x8 bB0 = tfrag(lds + O_BT, 16 * nb, 0, lane), bB1 = tfrag(lds + O_BT, 16 * nb, 1, lane);
              f32x4 d = mfma16(wA1, bB1, mfma16(wA0, bB0, z)); const float gj = GL[col];
#pragma unroll
              for (int e = 0; e < 4; ++e) d[e] = gj * (d[e] + ((row + e) == col ? 1.f : 0.f));
              *(u32x2*)(A.PG + (size_t)u * 4096 + col * 64 + row) = (u32x2){pk(d[0], d[1]), pk(d[2], d[3])}; }
            { const bf16x8 uB0 = frag(lds + O_U0T, 16 * nb, 0, lane), uB1 = frag(lds + O_U0T, 16 * nb, 1, lane), vB0 = tfrag(lds + O_VV, 16 * nb, 0, lane), vB1 = tfrag(lds + O_VV, 16 * nb, 1, lane);
              f32x4 d = mfma16(kA1, vB1, mfma16(kA0, vB0, mfma16(bA1, uB1, mfma16(bA0, uB0, z))));
              d = d * glr;
              *(f32x4*)(A.QT + (size_t)u * 4096 + col * 64 + row) = d; }
        }
    }
    RK_BAR();
}
__device__ __forceinline__ void ph_stage1(LAS unsigned char* lds, const S1Args& A, int blk, int nblk) {
    for (int c = blk; c < 256; c += nblk) {
        stage1_latents(lds, A, c * 64);
        RK_BAR();
#pragma unroll 1
        for (int h = 0; h < 16; ++h) stage1_unit(lds, A, c, h);
    }
}

__device__ __forceinline__ void chain_wave(const bf16* __restrict__ PG, const float* __restrict__ QT, bf16* __restrict__ H0T, int h, int ig, int lane) {
    const int fr = lane & 15, fq = lane >> 4;
    f32x4 H[4];
#pragma unroll
    for (int m = 0; m < 4; ++m) H[m] = (f32x4){0.f, 0.f, 0.f, 0.f};
    for (int c = 0; c < 256; ++c) {
        const size_t u = (size_t)c * 16 + h;
        const bf16* P = PG + u * 4096; const float* Q = QT + u * 4096 + (16 * ig + fr) * 64 + 4 * fq; bf16* Ho = H0T + u * 4096 + (16 * ig + fr) * 64 + 4 * fq;
        u32x2 a[4][2][2]; f32x4 cq[4];
#pragma unroll
        for (int m = 0; m < 4; ++m) { cq[m] = *(const f32x4*)(Q + 16 * m);
#pragma unroll
            for (int kb = 0; kb < 2; ++kb) { a[m][kb][0] = *(const u32x2*)(P + (16 * m + fr) * 64 + 32 * kb + 4 * fq); a[m][kb][1] = *(const u32x2*)(P + (16 * m + fr) * 64 + 32 * kb + 16 + 4 * fq); } }
        u32x4 bw[2];
#pragma unroll
        for (int m = 0; m < 4; ++m) { const u32x2 w = {pk(H[m][0], H[m][1]), pk(H[m][2], H[m][3])}; *(u32x2*)(Ho + 16 * m) = w; bw[m >> 1][2 * (m & 1)] = w.x; bw[m >> 1][2 * (m & 1) + 1] = w.y; }
#pragma unroll
        for (int m = 0; m < 4; ++m) {
            f32x4 d = cq[m];
#pragma unroll
            for (int kb = 0; kb < 2; ++kb) { const u32x4 aw = {a[m][kb][0].x, a[m][kb][0].y, a[m][kb][1].x, a[m][kb][1].y};
                d = mfma16(__builtin_bit_cast(bf16x8, aw), __builtin_bit_cast(bf16x8, bw[kb]), d); }
            H[m] = d;
        }
    }
}
__device__ __forceinline__ void ph_chain(const bf16* PG, const float* QT, bf16* H0T, int blk, int nblk) {
    const int tid = opq_tid(), lane = tid & 63;
    for (int gw = blk * 8 + (tid >> 6); gw < 64; gw += nblk * 8) chain_wave(PG, QT, H0T, gw >> 2, gw & 3, lane);
}

struct S3Args { const bf16* H0T; const bf16* RP; const float* Y0; const bf16* BV; const bf16* GB; const float* ln_w; const float* ln_b; bf16* mixed; };
__device__ __forceinline__ void ph_stage3(const S3Args& A, int blk, int nblk) {
    const int tid = opq_tid(), lane = tid & 63, fr = lane & 15, fq = lane >> 4;
    for (int it = blk * 8 + (tid >> 6); it < 4096 * 4; it += nblk * 8) {
        const int u = it >> 2, tb = it & 3, c = u >> 4, h = u & 15, t = 64 * c + 16 * tb + fr;
        const bf16* Hp = A.H0T + (size_t)u * 4096 + fr * 64 + 8 * fq; const bf16* Rp = A.RP + (size_t)t * 1024 + h * 64 + 8 * fq;
        const bf16x8 r0 = *(const bf16x8*)Rp, r1 = *(const bf16x8*)(Rp + 32);
        f32x4 y[4];
#pragma unroll
        for (int ib = 0; ib < 4; ++ib) { const f32x4 y0 = *(const f32x4*)(A.Y0 + (size_t)t * 1024 + h * 64 + 16 * ib + 4 * fq);
            y[ib] = mfma16(*(const bf16x8*)(Hp + ib * 1024 + 32), r1, mfma16(*(const bf16x8*)(Hp + ib * 1024), r0, y0)); }
        float s = 0.f;
#pragma unroll
        for (int ib = 0; ib < 4; ++ib) s += (y[ib][0] + y[ib][1]) + (y[ib][2] + y[ib][3]);
        s += __shfl_xor(s, 16); s += __shfl_xor(s, 32);
        const float mean = s * (1.0f / 64.0f); float q = 0.f;
#pragma unroll
        for (int ib = 0; ib < 4; ++ib)
#pragma unroll
            for (int e = 0; e < 4; ++e) { const float d = y[ib][e] - mean; y[ib][e] = d; q += d * d; }
        q += __shfl_xor(q, 16); q += __shfl_xor(q, 32);
        const float rstd = 1.0f / sqrtf(q * (1.0f / 64.0f) + GN_EPS);
#pragma unroll
        for (int ib = 0; ib < 4; ++ib) { const int ch = h * 64 + 16 * ib + 4 * fq; const size_t o = (size_t)t * 1024 + ch;
            const f32x4 lw = *(const f32x4*)(A.ln_w + ch), lb = *(const f32x4*)(A.ln_b + ch); const u32x2 bv = *(const u32x2*)(A.BV + o), gg = *(const u32x2*)(A.GB + o); f32x4 r;
            const float bvf[4] = {bflo(bv.x), bfhi(bv.x), bflo(bv.y), bfhi(bv.y)}, ggf[4] = {bflo(gg.x), bfhi(gg.x), bflo(gg.y), bfhi(gg.y)};
#pragma unroll
            for (int e = 0; e < 4; ++e) r[e] = (y[ib][e] * rstd * lw[e] + lb[e] + bvf[e]) * ggf[e];
            *(u32x2*)(A.mixed + (size_t)t * DM + 1024 + ch) = (u32x2){pk(r[0], r[1]), pk(r[2], r[3])}; }
    }
}
}
#define XB_TMO      128
#define XB_XCNT(j)  (256  + 64 * (j))
#define XB_XSUB(j)  (1280 + 64 * (j))
#define XB_XGEN(j)  (2304 + 64 * (j))
#define XB_TOP      3328
#define XB_TOPGEN   3392
#define XCD_BAR_WORDS 3456
#define XB_SPIN_CAP (1u << 22)

__device__ __forceinline__ unsigned xb_ld(unsigned* p)              { return __hip_atomic_load(p, __ATOMIC_RELAXED, __HIP_MEMORY_SCOPE_AGENT); }
__device__ __forceinline__ unsigned xb_add(unsigned* p, unsigned v) { return __hip_atomic_fetch_add(p, v, __ATOMIC_RELAXED, __HIP_MEMORY_SCOPE_AGENT); }
__device__ __forceinline__ unsigned xb_xcc_id() { return (unsigned)__builtin_amdgcn_s_getreg((3 << 11) | 20) & 0xFu; }
#define XB_SPIN(cond, bar) do { unsigned _sp = 0; while (cond) { __builtin_amdgcn_s_sleep(1); \
    if ((++_sp & 255u) == 0u) { if (xb_ld(&(bar)[XB_TMO])) break; if (_sp > XB_SPIN_CAP) { atomicAdd(&(bar)[XB_TMO], 1u); break; } } } } while (0)

struct XcdBarrier {
    unsigned* bar; unsigned x;
    volatile LAS unsigned* st;
};

__device__ __forceinline__ XcdBarrier xcd_barrier_post(unsigned* bar, volatile LAS unsigned* st) {
    XcdBarrier b; b.bar = bar; b.x = xb_xcc_id(); b.st = st;
    if (threadIdx.x == 0) (void)xb_add(&bar[XB_XCNT(b.x)], 1u);
    return b;
}
__device__ __forceinline__ void xcd_barrier_complete(unsigned* bar, unsigned x, unsigned& nloc, unsigned& nx) {
    const unsigned G = gridDim.x * gridDim.y * gridDim.z;
    unsigned sum, cnt, mine, sp = 0u;
    for (;;) {
        sum = 0u; cnt = 0u; mine = 0u;
#pragma unroll
        for (unsigned j = 0; j < 16; ++j) { const unsigned c = xb_ld(&bar[XB_XCNT(j)]); sum += c; cnt += (c > 0u) ? 1u : 0u; mine = (j == x) ? c : mine; }
        if (sum == G) break;
        __builtin_amdgcn_s_sleep(1);
        if ((++sp & 255u) == 0u) { if (xb_ld(&bar[XB_TMO])) break; if (sp > XB_SPIN_CAP) { atomicAdd(&bar[XB_TMO], 1u); break; } }
    }
    nloc = mine > 0u ? mine : 1u; nx = cnt > 0u ? cnt : 1u;
}

__device__ __forceinline__ void xcd_barrier(const XcdBarrier& b) {
    asm volatile("s_waitcnt vmcnt(0)" ::: "memory");
    __syncthreads();
    if (threadIdx.x == 0) {
        unsigned* bar = b.bar;
        __builtin_amdgcn_s_waitcnt(0);
        unsigned nloc = b.st[0], nx = b.st[1];
        if (nloc == 0u) { xcd_barrier_complete(bar, b.x, nloc, nx); b.st[0] = nloc; b.st[1] = nx; }
        const unsigned old = xb_add(&bar[XB_XSUB(b.x)], 1u);
        const unsigned gen = old / nloc;
        if (old + 1u == (gen + 1u) * nloc) {
            __builtin_amdgcn_fence(__ATOMIC_RELEASE, "agent");
            asm volatile("s_waitcnt vmcnt(0)" ::: "memory");
            const unsigned og = xb_add(&bar[XB_TOP], 1u);
            const unsigned tg = og / nx;
            if (og + 1u == (tg + 1u) * nx) xb_add(&bar[XB_TOPGEN], 1u);
            else XB_SPIN(xb_ld(&bar[XB_TOPGEN]) == tg, bar);
            __builtin_amdgcn_fence(__ATOMIC_ACQUIRE, "agent");
            xb_add(&bar[XB_XGEN(b.x)], 1u);
            asm volatile("s_waitcnt vmcnt(0)" ::: "memory");
        } else {
            XB_SPIN(xb_ld(&bar[XB_XGEN(b.x)]) == gen, bar);
            __builtin_amdgcn_fence(__ATOMIC_ACQUIRE, "agent");
            asm volatile("s_waitcnt vmcnt(0)" ::: "memory");
        }
    }
    __syncthreads();
}

constexpr size_t MiB = 1u << 20;
constexpr size_t WS_CTL = 0, CTL_ZERO_BYTES = 64 * 1024, WS_RINV = 1 * MiB, WS_WIN = 2 * MiB, WS_WOUT = 28 * MiB, WS_WUP = 36 * MiB, WS_WDOWN = 68 * MiB, WS_LORA = 100 * MiB, WS_XB = 102 * MiB,
                 WS_Q = 166 * MiB, WS_K = 198 * MiB, WS_V = 230 * MiB, WS_RW = 262 * MiB, WS_MIXED = 374 * MiB, WS_U = 166 * MiB, WS_VFIRST = 438 * MiB, WS_PG = 470 * MiB, WS_QT = 502 * MiB, WS_RP = 566 * MiB,
                 WS_Y0 = 598 * MiB, WS_H0T = 662 * MiB, WS_BV = 694 * MiB, WS_GB = 726 * MiB, WS_STASH = 758 * MiB, WS_END = 790 * MiB;
constexpr size_t LORA_W2 = 0, LORA_A2 = 1024 * 64 * 2, LORA_G2 = 2 * 1024 * 64 * 2, LORA_V2 = LORA_G2 + 1024 * 160 * 2;
constexpr int CW_BAR = 1024;
constexpr int RING_BYTES = 131072, MISC_OFF = 156000, LDS_BYTES = 156672;

struct Args { const float* in[26]; float* out; unsigned char* ws; int ph_lo, ph_hi; float lam_init[4]; };

template <bool PERMIN> __device__ __forceinline__ void convw_tile(LAS float* tile, const float* __restrict__ src, bf16* __restrict__ dst, const float* __restrict__ g, int K, int N, int item, int nkb, bool skipx = false) {
    const int k0 = (item % nkb) * 64, c0 = (item / nkb) * 64, tid = opq_tid();
    for (int i = tid; i < 64 * 64; i += 512) {
        const int kk = i >> 6, cc = i & 63, cp = c0 + cc; int col = cp;
        if (PERMIN) { const int lo = cp & 255, bj = lo >> 7, wc = (lo >> 5) & 3, j = lo & 31; col = (cp & ~255) + 64 * wc + 32 * bj + j; }
        float v = 0.f;
        if (col < N) { v = src[(size_t)(k0 + kk) * N + col]; if (g) v *= g[k0 + kk]; }
        tile[kk * 65 + cc] = v;
    }
    __syncthreads();
    for (int i = tid; i < 64 * 32; i += 512) {
        const int cc = i >> 5, kp = (i & 31) * 2, cp = c0 + cc;
        if (PERMIN && skipx && ((cp >= 6432 && cp < 6464) || (cp >= 6528 && cp < 6560))) continue;
        *(unsigned*)(dst + (size_t)cp * K + k0 + kp) = f2bf(tile[kp * 65 + cc]) | (f2bf(tile[(kp + 1) * 65 + cc]) << 16);
    }
    __syncthreads();
}
__device__ __forceinline__ void ph_convw(LAS unsigned char* lds, const __attribute__((address_space(4))) Args* a, int l, int blk, int nblk) {
    LAS float* tile = (LAS float*)lds; unsigned char* ws = a->ws;
    constexpr int I_IN = (DM / 64) * (NIN / 64), I_OUT = (DM / 64) * (DM / 64), I_UP = (DM / 64) * (DFF / 64), I_DN = (DFF / 64) * (DM / 64);
    for (int it = blk; it < I_IN + I_OUT + I_UP + I_DN; it += nblk) {
        int r = it;
        if (r < I_IN) { convw_tile<true>(tile, a->in[3] + (size_t)l * DM * PW, (bf16*)(ws + WS_WIN), a->in[1] + (size_t)l * DM, DM, PW, r, DM / 64, l > 0); continue; } r -= I_IN;
        if (r < I_OUT) { convw_tile<false>(tile, a->in[4] + (size_t)l * DM * DM, (bf16*)(ws + WS_WOUT), nullptr, DM, DM, r, DM / 64); continue; } r -= I_OUT;
        if (r < I_UP) { convw_tile<false>(tile, a->in[24] + (size_t)l * DM * DFF, (bf16*)(ws + WS_WUP), a->in[2] + (size_t)l * DM, DM, DFF, r, DM / 64); continue; } r -= I_UP;
        convw_tile<false>(tile, a->in[25] + (size_t)l * DFF * DM, (bf16*)(ws + WS_WDOWN), nullptr, DFF, DM, r, DFF / 64);
    }
    { const int tid = opq_tid(); const int lm = l > 0 ? l - 1 : 0;
      const float* w2 = a->in[12] + (size_t)l * 64 * 1024; const float* a2 = a->in[14] + (size_t)l * 64 * 1024; const float* g2 = a->in[15] + (size_t)l * 160 * 1024; const float* v2 = a->in[23] + (size_t)lm * 32 * 1024;
      bf16* lw = (bf16*)(ws + WS_LORA);
      for (int i = blk * 512 + tid; i < 1024 * 320; i += nblk * 512) {
          const int ch = i / 320, k = i % 320;
          if (k < 64) lw[LORA_W2 / 2 + ch * 64 + k] = (bf16)f2bf(w2[(size_t)k * 1024 + ch]);
          else if (k < 128) lw[LORA_A2 / 2 + ch * 64 + k - 64] = (bf16)f2bf(a2[(size_t)(k - 64) * 1024 + ch]);
          else if (k < 288) lw[LORA_G2 / 2 + ch * 160 + k - 128] = (bf16)f2bf(g2[(size_t)(k - 128) * 1024 + ch]);
          else lw[LORA_V2 / 2 + ch * 32 + k - 288] = (bf16)f2bf(v2[(size_t)(k - 288) * 1024 + ch]);
      } }
    if (l > 0) {
        const int tid = opq_tid(), kk = tid >> 6, o = tid & 63;
        const float* win = a->in[3] + (size_t)l * DM * PW; const float* g1 = a->in[1] + (size_t)l * DM; const float* muv = a->in[10] + (size_t)l * 3360 + 2048; const float* v1 = a->in[22] + (size_t)(l - 1) * 1024 * 32;
        bf16* wt = (bf16*)(ws + WS_WIN);
        for (int k0 = blk * 8; k0 < DM; k0 += nblk * 8) {
            const int k = k0 + kk; const float* wr = win + (size_t)k * PW + 5120; float acc = 0.f;
#pragma unroll 8
            for (int c = 0; c < 1024; ++c) { const float m = muv[c]; acc += wr[c] * ((o < 32) ? 1.0f - m : m) * v1[c * 32 + (o & 31)]; }
            const int row = (o < 32) ? 6528 + o : 6400 + o;
            wt[(size_t)row * DM + k] = (bf16)f2bf(acc * g1[k]);
        }
    }
}
__device__ __forceinline__ void ph_rownorm(const float* __restrict__ src, float* __restrict__ copy, bf16* __restrict__ xb, float* __restrict__ rinv, int blk, int nblk) {
    const int tid_ = opq_tid(), lane = tid_ & 63, gw = blk * 8 + (tid_ >> 6), ngw = nblk * 8;
    for (int row = gw; row < T_; row += ngw) {
        const f32x4* s = (const f32x4*)(src + (size_t)row * DM);
        float ss = 0.f;
#pragma unroll
        for (int j = 0; j < 8; ++j) { const f32x4 v = s[lane + 64 * j]; ss += (v[0] * v[0] + v[1] * v[1]) + (v[2] * v[2] + v[3] * v[3]);
            if (copy) ((f32x4*)(copy + (size_t)row * DM))[lane + 64 * j] = v;
            u32x2 w; w.x = f2bf(v[0]) | (f2bf(v[1]) << 16); w.y = f2bf(v[2]) | (f2bf(v[3]) << 16);
            ((u32x2*)(xb + (size_t)row * DM))[lane + 64 * j] = w; }
        ss = wave_sum(ss);
        if (lane == 0) rinv[row] = 1.0f / sqrtf(ss * (1.0f / DM) + RMS_EPS);
    }
}

constexpr int NPH = 10;
#ifndef PROBE_PH
#define PROBE_PH -1
#endif
#ifndef PROBE_REP
#define PROBE_REP 1
#endif
#define REP(k) for (int rep_ = 0; rep_ < ((k) == PROBE_PH ? PROBE_REP : 1); ++rep_)
typedef const __attribute__((address_space(4))) Args* CArgs;
__device__ __forceinline__ CArgs kargs() { CArgs p = (CArgs)__builtin_amdgcn_kernarg_segment_ptr(); asm volatile("" : "+s"(p)); return p; }
__global__ void __launch_bounds__(512, 2) fwd(Args args_unused) {
    extern __shared__ __attribute__((aligned(16))) unsigned char lds_raw[];
    LAS unsigned char* lds = (LAS unsigned char*)lds_raw;
    volatile LAS unsigned* MISC = (volatile LAS unsigned*)(lds + MISC_OFF);
    const int blk = (int)blockIdx.x, nblk = (int)gridDim.x;
    if (threadIdx.x < 32) MISC[threadIdx.x] = 0u;
    __syncthreads();
    int lo, hi; XcdBarrier bar;
    { CArgs ap = kargs(); lo = ap->ph_lo; hi = ap->ph_hi; unsigned* bw = (unsigned*)(ap->ws + WS_CTL) + CW_BAR; bar.bar = bw; bar.x = 0; bar.st = nullptr;
      if (hi - lo > 1) bar = xcd_barrier_post(bw, MISC + 8); }
#define IN(k) (lo <= (k) && (k) < hi)
#define SEAM(k) do { if (IN(k) && IN((k) + 1)) xcd_barrier(bar); } while (0)
#define WSP(T, off) ((T*)(ws + (off)))
#pragma unroll 1
    for (int l = 0; l < NL; ++l) {
        const int pb = l * NPH;
        if (IN(pb + 0)) REP(0) {
            CArgs ap = kargs(); unsigned char* ws = ap->ws;
            ph_convw(lds, ap, l, blk, nblk);
            ph_rownorm(l == 0 ? ap->in[0] : ap->out, l == 0 ? ap->out : nullptr, WSP(bf16, WS_XB), WSP(float, WS_RINV), blk, nblk);
        }
        SEAM(pb + 0);
        if (IN(pb + 1)) REP(1) {
            CArgs ap = kargs(); unsigned char* ws = ap->ws;
            pg8::Gemm g{WSP(bf16, WS_XB), WSP(bf16, WS_WIN), T_, NIN, DM, 0}; pg8::StaticOrder S; S.init(T_, NIN, nblk, blk);
            pg8::EpiIn E{WSP(float, WS_RINV), WSP(bf16, WS_Q), WSP(bf16, WS_K), WSP(bf16, WS_V), WSP(bf16, WS_RW), ap->in[5] + l * 128, ap->in[6] + l * 128};
            pg8::gemm_phase<pg8::EpiIn, pg8::StaticOrder, true, true>(lds, g, S, E);
        }
        SEAM(pb + 1);
        if (IN(pb + 2)) REP(2) {
            CArgs ap = kargs(); unsigned char* ws = ap->ws;
            att::Args A; A.Q = WSP(bf16, WS_Q); A.K = WSP(bf16, WS_K); A.V = WSP(bf16, WS_V); A.mixed = WSP(bf16, WS_MIXED); A.stash = WSP(float, WS_STASH); A.lq = ap->in[7] + l * 128; A.lk = ap->in[8] + l * 128; A.subln = ap->in[9] + l * 128;
            A.lam_init = ap->lam_init[l]; A.pad_ = 0;
            att::attn_phase(lds, A, blk, nblk);
        }
        SEAM(pb + 2);
        if (IN(pb + 3)) REP(3) {
            CArgs ap = kargs(); unsigned char* ws = ap->ws; const int lm = l > 0 ? l - 1 : 0;
            rk::S1Args A; A.rw = WSP(bf16, WS_RW); A.mu = ap->in[10] + (size_t)l * 3360; A.w0 = ap->in[11] + l * 1024; A.a0 = ap->in[13] + l * 1024; A.v0 = ap->in[21] + lm * 1024; A.k_k = ap->in[16] + l * 1024; A.k_a = ap->in[17] + l * 1024;
            A.r_k = ap->in[18] + l * 1024; A.w2t = (const bf16*)(ws + WS_LORA + LORA_W2); A.a2t = (const bf16*)(ws + WS_LORA + LORA_A2); A.g2t = (const bf16*)(ws + WS_LORA + LORA_G2); A.v2t = (const bf16*)(ws + WS_LORA + LORA_V2);
            A.vfirst = WSP(bf16, WS_VFIRST); A.BV = WSP(bf16, WS_BV); A.GB = WSP(bf16, WS_GB); A.PG = WSP(bf16, WS_PG); A.QT = WSP(float, WS_QT); A.RP = WSP(bf16, WS_RP); A.Y0 = WSP(float, WS_Y0); A.layer = l; A.pad_ = 0;
            rk::ph_stage1(lds, A, blk, nblk);
        }
        SEAM(pb + 3);
        if (IN(pb + 4)) REP(4) { CArgs ap = kargs(); unsigned char* ws = ap->ws; rk::ph_chain(WSP(bf16, WS_PG), WSP(float, WS_QT), WSP(bf16, WS_H0T), blk, nblk); }
        SEAM(pb + 4);
        if (IN(pb + 5)) REP(5) {
            CArgs ap = kargs(); unsigned char* ws = ap->ws;
            rk::S3Args A{WSP(bf16, WS_H0T), WSP(bf16, WS_RP), WSP(float, WS_Y0), WSP(bf16, WS_BV), WSP(bf16, WS_GB), ap->in[19] + l * 1024, ap->in[20] + l * 1024, WSP(bf16, WS_MIXED)};
            rk::ph_stage3(A, blk, nblk);
        }
        SEAM(pb + 5);
        if (IN(pb + 6)) {
            CArgs ap = kargs(); unsigned char* ws = ap->ws;
            pg8::Gemm g{WSP(bf16, WS_MIXED), WSP(bf16, WS_WOUT), T_, DM, DM, 0}; pg8::StaticOrder S; S.init(T_, DM, nblk, blk);
            pg8::EpiRes E{ap->out, DM, 0};
            pg8::gemm_phase<pg8::EpiRes, pg8::StaticOrder, true, true>(lds, g, S, E);
        }
        SEAM(pb + 6);
        if (IN(pb + 7)) { CArgs ap = kargs(); unsigned char* ws = ap->ws; ph_rownorm(ap->out, nullptr, WSP(bf16, WS_XB), WSP(float, WS_RINV), blk, nblk); }
        SEAM(pb + 7);
        if (IN(pb + 8)) REP(8) {
            CArgs ap = kargs(); unsigned char* ws = ap->ws;
            pg8::Gemm g{WSP(bf16, WS_XB), WSP(bf16, WS_WUP), T_, DFF, DM, 0}; pg8::StaticOrder S; S.init(T_, DFF, nblk, blk);
            pg8::EpiUp E{WSP(float, WS_RINV), WSP(bf16, WS_U), DFF, 0};
            pg8::gemm_phase<pg8::EpiUp, pg8::StaticOrder, true, true>(lds, g, S, E);
        }
        SEAM(pb + 8);
        if (IN(pb + 9)) {
            CArgs ap = kargs(); unsigned char* ws = ap->ws;
            pg8::Gemm g{WSP(bf16, WS_U), WSP(bf16, WS_WDOWN), T_, DM, DFF, 0}; pg8::StaticOrder S; S.init(T_, DM, nblk, blk);
            pg8::EpiRes E{ap->out, DM, 0};
            pg8::gemm_phase<pg8::EpiRes, pg8::StaticOrder, true, true>(lds, g, S, E);
        }
        SEAM(pb + 9);
    }
#undef IN
#undef SEAM
#undef WSP
}

#ifndef MK_PER_PHASE
#define MK_PER_PHASE 0
#endif
extern "C" void kernel_launch(void* const* d_in, const int* in_sizes, int n_in, void* d_out, int out_size, void* d_ws, size_t ws_size, hipStream_t stream) {
    static int grid = 0;
    if (grid == 0) {
        grid = -1;
        if (n_in != 26 || ws_size < WS_END || out_size != T_ * DM) { fprintf(stderr, "kernel_launch: unexpected shapes (n_in %d ws %zu out %d)\n", n_in, ws_size, out_size); return; }
        int dev = 0, cus = 0, per_cu = 0;
        if (hipGetDevice(&dev) != hipSuccess || hipDeviceGetAttribute(&cus, hipDeviceAttributeMultiprocessorCount, dev) != hipSuccess) return;
        if (hipFuncSetAttribute((const void*)fwd, hipFuncAttributeMaxDynamicSharedMemorySize, LDS_BYTES) != hipSuccess) return;
        if (hipOccupancyMaxActiveBlocksPerMultiprocessor(&per_cu, (const void*)fwd, 512, LDS_BYTES) != hipSuccess || per_cu < 1) { fprintf(stderr, "kernel_launch: occupancy query says %d\n", per_cu); (void)hipGetLastError(); return; }
        grid = cus;
    }
    if (grid < 0) return;
    if (hipMemsetAsync((char*)d_ws + WS_CTL, 0, CTL_ZERO_BYTES, stream) != hipSuccess) return;
    Args a;
    memset(&a, 0, sizeof(a));
    for (int i = 0; i < 26; ++i) a.in[i] = (const float*)d_in[i];
    a.out = (float*)d_out; a.ws = (unsigned char*)d_ws;
    for (int l = 0; l < NL; ++l) a.lam_init[l] = (float)(0.8 - 0.6 * exp(-0.3 * (double)l));
    const int nph = NL * NPH;
#if MK_PER_PHASE
    for (int p = 0; p < nph; ++p) { a.ph_lo = p; a.ph_hi = p + 1; hipLaunchKernelGGL(fwd, dim3(grid), dim3(512), LDS_BYTES, stream, a); }
#else
    a.ph_lo = 0; a.ph_hi = nph; hipLaunchKernelGGL(fwd, dim3(grid), dim3(512), LDS_BYTES, stream, a);
#endif
}
```

```cpp
#include <hip/hip_runtime.h>
#include <cstdio>
#include <cstdint>
#include <cstring>
#include <cmath>

constexpr int T_ = 16384, DM = 2048, NL = 4, PW = 6432, NIN = 6656, RWP = 3584, DFF = 8192, RW_ = 1024;
constexpr float RMS_EPS = 1e-6f, GN_EPS = 64e-5f;
typedef unsigned short bf16;
typedef float f32x4 __attribute__((ext_vector_type(4)));
typedef unsigned u32x4 __attribute__((ext_vector_type(4)));
typedef unsigned u32x2 __attribute__((ext_vector_type(2)));
#define LAS __attribute__((address_space(3)))

__device__ __forceinline__ unsigned f2bf(float f) { unsigned u = __builtin_bit_cast(unsigned, f); return (u + 0x7fffu + ((u >> 16) & 1u)) >> 16; }
__device__ __forceinline__ float bf2f(unsigned short b) { return __builtin_bit_cast(float, (unsigned)b << 16); }
__device__ __forceinline__ float bflo(unsigned w) { return __builtin_bit_cast(float, w << 16); }
__device__ __forceinline__ float bfhi(unsigned w) { return __builtin_bit_cast(float, w & 0xffff0000u); }
__device__ __forceinline__ float sigmoidf_(float x) { return 1.0f / (1.0f + __expf(-x)); }

template <int CTRL, int ROWMASK> __device__ __forceinline__ float dppf(float v) {
    return __builtin_bit_cast(float, __builtin_amdgcn_update_dpp(0, __builtin_bit_cast(int, v), CTRL, ROWMASK, 0xF, false));
}
__device__ __forceinline__ float wave_sum(float v) {
    v += dppf<0xB1, 0xF>(v); v += dppf<0x4E, 0xF>(v); v += dppf<0x141, 0xF>(v); v += dppf<0x140, 0xF>(v);
    v += dppf<0x142, 0xA>(v); v += dppf<0x143, 0xC>(v);
    return __builtin_bit_cast(float, __builtin_amdgcn_readlane(__builtin_bit_cast(int, v), 63));
}
__device__ __forceinline__ int opq_tid() { int t = (int)threadIdx.x; asm volatile("" : "+v"(t)); return t; }
namespace pg8 {
#define PG8_LAS __attribute__((address_space(3)))
typedef unsigned short bf16_t;
typedef short bf16x8 __attribute__((ext_vector_type(8)));
typedef float f32x4 __attribute__((ext_vector_type(4)));
typedef unsigned u32x4 __attribute__((ext_vector_type(4)));
constexpr int BM = 256, BK = 64, HALF = 128, HTB = HALF * BK * 2  , STAGE_BYTES = 8 * HTB, NXCD = 8, WGM = 8;

__host__ __device__ __forceinline__ int lds_byte(int r, int c) { const int st = (r >> 4) * 2 + (c >> 5), rr = r & 15, cc = c & 31, ob = rr * 64 + cc * 2; return st * 1024 + (ob ^ (((ob >> 9) & 1) << 5)); }
__host__ __device__ __forceinline__ void stage_rc(int b, int& R, int& C) { const int st = b / 1024, sb = b % 1024, swz = sb ^ (((sb >> 9) & 1) << 5); R = (st >> 1) * 16 + swz / 64; C = (st & 1) * 32 + (swz % 64) / 2; }
__host__ __device__ __forceinline__ int perm32(int rho) { const int n = rho >> 4, i = rho & 15; return 8 * (i >> 2) + 4 * n + (i & 3); }

struct Unit { int pm, pn; };
struct Gemm { const bf16_t* A; const bf16_t* Bt; int M, N, K, pad_; };

struct StaticOrder {
    int nM, nN, nwg, G, c;
    __host__ __device__ void init(int M, int N, int G_, int c_) { nM = M / BM; nN = N / BM; nwg = nM * nN; G = G_; c = c_; }
    __host__ __device__ bool next(int i, Unit& u) const {
        const long L = (long)i * G + c; if (L >= nwg) return false;
        int wgid = (int)L; { const int q = nwg / NXCD, r = nwg % NXCD, xcd = wgid % NXCD, off = wgid / NXCD; wgid = (xcd < r ? xcd * (q + 1) : r * (q + 1) + (xcd - r) * q) + off; }
        const int nig = WGM * nN, gid = wgid / nig, fm = gid * WGM, gsz = (nM - fm) < WGM ? (nM - fm) : WGM;
        u.pm = fm + ((wgid % nig) % gsz); u.pn = (wgid % nig) / gsz; return true;
    }
    __device__ __forceinline__ void a_ready(const Unit&) const {}
    __device__ __forceinline__ void done(const Unit&) const {}
};

__device__ __forceinline__ unsigned cvt_pk_bf16(float lo, float hi) { unsigned r; asm volatile("v_cvt_pk_bf16_f32 %0, %1, %2" : "=v"(r) : "v"(lo), "v"(hi)); return r; }
typedef float f32x2 __attribute__((ext_vector_type(2)));
struct EpiIn {
    static constexpr bool PERM = true, AFTER_DRAIN = false;
    const float* rinv; bf16_t* q; bf16_t* k; bf16_t* v; bf16_t* rw; const float* gq; const float* gk;
    __device__ __forceinline__ void operator()(const f32x4 (&acc)[2][2][4][2], const Unit& u, int wr, int wc, int fr, int fq) const {
        const int pn = u.pn;
        const int row0 = u.pm * BM + wr * 64 + fr;
        if (pn < 8) {
            const float* g = (pn < 4 ? gq : gk) + (wc & 1) * 64 + 8 * fq;
            f32x4 gv[2][2];
#pragma unroll
            for (int bj = 0; bj < 2; ++bj)
#pragma unroll
                for (int n = 0; n < 2; ++n) gv[bj][n] = *(const f32x4*)(g + 32 * bj + 4 * n);
            bf16_t* base = (pn < 4 ? q : k) + (pn & 3) * 256 + 64 * wc + 8 * fq;
#pragma unroll
            for (int ai = 0; ai < 2; ++ai)
#pragma unroll
                for (int m = 0; m < 4; ++m) {
                    const int row = row0 + ai * HALF + m * 16; const float ri = rinv[row];
                    f32x4 vv[2][2]; float ss = 0.f;
#pragma unroll
                    for (int bj = 0; bj < 2; ++bj)
#pragma unroll
                        for (int n = 0; n < 2; ++n) { vv[bj][n] = acc[ai][bj][m][n] * ri; const f32x4 t = vv[bj][n]; ss += (t[0] * t[0] + t[1] * t[1]) + (t[2] * t[2] + t[3] * t[3]); }
                    ss += __shfl_xor(ss, 16); ss += __shfl_xor(ss, 32);
                    const float rq = 1.0f / sqrtf(ss * (1.0f / 64.0f) + 1e-6f);
#pragma unroll
                    for (int bj = 0; bj < 2; ++bj) { const f32x4 a = vv[bj][0] * rq * gv[bj][0], b = vv[bj][1] * rq * gv[bj][1];
                        u32x4 w; w.x = cvt_pk_bf16(a[0], a[1]); w.y = cvt_pk_bf16(a[2], a[3]); w.z = cvt_pk_bf16(b[0], b[1]); w.w = cvt_pk_bf16(b[2], b[3]);
                        *(u32x4*)(base + (size_t)row * 1024 + 32 * bj) = w; }
                }
        } else {
            bf16_t* base; int ld;
            if (pn < 12) { base = v + (pn - 8) * 256 + 64 * wc + 8 * fq; ld = 1024; } else { base = rw + (pn - 12) * 256 + 64 * wc + 8 * fq; ld = 3584; }
#pragma unroll
            for (int ai = 0; ai < 2; ++ai)
#pragma unroll
                for (int m = 0; m < 4; ++m) {
                    const int row = row0 + ai * HALF + m * 16; const float ri = rinv[row];
#pragma unroll
                    for (int bj = 0; bj < 2; ++bj) { const f32x4 a = acc[ai][bj][m][0] * ri, b = acc[ai][bj][m][1] * ri;
                        u32x4 w; w.x = cvt_pk_bf16(a[0], a[1]); w.y = cvt_pk_bf16(a[2], a[3]); w.z = cvt_pk_bf16(b[0], b[1]); w.w = cvt_pk_bf16(b[2], b[3]);
                        *(u32x4*)(base + (size_t)row * ld + 32 * bj) = w; }
                }
        }
    }
};
struct EpiRes {
    static constexpr bool PERM = true, AFTER_DRAIN = false;
    float* x; int ldc; int pad_;
    __device__ __forceinline__ void operator()(const f32x4 (&acc)[2][2][4][2], const Unit& u, int wr, int wc, int fr, int fq) const {
        const int row0 = u.pm * BM + wr * 64 + fr, col0 = u.pn * BM + wc * 32 + 8 * fq;
#pragma unroll
        for (int ai = 0; ai < 2; ++ai)
#pragma unroll
            for (int m = 0; m < 4; ++m) { float* rowp = x + (size_t)(row0 + ai * HALF + m * 16) * ldc + col0;
#pragma unroll
                for (int bj = 0; bj < 2; ++bj) { f32x4* p = (f32x4*)(rowp + bj * HALF); const f32x4 o0 = p[0], o1 = p[1]; p[0] = o0 + acc[ai][bj][m][0]; p[1] = o1 + acc[ai][bj][m][1]; } }
    }
};
struct EpiUp {
    static constexpr bool PERM = true, AFTER_DRAIN = false;
    const float* rinv; bf16_t* o; int ldc; int pad_;
    __device__ __forceinline__ void operator()(const f32x4 (&acc)[2][2][4][2], const Unit& u, int wr, int wc, int fr, int fq) const {
        const int row0 = u.pm * BM + wr * 64 + fr, col0 = u.pn * BM + wc * 32 + 8 * fq;
#pragma unroll
        for (int ai = 0; ai < 2; ++ai)
#pragma unroll
            for (int m = 0; m < 4; ++m) { const int row = row0 + ai * HALF + m * 16; const float ri = rinv[row]; bf16_t* rowp = o + (size_t)row * ldc + col0;
#pragma unroll
                for (int bj = 0; bj < 2; ++bj) { f32x4 a = acc[ai][bj][m][0] * ri, b = acc[ai][bj][m][1] * ri;
#pragma unroll
                    for (int e = 0; e < 4; ++e) { a[e] = a[e] > 0.f ? a[e] * a[e] : 0.f; b[e] = b[e] > 0.f ? b[e] * b[e] : 0.f; }
                    u32x4 w; w.x = cvt_pk_bf16(a[0], a[1]); w.y = cvt_pk_bf16(a[2], a[3]); w.z = cvt_pk_bf16(b[0], b[1]); w.w = cvt_pk_bf16(b[2], b[3]);
                    *(u32x4*)(rowp + bj * HALF) = w; } }
    }
};
template <class Epi, class Sched, bool ALIGN_EPI = false, bool SP2 = false>
__device__ __forceinline__ void gemm_phase(PG8_LAS unsigned char* lds, const Gemm g, const Sched& S, const Epi& E) {
    const int tid = opq_tid(), wid = __builtin_amdgcn_readfirstlane(tid >> 6), lane = tid & 63, wr = wid >> 2, wc = wid & 3, fr = lane & 15, fq = lane >> 4;
    const int K = g.K, nt = K / BK;
    unsigned voffA[2], voffB[2];
#pragma unroll
    for (int i = 0; i < 2; ++i) { int R, C; stage_rc(tid * 16 + i * 8192, R, C); const int Rb = Epi::PERM ? ((R & ~31) + perm32(R & 31)) : R;
        voffA[i] = (unsigned)(R * K + C) * 2u; voffB[i] = (unsigned)(Rb * K + C) * 2u; }
    const size_t kstep = (size_t)(BK * 2);
    const size_t hstep = (size_t)HALF * K * 2;
    const size_t tstep = 2 * hstep;
    const unsigned ldsw = (unsigned)wid * 1024u;
    const int aoff = lds_byte(wr * 64 + fr, fq * 8), boff = lds_byte(wc * 32 + fr, fq * 8);
#define PG8_SA(b, h) (((b) * 2 + (h)) * HTB)
#define PG8_SB(b, h) ((4 + (b) * 2 + (h)) * HTB)
#define PG8_STAGE(bufoff, gbase, voff) do { _Pragma("unroll") for (int _i = 0; _i < 2; ++_i) \
        __builtin_amdgcn_global_load_lds((const unsigned*)((const char*)(gbase) + (voff)[_i]), (PG8_LAS unsigned*)(lds + (bufoff) + ldsw + _i * 8192), 16, 0, 0); } while (0)
#define PG8_LDA(dst, b, h) do { _Pragma("unroll") for (int m = 0; m < 4; ++m) _Pragma("unroll") for (int k = 0; k < 2; ++k) dst[m][k] = *(const PG8_LAS bf16x8*)(lds + PG8_SA(b, h) + aoff + m * 2048 + k * 1024); } while (0)
#define PG8_LDB(dst, b, h) do { _Pragma("unroll") for (int n = 0; n < 2; ++n) _Pragma("unroll") for (int k = 0; k < 2; ++k) dst[n][k] = *(const PG8_LAS bf16x8*)(lds + PG8_SB(b, h) + boff + n * 2048 + k * 1024); } while (0)
#define PG8_MMA(ai, bj, At, Bt) do { __builtin_amdgcn_s_setprio(1); _Pragma("unroll") for (int m = 0; m < 4; ++m) _Pragma("unroll") for (int n = 0; n < 2; ++n) _Pragma("unroll") for (int k = 0; k < 2; ++k) \
        acc[ai][bj][m][n] = __builtin_amdgcn_mfma_f32_16x16x32_bf16(Bt[n][k], At[m][k], acc[ai][bj][m][n], 0, 0, 0); __builtin_amdgcn_s_setprio(0); } while (0)
#define PG8_WAIT_V(n) asm volatile("s_waitcnt vmcnt(" #n ")" ::: "memory")
#define PG8_WAIT_L(n) asm volatile("s_waitcnt lgkmcnt(" #n ")" ::: "memory")
#define PG8_BAR __builtin_amdgcn_s_barrier()
#define PG8_SCHED __builtin_amdgcn_sched_barrier(0)
    Unit cur, nxt; int ui = 0;
    if (!S.next(0, cur)) return;
    f32x4 acc[2][2][4][2];
#pragma unroll
    for (int a = 0; a < 2; ++a)
#pragma unroll
        for (int b = 0; b < 2; ++b)
#pragma unroll
            for (int m = 0; m < 4; ++m)
#pragma unroll
                for (int n = 0; n < 2; ++n) acc[a][b][m][n] = (f32x4){0.f, 0.f, 0.f, 0.f};
    bf16x8 At[4][2], B0[2][2], B1[2][2];
    const char* cA = (const char*)g.A + (size_t)cur.pm * tstep; const char* cB = (const char*)g.Bt + (size_t)cur.pn * tstep;
    S.a_ready(cur);
    if constexpr (SP2) {
        PG8_STAGE(PG8_SB(0, 0), cB, voffB); PG8_STAGE(PG8_SB(0, 1), cB + hstep, voffB); PG8_STAGE(PG8_SA(0, 0), cA, voffA); PG8_STAGE(PG8_SA(0, 1), cA + hstep, voffA);
        if (wr == 1) PG8_BAR;
        PG8_WAIT_V(2); PG8_BAR;
        PG8_STAGE(PG8_SB(1, 0), cB + kstep, voffB); PG8_STAGE(PG8_SA(1, 0), cA + kstep, voffA); PG8_STAGE(PG8_SB(1, 1), cB + hstep + kstep, voffB);
        PG8_WAIT_V(6); PG8_BAR;
    } else {
        PG8_STAGE(PG8_SB(0, 0), cB, voffB); PG8_STAGE(PG8_SA(0, 0), cA, voffA); PG8_STAGE(PG8_SB(0, 1), cB + hstep, voffB); PG8_STAGE(PG8_SA(0, 1), cA + hstep, voffA);
        if (wr == 1) PG8_BAR;
        PG8_WAIT_V(4); PG8_BAR;
        PG8_STAGE(PG8_SB(1, 0), cB + kstep, voffB); PG8_STAGE(PG8_SA(1, 0), cA + kstep, voffA); PG8_STAGE(PG8_SB(1, 1), cB + hstep + kstep, voffB);
        PG8_WAIT_V(6); PG8_BAR;
    }
    for (;;) {
        const bool has_next = S.next(ui + 1, nxt);
        const char* nA = has_next ? (const char*)g.A + (size_t)nxt.pm * tstep : cA; const char* nB = has_next ? (const char*)g.Bt + (size_t)nxt.pn * tstep : cB;
        for (int t = 0; t < nt; t += 2) {
            const bool last = (t == nt - 2);
            const char* a1 = cA + (size_t)(t + 1) * kstep;
            const char* a2 = last ? nA : cA + (size_t)(t + 2) * kstep; const char* b2 = last ? nB : cB + (size_t)(t + 2) * kstep;
            const char* a3 = a2 + kstep; const char* b3 = b2 + kstep;
            if (last && has_next) S.a_ready(nxt);
            if constexpr (SP2) {
            PG8_LDB(B0, 0, 0); PG8_LDB(B1, 0, 1); PG8_SCHED; PG8_LDA(At, 0, 0); PG8_STAGE(PG8_SA(1, 1), a1 + hstep, voffA);
            PG8_WAIT_V(8); PG8_WAIT_L(0); PG8_BAR; PG8_MMA(0, 0, At, B0); PG8_MMA(0, 1, At, B1); PG8_BAR; PG8_SCHED;
            PG8_LDA(At, 0, 1); PG8_STAGE(PG8_SB(0, 0), b2, voffB); PG8_STAGE(PG8_SB(0, 1), b2 + hstep, voffB); PG8_STAGE(PG8_SA(0, 0), a2, voffA);
            PG8_WAIT_V(8); PG8_WAIT_L(0); PG8_BAR; PG8_MMA(1, 0, At, B0); PG8_MMA(1, 1, At, B1); PG8_BAR; PG8_SCHED;
            PG8_LDB(B0, 1, 0); PG8_LDB(B1, 1, 1); PG8_SCHED; PG8_LDA(At, 1, 0); PG8_STAGE(PG8_SA(0, 1), a2 + hstep, voffA);
            PG8_WAIT_V(8); PG8_WAIT_L(0); PG8_BAR; PG8_MMA(0, 0, At, B0); PG8_MMA(0, 1, At, B1); PG8_BAR; PG8_SCHED;
            PG8_LDA(At, 1, 1); PG8_STAGE(PG8_SB(1, 0), b3, voffB); PG8_STAGE(PG8_SB(1, 1), b3 + hstep, voffB); PG8_STAGE(PG8_SA(1, 0), a3, voffA);
            PG8_WAIT_V(8); PG8_WAIT_L(0); PG8_BAR; PG8_MMA(1, 0, At, B0); PG8_MMA(1, 1, At, B1); PG8_BAR; PG8_SCHED;
            } else {
            PG8_LDB(B0, 0, 0); PG8_SCHED; PG8_LDA(At, 0, 0); PG8_STAGE(PG8_SA(1, 1), a1 + hstep, voffA);
            PG8_WAIT_L(8); PG8_BAR; PG8_WAIT_L(0); PG8_MMA(0, 0, At, B0); PG8_BAR; PG8_SCHED;
            PG8_LDB(B1, 0, 1); PG8_STAGE(PG8_SB(0, 0), b2, voffB);
            PG8_BAR; PG8_WAIT_L(0); PG8_MMA(0, 1, At, B1); PG8_BAR;
            PG8_LDA(At, 0, 1); PG8_STAGE(PG8_SA(0, 0), a2, voffA);
            PG8_BAR; PG8_WAIT_L(0); PG8_MMA(1, 0, At, B0); PG8_BAR; PG8_SCHED;
            PG8_STAGE(PG8_SB(0, 1), b2 + hstep, voffB);
            PG8_WAIT_V(6); PG8_BAR; PG8_MMA(1, 1, At, B1); PG8_BAR;
            PG8_LDB(B0, 1, 0); PG8_SCHED; PG8_LDA(At, 1, 0); PG8_STAGE(PG8_SA(0, 1), a2 + hstep, voffA);
            PG8_WAIT_L(8); PG8_BAR; PG8_WAIT_L(0); PG8_MMA(0, 0, At, B0); PG8_BAR; PG8_SCHED;
            PG8_LDB(B1, 1, 1); PG8_STAGE(PG8_SB(1, 0), b3, voffB);
            PG8_BAR; PG8_WAIT_L(0); PG8_MMA(0, 1, At, B1); PG8_BAR;
            PG8_LDA(At, 1, 1); PG8_STAGE(PG8_SA(1, 0), a3, voffA);
            PG8_BAR; PG8_WAIT_L(0); PG8_MMA(1, 0, At, B0); PG8_BAR; PG8_SCHED;
            PG8_STAGE(PG8_SB(1, 1), b3 + hstep, voffB);
            PG8_WAIT_V(6); PG8_BAR; PG8_MMA(1, 1, At, B1); PG8_BAR;
            }
        }
        if constexpr (ALIGN_EPI) { if (wr == 0) PG8_BAR; }
        if constexpr (!Epi::AFTER_DRAIN) { E(acc, cur, wr, wc, fr, fq); S.done(cur); }
        if (!has_next) break;
#pragma unroll
        for (int a = 0; a < 2; ++a)
#pragma unroll
            for (int b = 0; b < 2; ++b)
#pragma unroll
                for (int m = 0; m < 4; ++m)
#pragma unroll
                    for (int n = 0; n < 2; ++n) acc[a][b][m][n] = (f32x4){0.f, 0.f, 0.f, 0.f};
        cur = nxt; cA = nA; cB = nB; ++ui;
        if constexpr (ALIGN_EPI) { if (wr == 1) PG8_BAR; }
    }
    PG8_WAIT_V(0);
    if constexpr (!ALIGN_EPI) { if (wr == 0) PG8_BAR; }
    PG8_BAR;
    if constexpr (Epi::AFTER_DRAIN) { E.fused(acc, cur, wr, wc, fr, fq, lds, wid, lane); S.done(cur); }
#undef PG8_SA
#undef PG8_SB
#undef PG8_STAGE
#undef PG8_LDA
#undef PG8_LDB
#undef PG8_MMA
#undef PG8_WAIT_V
#undef PG8_WAIT_L
#undef PG8_BAR
#undef PG8_SCHED
}
}

namespace att {
typedef short bf16x8 __attribute__((ext_vector_type(8)));
typedef short s16x4 __attribute__((ext_vector_type(4)));
typedef float f32x16 __attribute__((ext_vector_type(16)));
typedef float f32x2_t __attribute__((ext_vector_type(2)));
typedef __bf16 bf16x2_t __attribute__((ext_vector_type(2)));
typedef __attribute__((address_space(3))) const unsigned char* lds_cptr;
typedef short v4i16_t __attribute__((ext_vector_type(4)));
constexpr int KSLOT = 8192, VSLOT = 16384, LDS_K = 0, LDS_V = 2 * KSLOT, LDS_BYTES = 2 * KSLOT + 2 * VSLOT;
constexpr float LOG2E = 1.4426950408889634f, C2 = 0.125f * LOG2E;
__device__ __forceinline__ int crow(int r, int hi) { return (r & 3) + 8 * (r >> 2) + 4 * hi; }
__device__ __forceinline__ void glds16(const void* gsrc, unsigned lds_dst) { unsigned keep;
    asm volatile("s_mov_b32 %0, m0\n\ts_mov_b32 m0, %2\n\ts_nop 0\n\tglobal_load_lds_dwordx4 %1, off\n\ts_mov_b32 m0, %0" : "=&s"(keep) : "v"(gsrc), "s"(lds_dst) : "memory"); }
__device__ __forceinline__ unsigned cvtpk(float lo, float hi) { f32x2_t v = {lo, hi}; bf16x2_t b = __builtin_convertvector(v, bf16x2_t); return __builtin_bit_cast(unsigned, b); }
__device__ __forceinline__ s16x4 vtr(lds_cptr p) { return __builtin_bit_cast(s16x4, __builtin_amdgcn_ds_read_tr16_b64_v4i16((__attribute__((address_space(3))) v4i16_t*)p)); }
__device__ __forceinline__ float swap_max(float m) { auto rr = __builtin_amdgcn_permlane32_swap(__float_as_uint(m), __float_as_uint(m), false, false); return fmaxf(__uint_as_float(rr[0]), __uint_as_float(rr[1])); }
__device__ __forceinline__ float swap_sum(float m) { auto rr = __builtin_amdgcn_permlane32_swap(__float_as_uint(m), __float_as_uint(m), false, false); return __uint_as_float(rr[0]) + __uint_as_float(rr[1]); }
#define ATT_WAIT_BAR() asm volatile("s_waitcnt vmcnt(0) lgkmcnt(0)\n\ts_barrier" ::: "memory")

struct Args { const bf16* Q; const bf16* K; const bf16* V; bf16* mixed; float* stash; const float* lq; const float* lk; const float* subln; float lam_init; int pad_; };

__device__ __forceinline__ void attn_unit(__attribute__((address_space(3))) unsigned char* lds, const Args& A, int h, int qb, float lam, float* stash_blk) {
    const int tid = opq_tid(), lane = tid & 63, r32 = lane & 31, hi = lane >> 5; const int wid = __builtin_amdgcn_readfirstlane(tid >> 6);
    const int q0 = qb * 256 + wid * 32, qc = q0 >> 6, NT = 4 * qb + 4;
    const float slope2 = exp2f(-(float)(h + 1)) * LOG2E;
    const unsigned lds0 = (unsigned)(uintptr_t)lds;
    const lds_cptr kp0 = (lds_cptr)lds + LDS_K + hi * 1024 + r32 * 16;
    const lds_cptr vp0 = (lds_cptr)lds + LDS_V + ((lane >> 4) & 1) * 32 + (lane & 3) * 8 + (4 * hi + ((lane & 15) >> 2)) * 64;
    const bf16* vsrc = A.V + (size_t)(16 * (wid & 3) + (lane >> 2)) * 1024 + h * 128 + (wid >> 2) * 32 + (lane & 3) * 8;
    const unsigned kdst = lds0 + LDS_K + wid * 1024, vdst = lds0 + LDS_V + (wid >> 2) * 4096 + (wid & 3) * 1024;
    const int qrel = (q0 & 63) + r32;
    float* st = stash_blk + tid * 64;
#pragma unroll 1
    for (int c = 0; c < 2; ++c) {
        const bf16* ksrc = A.K + (size_t)lane * 1024 + h * 128 + c * 64 + wid * 8;
        bf16x8 qr[4];
        { const bf16* qp = A.Q + (size_t)(q0 + r32) * 1024 + h * 128 + c * 64 + hi * 8;
#pragma unroll
          for (int d0 = 0; d0 < 4; ++d0) qr[d0] = *(const bf16x8*)(qp + d0 * 16); }
        f32x16 oT[4];
#pragma unroll
        for (int d0 = 0; d0 < 4; ++d0)
#pragma unroll
            for (int r = 0; r < 16; ++r) oT[d0][r] = 0.f;
        float l = 0.f, mu = 0.f;
        glds16(ksrc, (unsigned)__builtin_amdgcn_readfirstlane(kdst)); glds16(vsrc, (unsigned)__builtin_amdgcn_readfirstlane(vdst)); glds16(vsrc + 64, (unsigned)__builtin_amdgcn_readfirstlane(vdst + 8192));
        ATT_WAIT_BAR();
#pragma unroll 1
        for (int t = 0; t < NT; ++t) {
            const int sl = t & 1;
            if (t + 1 < NT) { const size_t go = (size_t)(t + 1) * 64 * 1024; const unsigned so = (unsigned)(sl ^ 1);
                glds16(ksrc + go, (unsigned)__builtin_amdgcn_readfirstlane(kdst + so * KSLOT)); glds16(vsrc + go, (unsigned)__builtin_amdgcn_readfirstlane(vdst + so * VSLOT));
                glds16(vsrc + go + 64, (unsigned)__builtin_amdgcn_readfirstlane(vdst + so * VSLOT + 8192)); }
            if (t <= qc) {
                const bool diag = (t == qc);
                f32x16 p0, p1;
                const float sc = slope2 * (1.0f / C2), base0 = (float)(4 * hi) * sc - mu * (1.0f / C2), base1 = base0 + 32.0f * sc;
                if (!diag) {
#pragma unroll
                    for (int r = 0; r < 16; ++r) { const float kr = (float)((r & 3) + 8 * (r >> 2)); p0[r] = __builtin_fmaf(kr, sc, base0); p1[r] = __builtin_fmaf(kr, sc, base1); }
                } else {
                    const float q2 = (float)(2 * qrel - 8 * hi);
#pragma unroll
                    for (int r = 0; r < 16; ++r) { const float kr = (float)((r & 3) + 8 * (r >> 2));
                        p0[r] = __builtin_fmaf(fminf(kr, q2 - kr) , sc, base0); p1[r] = __builtin_fmaf(fminf(kr, q2 - 64.0f - kr), sc, base1); }
                }
                const lds_cptr kp = kp0 + sl * KSLOT;
#pragma unroll
                for (int d0 = 0; d0 < 4; ++d0) {
                    const bf16x8 k0 = *(const __attribute__((address_space(3))) bf16x8*)(kp + d0 * 2048), k1 = *(const __attribute__((address_space(3))) bf16x8*)(kp + d0 * 2048 + 512);
                    p0 = __builtin_amdgcn_mfma_f32_32x32x16_bf16(k0, qr[d0], p0, 0, 0, 0);
                    p1 = __builtin_amdgcn_mfma_f32_32x32x16_bf16(k1, qr[d0], p1, 0, 0, 0);
                }
                float rm = fmaxf(p0[0], p1[0]);
#pragma unroll
                for (int r = 1; r < 16; ++r) rm = fmaxf(rm, fmaxf(p0[r], p1[r]));
                rm = swap_max(rm);
                const float dl = (t == 0) ? C2 * rm : fmaxf(C2 * rm, 0.f);
                if (__any(dl != 0.f)) { const float f = __builtin_amdgcn_exp2f(-dl); l *= f;
#pragma unroll
                    for (int d0 = 0; d0 < 4; ++d0)
#pragma unroll
                        for (int r = 0; r < 16; ++r) oT[d0][r] *= f; }
                mu += dl;
                float ls = 0.f;
#pragma unroll
                for (int r = 0; r < 16; ++r) { p0[r] = __builtin_amdgcn_exp2f(p0[r] * C2 - dl); p1[r] = __builtin_amdgcn_exp2f(p1[r] * C2 - dl); ls += p0[r] + p1[r]; }
                l += ls;
                bf16x8 pw[4];
#pragma unroll
                for (int s = 0; s < 4; ++s) { u32x4 w;
#pragma unroll
                    for (int e = 0; e < 4; ++e) { const int r = 8 * (s & 1) + 2 * e; w[e] = (s < 2) ? cvtpk(p0[r], p0[r + 1]) : cvtpk(p1[r], p1[r + 1]); }
                    pw[s] = __builtin_bit_cast(bf16x8, w); }
                const lds_cptr vp = vp0 + sl * VSLOT;
#pragma unroll
                for (int d0 = 0; d0 < 4; ++d0) {
#pragma unroll
                    for (int s = 0; s < 4; ++s) { const s16x4 lo = vtr(vp + d0 * 4096 + s * 1024), hh = vtr(vp + d0 * 4096 + s * 1024 + 512);
                        const bf16x8 vf = (bf16x8){lo[0], lo[1], lo[2], lo[3], hh[0], hh[1], hh[2], hh[3]};
                        oT[d0] = __builtin_amdgcn_mfma_f32_32x32x16_bf16(vf, pw[s], oT[d0], 0, 0, 0); }
                    __builtin_amdgcn_sched_barrier(0); }
                mu -= 64.0f * slope2;
            }
            ATT_WAIT_BAR();
        }
        const float il = 1.0f / swap_sum(l);
        if (c == 0) {
#pragma unroll
            for (int d0 = 0; d0 < 4; ++d0)
#pragma unroll
                for (int r = 0; r < 16; r += 4) *(f32x4*)(st + d0 * 16 + r) = (f32x4){oT[d0][r] * il, oT[d0][r + 1] * il, oT[d0][r + 2] * il, oT[d0][r + 3] * il};
        } else {
            float ss = 0.f;
#pragma unroll
            for (int d0 = 0; d0 < 4; ++d0)
#pragma unroll
                for (int r = 0; r < 16; r += 4) { const f32x4 sv = *(const f32x4*)(st + d0 * 16 + r);
#pragma unroll
                    for (int e = 0; e < 4; ++e) { const float v = sv[e] - lam * (oT[d0][r + e] * il); oT[d0][r + e] = v; ss += v * v; } }
            ss = swap_sum(ss);
            const float rn = (1.0f / sqrtf(ss * (1.0f / 128.0f) + RMS_EPS)) * (1.0f - A.lam_init);
            bf16* op = A.mixed + (size_t)(q0 + r32) * DM + h * 128;
#pragma unroll
            for (int d0 = 0; d0 < 4; ++d0)
#pragma unroll
                for (int g4 = 0; g4 < 4; ++g4) { const int d = 32 * d0 + 8 * g4 + 4 * hi; const f32x4 gg = *(const f32x4*)(A.subln + d);
                    u32x2 w; w.x = cvtpk(oT[d0][4 * g4] * rn * gg[0], oT[d0][4 * g4 + 1] * rn * gg[1]); w.y = cvtpk(oT[d0][4 * g4 + 2] * rn * gg[2], oT[d0][4 * g4 + 3] * rn * gg[3]);
                    *(u32x2*)(op + d) = w; }
        }
    }
}
__device__ __forceinline__ void attn_phase(__attribute__((address_space(3))) unsigned char* lds, const Args& A, int blk, unsigned* ctr, volatile __attribute__((address_space(3))) unsigned* qslot) {
    const int tid = opq_tid(), lane = tid & 63;
    const float l0 = wave_sum(A.lq[lane] * A.lk[lane]), l1 = wave_sum(A.lq[64 + lane] * A.lk[64 + lane]);
    const float lam = __expf(l0) - __expf(l1) + A.lam_init;
    float* stash_blk = A.stash + (size_t)blk * (64 * 512);
    for (;;) {
        if (tid == 0) *qslot = __hip_atomic_fetch_add(ctr, 1u, __ATOMIC_RELAXED, __HIP_MEMORY_SCOPE_AGENT);
        asm volatile("s_waitcnt vmcnt(0) lgkmcnt(0)" ::: "memory"); __builtin_amdgcn_s_barrier(); asm volatile("" ::: "memory");
        const unsigned n = *qslot;
        asm volatile("s_waitcnt lgkmcnt(0)" ::: "memory"); __builtin_amdgcn_s_barrier(); asm volatile("" ::: "memory");
        if (n >= 512u) break;
        attn_unit(lds, A, (int)(n & 7u), 63 - (int)(n >> 3), lam, stash_blk);
    }
}
}

namespace rk {
typedef short bf16x8 __attribute__((ext_vector_type(8)));
typedef short s16x4 __attribute__((ext_vector_type(4)));
typedef short v4i16_t __attribute__((ext_vector_type(4)));
typedef const LAS unsigned char* lcp;
constexpr int ST = 72, MATB = 64 * ST * 2, NST = 68, SLG = 168, SVL = 40;
constexpr int O_AT = 0, O_RT = MATB, O_BT = 2 * MATB, O_KT = 3 * MATB, O_VV = 4 * MATB, O_AAK = 5 * MATB, O_ARB = 6 * MATB, O_ARK = 7 * MATB, O_NN = 8 * MATB, O_GG = O_NN + 64 * NST * 4,
              O_U0T = O_GG, O_WT = O_AAK, O_G2 = O_AAK  , O_VG = O_ARK  , O_SEG = O_GG + 64 * NST * 4, O_GL = O_SEG + 2048,
              O_LW = O_GL + 256, O_LA = O_LW + MATB, O_LG = O_LA + MATB, O_VL = O_LG + 64 * SLG * 2, O_END = O_VL + 64 * SVL * 2;
static_assert(64 * NST * 4 <= 2 * MATB && O_END <= 156000, "stage-1 LDS map");
__device__ __forceinline__ f32x4 mfma16(bf16x8 a, bf16x8 b, f32x4 c) { return __builtin_amdgcn_mfma_f32_16x16x32_bf16(a, b, c, 0, 0, 0); }
__device__ __forceinline__ s16x4 vtr(lcp p) { return __builtin_bit_cast(s16x4, __builtin_amdgcn_ds_read_tr16_b64_v4i16((LAS v4i16_t*)p)); }
__device__ __forceinline__ bf16x8 frag(lcp m, int row0, int ks, int lane, int st = ST) { return *(const LAS bf16x8*)(m + ((row0 + (lane & 15)) * st + 32 * ks + 8 * (lane >> 4)) * 2); }
__device__ __forceinline__ bf16x8 tfrag(lcp m, int c0, int ks, int lane) {
    const int i = lane & 15, q = i >> 2, p = i & 3, k0 = 32 * ks + 8 * (lane >> 4);
    const s16x4 lo = vtr(m + ((k0 + q) * ST + c0 + 4 * p) * 2), hi = vtr(m + ((k0 + 4 + q) * ST + c0 + 4 * p) * 2);
    return (bf16x8){lo[0], lo[1], lo[2], lo[3], hi[0], hi[1], hi[2], hi[3]};
}
__device__ __forceinline__ unsigned pk(float a, float b) { return f2bf(a) | (f2bf(b) << 16); }
#define RK_BAR() do { asm volatile("s_waitcnt vmcnt(0) lgkmcnt(0)" ::: "memory"); __builtin_amdgcn_s_barrier(); asm volatile("" ::: "memory"); } while (0)


template <int T> struct SolveRow {
    static __device__ __forceinline__ void load(f32x4 (&buf)[16], LAS unsigned char* lds) {
#pragma unroll
        for (int s4 = 0; s4 < 16; ++s4) if (s4 * 4 < T + 1) buf[s4] = *(const LAS f32x4*)(lds + ((T + 1) * NST + 4 * s4) * 4);
    }
    static __device__ __forceinline__ void run(float (&x)[64], f32x4 (&cur)[16], f32x4 (&nxt)[16], LAS unsigned char* lds) {
        if constexpr (T + 1 < 64) load(nxt, lds);
        asm volatile("" ::: "memory"); __builtin_amdgcn_sched_barrier(0);
        float acc = x[T];
#pragma unroll
        for (int s4 = 0; s4 < 16; ++s4)
#pragma unroll
            for (int e = 0; e < 4; ++e) if (4 * s4 + e < T) acc = __builtin_fmaf(cur[s4][e], x[4 * s4 + e], acc);
        x[T] = acc;
        asm volatile("" : "+v"(x[T]) :: "memory"); __builtin_amdgcn_sched_barrier(0);
        if constexpr (T + 1 < 64) SolveRow<T + 1>::run(x, nxt, cur, lds);
    }
};

struct S1Args {
    const bf16* rw; const float* mu; const float* w0; const float* a0; const float* v0; const float* k_k; const float* k_a; const float* r_k;
    const bf16* w2t; const bf16* a2t; const bf16* g2t; const bf16* v2t;
    bf16* vfirst; bf16* BV; bf16* GB; bf16* PG; float* QT; bf16* RP; float* Y0; int layer; int pad_;
};
__device__ __forceinline__ float ldbf(const bf16* p) { return bf2f(*p); }

__device__ __forceinline__ void stage1_latents(LAS unsigned char* lds, const S1Args& A, int t0) {
    const int tid = opq_tid();
    for (int idx = tid; idx < 64 * 320; idx += 512) {
        const int tok = idx / 320, col = idx % 320, t = t0 + tok;
        const bf16* p = A.rw + (size_t)t * RWP + 3072 + col;
        const float cur = ldbf(p);
        if (col < 288) {
            const float prev = t > 0 ? ldbf(p - RWP) : 0.f, sft = cur + A.mu[3072 + col] * (prev - cur);
            if (col < 64) *(LAS unsigned short*)(lds + O_LW + (tok * ST + col) * 2) = (unsigned short)f2bf(tanhf(sft));
            else if (col < 128) *(LAS unsigned short*)(lds + O_LA + (tok * ST + col - 64) * 2) = (unsigned short)f2bf(sft);
            else *(LAS unsigned short*)(lds + O_LG + (tok * SLG + col - 128) * 2) = (unsigned short)f2bf(sigmoidf_(sft));
        } else {
            const float x2 = t > 0 ? ldbf(p - RWP + 32) : 0.f;
            *(LAS unsigned short*)(lds + O_VL + (tok * SVL + col - 288) * 2) = (unsigned short)f2bf(cur + x2);
        }
    }
}

__device__ __forceinline__ void stage1_unit(LAS unsigned char* lds, const S1Args& A, int c, int h) {
    const int tid = opq_tid(), lane = tid & 63, wid = __builtin_amdgcn_readfirstlane(tid >> 6), rq = lane >> 4, l15 = lane & 15;
    const int t0 = c * 64, uc = h * 256 + c;
    const int b0 = wid >> 1;
    LAS float* SEG = (LAS float*)(lds + O_SEG); LAS float* GL = (LAS float*)(lds + O_GL);
    {
        const bf16x8 lw0 = frag(lds + O_LW, 16 * b0, 0, lane), lw1 = frag(lds + O_LW, 16 * b0, 1, lane), la0 = frag(lds + O_LA, 16 * b0, 0, lane), la1 = frag(lds + O_LA, 16 * b0, 1, lane);
        const bf16x8 lv0 = frag(lds + O_VL, 16 * b0, 0, lane, SVL);
        bf16x8 lg[5];
#pragma unroll
        for (int ks = 0; ks < 5; ++ks) lg[ks] = frag(lds + O_LG, 16 * b0, ks, lane, SLG);
#pragma unroll
        for (int cc = 0; cc < 2; ++cc) {
            const int cb = 2 * (wid & 1) + cc, jl = 16 * cb + l15, ch = h * 64 + jl;
            const f32x4 z = {0.f, 0.f, 0.f, 0.f};
            const bf16* pw = A.w2t + (size_t)ch * 64 + 8 * rq; const bf16* pa = A.a2t + (size_t)ch * 64 + 8 * rq; const bf16* pg = A.g2t + (size_t)ch * 160 + 8 * rq; const bf16* pv = A.v2t + (size_t)ch * 32 + 8 * rq;
            const f32x4 zw = mfma16(lw1, *(const bf16x8*)(pw + 32), mfma16(lw0, *(const bf16x8*)pw, z));
            const f32x4 za = mfma16(la1, *(const bf16x8*)(pa + 32), mfma16(la0, *(const bf16x8*)pa, z));
            f32x4 zg = z;
#pragma unroll
            for (int ks = 0; ks < 5; ++ks) zg = mfma16(lg[ks], *(const bf16x8*)(pg + 32 * ks), zg);
            const f32x4 zv = mfma16(lv0, *(const bf16x8*)pv, z);
            const float w0c = A.w0[ch], a0c = A.a0[ch], v0c = A.v0[ch];
#pragma unroll
            for (int e = 0; e < 4; ++e) {
                const int t = 16 * b0 + 4 * rq + e;
                const float zz = -(w0c + zw[e]), sp = fmaxf(zz, 0.f) + log1pf(__expf(-fabsf(zz))), wl = -sp - 0.5f;
                *(LAS float*)(lds + O_NN + (t * NST + jl) * 4) = -__expf(wl);
                *(LAS float*)(lds + O_GG + (t * NST + jl) * 4) = sigmoidf_(a0c + za[e]);
                *(LAS float*)(lds + O_G2 + (t * NST + jl) * 4) = zg[e];
                *(LAS unsigned short*)(lds + O_VG + (t * ST + jl) * 2) = (unsigned short)f2bf(sigmoidf_(v0c + zv[e]));
            }
        }
        RK_BAR();
    }
    {
        const int j = lane, ch = h * 64 + j; float lw[8], cum[8], va[8], vb[8], vk[8], vr_[8], vv[8];
        const float mur = A.mu[ch], muk = A.mu[1024 + ch], muv = A.mu[2048 + ch], kkw = A.k_k[ch], kaw = A.k_a[ch], rkw = A.r_k[ch];
        const int tf = t0 + 8 * wid;
        const bf16* rp = A.rw + (size_t)tf * RWP + ch;
        float pr = 0.f, pk_ = 0.f, pv = 0.f;
        if (tf > 0) { pr = ldbf(rp - RWP); pk_ = ldbf(rp - RWP + 1024); pv = ldbf(rp - RWP + 2048); }
#pragma unroll
        for (int e = 0; e < 8; ++e) {
            const float cr = ldbf(rp + (size_t)e * RWP), ck = ldbf(rp + (size_t)e * RWP + 1024), cv = ldbf(rp + (size_t)e * RWP + 2048);
            const float r = cr + mur * (pr - cr), kr = ck + muk * (pk_ - ck), vr = cv + muv * (pv - cv);
            pr = cr; pk_ = ck; pv = cv;
            const int tl = 8 * wid + e;
            lw[e] = *(const LAS float*)(lds + O_NN + (tl * NST + j) * 4);
            const float ar = *(const LAS float*)(lds + O_GG + (tl * NST + j) * 4), g = *(const LAS float*)(lds + O_G2 + (tl * NST + j) * 4);
            const float vg = bf2f(*(const LAS unsigned short*)(lds + O_VG + (tl * ST + j) * 2));
            const float kkv = kr * kkw, ss = wave_sum(kkv * kkv), kk = kkv * (1.0f / fmaxf(sqrtf(ss), 1e-12f));
            va[e] = -kk; vb[e] = kk * ar; vk[e] = kr * (1.0f + (ar - 1.0f) * kaw); vr_[e] = r;
            const size_t go = (size_t)(tf + e) * 1024 + ch;
            float v;
            if (A.layer == 0) { v = vr; A.vfirst[go] = (bf16)f2bf(vr); } else { v = vr + (bf2f(A.vfirst[go]) - vr) * vg; }
            vv[e] = v;
            const float bonus = wave_sum(r * vk[e] * rkw);
            A.BV[go] = (bf16)f2bf(bonus * v); A.GB[go] = (bf16)f2bf(g);
        }
        cum[0] = lw[0];
#pragma unroll
        for (int e = 1; e < 8; ++e) cum[e] = cum[e - 1] + lw[e];
        SEG[wid * 64 + j] = cum[7];
        RK_BAR();
        float off = 0.f, tot = 0.f;
#pragma unroll
        for (int s = 0; s < 8; ++s) { const float v = SEG[s * 64 + j]; off += (s < wid) ? v : 0.f; tot += v; }
        if (wid == 0) GL[j] = __expf(tot);
#pragma unroll
        for (int e = 0; e < 8; ++e) {
            const float cm = cum[e] + off, g = __expf(cm), gi = __expf(-cm), gp = __expf(cm - lw[e]);
            const int o = ((8 * wid + e) * ST + j) * 2;
            *(LAS unsigned short*)(lds + O_AT + o) = (unsigned short)f2bf(va[e] * gp);
            *(LAS unsigned short*)(lds + O_BT + o) = (unsigned short)f2bf(vb[e] * gi);
            *(LAS unsigned short*)(lds + O_KT + o) = (unsigned short)f2bf(vk[e] * gi);
            *(LAS unsigned short*)(lds + O_RT + o) = (unsigned short)f2bf(vr_[e] * g);
            *(LAS unsigned short*)(lds + O_VV + o) = (unsigned short)f2bf(vv[e]);
        }
        RK_BAR();
    }
    {
        const bf16x8 bA0 = frag(lds + O_BT, 16 * b0, 0, lane), bA1 = frag(lds + O_BT, 16 * b0, 1, lane), kA0 = frag(lds + O_KT, 16 * b0, 0, lane), kA1 = frag(lds + O_KT, 16 * b0, 1, lane);
#pragma unroll
        for (int tt = 0; tt < 2; ++tt) {
            const int tb = 2 * (wid & 1) + tt;
            const bf16x8 aB0 = frag(lds + O_AT, 16 * tb, 0, lane), aB1 = frag(lds + O_AT, 16 * tb, 1, lane), rB0 = frag(lds + O_RT, 16 * tb, 0, lane), rB1 = frag(lds + O_RT, 16 * tb, 1, lane);
            const f32x4 z = {0.f, 0.f, 0.f, 0.f};
            f32x4 ab = mfma16(bA1, aB1, mfma16(bA0, aB0, z)), ak = mfma16(kA1, aB1, mfma16(kA0, aB0, z)), rb = mfma16(bA1, rB1, mfma16(bA0, rB0, z)), rk_ = mfma16(kA1, rB1, mfma16(kA0, rB0, z));
            const int tcol = 16 * tb + l15, srow = 16 * b0 + 4 * rq;
#pragma unroll
            for (int e = 0; e < 4; ++e) { const bool st = tcol > srow + e, le = tcol >= srow + e; ab[e] = st ? ab[e] : 0.f; ak[e] = st ? ak[e] : 0.f; rb[e] = le ? rb[e] : 0.f; rk_[e] = le ? rk_[e] : 0.f; }
            *(LAS f32x4*)(lds + O_NN + (tcol * NST + srow) * 4) = ab;
            const int o = (tcol * ST + srow) * 2;
            *(LAS u32x2*)(lds + O_AAK + o) = (u32x2){pk(ak[0], ak[1]), pk(ak[2], ak[3])};
            *(LAS u32x2*)(lds + O_ARB + o) = (u32x2){pk(rb[0], rb[1]), pk(rb[2], rb[3])};
            *(LAS u32x2*)(lds + O_ARK + o) = (u32x2){pk(rk_[0], rk_[1]), pk(rk_[2], rk_[3])};
        }
        RK_BAR();
    }
    {
        const bf16x8 vA0 = tfrag(lds + O_VV, 16 * b0, 0, lane), vA1 = tfrag(lds + O_VV, 16 * b0, 1, lane);
#pragma unroll
        for (int tt = 0; tt < 2; ++tt) {
            const int tb = 2 * (wid & 1) + tt;
            const f32x4 z = {0.f, 0.f, 0.f, 0.f};
            const f32x4 g = mfma16(vA1, frag(lds + O_AAK, 16 * tb, 1, lane), mfma16(vA0, frag(lds + O_AAK, 16 * tb, 0, lane), z));
            *(LAS f32x4*)(lds + O_GG + ((16 * tb + l15) * NST + 16 * b0 + 4 * rq) * 4) = g;
        }
        RK_BAR();
    }
    if (wid < 2) {
        float x[64];
        if (wid == 0) {
#pragma unroll
            for (int t = 0; t < 64; ++t) x[t] = bf2f(*(const LAS unsigned short*)(lds + O_AT + (t * ST + lane) * 2));
        } else {
#pragma unroll
            for (int t = 0; t < 64; ++t) x[t] = *(const LAS float*)(lds + O_GG + (t * NST + lane) * 4);
        }
        f32x4 na[16], nb[16];
        LAS unsigned char* nn = lds + O_NN; asm volatile("" : "+v"(nn));
        SolveRow<0>::load(na, nn);
        SolveRow<1>::run(x, na, nb, nn);
        LAS unsigned char* dst = lds + (wid == 0 ? O_WT : O_U0T) + lane * ST * 2;
#pragma unroll
        for (int i = 0; i < 8; ++i) *(LAS u32x4*)(dst + i * 16) = (u32x4){pk(x[8 * i], x[8 * i + 1]), pk(x[8 * i + 2], x[8 * i + 3]), pk(x[8 * i + 4], x[8 * i + 5]), pk(x[8 * i + 6], x[8 * i + 7])};
    }
    RK_BAR();
    {
        const bf16x8 wA0 = frag(lds + O_WT, 16 * b0, 0, lane), wA1 = frag(lds + O_WT, 16 * b0, 1, lane);
        const bf16x8 uA0 = frag(lds + O_U0T, 16 * b0, 0, lane), uA1 = frag(lds + O_U0T, 16 * b0, 1, lane);
        const bf16x8 vA0 = tfrag(lds + O_VV, 16 * b0, 0, lane), vA1 = tfrag(lds + O_VV, 16 * b0, 1, lane);
        const bf16x8 bA0 = tfrag(lds + O_BT, 16 * b0, 0, lane), bA1 = tfrag(lds + O_BT, 16 * b0, 1, lane);
        const bf16x8 kA0 = tfrag(lds + O_KT, 16 * b0, 0, lane), kA1 = tfrag(lds + O_KT, 16 * b0, 1, lane);
        const f32x4 glr = *(const LAS f32x4*)(lds + O_GL + (16 * b0 + 4 * rq) * 4);
#pragma unroll
        for (int tt = 0; tt < 2; ++tt) {
            const int nb = 2 * (wid & 1) + tt, col = 16 * nb + l15, row = 16 * b0 + 4 * rq;
            const f32x4 z = {0.f, 0.f, 0.f, 0.f};
            const bf16x8 rbB0 = frag(lds + O_ARB, 16 * nb, 0, lane), rbB1 = frag(lds + O_ARB, 16 * nb, 1, lane), rkB0 = frag(lds + O_ARK, 16 * nb, 0, lane), rkB1 = frag(lds + O_ARK, 16 * nb, 1, lane);
            { f32x4 d = mfma16(wA1, rbB1, mfma16(wA0, rbB0, z)); const u32x2 rt = *(const LAS u32x2*)(lds + O_RT + (col * ST + row) * 2);
              d[0] += bflo(rt.x); d[1] += bfhi(rt.x); d[2] += bflo(rt.y); d[3] += bfhi(rt.y);
              *(u32x2*)(A.RP + (size_t)(t0 + col) * 1024 + h * 64 + row) = (u32x2){pk(d[0], d[1]), pk(d[2], d[3])}; }
            { const f32x4 d = mfma16(vA1, rkB1, mfma16(vA0, rkB0, mfma16(uA1, rbB1, mfma16(uA0, rbB0, z))));
              *(f32x4*)(A.Y0 + (size_t)(t0 + col) * 1024 + h * 64 + row) = d; }
            { const bf16x8 bB0 = tfrag(lds + O_BT, 16 * nb, 0, lane), bB1 = tfrag(lds + O_BT, 16 * nb, 1, lane);
              f32x4 d = mfma16(wA1, bB1, mfma16(wA0, bB0, z)); const float gj = GL[col];
#pragma unroll
              for (int e = 0; e < 4; ++e) d[e] = gj * (d[e] + ((row + e) == col ? 1.f : 0.f));
              *(u32x2*)(A.PG + (size_t)uc * 4096 + ((((col >> 4) * 2 + (row >> 5)) * 64 + ((row >> 2) & 3) * 16 + (col & 15)) * 8 + ((row >> 4) & 1) * 4)) = (u32x2){pk(d[0], d[1]), pk(d[2], d[3])}; }
            { const bf16x8 uB0 = frag(lds + O_U0T, 16 * nb, 0, lane), uB1 = frag(lds + O_U0T, 16 * nb, 1, lane), vB0 = tfrag(lds + O_VV, 16 * nb, 0, lane), vB1 = tfrag(lds + O_VV, 16 * nb, 1, lane);
              f32x4 d = mfma16(kA1, vB1, mfma16(kA0, vB0, mfma16(bA1, uB1, mfma16(bA0, uB0, z))));
              d = d * glr;
              *(f32x4*)(A.QT + (size_t)uc * 4096 + ((((col >> 4) * 4 + (row >> 4)) * 64 + ((row >> 2) & 3) * 16 + (col & 15)) * 4)) = d; }
        }
    }
    RK_BAR();
}
__device__ __forceinline__ void ph_stage1(LAS unsigned char* lds, const S1Args& A, int blk, int nblk) {
    for (int c = blk; c < 256; c += nblk) {
        stage1_latents(lds, A, c * 64);
        RK_BAR();
#pragma unroll 1
        for (int h = 0; h < 16; ++h) stage1_unit(lds, A, c, h);
    }
}

struct ChainOps { bf16x8 a[4][2]; f32x4 c[4]; };
__device__ __forceinline__ void chain_load(ChainOps& o, const bf16* __restrict__ PG, const float* __restrict__ QT, int h, int ig, int c, int lane) {
    const bf16* P = PG + (size_t)(h * 256 + c) * 4096 + lane * 8; const float* Q = QT + (size_t)(h * 256 + c) * 4096 + (ig * 4 * 64 + lane) * 4;
#pragma unroll
    for (int m = 0; m < 4; ++m) { o.c[m] = *(const f32x4*)(Q + m * 256);
#pragma unroll
        for (int kb = 0; kb < 2; ++kb) o.a[m][kb] = *(const bf16x8*)(P + (m * 2 + kb) * 512); }
}
__device__ __forceinline__ void chain_step(f32x4 (&H)[4], const ChainOps& o, bf16* __restrict__ H0T, int h, int ig, int c, int lane) {
    const int fr = lane & 15, fq = lane >> 4;
    bf16* Ho = H0T + (size_t)(c * 16 + h) * 4096 + (16 * ig + fr) * 64 + 4 * fq;
    u32x4 bw[2];
#pragma unroll
    for (int m = 0; m < 4; ++m) { const u32x2 w = {pk(H[m][0], H[m][1]), pk(H[m][2], H[m][3])}; *(u32x2*)(Ho + 16 * m) = w; bw[m >> 1][2 * (m & 1)] = w.x; bw[m >> 1][2 * (m & 1) + 1] = w.y; }
#pragma unroll
    for (int m = 0; m < 4; ++m) H[m] = mfma16(o.a[m][1], __builtin_bit_cast(bf16x8, bw[1]), mfma16(o.a[m][0], __builtin_bit_cast(bf16x8, bw[0]), o.c[m]));
}
__device__ __forceinline__ void chain_wave(const bf16* __restrict__ PG, const float* __restrict__ QT, bf16* __restrict__ H0T, int h, int ig, int lane) {
    f32x4 H[4];
#pragma unroll
    for (int m = 0; m < 4; ++m) H[m] = (f32x4){0.f, 0.f, 0.f, 0.f};
    ChainOps s0, s1, s2, s3;
    chain_load(s0, PG, QT, h, ig, 0, lane); chain_load(s1, PG, QT, h, ig, 1, lane); chain_load(s2, PG, QT, h, ig, 2, lane); chain_load(s3, PG, QT, h, ig, 3, lane);
#pragma unroll 1
    for (int c = 0; c < 256; c += 4) {
        const bool more = c + 4 < 256;
        chain_step(H, s0, H0T, h, ig, c, lane);     if (more) chain_load(s0, PG, QT, h, ig, c + 4, lane);
        chain_step(H, s1, H0T, h, ig, c + 1, lane); if (more) chain_load(s1, PG, QT, h, ig, c + 5, lane);
        chain_step(H, s2, H0T, h, ig, c + 2, lane); if (more) chain_load(s2, PG, QT, h, ig, c + 6, lane);
        chain_step(H, s3, H0T, h, ig, c + 3, lane); if (more) chain_load(s3, PG, QT, h, ig, c + 7, lane);
    }
}
__device__ __forceinline__ void ph_chain(const bf16* PG, const float* QT, bf16* H0T, int blk, int nblk) {
    const int tid = opq_tid(), lane = tid & 63;
    for (int gw = blk * 8 + (tid >> 6); gw < 64; gw += nblk * 8) chain_wave(PG, QT, H0T, gw >> 2, gw & 3, lane);
}

struct S3Args { const bf16* H0T; const bf16* RP; const float* Y0; const bf16* BV; const bf16* GB; const float* ln_w; const float* ln_b; bf16* mixed; };
__device__ __forceinline__ void ph_stage3(const S3Args& A, int blk, int nblk) {
    const int tid = opq_tid(), lane = tid & 63, fr = lane & 15, fq = lane >> 4;
    for (int it = blk * 8 + (tid >> 6); it < 4096 * 4; it += nblk * 8) {
        const int u = it >> 2, tb = it & 3, c = u >> 4, h = u & 15, t = 64 * c + 16 * tb + fr;
        const bf16* Hp = A.H0T + (size_t)u * 4096 + fr * 64 + 8 * fq; const bf16* Rp = A.RP + (size_t)t * 1024 + h * 64 + 8 * fq;
        const bf16x8 r0 = *(const bf16x8*)Rp, r1 = *(const bf16x8*)(Rp + 32);
        f32x4 y[4];
#pragma unroll
        for (int ib = 0; ib < 4; ++ib) { const f32x4 y0 = *(const f32x4*)(A.Y0 + (size_t)t * 1024 + h * 64 + 16 * ib + 4 * fq);
            y[ib] = mfma16(*(const bf16x8*)(Hp + ib * 1024 + 32), r1, mfma16(*(const bf16x8*)(Hp + ib * 1024), r0, y0)); }
        float s = 0.f;
#pragma unroll
        for (int ib = 0; ib < 4; ++ib) s += (y[ib][0] + y[ib][1]) + (y[ib][2] + y[ib][3]);
        s += __shfl_xor(s, 16); s += __shfl_xor(s, 32);
        const float mean = s * (1.0f / 64.0f); float q = 0.f;
#pragma unroll
        for (int ib = 0; ib < 4; ++ib)
#pragma unroll
            for (int e = 0; e < 4; ++e) { const float d = y[ib][e] - mean; y[ib][e] = d; q += d * d; }
        q += __shfl_xor(q, 16); q += __shfl_xor(q, 32);
        const float rstd = 1.0f / sqrtf(q * (1.0f / 64.0f) + GN_EPS);
#pragma unroll
        for (int ib = 0; ib < 4; ++ib) { const int ch = h * 64 + 16 * ib + 4 * fq; const size_t o = (size_t)t * 1024 + ch;
            const f32x4 lw = *(const f32x4*)(A.ln_w + ch), lb = *(const f32x4*)(A.ln_b + ch); const u32x2 bv = *(const u32x2*)(A.BV + o), gg = *(const u32x2*)(A.GB + o); f32x4 r;
            const float bvf[4] = {bflo(bv.x), bfhi(bv.x), bflo(bv.y), bfhi(bv.y)}, ggf[4] = {bflo(gg.x), bfhi(gg.x), bflo(gg.y), bfhi(gg.y)};
#pragma unroll
            for (int e = 0; e < 4; ++e) r[e] = (y[ib][e] * rstd * lw[e] + lb[e] + bvf[e]) * ggf[e];
            *(u32x2*)(A.mixed + (size_t)t * DM + 1024 + ch) = (u32x2){pk(r[0], r[1]), pk(r[2], r[3])}; }
    }
}
}
#define XB_TMO      128
#define XB_XCNT(j)  (256  + 64 * (j))
#define XB_XSUB(j)  (1280 + 64 * (j))
#define XB_XGEN(j)  (2304 + 64 * (j))
#define XB_TOP      3328
#define XB_TOPGEN   3392
#define XCD_BAR_WORDS 3456
#define XB_SPIN_CAP (1u << 22)

__device__ __forceinline__ unsigned xb_ld(unsigned* p)              { return __hip_atomic_load(p, __ATOMIC_RELAXED, __HIP_MEMORY_SCOPE_AGENT); }
__device__ __forceinline__ unsigned xb_add(unsigned* p, unsigned v) { return __hip_atomic_fetch_add(p, v, __ATOMIC_RELAXED, __HIP_MEMORY_SCOPE_AGENT); }
__device__ __forceinline__ unsigned xb_xcc_id() { return (unsigned)__builtin_amdgcn_s_getreg((3 << 11) | 20) & 0xFu; }
#define XB_SPIN(cond, bar) do { unsigned _sp = 0; while (cond) { __builtin_amdgcn_s_sleep(1); \
    if ((++_sp & 255u) == 0u) { if (xb_ld(&(bar)[XB_TMO])) break; if (_sp > XB_SPIN_CAP) { atomicAdd(&(bar)[XB_TMO], 1u); break; } } } } while (0)

struct XcdBarrier {
    unsigned* bar; unsigned x;
    volatile LAS unsigned* st;
};

__device__ __forceinline__ XcdBarrier xcd_barrier_post(unsigned* bar, volatile LAS unsigned* st) {
    XcdBarrier b; b.bar = bar; b.x = xb_xcc_id(); b.st = st;
    if (threadIdx.x == 0) (void)xb_add(&bar[XB_XCNT(b.x)], 1u);
    return b;
}
__device__ __forceinline__ void xcd_barrier_complete(unsigned* bar, unsigned x, unsigned& nloc, unsigned& nx) {
    const unsigned G = gridDim.x * gridDim.y * gridDim.z;
    unsigned sum, cnt, mine, sp = 0u;
    for (;;) {
        sum = 0u; cnt = 0u; mine = 0u;
#pragma unroll
        for (unsigned j = 0; j < 16; ++j) { const unsigned c = xb_ld(&bar[XB_XCNT(j)]); sum += c; cnt += (c > 0u) ? 1u : 0u; mine = (j == x) ? c : mine; }
        if (sum == G) break;
        __builtin_amdgcn_s_sleep(1);
        if ((++sp & 255u) == 0u) { if (xb_ld(&bar[XB_TMO])) break; if (sp > XB_SPIN_CAP) { atomicAdd(&bar[XB_TMO], 1u); break; } }
    }
    nloc = mine > 0u ? mine : 1u; nx = cnt > 0u ? cnt : 1u;
}

__device__ __forceinline__ void xcd_barrier(const XcdBarrier& b) {
    asm volatile("s_waitcnt vmcnt(0)" ::: "memory");
    __syncthreads();
    if (threadIdx.x == 0) {
        unsigned* bar = b.bar;
        __builtin_amdgcn_s_waitcnt(0);
        unsigned nloc = b.st[0], nx = b.st[1];
        if (nloc == 0u) { xcd_barrier_complete(bar, b.x, nloc, nx); b.st[0] = nloc; b.st[1] = nx; }
        const unsigned old = xb_add(&bar[XB_XSUB(b.x)], 1u);
        const unsigned gen = old / nloc;
        if (old + 1u == (gen + 1u) * nloc) {
            __builtin_amdgcn_fence(__ATOMIC_RELEASE, "agent");
            asm volatile("s_waitcnt vmcnt(0)" ::: "memory");
            const unsigned og = xb_add(&bar[XB_TOP], 1u);
            const unsigned tg = og / nx;
            if (og + 1u == (tg + 1u) * nx) xb_add(&bar[XB_TOPGEN], 1u);
            else XB_SPIN(xb_ld(&bar[XB_TOPGEN]) == tg, bar);
            __builtin_amdgcn_fence(__ATOMIC_ACQUIRE, "agent");
            xb_add(&bar[XB_XGEN(b.x)], 1u);
            asm volatile("s_waitcnt vmcnt(0)" ::: "memory");
        } else {
            XB_SPIN(xb_ld(&bar[XB_XGEN(b.x)]) == gen, bar);
            __builtin_amdgcn_fence(__ATOMIC_ACQUIRE, "agent");
            asm volatile("s_waitcnt vmcnt(0)" ::: "memory");
        }
    }
    __syncthreads();
}

constexpr size_t MiB = 1u << 20;
constexpr size_t WS_CTL = 0, CTL_ZERO_BYTES = 64 * 1024, WS_RINV = 1 * MiB, WS_WIN = 2 * MiB, WS_WOUT = 28 * MiB, WS_WUP = 36 * MiB, WS_WDOWN = 68 * MiB, WS_LORA = 100 * MiB, WS_XB = 102 * MiB,
                 WS_Q = 166 * MiB, WS_K = 198 * MiB, WS_V = 230 * MiB, WS_RW = 262 * MiB, WS_MIXED = 374 * MiB, WS_U = 166 * MiB, WS_VFIRST = 438 * MiB, WS_PG = 470 * MiB, WS_QT = 502 * MiB, WS_RP = 566 * MiB,
                 WS_Y0 = 598 * MiB, WS_H0T = 662 * MiB, WS_BV = 694 * MiB, WS_GB = 726 * MiB, WS_STASH = 758 * MiB, WS_END = 790 * MiB;
constexpr size_t LORA_W2 = 0, LORA_A2 = 1024 * 64 * 2, LORA_G2 = 2 * 1024 * 64 * 2, LORA_V2 = LORA_G2 + 1024 * 160 * 2;
constexpr int CW_BAR = 1024, CW_ATTQ = 512;
constexpr int RING_BYTES = 131072, MISC_OFF = 156000, LDS_BYTES = 156672;

struct Args { const float* in[26]; float* out; unsigned char* ws; int ph_lo, ph_hi; float lam_init[4]; };

template <bool PERMIN> __device__ __forceinline__ void convw_tile(LAS float* tile, const float* __restrict__ src, bf16* __restrict__ dst, const float* __restrict__ g, int K, int N, int item, int nkb, bool skipx = false) {
    const int k0 = (item % nkb) * 64, c0 = (item / nkb) * 64, tid = opq_tid();
    for (int i = tid; i < 64 * 64; i += 512) {
        const int kk = i >> 6, cc = i & 63, cp = c0 + cc; int col = cp;
        if (PERMIN) { const int lo = cp & 255, bj = lo >> 7, wc = (lo >> 5) & 3, j = lo & 31; col = (cp & ~255) + 64 * wc + 32 * bj + j; }
        float v = 0.f;
        if (col < N) { v = src[(size_t)(k0 + kk) * N + col]; if (g) v *= g[k0 + kk]; }
        tile[kk * 65 + cc] = v;
    }
    __syncthreads();
    for (int i = tid; i < 64 * 32; i += 512) {
        const int cc = i >> 5, kp = (i & 31) * 2, cp = c0 + cc;
        if (PERMIN && skipx && ((cp >= 6432 && cp < 6464) || (cp >= 6528 && cp < 6560))) continue;
        *(unsigned*)(dst + (size_t)cp * K + k0 + kp) = f2bf(tile[kp * 65 + cc]) | (f2bf(tile[(kp + 1) * 65 + cc]) << 16);
    }
    __syncthreads();
}
__device__ __forceinline__ void ph_convw(LAS unsigned char* lds, const __attribute__((address_space(4))) Args* a, int l, int blk, int nblk) {
    LAS float* tile = (LAS float*)lds; unsigned char* ws = a->ws;
    constexpr int I_IN = (DM / 64) * (NIN / 64), I_OUT = (DM / 64) * (DM / 64), I_UP = (DM / 64) * (DFF / 64), I_DN = (DFF / 64) * (DM / 64);
    for (int it = blk; it < I_IN + I_OUT + I_UP + I_DN; it += nblk) {
        int r = it;
        if (r < I_IN) { convw_tile<true>(tile, a->in[3] + (size_t)l * DM * PW, (bf16*)(ws + WS_WIN), a->in[1] + (size_t)l * DM, DM, PW, r, DM / 64, l > 0); continue; } r -= I_IN;
        if (r < I_OUT) { convw_tile<false>(tile, a->in[4] + (size_t)l * DM * DM, (bf16*)(ws + WS_WOUT), nullptr, DM, DM, r, DM / 64); continue; } r -= I_OUT;
        if (r < I_UP) { convw_tile<false>(tile, a->in[24] + (size_t)l * DM * DFF, (bf16*)(ws + WS_WUP), a->in[2] + (size_t)l * DM, DM, DFF, r, DM / 64); continue; } r -= I_UP;
        convw_tile<false>(tile, a->in[25] + (size_t)l * DFF * DM, (bf16*)(ws + WS_WDOWN), nullptr, DFF, DM, r, DFF / 64);
    }
    { const int tid = opq_tid(); const int lm = l > 0 ? l - 1 : 0;
      const float* w2 = a->in[12] + (size_t)l * 64 * 1024; const float* a2 = a->in[14] + (size_t)l * 64 * 1024; const float* g2 = a->in[15] + (size_t)l * 160 * 1024; const float* v2 = a->in[23] + (size_t)lm * 32 * 1024;
      bf16* lw = (bf16*)(ws + WS_LORA);
      for (int i = blk * 512 + tid; i < 1024 * 320; i += nblk * 512) {
          const int ch = i / 320, k = i % 320;
          if (k < 64) lw[LORA_W2 / 2 + ch * 64 + k] = (bf16)f2bf(w2[(size_t)k * 1024 + ch]);
          else if (k < 128) lw[LORA_A2 / 2 + ch * 64 + k - 64] = (bf16)f2bf(a2[(size_t)(k - 64) * 1024 + ch]);
          else if (k < 288) lw[LORA_G2 / 2 + ch * 160 + k - 128] = (bf16)f2bf(g2[(size_t)(k - 128) * 1024 + ch]);
          else lw[LORA_V2 / 2 + ch * 32 + k - 288] = (bf16)f2bf(v2[(size_t)(k - 288) * 1024 + ch]);
      } }
    if (l > 0) {
        const int tid = opq_tid(), kk = tid >> 6, o = tid & 63;
        const float* win = a->in[3] + (size_t)l * DM * PW; const float* g1 = a->in[1] + (size_t)l * DM; const float* muv = a->in[10] + (size_t)l * 3360 + 2048; const float* v1 = a->in[22] + (size_t)(l - 1) * 1024 * 32;
        bf16* wt = (bf16*)(ws + WS_WIN);
        for (int k0 = blk * 8; k0 < DM; k0 += nblk * 8) {
            const int k = k0 + kk; const float* wr = win + (size_t)k * PW + 5120; float acc = 0.f;
#pragma unroll 8
            for (int c = 0; c < 1024; ++c) { const float m = muv[c]; acc += wr[c] * ((o < 32) ? 1.0f - m : m) * v1[c * 32 + (o & 31)]; }
            const int row = (o < 32) ? 6528 + o : 6400 + o;
            wt[(size_t)row * DM + k] = (bf16)f2bf(acc * g1[k]);
        }
    }
}
__device__ __forceinline__ void ph_rownorm(const float* __restrict__ src, float* __restrict__ copy, bf16* __restrict__ xb, float* __restrict__ rinv, int blk, int nblk) {
    const int tid_ = opq_tid(), lane = tid_ & 63, gw = blk * 8 + (tid_ >> 6), ngw = nblk * 8;
    for (int row = gw; row < T_; row += ngw) {
        const f32x4* s = (const f32x4*)(src + (size_t)row * DM);
        float ss = 0.f;
#pragma unroll
        for (int j = 0; j < 8; ++j) { const f32x4 v = s[lane + 64 * j]; ss += (v[0] * v[0] + v[1] * v[1]) + (v[2] * v[2] + v[3] * v[3]);
            if (copy) ((f32x4*)(copy + (size_t)row * DM))[lane + 64 * j] = v;
            u32x2 w; w.x = f2bf(v[0]) | (f2bf(v[1]) << 16); w.y = f2bf(v[2]) | (f2bf(v[3]) << 16);
            ((u32x2*)(xb + (size_t)row * DM))[lane + 64 * j] = w; }
        ss = wave_sum(ss);
        if (lane == 0) rinv[row] = 1.0f / sqrtf(ss * (1.0f / DM) + RMS_EPS);
    }
}

constexpr int NPH = 9;
#ifndef PROBE_PH
#define PROBE_PH -1
#endif
#ifndef PROBE_REP
#define PROBE_REP 1
#endif
#define REP(k) for (int rep_ = 0; rep_ < ((k) == PROBE_PH ? PROBE_REP : 1); ++rep_)
typedef const __attribute__((address_space(4))) Args* CArgs;
__device__ __forceinline__ CArgs kargs() { CArgs p = (CArgs)__builtin_amdgcn_kernarg_segment_ptr(); asm volatile("" : "+s"(p)); return p; }
__global__ void __launch_bounds__(512, 2) fwd(Args args_unused) {
    extern __shared__ __attribute__((aligned(16))) unsigned char lds_raw[];
    LAS unsigned char* lds = (LAS unsigned char*)lds_raw;
    volatile LAS unsigned* MISC = (volatile LAS unsigned*)(lds + MISC_OFF);
    const int blk = (int)blockIdx.x, nblk = (int)gridDim.x;
    if (threadIdx.x < 32) MISC[threadIdx.x] = 0u;
    __syncthreads();
    int lo, hi; XcdBarrier bar;
    { CArgs ap = kargs(); lo = ap->ph_lo; hi = ap->ph_hi; unsigned* bw = (unsigned*)(ap->ws + WS_CTL) + CW_BAR; bar.bar = bw; bar.x = 0; bar.st = nullptr;
      if (hi - lo > 1) bar = xcd_barrier_post(bw, MISC + 8); }
#define IN(k) (lo <= (k) && (k) < hi)
#define SEAM(k) do { if (IN(k) && IN((k) + 1)) xcd_barrier(bar); } while (0)
#define WSP(T, off) ((T*)(ws + (off)))
#pragma unroll 1
    for (int l = 0; l < NL; ++l) {
        const int pb = l * NPH;
        if (IN(pb + 0)) REP(0) {
            CArgs ap = kargs(); unsigned char* ws = ap->ws;
            ph_convw(lds, ap, l, blk, nblk);
            ph_rownorm(l == 0 ? ap->in[0] : ap->out, l == 0 ? ap->out : nullptr, WSP(bf16, WS_XB), WSP(float, WS_RINV), blk, nblk);
        }
        SEAM(pb + 0);
        if (IN(pb + 1)) REP(1) {
            CArgs ap = kargs(); unsigned char* ws = ap->ws;
            pg8::Gemm g{WSP(bf16, WS_XB), WSP(bf16, WS_WIN), T_, NIN, DM, 0}; pg8::StaticOrder S; S.init(T_, NIN, nblk, blk);
            pg8::EpiIn E{WSP(float, WS_RINV), WSP(bf16, WS_Q), WSP(bf16, WS_K), WSP(bf16, WS_V), WSP(bf16, WS_RW), ap->in[5] + l * 128, ap->in[6] + l * 128};
            pg8::gemm_phase<pg8::EpiIn, pg8::StaticOrder, true, true>(lds, g, S, E);
        }
        SEAM(pb + 1);
        if (IN(pb + 2)) REP(2) {
            CArgs ap = kargs(); unsigned char* ws = ap->ws; const int lm = l > 0 ? l - 1 : 0;
            rk::S1Args A; A.rw = WSP(bf16, WS_RW); A.mu = ap->in[10] + (size_t)l * 3360; A.w0 = ap->in[11] + l * 1024; A.a0 = ap->in[13] + l * 1024; A.v0 = ap->in[21] + lm * 1024; A.k_k = ap->in[16] + l * 1024; A.k_a = ap->in[17] + l * 1024;
            A.r_k = ap->in[18] + l * 1024; A.w2t = (const bf16*)(ws + WS_LORA + LORA_W2); A.a2t = (const bf16*)(ws + WS_LORA + LORA_A2); A.g2t = (const bf16*)(ws + WS_LORA + LORA_G2); A.v2t = (const bf16*)(ws + WS_LORA + LORA_V2);
            A.vfirst = WSP(bf16, WS_VFIRST); A.BV = WSP(bf16, WS_BV); A.GB = WSP(bf16, WS_GB); A.PG = WSP(bf16, WS_PG); A.QT = WSP(float, WS_QT); A.RP = WSP(bf16, WS_RP); A.Y0 = WSP(float, WS_Y0); A.layer = l; A.pad_ = 0;
            rk::ph_stage1(lds, A, blk, nblk);
        }
        SEAM(pb + 2);
        if (IN(pb + 3)) {
            CArgs ap = kargs(); unsigned char* ws = ap->ws;
            rk::ph_chain(WSP(bf16, WS_PG), WSP(float, WS_QT), WSP(bf16, WS_H0T), blk, nblk);
            att::Args A; A.Q = WSP(bf16, WS_Q); A.K = WSP(bf16, WS_K); A.V = WSP(bf16, WS_V); A.mixed = WSP(bf16, WS_MIXED); A.stash = WSP(float, WS_STASH); A.lq = ap->in[7] + l * 128; A.lk = ap->in[8] + l * 128; A.subln = ap->in[9] + l * 128;
            A.lam_init = ap->lam_init[l]; A.pad_ = 0;
            att::attn_phase(lds, A, blk, (unsigned*)(ws + WS_CTL) + CW_ATTQ + 64 * l, MISC + 16);
        }
        SEAM(pb + 3);
        if (IN(pb + 4)) REP(4) {
            CArgs ap = kargs(); unsigned char* ws = ap->ws;
            rk::S3Args A{WSP(bf16, WS_H0T), WSP(bf16, WS_RP), WSP(float, WS_Y0), WSP(bf16, WS_BV), WSP(bf16, WS_GB), ap->in[19] + l * 1024, ap->in[20] + l * 1024, WSP(bf16, WS_MIXED)};
            rk::ph_stage3(A, blk, nblk);
        }
        SEAM(pb + 4);
        if (IN(pb + 5)) {
            CArgs ap = kargs(); unsigned char* ws = ap->ws;
            pg8::Gemm g{WSP(bf16, WS_MIXED), WSP(bf16, WS_WOUT), T_, DM, DM, 0}; pg8::StaticOrder S; S.init(T_, DM, nblk, blk);
            pg8::EpiRes E{ap->out, DM, 0};
            pg8::gemm_phase<pg8::EpiRes, pg8::StaticOrder, true, true>(lds, g, S, E);
        }
        SEAM(pb + 5);
        if (IN(pb + 6)) { CArgs ap = kargs(); unsigned char* ws = ap->ws; ph_rownorm(ap->out, nullptr, WSP(bf16, WS_XB), WSP(float, WS_RINV), blk, nblk); }
        SEAM(pb + 6);
        if (IN(pb + 7)) REP(7) {
            CArgs ap = kargs(); unsigned char* ws = ap->ws;
            pg8::Gemm g{WSP(bf16, WS_XB), WSP(bf16, WS_WUP), T_, DFF, DM, 0}; pg8::StaticOrder S; S.init(T_, DFF, nblk, blk);
            pg8::EpiUp E{WSP(float, WS_RINV), WSP(bf16, WS_U), DFF, 0};
            pg8::gemm_phase<pg8::EpiUp, pg8::StaticOrder, true, true>(lds, g, S, E);
        }
        SEAM(pb + 7);
        if (IN(pb + 8)) {
            CArgs ap = kargs(); unsigned char* ws = ap->ws;
            pg8::Gemm g{WSP(bf16, WS_U), WSP(bf16, WS_WDOWN), T_, DM, DFF, 0}; pg8::StaticOrder S; S.init(T_, DM, nblk, blk);
            pg8::EpiRes E{ap->out, DM, 0};
            pg8::gemm_phase<pg8::EpiRes, pg8::StaticOrder, true, true>(lds, g, S, E);
        }
        SEAM(pb + 8);
    }
#undef IN
#undef SEAM
#undef WSP
}

#ifndef MK_PER_PHASE
#define MK_PER_PHASE 0
#endif
extern "C" void kernel_launch(void* const* d_in, const int* in_sizes, int n_in, void* d_out, int out_size, void* d_ws, size_t ws_size, hipStream_t stream) {
    static int grid = 0;
    if (grid == 0) {
        grid = -1;
        if (n_in != 26 || ws_size < WS_END || out_size != T_ * DM) { fprintf(stderr, "kernel_launch: unexpected shapes (n_in %d ws %zu out %d)\n", n_in, ws_size, out_size); return; }
        int dev = 0, cus = 0, per_cu = 0;
        if (hipGetDevice(&dev) != hipSuccess || hipDeviceGetAttribute(&cus, hipDeviceAttributeMultiprocessorCount, dev) != hipSuccess) return;
        if (hipFuncSetAttribute((const void*)fwd, hipFuncAttributeMaxDynamicSharedMemorySize, LDS_BYTES) != hipSuccess) return;
        if (hipOccupancyMaxActiveBlocksPerMultiprocessor(&per_cu, (const void*)fwd, 512, LDS_BYTES) != hipSuccess || per_cu < 1) { fprintf(stderr, "kernel_launch: occupancy query says %d\n", per_cu); (void)hipGetLastError(); return; }
        grid = cus;
    }
    if (grid < 0) return;
    if (hipMemsetAsync((char*)d_ws + WS_CTL, 0, CTL_ZERO_BYTES, stream) != hipSuccess) return;
    Args a;
    memset(&a, 0, sizeof(a));
    for (int i = 0; i < 26; ++i) a.in[i] = (const float*)d_in[i];
    a.out = (float*)d_out; a.ws = (unsigned char*)d_ws;
    for (int l = 0; l < NL; ++l) a.lam_init[l] = (float)(0.8 - 0.6 * exp(-0.3 * (double)l));
    const int nph = NL * NPH;
#if MK_PER_PHASE
    for (int p = 0; p < nph; ++p) { a.ph_lo = p; a.ph_hi = p + 1; hipLaunchKernelGGL(fwd, dim3(grid), dim3(512), LDS_BYTES, stream, a); }
#else
    a.ph_lo = 0; a.ph_hi = nph; hipLaunchKernelGGL(fwd, dim3(grid), dim3(512), LDS_BYTES, stream, a);
#endif
}
```

```cpp
#include <hip/hip_runtime.h>
#include <cstdio>
#include <cstdint>
#include <cstring>
#include <cmath>

constexpr int T_ = 16384, DM = 2048, NL = 4, PW = 6432, NIN = 6656, RWP = 3584, DFF = 8192, RW_ = 1024;
constexpr float RMS_EPS = 1e-6f, GN_EPS = 64e-5f;
typedef unsigned short bf16;
typedef float f32x4 __attribute__((ext_vector_type(4)));
typedef unsigned u32x4 __attribute__((ext_vector_type(4)));
typedef unsigned u32x2 __attribute__((ext_vector_type(2)));
#define LAS __attribute__((address_space(3)))

__device__ __forceinline__ unsigned f2bf(float f) { unsigned u = __builtin_bit_cast(unsigned, f); return (u + 0x7fffu + ((u >> 16) & 1u)) >> 16; }
__device__ __forceinline__ float bf2f(unsigned short b) { return __builtin_bit_cast(float, (unsigned)b << 16); }
__device__ __forceinline__ float bflo(unsigned w) { return __builtin_bit_cast(float, w << 16); }
__device__ __forceinline__ float bfhi(unsigned w) { return __builtin_bit_cast(float, w & 0xffff0000u); }
__device__ __forceinline__ float sigmoidf_(float x) { return 1.0f / (1.0f + __expf(-x)); }

template <int CTRL, int ROWMASK> __device__ __forceinline__ float dppf(float v) {
    return __builtin_bit_cast(float, __builtin_amdgcn_update_dpp(0, __builtin_bit_cast(int, v), CTRL, ROWMASK, 0xF, false));
}
__device__ __forceinline__ float wave_sum(float v) {
    v += dppf<0xB1, 0xF>(v); v += dppf<0x4E, 0xF>(v); v += dppf<0x141, 0xF>(v); v += dppf<0x140, 0xF>(v);
    v += dppf<0x142, 0xA>(v); v += dppf<0x143, 0xC>(v);
    return __builtin_bit_cast(float, __builtin_amdgcn_readlane(__builtin_bit_cast(int, v), 63));
}
__device__ __forceinline__ int opq_tid() { int t = (int)threadIdx.x; asm volatile("" : "+v"(t)); return t; }
namespace pg8 {
#define PG8_LAS __attribute__((address_space(3)))
typedef unsigned short bf16_t;
typedef short bf16x8 __attribute__((ext_vector_type(8)));
typedef float f32x4 __attribute__((ext_vector_type(4)));
typedef unsigned u32x4 __attribute__((ext_vector_type(4)));
constexpr int BM = 256, BK = 64, HALF = 128, HTB = HALF * BK * 2  , STAGE_BYTES = 8 * HTB, NXCD = 8, WGM = 8;

__host__ __device__ __forceinline__ int lds_byte(int r, int c) { const int st = (r >> 4) * 2 + (c >> 5), rr = r & 15, cc = c & 31, ob = rr * 64 + cc * 2; return st * 1024 + (ob ^ (((ob >> 9) & 1) << 5)); }
__host__ __device__ __forceinline__ void stage_rc(int b, int& R, int& C) { const int st = b / 1024, sb = b % 1024, swz = sb ^ (((sb >> 9) & 1) << 5); R = (st >> 1) * 16 + swz / 64; C = (st & 1) * 32 + (swz % 64) / 2; }
__host__ __device__ __forceinline__ int perm32(int rho) { const int n = rho >> 4, i = rho & 15; return 8 * (i >> 2) + 4 * n + (i & 3); }

struct Unit { int pm, pn; };
struct Gemm { const bf16_t* A; const bf16_t* Bt; int M, N, K, pad_; };

struct StaticOrder {
    int nM, nN, nwg, G, c;
    __host__ __device__ void init(int M, int N, int G_, int c_) { nM = M / BM; nN = N / BM; nwg = nM * nN; G = G_; c = c_; }
    __host__ __device__ bool next(int i, Unit& u) const {
        const long L = (long)i * G + c; if (L >= nwg) return false;
        int wgid = (int)L; { const int q = nwg / NXCD, r = nwg % NXCD, xcd = wgid % NXCD, off = wgid / NXCD; wgid = (xcd < r ? xcd * (q + 1) : r * (q + 1) + (xcd - r) * q) + off; }
        const int nig = WGM * nN, gid = wgid / nig, fm = gid * WGM, gsz = (nM - fm) < WGM ? (nM - fm) : WGM;
        u.pm = fm + ((wgid % nig) % gsz); u.pn = (wgid % nig) / gsz; return true;
    }
    __device__ __forceinline__ void a_ready(const Unit&) const {}
    __device__ __forceinline__ void done(const Unit&) const {}
};

__device__ __forceinline__ unsigned cvt_pk_bf16(float lo, float hi) { unsigned r; asm volatile("v_cvt_pk_bf16_f32 %0, %1, %2" : "=v"(r) : "v"(lo), "v"(hi)); return r; }
typedef float f32x2 __attribute__((ext_vector_type(2)));
struct EpiIn {
    static constexpr bool PERM = true, AFTER_DRAIN = false;
    const float* rinv; bf16_t* q; bf16_t* k; bf16_t* v; bf16_t* rw; const float* gq; const float* gk;
    __device__ __forceinline__ void operator()(const f32x4 (&acc)[2][2][4][2], const Unit& u, int wr, int wc, int fr, int fq) const {
        const int pn = u.pn;
        const int row0 = u.pm * BM + wr * 64 + fr;
        if (pn < 8) {
            const float* g = (pn < 4 ? gq : gk) + (wc & 1) * 64 + 8 * fq;
            f32x4 gv[2][2];
#pragma unroll
            for (int bj = 0; bj < 2; ++bj)
#pragma unroll
                for (int n = 0; n < 2; ++n) gv[bj][n] = *(const f32x4*)(g + 32 * bj + 4 * n);
            bf16_t* base = (pn < 4 ? q : k) + (pn & 3) * 256 + 64 * wc + 8 * fq;
#pragma unroll
            for (int ai = 0; ai < 2; ++ai)
#pragma unroll
                for (int m = 0; m < 4; ++m) {
                    const int row = row0 + ai * HALF + m * 16; const float ri = rinv[row];
                    f32x4 vv[2][2]; float ss = 0.f;
#pragma unroll
                    for (int bj = 0; bj < 2; ++bj)
#pragma unroll
                        for (int n = 0; n < 2; ++n) { vv[bj][n] = acc[ai][bj][m][n] * ri; const f32x4 t = vv[bj][n]; ss += (t[0] * t[0] + t[1] * t[1]) + (t[2] * t[2] + t[3] * t[3]); }
                    ss += __shfl_xor(ss, 16); ss += __shfl_xor(ss, 32);
                    const float rq = 1.0f / sqrtf(ss * (1.0f / 64.0f) + 1e-6f);
#pragma unroll
                    for (int bj = 0; bj < 2; ++bj) { const f32x4 a = vv[bj][0] * rq * gv[bj][0], b = vv[bj][1] * rq * gv[bj][1];
                        u32x4 w; w.x = cvt_pk_bf16(a[0], a[1]); w.y = cvt_pk_bf16(a[2], a[3]); w.z = cvt_pk_bf16(b[0], b[1]); w.w = cvt_pk_bf16(b[2], b[3]);
                        *(u32x4*)(base + (size_t)row * 1024 + 32 * bj) = w; }
                }
        } else {
            bf16_t* base; int ld;
            if (pn < 12) { base = v + (pn - 8) * 256 + 64 * wc + 8 * fq; ld = 1024; } else { base = rw + (pn - 12) * 256 + 64 * wc + 8 * fq; ld = 3584; }
#pragma unroll
            for (int ai = 0; ai < 2; ++ai)
#pragma unroll
                for (int m = 0; m < 4; ++m) {
                    const int row = row0 + ai * HALF + m * 16; const float ri = rinv[row];
#pragma unroll
                    for (int bj = 0; bj < 2; ++bj) { const f32x4 a = acc[ai][bj][m][0] * ri, b = acc[ai][bj][m][1] * ri;
                        u32x4 w; w.x = cvt_pk_bf16(a[0], a[1]); w.y = cvt_pk_bf16(a[2], a[3]); w.z = cvt_pk_bf16(b[0], b[1]); w.w = cvt_pk_bf16(b[2], b[3]);
                        *(u32x4*)(base + (size_t)row * ld + 32 * bj) = w; }
                }
        }
    }
};
struct EpiRes {
    static constexpr bool PERM = true, AFTER_DRAIN = false;
    float* x; int ldc; int pad_;
    __device__ __forceinline__ void operator()(const f32x4 (&acc)[2][2][4][2], const Unit& u, int wr, int wc, int fr, int fq) const {
        const int row0 = u.pm * BM + wr * 64 + fr, col0 = u.pn * BM + wc * 32 + 8 * fq;
#pragma unroll
        for (int ai = 0; ai < 2; ++ai)
#pragma unroll
            for (int m = 0; m < 4; ++m) { float* rowp = x + (size_t)(row0 + ai * HALF + m * 16) * ldc + col0;
#pragma unroll
                for (int bj = 0; bj < 2; ++bj) { f32x4* p = (f32x4*)(rowp + bj * HALF); const f32x4 o0 = p[0], o1 = p[1]; p[0] = o0 + acc[ai][bj][m][0]; p[1] = o1 + acc[ai][bj][m][1]; } }
    }
};
struct EpiUp {
    static constexpr bool PERM = true, AFTER_DRAIN = false;
    const float* rinv; bf16_t* o; int ldc; int pad_;
    __device__ __forceinline__ void operator()(const f32x4 (&acc)[2][2][4][2], const Unit& u, int wr, int wc, int fr, int fq) const {
        const int row0 = u.pm * BM + wr * 64 + fr, col0 = u.pn * BM + wc * 32 + 8 * fq;
#pragma unroll
        for (int ai = 0; ai < 2; ++ai)
#pragma unroll
            for (int m = 0; m < 4; ++m) { const int row = row0 + ai * HALF + m * 16; const float ri = rinv[row]; bf16_t* rowp = o + (size_t)row * ldc + col0;
#pragma unroll
                for (int bj = 0; bj < 2; ++bj) { f32x4 a = acc[ai][bj][m][0] * ri, b = acc[ai][bj][m][1] * ri;
#pragma unroll
                    for (int e = 0; e < 4; ++e) { a[e] = a[e] > 0.f ? a[e] * a[e] : 0.f; b[e] = b[e] > 0.f ? b[e] * b[e] : 0.f; }
                    u32x4 w; w.x = cvt_pk_bf16(a[0], a[1]); w.y = cvt_pk_bf16(a[2], a[3]); w.z = cvt_pk_bf16(b[0], b[1]); w.w = cvt_pk_bf16(b[2], b[3]);
                    *(u32x4*)(rowp + bj * HALF) = w; } }
    }
};
template <class Epi, class Sched, bool ALIGN_EPI = false, bool SP2 = false>
__device__ __forceinline__ void gemm_phase(PG8_LAS unsigned char* lds, const Gemm g, const Sched& S, const Epi& E) {
    const int tid = opq_tid(), wid = __builtin_amdgcn_readfirstlane(tid >> 6), lane = tid & 63, wr = wid >> 2, wc = wid & 3, fr = lane & 15, fq = lane >> 4;
    const int K = g.K, nt = K / BK;
    unsigned voffA[2], voffB[2];
#pragma unroll
    for (int i = 0; i < 2; ++i) { int R, C; stage_rc(tid * 16 + i * 8192, R, C); const int Rb = Epi::PERM ? ((R & ~31) + perm32(R & 31)) : R;
        voffA[i] = (unsigned)(R * K + C) * 2u; voffB[i] = (unsigned)(Rb * K + C) * 2u; }
    const size_t kstep = (size_t)(BK * 2);
    const size_t hstep = (size_t)HALF * K * 2;
    const size_t tstep = 2 * hstep;
    const unsigned ldsw = (unsigned)wid * 1024u;
    const int aoff = lds_byte(wr * 64 + fr, fq * 8), boff = lds_byte(wc * 32 + fr, fq * 8);
#define PG8_SA(b, h) (((b) * 2 + (h)) * HTB)
#define PG8_SB(b, h) ((4 + (b) * 2 + (h)) * HTB)
#define PG8_STAGE(bufoff, gbase, voff) do { _Pragma("unroll") for (int _i = 0; _i < 2; ++_i) \
        __builtin_amdgcn_global_load_lds((const unsigned*)((const char*)(gbase) + (voff)[_i]), (PG8_LAS unsigned*)(lds + (bufoff) + ldsw + _i * 8192), 16, 0, 0); } while (0)
#define PG8_LDA(dst, b, h) do { _Pragma("unroll") for (int m = 0; m < 4; ++m) _Pragma("unroll") for (int k = 0; k < 2; ++k) dst[m][k] = *(const PG8_LAS bf16x8*)(lds + PG8_SA(b, h) + aoff + m * 2048 + k * 1024); } while (0)
#define PG8_LDB(dst, b, h) do { _Pragma("unroll") for (int n = 0; n < 2; ++n) _Pragma("unroll") for (int k = 0; k < 2; ++k) dst[n][k] = *(const PG8_LAS bf16x8*)(lds + PG8_SB(b, h) + boff + n * 2048 + k * 1024); } while (0)
#define PG8_MMA(ai, bj, At, Bt) do { __builtin_amdgcn_s_setprio(1); _Pragma("unroll") for (int m = 0; m < 4; ++m) _Pragma("unroll") for (int n = 0; n < 2; ++n) _Pragma("unroll") for (int k = 0; k < 2; ++k) \
        acc[ai][bj][m][n] = __builtin_amdgcn_mfma_f32_16x16x32_bf16(Bt[n][k], At[m][k], acc[ai][bj][m][n], 0, 0, 0); __builtin_amdgcn_s_setprio(0); } while (0)
#define PG8_WAIT_V(n) asm volatile("s_waitcnt vmcnt(" #n ")" ::: "memory")
#define PG8_WAIT_L(n) asm volatile("s_waitcnt lgkmcnt(" #n ")" ::: "memory")
#define PG8_BAR __builtin_amdgcn_s_barrier()
#define PG8_SCHED __builtin_amdgcn_sched_barrier(0)
    Unit cur, nxt; int ui = 0;
    if (!S.next(0, cur)) return;
    f32x4 acc[2][2][4][2];
#pragma unroll
    for (int a = 0; a < 2; ++a)
#pragma unroll
        for (int b = 0; b < 2; ++b)
#pragma unroll
            for (int m = 0; m < 4; ++m)
#pragma unroll
                for (int n = 0; n < 2; ++n) acc[a][b][m][n] = (f32x4){0.f, 0.f, 0.f, 0.f};
    bf16x8 At[4][2], B0[2][2], B1[2][2];
    const char* cA = (const char*)g.A + (size_t)cur.pm * tstep; const char* cB = (const char*)g.Bt + (size_t)cur.pn * tstep;
    S.a_ready(cur);
    if constexpr (SP2) {
        PG8_STAGE(PG8_SB(0, 0), cB, voffB); PG8_STAGE(PG8_SB(0, 1), cB + hstep, voffB); PG8_STAGE(PG8_SA(0, 0), cA, voffA); PG8_STAGE(PG8_SA(0, 1), cA + hstep, voffA);
        if (wr == 1) PG8_BAR;
        PG8_WAIT_V(2); PG8_BAR;
        PG8_STAGE(PG8_SB(1, 0), cB + kstep, voffB); PG8_STAGE(PG8_SA(1, 0), cA + kstep, voffA); PG8_STAGE(PG8_SB(1, 1), cB + hstep + kstep, voffB);
        PG8_WAIT_V(6); PG8_BAR;
    } else {
        PG8_STAGE(PG8_SB(0, 0), cB, voffB); PG8_STAGE(PG8_SA(0, 0), cA, voffA); PG8_STAGE(PG8_SB(0, 1), cB + hstep, voffB); PG8_STAGE(PG8_SA(0, 1), cA + hstep, voffA);
        if (wr == 1) PG8_BAR;
        PG8_WAIT_V(4); PG8_BAR;
        PG8_STAGE(PG8_SB(1, 0), cB + kstep, voffB); PG8_STAGE(PG8_SA(1, 0), cA + kstep, voffA); PG8_STAGE(PG8_SB(1, 1), cB + hstep + kstep, voffB);
        PG8_WAIT_V(6); PG8_BAR;
    }
    for (;;) {
        const bool has_next = S.next(ui + 1, nxt);
        const char* nA = has_next ? (const char*)g.A + (size_t)nxt.pm * tstep : cA; const char* nB = has_next ? (const char*)g.Bt + (size_t)nxt.pn * tstep : cB;
        for (int t = 0; t < nt; t += 2) {
            const bool last = (t == nt - 2);
            const char* a1 = cA + (size_t)(t + 1) * kstep;
            const char* a2 = last ? nA : cA + (size_t)(t + 2) * kstep; const char* b2 = last ? nB : cB + (size_t)(t + 2) * kstep;
            const char* a3 = a2 + kstep; const char* b3 = b2 + kstep;
            if (last && has_next) S.a_ready(nxt);
            if constexpr (SP2) {
            PG8_LDB(B0, 0, 0); PG8_LDB(B1, 0, 1); PG8_SCHED; PG8_LDA(At, 0, 0); PG8_STAGE(PG8_SA(1, 1), a1 + hstep, voffA);
            PG8_WAIT_V(8); PG8_WAIT_L(0); PG8_BAR; PG8_MMA(0, 0, At, B0); PG8_MMA(0, 1, At, B1); PG8_BAR; PG8_SCHED;
            PG8_LDA(At, 0, 1); PG8_STAGE(PG8_SB(0, 0), b2, voffB); PG8_STAGE(PG8_SB(0, 1), b2 + hstep, voffB); PG8_STAGE(PG8_SA(0, 0), a2, voffA);
            PG8_WAIT_V(8); PG8_WAIT_L(0); PG8_BAR; PG8_MMA(1, 0, At, B0); PG8_MMA(1, 1, At, B1); PG8_BAR; PG8_SCHED;
            PG8_LDB(B0, 1, 0); PG8_LDB(B1, 1, 1); PG8_SCHED; PG8_LDA(At, 1, 0); PG8_STAGE(PG8_SA(0, 1), a2 + hstep, voffA);
            PG8_WAIT_V(8); PG8_WAIT_L(0); PG8_BAR; PG8_MMA(0, 0, At, B0); PG8_MMA(0, 1, At, B1); PG8_BAR; PG8_SCHED;
            PG8_LDA(At, 1, 1); PG8_STAGE(PG8_SB(1, 0), b3, voffB); PG8_STAGE(PG8_SB(1, 1), b3 + hstep, voffB); PG8_STAGE(PG8_SA(1, 0), a3, voffA);
            PG8_WAIT_V(8); PG8_WAIT_L(0); PG8_BAR; PG8_MMA(1, 0, At, B0); PG8_MMA(1, 1, At, B1); PG8_BAR; PG8_SCHED;
            } else {
            PG8_LDB(B0, 0, 0); PG8_SCHED; PG8_LDA(At, 0, 0); PG8_STAGE(PG8_SA(1, 1), a1 + hstep, voffA);
            PG8_WAIT_L(8); PG8_BAR; PG8_WAIT_L(0); PG8_MMA(0, 0, At, B0); PG8_BAR; PG8_SCHED;
            PG8_LDB(B1, 0, 1); PG8_STAGE(PG8_SB(0, 0), b2, voffB);
            PG8_BAR; PG8_WAIT_L(0); PG8_MMA(0, 1, At, B1); PG8_BAR;
            PG8_LDA(At, 0, 1); PG8_STAGE(PG8_SA(0, 0), a2, voffA);
            PG8_BAR; PG8_WAIT_L(0); PG8_MMA(1, 0, At, B0); PG8_BAR; PG8_SCHED;
            PG8_STAGE(PG8_SB(0, 1), b2 + hstep, voffB);
            PG8_WAIT_V(6); PG8_BAR; PG8_MMA(1, 1, At, B1); PG8_BAR;
            PG8_LDB(B0, 1, 0); PG8_SCHED; PG8_LDA(At, 1, 0); PG8_STAGE(PG8_SA(0, 1), a2 + hstep, voffA);
            PG8_WAIT_L(8); PG8_BAR; PG8_WAIT_L(0); PG8_MMA(0, 0, At, B0); PG8_BAR; PG8_SCHED;
            PG8_LDB(B1, 1, 1); PG8_STAGE(PG8_SB(1, 0), b3, voffB);
            PG8_BAR; PG8_WAIT_L(0); PG8_MMA(0, 1, At, B1); PG8_BAR;
            PG8_LDA(At, 1, 1); PG8_STAGE(PG8_SA(1, 0), a3, voffA);
            PG8_BAR; PG8_WAIT_L(0); PG8_MMA(1, 0, At, B0); PG8_BAR; PG8_SCHED;
            PG8_STAGE(PG8_SB(1, 1), b3 + hstep, voffB);
            PG8_WAIT_V(6); PG8_BAR; PG8_MMA(1, 1, At, B1); PG8_BAR;
            }
        }
        if constexpr (ALIGN_EPI) { if (wr == 0) PG8_BAR; }
        if constexpr (!Epi::AFTER_DRAIN) { E(acc, cur, wr, wc, fr, fq); S.done(cur); }
        if (!has_next) break;
#pragma unroll
        for (int a = 0; a < 2; ++a)
#pragma unroll
            for (int b = 0; b < 2; ++b)
#pragma unroll
                for (int m = 0; m < 4; ++m)
#pragma unroll
                    for (int n = 0; n < 2; ++n) acc[a][b][m][n] = (f32x4){0.f, 0.f, 0.f, 0.f};
        cur = nxt; cA = nA; cB = nB; ++ui;
        if constexpr (ALIGN_EPI) { if (wr == 1) PG8_BAR; }
    }
    PG8_WAIT_V(0);
    if constexpr (!ALIGN_EPI) { if (wr == 0) PG8_BAR; }
    PG8_BAR;
    if constexpr (Epi::AFTER_DRAIN) { E.fused(acc, cur, wr, wc, fr, fq, lds, wid, lane); S.done(cur); }
#undef PG8_SA
#undef PG8_SB
#undef PG8_STAGE
#undef PG8_LDA
#undef PG8_LDB
#undef PG8_MMA
#undef PG8_WAIT_V
#undef PG8_WAIT_L
#undef PG8_BAR
#undef PG8_SCHED
}
}

namespace att {
typedef short bf16x8 __attribute__((ext_vector_type(8)));
typedef short s16x4 __attribute__((ext_vector_type(4)));
typedef float f32x16 __attribute__((ext_vector_type(16)));
typedef float f32x2_t __attribute__((ext_vector_type(2)));
typedef __bf16 bf16x2_t __attribute__((ext_vector_type(2)));
typedef __attribute__((address_space(3))) const unsigned char* lds_cptr;
typedef short v4i16_t __attribute__((ext_vector_type(4)));
constexpr int KSLOT = 8192, VSLOT = 16384, LDS_K = 0, LDS_V = 2 * KSLOT, LDS_BYTES = 2 * KSLOT + 2 * VSLOT;
constexpr float LOG2E = 1.4426950408889634f, C2 = 0.125f * LOG2E;
__device__ __forceinline__ int crow(int r, int hi) { return (r & 3) + 8 * (r >> 2) + 4 * hi; }
__device__ __forceinline__ void glds16(const void* gsrc, unsigned lds_dst) { unsigned keep;
    asm volatile("s_mov_b32 %0, m0\n\ts_mov_b32 m0, %2\n\ts_nop 0\n\tglobal_load_lds_dwordx4 %1, off\n\ts_mov_b32 m0, %0" : "=&s"(keep) : "v"(gsrc), "s"(lds_dst) : "memory"); }
__device__ __forceinline__ unsigned cvtpk(float lo, float hi) { f32x2_t v = {lo, hi}; bf16x2_t b = __builtin_convertvector(v, bf16x2_t); return __builtin_bit_cast(unsigned, b); }
__device__ __forceinline__ s16x4 vtr(lds_cptr p) { return __builtin_bit_cast(s16x4, __builtin_amdgcn_ds_read_tr16_b64_v4i16((__attribute__((address_space(3))) v4i16_t*)p)); }
__device__ __forceinline__ float swap_max(float m) { auto rr = __builtin_amdgcn_permlane32_swap(__float_as_uint(m), __float_as_uint(m), false, false); return fmaxf(__uint_as_float(rr[0]), __uint_as_float(rr[1])); }
__device__ __forceinline__ float swap_sum(float m) { auto rr = __builtin_amdgcn_permlane32_swap(__float_as_uint(m), __float_as_uint(m), false, false); return __uint_as_float(rr[0]) + __uint_as_float(rr[1]); }
#define ATT_WAIT_BAR() asm volatile("s_waitcnt vmcnt(0) lgkmcnt(0)\n\ts_barrier" ::: "memory")

struct Args { const bf16* Q; const bf16* K; const bf16* V; bf16* mixed; float* stash; const float* lq; const float* lk; const float* subln; const float* gq; const float* gk; float lam_init; int pad_; };

constexpr int PART_F = 68, PART_SLOT_F = 512 * PART_F, MAX_SLOTS = 1700, SPLIT_MIN = 80, TAB_OFF = 65536;
__device__ __forceinline__ void attn_pass(__attribute__((address_space(3))) unsigned char* lds, const Args& A, int h, int qb, int c, int ta, int tb, int nw, f32x16 (&oT)[4], float& l_out, float& M_out) {
    const int tid = opq_tid(), lane = tid & 63, r32 = lane & 31, hi = lane >> 5; const int wid = __builtin_amdgcn_readfirstlane(tid >> 6);
    const int q0 = qb * 256 + wid * 32, qc = q0 >> 6;
    const float slope2 = exp2f(-(float)(h + 1)) * LOG2E;
    const unsigned lds0 = (unsigned)(uintptr_t)lds;
    const lds_cptr kp0 = (lds_cptr)lds + LDS_K + hi * 1024 + r32 * 16;
    const lds_cptr vp0 = (lds_cptr)lds + LDS_V + ((lane >> 4) & 1) * 32 + (lane & 3) * 8 + (4 * hi + ((lane & 15) >> 2)) * 64;
    const bf16* vsrc = A.V + (size_t)(16 * (wid & 3) + (lane >> 2)) * 1024 + h * 128 + (wid >> 2) * 32 + (lane & 3) * 8;
    const unsigned kdst = lds0 + LDS_K + wid * 1024, vdst = lds0 + LDS_V + (wid >> 2) * 4096 + (wid & 3) * 1024;
    const int qrel = (q0 & 63) + r32;
    const int tw0 = max(ta, max(0, qc - nw));
    const bf16* ksrc = A.K + (size_t)lane * 1024 + h * 128 + c * 64 + wid * 8;
    bf16x8 qr[4];
    { const bf16* qp = A.Q + (size_t)(q0 + r32) * 1024 + h * 128 + c * 64 + hi * 8;
#pragma unroll
      for (int d0 = 0; d0 < 4; ++d0) qr[d0] = *(const bf16x8*)(qp + d0 * 16); }
#pragma unroll
    for (int d0 = 0; d0 < 4; ++d0)
#pragma unroll
        for (int r = 0; r < 16; ++r) oT[d0][r] = 0.f;
    float l = 0.f, mu = 0.f;
    if (ta < tb) {
        { const size_t go = (size_t)ta * 64 * 1024; const unsigned so = (unsigned)(ta & 1);
          glds16(ksrc + go, (unsigned)__builtin_amdgcn_readfirstlane(kdst + so * KSLOT)); glds16(vsrc + go, (unsigned)__builtin_amdgcn_readfirstlane(vdst + so * VSLOT)); glds16(vsrc + go + 64, (unsigned)__builtin_amdgcn_readfirstlane(vdst + so * VSLOT + 8192)); }
        ATT_WAIT_BAR();
#pragma unroll 1
        for (int t = ta; t < tb; ++t) {
            const int sl = t & 1;
            if (t + 1 < tb) { const size_t go = (size_t)(t + 1) * 64 * 1024; const unsigned so = (unsigned)(sl ^ 1);
                glds16(ksrc + go, (unsigned)__builtin_amdgcn_readfirstlane(kdst + so * KSLOT)); glds16(vsrc + go, (unsigned)__builtin_amdgcn_readfirstlane(vdst + so * VSLOT));
                glds16(vsrc + go + 64, (unsigned)__builtin_amdgcn_readfirstlane(vdst + so * VSLOT + 8192)); }
            if (t >= tw0 && t <= qc) {
                const bool diag = (t == qc);
                f32x16 p0, p1;
                const float sc = slope2 * (1.0f / C2), base0 = (float)(4 * hi) * sc - mu * (1.0f / C2), base1 = base0 + 32.0f * sc;
                if (!diag) {
#pragma unroll
                    for (int r = 0; r < 16; ++r) { const float kr = (float)((r & 3) + 8 * (r >> 2)); p0[r] = __builtin_fmaf(kr, sc, base0); p1[r] = __builtin_fmaf(kr, sc, base1); }
                } else {
                    const float q2 = (float)(2 * qrel - 8 * hi);
#pragma unroll
                    for (int r = 0; r < 16; ++r) { const float kr = (float)((r & 3) + 8 * (r >> 2));
                        p0[r] = __builtin_fmaf(fminf(kr, q2 - kr) , sc, base0); p1[r] = __builtin_fmaf(fminf(kr, q2 - 64.0f - kr), sc, base1); }
                }
                const lds_cptr kp = kp0 + sl * KSLOT;
#pragma unroll
                for (int d0 = 0; d0 < 4; ++d0) {
                    const bf16x8 k0 = *(const __attribute__((address_space(3))) bf16x8*)(kp + d0 * 2048), k1 = *(const __attribute__((address_space(3))) bf16x8*)(kp + d0 * 2048 + 512);
                    p0 = __builtin_amdgcn_mfma_f32_32x32x16_bf16(k0, qr[d0], p0, 0, 0, 0);
                    p1 = __builtin_amdgcn_mfma_f32_32x32x16_bf16(k1, qr[d0], p1, 0, 0, 0);
                }
                float rm = fmaxf(p0[0], p1[0]);
#pragma unroll
                for (int r = 1; r < 16; ++r) rm = fmaxf(rm, fmaxf(p0[r], p1[r]));
                rm = swap_max(rm);
                const float dl = (t == tw0) ? C2 * rm : fmaxf(C2 * rm, 0.f);
                if (__any(dl != 0.f)) { const float f = __builtin_amdgcn_exp2f(-dl); l *= f;
#pragma unroll
                    for (int d0 = 0; d0 < 4; ++d0)
#pragma unroll
                        for (int r = 0; r < 16; ++r) oT[d0][r] *= f; }
                mu += dl;
                float ls = 0.f;
#pragma unroll
                for (int r = 0; r < 16; ++r) { p0[r] = __builtin_amdgcn_exp2f(p0[r] * C2 - dl); p1[r] = __builtin_amdgcn_exp2f(p1[r] * C2 - dl); ls += p0[r] + p1[r]; }
                l += ls;
                bf16x8 pw[4];
#pragma unroll
                for (int s = 0; s < 4; ++s) { u32x4 w;
#pragma unroll
                    for (int e = 0; e < 4; ++e) { const int r = 8 * (s & 1) + 2 * e; w[e] = (s < 2) ? cvtpk(p0[r], p0[r + 1]) : cvtpk(p1[r], p1[r + 1]); }
                    pw[s] = __builtin_bit_cast(bf16x8, w); }
                const lds_cptr vp = vp0 + sl * VSLOT;
#pragma unroll
                for (int d0 = 0; d0 < 4; ++d0) {
#pragma unroll
                    for (int s = 0; s < 4; ++s) { const s16x4 lo = vtr(vp + d0 * 4096 + s * 1024), hh = vtr(vp + d0 * 4096 + s * 1024 + 512);
                        const bf16x8 vf = (bf16x8){lo[0], lo[1], lo[2], lo[3], hh[0], hh[1], hh[2], hh[3]};
                        oT[d0] = __builtin_amdgcn_mfma_f32_32x32x16_bf16(vf, pw[s], oT[d0], 0, 0, 0); }
                    __builtin_amdgcn_sched_barrier(0); }
                mu -= 64.0f * slope2;
            }
            ATT_WAIT_BAR();
        }
    }
    const int tl = min(qc, tb - 1);
    l_out = l; M_out = (tl >= tw0) ? mu + slope2 * 64.0f * (float)(tl + 1) : -1e30f;
}
__device__ __forceinline__ void attn_finalize(const Args& A, int h, int qb, const f32x16 (&o1)[4], f32x16 (&o2)[4], float lam) {
    const int tid = opq_tid(), lane = tid & 63, r32 = lane & 31, hi = lane >> 5; const int wid = __builtin_amdgcn_readfirstlane(tid >> 6);
    const int q0 = qb * 256 + wid * 32;
    float ss = 0.f;
#pragma unroll
    for (int d0 = 0; d0 < 4; ++d0)
#pragma unroll
        for (int r = 0; r < 16; ++r) { const float v = o1[d0][r] - lam * o2[d0][r]; o2[d0][r] = v; ss += v * v; }
    ss = swap_sum(ss);
    const float rn = (1.0f / sqrtf(ss * (1.0f / 128.0f) + RMS_EPS)) * (1.0f - A.lam_init);
    bf16* op = A.mixed + (size_t)(q0 + r32) * DM + h * 128;
#pragma unroll
    for (int d0 = 0; d0 < 4; ++d0)
#pragma unroll
        for (int g4 = 0; g4 < 4; ++g4) { const int d = 32 * d0 + 8 * g4 + 4 * hi; const f32x4 gg = *(const f32x4*)(A.subln + d);
            u32x2 w; w.x = cvtpk(o2[d0][4 * g4] * rn * gg[0], o2[d0][4 * g4 + 1] * rn * gg[1]); w.y = cvtpk(o2[d0][4 * g4 + 2] * rn * gg[2], o2[d0][4 * g4 + 3] * rn * gg[3]);
            *(u32x2*)(op + d) = w; }
}
struct Win { float smax0, smax1; };
__device__ __forceinline__ int win_nw(const Win& W, int h, int c) { const float smax = c ? W.smax1 : W.smax0, slope2 = exp2f(-(float)(h + 1)) * LOG2E, dmin = (2.0f * C2 * smax + 67.0f) / slope2; return (int)fminf(ceilf((dmin + 63.0f) * (1.0f / 64.0f)) - 1.0f, 256.0f); }
__device__ __forceinline__ void attn_windows(const Args& A, Win& W, float& lam) {
    const int lane = opq_tid() & 63;
    const float l0 = wave_sum(A.lq[lane] * A.lk[lane]), l1 = wave_sum(A.lq[64 + lane] * A.lk[64 + lane]);
    lam = __expf(l0) - __expf(l1) + A.lam_init;
#pragma unroll
    for (int c = 0; c < 2; ++c) { float a = fabsf(A.gq[c * 64 + lane]), b = fabsf(A.gk[c * 64 + lane]);
#pragma unroll
        for (int o = 1; o < 64; o <<= 1) { a = fmaxf(a, __shfl_xor(a, o)); b = fmaxf(b, __shfl_xor(b, o)); }
        const float smax = 64.0f * 1.02f * a * b; if (c == 0) W.smax0 = smax; else W.smax1 = smax; }
}
__device__ __forceinline__ int attn_ntile(const Win& W, int h, int qb, int c) { return 4 * qb + 4 - max(0, 4 * qb - win_nw(W, h, c)); }
__device__ __forceinline__ int attn_table(__attribute__((address_space(3))) unsigned char* lds, const Win& W) {
    volatile __attribute__((address_space(3))) unsigned* tab = (volatile __attribute__((address_space(3))) unsigned*)(lds + TAB_OFF);
    const int tid = opq_tid(), lane = tid & 63, wid = tid >> 6, qb = 63 - (tid >> 3), h = tid & 7;
    const int nt = max(attn_ntile(W, h, qb, 0), attn_ntile(W, h, qb, 1));
    int P = nt > SPLIT_MIN ? (nt + 63) / 64 : 1;
    int want = P > 1 ? 2 * P : 0, incl = want;
#pragma unroll
    for (int o = 1; o < 64; o <<= 1) { const int v = __shfl_up(incl, o); if (lane >= o) incl += v; }
    if (lane == 63) tab[1032 + wid] = (unsigned)incl;
    asm volatile("s_waitcnt lgkmcnt(0)" ::: "memory"); __builtin_amdgcn_s_barrier(); asm volatile("" ::: "memory");
    int sbase = 0;
#pragma unroll
    for (int w = 0; w < 8; ++w) sbase += (w < wid) ? (int)tab[1032 + w] : 0;
    const int sstart = sbase + incl - want;
    if (sstart + want > MAX_SLOTS) P = 1;
    const int cnt = P > 1 ? 2 * P : 1; int ci = cnt;
#pragma unroll
    for (int o = 1; o < 64; o <<= 1) { const int v = __shfl_up(ci, o); if (lane >= o) ci += v; }
    if (lane == 63) tab[1024 + wid] = (unsigned)ci;
    asm volatile("s_waitcnt lgkmcnt(0)" ::: "memory"); __builtin_amdgcn_s_barrier(); asm volatile("" ::: "memory");
    int ibase = 0, total = 0;
#pragma unroll
    for (int w = 0; w < 8; ++w) { const int v = (int)tab[1024 + w]; ibase += (w < wid) ? v : 0; total += v; }
    tab[tid] = (unsigned)(ibase + ci - cnt) | ((unsigned)P << 16); tab[512 + tid] = (unsigned)sstart;
    asm volatile("s_waitcnt lgkmcnt(0)" ::: "memory"); __builtin_amdgcn_s_barrier(); asm volatile("" ::: "memory");
    return total;
}
__device__ __forceinline__ void part_range(const Win& W, int h, int qb, int c, int P, int p, int& ta, int& tb) {
    const int NT = 4 * qb + 4, T0 = max(0, 4 * qb - win_nw(W, h, c)), len = (NT - T0 + P - 1) / P; ta = min(NT, T0 + p * len); tb = min(NT, ta + len);
}
__device__ __forceinline__ void attn_phase(__attribute__((address_space(3))) unsigned char* lds, const Args& A, int blk, unsigned* ctr, volatile __attribute__((address_space(3))) unsigned* qslot, float* part) {
    const int tid = opq_tid();
    Win W; float lam; attn_windows(A, W, lam);
    const int nitems = attn_table(lds, W);
    volatile __attribute__((address_space(3))) unsigned* tab = (volatile __attribute__((address_space(3))) unsigned*)(lds + TAB_OFF);
    float* st = A.stash + (size_t)blk * (64 * 512) + tid * 64;
    for (;;) {
        if (tid == 0) { const unsigned n = __hip_atomic_fetch_add(ctr, 1u, __ATOMIC_RELAXED, __HIP_MEMORY_SCOPE_AGENT); unsigned idx = 0;
            if (n < (unsigned)nitems) { int lo = 0, hi = 511; while (lo < hi) { const int mid = (lo + hi + 1) >> 1; if ((tab[mid] & 0xffffu) <= n) lo = mid; else hi = mid - 1; } idx = (unsigned)lo; }
            qslot[0] = n; qslot[1] = idx; }
        asm volatile("s_waitcnt vmcnt(0) lgkmcnt(0)" ::: "memory"); __builtin_amdgcn_s_barrier(); asm volatile("" ::: "memory");
        const unsigned n = qslot[0], idx = qslot[1];
        asm volatile("s_waitcnt lgkmcnt(0)" ::: "memory"); __builtin_amdgcn_s_barrier(); asm volatile("" ::: "memory");
        if (n >= (unsigned)nitems) break;
        const unsigned e = tab[idx]; const int P = (int)(e >> 16), sub = (int)(n - (e & 0xffffu)), h = (int)(idx & 7u), qb = 63 - (int)(idx >> 3);
        f32x16 oT[4]; float l, M;
        if (P == 1) {
#pragma unroll 1
            for (int c = 0; c < 2; ++c) {
                attn_pass(lds, A, h, qb, c, max(0, 4 * qb - win_nw(W, h, c)), 4 * qb + 4, win_nw(W, h, c), oT, l, M);
                const float il = 1.0f / swap_sum(l);
#pragma unroll
                for (int d0 = 0; d0 < 4; ++d0)
#pragma unroll
                    for (int r = 0; r < 16; ++r) oT[d0][r] *= il;
                if (c == 0) {
#pragma unroll
                    for (int d0 = 0; d0 < 4; ++d0)
#pragma unroll
                        for (int r = 0; r < 16; r += 4) *(f32x4*)(st + d0 * 16 + r) = (f32x4){oT[d0][r], oT[d0][r + 1], oT[d0][r + 2], oT[d0][r + 3]};
                } else { f32x16 o1[4];
#pragma unroll
                    for (int d0 = 0; d0 < 4; ++d0)
#pragma unroll
                        for (int r = 0; r < 16; r += 4) { const f32x4 v = *(const f32x4*)(st + d0 * 16 + r); o1[d0][r] = v[0]; o1[d0][r + 1] = v[1]; o1[d0][r + 2] = v[2]; o1[d0][r + 3] = v[3]; }
                    attn_finalize(A, h, qb, o1, oT, lam); }
            }
        } else {
            const int c = sub / P, p = sub % P; int ta, tb; part_range(W, h, qb, c, P, p, ta, tb);
            attn_pass(lds, A, h, qb, c, ta, tb, win_nw(W, h, c), oT, l, M);
            float* ps = part + (size_t)(tab[512 + idx] + (unsigned)sub) * PART_SLOT_F + tid * PART_F;
#pragma unroll
            for (int d0 = 0; d0 < 4; ++d0)
#pragma unroll
                for (int r = 0; r < 16; r += 4) *(f32x4*)(ps + d0 * 16 + r) = (f32x4){oT[d0][r], oT[d0][r + 1], oT[d0][r + 2], oT[d0][r + 3]};
            *(f32x4*)(ps + 64) = (f32x4){l, M, 0.f, 0.f};
        }
    }
}
__device__ __forceinline__ void attn_combine(__attribute__((address_space(3))) unsigned char* lds, const Args& A, int blk, int nblk, const float* part) {
    const int tid = opq_tid();
    Win W; float lam; attn_windows(A, W, lam);
    (void)attn_table(lds, W);
    volatile __attribute__((address_space(3))) unsigned* tab = (volatile __attribute__((address_space(3))) unsigned*)(lds + TAB_OFF);
    int seen = 0;
    for (int idx = 0; idx < 512; ++idx) {
        const unsigned e = tab[idx]; const int P = (int)(e >> 16); if (P == 1) continue;
        if ((seen++ % nblk) != blk) continue;
        const int h = idx & 7, qb = 63 - (idx >> 3);
        f32x16 o1[4], o2[4];
#pragma unroll 1
        for (int c = 0; c < 2; ++c) {
            const float* ps = part + (size_t)(tab[512 + idx] + (unsigned)(c * P)) * PART_SLOT_F + tid * PART_F;
            float M = -1e30f;
            for (int p = 0; p < P; ++p) M = fmaxf(M, ps[(size_t)p * PART_SLOT_F + 65]);
            float L = 0.f;
#pragma unroll
            for (int d0 = 0; d0 < 4; ++d0)
#pragma unroll
                for (int r = 0; r < 16; ++r) o2[d0][r] = 0.f;
            for (int p = 0; p < P; ++p) { const float* pp = ps + (size_t)p * PART_SLOT_F; const f32x4 lm = *(const f32x4*)(pp + 64); const float f = __builtin_amdgcn_exp2f(lm[1] - M); L += lm[0] * f;
#pragma unroll
                for (int d0 = 0; d0 < 4; ++d0)
#pragma unroll
                    for (int r = 0; r < 16; r += 4) { const f32x4 v = *(const f32x4*)(pp + d0 * 16 + r); o2[d0][r] += v[0] * f; o2[d0][r + 1] += v[1] * f; o2[d0][r + 2] += v[2] * f; o2[d0][r + 3] += v[3] * f; } }
            const float il = 1.0f / swap_sum(L);
            if (c == 0) {
#pragma unroll
                for (int d0 = 0; d0 < 4; ++d0)
#pragma unroll
                    for (int r = 0; r < 16; ++r) o1[d0][r] = o2[d0][r] * il;
            } else {
#pragma unroll
                for (int d0 = 0; d0 < 4; ++d0)
#pragma unroll
                    for (int r = 0; r < 16; ++r) o2[d0][r] *= il;
            }
        }
        attn_finalize(A, h, qb, o1, o2, lam);
    }
}
}

namespace rk {
typedef short bf16x8 __attribute__((ext_vector_type(8)));
typedef short s16x4 __attribute__((ext_vector_type(4)));
typedef short v4i16_t __attribute__((ext_vector_type(4)));
typedef const LAS unsigned char* lcp;
constexpr int ST = 72, MATB = 64 * ST * 2, NST = 68, SLG = 168, SVL = 40;
constexpr int O_AT = 0, O_RT = MATB, O_BT = 2 * MATB, O_KT = 3 * MATB, O_VV = 4 * MATB, O_AAK = 5 * MATB, O_ARB = 6 * MATB, O_ARK = 7 * MATB, O_NN = 8 * MATB, O_GG = O_NN + 64 * NST * 4,
              O_U0T = O_GG, O_WT = O_AAK, O_G2 = O_AAK  , O_VG = O_ARK  , O_SEG = O_GG + 64 * NST * 4, O_GL = O_SEG + 2048,
              O_LW = O_GL + 256, O_LA = O_LW + MATB, O_LG = O_LA + MATB, O_VL = O_LG + 64 * SLG * 2, O_END = O_VL + 64 * SVL * 2;
static_assert(64 * NST * 4 <= 2 * MATB && O_END <= 156000, "stage-1 LDS map");
__device__ __forceinline__ f32x4 mfma16(bf16x8 a, bf16x8 b, f32x4 c) { return __builtin_amdgcn_mfma_f32_16x16x32_bf16(a, b, c, 0, 0, 0); }
__device__ __forceinline__ s16x4 vtr(lcp p) { return __builtin_bit_cast(s16x4, __builtin_amdgcn_ds_read_tr16_b64_v4i16((LAS v4i16_t*)p)); }
__device__ __forceinline__ bf16x8 frag(lcp m, int row0, int ks, int lane, int st = ST) { return *(const LAS bf16x8*)(m + ((row0 + (lane & 15)) * st + 32 * ks + 8 * (lane >> 4)) * 2); }
__device__ __forceinline__ bf16x8 tfrag(lcp m, int c0, int ks, int lane) {
    const int i = lane & 15, q = i >> 2, p = i & 3, k0 = 32 * ks + 8 * (lane >> 4);
    const s16x4 lo = vtr(m + ((k0 + q) * ST + c0 + 4 * p) * 2), hi = vtr(m + ((k0 + 4 + q) * ST + c0 + 4 * p) * 2);
    return (bf16x8){lo[0], lo[1], lo[2], lo[3], hi[0], hi[1], hi[2], hi[3]};
}
__device__ __forceinline__ unsigned pk(float a, float b) { return f2bf(a) | (f2bf(b) << 16); }
#define RK_BAR() do { asm volatile("s_waitcnt lgkmcnt(0)" ::: "memory"); __builtin_amdgcn_s_barrier(); asm volatile("" ::: "memory"); } while (0)


template <int T> struct SolveRow {
    static __device__ __forceinline__ void load(f32x4 (&buf)[16], LAS unsigned char* lds) {
#pragma unroll
        for (int s4 = 0; s4 < 16; ++s4) if (s4 * 4 < T + 1) buf[s4] = *(const LAS f32x4*)(lds + ((T + 1) * NST + 4 * s4) * 4);
    }
    static __device__ __forceinline__ void run(float (&x)[64], f32x4 (&cur)[16], f32x4 (&nxt)[16], LAS unsigned char* lds) {
        if constexpr (T + 1 < 64) load(nxt, lds);
        asm volatile("" ::: "memory"); __builtin_amdgcn_sched_barrier(0);
        float acc = x[T];
#pragma unroll
        for (int s4 = 0; s4 < 16; ++s4)
#pragma unroll
            for (int e = 0; e < 4; ++e) if (4 * s4 + e < T) acc = __builtin_fmaf(cur[s4][e], x[4 * s4 + e], acc);
        x[T] = acc;
        asm volatile("" : "+v"(x[T]) :: "memory"); __builtin_amdgcn_sched_barrier(0);
        if constexpr (T + 1 < 64) SolveRow<T + 1>::run(x, nxt, cur, lds);
    }
};

struct S1Args {
    const bf16* rw; const float* mu; const float* w0; const float* a0; const float* v0; const float* k_k; const float* k_a; const float* r_k;
    const bf16* w2t; const bf16* a2t; const bf16* g2t; const bf16* v2t;
    bf16* vfirst; bf16* BV; bf16* GB; bf16* PG; float* QT; bf16* RP; float* Y0; int layer; int pad_;
};
__device__ __forceinline__ float ldbf(const bf16* p) { return bf2f(*p); }

__device__ __forceinline__ void stage1_latents(LAS unsigned char* lds, const S1Args& A, int t0) {
    const int tid = opq_tid();
    for (int idx = tid; idx < 64 * 320; idx += 512) {
        const int tok = idx / 320, col = idx % 320, t = t0 + tok;
        const bf16* p = A.rw + (size_t)t * RWP + 3072 + col;
        const float cur = ldbf(p);
        if (col < 288) {
            const float prev = t > 0 ? ldbf(p - RWP) : 0.f, sft = cur + A.mu[3072 + col] * (prev - cur);
            if (col < 64) *(LAS unsigned short*)(lds + O_LW + (tok * ST + col) * 2) = (unsigned short)f2bf(tanhf(sft));
            else if (col < 128) *(LAS unsigned short*)(lds + O_LA + (tok * ST + col - 64) * 2) = (unsigned short)f2bf(sft);
            else *(LAS unsigned short*)(lds + O_LG + (tok * SLG + col - 128) * 2) = (unsigned short)f2bf(sigmoidf_(sft));
        } else {
            const float x2 = t > 0 ? ldbf(p - RWP + 32) : 0.f;
            *(LAS unsigned short*)(lds + O_VL + (tok * SVL + col - 288) * 2) = (unsigned short)f2bf(cur + x2);
        }
    }
}

__device__ __forceinline__ void stage1_unit(LAS unsigned char* lds, const S1Args& A, int c, int h) {
    const int tid = opq_tid(), lane = tid & 63, wid = __builtin_amdgcn_readfirstlane(tid >> 6), rq = lane >> 4, l15 = lane & 15;
    const int t0 = c * 64, uc = h * 256 + c;
    const int b0 = wid >> 1;
    LAS float* SEG = (LAS float*)(lds + O_SEG); LAS float* GL = (LAS float*)(lds + O_GL);
    {
        const bf16x8 lw0 = frag(lds + O_LW, 16 * b0, 0, lane), lw1 = frag(lds + O_LW, 16 * b0, 1, lane), la0 = frag(lds + O_LA, 16 * b0, 0, lane), la1 = frag(lds + O_LA, 16 * b0, 1, lane);
        const bf16x8 lv0 = frag(lds + O_VL, 16 * b0, 0, lane, SVL);
        bf16x8 lg[5];
#pragma unroll
        for (int ks = 0; ks < 5; ++ks) lg[ks] = frag(lds + O_LG, 16 * b0, ks, lane, SLG);
#pragma unroll
        for (int cc = 0; cc < 2; ++cc) {
            const int cb = 2 * (wid & 1) + cc, jl = 16 * cb + l15, ch = h * 64 + jl;
            const f32x4 z = {0.f, 0.f, 0.f, 0.f};
            const bf16* pw = A.w2t + (size_t)ch * 64 + 8 * rq; const bf16* pa = A.a2t + (size_t)ch * 64 + 8 * rq; const bf16* pg = A.g2t + (size_t)ch * 160 + 8 * rq; const bf16* pv = A.v2t + (size_t)ch * 32 + 8 * rq;
            const f32x4 zw = mfma16(lw1, *(const bf16x8*)(pw + 32), mfma16(lw0, *(const bf16x8*)pw, z));
            const f32x4 za = mfma16(la1, *(const bf16x8*)(pa + 32), mfma16(la0, *(const bf16x8*)pa, z));
            f32x4 zg = z;
#pragma unroll
            for (int ks = 0; ks < 5; ++ks) zg = mfma16(lg[ks], *(const bf16x8*)(pg + 32 * ks), zg);
            const f32x4 zv = mfma16(lv0, *(const bf16x8*)pv, z);
            const float w0c = A.w0[ch], a0c = A.a0[ch], v0c = A.v0[ch];
#pragma unroll
            for (int e = 0; e < 4; ++e) {
                const int t = 16 * b0 + 4 * rq + e;
                const float zz = -(w0c + zw[e]), sp = fmaxf(zz, 0.f) + log1pf(__expf(-fabsf(zz))), wl = -sp - 0.5f;
                *(LAS float*)(lds + O_NN + (t * NST + jl) * 4) = -__expf(wl);
                *(LAS float*)(lds + O_GG + (t * NST + jl) * 4) = sigmoidf_(a0c + za[e]);
                *(LAS float*)(lds + O_G2 + (t * NST + jl) * 4) = zg[e];
                *(LAS unsigned short*)(lds + O_VG + (t * ST + jl) * 2) = (unsigned short)f2bf(sigmoidf_(v0c + zv[e]));
            }
        }
        RK_BAR();
    }
    {
        const int j = lane, ch = h * 64 + j; float lw[8], cum[8], va[8], vb[8], vk[8], vr_[8], vv[8];
        const float mur = A.mu[ch], muk = A.mu[1024 + ch], muv = A.mu[2048 + ch], kkw = A.k_k[ch], kaw = A.k_a[ch], rkw = A.r_k[ch];
        const int tf = t0 + 8 * wid;
        const bf16* rp = A.rw + (size_t)tf * RWP + ch;
        float pr = 0.f, pk_ = 0.f, pv = 0.f;
        if (tf > 0) { pr = ldbf(rp - RWP); pk_ = ldbf(rp - RWP + 1024); pv = ldbf(rp - RWP + 2048); }
#pragma unroll
        for (int e = 0; e < 8; ++e) {
            const float cr = ldbf(rp + (size_t)e * RWP), ck = ldbf(rp + (size_t)e * RWP + 1024), cv = ldbf(rp + (size_t)e * RWP + 2048);
            const float r = cr + mur * (pr - cr), kr = ck + muk * (pk_ - ck), vr = cv + muv * (pv - cv);
            pr = cr; pk_ = ck; pv = cv;
            const int tl = 8 * wid + e;
            lw[e] = *(const LAS float*)(lds + O_NN + (tl * NST + j) * 4);
            const float ar = *(const LAS float*)(lds + O_GG + (tl * NST + j) * 4), g = *(const LAS float*)(lds + O_G2 + (tl * NST + j) * 4);
            const float vg = bf2f(*(const LAS unsigned short*)(lds + O_VG + (tl * ST + j) * 2));
            const float kkv = kr * kkw, ss = wave_sum(kkv * kkv), kk = kkv * (1.0f / fmaxf(sqrtf(ss), 1e-12f));
            va[e] = -kk; vb[e] = kk * ar; vk[e] = kr * (1.0f + (ar - 1.0f) * kaw); vr_[e] = r;
            const size_t go = (size_t)(tf + e) * 1024 + ch;
            float v;
            if (A.layer == 0) { v = vr; A.vfirst[go] = (bf16)f2bf(vr); } else { v = vr + (bf2f(A.vfirst[go]) - vr) * vg; }
            vv[e] = v;
            const float bonus = wave_sum(r * vk[e] * rkw);
            A.BV[go] = (bf16)f2bf(bonus * v); A.GB[go] = (bf16)f2bf(g);
        }
        cum[0] = lw[0];
#pragma unroll
        for (int e = 1; e < 8; ++e) cum[e] = cum[e - 1] + lw[e];
        SEG[wid * 64 + j] = cum[7];
        RK_BAR();
        float off = 0.f, tot = 0.f;
#pragma unroll
        for (int s = 0; s < 8; ++s) { const float v = SEG[s * 64 + j]; off += (s < wid) ? v : 0.f; tot += v; }
        if (wid == 0) GL[j] = __expf(tot);
#pragma unroll
        for (int e = 0; e < 8; ++e) {
            const float cm = cum[e] + off, g = __expf(cm), gi = __expf(-cm), gp = __expf(cm - lw[e]);
            const int o = ((8 * wid + e) * ST + j) * 2;
            *(LAS unsigned short*)(lds + O_AT + o) = (unsigned short)f2bf(va[e] * gp);
            *(LAS unsigned short*)(lds + O_BT + o) = (unsigned short)f2bf(vb[e] * gi);
            *(LAS unsigned short*)(lds + O_KT + o) = (unsigned short)f2bf(vk[e] * gi);
            *(LAS unsigned short*)(lds + O_RT + o) = (unsigned short)f2bf(vr_[e] * g);
            *(LAS unsigned short*)(lds + O_VV + o) = (unsigned short)f2bf(vv[e]);
        }
        RK_BAR();
    }
    {
        const bf16x8 bA0 = frag(lds + O_BT, 16 * b0, 0, lane), bA1 = frag(lds + O_BT, 16 * b0, 1, lane), kA0 = frag(lds + O_KT, 16 * b0, 0, lane), kA1 = frag(lds + O_KT, 16 * b0, 1, lane);
#pragma unroll
        for (int tt = 0; tt < 2; ++tt) {
            const int tb = 2 * (wid & 1) + tt;
            const bf16x8 aB0 = frag(lds + O_AT, 16 * tb, 0, lane), aB1 = frag(lds + O_AT, 16 * tb, 1, lane), rB0 = frag(lds + O_RT, 16 * tb, 0, lane), rB1 = frag(lds + O_RT, 16 * tb, 1, lane);
            const f32x4 z = {0.f, 0.f, 0.f, 0.f};
            f32x4 ab = mfma16(bA1, aB1, mfma16(bA0, aB0, z)), ak = mfma16(kA1, aB1, mfma16(kA0, aB0, z)), rb = mfma16(bA1, rB1, mfma16(bA0, rB0, z)), rk_ = mfma16(kA1, rB1, mfma16(kA0, rB0, z));
            const int tcol = 16 * tb + l15, srow = 16 * b0 + 4 * rq;
#pragma unroll
            for (int e = 0; e < 4; ++e) { const bool st = tcol > srow + e, le = tcol >= srow + e; ab[e] = st ? ab[e] : 0.f; ak[e] = st ? ak[e] : 0.f; rb[e] = le ? rb[e] : 0.f; rk_[e] = le ? rk_[e] : 0.f; }
            *(LAS f32x4*)(lds + O_NN + (tcol * NST + srow) * 4) = ab;
            const int o = (tcol * ST + srow) * 2;
            *(LAS u32x2*)(lds + O_AAK + o) = (u32x2){pk(ak[0], ak[1]), pk(ak[2], ak[3])};
            *(LAS u32x2*)(lds + O_ARB + o) = (u32x2){pk(rb[0], rb[1]), pk(rb[2], rb[3])};
            *(LAS u32x2*)(lds + O_ARK + o) = (u32x2){pk(rk_[0], rk_[1]), pk(rk_[2], rk_[3])};
        }
        RK_BAR();
    }
    {
        const bf16x8 vA0 = tfrag(lds + O_VV, 16 * b0, 0, lane), vA1 = tfrag(lds + O_VV, 16 * b0, 1, lane);
#pragma unroll
        for (int tt = 0; tt < 2; ++tt) {
            const int tb = 2 * (wid & 1) + tt;
            const f32x4 z = {0.f, 0.f, 0.f, 0.f};
            const f32x4 g = mfma16(vA1, frag(lds + O_AAK, 16 * tb, 1, lane), mfma16(vA0, frag(lds + O_AAK, 16 * tb, 0, lane), z));
            *(LAS f32x4*)(lds + O_GG + ((16 * tb + l15) * NST + 16 * b0 + 4 * rq) * 4) = g;
        }
        RK_BAR();
    }
    if (wid < 2) {
        float x[64];
        if (wid == 0) {
#pragma unroll
            for (int t = 0; t < 64; ++t) x[t] = bf2f(*(const LAS unsigned short*)(lds + O_AT + (t * ST + lane) * 2));
        } else {
#pragma unroll
            for (int t = 0; t < 64; ++t) x[t] = *(const LAS float*)(lds + O_GG + (t * NST + lane) * 4);
        }
        f32x4 na[16], nb[16];
        LAS unsigned char* nn = lds + O_NN; asm volatile("" : "+v"(nn));
        SolveRow<0>::load(na, nn);
        SolveRow<1>::run(x, na, nb, nn);
        LAS unsigned char* dst = lds + (wid == 0 ? O_WT : O_U0T) + lane * ST * 2;
#pragma unroll
        for (int i = 0; i < 8; ++i) *(LAS u32x4*)(dst + i * 16) = (u32x4){pk(x[8 * i], x[8 * i + 1]), pk(x[8 * i + 2], x[8 * i + 3]), pk(x[8 * i + 4], x[8 * i + 5]), pk(x[8 * i + 6], x[8 * i + 7])};
    }
    RK_BAR();
    {
        const bf16x8 wA0 = frag(lds + O_WT, 16 * b0, 0, lane), wA1 = frag(lds + O_WT, 16 * b0, 1, lane);
        const bf16x8 uA0 = frag(lds + O_U0T, 16 * b0, 0, lane), uA1 = frag(lds + O_U0T, 16 * b0, 1, lane);
        const bf16x8 vA0 = tfrag(lds + O_VV, 16 * b0, 0, lane), vA1 = tfrag(lds + O_VV, 16 * b0, 1, lane);
        const bf16x8 bA0 = tfrag(lds + O_BT, 16 * b0, 0, lane), bA1 = tfrag(lds + O_BT, 16 * b0, 1, lane);
        const bf16x8 kA0 = tfrag(lds + O_KT, 16 * b0, 0, lane), kA1 = tfrag(lds + O_KT, 16 * b0, 1, lane);
        const f32x4 glr = *(const LAS f32x4*)(lds + O_GL + (16 * b0 + 4 * rq) * 4);
#pragma unroll
        for (int tt = 0; tt < 2; ++tt) {
            const int nb = 2 * (wid & 1) + tt, col = 16 * nb + l15, row = 16 * b0 + 4 * rq;
            const f32x4 z = {0.f, 0.f, 0.f, 0.f};
            const bf16x8 rbB0 = frag(lds + O_ARB, 16 * nb, 0, lane), rbB1 = frag(lds + O_ARB, 16 * nb, 1, lane), rkB0 = frag(lds + O_ARK, 16 * nb, 0, lane), rkB1 = frag(lds + O_ARK, 16 * nb, 1, lane);
            { f32x4 d = mfma16(wA1, rbB1, mfma16(wA0, rbB0, z)); const u32x2 rt = *(const LAS u32x2*)(lds + O_RT + (col * ST + row) * 2);
              d[0] += bflo(rt.x); d[1] += bfhi(rt.x); d[2] += bflo(rt.y); d[3] += bfhi(rt.y);
              *(u32x2*)(A.RP + (size_t)(t0 + col) * 1024 + h * 64 + row) = (u32x2){pk(d[0], d[1]), pk(d[2], d[3])}; }
            { const f32x4 d = mfma16(vA1, rkB1, mfma16(vA0, rkB0, mfma16(uA1, rbB1, mfma16(uA0, rbB0, z))));
              *(f32x4*)(A.Y0 + (size_t)(t0 + col) * 1024 + h * 64 + row) = d; }
            { const bf16x8 bB0 = tfrag(lds + O_BT, 16 * nb, 0, lane), bB1 = tfrag(lds + O_BT, 16 * nb, 1, lane);
              f32x4 d = mfma16(wA1, bB1, mfma16(wA0, bB0, z)); const float gj = GL[col];
#pragma unroll
              for (int e = 0; e < 4; ++e) d[e] = gj * (d[e] + ((row + e) == col ? 1.f : 0.f));
              *(u32x2*)(A.PG + (size_t)uc * 4096 + ((((col >> 4) * 2 + (row >> 5)) * 64 + ((row >> 2) & 3) * 16 + (col & 15)) * 8 + ((row >> 4) & 1) * 4)) = (u32x2){pk(d[0], d[1]), pk(d[2], d[3])}; }
            { const bf16x8 uB0 = frag(lds + O_U0T, 16 * nb, 0, lane), uB1 = frag(lds + O_U0T, 16 * nb, 1, lane), vB0 = tfrag(lds + O_VV, 16 * nb, 0, lane), vB1 = tfrag(lds + O_VV, 16 * nb, 1, lane);
              f32x4 d = mfma16(kA1, vB1, mfma16(kA0, vB0, mfma16(bA1, uB1, mfma16(bA0, uB0, z))));
              d = d * glr;
              *(f32x4*)(A.QT + (size_t)uc * 4096 + ((((col >> 4) * 4 + (row >> 4)) * 64 + ((row >> 2) & 3) * 16 + (col & 15)) * 4)) = d; }
        }
    }
    RK_BAR();
}
__device__ __forceinline__ void ph_stage1(LAS unsigned char* lds, const S1Args& A, int blk, int nblk) {
    for (int c = blk; c < 256; c += nblk) {
        stage1_latents(lds, A, c * 64);
        RK_BAR();
#pragma unroll 1
        for (int h = 0; h < 16; ++h) stage1_unit(lds, A, c, h);
    }
}

struct ChainOps { bf16x8 a[4][2]; f32x4 c[4]; };
__device__ __forceinline__ void chain_load(ChainOps& o, const bf16* __restrict__ PG, const float* __restrict__ QT, int h, int ig, int c, int lane) {
    const bf16* P = PG + (size_t)(h * 256 + c) * 4096 + lane * 8; const float* Q = QT + (size_t)(h * 256 + c) * 4096 + (ig * 4 * 64 + lane) * 4;
#pragma unroll
    for (int m = 0; m < 4; ++m) { o.c[m] = *(const f32x4*)(Q + m * 256);
#pragma unroll
        for (int kb = 0; kb < 2; ++kb) o.a[m][kb] = *(const bf16x8*)(P + (m * 2 + kb) * 512); }
}
__device__ __forceinline__ void chain_step(f32x4 (&H)[4], const ChainOps& o, bf16* __restrict__ H0T, int h, int ig, int c, int lane) {
    const int fr = lane & 15, fq = lane >> 4;
    bf16* Ho = H0T + (size_t)(c * 16 + h) * 4096 + (16 * ig + fr) * 64 + 4 * fq;
    u32x4 bw[2];
#pragma unroll
    for (int m = 0; m < 4; ++m) { const u32x2 w = {pk(H[m][0], H[m][1]), pk(H[m][2], H[m][3])}; *(u32x2*)(Ho + 16 * m) = w; bw[m >> 1][2 * (m & 1)] = w.x; bw[m >> 1][2 * (m & 1) + 1] = w.y; }
#pragma unroll
    for (int m = 0; m < 4; ++m) H[m] = mfma16(o.a[m][1], __builtin_bit_cast(bf16x8, bw[1]), mfma16(o.a[m][0], __builtin_bit_cast(bf16x8, bw[0]), o.c[m]));
}
__device__ __forceinline__ void chain_wave(const bf16* __restrict__ PG, const float* __restrict__ QT, bf16* __restrict__ H0T, int h, int ig, int lane) {
    f32x4 H[4];
#pragma unroll
    for (int m = 0; m < 4; ++m) H[m] = (f32x4){0.f, 0.f, 0.f, 0.f};
    ChainOps s0, s1, s2, s3;
    chain_load(s0, PG, QT, h, ig, 0, lane); chain_load(s1, PG, QT, h, ig, 1, lane); chain_load(s2, PG, QT, h, ig, 2, lane); chain_load(s3, PG, QT, h, ig, 3, lane);
#pragma unroll 1
    for (int c = 0; c < 256; c += 4) {
        const bool more = c + 4 < 256;
        chain_step(H, s0, H0T, h, ig, c, lane);     if (more) chain_load(s0, PG, QT, h, ig, c + 4, lane);
        chain_step(H, s1, H0T, h, ig, c + 1, lane); if (more) chain_load(s1, PG, QT, h, ig, c + 5, lane);
        chain_step(H, s2, H0T, h, ig, c + 2, lane); if (more) chain_load(s2, PG, QT, h, ig, c + 6, lane);
        chain_step(H, s3, H0T, h, ig, c + 3, lane); if (more) chain_load(s3, PG, QT, h, ig, c + 7, lane);
    }
}
__device__ __forceinline__ void ph_chain(const bf16* PG, const float* QT, bf16* H0T, int blk, int nblk) {
    const int tid = opq_tid(), lane = tid & 63;
    for (int gw = blk * 8 + (tid >> 6); gw < 64; gw += nblk * 8) chain_wave(PG, QT, H0T, gw >> 2, gw & 3, lane);
}

struct S3Args { const bf16* H0T; const bf16* RP; const float* Y0; const bf16* BV; const bf16* GB; const float* ln_w; const float* ln_b; bf16* mixed; };
__device__ __forceinline__ void ph_stage3(const S3Args& A, int blk, int nblk) {
    const int tid = opq_tid(), lane = tid & 63, fr = lane & 15, fq = lane >> 4;
    for (int it = blk * 8 + (tid >> 6); it < 4096 * 4; it += nblk * 8) {
        const int u = it >> 2, tb = it & 3, c = u >> 4, h = u & 15, t = 64 * c + 16 * tb + fr;
        const bf16* Hp = A.H0T + (size_t)u * 4096 + fr * 64 + 8 * fq; const bf16* Rp = A.RP + (size_t)t * 1024 + h * 64 + 8 * fq;
        const bf16x8 r0 = *(const bf16x8*)Rp, r1 = *(const bf16x8*)(Rp + 32);
        f32x4 y[4];
#pragma unroll
        for (int ib = 0; ib < 4; ++ib) { const f32x4 y0 = *(const f32x4*)(A.Y0 + (size_t)t * 1024 + h * 64 + 16 * ib + 4 * fq);
            y[ib] = mfma16(*(const bf16x8*)(Hp + ib * 1024 + 32), r1, mfma16(*(const bf16x8*)(Hp + ib * 1024), r0, y0)); }
        float s = 0.f;
#pragma unroll
        for (int ib = 0; ib < 4; ++ib) s += (y[ib][0] + y[ib][1]) + (y[ib][2] + y[ib][3]);
        s += __shfl_xor(s, 16); s += __shfl_xor(s, 32);
        const float mean = s * (1.0f / 64.0f); float q = 0.f;
#pragma unroll
        for (int ib = 0; ib < 4; ++ib)
#pragma unroll
            for (int e = 0; e < 4; ++e) { const float d = y[ib][e] - mean; y[ib][e] = d; q += d * d; }
        q += __shfl_xor(q, 16); q += __shfl_xor(q, 32);
        const float rstd = 1.0f / sqrtf(q * (1.0f / 64.0f) + GN_EPS);
#pragma unroll
        for (int ib = 0; ib < 4; ++ib) { const int ch = h * 64 + 16 * ib + 4 * fq; const size_t o = (size_t)t * 1024 + ch;
            const f32x4 lw = *(const f32x4*)(A.ln_w + ch), lb = *(const f32x4*)(A.ln_b + ch); const u32x2 bv = *(const u32x2*)(A.BV + o), gg = *(const u32x2*)(A.GB + o); f32x4 r;
            const float bvf[4] = {bflo(bv.x), bfhi(bv.x), bflo(bv.y), bfhi(bv.y)}, ggf[4] = {bflo(gg.x), bfhi(gg.x), bflo(gg.y), bfhi(gg.y)};
#pragma unroll
            for (int e = 0; e < 4; ++e) r[e] = (y[ib][e] * rstd * lw[e] + lb[e] + bvf[e]) * ggf[e];
            *(u32x2*)(A.mixed + (size_t)t * DM + 1024 + ch) = (u32x2){pk(r[0], r[1]), pk(r[2], r[3])}; }
    }
}
}
#define XB_TMO      128
#define XB_XCNT(j)  (256  + 64 * (j))
#define XB_XSUB(j)  (1280 + 64 * (j))
#define XB_XGEN(j)  (2304 + 64 * (j))
#define XB_TOP      3328
#define XB_TOPGEN   3392
#define XCD_BAR_WORDS 3456
#define XB_SPIN_CAP (1u << 22)

__device__ __forceinline__ unsigned xb_ld(unsigned* p)              { return __hip_atomic_load(p, __ATOMIC_RELAXED, __HIP_MEMORY_SCOPE_AGENT); }
__device__ __forceinline__ unsigned xb_add(unsigned* p, unsigned v) { return __hip_atomic_fetch_add(p, v, __ATOMIC_RELAXED, __HIP_MEMORY_SCOPE_AGENT); }
__device__ __forceinline__ unsigned xb_xcc_id() { return (unsigned)__builtin_amdgcn_s_getreg((3 << 11) | 20) & 0xFu; }
#define XB_SPIN(cond, bar) do { unsigned _sp = 0; while (cond) { __builtin_amdgcn_s_sleep(1); \
    if ((++_sp & 255u) == 0u) { if (xb_ld(&(bar)[XB_TMO])) break; if (_sp > XB_SPIN_CAP) { atomicAdd(&(bar)[XB_TMO], 1u); break; } } } } while (0)

struct XcdBarrier {
    unsigned* bar; unsigned x;
    volatile LAS unsigned* st;
};

__device__ __forceinline__ XcdBarrier xcd_barrier_post(unsigned* bar, volatile LAS unsigned* st) {
    XcdBarrier b; b.bar = bar; b.x = xb_xcc_id(); b.st = st;
    if (threadIdx.x == 0) (void)xb_add(&bar[XB_XCNT(b.x)], 1u);
    return b;
}
__device__ __forceinline__ void xcd_barrier_complete(unsigned* bar, unsigned x, unsigned& nloc, unsigned& nx) {
    const unsigned G = gridDim.x * gridDim.y * gridDim.z;
    unsigned sum, cnt, mine, sp = 0u;
    for (;;) {
        sum = 0u; cnt = 0u; mine = 0u;
#pragma unroll
        for (unsigned j = 0; j < 16; ++j) { const unsigned c = xb_ld(&bar[XB_XCNT(j)]); sum += c; cnt += (c > 0u) ? 1u : 0u; mine = (j == x) ? c : mine; }
        if (sum == G) break;
        __builtin_amdgcn_s_sleep(1);
        if ((++sp & 255u) == 0u) { if (xb_ld(&bar[XB_TMO])) break; if (sp > XB_SPIN_CAP) { atomicAdd(&bar[XB_TMO], 1u); break; } }
    }
    nloc = mine > 0u ? mine : 1u; nx = cnt > 0u ? cnt : 1u;
}

__device__ __forceinline__ void xcd_barrier(const XcdBarrier& b) {
    asm volatile("s_waitcnt vmcnt(0)" ::: "memory");
    __syncthreads();
    if (threadIdx.x == 0) {
        unsigned* bar = b.bar;
        __builtin_amdgcn_s_waitcnt(0);
        unsigned nloc = b.st[0], nx = b.st[1];
        if (nloc == 0u) { xcd_barrier_complete(bar, b.x, nloc, nx); b.st[0] = nloc; b.st[1] = nx; }
        const unsigned old = xb_add(&bar[XB_XSUB(b.x)], 1u);
        const unsigned gen = old / nloc;
        if (old + 1u == (gen + 1u) * nloc) {
            __builtin_amdgcn_fence(__ATOMIC_RELEASE, "agent");
            asm volatile("s_waitcnt vmcnt(0)" ::: "memory");
            const unsigned og = xb_add(&bar[XB_TOP], 1u);
            const unsigned tg = og / nx;
            if (og + 1u == (tg + 1u) * nx) xb_add(&bar[XB_TOPGEN], 1u);
            else XB_SPIN(xb_ld(&bar[XB_TOPGEN]) == tg, bar);
            __builtin_amdgcn_fence(__ATOMIC_ACQUIRE, "agent");
            xb_add(&bar[XB_XGEN(b.x)], 1u);
            asm volatile("s_waitcnt vmcnt(0)" ::: "memory");
        } else {
            XB_SPIN(xb_ld(&bar[XB_XGEN(b.x)]) == gen, bar);
            __builtin_amdgcn_fence(__ATOMIC_ACQUIRE, "agent");
            asm volatile("s_waitcnt vmcnt(0)" ::: "memory");
        }
    }
    __syncthreads();
}

constexpr size_t MiB = 1u << 20;
constexpr size_t WS_CTL = 0, CTL_ZERO_BYTES = 64 * 1024, WS_RINV = 1 * MiB, WS_WIN = 2 * MiB, WS_WOUT = 28 * MiB, WS_WUP = 36 * MiB, WS_WDOWN = 68 * MiB, WS_LORA = 100 * MiB, WS_XB = 102 * MiB,
                 WS_Q = 166 * MiB, WS_K = 198 * MiB, WS_V = 230 * MiB, WS_RW = 262 * MiB, WS_MIXED = 374 * MiB, WS_U = 166 * MiB, WS_VFIRST = 438 * MiB, WS_PG = 470 * MiB, WS_QT = 502 * MiB, WS_RP = 566 * MiB,
                 WS_Y0 = 598 * MiB, WS_H0T = 662 * MiB, WS_BV = 694 * MiB, WS_GB = 726 * MiB, WS_STASH = 758 * MiB, WS_PART = 790 * MiB, WS_END = 1020 * MiB;
constexpr size_t LORA_W2 = 0, LORA_A2 = 1024 * 64 * 2, LORA_G2 = 2 * 1024 * 64 * 2, LORA_V2 = LORA_G2 + 1024 * 160 * 2;
constexpr int CW_BAR = 1024, CW_ATTQ = 512;
constexpr int RING_BYTES = 131072, MISC_OFF = 156000, LDS_BYTES = 156672;

struct Args { const float* in[26]; float* out; unsigned char* ws; int ph_lo, ph_hi; float lam_init[4]; };

template <bool PERMIN> __device__ __forceinline__ void convw_tile(LAS float* tile, const float* __restrict__ src, bf16* __restrict__ dst, const float* __restrict__ g, int K, int N, int item, int nkb, bool skipx = false) {
    const int k0 = (item % nkb) * 64, c0 = (item / nkb) * 64, tid = opq_tid();
    for (int i = tid; i < 64 * 64; i += 512) {
        const int kk = i >> 6, cc = i & 63, cp = c0 + cc; int col = cp;
        if (PERMIN) { const int lo = cp & 255, bj = lo >> 7, wc = (lo >> 5) & 3, j = lo & 31; col = (cp & ~255) + 64 * wc + 32 * bj + j; }
        float v = 0.f;
        if (col < N) { v = src[(size_t)(k0 + kk) * N + col]; if (g) v *= g[k0 + kk]; }
        tile[kk * 65 + cc] = v;
    }
    __syncthreads();
    for (int i = tid; i < 64 * 32; i += 512) {
        const int cc = i >> 5, kp = (i & 31) * 2, cp = c0 + cc;
        if (PERMIN && skipx && ((cp >= 6432 && cp < 6464) || (cp >= 6528 && cp < 6560))) continue;
        *(unsigned*)(dst + (size_t)cp * K + k0 + kp) = f2bf(tile[kp * 65 + cc]) | (f2bf(tile[(kp + 1) * 65 + cc]) << 16);
    }
    __syncthreads();
}
__device__ __forceinline__ void ph_convw(LAS unsigned char* lds, const __attribute__((address_space(4))) Args* a, int l, int blk, int nblk) {
    LAS float* tile = (LAS float*)lds; unsigned char* ws = a->ws;
    constexpr int I_IN = (DM / 64) * (NIN / 64), I_OUT = (DM / 64) * (DM / 64), I_UP = (DM / 64) * (DFF / 64), I_DN = (DFF / 64) * (DM / 64);
    for (int it = blk; it < I_IN + I_OUT + I_UP + I_DN; it += nblk) {
        int r = it;
        if (r < I_IN) { convw_tile<true>(tile, a->in[3] + (size_t)l * DM * PW, (bf16*)(ws + WS_WIN), a->in[1] + (size_t)l * DM, DM, PW, r, DM / 64, l > 0); continue; } r -= I_IN;
        if (r < I_OUT) { convw_tile<false>(tile, a->in[4] + (size_t)l * DM * DM, (bf16*)(ws + WS_WOUT), nullptr, DM, DM, r, DM / 64); continue; } r -= I_OUT;
        if (r < I_UP) { convw_tile<false>(tile, a->in[24] + (size_t)l * DM * DFF, (bf16*)(ws + WS_WUP), a->in[2] + (size_t)l * DM, DM, DFF, r, DM / 64); continue; } r -= I_UP;
        convw_tile<false>(tile, a->in[25] + (size_t)l * DFF * DM, (bf16*)(ws + WS_WDOWN), nullptr, DFF, DM, r, DFF / 64);
    }
    { const int tid = opq_tid(); const int lm = l > 0 ? l - 1 : 0;
      const float* w2 = a->in[12] + (size_t)l * 64 * 1024; const float* a2 = a->in[14] + (size_t)l * 64 * 1024; const float* g2 = a->in[15] + (size_t)l * 160 * 1024; const float* v2 = a->in[23] + (size_t)lm * 32 * 1024;
      bf16* lw = (bf16*)(ws + WS_LORA);
      for (int i = blk * 512 + tid; i < 1024 * 320; i += nblk * 512) {
          const int ch = i / 320, k = i % 320;
          if (k < 64) lw[LORA_W2 / 2 + ch * 64 + k] = (bf16)f2bf(w2[(size_t)k * 1024 + ch]);
          else if (k < 128) lw[LORA_A2 / 2 + ch * 64 + k - 64] = (bf16)f2bf(a2[(size_t)(k - 64) * 1024 + ch]);
          else if (k < 288) lw[LORA_G2 / 2 + ch * 160 + k - 128] = (bf16)f2bf(g2[(size_t)(k - 128) * 1024 + ch]);
          else lw[LORA_V2 / 2 + ch * 32 + k - 288] = (bf16)f2bf(v2[(size_t)(k - 288) * 1024 + ch]);
      } }
    if (l > 0) {
        const int tid = opq_tid(), kk = tid >> 6, o = tid & 63;
        const float* win = a->in[3] + (size_t)l * DM * PW; const float* g1 = a->in[1] + (size_t)l * DM; const float* muv = a->in[10] + (size_t)l * 3360 + 2048; const float* v1 = a->in[22] + (size_t)(l - 1) * 1024 * 32;
        bf16* wt = (bf16*)(ws + WS_WIN);
        for (int k0 = blk * 8; k0 < DM; k0 += nblk * 8) {
            const int k = k0 + kk; const float* wr = win + (size_t)k * PW + 5120; float acc = 0.f;
#pragma unroll 8
            for (int c = 0; c < 1024; ++c) { const float m = muv[c]; acc += wr[c] * ((o < 32) ? 1.0f - m : m) * v1[c * 32 + (o & 31)]; }
            const int row = (o < 32) ? 6528 + o : 6400 + o;
            wt[(size_t)row * DM + k] = (bf16)f2bf(acc * g1[k]);
        }
    }
}
__device__ __forceinline__ void ph_rownorm(const float* __restrict__ src, float* __restrict__ copy, bf16* __restrict__ xb, float* __restrict__ rinv, int blk, int nblk) {
    const int tid_ = opq_tid(), lane = tid_ & 63, gw = blk * 8 + (tid_ >> 6), ngw = nblk * 8;
    for (int row = gw; row < T_; row += ngw) {
        const f32x4* s = (const f32x4*)(src + (size_t)row * DM);
        float ss = 0.f;
#pragma unroll
        for (int j = 0; j < 8; ++j) { const f32x4 v = s[lane + 64 * j]; ss += (v[0] * v[0] + v[1] * v[1]) + (v[2] * v[2] + v[3] * v[3]);
            if (copy) ((f32x4*)(copy + (size_t)row * DM))[lane + 64 * j] = v;
            u32x2 w; w.x = f2bf(v[0]) | (f2bf(v[1]) << 16); w.y = f2bf(v[2]) | (f2bf(v[3]) << 16);
            ((u32x2*)(xb + (size_t)row * DM))[lane + 64 * j] = w; }
        ss = wave_sum(ss);
        if (lane == 0) rinv[row] = 1.0f / sqrtf(ss * (1.0f / DM) + RMS_EPS);
    }
}

constexpr int NPH = 9;
#ifndef PROBE_PH
#define PROBE_PH -1
#endif
#ifndef PROBE_REP
#define PROBE_REP 1
#endif
#define REP(k) for (int rep_ = 0; rep_ < ((k) == PROBE_PH ? PROBE_REP : 1); ++rep_)
typedef const __attribute__((address_space(4))) Args* CArgs;
__device__ __forceinline__ CArgs kargs() { CArgs p = (CArgs)__builtin_amdgcn_kernarg_segment_ptr(); asm volatile("" : "+s"(p)); return p; }
__global__ void __launch_bounds__(512, 2) fwd(Args args_unused) {
    extern __shared__ __attribute__((aligned(16))) unsigned char lds_raw[];
    LAS unsigned char* lds = (LAS unsigned char*)lds_raw;
    volatile LAS unsigned* MISC = (volatile LAS unsigned*)(lds + MISC_OFF);
    const int blk = (int)blockIdx.x, nblk = (int)gridDim.x;
    if (threadIdx.x < 32) MISC[threadIdx.x] = 0u;
    __syncthreads();
    int lo, hi; XcdBarrier bar;
    { CArgs ap = kargs(); lo = ap->ph_lo; hi = ap->ph_hi; unsigned* bw = (unsigned*)(ap->ws + WS_CTL) + CW_BAR; bar.bar = bw; bar.x = 0; bar.st = nullptr;
      if (hi - lo > 1) bar = xcd_barrier_post(bw, MISC + 8); }
#define IN(k) (lo <= (k) && (k) < hi)
#define SEAM(k) do { if (IN(k) && IN((k) + 1)) xcd_barrier(bar); } while (0)
#define WSP(T, off) ((T*)(ws + (off)))
#pragma unroll 1
    for (int l = 0; l < NL; ++l) {
        const int pb = l * NPH;
        if (IN(pb + 0)) REP(0) {
            CArgs ap = kargs(); unsigned char* ws = ap->ws;
            ph_convw(lds, ap, l, blk, nblk);
            ph_rownorm(l == 0 ? ap->in[0] : ap->out, l == 0 ? ap->out : nullptr, WSP(bf16, WS_XB), WSP(float, WS_RINV), blk, nblk);
        }
        SEAM(pb + 0);
        if (IN(pb + 1)) REP(1) {
            CArgs ap = kargs(); unsigned char* ws = ap->ws;
            pg8::Gemm g{WSP(bf16, WS_XB), WSP(bf16, WS_WIN), T_, NIN, DM, 0}; pg8::StaticOrder S; S.init(T_, NIN, nblk, blk);
            pg8::EpiIn E{WSP(float, WS_RINV), WSP(bf16, WS_Q), WSP(bf16, WS_K), WSP(bf16, WS_V), WSP(bf16, WS_RW), ap->in[5] + l * 128, ap->in[6] + l * 128};
            pg8::gemm_phase<pg8::EpiIn, pg8::StaticOrder, true, true>(lds, g, S, E);
        }
        SEAM(pb + 1);
        if (IN(pb + 2)) REP(2) {
            CArgs ap = kargs(); unsigned char* ws = ap->ws; const int lm = l > 0 ? l - 1 : 0;
            rk::S1Args A; A.rw = WSP(bf16, WS_RW); A.mu = ap->in[10] + (size_t)l * 3360; A.w0 = ap->in[11] + l * 1024; A.a0 = ap->in[13] + l * 1024; A.v0 = ap->in[21] + lm * 1024; A.k_k = ap->in[16] + l * 1024; A.k_a = ap->in[17] + l * 1024;
            A.r_k = ap->in[18] + l * 1024; A.w2t = (const bf16*)(ws + WS_LORA + LORA_W2); A.a2t = (const bf16*)(ws + WS_LORA + LORA_A2); A.g2t = (const bf16*)(ws + WS_LORA + LORA_G2); A.v2t = (const bf16*)(ws + WS_LORA + LORA_V2);
            A.vfirst = WSP(bf16, WS_VFIRST); A.BV = WSP(bf16, WS_BV); A.GB = WSP(bf16, WS_GB); A.PG = WSP(bf16, WS_PG); A.QT = WSP(float, WS_QT); A.RP = WSP(bf16, WS_RP); A.Y0 = WSP(float, WS_Y0); A.layer = l; A.pad_ = 0;
            rk::ph_stage1(lds, A, blk, nblk);
        }
        SEAM(pb + 2);
        if (IN(pb + 3)) {
            CArgs ap = kargs(); unsigned char* ws = ap->ws;
            rk::ph_chain(WSP(bf16, WS_PG), WSP(float, WS_QT), WSP(bf16, WS_H0T), blk, nblk);
            att::Args A; A.Q = WSP(bf16, WS_Q); A.K = WSP(bf16, WS_K); A.V = WSP(bf16, WS_V); A.mixed = WSP(bf16, WS_MIXED); A.stash = WSP(float, WS_STASH); A.lq = ap->in[7] + l * 128; A.lk = ap->in[8] + l * 128; A.subln = ap->in[9] + l * 128; A.gq = ap->in[5] + l * 128; A.gk = ap->in[6] + l * 128;
            A.lam_init = ap->lam_init[l]; A.pad_ = 0;
            att::attn_phase(lds, A, blk, (unsigned*)(ws + WS_CTL) + CW_ATTQ + 64 * l, MISC + 16, WSP(float, WS_PART));
        }
        SEAM(pb + 3);
        if (IN(pb + 4)) REP(4) {
            CArgs ap = kargs(); unsigned char* ws = ap->ws;
            rk::S3Args A{WSP(bf16, WS_H0T), WSP(bf16, WS_RP), WSP(float, WS_Y0), WSP(bf16, WS_BV), WSP(bf16, WS_GB), ap->in[19] + l * 1024, ap->in[20] + l * 1024, WSP(bf16, WS_MIXED)};
            rk::ph_stage3(A, blk, nblk);
            att::Args B; B.Q = WSP(bf16, WS_Q); B.K = WSP(bf16, WS_K); B.V = WSP(bf16, WS_V); B.mixed = WSP(bf16, WS_MIXED); B.stash = WSP(float, WS_STASH); B.lq = ap->in[7] + l * 128; B.lk = ap->in[8] + l * 128; B.subln = ap->in[9] + l * 128;
            B.gq = ap->in[5] + l * 128; B.gk = ap->in[6] + l * 128; B.lam_init = ap->lam_init[l]; B.pad_ = 0;
            att::attn_combine(lds, B, blk, nblk, WSP(float, WS_PART));
        }
        SEAM(pb + 4);
        if (IN(pb + 5)) {
            CArgs ap = kargs(); unsigned char* ws = ap->ws;
            pg8::Gemm g{WSP(bf16, WS_MIXED), WSP(bf16, WS_WOUT), T_, DM, DM, 0}; pg8::StaticOrder S; S.init(T_, DM, nblk, blk);
            pg8::EpiRes E{ap->out, DM, 0};
            pg8::gemm_phase<pg8::EpiRes, pg8::StaticOrder, true, true>(lds, g, S, E);
        }
        SEAM(pb + 5);
        if (IN(pb + 6)) { CArgs ap = kargs(); unsigned char* ws = ap->ws; ph_rownorm(ap->out, nullptr, WSP(bf16, WS_XB), WSP(float, WS_RINV), blk, nblk); }
        SEAM(pb + 6);
        if (IN(pb + 7)) REP(7) {
            CArgs ap = kargs(); unsigned char* ws = ap->ws;
            pg8::Gemm g{WSP(bf16, WS_XB), WSP(bf16, WS_WUP), T_, DFF, DM, 0}; pg8::StaticOrder S; S.init(T_, DFF, nblk, blk);
            pg8::EpiUp E{WSP(float, WS_RINV), WSP(bf16, WS_U), DFF, 0};
            pg8::gemm_phase<pg8::EpiUp, pg8::StaticOrder, true, true>(lds, g, S, E);
        }
        SEAM(pb + 7);
        if (IN(pb + 8)) {
            CArgs ap = kargs(); unsigned char* ws = ap->ws;
            pg8::Gemm g{WSP(bf16, WS_U), WSP(bf16, WS_WDOWN), T_, DM, DFF, 0}; pg8::StaticOrder S; S.init(T_, DM, nblk, blk);
            pg8::EpiRes E{ap->out, DM, 0};
            pg8::gemm_phase<pg8::EpiRes, pg8::StaticOrder, true, true>(lds, g, S, E);
        }
        SEAM(pb + 8);
    }
#undef IN
#undef SEAM
#undef WSP
}

#ifndef MK_PER_PHASE
#define MK_PER_PHASE 0
#endif
extern "C" void kernel_launch(void* const* d_in, const int* in_sizes, int n_in, void* d_out, int out_size, void* d_ws, size_t ws_size, hipStream_t stream) {
    static int grid = 0;
    if (grid == 0) {
        grid = -1;
        if (n_in != 26 || ws_size < WS_END || out_size != T_ * DM) { fprintf(stderr, "kernel_launch: unexpected shapes (n_in %d ws %zu out %d)\n", n_in, ws_size, out_size); return; }
        int dev = 0, cus = 0, per_cu = 0;
        if (hipGetDevice(&dev) != hipSuccess || hipDeviceGetAttribute(&cus, hipDeviceAttributeMultiprocessorCount, dev) != hipSuccess) return;
        if (hipFuncSetAttribute((const void*)fwd, hipFuncAttributeMaxDynamicSharedMemorySize, LDS_BYTES) != hipSuccess) return;
        if (hipOccupancyMaxActiveBlocksPerMultiprocessor(&per_cu, (const void*)fwd, 512, LDS_BYTES) != hipSuccess || per_cu < 1) { fprintf(stderr, "kernel_launch: occupancy query says %d\n", per_cu); (void)hipGetLastError(); return; }
        grid = cus;
    }
    if (grid < 0) return;
    if (hipMemsetAsync((char*)d_ws + WS_CTL, 0, CTL_ZERO_BYTES, stream) != hipSuccess) return;
    Args a;
    memset(&a, 0, sizeof(a));
    for (int i = 0; i < 26; ++i) a.in[i] = (const float*)d_in[i];
    a.out = (float*)d_out; a.ws = (unsigned char*)d_ws;
    for (int l = 0; l < NL; ++l) a.lam_init[l] = (float)(0.8 - 0.6 * exp(-0.3 * (double)l));
    const int nph = NL * NPH;
#if MK_PER_PHASE
    for (int p = 0; p < nph; ++p) { a.ph_lo = p; a.ph_hi = p + 1; hipLaunchKernelGGL(fwd, dim3(grid), dim3(512), LDS_BYTES, stream, a); }
#else
    a.ph_lo = 0; a.ph_hi = nph; hipLaunchKernelGGL(fwd, dim3(grid), dim3(512), LDS_BYTES, stream, a);
#endif
}
```

```cpp
#include <hip/hip_runtime.h>
#include <cstdio>
#include <cstdint>
#include <cstring>
#include <cmath>

constexpr int T_ = 16384, DM = 2048, NL = 4, PW = 6432, NIN = 6656, RWP = 3584, DFF = 8192, RW_ = 1024;
constexpr float RMS_EPS = 1e-6f, GN_EPS = 64e-5f;
typedef unsigned short bf16;
typedef float f32x4 __attribute__((ext_vector_type(4)));
typedef unsigned u32x4 __attribute__((ext_vector_type(4)));
typedef unsigned u32x2 __attribute__((ext_vector_type(2)));
#define LAS __attribute__((address_space(3)))

__device__ __forceinline__ unsigned f2bf(float f) { unsigned u = __builtin_bit_cast(unsigned, f); return (u + 0x7fffu + ((u >> 16) & 1u)) >> 16; }
__device__ __forceinline__ float bf2f(unsigned short b) { return __builtin_bit_cast(float, (unsigned)b << 16); }
__device__ __forceinline__ float bflo(unsigned w) { return __builtin_bit_cast(float, w << 16); }
__device__ __forceinline__ float bfhi(unsigned w) { return __builtin_bit_cast(float, w & 0xffff0000u); }
__device__ __forceinline__ float sigmoidf_(float x) { return 1.0f / (1.0f + __expf(-x)); }

template <int CTRL, int ROWMASK> __device__ __forceinline__ float dppf(float v) {
    return __builtin_bit_cast(float, __builtin_amdgcn_update_dpp(0, __builtin_bit_cast(int, v), CTRL, ROWMASK, 0xF, false));
}
__device__ __forceinline__ float wave_sum(float v) {
    v += dppf<0xB1, 0xF>(v); v += dppf<0x4E, 0xF>(v); v += dppf<0x141, 0xF>(v); v += dppf<0x140, 0xF>(v);
    v += dppf<0x142, 0xA>(v); v += dppf<0x143, 0xC>(v);
    return __builtin_bit_cast(float, __builtin_amdgcn_readlane(__builtin_bit_cast(int, v), 63));
}
__device__ __forceinline__ int opq_tid() { int t = (int)threadIdx.x; asm volatile("" : "+v"(t)); return t; }
namespace pg8 {
#define PG8_LAS __attribute__((address_space(3)))
typedef unsigned short bf16_t;
typedef short bf16x8 __attribute__((ext_vector_type(8)));
typedef float f32x4 __attribute__((ext_vector_type(4)));
typedef unsigned u32x4 __attribute__((ext_vector_type(4)));
constexpr int BM = 256, BK = 64, HALF = 128, HTB = HALF * BK * 2  , STAGE_BYTES = 8 * HTB, NXCD = 8, WGM = 8;

__host__ __device__ __forceinline__ int lds_byte(int r, int c) { const int st = (r >> 4) * 2 + (c >> 5), rr = r & 15, cc = c & 31, ob = rr * 64 + cc * 2; return st * 1024 + (ob ^ (((ob >> 9) & 1) << 5)); }
__host__ __device__ __forceinline__ void stage_rc(int b, int& R, int& C) { const int st = b / 1024, sb = b % 1024, swz = sb ^ (((sb >> 9) & 1) << 5); R = (st >> 1) * 16 + swz / 64; C = (st & 1) * 32 + (swz % 64) / 2; }
__host__ __device__ __forceinline__ int perm32(int rho) { const int n = rho >> 4, i = rho & 15; return 8 * (i >> 2) + 4 * n + (i & 3); }

struct Unit { int pm, pn; };
struct Gemm { const bf16_t* A; const bf16_t* Bt; int M, N, K, pad_; };

struct StaticOrder {
    int nM, nN, nwg, G, c;
    __host__ __device__ void init(int M, int N, int G_, int c_) { nM = M / BM; nN = N / BM; nwg = nM * nN; G = G_; c = c_; }
    __host__ __device__ bool next(int i, Unit& u) const {
        const long L = (long)i * G + c; if (L >= nwg) return false;
        int wgid = (int)L; { const int q = nwg / NXCD, r = nwg % NXCD, xcd = wgid % NXCD, off = wgid / NXCD; wgid = (xcd < r ? xcd * (q + 1) : r * (q + 1) + (xcd - r) * q) + off; }
        const int nig = WGM * nN, gid = wgid / nig, fm = gid * WGM, gsz = (nM - fm) < WGM ? (nM - fm) : WGM;
        u.pm = fm + ((wgid % nig) % gsz); u.pn = (wgid % nig) / gsz; return true;
    }
    __device__ __forceinline__ void a_ready(const Unit&) const {}
    __device__ __forceinline__ void done(const Unit&) const {}
};

__device__ __forceinline__ unsigned cvt_pk_bf16(float lo, float hi) { unsigned r; asm volatile("v_cvt_pk_bf16_f32 %0, %1, %2" : "=v"(r) : "v"(lo), "v"(hi)); return r; }
typedef float f32x2 __attribute__((ext_vector_type(2)));
__device__ __forceinline__ float row_ssq(const float* ssq, int row, int fq) {
    const f32x4 a = *(const f32x4*)(ssq + (size_t)row * 32 + 8 * fq), b = *(const f32x4*)(ssq + (size_t)row * 32 + 8 * fq + 4);
    float s = ((a[0] + a[1]) + (a[2] + a[3])) + ((b[0] + b[1]) + (b[2] + b[3]));
    s += __shfl_xor(s, 16); s += __shfl_xor(s, 32); return s;
}
struct EpiIn {
    static constexpr bool PERM = true, AFTER_DRAIN = false;
    const float* rinv; bf16_t* q; bf16_t* k; bf16_t* v; bf16_t* rw; const float* gq; const float* gk;
    __device__ __forceinline__ void operator()(const f32x4 (&acc)[2][2][4][2], const Unit& u, int wr, int wc, int fr, int fq) const {
        const int pn = u.pn;
        const int row0 = u.pm * BM + wr * 64 + fr;
        if (pn < 8) {
            const float* g = (pn < 4 ? gq : gk) + (wc & 1) * 64 + 8 * fq;
            f32x4 gv[2][2];
#pragma unroll
            for (int bj = 0; bj < 2; ++bj)
#pragma unroll
                for (int n = 0; n < 2; ++n) gv[bj][n] = *(const f32x4*)(g + 32 * bj + 4 * n);
            bf16_t* base = (pn < 4 ? q : k) + (pn & 3) * 256 + 64 * wc + 8 * fq;
#pragma unroll
            for (int ai = 0; ai < 2; ++ai)
#pragma unroll
                for (int m = 0; m < 4; ++m) {
                    const int row = row0 + ai * HALF + m * 16; const float ri = 1.0f / sqrtf(row_ssq(rinv, row, fq) * (1.0f / 2048.0f) + 1e-6f);
                    f32x4 vv[2][2]; float ss = 0.f;
#pragma unroll
                    for (int bj = 0; bj < 2; ++bj)
#pragma unroll
                        for (int n = 0; n < 2; ++n) { vv[bj][n] = acc[ai][bj][m][n] * ri; const f32x4 t = vv[bj][n]; ss += (t[0] * t[0] + t[1] * t[1]) + (t[2] * t[2] + t[3] * t[3]); }
                    ss += __shfl_xor(ss, 16); ss += __shfl_xor(ss, 32);
                    const float rq = 1.0f / sqrtf(ss * (1.0f / 64.0f) + 1e-6f);
#pragma unroll
                    for (int bj = 0; bj < 2; ++bj) { const f32x4 a = vv[bj][0] * rq * gv[bj][0], b = vv[bj][1] * rq * gv[bj][1];
                        u32x4 w; w.x = cvt_pk_bf16(a[0], a[1]); w.y = cvt_pk_bf16(a[2], a[3]); w.z = cvt_pk_bf16(b[0], b[1]); w.w = cvt_pk_bf16(b[2], b[3]);
                        *(u32x4*)(base + (size_t)row * 1024 + 32 * bj) = w; }
                }
        } else {
            bf16_t* base; int ld;
            if (pn < 12) { base = v + (pn - 8) * 256 + 64 * wc + 8 * fq; ld = 1024; } else { base = rw + (pn - 12) * 256 + 64 * wc + 8 * fq; ld = 3584; }
#pragma unroll
            for (int ai = 0; ai < 2; ++ai)
#pragma unroll
                for (int m = 0; m < 4; ++m) {
                    const int row = row0 + ai * HALF + m * 16; const float ri = 1.0f / sqrtf(row_ssq(rinv, row, fq) * (1.0f / 2048.0f) + 1e-6f);
#pragma unroll
                    for (int bj = 0; bj < 2; ++bj) { const f32x4 a = acc[ai][bj][m][0] * ri, b = acc[ai][bj][m][1] * ri;
                        u32x4 w; w.x = cvt_pk_bf16(a[0], a[1]); w.y = cvt_pk_bf16(a[2], a[3]); w.z = cvt_pk_bf16(b[0], b[1]); w.w = cvt_pk_bf16(b[2], b[3]);
                        *(u32x4*)(base + (size_t)row * ld + 32 * bj) = w; }
                }
        }
    }
};
struct EpiRes {
    static constexpr bool PERM = true, AFTER_DRAIN = false;
    float* x; bf16_t* xb; float* ssq; int ldc; int pad_;
    __device__ __forceinline__ void operator()(const f32x4 (&acc)[2][2][4][2], const Unit& u, int wr, int wc, int fr, int fq) const {
        const int row0 = u.pm * BM + wr * 64 + fr, col0 = u.pn * BM + wc * 32 + 8 * fq;
#pragma unroll
        for (int ai = 0; ai < 2; ++ai)
#pragma unroll
            for (int m = 0; m < 4; ++m) { const int row = row0 + ai * HALF + m * 16; float* rowp = x + (size_t)row * ldc + col0; bf16_t* rowb = xb + (size_t)row * ldc + col0; float ss = 0.f;
#pragma unroll
                for (int bj = 0; bj < 2; ++bj) { f32x4* p = (f32x4*)(rowp + bj * HALF); const f32x4 o0 = p[0] + acc[ai][bj][m][0], o1 = p[1] + acc[ai][bj][m][1]; p[0] = o0; p[1] = o1;
                    ss += ((o0[0] * o0[0] + o0[1] * o0[1]) + (o0[2] * o0[2] + o0[3] * o0[3])) + ((o1[0] * o1[0] + o1[1] * o1[1]) + (o1[2] * o1[2] + o1[3] * o1[3]));
                    u32x4 w; w.x = cvt_pk_bf16(o0[0], o0[1]); w.y = cvt_pk_bf16(o0[2], o0[3]); w.z = cvt_pk_bf16(o1[0], o1[1]); w.w = cvt_pk_bf16(o1[2], o1[3]);
                    *(u32x4*)(rowb + bj * HALF) = w; }
                ss += __shfl_xor(ss, 16); ss += __shfl_xor(ss, 32);
                if (fq == 0) ssq[(size_t)row * 32 + u.pn * 4 + wc] = ss; }
    }
};
struct EpiUp {
    static constexpr bool PERM = true, AFTER_DRAIN = false;
    const float* rinv; bf16_t* o; int ldc; int pad_;
    __device__ __forceinline__ void operator()(const f32x4 (&acc)[2][2][4][2], const Unit& u, int wr, int wc, int fr, int fq) const {
        const int row0 = u.pm * BM + wr * 64 + fr, col0 = u.pn * BM + wc * 32 + 8 * fq;
#pragma unroll
        for (int ai = 0; ai < 2; ++ai)
#pragma unroll
            for (int m = 0; m < 4; ++m) { const int row = row0 + ai * HALF + m * 16; const float ri = 1.0f / sqrtf(row_ssq(rinv, row, fq) * (1.0f / 2048.0f) + 1e-6f);   bf16_t* rowp = o + (size_t)row * ldc + col0;
#pragma unroll
                for (int bj = 0; bj < 2; ++bj) { f32x4 a = acc[ai][bj][m][0] * ri, b = acc[ai][bj][m][1] * ri;
#pragma unroll
                    for (int e = 0; e < 4; ++e) { a[e] = a[e] > 0.f ? a[e] * a[e] : 0.f; b[e] = b[e] > 0.f ? b[e] * b[e] : 0.f; }
                    u32x4 w; w.x = cvt_pk_bf16(a[0], a[1]); w.y = cvt_pk_bf16(a[2], a[3]); w.z = cvt_pk_bf16(b[0], b[1]); w.w = cvt_pk_bf16(b[2], b[3]);
                    *(u32x4*)(rowp + bj * HALF) = w; } }
    }
};
template <class Epi, class Sched, bool ALIGN_EPI = false, bool SP2 = false>
__device__ __forceinline__ void gemm_phase(PG8_LAS unsigned char* lds, const Gemm g, const Sched& S, const Epi& E) {
    const int tid = opq_tid(), wid = __builtin_amdgcn_readfirstlane(tid >> 6), lane = tid & 63, wr = wid >> 2, wc = wid & 3, fr = lane & 15, fq = lane >> 4;
    const int K = g.K, nt = K / BK;
    unsigned voffA[2], voffB[2];
#pragma unroll
    for (int i = 0; i < 2; ++i) { int R, C; stage_rc(tid * 16 + i * 8192, R, C); const int Rb = Epi::PERM ? ((R & ~31) + perm32(R & 31)) : R;
        voffA[i] = (unsigned)(R * K + C) * 2u; voffB[i] = (unsigned)(Rb * K + C) * 2u; }
    const size_t kstep = (size_t)(BK * 2);
    const size_t hstep = (size_t)HALF * K * 2;
    const size_t tstep = 2 * hstep;
    const unsigned ldsw = (unsigned)wid * 1024u;
    const int aoff = lds_byte(wr * 64 + fr, fq * 8), boff = lds_byte(wc * 32 + fr, fq * 8);
#define PG8_SA(b, h) (((b) * 2 + (h)) * HTB)
#define PG8_SB(b, h) ((4 + (b) * 2 + (h)) * HTB)
#define PG8_STAGE(bufoff, gbase, voff) do { _Pragma("unroll") for (int _i = 0; _i < 2; ++_i) \
        __builtin_amdgcn_global_load_lds((const unsigned*)((const char*)(gbase) + (voff)[_i]), (PG8_LAS unsigned*)(lds + (bufoff) + ldsw + _i * 8192), 16, 0, 0); } while (0)
#define PG8_LDA(dst, b, h) do { _Pragma("unroll") for (int m = 0; m < 4; ++m) _Pragma("unroll") for (int k = 0; k < 2; ++k) dst[m][k] = *(const PG8_LAS bf16x8*)(lds + PG8_SA(b, h) + aoff + m * 2048 + k * 1024); } while (0)
#define PG8_LDB(dst, b, h) do { _Pragma("unroll") for (int n = 0; n < 2; ++n) _Pragma("unroll") for (int k = 0; k < 2; ++k) dst[n][k] = *(const PG8_LAS bf16x8*)(lds + PG8_SB(b, h) + boff + n * 2048 + k * 1024); } while (0)
#define PG8_MMA(ai, bj, At, Bt) do { __builtin_amdgcn_s_setprio(1); _Pragma("unroll") for (int m = 0; m < 4; ++m) _Pragma("unroll") for (int n = 0; n < 2; ++n) _Pragma("unroll") for (int k = 0; k < 2; ++k) \
        acc[ai][bj][m][n] = __builtin_amdgcn_mfma_f32_16x16x32_bf16(Bt[n][k], At[m][k], acc[ai][bj][m][n], 0, 0, 0); __builtin_amdgcn_s_setprio(0); } while (0)
#define PG8_WAIT_V(n) asm volatile("s_waitcnt vmcnt(" #n ")" ::: "memory")
#define PG8_WAIT_L(n) asm volatile("s_waitcnt lgkmcnt(" #n ")" ::: "memory")
#define PG8_BAR __builtin_amdgcn_s_barrier()
#define PG8_SCHED __builtin_amdgcn_sched_barrier(0)
    Unit cur, nxt; int ui = 0;
    if (!S.next(0, cur)) return;
    f32x4 acc[2][2][4][2];
#pragma unroll
    for (int a = 0; a < 2; ++a)
#pragma unroll
        for (int b = 0; b < 2; ++b)
#pragma unroll
            for (int m = 0; m < 4; ++m)
#pragma unroll
                for (int n = 0; n < 2; ++n) acc[a][b][m][n] = (f32x4){0.f, 0.f, 0.f, 0.f};
    bf16x8 At[4][2], B0[2][2], B1[2][2];
    const char* cA = (const char*)g.A + (size_t)cur.pm * tstep; const char* cB = (const char*)g.Bt + (size_t)cur.pn * tstep;
    S.a_ready(cur);
    if constexpr (SP2) {
        PG8_STAGE(PG8_SB(0, 0), cB, voffB); PG8_STAGE(PG8_SB(0, 1), cB + hstep, voffB); PG8_STAGE(PG8_SA(0, 0), cA, voffA); PG8_STAGE(PG8_SA(0, 1), cA + hstep, voffA);
        if (wr == 1) PG8_BAR;
        PG8_WAIT_V(2); PG8_BAR;
        PG8_STAGE(PG8_SB(1, 0), cB + kstep, voffB); PG8_STAGE(PG8_SA(1, 0), cA + kstep, voffA); PG8_STAGE(PG8_SB(1, 1), cB + hstep + kstep, voffB);
        PG8_WAIT_V(6); PG8_BAR;
    } else {
        PG8_STAGE(PG8_SB(0, 0), cB, voffB); PG8_STAGE(PG8_SA(0, 0), cA, voffA); PG8_STAGE(PG8_SB(0, 1), cB + hstep, voffB); PG8_STAGE(PG8_SA(0, 1), cA + hstep, voffA);
        if (wr == 1) PG8_BAR;
        PG8_WAIT_V(4); PG8_BAR;
        PG8_STAGE(PG8_SB(1, 0), cB + kstep, voffB); PG8_STAGE(PG8_SA(1, 0), cA + kstep, voffA); PG8_STAGE(PG8_SB(1, 1), cB + hstep + kstep, voffB);
        PG8_WAIT_V(6); PG8_BAR;
    }
    for (;;) {
        const bool has_next = S.next(ui + 1, nxt);
        const char* nA = has_next ? (const char*)g.A + (size_t)nxt.pm * tstep : cA; const char* nB = has_next ? (const char*)g.Bt + (size_t)nxt.pn * tstep : cB;
        for (int t = 0; t < nt; t += 2) {
            const bool last = (t == nt - 2);
            const char* a1 = cA + (size_t)(t + 1) * kstep;
            const char* a2 = last ? nA : cA + (size_t)(t + 2) * kstep; const char* b2 = last ? nB : cB + (size_t)(t + 2) * kstep;
            const char* a3 = a2 + kstep; const char* b3 = b2 + kstep;
            if (last && has_next) S.a_ready(nxt);
            if constexpr (SP2) {
            PG8_LDB(B0, 0, 0); PG8_LDB(B1, 0, 1); PG8_SCHED; PG8_LDA(At, 0, 0); PG8_STAGE(PG8_SA(1, 1), a1 + hstep, voffA);
            PG8_WAIT_V(8); PG8_WAIT_L(0); PG8_BAR; PG8_MMA(0, 0, At, B0); PG8_MMA(0, 1, At, B1); PG8_BAR; PG8_SCHED;
            PG8_LDA(At, 0, 1); PG8_STAGE(PG8_SB(0, 0), b2, voffB); PG8_STAGE(PG8_SB(0, 1), b2 + hstep, voffB); PG8_STAGE(PG8_SA(0, 0), a2, voffA);
            PG8_WAIT_V(8); PG8_WAIT_L(0); PG8_BAR; PG8_MMA(1, 0, At, B0); PG8_MMA(1, 1, At, B1); PG8_BAR; PG8_SCHED;
            PG8_LDB(B0, 1, 0); PG8_LDB(B1, 1, 1); PG8_SCHED; PG8_LDA(At, 1, 0); PG8_STAGE(PG8_SA(0, 1), a2 + hstep, voffA);
            PG8_WAIT_V(8); PG8_WAIT_L(0); PG8_BAR; PG8_MMA(0, 0, At, B0); PG8_MMA(0, 1, At, B1); PG8_BAR; PG8_SCHED;
            PG8_LDA(At, 1, 1); PG8_STAGE(PG8_SB(1, 0), b3, voffB); PG8_STAGE(PG8_SB(1, 1), b3 + hstep, voffB); PG8_STAGE(PG8_SA(1, 0), a3, voffA);
            PG8_WAIT_V(8); PG8_WAIT_L(0); PG8_BAR; PG8_MMA(1, 0, At, B0); PG8_MMA(1, 1, At, B1); PG8_BAR; PG8_SCHED;
            } else {
            PG8_LDB(B0, 0, 0); PG8_SCHED; PG8_LDA(At, 0, 0); PG8_STAGE(PG8_SA(1, 1), a1 + hstep, voffA);
            PG8_WAIT_L(8); PG8_BAR; PG8_WAIT_L(0); PG8_MMA(0, 0, At, B0); PG8_BAR; PG8_SCHED;
            PG8_LDB(B1, 0, 1); PG8_STAGE(PG8_SB(0, 0), b2, voffB);
            PG8_BAR; PG8_WAIT_L(0); PG8_MMA(0, 1, At, B1); PG8_BAR;
            PG8_LDA(At, 0, 1); PG8_STAGE(PG8_SA(0, 0), a2, voffA);
            PG8_BAR; PG8_WAIT_L(0); PG8_MMA(1, 0, At, B0); PG8_BAR; PG8_SCHED;
            PG8_STAGE(PG8_SB(0, 1), b2 + hstep, voffB);
            PG8_WAIT_V(6); PG8_BAR; PG8_MMA(1, 1, At, B1); PG8_BAR;
            PG8_LDB(B0, 1, 0); PG8_SCHED; PG8_LDA(At, 1, 0); PG8_STAGE(PG8_SA(0, 1), a2 + hstep, voffA);
            PG8_WAIT_L(8); PG8_BAR; PG8_WAIT_L(0); PG8_MMA(0, 0, At, B0); PG8_BAR; PG8_SCHED;
            PG8_LDB(B1, 1, 1); PG8_STAGE(PG8_SB(1, 0), b3, voffB);
            PG8_BAR; PG8_WAIT_L(0); PG8_MMA(0, 1, At, B1); PG8_BAR;
            PG8_LDA(At, 1, 1); PG8_STAGE(PG8_SA(1, 0), a3, voffA);
            PG8_BAR; PG8_WAIT_L(0); PG8_MMA(1, 0, At, B0); PG8_BAR; PG8_SCHED;
            PG8_STAGE(PG8_SB(1, 1), b3 + hstep, voffB);
            PG8_WAIT_V(6); PG8_BAR; PG8_MMA(1, 1, At, B1); PG8_BAR;
            }
        }
        if constexpr (ALIGN_EPI) { if (wr == 0) PG8_BAR; }
        if constexpr (!Epi::AFTER_DRAIN) { E(acc, cur, wr, wc, fr, fq); S.done(cur); }
        if (!has_next) break;
#pragma unroll
        for (int a = 0; a < 2; ++a)
#pragma unroll
            for (int b = 0; b < 2; ++b)
#pragma unroll
                for (int m = 0; m < 4; ++m)
#pragma unroll
                    for (int n = 0; n < 2; ++n) acc[a][b][m][n] = (f32x4){0.f, 0.f, 0.f, 0.f};
        cur = nxt; cA = nA; cB = nB; ++ui;
        if constexpr (ALIGN_EPI) { if (wr == 1) PG8_BAR; }
    }
    PG8_WAIT_V(0);
    if constexpr (!ALIGN_EPI) { if (wr == 0) PG8_BAR; }
    PG8_BAR;
    if constexpr (Epi::AFTER_DRAIN) { E.fused(acc, cur, wr, wc, fr, fq, lds, wid, lane); S.done(cur); }
#undef PG8_SA
#undef PG8_SB
#undef PG8_STAGE
#undef PG8_LDA
#undef PG8_LDB
#undef PG8_MMA
#undef PG8_WAIT_V
#undef PG8_WAIT_L
#undef PG8_BAR
#undef PG8_SCHED
}
}

namespace att {
typedef short bf16x8 __attribute__((ext_vector_type(8)));
typedef short s16x4 __attribute__((ext_vector_type(4)));
typedef float f32x16 __attribute__((ext_vector_type(16)));
typedef float f32x2_t __attribute__((ext_vector_type(2)));
typedef __bf16 bf16x2_t __attribute__((ext_vector_type(2)));
typedef __attribute__((address_space(3))) const unsigned char* lds_cptr;
typedef short v4i16_t __attribute__((ext_vector_type(4)));
constexpr int KSLOT = 8192, VSLOT = 16384, LDS_K = 0, LDS_V = 2 * KSLOT, LDS_BYTES = 2 * KSLOT + 2 * VSLOT;
constexpr float LOG2E = 1.4426950408889634f, C2 = 0.125f * LOG2E;
__device__ __forceinline__ int crow(int r, int hi) { return (r & 3) + 8 * (r >> 2) + 4 * hi; }
__device__ __forceinline__ void glds16(const void* gsrc, unsigned lds_dst) { unsigned keep;
    asm volatile("s_mov_b32 %0, m0\n\ts_mov_b32 m0, %2\n\ts_nop 0\n\tglobal_load_lds_dwordx4 %1, off\n\ts_mov_b32 m0, %0" : "=&s"(keep) : "v"(gsrc), "s"(lds_dst) : "memory"); }
__device__ __forceinline__ unsigned cvtpk(float lo, float hi) { f32x2_t v = {lo, hi}; bf16x2_t b = __builtin_convertvector(v, bf16x2_t); return __builtin_bit_cast(unsigned, b); }
__device__ __forceinline__ s16x4 vtr(lds_cptr p) { return __builtin_bit_cast(s16x4, __builtin_amdgcn_ds_read_tr16_b64_v4i16((__attribute__((address_space(3))) v4i16_t*)p)); }
__device__ __forceinline__ float swap_max(float m) { auto rr = __builtin_amdgcn_permlane32_swap(__float_as_uint(m), __float_as_uint(m), false, false); return fmaxf(__uint_as_float(rr[0]), __uint_as_float(rr[1])); }
__device__ __forceinline__ float swap_sum(float m) { auto rr = __builtin_amdgcn_permlane32_swap(__float_as_uint(m), __float_as_uint(m), false, false); return __uint_as_float(rr[0]) + __uint_as_float(rr[1]); }
#define ATT_WAIT_BAR() asm volatile("s_waitcnt vmcnt(0) lgkmcnt(0)\n\ts_barrier" ::: "memory")

struct Args { const bf16* Q; const bf16* K; const bf16* V; bf16* mixed; float* stash; const float* lq; const float* lk; const float* subln; const float* gq; const float* gk; float lam_init; int pad_; };

constexpr int PART_F = 68, PART_SLOT_F = 512 * PART_F, MAX_SLOTS = 1700, SPLIT_MIN = 80, TAB_OFF = 65536;
__device__ __forceinline__ void attn_pass(__attribute__((address_space(3))) unsigned char* lds, const Args& A, int h, int qb, int c, int ta, int tb, int nw, f32x16 (&oT)[4], float& l_out, float& M_out) {
    const int tid = opq_tid(), lane = tid & 63, r32 = lane & 31, hi = lane >> 5; const int wid = __builtin_amdgcn_readfirstlane(tid >> 6);
    const int q0 = qb * 256 + wid * 32, qc = q0 >> 6;
    const float slope2 = exp2f(-(float)(h + 1)) * LOG2E;
    const unsigned lds0 = (unsigned)(uintptr_t)lds;
    const lds_cptr kp0 = (lds_cptr)lds + LDS_K + hi * 1024 + r32 * 16;
    const lds_cptr vp0 = (lds_cptr)lds + LDS_V + ((lane >> 4) & 1) * 32 + (lane & 3) * 8 + (4 * hi + ((lane & 15) >> 2)) * 64;
    const bf16* vsrc = A.V + (size_t)(16 * (wid & 3) + (lane >> 2)) * 1024 + h * 128 + (wid >> 2) * 32 + (lane & 3) * 8;
    const unsigned kdst = lds0 + LDS_K + wid * 1024, vdst = lds0 + LDS_V + (wid >> 2) * 4096 + (wid & 3) * 1024;
    const int qrel = (q0 & 63) + r32;
    const int tw0 = max(ta, max(0, qc - nw));
    const bf16* ksrc = A.K + (size_t)lane * 1024 + h * 128 + c * 64 + wid * 8;
    bf16x8 qr[4];
    { const bf16* qp = A.Q + (size_t)(q0 + r32) * 1024 + h * 128 + c * 64 + hi * 8;
#pragma unroll
      for (int d0 = 0; d0 < 4; ++d0) qr[d0] = *(const bf16x8*)(qp + d0 * 16); }
#pragma unroll
    for (int d0 = 0; d0 < 4; ++d0)
#pragma unroll
        for (int r = 0; r < 16; ++r) oT[d0][r] = 0.f;
    float l = 0.f, mu = 0.f;
    if (ta < tb) {
        { const size_t go = (size_t)ta * 64 * 1024; const unsigned so = (unsigned)(ta & 1);
          glds16(ksrc + go, (unsigned)__builtin_amdgcn_readfirstlane(kdst + so * KSLOT)); glds16(vsrc + go, (unsigned)__builtin_amdgcn_readfirstlane(vdst + so * VSLOT)); glds16(vsrc + go + 64, (unsigned)__builtin_amdgcn_readfirstlane(vdst + so * VSLOT + 8192)); }
        ATT_WAIT_BAR();
#pragma unroll 1
        for (int t = ta; t < tb; ++t) {
            const int sl = t & 1;
            if (t + 1 < tb) { const size_t go = (size_t)(t + 1) * 64 * 1024; const unsigned so = (unsigned)(sl ^ 1);
                glds16(ksrc + go, (unsigned)__builtin_amdgcn_readfirstlane(kdst + so * KSLOT)); glds16(vsrc + go, (unsigned)__builtin_amdgcn_readfirstlane(vdst + so * VSLOT));
                glds16(vsrc + go + 64, (unsigned)__builtin_amdgcn_readfirstlane(vdst + so * VSLOT + 8192)); }
            if (t >= tw0 && t <= qc) {
                const bool diag = (t == qc);
                f32x16 p0, p1;
                const float sc = slope2 * (1.0f / C2), base0 = (float)(4 * hi) * sc - mu * (1.0f / C2), base1 = base0 + 32.0f * sc;
                if (!diag) {
#pragma unroll
                    for (int r = 0; r < 16; ++r) { const float kr = (float)((r & 3) + 8 * (r >> 2)); p0[r] = __builtin_fmaf(kr, sc, base0); p1[r] = __builtin_fmaf(kr, sc, base1); }
                } else {
                    const float q2 = (float)(2 * qrel - 8 * hi);
#pragma unroll
                    for (int r = 0; r < 16; ++r) { const float kr = (float)((r & 3) + 8 * (r >> 2));
                        p0[r] = __builtin_fmaf(fminf(kr, q2 - kr) , sc, base0); p1[r] = __builtin_fmaf(fminf(kr, q2 - 64.0f - kr), sc, base1); }
                }
                const lds_cptr kp = kp0 + sl * KSLOT;
#pragma unroll
                for (int d0 = 0; d0 < 4; ++d0) {
                    const bf16x8 k0 = *(const __attribute__((address_space(3))) bf16x8*)(kp + d0 * 2048), k1 = *(const __attribute__((address_space(3))) bf16x8*)(kp + d0 * 2048 + 512);
                    p0 = __builtin_amdgcn_mfma_f32_32x32x16_bf16(k0, qr[d0], p0, 0, 0, 0);
                    p1 = __builtin_amdgcn_mfma_f32_32x32x16_bf16(k1, qr[d0], p1, 0, 0, 0);
                }
                float rm = fmaxf(p0[0], p1[0]);
#pragma unroll
                for (int r = 1; r < 16; ++r) rm = fmaxf(rm, fmaxf(p0[r], p1[r]));
                rm = swap_max(rm);
                const float dl = (t == tw0) ? C2 * rm : fmaxf(C2 * rm, 0.f);
                if (__any(dl != 0.f)) { const float f = __builtin_amdgcn_exp2f(-dl); l *= f;
#pragma unroll
                    for (int d0 = 0; d0 < 4; ++d0)
#pragma unroll
                        for (int r = 0; r < 16; ++r) oT[d0][r] *= f; }
                mu += dl;
                float ls = 0.f;
#pragma unroll
                for (int r = 0; r < 16; ++r) { p0[r] = __builtin_amdgcn_exp2f(p0[r] * C2 - dl); p1[r] = __builtin_amdgcn_exp2f(p1[r] * C2 - dl); ls += p0[r] + p1[r]; }
                l += ls;
                bf16x8 pw[4];
#pragma unroll
                for (int s = 0; s < 4; ++s) { u32x4 w;
#pragma unroll
                    for (int e = 0; e < 4; ++e) { const int r = 8 * (s & 1) + 2 * e; w[e] = (s < 2) ? cvtpk(p0[r], p0[r + 1]) : cvtpk(p1[r], p1[r + 1]); }
                    pw[s] = __builtin_bit_cast(bf16x8, w); }
                const lds_cptr vp = vp0 + sl * VSLOT;
#pragma unroll
                for (int d0 = 0; d0 < 4; ++d0) {
#pragma unroll
                    for (int s = 0; s < 4; ++s) { const s16x4 lo = vtr(vp + d0 * 4096 + s * 1024), hh = vtr(vp + d0 * 4096 + s * 1024 + 512);
                        const bf16x8 vf = (bf16x8){lo[0], lo[1], lo[2], lo[3], hh[0], hh[1], hh[2], hh[3]};
                        oT[d0] = __builtin_amdgcn_mfma_f32_32x32x16_bf16(vf, pw[s], oT[d0], 0, 0, 0); }
                    __builtin_amdgcn_sched_barrier(0); }
                mu -= 64.0f * slope2;
            }
            ATT_WAIT_BAR();
        }
    }
    const int tl = min(qc, tb - 1);
    l_out = l; M_out = (tl >= tw0) ? mu + slope2 * 64.0f * (float)(tl + 1) : -1e30f;
}
__device__ __forceinline__ void attn_finalize(const Args& A, int h, int qb, const f32x16 (&o1)[4], f32x16 (&o2)[4], float lam) {
    const int tid = opq_tid(), lane = tid & 63, r32 = lane & 31, hi = lane >> 5; const int wid = __builtin_amdgcn_readfirstlane(tid >> 6);
    const int q0 = qb * 256 + wid * 32;
    float ss = 0.f;
#pragma unroll
    for (int d0 = 0; d0 < 4; ++d0)
#pragma unroll
        for (int r = 0; r < 16; ++r) { const float v = o1[d0][r] - lam * o2[d0][r]; o2[d0][r] = v; ss += v * v; }
    ss = swap_sum(ss);
    const float rn = (1.0f / sqrtf(ss * (1.0f / 128.0f) + RMS_EPS)) * (1.0f - A.lam_init);
    bf16* op = A.mixed + (size_t)(q0 + r32) * DM + h * 128;
#pragma unroll
    for (int d0 = 0; d0 < 4; ++d0)
#pragma unroll
        for (int g4 = 0; g4 < 4; ++g4) { const int d = 32 * d0 + 8 * g4 + 4 * hi; const f32x4 gg = *(const f32x4*)(A.subln + d);
            u32x2 w; w.x = cvtpk(o2[d0][4 * g4] * rn * gg[0], o2[d0][4 * g4 + 1] * rn * gg[1]); w.y = cvtpk(o2[d0][4 * g4 + 2] * rn * gg[2], o2[d0][4 * g4 + 3] * rn * gg[3]);
            *(u32x2*)(op + d) = w; }
}
struct Win { float smax0, smax1; };
__device__ __forceinline__ int win_nw(const Win& W, int h, int c) { const float smax = c ? W.smax1 : W.smax0, slope2 = exp2f(-(float)(h + 1)) * LOG2E, dmin = (2.0f * C2 * smax + 67.0f) / slope2; return (int)fminf(ceilf((dmin + 63.0f) * (1.0f / 64.0f)) - 1.0f, 256.0f); }
__device__ __forceinline__ void attn_windows(const Args& A, Win& W, float& lam) {
    const int lane = opq_tid() & 63;
    const float l0 = wave_sum(A.lq[lane] * A.lk[lane]), l1 = wave_sum(A.lq[64 + lane] * A.lk[64 + lane]);
    lam = __expf(l0) - __expf(l1) + A.lam_init;
#pragma unroll
    for (int c = 0; c < 2; ++c) { float a = fabsf(A.gq[c * 64 + lane]), b = fabsf(A.gk[c * 64 + lane]);
#pragma unroll
        for (int o = 1; o < 64; o <<= 1) { a = fmaxf(a, __shfl_xor(a, o)); b = fmaxf(b, __shfl_xor(b, o)); }
        const float smax = 64.0f * 1.02f * a * b; if (c == 0) W.smax0 = smax; else W.smax1 = smax; }
}
__device__ __forceinline__ int attn_ntile(const Win& W, int h, int qb, int c) { return 4 * qb + 4 - max(0, 4 * qb - win_nw(W, h, c)); }
__device__ __forceinline__ int attn_table(__attribute__((address_space(3))) unsigned char* lds, const Win& W) {
    volatile __attribute__((address_space(3))) unsigned* tab = (volatile __attribute__((address_space(3))) unsigned*)(lds + TAB_OFF);
    const int tid = opq_tid(), lane = tid & 63, wid = tid >> 6, qb = 63 - (tid >> 3), h = tid & 7;
    const int nt = max(attn_ntile(W, h, qb, 0), attn_ntile(W, h, qb, 1));
    int P = nt > SPLIT_MIN ? (nt + 63) / 64 : 1;
    int want = P > 1 ? 2 * P : 0, incl = want;
#pragma unroll
    for (int o = 1; o < 64; o <<= 1) { const int v = __shfl_up(incl, o); if (lane >= o) incl += v; }
    if (lane == 63) tab[1032 + wid] = (unsigned)incl;
    asm volatile("s_waitcnt lgkmcnt(0)" ::: "memory"); __builtin_amdgcn_s_barrier(); asm volatile("" ::: "memory");
    int sbase = 0;
#pragma unroll
    for (int w = 0; w < 8; ++w) sbase += (w < wid) ? (int)tab[1032 + w] : 0;
    const int sstart = sbase + incl - want;
    if (sstart + want > MAX_SLOTS) P = 1;
    const int cnt = P > 1 ? 2 * P : 1; int ci = cnt;
#pragma unroll
    for (int o = 1; o < 64; o <<= 1) { const int v = __shfl_up(ci, o); if (lane >= o) ci += v; }
    if (lane == 63) tab[1024 + wid] = (unsigned)ci;
    asm volatile("s_waitcnt lgkmcnt(0)" ::: "memory"); __builtin_amdgcn_s_barrier(); asm volatile("" ::: "memory");
    int ibase = 0, total = 0;
#pragma unroll
    for (int w = 0; w < 8; ++w) { const int v = (int)tab[1024 + w]; ibase += (w < wid) ? v : 0; total += v; }
    tab[tid] = (unsigned)(ibase + ci - cnt) | ((unsigned)P << 16); tab[512 + tid] = (unsigned)sstart;
    asm volatile("s_waitcnt lgkmcnt(0)" ::: "memory"); __builtin_amdgcn_s_barrier(); asm volatile("" ::: "memory");
    return total;
}
__device__ __forceinline__ void part_range(const Win& W, int h, int qb, int c, int P, int p, int& ta, int& tb) {
    const int NT = 4 * qb + 4, T0 = max(0, 4 * qb - win_nw(W, h, c)), len = (NT - T0 + P - 1) / P; ta = min(NT, T0 + p * len); tb = min(NT, ta + len);
}
__device__ __forceinline__ void attn_phase(__attribute__((address_space(3))) unsigned char* lds, const Args& A, int blk, unsigned* ctr, volatile __attribute__((address_space(3))) unsigned* qslot, float* part) {
    const int tid = opq_tid();
    Win W; float lam; attn_windows(A, W, lam);
    const int nitems = attn_table(lds, W);
    volatile __attribute__((address_space(3))) unsigned* tab = (volatile __attribute__((address_space(3))) unsigned*)(lds + TAB_OFF);
    float* st = A.stash + (size_t)blk * (64 * 512) + tid * 64;
    for (;;) {
        if (tid == 0) { const unsigned n = __hip_atomic_fetch_add(ctr, 1u, __ATOMIC_RELAXED, __HIP_MEMORY_SCOPE_AGENT); unsigned idx = 0;
            if (n < (unsigned)nitems) { int lo = 0, hi = 511; while (lo < hi) { const int mid = (lo + hi + 1) >> 1; if ((tab[mid] & 0xffffu) <= n) lo = mid; else hi = mid - 1; } idx = (unsigned)lo; }
            qslot[0] = n; qslot[1] = idx; }
        asm volatile("s_waitcnt vmcnt(0) lgkmcnt(0)" ::: "memory"); __builtin_amdgcn_s_barrier(); asm volatile("" ::: "memory");
        const unsigned n = qslot[0], idx = qslot[1];
        asm volatile("s_waitcnt lgkmcnt(0)" ::: "memory"); __builtin_amdgcn_s_barrier(); asm volatile("" ::: "memory");
        if (n >= (unsigned)nitems) break;
        const unsigned e = tab[idx]; const int P = (int)(e >> 16), sub = (int)(n - (e & 0xffffu)), h = (int)(idx & 7u), qb = 63 - (int)(idx >> 3);
        f32x16 oT[4]; float l, M;
        if (P == 1) {
#pragma unroll 1
            for (int c = 0; c < 2; ++c) {
                attn_pass(lds, A, h, qb, c, max(0, 4 * qb - win_nw(W, h, c)), 4 * qb + 4, win_nw(W, h, c), oT, l, M);
                const float il = 1.0f / swap_sum(l);
#pragma unroll
                for (int d0 = 0; d0 < 4; ++d0)
#pragma unroll
                    for (int r = 0; r < 16; ++r) oT[d0][r] *= il;
                if (c == 0) {
#pragma unroll
                    for (int d0 = 0; d0 < 4; ++d0)
#pragma unroll
                        for (int r = 0; r < 16; r += 4) *(f32x4*)(st + d0 * 16 + r) = (f32x4){oT[d0][r], oT[d0][r + 1], oT[d0][r + 2], oT[d0][r + 3]};
                } else { f32x16 o1[4];
#pragma unroll
                    for (int d0 = 0; d0 < 4; ++d0)
#pragma unroll
                        for (int r = 0; r < 16; r += 4) { const f32x4 v = *(const f32x4*)(st + d0 * 16 + r); o1[d0][r] = v[0]; o1[d0][r + 1] = v[1]; o1[d0][r + 2] = v[2]; o1[d0][r + 3] = v[3]; }
                    attn_finalize(A, h, qb, o1, oT, lam); }
            }
        } else {
            const int c = sub / P, p = sub % P; int ta, tb; part_range(W, h, qb, c, P, p, ta, tb);
            attn_pass(lds, A, h, qb, c, ta, tb, win_nw(W, h, c), oT, l, M);
            float* ps = part + (size_t)(tab[512 + idx] + (unsigned)sub) * PART_SLOT_F + tid * PART_F;
#pragma unroll
            for (int d0 = 0; d0 < 4; ++d0)
#pragma unroll
                for (int r = 0; r < 16; r += 4) *(f32x4*)(ps + d0 * 16 + r) = (f32x4){oT[d0][r], oT[d0][r + 1], oT[d0][r + 2], oT[d0][r + 3]};
            *(f32x4*)(ps + 64) = (f32x4){l, M, 0.f, 0.f};
        }
    }
}
__device__ __forceinline__ void attn_combine(__attribute__((address_space(3))) unsigned char* lds, const Args& A, int blk, int nblk, const float* part) {
    const int tid = opq_tid();
    Win W; float lam; attn_windows(A, W, lam);
    (void)attn_table(lds, W);
    volatile __attribute__((address_space(3))) unsigned* tab = (volatile __attribute__((address_space(3))) unsigned*)(lds + TAB_OFF);
    int seen = 0, mine = blk;
    for (int idx = 0; idx < 512; ++idx) {
        const unsigned e = tab[idx]; const int P = (int)(e >> 16); if (P == 1) continue;
        if (seen++ != mine) continue;
        mine += nblk;
        const int h = idx & 7, qb = 63 - (idx >> 3);
        f32x16 o1[4], o2[4];
#pragma unroll 1
        for (int c = 0; c < 2; ++c) {
            const float* ps = part + (size_t)(tab[512 + idx] + (unsigned)(c * P)) * PART_SLOT_F + tid * PART_F;
            float M = -1e30f;
            for (int p = 0; p < P; ++p) M = fmaxf(M, ps[(size_t)p * PART_SLOT_F + 65]);
            float L = 0.f;
#pragma unroll
            for (int d0 = 0; d0 < 4; ++d0)
#pragma unroll
                for (int r = 0; r < 16; ++r) o2[d0][r] = 0.f;
            for (int p = 0; p < P; ++p) { const float* pp = ps + (size_t)p * PART_SLOT_F; const f32x4 lm = *(const f32x4*)(pp + 64); const float f = __builtin_amdgcn_exp2f(lm[1] - M); L += lm[0] * f;
#pragma unroll
                for (int d0 = 0; d0 < 4; ++d0)
#pragma unroll
                    for (int r = 0; r < 16; r += 4) { const f32x4 v = *(const f32x4*)(pp + d0 * 16 + r); o2[d0][r] += v[0] * f; o2[d0][r + 1] += v[1] * f; o2[d0][r + 2] += v[2] * f; o2[d0][r + 3] += v[3] * f; } }
            const float il = 1.0f / swap_sum(L);
            if (c == 0) {
#pragma unroll
                for (int d0 = 0; d0 < 4; ++d0)
#pragma unroll
                    for (int r = 0; r < 16; ++r) o1[d0][r] = o2[d0][r] * il;
            } else {
#pragma unroll
                for (int d0 = 0; d0 < 4; ++d0)
#pragma unroll
                    for (int r = 0; r < 16; ++r) o2[d0][r] *= il;
            }
        }
        attn_finalize(A, h, qb, o1, o2, lam);
    }
}
}

namespace rk {
typedef short bf16x8 __attribute__((ext_vector_type(8)));
typedef short s16x4 __attribute__((ext_vector_type(4)));
typedef short v4i16_t __attribute__((ext_vector_type(4)));
typedef const LAS unsigned char* lcp;
constexpr int ST = 72, MATB = 64 * ST * 2, NST = 68, SLG = 168, SVL = 40;
constexpr int O_AT = 0, O_RT = MATB, O_BT = 2 * MATB, O_KT = 3 * MATB, O_VV = 4 * MATB, O_AAK = 5 * MATB, O_ARB = 6 * MATB, O_ARK = 7 * MATB, O_NN = 8 * MATB, O_GG = O_NN + 64 * NST * 4,
              O_U0T = O_GG, O_WT = O_AAK, O_G2 = O_AAK  , O_VG = O_ARK  , O_SEG = O_GG + 64 * NST * 4, O_GL = O_SEG + 2048,
              O_LW = O_GL + 256, O_LA = O_LW + MATB, O_LG = O_LA + MATB, O_VL = O_LG + 64 * SLG * 2, O_END = O_VL + 64 * SVL * 2;
static_assert(64 * NST * 4 <= 2 * MATB && O_END <= 156000, "stage-1 LDS map");
__device__ __forceinline__ f32x4 mfma16(bf16x8 a, bf16x8 b, f32x4 c) { return __builtin_amdgcn_mfma_f32_16x16x32_bf16(a, b, c, 0, 0, 0); }
__device__ __forceinline__ s16x4 vtr(lcp p) { return __builtin_bit_cast(s16x4, __builtin_amdgcn_ds_read_tr16_b64_v4i16((LAS v4i16_t*)p)); }
__device__ __forceinline__ bf16x8 frag(lcp m, int row0, int ks, int lane, int st = ST) { return *(const LAS bf16x8*)(m + ((row0 + (lane & 15)) * st + 32 * ks + 8 * (lane >> 4)) * 2); }
__device__ __forceinline__ bf16x8 tfrag(lcp m, int c0, int ks, int lane) {
    const int i = lane & 15, q = i >> 2, p = i & 3, k0 = 32 * ks + 8 * (lane >> 4);
    const s16x4 lo = vtr(m + ((k0 + q) * ST + c0 + 4 * p) * 2), hi = vtr(m + ((k0 + 4 + q) * ST + c0 + 4 * p) * 2);
    return (bf16x8){lo[0], lo[1], lo[2], lo[3], hi[0], hi[1], hi[2], hi[3]};
}
__device__ __forceinline__ unsigned pk(float a, float b) { return f2bf(a) | (f2bf(b) << 16); }
#define RK_BAR() do { asm volatile("s_waitcnt lgkmcnt(0)" ::: "memory"); __builtin_amdgcn_s_barrier(); asm volatile("" ::: "memory"); } while (0)


template <int T> struct SolveRow {
    static __device__ __forceinline__ void load(f32x4 (&buf)[16], LAS unsigned char* lds) {
#pragma unroll
        for (int s4 = 0; s4 < 16; ++s4) if (s4 * 4 < T + 1) buf[s4] = *(const LAS f32x4*)(lds + ((T + 1) * NST + 4 * s4) * 4);
    }
    static __device__ __forceinline__ void run(float (&x)[64], f32x4 (&cur)[16], f32x4 (&nxt)[16], LAS unsigned char* lds) {
        if constexpr (T + 1 < 64) load(nxt, lds);
        asm volatile("" ::: "memory"); __builtin_amdgcn_sched_barrier(0);
        float acc = x[T];
#pragma unroll
        for (int s4 = 0; s4 < 16; ++s4)
#pragma unroll
            for (int e = 0; e < 4; ++e) if (4 * s4 + e < T) acc = __builtin_fmaf(cur[s4][e], x[4 * s4 + e], acc);
        x[T] = acc;
        asm volatile("" : "+v"(x[T]) :: "memory"); __builtin_amdgcn_sched_barrier(0);
        if constexpr (T + 1 < 64) SolveRow<T + 1>::run(x, nxt, cur, lds);
    }
};

struct S1Args {
    const bf16* rw; const float* mu; const float* w0; const float* a0; const float* v0; const float* k_k; const float* k_a; const float* r_k;
    const bf16* w2t; const bf16* a2t; const bf16* g2t; const bf16* v2t;
    bf16* vfirst; bf16* BV; bf16* GB; bf16* PG; float* QT; bf16* RP; float* Y0; int layer; int pad_;
};
__device__ __forceinline__ float ldbf(const bf16* p) { return bf2f(*p); }

__device__ __forceinline__ void stage1_latents(LAS unsigned char* lds, const S1Args& A, int t0) {
    const int tid = opq_tid();
    for (int idx = tid; idx < 64 * 320; idx += 512) {
        const int tok = idx / 320, col = idx % 320, t = t0 + tok;
        const bf16* p = A.rw + (size_t)t * RWP + 3072 + col;
        const float cur = ldbf(p);
        if (col < 288) {
            const float prev = t > 0 ? ldbf(p - RWP) : 0.f, sft = cur + A.mu[3072 + col] * (prev - cur);
            if (col < 64) *(LAS unsigned short*)(lds + O_LW + (tok * ST + col) * 2) = (unsigned short)f2bf(tanhf(sft));
            else if (col < 128) *(LAS unsigned short*)(lds + O_LA + (tok * ST + col - 64) * 2) = (unsigned short)f2bf(sft);
            else *(LAS unsigned short*)(lds + O_LG + (tok * SLG + col - 128) * 2) = (unsigned short)f2bf(sigmoidf_(sft));
        } else {
            const float x2 = t > 0 ? ldbf(p - RWP + 32) : 0.f;
            *(LAS unsigned short*)(lds + O_VL + (tok * SVL + col - 288) * 2) = (unsigned short)f2bf(cur + x2);
        }
    }
}

__device__ __forceinline__ void stage1_unit(LAS unsigned char* lds, const S1Args& A, int c, int h) {
    const int tid = opq_tid(), lane = tid & 63, wid = __builtin_amdgcn_readfirstlane(tid >> 6), rq = lane >> 4, l15 = lane & 15;
    const int t0 = c * 64, uc = h * 256 + c;
    const int b0 = wid >> 1;
    LAS float* SEG = (LAS float*)(lds + O_SEG); LAS float* GL = (LAS float*)(lds + O_GL);
    {
        const bf16x8 lw0 = frag(lds + O_LW, 16 * b0, 0, lane), lw1 = frag(lds + O_LW, 16 * b0, 1, lane), la0 = frag(lds + O_LA, 16 * b0, 0, lane), la1 = frag(lds + O_LA, 16 * b0, 1, lane);
        const bf16x8 lv0 = frag(lds + O_VL, 16 * b0, 0, lane, SVL);
        bf16x8 lg[5];
#pragma unroll
        for (int ks = 0; ks < 5; ++ks) lg[ks] = frag(lds + O_LG, 16 * b0, ks, lane, SLG);
#pragma unroll
        for (int cc = 0; cc < 2; ++cc) {
            const int cb = 2 * (wid & 1) + cc, jl = 16 * cb + l15, ch = h * 64 + jl;
            const f32x4 z = {0.f, 0.f, 0.f, 0.f};
            const bf16* pw = A.w2t + (size_t)ch * 64 + 8 * rq; const bf16* pa = A.a2t + (size_t)ch * 64 + 8 * rq; const bf16* pg = A.g2t + (size_t)ch * 160 + 8 * rq; const bf16* pv = A.v2t + (size_t)ch * 32 + 8 * rq;
            const f32x4 zw = mfma16(lw1, *(const bf16x8*)(pw + 32), mfma16(lw0, *(const bf16x8*)pw, z));
            const f32x4 za = mfma16(la1, *(const bf16x8*)(pa + 32), mfma16(la0, *(const bf16x8*)pa, z));
            f32x4 zg = z;
#pragma unroll
            for (int ks = 0; ks < 5; ++ks) zg = mfma16(lg[ks], *(const bf16x8*)(pg + 32 * ks), zg);
            const f32x4 zv = mfma16(lv0, *(const bf16x8*)pv, z);
            const float w0c = A.w0[ch], a0c = A.a0[ch], v0c = A.v0[ch];
#pragma unroll
            for (int e = 0; e < 4; ++e) {
                const int t = 16 * b0 + 4 * rq + e;
                const float zz = -(w0c + zw[e]), sp = fmaxf(zz, 0.f) + log1pf(__expf(-fabsf(zz))), wl = -sp - 0.5f;
                *(LAS float*)(lds + O_NN + (t * NST + jl) * 4) = -__expf(wl);
                *(LAS float*)(lds + O_GG + (t * NST + jl) * 4) = sigmoidf_(a0c + za[e]);
                *(LAS float*)(lds + O_G2 + (t * NST + jl) * 4) = zg[e];
                *(LAS unsigned short*)(lds + O_VG + (t * ST + jl) * 2) = (unsigned short)f2bf(sigmoidf_(v0c + zv[e]));
            }
        }
        RK_BAR();
    }
    {
        const int j = lane, ch = h * 64 + j; float lw[8], cum[8], va[8], vb[8], vk[8], vr_[8], vv[8];
        const float mur = A.mu[ch], muk = A.mu[1024 + ch], muv = A.mu[2048 + ch], kkw = A.k_k[ch], kaw = A.k_a[ch], rkw = A.r_k[ch];
        const int tf = t0 + 8 * wid;
        const bf16* rp = A.rw + (size_t)tf * RWP + ch;
        float pr = 0.f, pk_ = 0.f, pv = 0.f;
        if (tf > 0) { pr = ldbf(rp - RWP); pk_ = ldbf(rp - RWP + 1024); pv = ldbf(rp - RWP + 2048); }
#pragma unroll
        for (int e = 0; e < 8; ++e) {
            const float cr = ldbf(rp + (size_t)e * RWP), ck = ldbf(rp + (size_t)e * RWP + 1024), cv = ldbf(rp + (size_t)e * RWP + 2048);
            const float r = cr + mur * (pr - cr), kr = ck + muk * (pk_ - ck), vr = cv + muv * (pv - cv);
            pr = cr; pk_ = ck; pv = cv;
            const int tl = 8 * wid + e;
            lw[e] = *(const LAS float*)(lds + O_NN + (tl * NST + j) * 4);
            const float ar = *(const LAS float*)(lds + O_GG + (tl * NST + j) * 4), g = *(const LAS float*)(lds + O_G2 + (tl * NST + j) * 4);
            const float vg = bf2f(*(const LAS unsigned short*)(lds + O_VG + (tl * ST + j) * 2));
            const float kkv = kr * kkw, ss = wave_sum(kkv * kkv), kk = kkv * (1.0f / fmaxf(sqrtf(ss), 1e-12f));
            va[e] = -kk; vb[e] = kk * ar; vk[e] = kr * (1.0f + (ar - 1.0f) * kaw); vr_[e] = r;
            const size_t go = (size_t)(tf + e) * 1024 + ch;
            float v;
            if (A.layer == 0) { v = vr; A.vfirst[go] = (bf16)f2bf(vr); } else { v = vr + (bf2f(A.vfirst[go]) - vr) * vg; }
            vv[e] = v;
            const float bonus = wave_sum(r * vk[e] * rkw);
            A.BV[go] = (bf16)f2bf(bonus * v); A.GB[go] = (bf16)f2bf(g);
        }
        cum[0] = lw[0];
#pragma unroll
        for (int e = 1; e < 8; ++e) cum[e] = cum[e - 1] + lw[e];
        SEG[wid * 64 + j] = cum[7];
        RK_BAR();
        float off = 0.f, tot = 0.f;
#pragma unroll
        for (int s = 0; s < 8; ++s) { const float v = SEG[s * 64 + j]; off += (s < wid) ? v : 0.f; tot += v; }
        if (wid == 0) GL[j] = __expf(tot);
#pragma unroll
        for (int e = 0; e < 8; ++e) {
            const float cm = cum[e] + off, g = __expf(cm), gi = __expf(-cm), gp = __expf(cm - lw[e]);
            const int o = ((8 * wid + e) * ST + j) * 2;
            *(LAS unsigned short*)(lds + O_AT + o) = (unsigned short)f2bf(va[e] * gp);
            *(LAS unsigned short*)(lds + O_BT + o) = (unsigned short)f2bf(vb[e] * gi);
            *(LAS unsigned short*)(lds + O_KT + o) = (unsigned short)f2bf(vk[e] * gi);
            *(LAS unsigned short*)(lds + O_RT + o) = (unsigned short)f2bf(vr_[e] * g);
            *(LAS unsigned short*)(lds + O_VV + o) = (unsigned short)f2bf(vv[e]);
        }
        RK_BAR();
    }
    {
        const bf16x8 bA0 = frag(lds + O_BT, 16 * b0, 0, lane), bA1 = frag(lds + O_BT, 16 * b0, 1, lane), kA0 = frag(lds + O_KT, 16 * b0, 0, lane), kA1 = frag(lds + O_KT, 16 * b0, 1, lane);
#pragma unroll
        for (int tt = 0; tt < 2; ++tt) {
            const int tb = 2 * (wid & 1) + tt;
            const bf16x8 aB0 = frag(lds + O_AT, 16 * tb, 0, lane), aB1 = frag(lds + O_AT, 16 * tb, 1, lane), rB0 = frag(lds + O_RT, 16 * tb, 0, lane), rB1 = frag(lds + O_RT, 16 * tb, 1, lane);
            const f32x4 z = {0.f, 0.f, 0.f, 0.f};
            f32x4 ab = mfma16(bA1, aB1, mfma16(bA0, aB0, z)), ak = mfma16(kA1, aB1, mfma16(kA0, aB0, z)), rb = mfma16(bA1, rB1, mfma16(bA0, rB0, z)), rk_ = mfma16(kA1, rB1, mfma16(kA0, rB0, z));
            const int tcol = 16 * tb + l15, srow = 16 * b0 + 4 * rq;
#pragma unroll
            for (int e = 0; e < 4; ++e) { const bool st = tcol > srow + e, le = tcol >= srow + e; ab[e] = st ? ab[e] : 0.f; ak[e] = st ? ak[e] : 0.f; rb[e] = le ? rb[e] : 0.f; rk_[e] = le ? rk_[e] : 0.f; }
            *(LAS f32x4*)(lds + O_NN + (tcol * NST + srow) * 4) = ab;
            const int o = (tcol * ST + srow) * 2;
            *(LAS u32x2*)(lds + O_AAK + o) = (u32x2){pk(ak[0], ak[1]), pk(ak[2], ak[3])};
            *(LAS u32x2*)(lds + O_ARB + o) = (u32x2){pk(rb[0], rb[1]), pk(rb[2], rb[3])};
            *(LAS u32x2*)(lds + O_ARK + o) = (u32x2){pk(rk_[0], rk_[1]), pk(rk_[2], rk_[3])};
        }
        RK_BAR();
    }
    {
        const bf16x8 vA0 = tfrag(lds + O_VV, 16 * b0, 0, lane), vA1 = tfrag(lds + O_VV, 16 * b0, 1, lane);
#pragma unroll
        for (int tt = 0; tt < 2; ++tt) {
            const int tb = 2 * (wid & 1) + tt;
            const f32x4 z = {0.f, 0.f, 0.f, 0.f};
            const f32x4 g = mfma16(vA1, frag(lds + O_AAK, 16 * tb, 1, lane), mfma16(vA0, frag(lds + O_AAK, 16 * tb, 0, lane), z));
            *(LAS f32x4*)(lds + O_GG + ((16 * tb + l15) * NST + 16 * b0 + 4 * rq) * 4) = g;
        }
        RK_BAR();
    }
    if (wid < 2) {
        float x[64];
        if (wid == 0) {
#pragma unroll
            for (int t = 0; t < 64; ++t) x[t] = bf2f(*(const LAS unsigned short*)(lds + O_AT + (t * ST + lane) * 2));
        } else {
#pragma unroll
            for (int t = 0; t < 64; ++t) x[t] = *(const LAS float*)(lds + O_GG + (t * NST + lane) * 4);
        }
        f32x4 na[16], nb[16];
        LAS unsigned char* nn = lds + O_NN; asm volatile("" : "+v"(nn));
        SolveRow<0>::load(na, nn);
        SolveRow<1>::run(x, na, nb, nn);
        LAS unsigned char* dst = lds + (wid == 0 ? O_WT : O_U0T) + lane * ST * 2;
#pragma unroll
        for (int i = 0; i < 8; ++i) *(LAS u32x4*)(dst + i * 16) = (u32x4){pk(x[8 * i], x[8 * i + 1]), pk(x[8 * i + 2], x[8 * i + 3]), pk(x[8 * i + 4], x[8 * i + 5]), pk(x[8 * i + 6], x[8 * i + 7])};
    }
    RK_BAR();
    {
        const bf16x8 wA0 = frag(lds + O_WT, 16 * b0, 0, lane), wA1 = frag(lds + O_WT, 16 * b0, 1, lane);
        const bf16x8 uA0 = frag(lds + O_U0T, 16 * b0, 0, lane), uA1 = frag(lds + O_U0T, 16 * b0, 1, lane);
        const bf16x8 vA0 = tfrag(lds + O_VV, 16 * b0, 0, lane), vA1 = tfrag(lds + O_VV, 16 * b0, 1, lane);
        const bf16x8 bA0 = tfrag(lds + O_BT, 16 * b0, 0, lane), bA1 = tfrag(lds + O_BT, 16 * b0, 1, lane);
        const bf16x8 kA0 = tfrag(lds + O_KT, 16 * b0, 0, lane), kA1 = tfrag(lds + O_KT, 16 * b0, 1, lane);
        const f32x4 glr = *(const LAS f32x4*)(lds + O_GL + (16 * b0 + 4 * rq) * 4);
#pragma unroll
        for (int tt = 0; tt < 2; ++tt) {
            const int nb = 2 * (wid & 1) + tt, col = 16 * nb + l15, row = 16 * b0 + 4 * rq;
            const f32x4 z = {0.f, 0.f, 0.f, 0.f};
            const bf16x8 rbB0 = frag(lds + O_ARB, 16 * nb, 0, lane), rbB1 = frag(lds + O_ARB, 16 * nb, 1, lane), rkB0 = frag(lds + O_ARK, 16 * nb, 0, lane), rkB1 = frag(lds + O_ARK, 16 * nb, 1, lane);
            { f32x4 d = mfma16(wA1, rbB1, mfma16(wA0, rbB0, z)); const u32x2 rt = *(const LAS u32x2*)(lds + O_RT + (col * ST + row) * 2);
              d[0] += bflo(rt.x); d[1] += bfhi(rt.x); d[2] += bflo(rt.y); d[3] += bfhi(rt.y);
              *(u32x2*)(A.RP + (size_t)(t0 + col) * 1024 + h * 64 + row) = (u32x2){pk(d[0], d[1]), pk(d[2], d[3])}; }
            { const f32x4 d = mfma16(vA1, rkB1, mfma16(vA0, rkB0, mfma16(uA1, rbB1, mfma16(uA0, rbB0, z))));
              *(f32x4*)(A.Y0 + (size_t)(t0 + col) * 1024 + h * 64 + row) = d; }
            { const bf16x8 bB0 = tfrag(lds + O_BT, 16 * nb, 0, lane), bB1 = tfrag(lds + O_BT, 16 * nb, 1, lane);
              f32x4 d = mfma16(wA1, bB1, mfma16(wA0, bB0, z)); const float gj = GL[col];
#pragma unroll
              for (int e = 0; e < 4; ++e) d[e] = gj * (d[e] + ((row + e) == col ? 1.f : 0.f));
              *(u32x2*)(A.PG + (size_t)uc * 4096 + ((((col >> 4) * 2 + (row >> 5)) * 64 + ((row >> 2) & 3) * 16 + (col & 15)) * 8 + ((row >> 4) & 1) * 4)) = (u32x2){pk(d[0], d[1]), pk(d[2], d[3])}; }
            { const bf16x8 uB0 = frag(lds + O_U0T, 16 * nb, 0, lane), uB1 = frag(lds + O_U0T, 16 * nb, 1, lane), vB0 = tfrag(lds + O_VV, 16 * nb, 0, lane), vB1 = tfrag(lds + O_VV, 16 * nb, 1, lane);
              f32x4 d = mfma16(kA1, vB1, mfma16(kA0, vB0, mfma16(bA1, uB1, mfma16(bA0, uB0, z))));
              d = d * glr;
              *(f32x4*)(A.QT + (size_t)uc * 4096 + ((((col >> 4) * 4 + (row >> 4)) * 64 + ((row >> 2) & 3) * 16 + (col & 15)) * 4)) = d; }
        }
    }
    RK_BAR();
}
__device__ __forceinline__ void ph_stage1(LAS unsigned char* lds, const S1Args& A, int blk, int nblk) {
    for (int c = blk; c < 256; c += nblk) {
        stage1_latents(lds, A, c * 64);
        RK_BAR();
#pragma unroll 1
        for (int h = 0; h < 16; ++h) stage1_unit(lds, A, c, h);
    }
}

struct ChainOps { bf16x8 a[4][2]; f32x4 c[4]; };
__device__ __forceinline__ void chain_load(ChainOps& o, const bf16* __restrict__ PG, const float* __restrict__ QT, int h, int ig, int c, int lane) {
    const bf16* P = PG + (size_t)(h * 256 + c) * 4096 + lane * 8; const float* Q = QT + (size_t)(h * 256 + c) * 4096 + (ig * 4 * 64 + lane) * 4;
#pragma unroll
    for (int m = 0; m < 4; ++m) { o.c[m] = *(const f32x4*)(Q + m * 256);
#pragma unroll
        for (int kb = 0; kb < 2; ++kb) o.a[m][kb] = *(const bf16x8*)(P + (m * 2 + kb) * 512); }
}
__device__ __forceinline__ void chain_step(f32x4 (&H)[4], const ChainOps& o, bf16* __restrict__ H0T, int h, int ig, int c, int lane) {
    const int fr = lane & 15, fq = lane >> 4;
    bf16* Ho = H0T + (size_t)(c * 16 + h) * 4096 + (16 * ig + fr) * 64 + 4 * fq;
    u32x4 bw[2];
#pragma unroll
    for (int m = 0; m < 4; ++m) { const u32x2 w = {pk(H[m][0], H[m][1]), pk(H[m][2], H[m][3])}; *(u32x2*)(Ho + 16 * m) = w; bw[m >> 1][2 * (m & 1)] = w.x; bw[m >> 1][2 * (m & 1) + 1] = w.y; }
#pragma unroll
    for (int m = 0; m < 4; ++m) H[m] = mfma16(o.a[m][1], __builtin_bit_cast(bf16x8, bw[1]), mfma16(o.a[m][0], __builtin_bit_cast(bf16x8, bw[0]), o.c[m]));
}
__device__ __forceinline__ void chain_wave(const bf16* __restrict__ PG, const float* __restrict__ QT, bf16* __restrict__ H0T, int h, int ig, int lane) {
    f32x4 H[4];
#pragma unroll
    for (int m = 0; m < 4; ++m) H[m] = (f32x4){0.f, 0.f, 0.f, 0.f};
    ChainOps s0, s1, s2, s3;
    chain_load(s0, PG, QT, h, ig, 0, lane); chain_load(s1, PG, QT, h, ig, 1, lane); chain_load(s2, PG, QT, h, ig, 2, lane); chain_load(s3, PG, QT, h, ig, 3, lane);
#pragma unroll 1
    for (int c = 0; c < 256; c += 4) {
        const bool more = c + 4 < 256;
        chain_step(H, s0, H0T, h, ig, c, lane);     if (more) chain_load(s0, PG, QT, h, ig, c + 4, lane);
        chain_step(H, s1, H0T, h, ig, c + 1, lane); if (more) chain_load(s1, PG, QT, h, ig, c + 5, lane);
        chain_step(H, s2, H0T, h, ig, c + 2, lane); if (more) chain_load(s2, PG, QT, h, ig, c + 6, lane);
        chain_step(H, s3, H0T, h, ig, c + 3, lane); if (more) chain_load(s3, PG, QT, h, ig, c + 7, lane);
    }
}
__device__ __forceinline__ void ph_chain(const bf16* PG, const float* QT, bf16* H0T, int blk, int nblk) {
    const int tid = opq_tid(), lane = tid & 63;
    for (int gw = blk * 8 + (tid >> 6); gw < 64; gw += nblk * 8) chain_wave(PG, QT, H0T, gw >> 2, gw & 3, lane);
}

struct S3Args { const bf16* H0T; const bf16* RP; const float* Y0; const bf16* BV; const bf16* GB; const float* ln_w; const float* ln_b; bf16* mixed; };
__device__ __forceinline__ void ph_stage3(const S3Args& A, int blk, int nblk) {
    const int tid = opq_tid(), lane = tid & 63, fr = lane & 15, fq = lane >> 4;
    for (int it = blk * 8 + (tid >> 6); it < 4096 * 4; it += nblk * 8) {
        const int u = it >> 2, tb = it & 3, c = u >> 4, h = u & 15, t = 64 * c + 16 * tb + fr;
        const bf16* Hp = A.H0T + (size_t)u * 4096 + fr * 64 + 8 * fq; const bf16* Rp = A.RP + (size_t)t * 1024 + h * 64 + 8 * fq;
        const bf16x8 r0 = *(const bf16x8*)Rp, r1 = *(const bf16x8*)(Rp + 32);
        f32x4 y[4];
#pragma unroll
        for (int ib = 0; ib < 4; ++ib) { const f32x4 y0 = *(const f32x4*)(A.Y0 + (size_t)t * 1024 + h * 64 + 16 * ib + 4 * fq);
            y[ib] = mfma16(*(const bf16x8*)(Hp + ib * 1024 + 32), r1, mfma16(*(const bf16x8*)(Hp + ib * 1024), r0, y0)); }
        float s = 0.f;
#pragma unroll
        for (int ib = 0; ib < 4; ++ib) s += (y[ib][0] + y[ib][1]) + (y[ib][2] + y[ib][3]);
        s += __shfl_xor(s, 16); s += __shfl_xor(s, 32);
        const float mean = s * (1.0f / 64.0f); float q = 0.f;
#pragma unroll
        for (int ib = 0; ib < 4; ++ib)
#pragma unroll
            for (int e = 0; e < 4; ++e) { const float d = y[ib][e] - mean; y[ib][e] = d; q += d * d; }
        q += __shfl_xor(q, 16); q += __shfl_xor(q, 32);
        const float rstd = 1.0f / sqrtf(q * (1.0f / 64.0f) + GN_EPS);
#pragma unroll
        for (int ib = 0; ib < 4; ++ib) { const int ch = h * 64 + 16 * ib + 4 * fq; const size_t o = (size_t)t * 1024 + ch;
            const f32x4 lw = *(const f32x4*)(A.ln_w + ch), lb = *(const f32x4*)(A.ln_b + ch); const u32x2 bv = *(const u32x2*)(A.BV + o), gg = *(const u32x2*)(A.GB + o); f32x4 r;
            const float bvf[4] = {bflo(bv.x), bfhi(bv.x), bflo(bv.y), bfhi(bv.y)}, ggf[4] = {bflo(gg.x), bfhi(gg.x), bflo(gg.y), bfhi(gg.y)};
#pragma unroll
            for (int e = 0; e < 4; ++e) r[e] = (y[ib][e] * rstd * lw[e] + lb[e] + bvf[e]) * ggf[e];
            *(u32x2*)(A.mixed + (size_t)t * DM + 1024 + ch) = (u32x2){pk(r[0], r[1]), pk(r[2], r[3])}; }
    }
}
}
#define XB_TMO      128
#define XB_XCNT(j)  (256  + 64 * (j))
#define XB_XSUB(j)  (1280 + 64 * (j))
#define XB_XGEN(j)  (2304 + 64 * (j))
#define XB_TOP      3328
#define XB_TOPGEN   3392
#define XCD_BAR_WORDS 3456
#define XB_SPIN_CAP (1u << 22)

__device__ __forceinline__ unsigned xb_ld(unsigned* p)              { return __hip_atomic_load(p, __ATOMIC_RELAXED, __HIP_MEMORY_SCOPE_AGENT); }
__device__ __forceinline__ unsigned xb_add(unsigned* p, unsigned v) { return __hip_atomic_fetch_add(p, v, __ATOMIC_RELAXED, __HIP_MEMORY_SCOPE_AGENT); }
__device__ __forceinline__ unsigned xb_xcc_id() { return (unsigned)__builtin_amdgcn_s_getreg((3 << 11) | 20) & 0xFu; }
#define XB_SPIN(cond, bar) do { unsigned _sp = 0; while (cond) { __builtin_amdgcn_s_sleep(1); \
    if ((++_sp & 255u) == 0u) { if (xb_ld(&(bar)[XB_TMO])) break; if (_sp > XB_SPIN_CAP) { atomicAdd(&(bar)[XB_TMO], 1u); break; } } } } while (0)

struct XcdBarrier {
    unsigned* bar; unsigned x;
    volatile LAS unsigned* st;
};

__device__ __forceinline__ XcdBarrier xcd_barrier_post(unsigned* bar, volatile LAS unsigned* st) {
    XcdBarrier b; b.bar = bar; b.x = xb_xcc_id(); b.st = st;
    if (threadIdx.x == 0) (void)xb_add(&bar[XB_XCNT(b.x)], 1u);
    return b;
}
__device__ __forceinline__ void xcd_barrier_complete(unsigned* bar, unsigned x, unsigned& nloc, unsigned& nx) {
    const unsigned G = gridDim.x * gridDim.y * gridDim.z;
    unsigned sum, cnt, mine, sp = 0u;
    for (;;) {
        sum = 0u; cnt = 0u; mine = 0u;
#pragma unroll
        for (unsigned j = 0; j < 16; ++j) { const unsigned c = xb_ld(&bar[XB_XCNT(j)]); sum += c; cnt += (c > 0u) ? 1u : 0u; mine = (j == x) ? c : mine; }
        if (sum == G) break;
        __builtin_amdgcn_s_sleep(1);
        if ((++sp & 255u) == 0u) { if (xb_ld(&bar[XB_TMO])) break; if (sp > XB_SPIN_CAP) { atomicAdd(&bar[XB_TMO], 1u); break; } }
    }
    nloc = mine > 0u ? mine : 1u; nx = cnt > 0u ? cnt : 1u;
}

__device__ __forceinline__ void xcd_barrier(const XcdBarrier& b) {
    asm volatile("s_waitcnt vmcnt(0)" ::: "memory");
    __syncthreads();
    if (threadIdx.x == 0) {
        unsigned* bar = b.bar;
        __builtin_amdgcn_s_waitcnt(0);
        unsigned nloc = b.st[0], nx = b.st[1];
        if (nloc == 0u) { xcd_barrier_complete(bar, b.x, nloc, nx); b.st[0] = nloc; b.st[1] = nx; }
        const unsigned old = xb_add(&bar[XB_XSUB(b.x)], 1u);
        const unsigned gen = old / nloc;
        if (old + 1u == (gen + 1u) * nloc) {
            __builtin_amdgcn_fence(__ATOMIC_RELEASE, "agent");
            asm volatile("s_waitcnt vmcnt(0)" ::: "memory");
            const unsigned og = xb_add(&bar[XB_TOP], 1u);
            const unsigned tg = og / nx;
            if (og + 1u == (tg + 1u) * nx) xb_add(&bar[XB_TOPGEN], 1u);
            else XB_SPIN(xb_ld(&bar[XB_TOPGEN]) == tg, bar);
            __builtin_amdgcn_fence(__ATOMIC_ACQUIRE, "agent");
            xb_add(&bar[XB_XGEN(b.x)], 1u);
            asm volatile("s_waitcnt vmcnt(0)" ::: "memory");
        } else {
            XB_SPIN(xb_ld(&bar[XB_XGEN(b.x)]) == gen, bar);
            __builtin_amdgcn_fence(__ATOMIC_ACQUIRE, "agent");
            asm volatile("s_waitcnt vmcnt(0)" ::: "memory");
        }
    }
    __syncthreads();
}

constexpr size_t MiB = 1u << 20;
constexpr size_t WS_CTL = 0, CTL_ZERO_BYTES = 64 * 1024, WS_SSQA = 1016 * MiB, WS_SSQB = 1018 * MiB,      WS_WIN = 2 * MiB, WS_WOUT = 28 * MiB, WS_WUP = 36 * MiB, WS_WDOWN = 68 * MiB, WS_LORA = 100 * MiB, WS_XB = 102 * MiB,
                 WS_Q = 166 * MiB, WS_K = 198 * MiB, WS_V = 230 * MiB, WS_RW = 262 * MiB, WS_MIXED = 374 * MiB, WS_U = 166 * MiB, WS_VFIRST = 438 * MiB, WS_PG = 470 * MiB, WS_QT = 502 * MiB, WS_RP = 566 * MiB,
                 WS_Y0 = 598 * MiB, WS_H0T = 662 * MiB, WS_BV = 694 * MiB, WS_GB = 726 * MiB, WS_STASH = 758 * MiB, WS_PART = 790 * MiB, WS_END = 1020 * MiB;
constexpr size_t LORA_W2 = 0, LORA_A2 = 1024 * 64 * 2, LORA_G2 = 2 * 1024 * 64 * 2, LORA_V2 = LORA_G2 + 1024 * 160 * 2;
constexpr int CW_BAR = 1024, CW_ATTQ = 512;
constexpr int RING_BYTES = 131072, MISC_OFF = 156000, LDS_BYTES = 156672;

struct Args { const float* in[26]; float* out; unsigned char* ws; int ph_lo, ph_hi; float lam_init[4]; };

struct ConvItem { const float* src; bf16* dst; const float* g; int K, N, k0, c0; bool permin, skipx; };
__device__ __forceinline__ void conv_item(ConvItem& I, const __attribute__((address_space(4))) Args* a, unsigned char* ws, int l, int it) {
    constexpr int I_IN = (DM / 64) * (NIN / 64), I_OUT = (DM / 64) * (DM / 64), I_UP = (DM / 64) * (DFF / 64);
    int r = it, nkbs;
    if (r < I_IN) { I.src = a->in[3] + (size_t)l * DM * PW; I.dst = (bf16*)(ws + WS_WIN); I.g = a->in[1] + (size_t)l * DM; I.K = DM; I.N = PW; nkbs = 5; I.permin = true; I.skipx = l > 0; }
    else if ((r -= I_IN) < I_OUT) { I.src = a->in[4] + (size_t)l * DM * DM; I.dst = (bf16*)(ws + WS_WOUT); I.g = nullptr; I.K = DM; I.N = DM; nkbs = 5; I.permin = false; I.skipx = false; }
    else if ((r -= I_OUT) < I_UP) { I.src = a->in[24] + (size_t)l * DM * DFF; I.dst = (bf16*)(ws + WS_WUP); I.g = a->in[2] + (size_t)l * DM; I.K = DM; I.N = DFF; nkbs = 5; I.permin = false; I.skipx = false; }
    else { r -= I_UP; I.src = a->in[25] + (size_t)l * DFF * DM; I.dst = (bf16*)(ws + WS_WDOWN); I.g = nullptr; I.K = DFF; I.N = DM; nkbs = 7; I.permin = false; I.skipx = false; }
    I.k0 = (r & ((1 << nkbs) - 1)) * 64; I.c0 = (r >> nkbs) * 64;
}
__device__ __forceinline__ void conv_load(const ConvItem& I, float (&v)[8], int tid) {
#pragma unroll
    for (int i = 0; i < 8; ++i) { const int idx = tid + 512 * i, kk = idx >> 6, cc = idx & 63, cp = I.c0 + cc; int col = cp;
        if (I.permin) { const int lo = cp & 255, bj = lo >> 7, wc = (lo >> 5) & 3, j = lo & 31; col = (cp & ~255) + 64 * wc + 32 * bj + j; }
        float x = 0.f; if (col < I.N) { x = I.src[(size_t)(I.k0 + kk) * I.N + col]; if (I.g) x *= I.g[I.k0 + kk]; }
        v[i] = x; }
}
__device__ __forceinline__ void ph_convw(LAS unsigned char* lds, const __attribute__((address_space(4))) Args* a, int l, int blk, int nblk) {
    LAS float* tile = (LAS float*)lds; unsigned char* ws = a->ws; const int tid = opq_tid();
    constexpr int NITEM = (DM / 64) * (NIN / 64) + (DM / 64) * (DM / 64) + (DM / 64) * (DFF / 64) + (DFF / 64) * (DM / 64);
    ConvItem I; float v[8];
    int it = blk;
    if (it < NITEM) { conv_item(I, a, ws, l, it); conv_load(I, v, tid); }
    while (it < NITEM) {
#pragma unroll
        for (int i = 0; i < 8; ++i) { const int idx = tid + 512 * i; tile[(idx >> 6) * 65 + (idx & 63)] = v[i]; }
        __syncthreads();
        const ConvItem C = I; const int nx = it + nblk;
        if (nx < NITEM) { conv_item(I, a, ws, l, nx); conv_load(I, v, tid); }
        { const int cc = tid >> 3, k8 = (tid & 7) * 8, cp = C.c0 + cc;
          if (!(C.permin && C.skipx && ((cp >= 6432 && cp < 6464) || (cp >= 6528 && cp < 6560)))) {
              u32x4 w;
#pragma unroll
              for (int e = 0; e < 4; ++e) w[e] = f2bf(tile[(k8 + 2 * e) * 65 + cc]) | (f2bf(tile[(k8 + 2 * e + 1) * 65 + cc]) << 16);
              *(u32x4*)(C.dst + (size_t)cp * C.K + C.k0 + k8) = w; } }
        __syncthreads();
        it = nx;
    }
    { const int tid = opq_tid(); const int lm = l > 0 ? l - 1 : 0;
      const float* w2 = a->in[12] + (size_t)l * 64 * 1024; const float* a2 = a->in[14] + (size_t)l * 64 * 1024; const float* g2 = a->in[15] + (size_t)l * 160 * 1024; const float* v2 = a->in[23] + (size_t)lm * 32 * 1024;
      bf16* lw = (bf16*)(ws + WS_LORA);
      for (int i = blk * 512 + tid; i < 1024 * 320; i += nblk * 512) {
          const int ch = i / 320, k = i % 320;
          if (k < 64) lw[LORA_W2 / 2 + ch * 64 + k] = (bf16)f2bf(w2[(size_t)k * 1024 + ch]);
          else if (k < 128) lw[LORA_A2 / 2 + ch * 64 + k - 64] = (bf16)f2bf(a2[(size_t)(k - 64) * 1024 + ch]);
          else if (k < 288) lw[LORA_G2 / 2 + ch * 160 + k - 128] = (bf16)f2bf(g2[(size_t)(k - 128) * 1024 + ch]);
          else lw[LORA_V2 / 2 + ch * 32 + k - 288] = (bf16)f2bf(v2[(size_t)(k - 288) * 1024 + ch]);
      } }
    if (l > 0) {
        const int tid = opq_tid(), kk = tid >> 6, o = tid & 63;
        const float* win = a->in[3] + (size_t)l * DM * PW; const float* g1 = a->in[1] + (size_t)l * DM; const float* muv = a->in[10] + (size_t)l * 3360 + 2048; const float* v1 = a->in[22] + (size_t)(l - 1) * 1024 * 32;
        bf16* wt = (bf16*)(ws + WS_WIN);
        for (int k0 = blk * 8; k0 < DM; k0 += nblk * 8) {
            const int k = k0 + kk; const float* wr = win + (size_t)k * PW + 5120; float acc = 0.f;
#pragma unroll 8
            for (int c = 0; c < 1024; ++c) { const float m = muv[c]; acc += wr[c] * ((o < 32) ? 1.0f - m : m) * v1[c * 32 + (o & 31)]; }
            const int row = (o < 32) ? 6528 + o : 6400 + o;
            wt[(size_t)row * DM + k] = (bf16)f2bf(acc * g1[k]);
        }
    }
}
__device__ __forceinline__ void ph_copy_x(const float* __restrict__ src, float* __restrict__ copy, bf16* __restrict__ xb, float* __restrict__ ssq, int blk, int nblk) {
    const int tid_ = opq_tid(), lane = tid_ & 63, gw = blk * 8 + (tid_ >> 6), ngw = nblk * 8;
    for (int row = gw; row < T_; row += ngw) {
        const f32x4* s = (const f32x4*)(src + (size_t)row * DM);
        float ss = 0.f;
#pragma unroll
        for (int j = 0; j < 8; ++j) { const f32x4 v = s[lane + 64 * j]; ss += (v[0] * v[0] + v[1] * v[1]) + (v[2] * v[2] + v[3] * v[3]);
            ((f32x4*)(copy + (size_t)row * DM))[lane + 64 * j] = v;
            u32x2 w; w.x = f2bf(v[0]) | (f2bf(v[1]) << 16); w.y = f2bf(v[2]) | (f2bf(v[3]) << 16);
            ((u32x2*)(xb + (size_t)row * DM))[lane + 64 * j] = w; }
        ss = wave_sum(ss);
        if (lane < 32) ssq[(size_t)row * 32 + lane] = lane == 0 ? ss : 0.f;
    }
}
__device__ __forceinline__ void ph_zero(float* p, int n, int blk, int nblk) { const int tid = opq_tid();
#pragma unroll
    for (int r = 0; r < 4; ++r) { const int i = (r * nblk + blk) * 512 + tid; if (i < n) __hip_atomic_store(p + i, 0.f, __ATOMIC_RELAXED, __HIP_MEMORY_SCOPE_AGENT); } }

#ifndef MK_PER_PHASE
#define MK_PER_PHASE 0
#endif
constexpr int NPH = 8;
#ifndef PROBE_PH
#define PROBE_PH -1
#endif
#ifndef PROBE_REP
#define PROBE_REP 1
#endif
#define REP(k) for (int rep_ = 0; rep_ < ((k) == PROBE_PH ? PROBE_REP : 1); ++rep_)
typedef const __attribute__((address_space(4))) Args* CArgs;
__device__ __forceinline__ CArgs kargs() { CArgs p = (CArgs)__builtin_amdgcn_kernarg_segment_ptr(); asm volatile("" : "+s"(p)); return p; }
__global__ void __launch_bounds__(512, 2) fwd(Args args_unused) {
    extern __shared__ __attribute__((aligned(16))) unsigned char lds_raw[];
    LAS unsigned char* lds = (LAS unsigned char*)lds_raw;
    volatile LAS unsigned* MISC = (volatile LAS unsigned*)(lds + MISC_OFF);
    const int blk = (int)blockIdx.x, nblk = (int)gridDim.x;
    if (threadIdx.x < 32) MISC[threadIdx.x] = 0u;
    __syncthreads();
    XcdBarrier bar;
#if MK_PER_PHASE
    int lo, hi;
    { CArgs ap = kargs(); lo = ap->ph_lo; hi = ap->ph_hi; unsigned* bw = (unsigned*)(ap->ws + WS_CTL) + CW_BAR; bar.bar = bw; bar.x = 0; bar.st = nullptr;
      if (hi - lo > 1) bar = xcd_barrier_post(bw, MISC + 8); }
#else
    { CArgs ap = kargs(); bar = xcd_barrier_post((unsigned*)(ap->ws + WS_CTL) + CW_BAR, MISC + 8); }
#endif
#if MK_PER_PHASE
#define IN(k) (lo <= (k) && (k) < hi)
#define SEAM(k) do { if (IN(k) && IN((k) + 1)) xcd_barrier(bar); } while (0)
#else
#define IN(k) true
#define SEAM(k) do { if ((k) + 1 < NL * NPH) xcd_barrier(bar); } while (0)
#endif
#define WSP(T, off) ((T*)(ws + (off)))
#pragma unroll 1
    for (int l = 0; l < NL; ++l) {
        const int pb = l * NPH;
        if (IN(pb + 0)) REP(0) {
            CArgs ap = kargs(); unsigned char* ws = ap->ws;
            ph_convw(lds, ap, l, blk, nblk);
            if (l == 0) ph_copy_x(ap->in[0], ap->out, WSP(bf16, WS_XB), WSP(float, WS_SSQA), blk, nblk);

        }
        SEAM(pb + 0);
        if (IN(pb + 1)) REP(1) {
            CArgs ap = kargs(); unsigned char* ws = ap->ws;
            pg8::Gemm g{WSP(bf16, WS_XB), WSP(bf16, WS_WIN), T_, NIN, DM, 0}; pg8::StaticOrder S; S.init(T_, NIN, nblk, blk);
            pg8::EpiIn E{WSP(float, WS_SSQA), WSP(bf16, WS_Q), WSP(bf16, WS_K), WSP(bf16, WS_V), WSP(bf16, WS_RW), ap->in[5] + l * 128, ap->in[6] + l * 128};
            pg8::gemm_phase<pg8::EpiIn, pg8::StaticOrder, true, true>(lds, g, S, E);
        }
        SEAM(pb + 1);
        if (IN(pb + 2)) REP(2) {
            CArgs ap = kargs(); unsigned char* ws = ap->ws; const int lm = l > 0 ? l - 1 : 0;
            rk::S1Args A; A.rw = WSP(bf16, WS_RW); A.mu = ap->in[10] + (size_t)l * 3360; A.w0 = ap->in[11] + l * 1024; A.a0 = ap->in[13] + l * 1024; A.v0 = ap->in[21] + lm * 1024; A.k_k = ap->in[16] + l * 1024; A.k_a = ap->in[17] + l * 1024;
            A.r_k = ap->in[18] + l * 1024; A.w2t = (const bf16*)(ws + WS_LORA + LORA_W2); A.a2t = (const bf16*)(ws + WS_LORA + LORA_A2); A.g2t = (const bf16*)(ws + WS_LORA + LORA_G2); A.v2t = (const bf16*)(ws + WS_LORA + LORA_V2);
            A.vfirst = WSP(bf16, WS_VFIRST); A.BV = WSP(bf16, WS_BV); A.GB = WSP(bf16, WS_GB); A.PG = WSP(bf16, WS_PG); A.QT = WSP(float, WS_QT); A.RP = WSP(bf16, WS_RP); A.Y0 = WSP(float, WS_Y0); A.layer = l; A.pad_ = 0;
            rk::ph_stage1(lds, A, blk, nblk);
        }
        SEAM(pb + 2);
        if (IN(pb + 3)) {
            CArgs ap = kargs(); unsigned char* ws = ap->ws;
            rk::ph_chain(WSP(bf16, WS_PG), WSP(float, WS_QT), WSP(bf16, WS_H0T), blk, nblk);
            att::Args A; A.Q = WSP(bf16, WS_Q); A.K = WSP(bf16, WS_K); A.V = WSP(bf16, WS_V); A.mixed = WSP(bf16, WS_MIXED); A.stash = WSP(float, WS_STASH); A.lq = ap->in[7] + l * 128; A.lk = ap->in[8] + l * 128; A.subln = ap->in[9] + l * 128; A.gq = ap->in[5] + l * 128; A.gk = ap->in[6] + l * 128;
            A.lam_init = ap->lam_init[l]; A.pad_ = 0;
            att::attn_phase(lds, A, blk, (unsigned*)(ws + WS_CTL) + CW_ATTQ + 64 * l, MISC + 16, WSP(float, WS_PART));
        }
        SEAM(pb + 3);
        if (IN(pb + 4)) REP(4) {
            CArgs ap = kargs(); unsigned char* ws = ap->ws;
            rk::S3Args A{WSP(bf16, WS_H0T), WSP(bf16, WS_RP), WSP(float, WS_Y0), WSP(bf16, WS_BV), WSP(bf16, WS_GB), ap->in[19] + l * 1024, ap->in[20] + l * 1024, WSP(bf16, WS_MIXED)};
            rk::ph_stage3(A, blk, nblk);
            att::Args B; B.Q = WSP(bf16, WS_Q); B.K = WSP(bf16, WS_K); B.V = WSP(bf16, WS_V); B.mixed = WSP(bf16, WS_MIXED); B.stash = WSP(float, WS_STASH); B.lq = ap->in[7] + l * 128; B.lk = ap->in[8] + l * 128; B.subln = ap->in[9] + l * 128;
            B.gq = ap->in[5] + l * 128; B.gk = ap->in[6] + l * 128; B.lam_init = ap->lam_init[l]; B.pad_ = 0;
            att::attn_combine(lds, B, blk, nblk, WSP(float, WS_PART));
        }
        SEAM(pb + 4);
        if (IN(pb + 5)) {
            CArgs ap = kargs(); unsigned char* ws = ap->ws;
            pg8::Gemm g{WSP(bf16, WS_MIXED), WSP(bf16, WS_WOUT), T_, DM, DM, 0}; pg8::StaticOrder S; S.init(T_, DM, nblk, blk);
            pg8::EpiRes E{ap->out, WSP(bf16, WS_XB), WSP(float, WS_SSQB), DM, 0};
            pg8::gemm_phase<pg8::EpiRes, pg8::StaticOrder, true, true>(lds, g, S, E);
        }
        SEAM(pb + 5);
        if (IN(pb + 6)) REP(6) {
            CArgs ap = kargs(); unsigned char* ws = ap->ws;
            pg8::Gemm g{WSP(bf16, WS_XB), WSP(bf16, WS_WUP), T_, DFF, DM, 0}; pg8::StaticOrder S; S.init(T_, DFF, nblk, blk);
            pg8::EpiUp E{WSP(float, WS_SSQB), WSP(bf16, WS_U), DFF, 0};
            pg8::gemm_phase<pg8::EpiUp, pg8::StaticOrder, true, true>(lds, g, S, E);
        }
        SEAM(pb + 6);
        if (IN(pb + 7)) {
            CArgs ap = kargs(); unsigned char* ws = ap->ws;
            pg8::Gemm g{WSP(bf16, WS_U), WSP(bf16, WS_WDOWN), T_, DM, DFF, 0}; pg8::StaticOrder S; S.init(T_, DM, nblk, blk);
            pg8::EpiRes E{ap->out, WSP(bf16, WS_XB), WSP(float, WS_SSQA), DM, 0};
            pg8::gemm_phase<pg8::EpiRes, pg8::StaticOrder, true, true>(lds, g, S, E);
        }
        SEAM(pb + 7);
    }
#undef IN
#undef SEAM
#undef WSP
}

extern "C" void kernel_launch(void* const* d_in, const int* in_sizes, int n_in, void* d_out, int out_size, void* d_ws, size_t ws_size, hipStream_t stream) {
    static int grid = 0;
    if (grid == 0) {
        grid = -1;
        if (n_in != 26 || ws_size < WS_END || out_size != T_ * DM) { fprintf(stderr, "kernel_launch: unexpected shapes (n_in %d ws %zu out %d)\n", n_in, ws_size, out_size); return; }
        int dev = 0, cus = 0, per_cu = 0;
        if (hipGetDevice(&dev) != hipSuccess || hipDeviceGetAttribute(&cus, hipDeviceAttributeMultiprocessorCount, dev) != hipSuccess) return;
        if (hipFuncSetAttribute((const void*)fwd, hipFuncAttributeMaxDynamicSharedMemorySize, LDS_BYTES) != hipSuccess) return;
        if (hipOccupancyMaxActiveBlocksPerMultiprocessor(&per_cu, (const void*)fwd, 512, LDS_BYTES) != hipSuccess || per_cu < 1) { fprintf(stderr, "kernel_launch: occupancy query says %d\n", per_cu); (void)hipGetLastError(); return; }
        if (cus < 8) return;
        grid = cus;
    }
    if (grid < 0) return;
    if (hipMemsetAsync((char*)d_ws + WS_CTL, 0, CTL_ZERO_BYTES, stream) != hipSuccess) return;
    Args a;
    memset(&a, 0, sizeof(a));
    for (int i = 0; i < 26; ++i) a.in[i] = (const float*)d_in[i];
    a.out = (float*)d_out; a.ws = (unsigned char*)d_ws;
    for (int l = 0; l < NL; ++l) a.lam_init[l] = (float)(0.8 - 0.6 * exp(-0.3 * (double)l));
    const int nph = NL * NPH;
#if MK_PER_PHASE
    for (int p = 0; p < nph; ++p) { a.ph_lo = p; a.ph_hi = p + 1; hipLaunchKernelGGL(fwd, dim3(grid), dim3(512), LDS_BYTES, stream, a); }
#else
    a.ph_lo = 0; a.ph_hi = nph; hipLaunchKernelGGL(fwd, dim3(grid), dim3(512), LDS_BYTES, stream, a);
#endif
}
```

```cpp
#include <hip/hip_runtime.h>
#include <cstdio>
#include <cstdint>
#include <cstring>
#include <cmath>

constexpr int T_ = 16384, DM = 2048, NL = 4, PW = 6432, NIN = 6656, RWP = 3584, DFF = 8192, RW_ = 1024;
constexpr float RMS_EPS = 1e-6f, GN_EPS = 64e-5f;
typedef unsigned short bf16;
typedef float f32x4 __attribute__((ext_vector_type(4)));
typedef unsigned u32x4 __attribute__((ext_vector_type(4)));
typedef unsigned u32x2 __attribute__((ext_vector_type(2)));
#define LAS __attribute__((address_space(3)))

__device__ __forceinline__ unsigned f2bf(float f) { unsigned u = __builtin_bit_cast(unsigned, f); return (u + 0x7fffu + ((u >> 16) & 1u)) >> 16; }
__device__ __forceinline__ float bf2f(unsigned short b) { return __builtin_bit_cast(float, (unsigned)b << 16); }
__device__ __forceinline__ float bflo(unsigned w) { return __builtin_bit_cast(float, w << 16); }
__device__ __forceinline__ float bfhi(unsigned w) { return __builtin_bit_cast(float, w & 0xffff0000u); }
__device__ __forceinline__ float sigmoidf_(float x) { return 1.0f / (1.0f + __expf(-x)); }

template <int CTRL, int ROWMASK> __device__ __forceinline__ float dppf(float v) {
    return __builtin_bit_cast(float, __builtin_amdgcn_update_dpp(0, __builtin_bit_cast(int, v), CTRL, ROWMASK, 0xF, false));
}
__device__ __forceinline__ float wave_sum(float v) {
    v += dppf<0xB1, 0xF>(v); v += dppf<0x4E, 0xF>(v); v += dppf<0x141, 0xF>(v); v += dppf<0x140, 0xF>(v);
    v += dppf<0x142, 0xA>(v); v += dppf<0x143, 0xC>(v);
    return __builtin_bit_cast(float, __builtin_amdgcn_readlane(__builtin_bit_cast(int, v), 63));
}
__device__ __forceinline__ int opq_tid() { int t = (int)threadIdx.x; asm volatile("" : "+v"(t)); return t; }
namespace pg8 {
#define PG8_LAS __attribute__((address_space(3)))
typedef unsigned short bf16_t;
typedef short bf16x8 __attribute__((ext_vector_type(8)));
typedef float f32x4 __attribute__((ext_vector_type(4)));
typedef unsigned u32x4 __attribute__((ext_vector_type(4)));
constexpr int BM = 256, BK = 64, HALF = 128, HTB = HALF * BK * 2  , STAGE_BYTES = 8 * HTB, NXCD = 8, WGM = 8;

__host__ __device__ __forceinline__ int lds_byte(int r, int c) { const int st = (r >> 4) * 2 + (c >> 5), rr = r & 15, cc = c & 31, ob = rr * 64 + cc * 2; return st * 1024 + (ob ^ (((ob >> 9) & 1) << 5)); }
__host__ __device__ __forceinline__ void stage_rc(int b, int& R, int& C) { const int st = b / 1024, sb = b % 1024, swz = sb ^ (((sb >> 9) & 1) << 5); R = (st >> 1) * 16 + swz / 64; C = (st & 1) * 32 + (swz % 64) / 2; }
__host__ __device__ __forceinline__ int perm32(int rho) { const int n = rho >> 4, i = rho & 15; return 8 * (i >> 2) + 4 * n + (i & 3); }

struct Unit { int pm, pn; };
struct Gemm { const bf16_t* A; const bf16_t* Bt; int M, N, K, pad_; };

struct StaticOrder {
    int nM, nN, nwg, G, c;
    __host__ __device__ void init(int M, int N, int G_, int c_) { nM = M / BM; nN = N / BM; nwg = nM * nN; G = G_; c = c_; }
    __host__ __device__ bool next(int i, Unit& u) const {
        const long L = (long)i * G + c; if (L >= nwg) return false;
        int wgid = (int)L; { const int q = nwg / NXCD, r = nwg % NXCD, xcd = wgid % NXCD, off = wgid / NXCD; wgid = (xcd < r ? xcd * (q + 1) : r * (q + 1) + (xcd - r) * q) + off; }
        const int nig = WGM * nN, gid = wgid / nig, fm = gid * WGM, gsz = (nM - fm) < WGM ? (nM - fm) : WGM;
        u.pm = fm + ((wgid % nig) % gsz); u.pn = (wgid % nig) / gsz; return true;
    }
    __device__ __forceinline__ void a_ready(const Unit&) const {}
    __device__ __forceinline__ void done(const Unit&) const {}
};

__device__ __forceinline__ unsigned cvt_pk_bf16(float lo, float hi) { unsigned r; asm volatile("v_cvt_pk_bf16_f32 %0, %1, %2" : "=v"(r) : "v"(lo), "v"(hi)); return r; }
typedef float f32x2 __attribute__((ext_vector_type(2)));
__device__ __forceinline__ float row_ssq(const float* ssq, int row, int fq) {
    const f32x4 a = *(const f32x4*)(ssq + (size_t)row * 32 + 8 * fq), b = *(const f32x4*)(ssq + (size_t)row * 32 + 8 * fq + 4);
    float s = ((a[0] + a[1]) + (a[2] + a[3])) + ((b[0] + b[1]) + (b[2] + b[3]));
    s += __shfl_xor(s, 16); s += __shfl_xor(s, 32); return s;
}
struct EpiIn {
    static constexpr bool PERM = true, AFTER_DRAIN = false;
    const float* rinv; bf16_t* q; bf16_t* k; bf16_t* v; bf16_t* rw; const float* gq; const float* gk;
    __device__ __forceinline__ void operator()(const f32x4 (&acc)[2][2][4][2], const Unit& u, int wr, int wc, int fr, int fq) const {
        const int pn = u.pn;
        const int row0 = u.pm * BM + wr * 64 + fr;
        if (pn < 8) {
            const float* g = (pn < 4 ? gq : gk) + (wc & 1) * 64 + 8 * fq;
            f32x4 gv[2][2];
#pragma unroll
            for (int bj = 0; bj < 2; ++bj)
#pragma unroll
                for (int n = 0; n < 2; ++n) gv[bj][n] = *(const f32x4*)(g + 32 * bj + 4 * n);
            bf16_t* base = (pn < 4 ? q : k) + (pn & 3) * 256 + 64 * wc + 8 * fq;
#pragma unroll
            for (int ai = 0; ai < 2; ++ai)
#pragma unroll
                for (int m = 0; m < 4; ++m) {
                    const int row = row0 + ai * HALF + m * 16; const float ri = 1.0f / sqrtf(row_ssq(rinv, row, fq) * (1.0f / 2048.0f) + 1e-6f);
                    f32x4 vv[2][2]; float ss = 0.f;
#pragma unroll
                    for (int bj = 0; bj < 2; ++bj)
#pragma unroll
                        for (int n = 0; n < 2; ++n) { vv[bj][n] = acc[ai][bj][m][n] * ri; const f32x4 t = vv[bj][n]; ss += (t[0] * t[0] + t[1] * t[1]) + (t[2] * t[2] + t[3] * t[3]); }
                    ss += __shfl_xor(ss, 16); ss += __shfl_xor(ss, 32);
                    const float rq = 1.0f / sqrtf(ss * (1.0f / 64.0f) + 1e-6f);
#pragma unroll
                    for (int bj = 0; bj < 2; ++bj) { const f32x4 a = vv[bj][0] * rq * gv[bj][0], b = vv[bj][1] * rq * gv[bj][1];
                        u32x4 w; w.x = cvt_pk_bf16(a[0], a[1]); w.y = cvt_pk_bf16(a[2], a[3]); w.z = cvt_pk_bf16(b[0], b[1]); w.w = cvt_pk_bf16(b[2], b[3]);
                        *(u32x4*)(base + (size_t)row * 1024 + 32 * bj) = w; }
                }
        } else {
            bf16_t* base; int ld;
            if (pn < 12) { base = v + (pn - 8) * 256 + 64 * wc + 8 * fq; ld = 1024; } else { base = rw + (pn - 12) * 256 + 64 * wc + 8 * fq; ld = 3584; }
#pragma unroll
            for (int ai = 0; ai < 2; ++ai)
#pragma unroll
                for (int m = 0; m < 4; ++m) {
                    const int row = row0 + ai * HALF + m * 16; const float ri = 1.0f / sqrtf(row_ssq(rinv, row, fq) * (1.0f / 2048.0f) + 1e-6f);
#pragma unroll
                    for (int bj = 0; bj < 2; ++bj) { const f32x4 a = acc[ai][bj][m][0] * ri, b = acc[ai][bj][m][1] * ri;
                        u32x4 w; w.x = cvt_pk_bf16(a[0], a[1]); w.y = cvt_pk_bf16(a[2], a[3]); w.z = cvt_pk_bf16(b[0], b[1]); w.w = cvt_pk_bf16(b[2], b[3]);
                        *(u32x4*)(base + (size_t)row * ld + 32 * bj) = w; }
                }
        }
    }
};
struct EpiRes {
    static constexpr bool PERM = true, AFTER_DRAIN = false;
    float* x; bf16_t* xb; float* ssq; int ldc; int pad_;
    __device__ __forceinline__ void operator()(const f32x4 (&acc)[2][2][4][2], const Unit& u, int wr, int wc, int fr, int fq) const {
        const int row0 = u.pm * BM + wr * 64 + fr, col0 = u.pn * BM + wc * 32 + 8 * fq;
#pragma unroll
        for (int ai = 0; ai < 2; ++ai)
#pragma unroll
            for (int m = 0; m < 4; ++m) { const int row = row0 + ai * HALF + m * 16; float* rowp = x + (size_t)row * ldc + col0; bf16_t* rowb = xb + (size_t)row * ldc + col0; float ss = 0.f;
#pragma unroll
                for (int bj = 0; bj < 2; ++bj) { f32x4* p = (f32x4*)(rowp + bj * HALF); const f32x4 o0 = p[0] + acc[ai][bj][m][0], o1 = p[1] + acc[ai][bj][m][1]; p[0] = o0; p[1] = o1;
                    ss += ((o0[0] * o0[0] + o0[1] * o0[1]) + (o0[2] * o0[2] + o0[3] * o0[3])) + ((o1[0] * o1[0] + o1[1] * o1[1]) + (o1[2] * o1[2] + o1[3] * o1[3]));
                    u32x4 w; w.x = cvt_pk_bf16(o0[0], o0[1]); w.y = cvt_pk_bf16(o0[2], o0[3]); w.z = cvt_pk_bf16(o1[0], o1[1]); w.w = cvt_pk_bf16(o1[2], o1[3]);
                    *(u32x4*)(rowb + bj * HALF) = w; }
                ss += __shfl_xor(ss, 16); ss += __shfl_xor(ss, 32);
                if (fq == 0) ssq[(size_t)row * 32 + u.pn * 4 + wc] = ss; }
    }
};
struct EpiUp {
    static constexpr bool PERM = true, AFTER_DRAIN = false;
    const float* rinv; bf16_t* o; int ldc; int pad_;
    __device__ __forceinline__ void operator()(const f32x4 (&acc)[2][2][4][2], const Unit& u, int wr, int wc, int fr, int fq) const {
        const int row0 = u.pm * BM + wr * 64 + fr, col0 = u.pn * BM + wc * 32 + 8 * fq;
#pragma unroll
        for (int ai = 0; ai < 2; ++ai)
#pragma unroll
            for (int m = 0; m < 4; ++m) { const int row = row0 + ai * HALF + m * 16; const float ri = 1.0f / sqrtf(row_ssq(rinv, row, fq) * (1.0f / 2048.0f) + 1e-6f);   bf16_t* rowp = o + (size_t)row * ldc + col0;
#pragma unroll
                for (int bj = 0; bj < 2; ++bj) { f32x4 a = acc[ai][bj][m][0] * ri, b = acc[ai][bj][m][1] * ri;
#pragma unroll
                    for (int e = 0; e < 4; ++e) { a[e] = a[e] > 0.f ? a[e] * a[e] : 0.f; b[e] = b[e] > 0.f ? b[e] * b[e] : 0.f; }
                    u32x4 w; w.x = cvt_pk_bf16(a[0], a[1]); w.y = cvt_pk_bf16(a[2], a[3]); w.z = cvt_pk_bf16(b[0], b[1]); w.w = cvt_pk_bf16(b[2], b[3]);
                    *(u32x4*)(rowp + bj * HALF) = w; } }
    }
};
template <class Epi, class Sched, bool ALIGN_EPI = false, bool SP2 = false>
__device__ __forceinline__ void gemm_phase(PG8_LAS unsigned char* lds, const Gemm g, const Sched& S, const Epi& E) {
    const int tid = opq_tid(), wid = __builtin_amdgcn_readfirstlane(tid >> 6), lane = tid & 63, wr = wid >> 2, wc = wid & 3, fr = lane & 15, fq = lane >> 4;
    const int K = g.K, nt = K / BK;
    unsigned voffA[2], voffB[2];
#pragma unroll
    for (int i = 0; i < 2; ++i) { int R, C; stage_rc(tid * 16 + i * 8192, R, C); const int Rb = Epi::PERM ? ((R & ~31) + perm32(R & 31)) : R;
        voffA[i] = (unsigned)(R * K + C) * 2u; voffB[i] = (unsigned)(Rb * K + C) * 2u; }
    const size_t kstep = (size_t)(BK * 2);
    const size_t hstep = (size_t)HALF * K * 2;
    const size_t tstep = 2 * hstep;
    const unsigned ldsw = (unsigned)wid * 1024u;
    const int aoff = lds_byte(wr * 64 + fr, fq * 8), boff = lds_byte(wc * 32 + fr, fq * 8);
#define PG8_SA(b, h) (((b) * 2 + (h)) * HTB)
#define PG8_SB(b, h) ((4 + (b) * 2 + (h)) * HTB)
#define PG8_STAGE(bufoff, gbase, voff) do { _Pragma("unroll") for (int _i = 0; _i < 2; ++_i) \
        __builtin_amdgcn_global_load_lds((const unsigned*)((const char*)(gbase) + (voff)[_i]), (PG8_LAS unsigned*)(lds + (bufoff) + ldsw + _i * 8192), 16, 0, 0); } while (0)
#define PG8_LDA(dst, b, h) do { _Pragma("unroll") for (int m = 0; m < 4; ++m) _Pragma("unroll") for (int k = 0; k < 2; ++k) dst[m][k] = *(const PG8_LAS bf16x8*)(lds + PG8_SA(b, h) + aoff + m * 2048 + k * 1024); } while (0)
#define PG8_LDB(dst, b, h) do { _Pragma("unroll") for (int n = 0; n < 2; ++n) _Pragma("unroll") for (int k = 0; k < 2; ++k) dst[n][k] = *(const PG8_LAS bf16x8*)(lds + PG8_SB(b, h) + boff + n * 2048 + k * 1024); } while (0)
#define PG8_MMA(ai, bj, At, Bt) do { __builtin_amdgcn_s_setprio(1); _Pragma("unroll") for (int m = 0; m < 4; ++m) _Pragma("unroll") for (int n = 0; n < 2; ++n) _Pragma("unroll") for (int k = 0; k < 2; ++k) \
        acc[ai][bj][m][n] = __builtin_amdgcn_mfma_f32_16x16x32_bf16(Bt[n][k], At[m][k], acc[ai][bj][m][n], 0, 0, 0); __builtin_amdgcn_s_setprio(0); } while (0)
#define PG8_WAIT_V(n) asm volatile("s_waitcnt vmcnt(" #n ")" ::: "memory")
#define PG8_WAIT_L(n) asm volatile("s_waitcnt lgkmcnt(" #n ")" ::: "memory")
#define PG8_BAR __builtin_amdgcn_s_barrier()
#define PG8_SCHED __builtin_amdgcn_sched_barrier(0)
    Unit cur, nxt; int ui = 0;
    if (!S.next(0, cur)) return;
    f32x4 acc[2][2][4][2];
#pragma unroll
    for (int a = 0; a < 2; ++a)
#pragma unroll
        for (int b = 0; b < 2; ++b)
#pragma unroll
            for (int m = 0; m < 4; ++m)
#pragma unroll
                for (int n = 0; n < 2; ++n) acc[a][b][m][n] = (f32x4){0.f, 0.f, 0.f, 0.f};
    bf16x8 At[4][2], B0[2][2], B1[2][2];
    const char* cA = (const char*)g.A + (size_t)cur.pm * tstep; const char* cB = (const char*)g.Bt + (size_t)cur.pn * tstep;
    S.a_ready(cur);
    if constexpr (SP2) {
        PG8_STAGE(PG8_SB(0, 0), cB, voffB); PG8_STAGE(PG8_SB(0, 1), cB + hstep, voffB); PG8_STAGE(PG8_SA(0, 0), cA, voffA); PG8_STAGE(PG8_SA(0, 1), cA + hstep, voffA);
        if (wr == 1) PG8_BAR;
        PG8_WAIT_V(2); PG8_BAR;
        PG8_STAGE(PG8_SB(1, 0), cB + kstep, voffB); PG8_STAGE(PG8_SA(1, 0), cA + kstep, voffA); PG8_STAGE(PG8_SB(1, 1), cB + hstep + kstep, voffB);
        PG8_WAIT_V(6); PG8_BAR;
    } else {
        PG8_STAGE(PG8_SB(0, 0), cB, voffB); PG8_STAGE(PG8_SA(0, 0), cA, voffA); PG8_STAGE(PG8_SB(0, 1), cB + hstep, voffB); PG8_STAGE(PG8_SA(0, 1), cA + hstep, voffA);
        if (wr == 1) PG8_BAR;
        PG8_WAIT_V(4); PG8_BAR;
        PG8_STAGE(PG8_SB(1, 0), cB + kstep, voffB); PG8_STAGE(PG8_SA(1, 0), cA + kstep, voffA); PG8_STAGE(PG8_SB(1, 1), cB + hstep + kstep, voffB);
        PG8_WAIT_V(6); PG8_BAR;
    }
    for (;;) {
        const bool has_next = S.next(ui + 1, nxt);
        const char* nA = has_next ? (const char*)g.A + (size_t)nxt.pm * tstep : cA; const char* nB = has_next ? (const char*)g.Bt + (size_t)nxt.pn * tstep : cB;
        for (int t = 0; t < nt; t += 2) {
            const bool last = (t == nt - 2);
            const char* a1 = cA + (size_t)(t + 1) * kstep;
            const char* a2 = last ? nA : cA + (size_t)(t + 2) * kstep; const char* b2 = last ? nB : cB + (size_t)(t + 2) * kstep;
            const char* a3 = a2 + kstep; const char* b3 = b2 + kstep;
            if (last && has_next) S.a_ready(nxt);
            if constexpr (SP2) {
            PG8_LDB(B0, 0, 0); PG8_LDB(B1, 0, 1); PG8_SCHED; PG8_LDA(At, 0, 0); PG8_STAGE(PG8_SA(1, 1), a1 + hstep, voffA);
            PG8_WAIT_V(8); PG8_WAIT_L(0); PG8_BAR; PG8_MMA(0, 0, At, B0); PG8_MMA(0, 1, At, B1); PG8_BAR; PG8_SCHED;
            PG8_LDA(At, 0, 1); PG8_STAGE(PG8_SB(0, 0), b2, voffB); PG8_STAGE(PG8_SB(0, 1), b2 + hstep, voffB); PG8_STAGE(PG8_SA(0, 0), a2, voffA);
            PG8_WAIT_V(8); PG8_WAIT_L(0); PG8_BAR; PG8_MMA(1, 0, At, B0); PG8_MMA(1, 1, At, B1); PG8_BAR; PG8_SCHED;
            PG8_LDB(B0, 1, 0); PG8_LDB(B1, 1, 1); PG8_SCHED; PG8_LDA(At, 1, 0); PG8_STAGE(PG8_SA(0, 1), a2 + hstep, voffA);
            PG8_WAIT_V(8); PG8_WAIT_L(0); PG8_BAR; PG8_MMA(0, 0, At, B0); PG8_MMA(0, 1, At, B1); PG8_BAR; PG8_SCHED;
            PG8_LDA(At, 1, 1); PG8_STAGE(PG8_SB(1, 0), b3, voffB); PG8_STAGE(PG8_SB(1, 1), b3 + hstep, voffB); PG8_STAGE(PG8_SA(1, 0), a3, voffA);
            PG8_WAIT_V(8); PG8_WAIT_L(0); PG8_BAR; PG8_MMA(1, 0, At, B0); PG8_MMA(1, 1, At, B1); PG8_BAR; PG8_SCHED;
            } else {
            PG8_LDB(B0, 0, 0); PG8_SCHED; PG8_LDA(At, 0, 0); PG8_STAGE(PG8_SA(1, 1), a1 + hstep, voffA);
            PG8_WAIT_L(8); PG8_BAR; PG8_WAIT_L(0); PG8_MMA(0, 0, At, B0); PG8_BAR; PG8_SCHED;
            PG8_LDB(B1, 0, 1); PG8_STAGE(PG8_SB(0, 0), b2, voffB);
            PG8_BAR; PG8_WAIT_L(0); PG8_MMA(0, 1, At, B1); PG8_BAR;
            PG8_LDA(At, 0, 1); PG8_STAGE(PG8_SA(0, 0), a2, voffA);
            PG8_BAR; PG8_WAIT_L(0); PG8_MMA(1, 0, At, B0); PG8_BAR; PG8_SCHED;
            PG8_STAGE(PG8_SB(0, 1), b2 + hstep, voffB);
            PG8_WAIT_V(6); PG8_BAR; PG8_MMA(1, 1, At, B1); PG8_BAR;
            PG8_LDB(B0, 1, 0); PG8_SCHED; PG8_LDA(At, 1, 0); PG8_STAGE(PG8_SA(0, 1), a2 + hstep, voffA);
            PG8_WAIT_L(8); PG8_BAR; PG8_WAIT_L(0); PG8_MMA(0, 0, At, B0); PG8_BAR; PG8_SCHED;
            PG8_LDB(B1, 1, 1); PG8_STAGE(PG8_SB(1, 0), b3, voffB);
            PG8_BAR; PG8_WAIT_L(0); PG8_MMA(0, 1, At, B1); PG8_BAR;
            PG8_LDA(At, 1, 1); PG8_STAGE(PG8_SA(1, 0), a3, voffA);
            PG8_BAR; PG8_WAIT_L(0); PG8_MMA(1, 0, At, B0); PG8_BAR; PG8_SCHED;
            PG8_STAGE(PG8_SB(1, 1), b3 + hstep, voffB);
            PG8_WAIT_V(6); PG8_BAR; PG8_MMA(1, 1, At, B1); PG8_BAR;
            }
        }
        if constexpr (ALIGN_EPI) { if (wr == 0) PG8_BAR; }
        if constexpr (!Epi::AFTER_DRAIN) { E(acc, cur, wr, wc, fr, fq); S.done(cur); }
        if (!has_next) break;
#pragma unroll
        for (int a = 0; a < 2; ++a)
#pragma unroll
            for (int b = 0; b < 2; ++b)
#pragma unroll
                for (int m = 0; m < 4; ++m)
#pragma unroll
                    for (int n = 0; n < 2; ++n) acc[a][b][m][n] = (f32x4){0.f, 0.f, 0.f, 0.f};
        cur = nxt; cA = nA; cB = nB; ++ui;
        if constexpr (ALIGN_EPI) { if (wr == 1) PG8_BAR; }
    }
    PG8_WAIT_V(0);
    if constexpr (!ALIGN_EPI) { if (wr == 0) PG8_BAR; }
    PG8_BAR;
    if constexpr (Epi::AFTER_DRAIN) { E.fused(acc, cur, wr, wc, fr, fq, lds, wid, lane); S.done(cur); }
#undef PG8_SA
#undef PG8_SB
#undef PG8_STAGE
#undef PG8_LDA
#undef PG8_LDB
#undef PG8_MMA
#undef PG8_WAIT_V
#undef PG8_WAIT_L
#undef PG8_BAR
#undef PG8_SCHED
}
}

namespace att {
typedef short bf16x8 __attribute__((ext_vector_type(8)));
typedef short s16x4 __attribute__((ext_vector_type(4)));
typedef float f32x16 __attribute__((ext_vector_type(16)));
typedef float f32x2_t __attribute__((ext_vector_type(2)));
typedef __bf16 bf16x2_t __attribute__((ext_vector_type(2)));
typedef __attribute__((address_space(3))) const unsigned char* lds_cptr;
typedef short v4i16_t __attribute__((ext_vector_type(4)));
constexpr int KSLOT = 8192, VSLOT = 16384, LDS_K = 0, LDS_V = 2 * KSLOT, LDS_BYTES = 2 * KSLOT + 2 * VSLOT;
constexpr float LOG2E = 1.4426950408889634f, C2 = 0.125f * LOG2E;
__device__ __forceinline__ int crow(int r, int hi) { return (r & 3) + 8 * (r >> 2) + 4 * hi; }
__device__ __forceinline__ void glds16(const void* gsrc, unsigned lds_dst) { unsigned keep;
    asm volatile("s_mov_b32 %0, m0\n\ts_mov_b32 m0, %2\n\ts_nop 0\n\tglobal_load_lds_dwordx4 %1, off\n\ts_mov_b32 m0, %0" : "=&s"(keep) : "v"(gsrc), "s"(lds_dst) : "memory"); }
__device__ __forceinline__ unsigned cvtpk(float lo, float hi) { f32x2_t v = {lo, hi}; bf16x2_t b = __builtin_convertvector(v, bf16x2_t); return __builtin_bit_cast(unsigned, b); }
__device__ __forceinline__ s16x4 vtr(lds_cptr p) { return __builtin_bit_cast(s16x4, __builtin_amdgcn_ds_read_tr16_b64_v4i16((__attribute__((address_space(3))) v4i16_t*)p)); }
__device__ __forceinline__ float swap_max(float m) { auto rr = __builtin_amdgcn_permlane32_swap(__float_as_uint(m), __float_as_uint(m), false, false); return fmaxf(__uint_as_float(rr[0]), __uint_as_float(rr[1])); }
__device__ __forceinline__ float swap_sum(float m) { auto rr = __builtin_amdgcn_permlane32_swap(__float_as_uint(m), __float_as_uint(m), false, false); return __uint_as_float(rr[0]) + __uint_as_float(rr[1]); }
#define ATT_WAIT_BAR() asm volatile("s_waitcnt vmcnt(0) lgkmcnt(0)\n\ts_barrier" ::: "memory")

struct Args { const bf16* Q; const bf16* K; const bf16* V; bf16* mixed; float* stash; const float* lq; const float* lk; const float* subln; const float* gq; const float* gk; float lam_init; int pad_; };

constexpr int PART_F = 68, PART_SLOT_F = 512 * PART_F, MAX_SLOTS = 1700, SPLIT_MIN = 20, PART_TILES = 40, TAB_OFF = 65536;
__device__ __forceinline__ void attn_pass(__attribute__((address_space(3))) unsigned char* lds, const Args& A, int h, int qb, int c, int ta, int tb, int nw, f32x16 (&oT)[4], float& l_out, float& M_out) {
    const int tid = opq_tid(), lane = tid & 63, r32 = lane & 31, hi = lane >> 5; const int wid = __builtin_amdgcn_readfirstlane(tid >> 6);
    const int q0 = qb * 256 + wid * 32, qc = q0 >> 6;
    const float slope2 = exp2f(-(float)(h + 1)) * LOG2E;
    const unsigned lds0 = (unsigned)(uintptr_t)lds;
    const lds_cptr kp0 = (lds_cptr)lds + LDS_K + hi * 1024 + r32 * 16;
    const lds_cptr vp0 = (lds_cptr)lds + LDS_V + ((lane >> 4) & 1) * 32 + (lane & 3) * 8 + (4 * hi + ((lane & 15) >> 2)) * 64;
    const bf16* vsrc = A.V + (size_t)(16 * (wid & 3) + (lane >> 2)) * 1024 + h * 128 + (wid >> 2) * 32 + (lane & 3) * 8;
    const unsigned kdst = lds0 + LDS_K + wid * 1024, vdst = lds0 + LDS_V + (wid >> 2) * 4096 + (wid & 3) * 1024;
    const int qrel = (q0 & 63) + r32;
    const int tw0 = max(ta, max(0, qc - nw));
    const bf16* ksrc = A.K + (size_t)lane * 1024 + h * 128 + c * 64 + wid * 8;
    bf16x8 qr[4];
    { const bf16* qp = A.Q + (size_t)(q0 + r32) * 1024 + h * 128 + c * 64 + hi * 8;
#pragma unroll
      for (int d0 = 0; d0 < 4; ++d0) qr[d0] = *(const bf16x8*)(qp + d0 * 16); }
#pragma unroll
    for (int d0 = 0; d0 < 4; ++d0)
#pragma unroll
        for (int r = 0; r < 16; ++r) oT[d0][r] = 0.f;
    float l = 0.f, mu = 0.f;
    if (ta < tb) {
        { const size_t go = (size_t)ta * 64 * 1024; const unsigned so = (unsigned)(ta & 1);
          glds16(ksrc + go, (unsigned)__builtin_amdgcn_readfirstlane(kdst + so * KSLOT)); glds16(vsrc + go, (unsigned)__builtin_amdgcn_readfirstlane(vdst + so * VSLOT)); glds16(vsrc + go + 64, (unsigned)__builtin_amdgcn_readfirstlane(vdst + so * VSLOT + 8192)); }
        ATT_WAIT_BAR();
#pragma unroll 1
        for (int t = ta; t < tb; ++t) {
            const int sl = t & 1;
            if (t + 1 < tb) { const size_t go = (size_t)(t + 1) * 64 * 1024; const unsigned so = (unsigned)(sl ^ 1);
                glds16(ksrc + go, (unsigned)__builtin_amdgcn_readfirstlane(kdst + so * KSLOT)); glds16(vsrc + go, (unsigned)__builtin_amdgcn_readfirstlane(vdst + so * VSLOT));
                glds16(vsrc + go + 64, (unsigned)__builtin_amdgcn_readfirstlane(vdst + so * VSLOT + 8192)); }
            if (t >= tw0 && t <= qc) {
                const bool diag = (t == qc);
                f32x16 p0, p1;
                const float sc = slope2 * (1.0f / C2), base0 = (float)(4 * hi) * sc - mu * (1.0f / C2), base1 = base0 + 32.0f * sc;
                if (!diag) {
#pragma unroll
                    for (int r = 0; r < 16; ++r) { const float kr = (float)((r & 3) + 8 * (r >> 2)); p0[r] = __builtin_fmaf(kr, sc, base0); p1[r] = __builtin_fmaf(kr, sc, base1); }
                } else {
                    const float q2 = (float)(2 * qrel - 8 * hi);
#pragma unroll
                    for (int r = 0; r < 16; ++r) { const float kr = (float)((r & 3) + 8 * (r >> 2));
                        p0[r] = __builtin_fmaf(fminf(kr, q2 - kr) , sc, base0); p1[r] = __builtin_fmaf(fminf(kr, q2 - 64.0f - kr), sc, base1); }
                }
                const lds_cptr kp = kp0 + sl * KSLOT;
#pragma unroll
                for (int d0 = 0; d0 < 4; ++d0) {
                    const bf16x8 k0 = *(const __attribute__((address_space(3))) bf16x8*)(kp + d0 * 2048), k1 = *(const __attribute__((address_space(3))) bf16x8*)(kp + d0 * 2048 + 512);
                    p0 = __builtin_amdgcn_mfma_f32_32x32x16_bf16(k0, qr[d0], p0, 0, 0, 0);
                    p1 = __builtin_amdgcn_mfma_f32_32x32x16_bf16(k1, qr[d0], p1, 0, 0, 0);
                }
                float rm = fmaxf(p0[0], p1[0]);
#pragma unroll
                for (int r = 1; r < 16; ++r) rm = fmaxf(rm, fmaxf(p0[r], p1[r]));
                rm = swap_max(rm);
                const float dl = (t == tw0) ? C2 * rm : fmaxf(C2 * rm, 0.f);
                if (__any(dl != 0.f)) { const float f = __builtin_amdgcn_exp2f(-dl); l *= f;
#pragma unroll
                    for (int d0 = 0; d0 < 4; ++d0)
#pragma unroll
                        for (int r = 0; r < 16; ++r) oT[d0][r] *= f; }
                mu += dl;
                float ls = 0.f;
#pragma unroll
                for (int r = 0; r < 16; ++r) { p0[r] = __builtin_amdgcn_exp2f(p0[r] * C2 - dl); p1[r] = __builtin_amdgcn_exp2f(p1[r] * C2 - dl); ls += p0[r] + p1[r]; }
                l += ls;
                bf16x8 pw[4];
#pragma unroll
                for (int s = 0; s < 4; ++s) { u32x4 w;
#pragma unroll
                    for (int e = 0; e < 4; ++e) { const int r = 8 * (s & 1) + 2 * e; w[e] = (s < 2) ? cvtpk(p0[r], p0[r + 1]) : cvtpk(p1[r], p1[r + 1]); }
                    pw[s] = __builtin_bit_cast(bf16x8, w); }
                const lds_cptr vp = vp0 + sl * VSLOT;
#pragma unroll
                for (int d0 = 0; d0 < 4; ++d0) {
#pragma unroll
                    for (int s = 0; s < 4; ++s) { const s16x4 lo = vtr(vp + d0 * 4096 + s * 1024), hh = vtr(vp + d0 * 4096 + s * 1024 + 512);
                        const bf16x8 vf = (bf16x8){lo[0], lo[1], lo[2], lo[3], hh[0], hh[1], hh[2], hh[3]};
                        oT[d0] = __builtin_amdgcn_mfma_f32_32x32x16_bf16(vf, pw[s], oT[d0], 0, 0, 0); }
                    __builtin_amdgcn_sched_barrier(0); }
                mu -= 64.0f * slope2;
            }
            ATT_WAIT_BAR();
        }
    }
    const int tl = min(qc, tb - 1);
    l_out = l; M_out = (tl >= tw0) ? mu + slope2 * 64.0f * (float)(tl + 1) : -1e30f;
}
__device__ __forceinline__ void attn_finalize(const Args& A, int h, int qb, const f32x16 (&o1)[4], f32x16 (&o2)[4], float lam) {
    const int tid = opq_tid(), lane = tid & 63, r32 = lane & 31, hi = lane >> 5; const int wid = __builtin_amdgcn_readfirstlane(tid >> 6);
    const int q0 = qb * 256 + wid * 32;
    float ss = 0.f;
#pragma unroll
    for (int d0 = 0; d0 < 4; ++d0)
#pragma unroll
        for (int r = 0; r < 16; ++r) { const float v = o1[d0][r] - lam * o2[d0][r]; o2[d0][r] = v; ss += v * v; }
    ss = swap_sum(ss);
    const float rn = (1.0f / sqrtf(ss * (1.0f / 128.0f) + RMS_EPS)) * (1.0f - A.lam_init);
    bf16* op = A.mixed + (size_t)(q0 + r32) * DM + h * 128;
#pragma unroll
    for (int d0 = 0; d0 < 4; ++d0)
#pragma unroll
        for (int g4 = 0; g4 < 4; ++g4) { const int d = 32 * d0 + 8 * g4 + 4 * hi; const f32x4 gg = *(const f32x4*)(A.subln + d);
            u32x2 w; w.x = cvtpk(o2[d0][4 * g4] * rn * gg[0], o2[d0][4 * g4 + 1] * rn * gg[1]); w.y = cvtpk(o2[d0][4 * g4 + 2] * rn * gg[2], o2[d0][4 * g4 + 3] * rn * gg[3]);
            *(u32x2*)(op + d) = w; }
}
struct Win { float smax0, smax1; };
__device__ __forceinline__ int win_nw(const Win& W, int h, int c) { const float smax = c ? W.smax1 : W.smax0, slope2 = exp2f(-(float)(h + 1)) * LOG2E, dmin = (2.0f * C2 * smax + 67.0f) / slope2; return (int)fminf(ceilf((dmin + 63.0f) * (1.0f / 64.0f)) - 1.0f, 256.0f); }
__device__ __forceinline__ void attn_windows(const Args& A, Win& W, float& lam) {
    const int lane = opq_tid() & 63;
    const float l0 = wave_sum(A.lq[lane] * A.lk[lane]), l1 = wave_sum(A.lq[64 + lane] * A.lk[64 + lane]);
    lam = __expf(l0) - __expf(l1) + A.lam_init;
#pragma unroll
    for (int c = 0; c < 2; ++c) { float a = fabsf(A.gq[c * 64 + lane]), b = fabsf(A.gk[c * 64 + lane]);
#pragma unroll
        for (int o = 1; o < 64; o <<= 1) { a = fmaxf(a, __shfl_xor(a, o)); b = fmaxf(b, __shfl_xor(b, o)); }
        const float smax = 64.0f * 1.02f * a * b; if (c == 0) W.smax0 = smax; else W.smax1 = smax; }
}
__device__ __forceinline__ int attn_ntile(const Win& W, int h, int qb, int c) { return 4 * qb + 4 - max(0, 4 * qb - win_nw(W, h, c)); }
__device__ __forceinline__ int attn_table(__attribute__((address_space(3))) unsigned char* lds, const Win& W) {
    volatile __attribute__((address_space(3))) unsigned* tab = (volatile __attribute__((address_space(3))) unsigned*)(lds + TAB_OFF);
    const int tid = opq_tid(), lane = tid & 63, wid = tid >> 6, qb = 63 - (tid >> 3), h = tid & 7;
    const int nt = max(attn_ntile(W, h, qb, 0), attn_ntile(W, h, qb, 1));
    int P = nt > SPLIT_MIN ? (nt + PART_TILES - 1) / PART_TILES : 0;
    int want = 2 * P, incl = want;
#pragma unroll
    for (int o = 1; o < 64; o <<= 1) { const int v = __shfl_up(incl, o); if (lane >= o) incl += v; }
    if (lane == 63) tab[1032 + wid] = (unsigned)incl;
    asm volatile("s_waitcnt lgkmcnt(0)" ::: "memory"); __builtin_amdgcn_s_barrier(); asm volatile("" ::: "memory");
    int sbase = 0;
#pragma unroll
    for (int w = 0; w < 8; ++w) sbase += (w < wid) ? (int)tab[1032 + w] : 0;
    const int sstart = sbase + incl - want;
    if (sstart + want > MAX_SLOTS) P = 0;
    const int cnt = P > 0 ? 2 * P : 1; int ci = cnt;
#pragma unroll
    for (int o = 1; o < 64; o <<= 1) { const int v = __shfl_up(ci, o); if (lane >= o) ci += v; }
    if (lane == 63) tab[1024 + wid] = (unsigned)ci;
    asm volatile("s_waitcnt lgkmcnt(0)" ::: "memory"); __builtin_amdgcn_s_barrier(); asm volatile("" ::: "memory");
    int ibase = 0, total = 0;
#pragma unroll
    for (int w = 0; w < 8; ++w) { const int v = (int)tab[1024 + w]; ibase += (w < wid) ? v : 0; total += v; }
    tab[tid] = (unsigned)(ibase + ci - cnt) | ((unsigned)P << 16); tab[512 + tid] = (unsigned)sstart;
    asm volatile("s_waitcnt lgkmcnt(0)" ::: "memory"); __builtin_amdgcn_s_barrier(); asm volatile("" ::: "memory");
    return total;
}
__device__ __forceinline__ void part_range(const Win& W, int h, int qb, int c, int P, int p, int& ta, int& tb) {
    const int NT = 4 * qb + 4, T0 = max(0, 4 * qb - win_nw(W, h, c)), len = (NT - T0 + P - 1) / P; ta = min(NT, T0 + p * len); tb = min(NT, ta + len);
}
__device__ __forceinline__ void attn_phase(__attribute__((address_space(3))) unsigned char* lds, const Args& A, int blk, unsigned* ctr, volatile __attribute__((address_space(3))) unsigned* qslot, float* part) {
    const int tid = opq_tid();
    Win W; float lam; attn_windows(A, W, lam);
    const int nitems = attn_table(lds, W);
    volatile __attribute__((address_space(3))) unsigned* tab = (volatile __attribute__((address_space(3))) unsigned*)(lds + TAB_OFF);
    float* st = A.stash + (size_t)blk * (64 * 512) + tid * 64;
    for (;;) {
        if (tid == 0) { const unsigned n = __hip_atomic_fetch_add(ctr, 1u, __ATOMIC_RELAXED, __HIP_MEMORY_SCOPE_AGENT); unsigned idx = 0;
            if (n < (unsigned)nitems) { int lo = 0, hi = 511; while (lo < hi) { const int mid = (lo + hi + 1) >> 1; if ((tab[mid] & 0xffffu) <= n) lo = mid; else hi = mid - 1; } idx = (unsigned)lo; }
            qslot[0] = n; qslot[1] = idx; }
        asm volatile("s_waitcnt vmcnt(0) lgkmcnt(0)" ::: "memory"); __builtin_amdgcn_s_barrier(); asm volatile("" ::: "memory");
        const unsigned n = qslot[0], idx = qslot[1];
        asm volatile("s_waitcnt lgkmcnt(0)" ::: "memory"); __builtin_amdgcn_s_barrier(); asm volatile("" ::: "memory");
        if (n >= (unsigned)nitems) break;
        const unsigned e = tab[idx]; const int P = (int)(e >> 16), sub = (int)(n - (e & 0xffffu)), h = (int)(idx & 7u), qb = 63 - (int)(idx >> 3);
        f32x16 oT[4]; float l, M;
        if (P == 0) {
#pragma unroll 1
            for (int c = 0; c < 2; ++c) {
                attn_pass(lds, A, h, qb, c, max(0, 4 * qb - win_nw(W, h, c)), 4 * qb + 4, win_nw(W, h, c), oT, l, M);
                const float il = 1.0f / swap_sum(l);
#pragma unroll
                for (int d0 = 0; d0 < 4; ++d0)
#pragma unroll
                    for (int r = 0; r < 16; ++r) oT[d0][r] *= il;
                if (c == 0) {
#pragma unroll
                    for (int d0 = 0; d0 < 4; ++d0)
#pragma unroll
                        for (int r = 0; r < 16; r += 4) *(f32x4*)(st + d0 * 16 + r) = (f32x4){oT[d0][r], oT[d0][r + 1], oT[d0][r + 2], oT[d0][r + 3]};
                } else { f32x16 o1[4];
#pragma unroll
                    for (int d0 = 0; d0 < 4; ++d0)
#pragma unroll
                        for (int r = 0; r < 16; r += 4) { const f32x4 v = *(const f32x4*)(st + d0 * 16 + r); o1[d0][r] = v[0]; o1[d0][r + 1] = v[1]; o1[d0][r + 2] = v[2]; o1[d0][r + 3] = v[3]; }
                    attn_finalize(A, h, qb, o1, oT, lam); }
            }
        } else {
            const int c = sub / P, p = sub % P; int ta, tb; part_range(W, h, qb, c, P, p, ta, tb);
            attn_pass(lds, A, h, qb, c, ta, tb, win_nw(W, h, c), oT, l, M);
            float* ps = part + (size_t)(tab[512 + idx] + (unsigned)sub) * PART_SLOT_F + tid * PART_F;
#pragma unroll
            for (int d0 = 0; d0 < 4; ++d0)
#pragma unroll
                for (int r = 0; r < 16; r += 4) *(f32x4*)(ps + d0 * 16 + r) = (f32x4){oT[d0][r], oT[d0][r + 1], oT[d0][r + 2], oT[d0][r + 3]};
            *(f32x4*)(ps + 64) = (f32x4){l, M, 0.f, 0.f};
        }
    }
}
__device__ __forceinline__ void attn_combine(__attribute__((address_space(3))) unsigned char* lds, const Args& A, int blk, int nblk, const float* part) {
    const int tid = opq_tid();
    Win W; float lam; attn_windows(A, W, lam);
    (void)attn_table(lds, W);
    volatile __attribute__((address_space(3))) unsigned* tab = (volatile __attribute__((address_space(3))) unsigned*)(lds + TAB_OFF);
    int seen = 0, mine = blk;
    for (int idx = 0; idx < 512; ++idx) {
        const unsigned e = tab[idx]; const int P = (int)(e >> 16); if (P == 0) continue;
        if (seen++ != mine) continue;
        mine += nblk;
        const int h = idx & 7, qb = 63 - (idx >> 3);
        f32x16 o1[4], o2[4];
#pragma unroll 1
        for (int c = 0; c < 2; ++c) {
            const float* ps = part + (size_t)(tab[512 + idx] + (unsigned)(c * P)) * PART_SLOT_F + tid * PART_F;
            float M = -1e30f;
            for (int p = 0; p < P; ++p) M = fmaxf(M, ps[(size_t)p * PART_SLOT_F + 65]);
            float L = 0.f;
#pragma unroll
            for (int d0 = 0; d0 < 4; ++d0)
#pragma unroll
                for (int r = 0; r < 16; ++r) o2[d0][r] = 0.f;
            for (int p = 0; p < P; ++p) { const float* pp = ps + (size_t)p * PART_SLOT_F; const f32x4 lm = *(const f32x4*)(pp + 64); const float f = __builtin_amdgcn_exp2f(lm[1] - M); L += lm[0] * f;
#pragma unroll
                for (int d0 = 0; d0 < 4; ++d0)
#pragma unroll
                    for (int r = 0; r < 16; r += 4) { const f32x4 v = *(const f32x4*)(pp + d0 * 16 + r); o2[d0][r] += v[0] * f; o2[d0][r + 1] += v[1] * f; o2[d0][r + 2] += v[2] * f; o2[d0][r + 3] += v[3] * f; } }
            const float il = 1.0f / swap_sum(L);
            if (c == 0) {
#pragma unroll
                for (int d0 = 0; d0 < 4; ++d0)
#pragma unroll
                    for (int r = 0; r < 16; ++r) o1[d0][r] = o2[d0][r] * il;
            } else {
#pragma unroll
                for (int d0 = 0; d0 < 4; ++d0)
#pragma unroll
                    for (int r = 0; r < 16; ++r) o2[d0][r] *= il;
            }
        }
        attn_finalize(A, h, qb, o1, o2, lam);
    }
}
}

namespace rk {
typedef short bf16x8 __attribute__((ext_vector_type(8)));
typedef short s16x4 __attribute__((ext_vector_type(4)));
typedef short v4i16_t __attribute__((ext_vector_type(4)));
typedef const LAS unsigned char* lcp;
constexpr int ST = 72, MATB = 64 * ST * 2, NST = 68, SLG = 168, SVL = 40;
constexpr int O_AT = 0, O_RT = MATB, O_BT = 2 * MATB, O_KT = 3 * MATB, O_VV = 4 * MATB, O_AAK = 5 * MATB, O_ARB = 6 * MATB, O_ARK = 7 * MATB, O_NN = 8 * MATB, O_GG = O_NN + 64 * NST * 4,
              O_U0T = O_GG, O_WT = O_AAK, O_G2 = O_AAK  , O_VG = O_ARK  , O_SEG = O_GG + 64 * NST * 4, O_GL = O_SEG + 2048,
              O_LW = O_GL + 256, O_LA = O_LW + MATB, O_LG = O_LA + MATB, O_VL = O_LG + 64 * SLG * 2, O_END = O_VL + 64 * SVL * 2;
static_assert(64 * NST * 4 <= 2 * MATB && O_END <= 156000, "stage-1 LDS map");
__device__ __forceinline__ f32x4 mfma16(bf16x8 a, bf16x8 b, f32x4 c) { return __builtin_amdgcn_mfma_f32_16x16x32_bf16(a, b, c, 0, 0, 0); }
__device__ __forceinline__ s16x4 vtr(lcp p) { return __builtin_bit_cast(s16x4, __builtin_amdgcn_ds_read_tr16_b64_v4i16((LAS v4i16_t*)p)); }
__device__ __forceinline__ bf16x8 frag(lcp m, int row0, int ks, int lane, int st = ST) { return *(const LAS bf16x8*)(m + ((row0 + (lane & 15)) * st + 32 * ks + 8 * (lane >> 4)) * 2); }
__device__ __forceinline__ bf16x8 tfrag(lcp m, int c0, int ks, int lane) {
    const int i = lane & 15, q = i >> 2, p = i & 3, k0 = 32 * ks + 8 * (lane >> 4);
    const s16x4 lo = vtr(m + ((k0 + q) * ST + c0 + 4 * p) * 2), hi = vtr(m + ((k0 + 4 + q) * ST + c0 + 4 * p) * 2);
    return (bf16x8){lo[0], lo[1], lo[2], lo[3], hi[0], hi[1], hi[2], hi[3]};
}
__device__ __forceinline__ unsigned pk(float a, float b) { return f2bf(a) | (f2bf(b) << 16); }
#define RK_BAR() do { asm volatile("s_waitcnt lgkmcnt(0)" ::: "memory"); __builtin_amdgcn_s_barrier(); asm volatile("" ::: "memory"); } while (0)


constexpr int SOLVE_DEPTH = 3;
__host__ __device__ constexpr int solve_quads(int p) { return (2 * p + 1 + 3) / 4; }
typedef float f32x2 __attribute__((ext_vector_type(2)));
template <int P, int Q> struct SolveStep {
    static constexpr int NQ = solve_quads(P);
    template <int D, int PP, int QQ> struct Ahead { static constexpr int nxtP = (QQ + 1 < solve_quads(PP)) ? PP : PP + 1, nxtQ = (QQ + 1 < solve_quads(PP)) ? QQ + 1 : 0; using T = typename Ahead<D - 1, nxtP, nxtQ>::T; };
    template <int PP, int QQ> struct Ahead<0, PP, QQ> { using T = SolveStep<PP, QQ>; };
    static __device__ __forceinline__ void load(f32x4 (&ring)[SOLVE_DEPTH][2], int slot, LAS unsigned char* nn) {
        if constexpr (P < 32) { ring[slot][0] = *(const LAS f32x4*)(nn + ((2 * P) * NST + 4 * Q) * 4); ring[slot][1] = *(const LAS f32x4*)(nn + ((2 * P + 1) * NST + 4 * Q) * 4); }
    }
    template <int SLOT> static __device__ __forceinline__ void run(f32x2 (&x)[64], f32x2& a0, f32x2& a1, f32x4 (&ring)[SOLVE_DEPTH][2], LAS unsigned char* nn) {
        using AH = typename Ahead<SOLVE_DEPTH, P, Q>::T;
        const f32x4 n0 = ring[SLOT][0], n1 = ring[SLOT][1];
        asm volatile("" ::: "memory"); __builtin_amdgcn_sched_barrier(0);
        AH::load(ring, SLOT, nn);
        asm volatile("" ::: "memory"); __builtin_amdgcn_sched_barrier(0);
#pragma unroll
        for (int e = 0; e < 4; ++e)
            if (4 * Q + e < 2 * P) { a0 = __builtin_elementwise_fma((f32x2){n0[e], n0[e]}, x[4 * Q + e], a0); a1 = __builtin_elementwise_fma((f32x2){n1[e], n1[e]}, x[4 * Q + e], a1); }
        if constexpr (Q + 1 == NQ) {
            x[2 * P] = a0; asm volatile("" : "+v"(x[2 * P]));
            { constexpr int c = 2 * P, q = c / 4, e = c % 4; static_assert(q == Q, "column 2P lies in the pair's last quad"); a1 = __builtin_elementwise_fma((f32x2){n1[e], n1[e]}, x[c], a1); }
            x[2 * P + 1] = a1; asm volatile("" : "+v"(x[2 * P + 1]));
            if constexpr (P + 1 < 32) { a0 = x[2 * P + 2]; a1 = x[2 * P + 3]; SolveStep<P + 1, 0>::template run<(SLOT + 1) % SOLVE_DEPTH>(x, a0, a1, ring, nn); }
        } else {
            asm volatile("" : "+v"(a0), "+v"(a1));
            SolveStep<P, Q + 1>::template run<(SLOT + 1) % SOLVE_DEPTH>(x, a0, a1, ring, nn);
        }
    }
};

struct S1Args {
    const bf16* rw; const float* mu; const float* w0; const float* a0; const float* v0; const float* k_k; const float* k_a; const float* r_k;
    const bf16* w2t; const bf16* a2t; const bf16* g2t; const bf16* v2t;
    bf16* vfirst; bf16* BV; bf16* GB; bf16* PG; float* QT; bf16* RP; float* Y0; unsigned char* act; int layer; int pad_;
};
constexpr int ACT_LOGW = 0, ACT_AR = 262144, ACT_G = 524288, ACT_VG = 655360, ACT_WG_BYTES = 786432;
__device__ __forceinline__ float frcp(float x) { return __builtin_amdgcn_rcpf(x); }
__device__ __forceinline__ float fsigmoid(float x) { return frcp(1.0f + __expf(-x)); }
__device__ __forceinline__ float ftanh(float x) { const float e = __expf(-2.0f * fabsf(x)), t = (1.0f - e) * frcp(1.0f + e); return x < 0.f ? -t : t; }
__device__ __forceinline__ float ldbf(const bf16* p) { return bf2f(*p); }

__device__ __forceinline__ void stage1_latents(LAS unsigned char* lds, const S1Args& A, int t0) {
    const int tid = opq_tid();
#pragma unroll 1
    for (int bt = 0; bt < 5; ++bt) {
        float cur[8], prv[8], muv[8];
#pragma unroll
        for (int i = 0; i < 8; ++i) { const int idx = tid + 512 * (bt * 8 + i), tok = idx / 320, col = idx % 320, t = t0 + tok;
            const bf16* p = A.rw + (size_t)t * RWP + 3072 + col;
            cur[i] = ldbf(p); prv[i] = t > 0 ? ldbf(p - RWP + (col < 288 ? 0 : 32)) : 0.f; muv[i] = col < 288 ? A.mu[3072 + col] : 0.f; }
#pragma unroll
        for (int i = 0; i < 8; ++i) { const int idx = tid + 512 * (bt * 8 + i), tok = idx / 320, col = idx % 320;
            if (col < 288) { const float sft = cur[i] + muv[i] * (prv[i] - cur[i]);
                if (col < 64) *(LAS unsigned short*)(lds + O_LW + (tok * ST + col) * 2) = (unsigned short)f2bf(ftanh(sft));
                else if (col < 128) *(LAS unsigned short*)(lds + O_LA + (tok * ST + col - 64) * 2) = (unsigned short)f2bf(sft);
                else *(LAS unsigned short*)(lds + O_LG + (tok * SLG + col - 128) * 2) = (unsigned short)f2bf(fsigmoid(sft));
            } else *(LAS unsigned short*)(lds + O_VL + (tok * SVL + col - 288) * 2) = (unsigned short)f2bf(cur[i] + prv[i]); }
    }
}

struct LoraB { bf16x8 w[2], a[2], g[5], v; float w0c, a0c, v0c; };
__device__ __forceinline__ void lora_load(LoraB& B, const S1Args& A, int it, int wid, int lane) {
    const int rq = lane >> 4, l15 = lane & 15, ch = (it >> 1) * 64 + 16 * (2 * (wid & 1) + (it & 1)) + l15;
    const bf16* pw = A.w2t + (size_t)ch * 64 + 8 * rq; const bf16* pa = A.a2t + (size_t)ch * 64 + 8 * rq; const bf16* pg = A.g2t + (size_t)ch * 160 + 8 * rq; const bf16* pv = A.v2t + (size_t)ch * 32 + 8 * rq;
    B.w[0] = *(const bf16x8*)pw; B.w[1] = *(const bf16x8*)(pw + 32); B.a[0] = *(const bf16x8*)pa; B.a[1] = *(const bf16x8*)(pa + 32); B.v = *(const bf16x8*)pv;
#pragma unroll
    for (int ks = 0; ks < 5; ++ks) B.g[ks] = *(const bf16x8*)(pg + 32 * ks);
    B.w0c = A.w0[ch]; B.a0c = A.a0[ch]; B.v0c = A.v0[ch];
}
__device__ __forceinline__ void lora_tile(const LoraB& B, const S1Args& A, int it, int wid, int lane, const bf16x8 (&lw)[2], const bf16x8 (&la)[2], const bf16x8 (&lg)[5], const bf16x8& lv) {
    const int rq = lane >> 4, l15 = lane & 15, b0 = wid >> 1, h = it >> 1, jl = 16 * (2 * (wid & 1) + (it & 1)) + l15, ch = h * 64 + jl;
    const f32x4 z = {0.f, 0.f, 0.f, 0.f};
    const f32x4 zw = mfma16(lw[1], B.w[1], mfma16(lw[0], B.w[0], z)), za = mfma16(la[1], B.a[1], mfma16(la[0], B.a[0], z)), zv = mfma16(lv, B.v, z);
    f32x4 zg = z;
#pragma unroll
    for (int ks = 0; ks < 5; ++ks) zg = mfma16(lg[ks], B.g[ks], zg);
    const float w0c = B.w0c, a0c = B.a0c, v0c = B.v0c;
#pragma unroll
    for (int e = 0; e < 4; ++e) {
        const int o = (h * 64 + 16 * b0 + 4 * rq + e) * 64 + jl;
        const float zz = -(w0c + zw[e]), sp = fmaxf(zz, 0.f) + __logf(1.0f + __expf(-fabsf(zz))), wl = -sp - 0.5f;
        *(float*)(A.act + ACT_LOGW + o * 4) = -__expf(wl);
        *(float*)(A.act + ACT_AR + o * 4) = fsigmoid(a0c + za[e]);
        *(bf16*)(A.act + ACT_G + o * 2) = (bf16)f2bf(zg[e]);
        *(bf16*)(A.act + ACT_VG + o * 2) = (bf16)f2bf(fsigmoid(v0c + zv[e]));
    }
}
__device__ __forceinline__ void stage1_lora_all(LAS unsigned char* lds, const S1Args& A) {
    const int tid = opq_tid(), lane = tid & 63, wid = __builtin_amdgcn_readfirstlane(tid >> 6), b0 = wid >> 1;
    bf16x8 lw[2], la[2], lg[5], lv;
    lw[0] = frag(lds + O_LW, 16 * b0, 0, lane); lw[1] = frag(lds + O_LW, 16 * b0, 1, lane); la[0] = frag(lds + O_LA, 16 * b0, 0, lane); la[1] = frag(lds + O_LA, 16 * b0, 1, lane); lv = frag(lds + O_VL, 16 * b0, 0, lane, SVL);
#pragma unroll
    for (int ks = 0; ks < 5; ++ks) lg[ks] = frag(lds + O_LG, 16 * b0, ks, lane, SLG);
    LoraB B0, B1;
    lora_load(B0, A, 0, wid, lane);
#pragma unroll 1
    for (int it = 0; it < 32; it += 2) {
        lora_load(B1, A, it + 1, wid, lane);
        lora_tile(B0, A, it, wid, lane, lw, la, lg, lv);
        if (it + 2 < 32) lora_load(B0, A, it + 2, wid, lane);
        lora_tile(B1, A, it + 1, wid, lane, lw, la, lg, lv);
    }
}
struct PreF { unsigned short r[9], k[9], v[9], vf[8], g[8], vg[8]; float lw[8], ar[8], mur, muk, muv, kkw, kaw, rkw; };
__device__ __forceinline__ void pref_load(PreF& P, const S1Args& A, int c, int h, int wid, int lane) {
    const int ch = h * 64 + lane, tf = c * 64 + 8 * wid;
    P.mur = A.mu[ch]; P.muk = A.mu[1024 + ch]; P.muv = A.mu[2048 + ch]; P.kkw = A.k_k[ch]; P.kaw = A.k_a[ch]; P.rkw = A.r_k[ch];
    const bf16* rp = A.rw + (size_t)tf * RWP + ch;
    if (tf > 0) { P.r[0] = rp[-RWP]; P.k[0] = rp[-RWP + 1024]; P.v[0] = rp[-RWP + 2048]; } else { P.r[0] = 0; P.k[0] = 0; P.v[0] = 0; }
#pragma unroll
    for (int e = 0; e < 8; ++e) { P.r[e + 1] = rp[(size_t)e * RWP]; P.k[e + 1] = rp[(size_t)e * RWP + 1024]; P.v[e + 1] = rp[(size_t)e * RWP + 2048];
        const int o = (h * 64 + 8 * wid + e) * 64 + lane;
        P.lw[e] = *(const float*)(A.act + ACT_LOGW + o * 4); P.ar[e] = *(const float*)(A.act + ACT_AR + o * 4); P.g[e] = *(const bf16*)(A.act + ACT_G + o * 2); P.vg[e] = *(const bf16*)(A.act + ACT_VG + o * 2);
        P.vf[e] = A.layer > 0 ? A.vfirst[(size_t)(tf + e) * 1024 + ch] : (unsigned short)0; }
}

__device__ __forceinline__ void stage1_unit(LAS unsigned char* lds, const S1Args& A, int c, int h, PreF& P) {
    const int tid = opq_tid(), lane = tid & 63, wid = __builtin_amdgcn_readfirstlane(tid >> 6), rq = lane >> 4, l15 = lane & 15;
    const int t0 = c * 64, uc = h * 256 + c;
    const int b0 = wid >> 1;
    LAS float* SEG = (LAS float*)(lds + O_SEG); LAS float* GL = (LAS float*)(lds + O_GL);
    {
        const int j = lane, ch = h * 64 + j; float lw[8], cum[8], va[8], vb[8], vk[8], vr_[8], vv[8];
        const float mur = P.mur, muk = P.muk, muv = P.muv, kkw = P.kkw, kaw = P.kaw, rkw = P.rkw;
        const int tf = t0 + 8 * wid;
#pragma unroll
        for (int e = 0; e < 8; ++e) {
            const float cr = bf2f(P.r[e + 1]), ck = bf2f(P.k[e + 1]), cv = bf2f(P.v[e + 1]), pr = bf2f(P.r[e]), pk_ = bf2f(P.k[e]), pv = bf2f(P.v[e]);
            const float r = cr + mur * (pr - cr), kr = ck + muk * (pk_ - ck), vr = cv + muv * (pv - cv);
            lw[e] = P.lw[e];
            const float ar = P.ar[e], g = bf2f(P.g[e]), vg = bf2f(P.vg[e]);
            const float kkv = kr * kkw, ss = wave_sum(kkv * kkv), kk = kkv * __builtin_amdgcn_rsqf(fmaxf(ss, 1e-24f));
            va[e] = -kk; vb[e] = kk * ar; vk[e] = kr * (1.0f + (ar - 1.0f) * kaw); vr_[e] = r;
            const size_t go = (size_t)(tf + e) * 1024 + ch;
            float v;
            if (A.layer == 0) { v = vr; A.vfirst[go] = (bf16)f2bf(vr); } else { v = vr + (bf2f(P.vf[e]) - vr) * vg; }
            vv[e] = v;
            const float bonus = wave_sum(r * vk[e] * rkw);
            A.BV[go] = (bf16)f2bf(bonus * v); A.GB[go] = (bf16)f2bf(g);
        }
        cum[0] = lw[0];
#pragma unroll
        for (int e = 1; e < 8; ++e) cum[e] = cum[e - 1] + lw[e];
        SEG[wid * 64 + j] = cum[7];
        RK_BAR();
        float off = 0.f, tot = 0.f;
#pragma unroll
        for (int s = 0; s < 8; ++s) { const float v = SEG[s * 64 + j]; off += (s < wid) ? v : 0.f; tot += v; }
        if (wid == 0) GL[j] = __expf(tot);
        float gprev = __expf(off);
#pragma unroll
        for (int e = 0; e < 8; ++e) {
            const float cm = cum[e] + off, g = __expf(cm), gi = frcp(g), gp = gprev; gprev = g;
            const int o = ((8 * wid + e) * ST + j) * 2;
            *(LAS unsigned short*)(lds + O_AT + o) = (unsigned short)f2bf(va[e] * gp);
            *(LAS unsigned short*)(lds + O_BT + o) = (unsigned short)f2bf(vb[e] * gi);
            *(LAS unsigned short*)(lds + O_KT + o) = (unsigned short)f2bf(vk[e] * gi);
            *(LAS unsigned short*)(lds + O_RT + o) = (unsigned short)f2bf(vr_[e] * g);
            *(LAS unsigned short*)(lds + O_VV + o) = (unsigned short)f2bf(vv[e]);
        }
        RK_BAR();
    }
    {
        const bf16x8 bA0 = frag(lds + O_BT, 16 * b0, 0, lane), bA1 = frag(lds + O_BT, 16 * b0, 1, lane), kA0 = frag(lds + O_KT, 16 * b0, 0, lane), kA1 = frag(lds + O_KT, 16 * b0, 1, lane);
#pragma unroll
        for (int tt = 0; tt < 2; ++tt) {
            const int tb = 2 * (wid & 1) + tt;
            const bf16x8 aB0 = frag(lds + O_AT, 16 * tb, 0, lane), aB1 = frag(lds + O_AT, 16 * tb, 1, lane), rB0 = frag(lds + O_RT, 16 * tb, 0, lane), rB1 = frag(lds + O_RT, 16 * tb, 1, lane);
            const f32x4 z = {0.f, 0.f, 0.f, 0.f};
            f32x4 ab = mfma16(bA1, aB1, mfma16(bA0, aB0, z)), ak = mfma16(kA1, aB1, mfma16(kA0, aB0, z)), rb = mfma16(bA1, rB1, mfma16(bA0, rB0, z)), rk_ = mfma16(kA1, rB1, mfma16(kA0, rB0, z));
            const int tcol = 16 * tb + l15, srow = 16 * b0 + 4 * rq;
#pragma unroll
            for (int e = 0; e < 4; ++e) { const bool st = tcol > srow + e, le = tcol >= srow + e; ab[e] = st ? ab[e] : 0.f; ak[e] = st ? ak[e] : 0.f; rb[e] = le ? rb[e] : 0.f; rk_[e] = le ? rk_[e] : 0.f; }
            *(LAS f32x4*)(lds + O_NN + (tcol * NST + srow) * 4) = ab;
            const int o = (tcol * ST + srow) * 2;
            *(LAS u32x2*)(lds + O_AAK + o) = (u32x2){pk(ak[0], ak[1]), pk(ak[2], ak[3])};
            *(LAS u32x2*)(lds + O_ARB + o) = (u32x2){pk(rb[0], rb[1]), pk(rb[2], rb[3])};
            *(LAS u32x2*)(lds + O_ARK + o) = (u32x2){pk(rk_[0], rk_[1]), pk(rk_[2], rk_[3])};
        }
        RK_BAR();
    }
    {
        const bf16x8 vA0 = tfrag(lds + O_VV, 16 * b0, 0, lane), vA1 = tfrag(lds + O_VV, 16 * b0, 1, lane);
#pragma unroll
        for (int tt = 0; tt < 2; ++tt) {
            const int tb = 2 * (wid & 1) + tt;
            const f32x4 z = {0.f, 0.f, 0.f, 0.f};
            const f32x4 g = mfma16(vA1, frag(lds + O_AAK, 16 * tb, 1, lane), mfma16(vA0, frag(lds + O_AAK, 16 * tb, 0, lane), z));
            *(LAS f32x4*)(lds + O_GG + ((16 * tb + l15) * NST + 16 * b0 + 4 * rq) * 4) = g;
        }
        RK_BAR();
    }
    if (wid == 0) {
        f32x2 x[64];
#pragma unroll
        for (int t = 0; t < 64; ++t) x[t] = (f32x2){bf2f(*(const LAS unsigned short*)(lds + O_AT + (t * ST + lane) * 2)), *(const LAS float*)(lds + O_GG + (t * NST + lane) * 4)};
        LAS unsigned char* nn = lds + O_NN; asm volatile("" : "+v"(nn));
        f32x4 ring[SOLVE_DEPTH][2];
        SolveStep<0, 0>::load(ring, 0, nn); SolveStep<1, 0>::load(ring, 1, nn); SolveStep<2, 0>::load(ring, 2, nn);
        { f32x2 a0 = x[0], a1 = x[1]; SolveStep<0, 0>::run<0>(x, a0, a1, ring, nn); }
        LAS unsigned char* dw = lds + O_WT + lane * ST * 2; LAS unsigned char* du = lds + O_U0T + lane * ST * 2;
#pragma unroll
        for (int i = 0; i < 8; ++i) {
            *(LAS u32x4*)(dw + i * 16) = (u32x4){pk(x[8 * i].x, x[8 * i + 1].x), pk(x[8 * i + 2].x, x[8 * i + 3].x), pk(x[8 * i + 4].x, x[8 * i + 5].x), pk(x[8 * i + 6].x, x[8 * i + 7].x)};
            *(LAS u32x4*)(du + i * 16) = (u32x4){pk(x[8 * i].y, x[8 * i + 1].y), pk(x[8 * i + 2].y, x[8 * i + 3].y), pk(x[8 * i + 4].y, x[8 * i + 5].y), pk(x[8 * i + 6].y, x[8 * i + 7].y)}; }
    }
    if (h + 1 < 16) { const int tid2 = opq_tid(); pref_load(P, A, c, h + 1, __builtin_amdgcn_readfirstlane(tid2 >> 6), tid2 & 63); }
    RK_BAR();
    {
        const int tid = opq_tid(), lane = tid & 63, wid = __builtin_amdgcn_readfirstlane(tid >> 6), rq = lane >> 4, l15 = lane & 15, b0 = wid >> 1;
        const bf16x8 wA0 = frag(lds + O_WT, 16 * b0, 0, lane), wA1 = frag(lds + O_WT, 16 * b0, 1, lane);
        const bf16x8 uA0 = frag(lds + O_U0T, 16 * b0, 0, lane), uA1 = frag(lds + O_U0T, 16 * b0, 1, lane);
        const bf16x8 vA0 = tfrag(lds + O_VV, 16 * b0, 0, lane), vA1 = tfrag(lds + O_VV, 16 * b0, 1, lane);
        const bf16x8 bA0 = tfrag(lds + O_BT, 16 * b0, 0, lane), bA1 = tfrag(lds + O_BT, 16 * b0, 1, lane);
        const bf16x8 kA0 = tfrag(lds + O_KT, 16 * b0, 0, lane), kA1 = tfrag(lds + O_KT, 16 * b0, 1, lane);
        const f32x4 glr = *(const LAS f32x4*)(lds + O_GL + (16 * b0 + 4 * rq) * 4);
#pragma unroll
        for (int tt = 0; tt < 2; ++tt) {
            const int nb = 2 * (wid & 1) + tt, col = 16 * nb + l15, row = 16 * b0 + 4 * rq;
            const f32x4 z = {0.f, 0.f, 0.f, 0.f};
            const bf16x8 rbB0 = frag(lds + O_ARB, 16 * nb, 0, lane), rbB1 = frag(lds + O_ARB, 16 * nb, 1, lane), rkB0 = frag(lds + O_ARK, 16 * nb, 0, lane), rkB1 = frag(lds + O_ARK, 16 * nb, 1, lane);
            { f32x4 d = mfma16(wA1, rbB1, mfma16(wA0, rbB0, z)); const u32x2 rt = *(const LAS u32x2*)(lds + O_RT + (col * ST + row) * 2);
              d[0] += bflo(rt.x); d[1] += bfhi(rt.x); d[2] += bflo(rt.y); d[3] += bfhi(rt.y);
              *(u32x2*)(A.RP + (size_t)(t0 + col) * 1024 + h * 64 + row) = (u32x2){pk(d[0], d[1]), pk(d[2], d[3])}; }
            { const f32x4 d = mfma16(vA1, rkB1, mfma16(vA0, rkB0, mfma16(uA1, rbB1, mfma16(uA0, rbB0, z))));
              *(f32x4*)(A.Y0 + (size_t)(t0 + col) * 1024 + h * 64 + row) = d; }
            { const bf16x8 bB0 = tfrag(lds + O_BT, 16 * nb, 0, lane), bB1 = tfrag(lds + O_BT, 16 * nb, 1, lane);
              f32x4 d = mfma16(wA1, bB1, mfma16(wA0, bB0, z)); const float gj = GL[col];
#pragma unroll
              for (int e = 0; e < 4; ++e) d[e] = gj * (d[e] + ((row + e) == col ? 1.f : 0.f));
              *(u32x2*)(A.PG + (size_t)uc * 4096 + ((((col >> 4) * 2 + (row >> 5)) * 64 + ((row >> 2) & 3) * 16 + (col & 15)) * 8 + ((row >> 4) & 1) * 4)) = (u32x2){pk(d[0], d[1]), pk(d[2], d[3])}; }
            { const bf16x8 uB0 = frag(lds + O_U0T, 16 * nb, 0, lane), uB1 = frag(lds + O_U0T, 16 * nb, 1, lane), vB0 = tfrag(lds + O_VV, 16 * nb, 0, lane), vB1 = tfrag(lds + O_VV, 16 * nb, 1, lane);
              f32x4 d = mfma16(kA1, vB1, mfma16(kA0, vB0, mfma16(bA1, uB1, mfma16(bA0, uB0, z))));
              d = d * glr;
              *(f32x4*)(A.QT + (size_t)uc * 4096 + ((((col >> 4) * 4 + (row >> 4)) * 64 + ((row >> 2) & 3) * 16 + (col & 15)) * 4)) = d; }
        }
    }
    RK_BAR();
}
__device__ __forceinline__ void ph_stage1(LAS unsigned char* lds, const S1Args& A, int blk, int nblk) {
    for (int c = blk; c < 256; c += nblk) {
        stage1_latents(lds, A, c * 64);
        RK_BAR();
        stage1_lora_all(lds, A);
        asm volatile("s_waitcnt vmcnt(0)" ::: "memory");
        RK_BAR();
        PreF P; { const int tid = opq_tid(); pref_load(P, A, c, 0, __builtin_amdgcn_readfirstlane(tid >> 6), tid & 63); }
#pragma unroll 1
        for (int h = 0; h < 16; ++h) stage1_unit(lds, A, c, h, P);
    }
}

struct ChainOps { bf16x8 a[4][2]; f32x4 c[4]; };
__device__ __forceinline__ void chain_load(ChainOps& o, const bf16* __restrict__ PG, const float* __restrict__ QT, int h, int ig, int c, int lane) {
    const bf16* P = PG + (size_t)(h * 256 + c) * 4096 + lane * 8; const float* Q = QT + (size_t)(h * 256 + c) * 4096 + (ig * 4 * 64 + lane) * 4;
#pragma unroll
    for (int m = 0; m < 4; ++m) { o.c[m] = *(const f32x4*)(Q + m * 256);
#pragma unroll
        for (int kb = 0; kb < 2; ++kb) o.a[m][kb] = *(const bf16x8*)(P + (m * 2 + kb) * 512); }
}
__device__ __forceinline__ void chain_step(f32x4 (&H)[4], const ChainOps& o, bf16* __restrict__ H0T, int h, int ig, int c, int lane) {
    const int fr = lane & 15, fq = lane >> 4;
    bf16* Ho = H0T + (size_t)(c * 16 + h) * 4096 + (16 * ig + fr) * 64 + 4 * fq;
    u32x4 bw[2];
#pragma unroll
    for (int m = 0; m < 4; ++m) { const u32x2 w = {pk(H[m][0], H[m][1]), pk(H[m][2], H[m][3])}; *(u32x2*)(Ho + 16 * m) = w; bw[m >> 1][2 * (m & 1)] = w.x; bw[m >> 1][2 * (m & 1) + 1] = w.y; }
#pragma unroll
    for (int m = 0; m < 4; ++m) H[m] = mfma16(o.a[m][1], __builtin_bit_cast(bf16x8, bw[1]), mfma16(o.a[m][0], __builtin_bit_cast(bf16x8, bw[0]), o.c[m]));
}
__device__ __forceinline__ void chain_wave(const bf16* __restrict__ PG, const float* __restrict__ QT, bf16* __restrict__ H0T, int h, int ig, int lane) {
    f32x4 H[4];
#pragma unroll
    for (int m = 0; m < 4; ++m) H[m] = (f32x4){0.f, 0.f, 0.f, 0.f};
    ChainOps s0, s1, s2, s3;
    chain_load(s0, PG, QT, h, ig, 0, lane); chain_load(s1, PG, QT, h, ig, 1, lane); chain_load(s2, PG, QT, h, ig, 2, lane); chain_load(s3, PG, QT, h, ig, 3, lane);
#pragma unroll 1
    for (int c = 0; c < 256; c += 4) {
        const bool more = c + 4 < 256;
        chain_step(H, s0, H0T, h, ig, c, lane);     if (more) chain_load(s0, PG, QT, h, ig, c + 4, lane);
        chain_step(H, s1, H0T, h, ig, c + 1, lane); if (more) chain_load(s1, PG, QT, h, ig, c + 5, lane);
        chain_step(H, s2, H0T, h, ig, c + 2, lane); if (more) chain_load(s2, PG, QT, h, ig, c + 6, lane);
        chain_step(H, s3, H0T, h, ig, c + 3, lane); if (more) chain_load(s3, PG, QT, h, ig, c + 7, lane);
    }
}
__device__ __forceinline__ void ph_chain(const bf16* PG, const float* QT, bf16* H0T, int blk, int nblk) {
    const int tid = opq_tid(), lane = tid & 63;
    for (int gw = blk * 8 + (tid >> 6); gw < 64; gw += nblk * 8) chain_wave(PG, QT, H0T, gw >> 2, gw & 3, lane);
}

struct S3Args { const bf16* H0T; const bf16* RP; const float* Y0; const bf16* BV; const bf16* GB; const float* ln_w; const float* ln_b; bf16* mixed; };
__device__ __forceinline__ void ph_stage3(const S3Args& A, int blk, int nblk) {
    const int tid = opq_tid(), lane = tid & 63, fr = lane & 15, fq = lane >> 4;
    for (int it = blk * 8 + (tid >> 6); it < 4096 * 4; it += nblk * 8) {
        const int u = it >> 2, tb = it & 3, c = u >> 4, h = u & 15, t = 64 * c + 16 * tb + fr;
        const bf16* Hp = A.H0T + (size_t)u * 4096 + fr * 64 + 8 * fq; const bf16* Rp = A.RP + (size_t)t * 1024 + h * 64 + 8 * fq;
        const bf16x8 r0 = *(const bf16x8*)Rp, r1 = *(const bf16x8*)(Rp + 32);
        f32x4 y[4];
#pragma unroll
        for (int ib = 0; ib < 4; ++ib) { const f32x4 y0 = *(const f32x4*)(A.Y0 + (size_t)t * 1024 + h * 64 + 16 * ib + 4 * fq);
            y[ib] = mfma16(*(const bf16x8*)(Hp + ib * 1024 + 32), r1, mfma16(*(const bf16x8*)(Hp + ib * 1024), r0, y0)); }
        float s = 0.f;
#pragma unroll
        for (int ib = 0; ib < 4; ++ib) s += (y[ib][0] + y[ib][1]) + (y[ib][2] + y[ib][3]);
        s += __shfl_xor(s, 16); s += __shfl_xor(s, 32);
        const float mean = s * (1.0f / 64.0f); float q = 0.f;
#pragma unroll
        for (int ib = 0; ib < 4; ++ib)
#pragma unroll
            for (int e = 0; e < 4; ++e) { const float d = y[ib][e] - mean; y[ib][e] = d; q += d * d; }
        q += __shfl_xor(q, 16); q += __shfl_xor(q, 32);
        const float rstd = 1.0f / sqrtf(q * (1.0f / 64.0f) + GN_EPS);
#pragma unroll
        for (int ib = 0; ib < 4; ++ib) { const int ch = h * 64 + 16 * ib + 4 * fq; const size_t o = (size_t)t * 1024 + ch;
            const f32x4 lw = *(const f32x4*)(A.ln_w + ch), lb = *(const f32x4*)(A.ln_b + ch); const u32x2 bv = *(const u32x2*)(A.BV + o), gg = *(const u32x2*)(A.GB + o); f32x4 r;
            const float bvf[4] = {bflo(bv.x), bfhi(bv.x), bflo(bv.y), bfhi(bv.y)}, ggf[4] = {bflo(gg.x), bfhi(gg.x), bflo(gg.y), bfhi(gg.y)};
#pragma unroll
            for (int e = 0; e < 4; ++e) r[e] = (y[ib][e] * rstd * lw[e] + lb[e] + bvf[e]) * ggf[e];
            *(u32x2*)(A.mixed + (size_t)t * DM + 1024 + ch) = (u32x2){pk(r[0], r[1]), pk(r[2], r[3])}; }
    }
}
}
#define XB_TMO      128
#define XB_XCNT(j)  (256  + 64 * (j))
#define XB_XSUB(j)  (1280 + 64 * (j))
#define XB_XGEN(j)  (2304 + 64 * (j))
#define XB_TOP      3328
#define XB_TOPGEN   3392
#define XCD_BAR_WORDS 3456
#define XB_SPIN_CAP (1u << 22)

__device__ __forceinline__ unsigned xb_ld(unsigned* p)              { return __hip_atomic_load(p, __ATOMIC_RELAXED, __HIP_MEMORY_SCOPE_AGENT); }
__device__ __forceinline__ unsigned xb_add(unsigned* p, unsigned v) { return __hip_atomic_fetch_add(p, v, __ATOMIC_RELAXED, __HIP_MEMORY_SCOPE_AGENT); }
__device__ __forceinline__ unsigned xb_xcc_id() { return (unsigned)__builtin_amdgcn_s_getreg((3 << 11) | 20) & 0xFu; }
#define XB_SPIN(cond, bar) do { unsigned _sp = 0; while (cond) { __builtin_amdgcn_s_sleep(1); \
    if ((++_sp & 255u) == 0u) { if (xb_ld(&(bar)[XB_TMO])) break; if (_sp > XB_SPIN_CAP) { atomicAdd(&(bar)[XB_TMO], 1u); break; } } } } while (0)

struct XcdBarrier {
    unsigned* bar; unsigned x;
    volatile LAS unsigned* st;
};

__device__ __forceinline__ XcdBarrier xcd_barrier_post(unsigned* bar, volatile LAS unsigned* st) {
    XcdBarrier b; b.bar = bar; b.x = xb_xcc_id(); b.st = st;
    if (threadIdx.x == 0) (void)xb_add(&bar[XB_XCNT(b.x)], 1u);
    return b;
}
__device__ __forceinline__ void xcd_barrier_complete(unsigned* bar, unsigned x, unsigned& nloc, unsigned& nx) {
    const unsigned G = gridDim.x * gridDim.y * gridDim.z;
    unsigned sum, cnt, mine, sp = 0u;
    for (;;) {
        sum = 0u; cnt = 0u; mine = 0u;
#pragma unroll
        for (unsigned j = 0; j < 16; ++j) { const unsigned c = xb_ld(&bar[XB_XCNT(j)]); sum += c; cnt += (c > 0u) ? 1u : 0u; mine = (j == x) ? c : mine; }
        if (sum == G) break;
        __builtin_amdgcn_s_sleep(1);
        if ((++sp & 255u) == 0u) { if (xb_ld(&bar[XB_TMO])) break; if (sp > XB_SPIN_CAP) { atomicAdd(&bar[XB_TMO], 1u); break; } }
    }
    nloc = mine > 0u ? mine : 1u; nx = cnt > 0u ? cnt : 1u;
}

__device__ __forceinline__ void xcd_barrier(const XcdBarrier& b) {
    asm volatile("s_waitcnt vmcnt(0)" ::: "memory");
    __syncthreads();
    if (threadIdx.x == 0) {
        unsigned* bar = b.bar;
        __builtin_amdgcn_s_waitcnt(0);
        unsigned nloc = b.st[0], nx = b.st[1];
        if (nloc == 0u) { xcd_barrier_complete(bar, b.x, nloc, nx); b.st[0] = nloc; b.st[1] = nx; }
        const unsigned old = xb_add(&bar[XB_XSUB(b.x)], 1u);
        const unsigned gen = old / nloc;
        if (old + 1u == (gen + 1u) * nloc) {
            __builtin_amdgcn_fence(__ATOMIC_RELEASE, "agent");
            asm volatile("s_waitcnt vmcnt(0)" ::: "memory");
            const unsigned og = xb_add(&bar[XB_TOP], 1u);
            const unsigned tg = og / nx;
            if (og + 1u == (tg + 1u) * nx) xb_add(&bar[XB_TOPGEN], 1u);
            else XB_SPIN(xb_ld(&bar[XB_TOPGEN]) == tg, bar);
            __builtin_amdgcn_fence(__ATOMIC_ACQUIRE, "agent");
            xb_add(&bar[XB_XGEN(b.x)], 1u);
            asm volatile("s_waitcnt vmcnt(0)" ::: "memory");
        } else {
            XB_SPIN(xb_ld(&bar[XB_XGEN(b.x)]) == gen, bar);
            __builtin_amdgcn_fence(__ATOMIC_ACQUIRE, "agent");
            asm volatile("s_waitcnt vmcnt(0)" ::: "memory");
        }
    }
    __syncthreads();
}

constexpr size_t MiB = 1u << 20;
constexpr size_t WS_CTL = 0, CTL_ZERO_BYTES = 64 * 1024, WS_SSQA = 1016 * MiB, WS_SSQB = 1018 * MiB,      WS_WIN = 2 * MiB, WS_WOUT = 28 * MiB, WS_WUP = 36 * MiB, WS_WDOWN = 68 * MiB, WS_LORA = 100 * MiB, WS_XB = 102 * MiB,
                 WS_Q = 166 * MiB, WS_K = 198 * MiB, WS_V = 230 * MiB, WS_RW = 262 * MiB, WS_MIXED = 374 * MiB, WS_U = 166 * MiB, WS_VFIRST = 438 * MiB, WS_PG = 470 * MiB, WS_QT = 502 * MiB, WS_RP = 566 * MiB,
                 WS_Y0 = 598 * MiB, WS_H0T = 662 * MiB, WS_BV = 694 * MiB, WS_GB = 726 * MiB, WS_STASH = 758 * MiB, WS_PART = 790 * MiB, WS_END = 1020 * MiB;
constexpr size_t LORA_W2 = 0, LORA_A2 = 1024 * 64 * 2, LORA_G2 = 2 * 1024 * 64 * 2, LORA_V2 = LORA_G2 + 1024 * 160 * 2;
constexpr int CW_BAR = 1024, CW_ATTQ = 512;
constexpr int RING_BYTES = 131072, MISC_OFF = 156000, LDS_BYTES = 156672;

struct Args { const float* in[26]; float* out; unsigned char* ws; int ph_lo, ph_hi; float lam_init[4]; };

struct ConvItem { const float* src; bf16* dst; const float* g; int K, N, k0, c0; bool permin, skipx; };
__device__ __forceinline__ void conv_item(ConvItem& I, const __attribute__((address_space(4))) Args* a, unsigned char* ws, int l, int it) {
    constexpr int I_IN = (DM / 64) * (NIN / 64), I_OUT = (DM / 64) * (DM / 64), I_UP = (DM / 64) * (DFF / 64);
    int r = it, nkbs;
    if (r < I_IN) { I.src = a->in[3] + (size_t)l * DM * PW; I.dst = (bf16*)(ws + WS_WIN); I.g = a->in[1] + (size_t)l * DM; I.K = DM; I.N = PW; nkbs = 5; I.permin = true; I.skipx = l > 0; }
    else if ((r -= I_IN) < I_OUT) { I.src = a->in[4] + (size_t)l * DM * DM; I.dst = (bf16*)(ws + WS_WOUT); I.g = nullptr; I.K = DM; I.N = DM; nkbs = 5; I.permin = false; I.skipx = false; }
    else if ((r -= I_OUT) < I_UP) { I.src = a->in[24] + (size_t)l * DM * DFF; I.dst = (bf16*)(ws + WS_WUP); I.g = a->in[2] + (size_t)l * DM; I.K = DM; I.N = DFF; nkbs = 5; I.permin = false; I.skipx = false; }
    else { r -= I_UP; I.src = a->in[25] + (size_t)l * DFF * DM; I.dst = (bf16*)(ws + WS_WDOWN); I.g = nullptr; I.K = DFF; I.N = DM; nkbs = 7; I.permin = false; I.skipx = false; }
    I.k0 = (r & ((1 << nkbs) - 1)) * 64; I.c0 = (r >> nkbs) * 64;
}
__device__ __forceinline__ void conv_load(const ConvItem& I, float (&v)[8], int tid) {
#pragma unroll
    for (int i = 0; i < 8; ++i) { const int idx = tid + 512 * i, kk = idx >> 6, cc = idx & 63, cp = I.c0 + cc; int col = cp;
        if (I.permin) { const int lo = cp & 255, bj = lo >> 7, wc = (lo >> 5) & 3, j = lo & 31; col = (cp & ~255) + 64 * wc + 32 * bj + j; }
        float x = 0.f; if (col < I.N) { x = I.src[(size_t)(I.k0 + kk) * I.N + col]; if (I.g) x *= I.g[I.k0 + kk]; }
        v[i] = x; }
}
__device__ __forceinline__ void ph_convw(LAS unsigned char* lds, const __attribute__((address_space(4))) Args* a, int l, int blk, int nblk) {
    LAS float* tile = (LAS float*)lds; unsigned char* ws = a->ws; const int tid = opq_tid();
    constexpr int NITEM = (DM / 64) * (NIN / 64) + (DM / 64) * (DM / 64) + (DM / 64) * (DFF / 64) + (DFF / 64) * (DM / 64);
    ConvItem I0, I1, I2; float v0[8], v1[8], v2[8];
    int it = blk;
    if (it < NITEM) { conv_item(I0, a, ws, l, it); conv_load(I0, v0, tid); }
    if (it + nblk < NITEM) { conv_item(I1, a, ws, l, it + nblk); conv_load(I1, v1, tid); }
    int par = 0;
#define CONV_STEP(IC, VC, IN_, VN_) do { \
        LAS float* tl = tile + par * (64 * 65); par ^= 1; \
        _Pragma("unroll") for (int i = 0; i < 8; ++i) { const int idx = tid + 512 * i; tl[(idx >> 6) * 65 + (idx & 63)] = VC[i]; } \
        if (it + 2 * nblk < NITEM) { conv_item(IN_, a, ws, l, it + 2 * nblk); conv_load(IN_, VN_, tid); } \
        __syncthreads(); \
        { const int cc = tid >> 3, k8 = (tid & 7) * 8, cp = IC.c0 + cc; \
          if (!(IC.permin && IC.skipx && ((cp >= 6432 && cp < 6464) || (cp >= 6528 && cp < 6560)))) {        \
              u32x4 w; \
              _Pragma("unroll") for (int e = 0; e < 4; ++e) w[e] = f2bf(tl[(k8 + 2 * e) * 65 + cc]) | (f2bf(tl[(k8 + 2 * e + 1) * 65 + cc]) << 16); \
              *(u32x4*)(IC.dst + (size_t)cp * IC.K + IC.k0 + k8) = w; } } \
        it += nblk; } while (0)
    while (it < NITEM) {
        CONV_STEP(I0, v0, I2, v2); if (it >= NITEM) break;
        CONV_STEP(I1, v1, I0, v0); if (it >= NITEM) break;
        CONV_STEP(I2, v2, I1, v1);
    }
#undef CONV_STEP
    __syncthreads();
    { const int tid = opq_tid(); const int lm = l > 0 ? l - 1 : 0;
      const float* w2 = a->in[12] + (size_t)l * 64 * 1024; const float* a2 = a->in[14] + (size_t)l * 64 * 1024; const float* g2 = a->in[15] + (size_t)l * 160 * 1024; const float* v2 = a->in[23] + (size_t)lm * 32 * 1024;
      bf16* lw = (bf16*)(ws + WS_LORA);
      for (int i = blk * 512 + tid; i < 1024 * 320; i += nblk * 512) {
          const int ch = i / 320, k = i % 320;
          if (k < 64) lw[LORA_W2 / 2 + ch * 64 + k] = (bf16)f2bf(w2[(size_t)k * 1024 + ch]);
          else if (k < 128) lw[LORA_A2 / 2 + ch * 64 + k - 64] = (bf16)f2bf(a2[(size_t)(k - 64) * 1024 + ch]);
          else if (k < 288) lw[LORA_G2 / 2 + ch * 160 + k - 128] = (bf16)f2bf(g2[(size_t)(k - 128) * 1024 + ch]);
          else lw[LORA_V2 / 2 + ch * 32 + k - 288] = (bf16)f2bf(v2[(size_t)(k - 288) * 1024 + ch]);
      } }
    if (l > 0) {
        const int tid = opq_tid(), sl = tid >> 6, o = tid & 63;
        const float* win = a->in[3] + (size_t)l * DM * PW; const float* g1 = a->in[1] + (size_t)l * DM; const float* muv = a->in[10] + (size_t)l * 3360 + 2048; const float* v1 = a->in[22] + (size_t)(l - 1) * 1024 * 32;
        bf16* wt = (bf16*)(ws + WS_WIN);
        LAS float* wrow = (LAS float*)lds;
        LAS float* part = wrow + 8 * 1024;
        for (int k0 = blk * 8; k0 < DM; k0 += nblk * 8) {
            for (int i = tid; i < 8 * 1024; i += 512) wrow[i] = win[(size_t)(k0 + (i >> 10)) * PW + 5120 + (i & 1023)];
            __syncthreads();
            float acc[8];
#pragma unroll
            for (int r = 0; r < 8; ++r) acc[r] = 0.f;
#pragma unroll 8
            for (int ci = 0; ci < 128; ++ci) { const int c = sl * 128 + ci; const float m = muv[c], f = ((o < 32) ? 1.0f - m : m) * v1[c * 32 + (o & 31)];
#pragma unroll
                for (int r = 0; r < 8; ++r) acc[r] = __builtin_fmaf(wrow[r * 1024 + c], f, acc[r]); }
#pragma unroll
            for (int r = 0; r < 8; ++r) part[(sl * 8 + r) * 64 + o] = acc[r];
            __syncthreads();
            { const int r = sl; float s = 0.f;
#pragma unroll
              for (int q = 0; q < 8; ++q) s += part[(q * 8 + r) * 64 + o];
              const int row = (o < 32) ? 6528 + o : 6400 + o;
              wt[(size_t)row * DM + k0 + r] = (bf16)f2bf(s * g1[k0 + r]); }
            __syncthreads();
        }
    }
}
__device__ __forceinline__ void ph_copy_x(const float* __restrict__ src, float* __restrict__ copy, bf16* __restrict__ xb, float* __restrict__ ssq, int blk, int nblk) {
    const int tid_ = opq_tid(), lane = tid_ & 63, gw = blk * 8 + (tid_ >> 6), ngw = nblk * 8;
    for (int row = gw; row < T_; row += ngw) {
        const f32x4* s = (const f32x4*)(src + (size_t)row * DM);
        float ss = 0.f;
#pragma unroll
        for (int j = 0; j < 8; ++j) { const f32x4 v = s[lane + 64 * j]; ss += (v[0] * v[0] + v[1] * v[1]) + (v[2] * v[2] + v[3] * v[3]);
            ((f32x4*)(copy + (size_t)row * DM))[lane + 64 * j] = v;
            u32x2 w; w.x = f2bf(v[0]) | (f2bf(v[1]) << 16); w.y = f2bf(v[2]) | (f2bf(v[3]) << 16);
            ((u32x2*)(xb + (size_t)row * DM))[lane + 64 * j] = w; }
        ss = wave_sum(ss);
        if (lane < 32) ssq[(size_t)row * 32 + lane] = lane == 0 ? ss : 0.f;
    }
}
__device__ __forceinline__ void ph_zero(float* p, int n, int blk, int nblk) { const int tid = opq_tid();
#pragma unroll
    for (int r = 0; r < 4; ++r) { const int i = (r * nblk + blk) * 512 + tid; if (i < n) __hip_atomic_store(p + i, 0.f, __ATOMIC_RELAXED, __HIP_MEMORY_SCOPE_AGENT); } }

#ifndef MK_PER_PHASE
#define MK_PER_PHASE 0
#endif
constexpr int NPH = 8;
#ifndef PROBE_PH
#define PROBE_PH -1
#endif
#ifndef PROBE_REP
#define PROBE_REP 1
#endif
#define REP(k) for (int rep_ = 0; rep_ < ((k) == PROBE_PH ? PROBE_REP : 1); ++rep_)
typedef const __attribute__((address_space(4))) Args* CArgs;
__device__ __forceinline__ CArgs kargs() { CArgs p = (CArgs)__builtin_amdgcn_kernarg_segment_ptr(); asm volatile("" : "+s"(p)); return p; }
__global__ void __launch_bounds__(512, 2) fwd(Args args_unused) {
    extern __shared__ __attribute__((aligned(16))) unsigned char lds_raw[];
    LAS unsigned char* lds = (LAS unsigned char*)lds_raw;
    volatile LAS unsigned* MISC = (volatile LAS unsigned*)(lds + MISC_OFF);
    const int blk = (int)blockIdx.x, nblk = (int)gridDim.x;
    if (threadIdx.x < 32) MISC[threadIdx.x] = 0u;
    __syncthreads();
    XcdBarrier bar;
#if MK_PER_PHASE
    int lo, hi;
    { CArgs ap = kargs(); lo = ap->ph_lo; hi = ap->ph_hi; unsigned* bw = (unsigned*)(ap->ws + WS_CTL) + CW_BAR; bar.bar = bw; bar.x = 0; bar.st = nullptr;
      if (hi - lo > 1) bar = xcd_barrier_post(bw, MISC + 8); }
#else
    { CArgs ap = kargs(); bar = xcd_barrier_post((unsigned*)(ap->ws + WS_CTL) + CW_BAR, MISC + 8); }
#endif
#if MK_PER_PHASE
#define IN(k) (lo <= (k) && (k) < hi)
#define SEAM(k) do { if (IN(k) && IN((k) + 1)) xcd_barrier(bar); } while (0)
#else
#define IN(k) true
#define SEAM(k) do { if ((k) + 1 < NL * NPH) xcd_barrier(bar); } while (0)
#endif
#define WSP(T, off) ((T*)(ws + (off)))
#pragma unroll 1
    for (int l = 0; l < NL; ++l) {
        const int pb = l * NPH;
        if (IN(pb + 0)) REP(0) {
            CArgs ap = kargs(); unsigned char* ws = ap->ws;
            ph_convw(lds, ap, l, blk, nblk);
            if (l == 0) ph_copy_x(ap->in[0], ap->out, WSP(bf16, WS_XB), WSP(float, WS_SSQA), blk, nblk);

        }
        SEAM(pb + 0);
        if (IN(pb + 1)) REP(1) {
            CArgs ap = kargs(); unsigned char* ws = ap->ws;
            pg8::Gemm g{WSP(bf16, WS_XB), WSP(bf16, WS_WIN), T_, NIN, DM, 0}; pg8::StaticOrder S; S.init(T_, NIN, nblk, blk);
            pg8::EpiIn E{WSP(float, WS_SSQA), WSP(bf16, WS_Q), WSP(bf16, WS_K), WSP(bf16, WS_V), WSP(bf16, WS_RW), ap->in[5] + l * 128, ap->in[6] + l * 128};
            pg8::gemm_phase<pg8::EpiIn, pg8::StaticOrder, true, true>(lds, g, S, E);
        }
        SEAM(pb + 1);
        if (IN(pb + 2)) REP(2) {
            CArgs ap = kargs(); unsigned char* ws = ap->ws; const int lm = l > 0 ? l - 1 : 0;
            rk::S1Args A; A.rw = WSP(bf16, WS_RW); A.mu = ap->in[10] + (size_t)l * 3360; A.w0 = ap->in[11] + l * 1024; A.a0 = ap->in[13] + l * 1024; A.v0 = ap->in[21] + lm * 1024; A.k_k = ap->in[16] + l * 1024; A.k_a = ap->in[17] + l * 1024;
            A.r_k = ap->in[18] + l * 1024; A.w2t = (const bf16*)(ws + WS_LORA + LORA_W2); A.a2t = (const bf16*)(ws + WS_LORA + LORA_A2); A.g2t = (const bf16*)(ws + WS_LORA + LORA_G2); A.v2t = (const bf16*)(ws + WS_LORA + LORA_V2);
            A.vfirst = WSP(bf16, WS_VFIRST); A.BV = WSP(bf16, WS_BV); A.GB = WSP(bf16, WS_GB); A.PG = WSP(bf16, WS_PG); A.QT = WSP(float, WS_QT); A.RP = WSP(bf16, WS_RP); A.Y0 = WSP(float, WS_Y0); A.act = ws + WS_PART + (size_t)blk * rk::ACT_WG_BYTES; A.layer = l; A.pad_ = 0;
            rk::ph_stage1(lds, A, blk, nblk);
        }
        SEAM(pb + 2);
        if (IN(pb + 3)) {
            CArgs ap = kargs(); unsigned char* ws = ap->ws;
            rk::ph_chain(WSP(bf16, WS_PG), WSP(float, WS_QT), WSP(bf16, WS_H0T), blk, nblk);
            att::Args A; A.Q = WSP(bf16, WS_Q); A.K = WSP(bf16, WS_K); A.V = WSP(bf16, WS_V); A.mixed = WSP(bf16, WS_MIXED); A.stash = WSP(float, WS_STASH); A.lq = ap->in[7] + l * 128; A.lk = ap->in[8] + l * 128; A.subln = ap->in[9] + l * 128; A.gq = ap->in[5] + l * 128; A.gk = ap->in[6] + l * 128;
            A.lam_init = ap->lam_init[l]; A.pad_ = 0;
            att::attn_phase(lds, A, blk, (unsigned*)(ws + WS_CTL) + CW_ATTQ + 64 * l, MISC + 16, WSP(float, WS_PART));
        }
        SEAM(pb + 3);
        if (IN(pb + 4)) REP(4) {
            CArgs ap = kargs(); unsigned char* ws = ap->ws;
            rk::S3Args A{WSP(bf16, WS_H0T), WSP(bf16, WS_RP), WSP(float, WS_Y0), WSP(bf16, WS_BV), WSP(bf16, WS_GB), ap->in[19] + l * 1024, ap->in[20] + l * 1024, WSP(bf16, WS_MIXED)};
            rk::ph_stage3(A, blk, nblk);
            att::Args B; B.Q = WSP(bf16, WS_Q); B.K = WSP(bf16, WS_K); B.V = WSP(bf16, WS_V); B.mixed = WSP(bf16, WS_MIXED); B.stash = WSP(float, WS_STASH); B.lq = ap->in[7] + l * 128; B.lk = ap->in[8] + l * 128; B.subln = ap->in[9] + l * 128;
            B.gq = ap->in[5] + l * 128; B.gk = ap->in[6] + l * 128; B.lam_init = ap->lam_init[l]; B.pad_ = 0;
            att::attn_combine(lds, B, blk, nblk, WSP(float, WS_PART));
        }
        SEAM(pb + 4);
        if (IN(pb + 5)) {
            CArgs ap = kargs(); unsigned char* ws = ap->ws;
            pg8::Gemm g{WSP(bf16, WS_MIXED), WSP(bf16, WS_WOUT), T_, DM, DM, 0}; pg8::StaticOrder S; S.init(T_, DM, nblk, blk);
            pg8::EpiRes E{ap->out, WSP(bf16, WS_XB), WSP(float, WS_SSQB), DM, 0};
            pg8::gemm_phase<pg8::EpiRes, pg8::StaticOrder, true, true>(lds, g, S, E);
        }
        SEAM(pb + 5);
        if (IN(pb + 6)) REP(6) {
            CArgs ap = kargs(); unsigned char* ws = ap->ws;
            pg8::Gemm g{WSP(bf16, WS_XB), WSP(bf16, WS_WUP), T_, DFF, DM, 0}; pg8::StaticOrder S; S.init(T_, DFF, nblk, blk);
            pg8::EpiUp E{WSP(float, WS_SSQB), WSP(bf16, WS_U), DFF, 0};
            pg8::gemm_phase<pg8::EpiUp, pg8::StaticOrder, true, true>(lds, g, S, E);
        }
        SEAM(pb + 6);
        if (IN(pb + 7)) {
            CArgs ap = kargs(); unsigned char* ws = ap->ws;
            pg8::Gemm g{WSP(bf16, WS_U), WSP(bf16, WS_WDOWN), T_, DM, DFF, 0}; pg8::StaticOrder S; S.init(T_, DM, nblk, blk);
            pg8::EpiRes E{ap->out, WSP(bf16, WS_XB), WSP(float, WS_SSQA), DM, 0};
            pg8::gemm_phase<pg8::EpiRes, pg8::StaticOrder, true, true>(lds, g, S, E);
        }
        SEAM(pb + 7);
    }
#undef IN
#undef SEAM
#undef WSP
}

extern "C" void kernel_launch(void* const* d_in, const int* in_sizes, int n_in, void* d_out, int out_size, void* d_ws, size_t ws_size, hipStream_t stream) {
    static int grid = 0;
    if (grid == 0) {
        grid = -1;
        if (n_in != 26 || ws_size < WS_END || out_size != T_ * DM) { fprintf(stderr, "kernel_launch: unexpected shapes (n_in %d ws %zu out %d)\n", n_in, ws_size, out_size); return; }
        int dev = 0, cus = 0, per_cu = 0;
        if (hipGetDevice(&dev) != hipSuccess || hipDeviceGetAttribute(&cus, hipDeviceAttributeMultiprocessorCount, dev) != hipSuccess) return;
        if (hipFuncSetAttribute((const void*)fwd, hipFuncAttributeMaxDynamicSharedMemorySize, LDS_BYTES) != hipSuccess) return;
        if (hipOccupancyMaxActiveBlocksPerMultiprocessor(&per_cu, (const void*)fwd, 512, LDS_BYTES) != hipSuccess || per_cu < 1) { fprintf(stderr, "kernel_launch: occupancy query says %d\n", per_cu); (void)hipGetLastError(); return; }
        if (cus < 8) return;
        grid = cus;
    }
    if (grid < 0) return;
    if (hipMemsetAsync((char*)d_ws + WS_CTL, 0, CTL_ZERO_BYTES, stream) != hipSuccess) return;
    Args a;
    memset(&a, 0, sizeof(a));
    for (int i = 0; i < 26; ++i) a.in[i] = (const float*)d_in[i];
    a.out = (float*)d_out; a.ws = (unsigned char*)d_ws;
    for (int l = 0; l < NL; ++l) a.lam_init[l] = (float)(0.8 - 0.6 * exp(-0.3 * (double)l));
    const int nph = NL * NPH;
#if MK_PER_PHASE
    for (int p = 0; p < nph; ++p) { a.ph_lo = p; a.ph_hi = p + 1; hipLaunchKernelGGL(fwd, dim3(grid), dim3(512), LDS_BYTES, stream, a); }
#else
    a.ph_lo = 0; a.ph_hi = nph; hipLaunchKernelGGL(fwd, dim3(grid), dim3(512), LDS_BYTES, stream, a);
#endif
}
```

```cpp
#include <hip/hip_runtime.h>
#include <cstdio>
#include <cstdint>
#include <cstring>
#include <cmath>

constexpr int T_ = 16384, DM = 2048, NL = 4, PW = 6432, NIN = 6656, RWP = 3584, DFF = 8192, RW_ = 1024;
constexpr float RMS_EPS = 1e-6f, GN_EPS = 64e-5f;
typedef unsigned short bf16;
typedef float f32x4 __attribute__((ext_vector_type(4)));
typedef unsigned u32x4 __attribute__((ext_vector_type(4)));
typedef unsigned u32x2 __attribute__((ext_vector_type(2)));
#define LAS __attribute__((address_space(3)))

__device__ __forceinline__ unsigned f2bf(float f) { unsigned u = __builtin_bit_cast(unsigned, f); return (u + 0x7fffu + ((u >> 16) & 1u)) >> 16; }
__device__ __forceinline__ float bf2f(unsigned short b) { return __builtin_bit_cast(float, (unsigned)b << 16); }
__device__ __forceinline__ float bflo(unsigned w) { return __builtin_bit_cast(float, w << 16); }
__device__ __forceinline__ float bfhi(unsigned w) { return __builtin_bit_cast(float, w & 0xffff0000u); }
__device__ __forceinline__ float sigmoidf_(float x) { return 1.0f / (1.0f + __expf(-x)); }

template <int CTRL, int ROWMASK> __device__ __forceinline__ float dppf(float v) {
    return __builtin_bit_cast(float, __builtin_amdgcn_update_dpp(0, __builtin_bit_cast(int, v), CTRL, ROWMASK, 0xF, false));
}
__device__ __forceinline__ float wave_sum(float v) {
    v += dppf<0xB1, 0xF>(v); v += dppf<0x4E, 0xF>(v); v += dppf<0x141, 0xF>(v); v += dppf<0x140, 0xF>(v);
    v += dppf<0x142, 0xA>(v); v += dppf<0x143, 0xC>(v);
    return __builtin_bit_cast(float, __builtin_amdgcn_readlane(__builtin_bit_cast(int, v), 63));
}
__device__ __forceinline__ int opq_tid() { int t = (int)threadIdx.x; asm volatile("" : "+v"(t)); return t; }
namespace pg8 {
#define PG8_LAS __attribute__((address_space(3)))
typedef unsigned short bf16_t;
typedef short bf16x8 __attribute__((ext_vector_type(8)));
typedef float f32x4 __attribute__((ext_vector_type(4)));
typedef unsigned u32x4 __attribute__((ext_vector_type(4)));
constexpr int BM = 256, BK = 64, HALF = 128, HTB = HALF * BK * 2  , STAGE_BYTES = 8 * HTB, NXCD = 8, WGM = 8;

__host__ __device__ __forceinline__ int lds_byte(int r, int c) { const int st = (r >> 4) * 2 + (c >> 5), rr = r & 15, cc = c & 31, ob = rr * 64 + cc * 2; return st * 1024 + (ob ^ (((ob >> 9) & 1) << 5)); }
__host__ __device__ __forceinline__ void stage_rc(int b, int& R, int& C) { const int st = b / 1024, sb = b % 1024, swz = sb ^ (((sb >> 9) & 1) << 5); R = (st >> 1) * 16 + swz / 64; C = (st & 1) * 32 + (swz % 64) / 2; }
__host__ __device__ __forceinline__ int perm32(int rho) { const int n = rho >> 4, i = rho & 15; return 8 * (i >> 2) + 4 * n + (i & 3); }

struct Unit { int pm, pn; };
struct Gemm { const bf16_t* A; const bf16_t* Bt; int M, N, K, pad_; };

struct StaticOrder {
    int nM, nN, nwg, G, c;
    __host__ __device__ void init(int M, int N, int G_, int c_) { nM = M / BM; nN = N / BM; nwg = nM * nN; G = G_; c = c_; }
    __host__ __device__ bool next(int i, Unit& u) const {
        const long L = (long)i * G + c; if (L >= nwg) return false;
        int wgid = (int)L; { const int q = nwg / NXCD, r = nwg % NXCD, xcd = wgid % NXCD, off = wgid / NXCD; wgid = (xcd < r ? xcd * (q + 1) : r * (q + 1) + (xcd - r) * q) + off; }
        const int nig = WGM * nN, gid = wgid / nig, fm = gid * WGM, gsz = (nM - fm) < WGM ? (nM - fm) : WGM;
        u.pm = fm + ((wgid % nig) % gsz); u.pn = (wgid % nig) / gsz; return true;
    }
    __device__ __forceinline__ void a_ready(const Unit&) const {}
    __device__ __forceinline__ void done(const Unit&) const {}
};

__device__ __forceinline__ unsigned cvt_pk_bf16(float lo, float hi) { unsigned r; asm volatile("v_cvt_pk_bf16_f32 %0, %1, %2" : "=v"(r) : "v"(lo), "v"(hi)); return r; }
typedef float f32x2 __attribute__((ext_vector_type(2)));
__device__ __forceinline__ float row_ssq(const float* ssq, int row, int fq) {
    const f32x4 a = *(const f32x4*)(ssq + (size_t)row * 32 + 8 * fq), b = *(const f32x4*)(ssq + (size_t)row * 32 + 8 * fq + 4);
    float s = ((a[0] + a[1]) + (a[2] + a[3])) + ((b[0] + b[1]) + (b[2] + b[3]));
    s += __shfl_xor(s, 16); s += __shfl_xor(s, 32); return s;
}
struct EpiIn {
    static constexpr bool PERM = true, AFTER_DRAIN = false;
    const float* rinv; bf16_t* q; bf16_t* k; bf16_t* v; bf16_t* rw; const float* gq; const float* gk;
    __device__ __forceinline__ void operator()(const f32x4 (&acc)[2][2][4][2], const Unit& u, int wr, int wc, int fr, int fq) const {
        const int pn = u.pn;
        const int row0 = u.pm * BM + wr * 64 + fr;
        if (pn < 8) {
            const float* g = (pn < 4 ? gq : gk) + (wc & 1) * 64 + 8 * fq;
            f32x4 gv[2][2];
#pragma unroll
            for (int bj = 0; bj < 2; ++bj)
#pragma unroll
                for (int n = 0; n < 2; ++n) gv[bj][n] = *(const f32x4*)(g + 32 * bj + 4 * n);
            bf16_t* base = (pn < 4 ? q : k) + (pn & 3) * 256 + 64 * wc + 8 * fq;
#pragma unroll
            for (int ai = 0; ai < 2; ++ai)
#pragma unroll
                for (int m = 0; m < 4; ++m) {
                    const int row = row0 + ai * HALF + m * 16; const float ri = 1.0f / sqrtf(row_ssq(rinv, row, fq) * (1.0f / 2048.0f) + 1e-6f);
                    f32x4 vv[2][2]; float ss = 0.f;
#pragma unroll
                    for (int bj = 0; bj < 2; ++bj)
#pragma unroll
                        for (int n = 0; n < 2; ++n) { vv[bj][n] = acc[ai][bj][m][n] * ri; const f32x4 t = vv[bj][n]; ss += (t[0] * t[0] + t[1] * t[1]) + (t[2] * t[2] + t[3] * t[3]); }
                    ss += __shfl_xor(ss, 16); ss += __shfl_xor(ss, 32);
                    const float rq = 1.0f / sqrtf(ss * (1.0f / 64.0f) + 1e-6f);
#pragma unroll
                    for (int bj = 0; bj < 2; ++bj) { const f32x4 a = vv[bj][0] * rq * gv[bj][0], b = vv[bj][1] * rq * gv[bj][1];
                        u32x4 w; w.x = cvt_pk_bf16(a[0], a[1]); w.y = cvt_pk_bf16(a[2], a[3]); w.z = cvt_pk_bf16(b[0], b[1]); w.w = cvt_pk_bf16(b[2], b[3]);
                        *(u32x4*)(base + (size_t)row * 1024 + 32 * bj) = w; }
                }
        } else {
            bf16_t* base; int ld;
            if (pn < 12) { base = v + (pn - 8) * 256 + 64 * wc + 8 * fq; ld = 1024; } else { base = rw + (pn - 12) * 256 + 64 * wc + 8 * fq; ld = 3584; }
#pragma unroll
            for (int ai = 0; ai < 2; ++ai)
#pragma unroll
                for (int m = 0; m < 4; ++m) {
                    const int row = row0 + ai * HALF + m * 16; const float ri = 1.0f / sqrtf(row_ssq(rinv, row, fq) * (1.0f / 2048.0f) + 1e-6f);
#pragma unroll
                    for (int bj = 0; bj < 2; ++bj) { const f32x4 a = acc[ai][bj][m][0] * ri, b = acc[ai][bj][m][1] * ri;
                        u32x4 w; w.x = cvt_pk_bf16(a[0], a[1]); w.y = cvt_pk_bf16(a[2], a[3]); w.z = cvt_pk_bf16(b[0], b[1]); w.w = cvt_pk_bf16(b[2], b[3]);
                        *(u32x4*)(base + (size_t)row * ld + 32 * bj) = w; }
                }
        }
    }
};
struct EpiRes {
    static constexpr bool PERM = true, AFTER_DRAIN = false;
    float* x; bf16_t* xb; float* ssq; int ldc; int pad_;
    __device__ __forceinline__ void operator()(const f32x4 (&acc)[2][2][4][2], const Unit& u, int wr, int wc, int fr, int fq) const {
        const int row0 = u.pm * BM + wr * 64 + fr, col0 = u.pn * BM + wc * 32 + 8 * fq;
#pragma unroll
        for (int ai = 0; ai < 2; ++ai)
#pragma unroll
            for (int m = 0; m < 4; ++m) { const int row = row0 + ai * HALF + m * 16; float* rowp = x + (size_t)row * ldc + col0; bf16_t* rowb = xb + (size_t)row * ldc + col0; float ss = 0.f;
#pragma unroll
                for (int bj = 0; bj < 2; ++bj) { f32x4* p = (f32x4*)(rowp + bj * HALF); const f32x4 o0 = p[0] + acc[ai][bj][m][0], o1 = p[1] + acc[ai][bj][m][1]; p[0] = o0; p[1] = o1;
                    ss += ((o0[0] * o0[0] + o0[1] * o0[1]) + (o0[2] * o0[2] + o0[3] * o0[3])) + ((o1[0] * o1[0] + o1[1] * o1[1]) + (o1[2] * o1[2] + o1[3] * o1[3]));
                    u32x4 w; w.x = cvt_pk_bf16(o0[0], o0[1]); w.y = cvt_pk_bf16(o0[2], o0[3]); w.z = cvt_pk_bf16(o1[0], o1[1]); w.w = cvt_pk_bf16(o1[2], o1[3]);
                    *(u32x4*)(rowb + bj * HALF) = w; }
                ss += __shfl_xor(ss, 16); ss += __shfl_xor(ss, 32);
                if (fq == 0) ssq[(size_t)row * 32 + u.pn * 4 + wc] = ss; }
    }
};
struct EpiUp {
    static constexpr bool PERM = true, AFTER_DRAIN = false;
    const float* rinv; bf16_t* o; int ldc; int pad_;
    __device__ __forceinline__ void operator()(const f32x4 (&acc)[2][2][4][2], const Unit& u, int wr, int wc, int fr, int fq) const {
        const int row0 = u.pm * BM + wr * 64 + fr, col0 = u.pn * BM + wc * 32 + 8 * fq;
#pragma unroll
        for (int ai = 0; ai < 2; ++ai)
#pragma unroll
            for (int m = 0; m < 4; ++m) { const int row = row0 + ai * HALF + m * 16; const float ri = 1.0f / sqrtf(row_ssq(rinv, row, fq) * (1.0f / 2048.0f) + 1e-6f);   bf16_t* rowp = o + (size_t)row * ldc + col0;
#pragma unroll
                for (int bj = 0; bj < 2; ++bj) { f32x4 a = acc[ai][bj][m][0] * ri, b = acc[ai][bj][m][1] * ri;
#pragma unroll
                    for (int e = 0; e < 4; ++e) { a[e] = a[e] > 0.f ? a[e] * a[e] : 0.f; b[e] = b[e] > 0.f ? b[e] * b[e] : 0.f; }
                    u32x4 w; w.x = cvt_pk_bf16(a[0], a[1]); w.y = cvt_pk_bf16(a[2], a[3]); w.z = cvt_pk_bf16(b[0], b[1]); w.w = cvt_pk_bf16(b[2], b[3]);
                    *(u32x4*)(rowp + bj * HALF) = w; } }
    }
};
template <class Epi, class Sched, bool ALIGN_EPI = false, bool SP2 = false>
__device__ __forceinline__ void gemm_phase(PG8_LAS unsigned char* lds, const Gemm g, const Sched& S, const Epi& E) {
    const int tid = opq_tid(), wid = __builtin_amdgcn_readfirstlane(tid >> 6), lane = tid & 63, wr = wid >> 2, wc = wid & 3, fr = lane & 15, fq = lane >> 4;
    const int K = g.K, nt = K / BK;
    unsigned voffA[2], voffB[2];
#pragma unroll
    for (int i = 0; i < 2; ++i) { int R, C; stage_rc(tid * 16 + i * 8192, R, C); const int Rb = Epi::PERM ? ((R & ~31) + perm32(R & 31)) : R;
        voffA[i] = (unsigned)(R * K + C) * 2u; voffB[i] = (unsigned)(Rb * K + C) * 2u; }
    const size_t kstep = (size_t)(BK * 2);
    const size_t hstep = (size_t)HALF * K * 2;
    const size_t tstep = 2 * hstep;
    const unsigned ldsw = (unsigned)wid * 1024u;
    const int aoff = lds_byte(wr * 64 + fr, fq * 8), boff = lds_byte(wc * 32 + fr, fq * 8);
#define PG8_SA(b, h) (((b) * 2 + (h)) * HTB)
#define PG8_SB(b, h) ((4 + (b) * 2 + (h)) * HTB)
#define PG8_STAGE(bufoff, gbase, voff) do { _Pragma("unroll") for (int _i = 0; _i < 2; ++_i) \
        __builtin_amdgcn_global_load_lds((const unsigned*)((const char*)(gbase) + (voff)[_i]), (PG8_LAS unsigned*)(lds + (bufoff) + ldsw + _i * 8192), 16, 0, 0); } while (0)
#define PG8_LDA(dst, b, h) do { _Pragma("unroll") for (int m = 0; m < 4; ++m) _Pragma("unroll") for (int k = 0; k < 2; ++k) dst[m][k] = *(const PG8_LAS bf16x8*)(lds + PG8_SA(b, h) + aoff + m * 2048 + k * 1024); } while (0)
#define PG8_LDB(dst, b, h) do { _Pragma("unroll") for (int n = 0; n < 2; ++n) _Pragma("unroll") for (int k = 0; k < 2; ++k) dst[n][k] = *(const PG8_LAS bf16x8*)(lds + PG8_SB(b, h) + boff + n * 2048 + k * 1024); } while (0)
#define PG8_MMA(ai, bj, At, Bt) do { __builtin_amdgcn_s_setprio(1); _Pragma("unroll") for (int m = 0; m < 4; ++m) _Pragma("unroll") for (int n = 0; n < 2; ++n) _Pragma("unroll") for (int k = 0; k < 2; ++k) \
        acc[ai][bj][m][n] = __builtin_amdgcn_mfma_f32_16x16x32_bf16(Bt[n][k], At[m][k], acc[ai][bj][m][n], 0, 0, 0); __builtin_amdgcn_s_setprio(0); } while (0)
#define PG8_WAIT_V(n) asm volatile("s_waitcnt vmcnt(" #n ")" ::: "memory")
#define PG8_WAIT_L(n) asm volatile("s_waitcnt lgkmcnt(" #n ")" ::: "memory")
#define PG8_BAR __builtin_amdgcn_s_barrier()
#define PG8_SCHED __builtin_amdgcn_sched_barrier(0)
    Unit cur, nxt; int ui = 0;
    if (!S.next(0, cur)) return;
    f32x4 acc[2][2][4][2];
#pragma unroll
    for (int a = 0; a < 2; ++a)
#pragma unroll
        for (int b = 0; b < 2; ++b)
#pragma unroll
            for (int m = 0; m < 4; ++m)
#pragma unroll
                for (int n = 0; n < 2; ++n) acc[a][b][m][n] = (f32x4){0.f, 0.f, 0.f, 0.f};
    bf16x8 At[4][2], B0[2][2], B1[2][2];
    const char* cA = (const char*)g.A + (size_t)cur.pm * tstep; const char* cB = (const char*)g.Bt + (size_t)cur.pn * tstep;
    S.a_ready(cur);
    if constexpr (SP2) {
        PG8_STAGE(PG8_SB(0, 0), cB, voffB); PG8_STAGE(PG8_SB(0, 1), cB + hstep, voffB); PG8_STAGE(PG8_SA(0, 0), cA, voffA); PG8_STAGE(PG8_SA(0, 1), cA + hstep, voffA);
        if (wr == 1) PG8_BAR;
        PG8_WAIT_V(2); PG8_BAR;
        PG8_STAGE(PG8_SB(1, 0), cB + kstep, voffB); PG8_STAGE(PG8_SA(1, 0), cA + kstep, voffA); PG8_STAGE(PG8_SB(1, 1), cB + hstep + kstep, voffB);
        PG8_WAIT_V(6); PG8_BAR;
    } else {
        PG8_STAGE(PG8_SB(0, 0), cB, voffB); PG8_STAGE(PG8_SA(0, 0), cA, voffA); PG8_STAGE(PG8_SB(0, 1), cB + hstep, voffB); PG8_STAGE(PG8_SA(0, 1), cA + hstep, voffA);
        if (wr == 1) PG8_BAR;
        PG8_WAIT_V(4); PG8_BAR;
        PG8_STAGE(PG8_SB(1, 0), cB + kstep, voffB); PG8_STAGE(PG8_SA(1, 0), cA + kstep, voffA); PG8_STAGE(PG8_SB(1, 1), cB + hstep + kstep, voffB);
        PG8_WAIT_V(6); PG8_BAR;
    }
    for (;;) {
        const bool has_next = S.next(ui + 1, nxt);
        const char* nA = has_next ? (const char*)g.A + (size_t)nxt.pm * tstep : cA; const char* nB = has_next ? (const char*)g.Bt + (size_t)nxt.pn * tstep : cB;
        for (int t = 0; t < nt; t += 2) {
            const bool last = (t == nt - 2);
            const char* a1 = cA + (size_t)(t + 1) * kstep;
            const char* a2 = last ? nA : cA + (size_t)(t + 2) * kstep; const char* b2 = last ? nB : cB + (size_t)(t + 2) * kstep;
            const char* a3 = a2 + kstep; const char* b3 = b2 + kstep;
            if (last && has_next) S.a_ready(nxt);
            if constexpr (SP2) {
            PG8_LDB(B0, 0, 0); PG8_LDB(B1, 0, 1); PG8_SCHED; PG8_LDA(At, 0, 0); PG8_STAGE(PG8_SA(1, 1), a1 + hstep, voffA);
            PG8_WAIT_V(8); PG8_WAIT_L(0); PG8_BAR; PG8_MMA(0, 0, At, B0); PG8_MMA(0, 1, At, B1); PG8_BAR; PG8_SCHED;
            PG8_LDA(At, 0, 1); PG8_STAGE(PG8_SB(0, 0), b2, voffB); PG8_STAGE(PG8_SB(0, 1), b2 + hstep, voffB); PG8_STAGE(PG8_SA(0, 0), a2, voffA);
            PG8_WAIT_V(8); PG8_WAIT_L(0); PG8_BAR; PG8_MMA(1, 0, At, B0); PG8_MMA(1, 1, At, B1); PG8_BAR; PG8_SCHED;
            PG8_LDB(B0, 1, 0); PG8_LDB(B1, 1, 1); PG8_SCHED; PG8_LDA(At, 1, 0); PG8_STAGE(PG8_SA(0, 1), a2 + hstep, voffA);
            PG8_WAIT_V(8); PG8_WAIT_L(0); PG8_BAR; PG8_MMA(0, 0, At, B0); PG8_MMA(0, 1, At, B1); PG8_BAR; PG8_SCHED;
            PG8_LDA(At, 1, 1); PG8_STAGE(PG8_SB(1, 0), b3, voffB); PG8_STAGE(PG8_SB(1, 1), b3 + hstep, voffB); PG8_STAGE(PG8_SA(1, 0), a3, voffA);
            PG8_WAIT_V(8); PG8_WAIT_L(0); PG8_BAR; PG8_MMA(1, 0, At, B0); PG8_MMA(1, 1, At, B1); PG8_BAR; PG8_SCHED;
            } else {
            PG8_LDB(B0, 0, 0); PG8_SCHED; PG8_LDA(At, 0, 0); PG8_STAGE(PG8_SA(1, 1), a1 + hstep, voffA);
            PG8_WAIT_L(8); PG8_BAR; PG8_WAIT_L(0); PG8_MMA(0, 0, At, B0); PG8_BAR; PG8_SCHED;
            PG8_LDB(B1, 0, 1); PG8_STAGE(PG8_SB(0, 0), b2, voffB);
            PG8_BAR; PG8_WAIT_L(0); PG8_MMA(0, 1, At, B1); PG8_BAR;
            PG8_LDA(At, 0, 1); PG8_STAGE(PG8_SA(0, 0), a2, voffA);
            PG8_BAR; PG8_WAIT_L(0); PG8_MMA(1, 0, At, B0); PG8_BAR; PG8_SCHED;
            PG8_STAGE(PG8_SB(0, 1), b2 + hstep, voffB);
            PG8_WAIT_V(6); PG8_BAR; PG8_MMA(1, 1, At, B1); PG8_BAR;
            PG8_LDB(B0, 1, 0); PG8_SCHED; PG8_LDA(At, 1, 0); PG8_STAGE(PG8_SA(0, 1), a2 + hstep, voffA);
            PG8_WAIT_L(8); PG8_BAR; PG8_WAIT_L(0); PG8_MMA(0, 0, At, B0); PG8_BAR; PG8_SCHED;
            PG8_LDB(B1, 1, 1); PG8_STAGE(PG8_SB(1, 0), b3, voffB);
            PG8_BAR; PG8_WAIT_L(0); PG8_MMA(0, 1, At, B1); PG8_BAR;
            PG8_LDA(At, 1, 1); PG8_STAGE(PG8_SA(1, 0), a3, voffA);
            PG8_BAR; PG8_WAIT_L(0); PG8_MMA(1, 0, At, B0); PG8_BAR; PG8_SCHED;
            PG8_STAGE(PG8_SB(1, 1), b3 + hstep, voffB);
            PG8_WAIT_V(6); PG8_BAR; PG8_MMA(1, 1, At, B1); PG8_BAR;
            }
        }
        if constexpr (ALIGN_EPI) { if (wr == 0) PG8_BAR; }
        if constexpr (!Epi::AFTER_DRAIN) { E(acc, cur, wr, wc, fr, fq); S.done(cur); }
        if (!has_next) break;
#pragma unroll
        for (int a = 0; a < 2; ++a)
#pragma unroll
            for (int b = 0; b < 2; ++b)
#pragma unroll
                for (int m = 0; m < 4; ++m)
#pragma unroll
                    for (int n = 0; n < 2; ++n) acc[a][b][m][n] = (f32x4){0.f, 0.f, 0.f, 0.f};
        cur = nxt; cA = nA; cB = nB; ++ui;
        if constexpr (ALIGN_EPI) { if (wr == 1) PG8_BAR; }
    }
    PG8_WAIT_V(0);
    if constexpr (!ALIGN_EPI) { if (wr == 0) PG8_BAR; }
    PG8_BAR;
    if constexpr (Epi::AFTER_DRAIN) { E.fused(acc, cur, wr, wc, fr, fq, lds, wid, lane); S.done(cur); }
#undef PG8_SA
#undef PG8_SB
#undef PG8_STAGE
#undef PG8_LDA
#undef PG8_LDB
#undef PG8_MMA
#undef PG8_WAIT_V
#undef PG8_WAIT_L
#undef PG8_BAR
#undef PG8_SCHED
}
}

namespace att {
typedef short bf16x8 __attribute__((ext_vector_type(8)));
typedef short s16x4 __attribute__((ext_vector_type(4)));
typedef float f32x16 __attribute__((ext_vector_type(16)));
typedef float f32x2_t __attribute__((ext_vector_type(2)));
typedef __bf16 bf16x2_t __attribute__((ext_vector_type(2)));
typedef __attribute__((address_space(3))) const unsigned char* lds_cptr;
typedef short v4i16_t __attribute__((ext_vector_type(4)));
constexpr int KTILE = 8192, VTILE = 16384, KSLOT = 2 * KTILE, VSLOT = 2 * VTILE, LDS_K = 0, LDS_V = 2 * KSLOT, LDS_BYTES = 2 * KSLOT + 2 * VSLOT;
constexpr float LOG2E = 1.4426950408889634f, C2 = 0.125f * LOG2E;
__device__ __forceinline__ int crow(int r, int hi) { return (r & 3) + 8 * (r >> 2) + 4 * hi; }
__device__ __forceinline__ void glds16(const void* gsrc, unsigned lds_dst) { unsigned keep;
    asm volatile("s_mov_b32 %0, m0\n\ts_mov_b32 m0, %2\n\ts_nop 0\n\tglobal_load_lds_dwordx4 %1, off\n\ts_mov_b32 m0, %0" : "=&s"(keep) : "v"(gsrc), "s"(lds_dst) : "memory"); }
__device__ __forceinline__ unsigned cvtpk(float lo, float hi) { f32x2_t v = {lo, hi}; bf16x2_t b = __builtin_convertvector(v, bf16x2_t); return __builtin_bit_cast(unsigned, b); }
__device__ __forceinline__ s16x4 vtr(lds_cptr p) { return __builtin_bit_cast(s16x4, __builtin_amdgcn_ds_read_tr16_b64_v4i16((__attribute__((address_space(3))) v4i16_t*)p)); }
__device__ __forceinline__ float swap_max(float m) { auto rr = __builtin_amdgcn_permlane32_swap(__float_as_uint(m), __float_as_uint(m), false, false); return fmaxf(__uint_as_float(rr[0]), __uint_as_float(rr[1])); }
__device__ __forceinline__ float swap_sum(float m) { auto rr = __builtin_amdgcn_permlane32_swap(__float_as_uint(m), __float_as_uint(m), false, false); return __uint_as_float(rr[0]) + __uint_as_float(rr[1]); }
#define ATT_WAIT_BAR() asm volatile("s_waitcnt vmcnt(0) lgkmcnt(0)\n\ts_barrier" ::: "memory")

struct Args { const bf16* Q; const bf16* K; const bf16* V; bf16* mixed; float* stash; const float* lq; const float* lk; const float* subln; const float* gq; const float* gk; float lam_init; int pad_; };

constexpr int PART_F = 68, PART_SLOT_F = 512 * PART_F, MAX_SLOTS = 1700, SPLIT_MIN = 20, PART_TILES = 40, TAB_OFF = 102400;
__device__ __forceinline__ void attn_pass(__attribute__((address_space(3))) unsigned char* lds, const Args& A, int h, int qb, int c, int ta, int tb, int nw, f32x16 (&oT)[4], float& l_out, float& M_out) {
    const int tid = opq_tid(), lane = tid & 63, r32 = lane & 31, hi = lane >> 5; const int wid = __builtin_amdgcn_readfirstlane(tid >> 6);
    const int q0 = qb * 256 + wid * 32, qc = q0 >> 6;
    const float slope2 = exp2f(-(float)(h + 1)) * LOG2E;
    const unsigned lds0 = (unsigned)(uintptr_t)lds;
    const lds_cptr kp0 = (lds_cptr)lds + LDS_K + hi * 1024 + r32 * 16;
    const lds_cptr vp0 = (lds_cptr)lds + LDS_V + ((lane >> 4) & 1) * 32 + (lane & 3) * 8 + (4 * hi + ((lane & 15) >> 2)) * 64;
    const bf16* vsrc = A.V + (size_t)(16 * (wid & 3) + (lane >> 2)) * 1024 + h * 128 + (wid >> 2) * 32 + (lane & 3) * 8;
    const unsigned kdst = lds0 + LDS_K + wid * 1024, vdst = lds0 + LDS_V + (wid >> 2) * 4096 + (wid & 3) * 1024;
    const int qrel = (q0 & 63) + r32;
    const int tw0 = max(ta, max(0, qc - nw));
    const bf16* ksrc = A.K + (size_t)lane * 1024 + h * 128 + c * 64 + wid * 8;
    bf16x8 qr[4];
    { const bf16* qp = A.Q + (size_t)(q0 + r32) * 1024 + h * 128 + c * 64 + hi * 8;
#pragma unroll
      for (int d0 = 0; d0 < 4; ++d0) qr[d0] = *(const bf16x8*)(qp + d0 * 16); }
#pragma unroll
    for (int d0 = 0; d0 < 4; ++d0)
#pragma unroll
        for (int r = 0; r < 16; ++r) oT[d0][r] = 0.f;
    float l = 0.f, mu = 0.f;
    if (ta < tb) {
#define ATT_DMA(t_, so_, u_) do { const size_t go = (size_t)(t_) * 64 * 1024; \
            glds16(ksrc + go, (unsigned)__builtin_amdgcn_readfirstlane(kdst + (so_) * KSLOT + (u_) * KTILE)); glds16(vsrc + go, (unsigned)__builtin_amdgcn_readfirstlane(vdst + (so_) * VSLOT + (u_) * VTILE)); \
            glds16(vsrc + go + 64, (unsigned)__builtin_amdgcn_readfirstlane(vdst + (so_) * VSLOT + (u_) * VTILE + 8192)); } while (0)
        ATT_DMA(ta, 0u, 0u); if (ta + 1 < tb) ATT_DMA(ta + 1, 0u, 1u);
        ATT_WAIT_BAR();
#pragma unroll 1
        for (int T = ta; T < tb; T += 2) {
          const unsigned so = (unsigned)(((T - ta) >> 1) & 1);
          if (T + 2 < tb) { ATT_DMA(T + 2, so ^ 1u, 0u); if (T + 3 < tb) ATT_DMA(T + 3, so ^ 1u, 1u); }
#pragma unroll 1
          for (int u = 0; u < 2; ++u) {
            const int t = T + u, sl = 0; (void)sl;
            if (t >= tb) break;
            if (t >= tw0 && t <= qc) {
                const bool diag = (t == qc);
                f32x16 p0, p1;
                const float sc = slope2 * (1.0f / C2), base0 = (float)(4 * hi) * sc - mu * (1.0f / C2), base1 = base0 + 32.0f * sc;
                if (!diag) {
#pragma unroll
                    for (int r = 0; r < 16; ++r) { const float kr = (float)((r & 3) + 8 * (r >> 2)); p0[r] = __builtin_fmaf(kr, sc, base0); p1[r] = __builtin_fmaf(kr, sc, base1); }
                } else {
                    const float q2 = (float)(2 * qrel - 8 * hi);
#pragma unroll
                    for (int r = 0; r < 16; ++r) { const float kr = (float)((r & 3) + 8 * (r >> 2));
                        p0[r] = __builtin_fmaf(fminf(kr, q2 - kr) , sc, base0); p1[r] = __builtin_fmaf(fminf(kr, q2 - 64.0f - kr), sc, base1); }
                }
                const lds_cptr kp = kp0 + so * KSLOT + u * KTILE;
#pragma unroll
                for (int d0 = 0; d0 < 4; ++d0) {
                    const bf16x8 k0 = *(const __attribute__((address_space(3))) bf16x8*)(kp + d0 * 2048), k1 = *(const __attribute__((address_space(3))) bf16x8*)(kp + d0 * 2048 + 512);
                    p0 = __builtin_amdgcn_mfma_f32_32x32x16_bf16(k0, qr[d0], p0, 0, 0, 0);
                    p1 = __builtin_amdgcn_mfma_f32_32x32x16_bf16(k1, qr[d0], p1, 0, 0, 0);
                }
                const lds_cptr vp = vp0 + so * VSLOT + u * VTILE;
                bf16x8 vfA[4], vfB[4];
#define ATT_VLOAD(dst, d0_) do { _Pragma("unroll") for (int s = 0; s < 4; ++s) { const s16x4 lo = vtr(vp + (d0_) * 4096 + s * 1024), hh = vtr(vp + (d0_) * 4096 + s * 1024 + 512); \
                        dst[s] = (bf16x8){lo[0], lo[1], lo[2], lo[3], hh[0], hh[1], hh[2], hh[3]}; } } while (0)
#define ATT_PV(src, d0_) do { _Pragma("unroll") for (int s = 0; s < 4; ++s) oT[d0_] = __builtin_amdgcn_mfma_f32_32x32x16_bf16(src[s], pw[s], oT[d0_], 0, 0, 0); } while (0)
                ATT_VLOAD(vfA, 0);
                __builtin_amdgcn_sched_barrier(0);
                float rm = fmaxf(fmaxf(p0[0], p1[0]), p0[1]);
#pragma unroll
                for (int r = 1; r < 16; ++r) rm = fmaxf(fmaxf(rm, p1[r]), r + 1 < 16 ? p0[r + 1] : p1[r]);
                rm = swap_max(rm);
                const float dl = (t == tw0) ? C2 * rm : fmaxf(C2 * rm, 0.f);
                if (__any(dl != 0.f)) { const float f = __builtin_amdgcn_exp2f(-dl); l *= f;
#pragma unroll
                    for (int d0 = 0; d0 < 4; ++d0)
#pragma unroll
                        for (int r = 0; r < 16; ++r) oT[d0][r] *= f; }
                mu += dl;
                float ls = 0.f;
#pragma unroll
                for (int r = 0; r < 16; ++r) { p0[r] = __builtin_amdgcn_exp2f(p0[r] * C2 - dl); p1[r] = __builtin_amdgcn_exp2f(p1[r] * C2 - dl); ls += p0[r] + p1[r]; }
                l += ls;
                bf16x8 pw[4];
#pragma unroll
                for (int s = 0; s < 4; ++s) { u32x4 w;
#pragma unroll
                    for (int e = 0; e < 4; ++e) { const int r = 8 * (s & 1) + 2 * e; w[e] = (s < 2) ? cvtpk(p0[r], p0[r + 1]) : cvtpk(p1[r], p1[r + 1]); }
                    pw[s] = __builtin_bit_cast(bf16x8, w); }
                ATT_VLOAD(vfB, 1); __builtin_amdgcn_sched_barrier(0);
                ATT_PV(vfA, 0);
                ATT_VLOAD(vfA, 2); __builtin_amdgcn_sched_barrier(0);
                ATT_PV(vfB, 1);
                ATT_VLOAD(vfB, 3); __builtin_amdgcn_sched_barrier(0);
                ATT_PV(vfA, 2);
                __builtin_amdgcn_sched_barrier(0);
                ATT_PV(vfB, 3);
#undef ATT_VLOAD
#undef ATT_PV
                mu -= 64.0f * slope2;
            }
          }
          ATT_WAIT_BAR();
        }
#undef ATT_DMA
    }
    const int tl = min(qc, tb - 1);
    l_out = l; M_out = (tl >= tw0) ? mu + slope2 * 64.0f * (float)(tl + 1) : -1e30f;
}
__device__ __forceinline__ void attn_finalize(const Args& A, int h, int qb, const f32x16 (&o1)[4], f32x16 (&o2)[4], float lam) {
    const int tid = opq_tid(), lane = tid & 63, r32 = lane & 31, hi = lane >> 5; const int wid = __builtin_amdgcn_readfirstlane(tid >> 6);
    const int q0 = qb * 256 + wid * 32;
    float ss = 0.f;
#pragma unroll
    for (int d0 = 0; d0 < 4; ++d0)
#pragma unroll
        for (int r = 0; r < 16; ++r) { const float v = o1[d0][r] - lam * o2[d0][r]; o2[d0][r] = v; ss += v * v; }
    ss = swap_sum(ss);
    const float rn = (1.0f / sqrtf(ss * (1.0f / 128.0f) + RMS_EPS)) * (1.0f - A.lam_init);
    bf16* op = A.mixed + (size_t)(q0 + r32) * DM + h * 128;
#pragma unroll
    for (int d0 = 0; d0 < 4; ++d0)
#pragma unroll
        for (int g4 = 0; g4 < 4; ++g4) { const int d = 32 * d0 + 8 * g4 + 4 * hi; const f32x4 gg = *(const f32x4*)(A.subln + d);
            u32x2 w; w.x = cvtpk(o2[d0][4 * g4] * rn * gg[0], o2[d0][4 * g4 + 1] * rn * gg[1]); w.y = cvtpk(o2[d0][4 * g4 + 2] * rn * gg[2], o2[d0][4 * g4 + 3] * rn * gg[3]);
            *(u32x2*)(op + d) = w; }
}
struct Win { float smax0, smax1; };
__device__ __forceinline__ int win_nw(const Win& W, int h, int c) { const float smax = c ? W.smax1 : W.smax0, slope2 = exp2f(-(float)(h + 1)) * LOG2E, dmin = (2.0f * C2 * smax + 67.0f) / slope2; return (int)fminf(ceilf((dmin + 63.0f) * (1.0f / 64.0f)) - 1.0f, 256.0f); }
__device__ __forceinline__ void attn_windows(const Args& A, Win& W, float& lam) {
    const int lane = opq_tid() & 63;
    const float l0 = wave_sum(A.lq[lane] * A.lk[lane]), l1 = wave_sum(A.lq[64 + lane] * A.lk[64 + lane]);
    lam = __expf(l0) - __expf(l1) + A.lam_init;
#pragma unroll
    for (int c = 0; c < 2; ++c) { float a = fabsf(A.gq[c * 64 + lane]), b = fabsf(A.gk[c * 64 + lane]);
#pragma unroll
        for (int o = 1; o < 64; o <<= 1) { a = fmaxf(a, __shfl_xor(a, o)); b = fmaxf(b, __shfl_xor(b, o)); }
        const float smax = 64.0f * 1.02f * a * b; if (c == 0) W.smax0 = smax; else W.smax1 = smax; }
}
__device__ __forceinline__ int attn_ntile(const Win& W, int h, int qb, int c) { return 4 * qb + 4 - max(0, 4 * qb - win_nw(W, h, c)); }
__device__ __forceinline__ int attn_table(__attribute__((address_space(3))) unsigned char* lds, const Win& W) {
    volatile __attribute__((address_space(3))) unsigned* tab = (volatile __attribute__((address_space(3))) unsigned*)(lds + TAB_OFF);
    const int tid = opq_tid(), lane = tid & 63, wid = tid >> 6, qb = 63 - (tid >> 3), h = tid & 7;
    const int nt = max(attn_ntile(W, h, qb, 0), attn_ntile(W, h, qb, 1));
    int P = nt > SPLIT_MIN ? (nt + PART_TILES - 1) / PART_TILES : 0;
    int want = 2 * P, incl = want;
#pragma unroll
    for (int o = 1; o < 64; o <<= 1) { const int v = __shfl_up(incl, o); if (lane >= o) incl += v; }
    if (lane == 63) tab[1032 + wid] = (unsigned)incl;
    asm volatile("s_waitcnt lgkmcnt(0)" ::: "memory"); __builtin_amdgcn_s_barrier(); asm volatile("" ::: "memory");
    int sbase = 0;
#pragma unroll
    for (int w = 0; w < 8; ++w) sbase += (w < wid) ? (int)tab[1032 + w] : 0;
    const int sstart = sbase + incl - want;
    if (sstart + want > MAX_SLOTS) P = 0;
    const int cnt = P > 0 ? 2 * P : 1; int ci = cnt;
#pragma unroll
    for (int o = 1; o < 64; o <<= 1) { const int v = __shfl_up(ci, o); if (lane >= o) ci += v; }
    if (lane == 63) tab[1024 + wid] = (unsigned)ci;
    asm volatile("s_waitcnt lgkmcnt(0)" ::: "memory"); __builtin_amdgcn_s_barrier(); asm volatile("" ::: "memory");
    int ibase = 0, total = 0;
#pragma unroll
    for (int w = 0; w < 8; ++w) { const int v = (int)tab[1024 + w]; ibase += (w < wid) ? v : 0; total += v; }
    tab[tid] = (unsigned)(ibase + ci - cnt) | ((unsigned)P << 16); tab[512 + tid] = (unsigned)sstart;
    asm volatile("s_waitcnt lgkmcnt(0)" ::: "memory"); __builtin_amdgcn_s_barrier(); asm volatile("" ::: "memory");
    return total;
}
__device__ __forceinline__ void part_range(const Win& W, int h, int qb, int c, int P, int p, int& ta, int& tb) {
    const int NT = 4 * qb + 4, T0 = max(0, 4 * qb - win_nw(W, h, c)), len = (NT - T0 + P - 1) / P; ta = min(NT, T0 + p * len); tb = min(NT, ta + len);
}
__device__ __forceinline__ void attn_phase(__attribute__((address_space(3))) unsigned char* lds, const Args& A, int blk, unsigned* ctr, volatile __attribute__((address_space(3))) unsigned* qslot, float* part) {
    const int tid = opq_tid();
    Win W; float lam; attn_windows(A, W, lam);
    const int nitems = attn_table(lds, W);
    volatile __attribute__((address_space(3))) unsigned* tab = (volatile __attribute__((address_space(3))) unsigned*)(lds + TAB_OFF);
    float* st = A.stash + (size_t)blk * (64 * 512) + tid * 64;
    for (;;) {
        if (tid == 0) { const unsigned n = __hip_atomic_fetch_add(ctr, 1u, __ATOMIC_RELAXED, __HIP_MEMORY_SCOPE_AGENT); unsigned idx = 0;
            if (n < (unsigned)nitems) { int lo = 0, hi = 511; while (lo < hi) { const int mid = (lo + hi + 1) >> 1; if ((tab[mid] & 0xffffu) <= n) lo = mid; else hi = mid - 1; } idx = (unsigned)lo; }
            qslot[0] = n; qslot[1] = idx; }
        asm volatile("s_waitcnt vmcnt(0) lgkmcnt(0)" ::: "memory"); __builtin_amdgcn_s_barrier(); asm volatile("" ::: "memory");
        const unsigned n = qslot[0], idx = qslot[1];
        asm volatile("s_waitcnt lgkmcnt(0)" ::: "memory"); __builtin_amdgcn_s_barrier(); asm volatile("" ::: "memory");
        if (n >= (unsigned)nitems) break;
        const unsigned e = tab[idx]; const int P = (int)(e >> 16), sub = (int)(n - (e & 0xffffu)), h = (int)(idx & 7u), qb = 63 - (int)(idx >> 3);
        f32x16 oT[4]; float l, M;
        if (P == 0) {
#pragma unroll 1
            for (int c = 0; c < 2; ++c) {
                attn_pass(lds, A, h, qb, c, max(0, 4 * qb - win_nw(W, h, c)), 4 * qb + 4, win_nw(W, h, c), oT, l, M);
                const float il = 1.0f / swap_sum(l);
#pragma unroll
                for (int d0 = 0; d0 < 4; ++d0)
#pragma unroll
                    for (int r = 0; r < 16; ++r) oT[d0][r] *= il;
                if (c == 0) {
#pragma unroll
                    for (int d0 = 0; d0 < 4; ++d0)
#pragma unroll
                        for (int r = 0; r < 16; r += 4) *(f32x4*)(st + d0 * 16 + r) = (f32x4){oT[d0][r], oT[d0][r + 1], oT[d0][r + 2], oT[d0][r + 3]};
                } else { f32x16 o1[4];
#pragma unroll
                    for (int d0 = 0; d0 < 4; ++d0)
#pragma unroll
                        for (int r = 0; r < 16; r += 4) { const f32x4 v = *(const f32x4*)(st + d0 * 16 + r); o1[d0][r] = v[0]; o1[d0][r + 1] = v[1]; o1[d0][r + 2] = v[2]; o1[d0][r + 3] = v[3]; }
                    attn_finalize(A, h, qb, o1, oT, lam); }
            }
        } else {
            const int c = sub / P, p = sub % P; int ta, tb; part_range(W, h, qb, c, P, p, ta, tb);
            attn_pass(lds, A, h, qb, c, ta, tb, win_nw(W, h, c), oT, l, M);
            float* ps = part + (size_t)(tab[512 + idx] + (unsigned)sub) * PART_SLOT_F + tid * PART_F;
#pragma unroll
            for (int d0 = 0; d0 < 4; ++d0)
#pragma unroll
                for (int r = 0; r < 16; r += 4) *(f32x4*)(ps + d0 * 16 + r) = (f32x4){oT[d0][r], oT[d0][r + 1], oT[d0][r + 2], oT[d0][r + 3]};
            *(f32x4*)(ps + 64) = (f32x4){l, M, 0.f, 0.f};
        }
    }
}
__device__ __forceinline__ void attn_combine(__attribute__((address_space(3))) unsigned char* lds, const Args& A, int blk, int nblk, const float* part) {
    const int tid = opq_tid();
    Win W; float lam; attn_windows(A, W, lam);
    (void)attn_table(lds, W);
    volatile __attribute__((address_space(3))) unsigned* tab = (volatile __attribute__((address_space(3))) unsigned*)(lds + TAB_OFF);
    int seen = 0, mine = blk;
    for (int idx = 0; idx < 512; ++idx) {
        const unsigned e = tab[idx]; const int P = (int)(e >> 16); if (P == 0) continue;
        if (seen++ != mine) continue;
        mine += nblk;
        const int h = idx & 7, qb = 63 - (idx >> 3);
        f32x16 o1[4], o2[4];
#pragma unroll 1
        for (int c = 0; c < 2; ++c) {
            const float* ps = part + (size_t)(tab[512 + idx] + (unsigned)(c * P)) * PART_SLOT_F + tid * PART_F;
            float M = -1e30f;
            for (int p = 0; p < P; ++p) M = fmaxf(M, ps[(size_t)p * PART_SLOT_F + 65]);
            float L = 0.f;
#pragma unroll
            for (int d0 = 0; d0 < 4; ++d0)
#pragma unroll
                for (int r = 0; r < 16; ++r) o2[d0][r] = 0.f;
            for (int p = 0; p < P; ++p) { const float* pp = ps + (size_t)p * PART_SLOT_F; const f32x4 lm = *(const f32x4*)(pp + 64); const float f = __builtin_amdgcn_exp2f(lm[1] - M); L += lm[0] * f;
#pragma unroll
                for (int d0 = 0; d0 < 4; ++d0)
#pragma unroll
                    for (int r = 0; r < 16; r += 4) { const f32x4 v = *(const f32x4*)(pp + d0 * 16 + r); o2[d0][r] += v[0] * f; o2[d0][r + 1] += v[1] * f; o2[d0][r + 2] += v[2] * f; o2[d0][r + 3] += v[3] * f; } }
            const float il = 1.0f / swap_sum(L);
            if (c == 0) {
#pragma unroll
                for (int d0 = 0; d0 < 4; ++d0)
#pragma unroll
                    for (int r = 0; r < 16; ++r) o1[d0][r] = o2[d0][r] * il;
            } else {
#pragma unroll
                for (int d0 = 0; d0 < 4; ++d0)
#pragma unroll
                    for (int r = 0; r < 16; ++r) o2[d0][r] *= il;
            }
        }
        attn_finalize(A, h, qb, o1, o2, lam);
    }
}
}

namespace rk {
typedef short bf16x8 __attribute__((ext_vector_type(8)));
typedef short s16x4 __attribute__((ext_vector_type(4)));
typedef short v4i16_t __attribute__((ext_vector_type(4)));
typedef const LAS unsigned char* lcp;
constexpr int ST = 72, MATB = 64 * ST * 2, NST = 68, SLG = 168, SVL = 40;
constexpr int O_AT = 0, O_RT = MATB, O_BT = 2 * MATB, O_KT = 3 * MATB, O_VV = 4 * MATB, O_AAK = 5 * MATB, O_ARB = 6 * MATB, O_ARK = 7 * MATB, O_NN = 8 * MATB, O_GG = O_NN + 64 * NST * 4,
              O_U0T = O_GG, O_WT = O_AAK, O_G2 = O_AAK  , O_VG = O_ARK  , O_SEG = O_GG + 64 * NST * 4, O_GL = O_SEG + 2048,
              O_LW = O_GL + 256, O_LA = O_LW + MATB, O_LG = O_LA + MATB, O_VL = O_LG + 64 * SLG * 2, O_END = O_VL + 64 * SVL * 2;
static_assert(64 * NST * 4 <= 2 * MATB && O_END <= 156000, "stage-1 LDS map");
__device__ __forceinline__ f32x4 mfma16(bf16x8 a, bf16x8 b, f32x4 c) { return __builtin_amdgcn_mfma_f32_16x16x32_bf16(a, b, c, 0, 0, 0); }
__device__ __forceinline__ s16x4 vtr(lcp p) { return __builtin_bit_cast(s16x4, __builtin_amdgcn_ds_read_tr16_b64_v4i16((LAS v4i16_t*)p)); }
__device__ __forceinline__ bf16x8 frag(lcp m, int row0, int ks, int lane, int st = ST) { return *(const LAS bf16x8*)(m + ((row0 + (lane & 15)) * st + 32 * ks + 8 * (lane >> 4)) * 2); }
__device__ __forceinline__ bf16x8 tfrag(lcp m, int c0, int ks, int lane) {
    const int i = lane & 15, q = i >> 2, p = i & 3, k0 = 32 * ks + 8 * (lane >> 4);
    const s16x4 lo = vtr(m + ((k0 + q) * ST + c0 + 4 * p) * 2), hi = vtr(m + ((k0 + 4 + q) * ST + c0 + 4 * p) * 2);
    return (bf16x8){lo[0], lo[1], lo[2], lo[3], hi[0], hi[1], hi[2], hi[3]};
}
__device__ __forceinline__ unsigned pk(float a, float b) { return f2bf(a) | (f2bf(b) << 16); }
#define RK_BAR() do { asm volatile("s_waitcnt lgkmcnt(0)" ::: "memory"); __builtin_amdgcn_s_barrier(); asm volatile("" ::: "memory"); } while (0)


constexpr int SOLVE_DEPTH = 3;
__host__ __device__ constexpr int solve_quads(int p) { return (2 * p + 1 + 3) / 4; }
typedef float f32x2 __attribute__((ext_vector_type(2)));
template <int P, int Q> struct SolveStep {
    static constexpr int NQ = solve_quads(P);
    template <int D, int PP, int QQ> struct Ahead { static constexpr int nxtP = (QQ + 1 < solve_quads(PP)) ? PP : PP + 1, nxtQ = (QQ + 1 < solve_quads(PP)) ? QQ + 1 : 0; using T = typename Ahead<D - 1, nxtP, nxtQ>::T; };
    template <int PP, int QQ> struct Ahead<0, PP, QQ> { using T = SolveStep<PP, QQ>; };
    static __device__ __forceinline__ void load(f32x4 (&ring)[SOLVE_DEPTH][2], int slot, LAS unsigned char* nn) {
        if constexpr (P < 32) { ring[slot][0] = *(const LAS f32x4*)(nn + ((2 * P) * NST + 4 * Q) * 4); ring[slot][1] = *(const LAS f32x4*)(nn + ((2 * P + 1) * NST + 4 * Q) * 4); }
    }
    template <int SLOT> static __device__ __forceinline__ void run(f32x2 (&x)[64], f32x2& a0, f32x2& a1, f32x4 (&ring)[SOLVE_DEPTH][2], LAS unsigned char* nn) {
        using AH = typename Ahead<SOLVE_DEPTH, P, Q>::T;
        const f32x4 n0 = ring[SLOT][0], n1 = ring[SLOT][1];
        asm volatile("" ::: "memory"); __builtin_amdgcn_sched_barrier(0);
        AH::load(ring, SLOT, nn);
        asm volatile("" ::: "memory"); __builtin_amdgcn_sched_barrier(0);
#pragma unroll
        for (int e = 0; e < 4; ++e)
            if (4 * Q + e < 2 * P) { a0 = __builtin_elementwise_fma((f32x2){n0[e], n0[e]}, x[4 * Q + e], a0); a1 = __builtin_elementwise_fma((f32x2){n1[e], n1[e]}, x[4 * Q + e], a1); }
        if constexpr (Q + 1 == NQ) {
            x[2 * P] = a0; asm volatile("" : "+v"(x[2 * P]));
            { constexpr int c = 2 * P, q = c / 4, e = c % 4; static_assert(q == Q, "column 2P lies in the pair's last quad"); a1 = __builtin_elementwise_fma((f32x2){n1[e], n1[e]}, x[c], a1); }
            x[2 * P + 1] = a1; asm volatile("" : "+v"(x[2 * P + 1]));
            if constexpr (P + 1 < 32) { a0 = x[2 * P + 2]; a1 = x[2 * P + 3]; SolveStep<P + 1, 0>::template run<(SLOT + 1) % SOLVE_DEPTH>(x, a0, a1, ring, nn); }
        } else {
            asm volatile("" : "+v"(a0), "+v"(a1));
            SolveStep<P, Q + 1>::template run<(SLOT + 1) % SOLVE_DEPTH>(x, a0, a1, ring, nn);
        }
    }
};

struct S1Args {
    const bf16* rw; const float* mu; const float* w0; const float* a0; const float* v0; const float* k_k; const float* k_a; const float* r_k;
    const bf16* w2t; const bf16* a2t; const bf16* g2t; const bf16* v2t;
    bf16* vfirst; bf16* BV; bf16* GB; bf16* PG; float* QT; bf16* RP; float* Y0; unsigned char* act; int layer; int pad_;
};
constexpr int ACT_LOGW = 0, ACT_AR = 262144, ACT_G = 524288, ACT_VG = 655360, ACT_WG_BYTES = 786432;
__device__ __forceinline__ float frcp(float x) { return __builtin_amdgcn_rcpf(x); }
__device__ __forceinline__ float fsigmoid(float x) { return frcp(1.0f + __expf(-x)); }
__device__ __forceinline__ float ftanh(float x) { const float e = __expf(-2.0f * fabsf(x)), t = (1.0f - e) * frcp(1.0f + e); return x < 0.f ? -t : t; }
__device__ __forceinline__ float ldbf(const bf16* p) { return bf2f(*p); }

__device__ __forceinline__ void stage1_latents(LAS unsigned char* lds, const S1Args& A, int t0) {
    const int tid = opq_tid();
#pragma unroll 1
    for (int bt = 0; bt < 5; ++bt) {
        float cur[8], prv[8], muv[8];
#pragma unroll
        for (int i = 0; i < 8; ++i) { const int idx = tid + 512 * (bt * 8 + i), tok = idx / 320, col = idx % 320, t = t0 + tok;
            const bf16* p = A.rw + (size_t)t * RWP + 3072 + col;
            cur[i] = ldbf(p); prv[i] = t > 0 ? ldbf(p - RWP + (col < 288 ? 0 : 32)) : 0.f; muv[i] = col < 288 ? A.mu[3072 + col] : 0.f; }
#pragma unroll
        for (int i = 0; i < 8; ++i) { const int idx = tid + 512 * (bt * 8 + i), tok = idx / 320, col = idx % 320;
            if (col < 288) { const float sft = cur[i] + muv[i] * (prv[i] - cur[i]);
                if (col < 64) *(LAS unsigned short*)(lds + O_LW + (tok * ST + col) * 2) = (unsigned short)f2bf(ftanh(sft));
                else if (col < 128) *(LAS unsigned short*)(lds + O_LA + (tok * ST + col - 64) * 2) = (unsigned short)f2bf(sft);
                else *(LAS unsigned short*)(lds + O_LG + (tok * SLG + col - 128) * 2) = (unsigned short)f2bf(fsigmoid(sft));
            } else *(LAS unsigned short*)(lds + O_VL + (tok * SVL + col - 288) * 2) = (unsigned short)f2bf(cur[i] + prv[i]); }
    }
}

struct LoraB { bf16x8 w[2], a[2], g[5], v; f32x4 w0c, a0c, v0c; };
__device__ __forceinline__ void lora_load(LoraB& B, const S1Args& A, int it, int lane) {
    const int rq = lane >> 4, l15 = lane & 15, ch0 = 16 * it, ch = ch0 + l15;
    const bf16* pw = A.w2t + (size_t)ch * 64 + 8 * rq; const bf16* pa = A.a2t + (size_t)ch * 64 + 8 * rq; const bf16* pg = A.g2t + (size_t)ch * 160 + 8 * rq; const bf16* pv = A.v2t + (size_t)ch * 32 + 8 * rq;
    B.w[0] = *(const bf16x8*)pw; B.w[1] = *(const bf16x8*)(pw + 32); B.a[0] = *(const bf16x8*)pa; B.a[1] = *(const bf16x8*)(pa + 32); B.v = *(const bf16x8*)pv;
#pragma unroll
    for (int ks = 0; ks < 5; ++ks) B.g[ks] = *(const bf16x8*)(pg + 32 * ks);
    B.w0c = *(const f32x4*)(A.w0 + ch0 + 4 * rq); B.a0c = *(const f32x4*)(A.a0 + ch0 + 4 * rq); B.v0c = *(const f32x4*)(A.v0 + ch0 + 4 * rq);
}
__device__ __forceinline__ void lora_item(LAS unsigned char* lds, const LoraB& B, const S1Args& A, int it, int lane) {
    const int rq = lane >> 4, l15 = lane & 15, h = it >> 2, j0 = 16 * (it & 3) + 4 * rq;
#pragma unroll 1
    for (int tb = 0; tb < 4; ++tb) {
        const f32x4 z = {0.f, 0.f, 0.f, 0.f};
        const f32x4 zw = mfma16(B.w[1], frag(lds + O_LW, 16 * tb, 1, lane), mfma16(B.w[0], frag(lds + O_LW, 16 * tb, 0, lane), z));
        const f32x4 za = mfma16(B.a[1], frag(lds + O_LA, 16 * tb, 1, lane), mfma16(B.a[0], frag(lds + O_LA, 16 * tb, 0, lane), z));
        const f32x4 zv = mfma16(B.v, frag(lds + O_VL, 16 * tb, 0, lane, SVL), z);
        f32x4 zg = z;
#pragma unroll
        for (int ks = 0; ks < 5; ++ks) zg = mfma16(B.g[ks], frag(lds + O_LG, 16 * tb, ks, lane, SLG), zg);
        const int o = (h * 64 + 16 * tb + l15) * 64 + j0;
        f32x4 lo_, ar_; u32x2 gg_, vg_; float vgf[4];
#pragma unroll
        for (int e = 0; e < 4; ++e) {
            const float zz = -(B.w0c[e] + zw[e]), sp = fmaxf(zz, 0.f) + __logf(1.0f + __expf(-fabsf(zz))), wl = -sp - 0.5f;
            lo_[e] = -__expf(wl);
            ar_[e] = fsigmoid(B.a0c[e] + za[e]);
            vgf[e] = fsigmoid(B.v0c[e] + zv[e]);
        }
        gg_.x = pk(zg[0], zg[1]); gg_.y = pk(zg[2], zg[3]); vg_.x = pk(vgf[0], vgf[1]); vg_.y = pk(vgf[2], vgf[3]);
        *(f32x4*)(A.act + ACT_LOGW + o * 4) = lo_; *(f32x4*)(A.act + ACT_AR + o * 4) = ar_; *(u32x2*)(A.act + ACT_G + o * 2) = gg_; *(u32x2*)(A.act + ACT_VG + o * 2) = vg_;
    }
}
__device__ __forceinline__ void stage1_lora_all(LAS unsigned char* lds, const S1Args& A) {
    const int tid = opq_tid(), lane = tid & 63, wid = __builtin_amdgcn_readfirstlane(tid >> 6);
    LoraB B0, B1;
    lora_load(B0, A, wid, lane);
#pragma unroll 1
    for (int k = 0; k < 8; k += 2) {
        lora_load(B1, A, wid + 8 * (k + 1), lane);
        lora_item(lds, B0, A, wid + 8 * k, lane);
        if (k + 2 < 8) lora_load(B0, A, wid + 8 * (k + 2), lane);
        lora_item(lds, B1, A, wid + 8 * (k + 1), lane);
    }
}
struct PreF { unsigned short r[9], k[9], v[9], vf[8], g[8], vg[8]; float lw[8], ar[8], mur, muk, muv, kkw, kaw, rkw; };
__device__ __forceinline__ void pref_load(PreF& P, const S1Args& A, int c, int h, int wid, int lane) {
    const int ch = h * 64 + lane, tf = c * 64 + 8 * wid;
    P.mur = A.mu[ch]; P.muk = A.mu[1024 + ch]; P.muv = A.mu[2048 + ch]; P.kkw = A.k_k[ch]; P.kaw = A.k_a[ch]; P.rkw = A.r_k[ch];
    const bf16* rp = A.rw + (size_t)tf * RWP + ch;
    if (tf > 0) { P.r[0] = rp[-RWP]; P.k[0] = rp[-RWP + 1024]; P.v[0] = rp[-RWP + 2048]; } else { P.r[0] = 0; P.k[0] = 0; P.v[0] = 0; }
#pragma unroll
    for (int e = 0; e < 8; ++e) { P.r[e + 1] = rp[(size_t)e * RWP]; P.k[e + 1] = rp[(size_t)e * RWP + 1024]; P.v[e + 1] = rp[(size_t)e * RWP + 2048];
        const int o = (h * 64 + 8 * wid + e) * 64 + lane;
        P.lw[e] = *(const float*)(A.act + ACT_LOGW + o * 4); P.ar[e] = *(const float*)(A.act + ACT_AR + o * 4); P.g[e] = *(const bf16*)(A.act + ACT_G + o * 2); P.vg[e] = *(const bf16*)(A.act + ACT_VG + o * 2);
        P.vf[e] = A.layer > 0 ? A.vfirst[(size_t)(tf + e) * 1024 + ch] : (unsigned short)0; }
}

__device__ __forceinline__ void stage1_unit(LAS unsigned char* lds, const S1Args& A, int c, int h, PreF& P) {
    const int tid = opq_tid(), lane = tid & 63, wid = __builtin_amdgcn_readfirstlane(tid >> 6), rq = lane >> 4, l15 = lane & 15;
    const int t0 = c * 64, uc = h * 256 + c;
    const int b0 = wid >> 1;
    LAS float* SEG = (LAS float*)(lds + O_SEG); LAS float* GL = (LAS float*)(lds + O_GL);
    {
        const int j = lane, ch = h * 64 + j; float lw[8], cum[8], va[8], vb[8], vk[8], vr_[8], vv[8];
        const float mur = P.mur, muk = P.muk, muv = P.muv, kkw = P.kkw, kaw = P.kaw, rkw = P.rkw;
        const int tf = t0 + 8 * wid;
#pragma unroll
        for (int e = 0; e < 8; ++e) {
            const float cr = bf2f(P.r[e + 1]), ck = bf2f(P.k[e + 1]), cv = bf2f(P.v[e + 1]), pr = bf2f(P.r[e]), pk_ = bf2f(P.k[e]), pv = bf2f(P.v[e]);
            const float r = cr + mur * (pr - cr), kr = ck + muk * (pk_ - ck), vr = cv + muv * (pv - cv);
            lw[e] = P.lw[e];
            const float ar = P.ar[e], g = bf2f(P.g[e]), vg = bf2f(P.vg[e]);
            const float kkv = kr * kkw, ss = wave_sum(kkv * kkv), kk = kkv * __builtin_amdgcn_rsqf(fmaxf(ss, 1e-24f));
            va[e] = -kk; vb[e] = kk * ar; vk[e] = kr * (1.0f + (ar - 1.0f) * kaw); vr_[e] = r;
            const size_t go = (size_t)(tf + e) * 1024 + ch;
            float v;
            if (A.layer == 0) { v = vr; A.vfirst[go] = (bf16)f2bf(vr); } else { v = vr + (bf2f(P.vf[e]) - vr) * vg; }
            vv[e] = v;
            const float bonus = wave_sum(r * vk[e] * rkw);
            A.BV[go] = (bf16)f2bf(bonus * v); A.GB[go] = (bf16)f2bf(g);
        }
        cum[0] = lw[0];
#pragma unroll
        for (int e = 1; e < 8; ++e) cum[e] = cum[e - 1] + lw[e];
        SEG[wid * 64 + j] = cum[7];
        RK_BAR();
        float off = 0.f, tot = 0.f;
#pragma unroll
        for (int s = 0; s < 8; ++s) { const float v = SEG[s * 64 + j]; off += (s < wid) ? v : 0.f; tot += v; }
        if (wid == 0) GL[j] = __expf(tot);
        float gprev = __expf(off);
#pragma unroll
        for (int e = 0; e < 8; ++e) {
            const float cm = cum[e] + off, g = __expf(cm), gi = frcp(g), gp = gprev; gprev = g;
            const int o = ((8 * wid + e) * ST + j) * 2;
            *(LAS unsigned short*)(lds + O_AT + o) = (unsigned short)f2bf(va[e] * gp);
            *(LAS unsigned short*)(lds + O_BT + o) = (unsigned short)f2bf(vb[e] * gi);
            *(LAS unsigned short*)(lds + O_KT + o) = (unsigned short)f2bf(vk[e] * gi);
            *(LAS unsigned short*)(lds + O_RT + o) = (unsigned short)f2bf(vr_[e] * g);
            *(LAS unsigned short*)(lds + O_VV + o) = (unsigned short)f2bf(vv[e]);
        }
        RK_BAR();
    }
    {
        const bf16x8 bA0 = frag(lds + O_BT, 16 * b0, 0, lane), bA1 = frag(lds + O_BT, 16 * b0, 1, lane), kA0 = frag(lds + O_KT, 16 * b0, 0, lane), kA1 = frag(lds + O_KT, 16 * b0, 1, lane);
#pragma unroll
        for (int tt = 0; tt < 2; ++tt) {
            const int tb = 2 * (wid & 1) + tt;
            const bf16x8 aB0 = frag(lds + O_AT, 16 * tb, 0, lane), aB1 = frag(lds + O_AT, 16 * tb, 1, lane), rB0 = frag(lds + O_RT, 16 * tb, 0, lane), rB1 = frag(lds + O_RT, 16 * tb, 1, lane);
            const f32x4 z = {0.f, 0.f, 0.f, 0.f};
            f32x4 ab = mfma16(bA1, aB1, mfma16(bA0, aB0, z)), ak = mfma16(kA1, aB1, mfma16(kA0, aB0, z)), rb = mfma16(bA1, rB1, mfma16(bA0, rB0, z)), rk_ = mfma16(kA1, rB1, mfma16(kA0, rB0, z));
            const int tcol = 16 * tb + l15, srow = 16 * b0 + 4 * rq;
#pragma unroll
            for (int e = 0; e < 4; ++e) { const bool st = tcol > srow + e, le = tcol >= srow + e; ab[e] = st ? ab[e] : 0.f; ak[e] = st ? ak[e] : 0.f; rb[e] = le ? rb[e] : 0.f; rk_[e] = le ? rk_[e] : 0.f; }
            *(LAS f32x4*)(lds + O_NN + (tcol * NST + srow) * 4) = ab;
            const int o = (tcol * ST + srow) * 2;
            *(LAS u32x2*)(lds + O_AAK + o) = (u32x2){pk(ak[0], ak[1]), pk(ak[2], ak[3])};
            *(LAS u32x2*)(lds + O_ARB + o) = (u32x2){pk(rb[0], rb[1]), pk(rb[2], rb[3])};
            *(LAS u32x2*)(lds + O_ARK + o) = (u32x2){pk(rk_[0], rk_[1]), pk(rk_[2], rk_[3])};
        }
        RK_BAR();
    }
    {
        const bf16x8 vA0 = tfrag(lds + O_VV, 16 * b0, 0, lane), vA1 = tfrag(lds + O_VV, 16 * b0, 1, lane);
#pragma unroll
        for (int tt = 0; tt < 2; ++tt) {
            const int tb = 2 * (wid & 1) + tt;
            const f32x4 z = {0.f, 0.f, 0.f, 0.f};
            const f32x4 g = mfma16(vA1, frag(lds + O_AAK, 16 * tb, 1, lane), mfma16(vA0, frag(lds + O_AAK, 16 * tb, 0, lane), z));
            *(LAS f32x4*)(lds + O_GG + ((16 * tb + l15) * NST + 16 * b0 + 4 * rq) * 4) = g;
        }
        RK_BAR();
    }
    if (wid == 0) {
        f32x2 x[64];
#pragma unroll
        for (int t = 0; t < 64; ++t) x[t] = (f32x2){bf2f(*(const LAS unsigned short*)(lds + O_AT + (t * ST + lane) * 2)), *(const LAS float*)(lds + O_GG + (t * NST + lane) * 4)};
        LAS unsigned char* nn = lds + O_NN; asm volatile("" : "+v"(nn));
        f32x4 ring[SOLVE_DEPTH][2];
        SolveStep<0, 0>::load(ring, 0, nn); SolveStep<1, 0>::load(ring, 1, nn); SolveStep<2, 0>::load(ring, 2, nn);
        { f32x2 a0 = x[0], a1 = x[1]; SolveStep<0, 0>::run<0>(x, a0, a1, ring, nn); }
        LAS unsigned char* dw = lds + O_WT + lane * ST * 2; LAS unsigned char* du = lds + O_U0T + lane * ST * 2;
#pragma unroll
        for (int i = 0; i < 8; ++i) {
            *(LAS u32x4*)(dw + i * 16) = (u32x4){pk(x[8 * i].x, x[8 * i + 1].x), pk(x[8 * i + 2].x, x[8 * i + 3].x), pk(x[8 * i + 4].x, x[8 * i + 5].x), pk(x[8 * i + 6].x, x[8 * i + 7].x)};
            *(LAS u32x4*)(du + i * 16) = (u32x4){pk(x[8 * i].y, x[8 * i + 1].y), pk(x[8 * i + 2].y, x[8 * i + 3].y), pk(x[8 * i + 4].y, x[8 * i + 5].y), pk(x[8 * i + 6].y, x[8 * i + 7].y)}; }
    }
    if (h + 1 < 16) { const int tid2 = opq_tid(); pref_load(P, A, c, h + 1, __builtin_amdgcn_readfirstlane(tid2 >> 6), tid2 & 63); }
    RK_BAR();
    {
        const int tid = opq_tid(), lane = tid & 63, wid = __builtin_amdgcn_readfirstlane(tid >> 6), rq = lane >> 4, l15 = lane & 15, b0 = wid >> 1;
        const bf16x8 wA0 = frag(lds + O_WT, 16 * b0, 0, lane), wA1 = frag(lds + O_WT, 16 * b0, 1, lane);
        const bf16x8 uA0 = frag(lds + O_U0T, 16 * b0, 0, lane), uA1 = frag(lds + O_U0T, 16 * b0, 1, lane);
        const bf16x8 vA0 = tfrag(lds + O_VV, 16 * b0, 0, lane), vA1 = tfrag(lds + O_VV, 16 * b0, 1, lane);
        const bf16x8 bA0 = tfrag(lds + O_BT, 16 * b0, 0, lane), bA1 = tfrag(lds + O_BT, 16 * b0, 1, lane);
        const bf16x8 kA0 = tfrag(lds + O_KT, 16 * b0, 0, lane), kA1 = tfrag(lds + O_KT, 16 * b0, 1, lane);
        const f32x4 glr = *(const LAS f32x4*)(lds + O_GL + (16 * b0 + 4 * rq) * 4);
#pragma unroll
        for (int tt = 0; tt < 2; ++tt) {
            const int nb = 2 * (wid & 1) + tt, col = 16 * nb + l15, row = 16 * b0 + 4 * rq;
            const f32x4 z = {0.f, 0.f, 0.f, 0.f};
            const bf16x8 rbB0 = frag(lds + O_ARB, 16 * nb, 0, lane), rbB1 = frag(lds + O_ARB, 16 * nb, 1, lane), rkB0 = frag(lds + O_ARK, 16 * nb, 0, lane), rkB1 = frag(lds + O_ARK, 16 * nb, 1, lane);
            { f32x4 d = mfma16(wA1, rbB1, mfma16(wA0, rbB0, z)); const u32x2 rt = *(const LAS u32x2*)(lds + O_RT + (col * ST + row) * 2);
              d[0] += bflo(rt.x); d[1] += bfhi(rt.x); d[2] += bflo(rt.y); d[3] += bfhi(rt.y);
              *(u32x2*)(A.RP + (size_t)(t0 + col) * 1024 + h * 64 + row) = (u32x2){pk(d[0], d[1]), pk(d[2], d[3])}; }
            { const f32x4 d = mfma16(vA1, rkB1, mfma16(vA0, rkB0, mfma16(uA1, rbB1, mfma16(uA0, rbB0, z))));
              *(f32x4*)(A.Y0 + (size_t)(t0 + col) * 1024 + h * 64 + row) = d; }
            { const bf16x8 bB0 = tfrag(lds + O_BT, 16 * nb, 0, lane), bB1 = tfrag(lds + O_BT, 16 * nb, 1, lane);
              f32x4 d = mfma16(wA1, bB1, mfma16(wA0, bB0, z)); const float gj = GL[col];
#pragma unroll
              for (int e = 0; e < 4; ++e) d[e] = gj * (d[e] + ((row + e) == col ? 1.f : 0.f));
              *(u32x2*)(A.PG + (size_t)uc * 4096 + ((((col >> 4) * 2 + (row >> 5)) * 64 + ((row >> 2) & 3) * 16 + (col & 15)) * 8 + ((row >> 4) & 1) * 4)) = (u32x2){pk(d[0], d[1]), pk(d[2], d[3])}; }
            { const bf16x8 uB0 = frag(lds + O_U0T, 16 * nb, 0, lane), uB1 = frag(lds + O_U0T, 16 * nb, 1, lane), vB0 = tfrag(lds + O_VV, 16 * nb, 0, lane), vB1 = tfrag(lds + O_VV, 16 * nb, 1, lane);
              f32x4 d = mfma16(kA1, vB1, mfma16(kA0, vB0, mfma16(bA1, uB1, mfma16(bA0, uB0, z))));
              d = d * glr;
              *(f32x4*)(A.QT + (size_t)uc * 4096 + ((((col >> 4) * 4 + (row >> 4)) * 64 + ((row >> 2) & 3) * 16 + (col & 15)) * 4)) = d; }
        }
    }
    RK_BAR();
}
__device__ __forceinline__ void ph_stage1(LAS unsigned char* lds, const S1Args& A, int blk, int nblk) {
    for (int c = blk; c < 256; c += nblk) {
        stage1_latents(lds, A, c * 64);
        RK_BAR();
        stage1_lora_all(lds, A);
        asm volatile("s_waitcnt vmcnt(0)" ::: "memory");
        RK_BAR();
        PreF P; { const int tid = opq_tid(); pref_load(P, A, c, 0, __builtin_amdgcn_readfirstlane(tid >> 6), tid & 63); }
#pragma unroll 1
        for (int h = 0; h < 16; ++h) stage1_unit(lds, A, c, h, P);
    }
}

struct ChainOps { bf16x8 a[4][2]; f32x4 c[4]; };
__device__ __forceinline__ void chain_load(ChainOps& o, const bf16* __restrict__ PG, const float* __restrict__ QT, int h, int ig, int c, int lane) {
    const bf16* P = PG + (size_t)(h * 256 + c) * 4096 + lane * 8; const float* Q = QT + (size_t)(h * 256 + c) * 4096 + (ig * 4 * 64 + lane) * 4;
#pragma unroll
    for (int m = 0; m < 4; ++m) { o.c[m] = *(const f32x4*)(Q + m * 256);
#pragma unroll
        for (int kb = 0; kb < 2; ++kb) o.a[m][kb] = *(const bf16x8*)(P + (m * 2 + kb) * 512); }
}
__device__ __forceinline__ void chain_step(f32x4 (&H)[4], const ChainOps& o, bf16* __restrict__ H0T, int h, int ig, int c, int lane) {
    const int fr = lane & 15, fq = lane >> 4;
    bf16* Ho = H0T + (size_t)(c * 16 + h) * 4096 + (16 * ig + fr) * 64 + 4 * fq;
    u32x4 bw[2];
#pragma unroll
    for (int m = 0; m < 4; ++m) { const u32x2 w = {pk(H[m][0], H[m][1]), pk(H[m][2], H[m][3])}; *(u32x2*)(Ho + 16 * m) = w; bw[m >> 1][2 * (m & 1)] = w.x; bw[m >> 1][2 * (m & 1) + 1] = w.y; }
#pragma unroll
    for (int m = 0; m < 4; ++m) H[m] = mfma16(o.a[m][1], __builtin_bit_cast(bf16x8, bw[1]), mfma16(o.a[m][0], __builtin_bit_cast(bf16x8, bw[0]), o.c[m]));
}
__device__ __forceinline__ void chain_wave(const bf16* __restrict__ PG, const float* __restrict__ QT, bf16* __restrict__ H0T, int h, int ig, int lane) {
    f32x4 H[4];
#pragma unroll
    for (int m = 0; m < 4; ++m) H[m] = (f32x4){0.f, 0.f, 0.f, 0.f};
    ChainOps s0, s1, s2, s3;
    chain_load(s0, PG, QT, h, ig, 0, lane); chain_load(s1, PG, QT, h, ig, 1, lane); chain_load(s2, PG, QT, h, ig, 2, lane); chain_load(s3, PG, QT, h, ig, 3, lane);
#pragma unroll 1
    for (int c = 0; c < 256; c += 4) {
        const bool more = c + 4 < 256;
        chain_step(H, s0, H0T, h, ig, c, lane);     if (more) chain_load(s0, PG, QT, h, ig, c + 4, lane);
        chain_step(H, s1, H0T, h, ig, c + 1, lane); if (more) chain_load(s1, PG, QT, h, ig, c + 5, lane);
        chain_step(H, s2, H0T, h, ig, c + 2, lane); if (more) chain_load(s2, PG, QT, h, ig, c + 6, lane);
        chain_step(H, s3, H0T, h, ig, c + 3, lane); if (more) chain_load(s3, PG, QT, h, ig, c + 7, lane);
    }
}
__device__ __forceinline__ void ph_chain(const bf16* PG, const float* QT, bf16* H0T, int blk, int nblk) {
    const int tid = opq_tid(), lane = tid & 63;
    for (int gw = blk * 8 + (tid >> 6); gw < 64; gw += nblk * 8) chain_wave(PG, QT, H0T, gw >> 2, gw & 3, lane);
}

struct S3Args { const bf16* H0T; const bf16* RP; const float* Y0; const bf16* BV; const bf16* GB; const float* ln_w; const float* ln_b; bf16* mixed; };
__device__ __forceinline__ void ph_stage3(const S3Args& A, int blk, int nblk) {
    const int tid = opq_tid(), lane = tid & 63, fr = lane & 15, fq = lane >> 4;
    for (int it = blk * 8 + (tid >> 6); it < 4096 * 4; it += nblk * 8) {
        const int u = it >> 2, tb = it & 3, c = u >> 4, h = u & 15, t = 64 * c + 16 * tb + fr;
        const bf16* Hp = A.H0T + (size_t)u * 4096 + fr * 64 + 8 * fq; const bf16* Rp = A.RP + (size_t)t * 1024 + h * 64 + 8 * fq;
        const bf16x8 r0 = *(const bf16x8*)Rp, r1 = *(const bf16x8*)(Rp + 32);
        f32x4 y[4];
#pragma unroll
        for (int ib = 0; ib < 4; ++ib) { const f32x4 y0 = *(const f32x4*)(A.Y0 + (size_t)t * 1024 + h * 64 + 16 * ib + 4 * fq);
            y[ib] = mfma16(*(const bf16x8*)(Hp + ib * 1024 + 32), r1, mfma16(*(const bf16x8*)(Hp + ib * 1024), r0, y0)); }
        float s = 0.f;
#pragma unroll
        for (int ib = 0; ib < 4; ++ib) s += (y[ib][0] + y[ib][1]) + (y[ib][2] + y[ib][3]);
        s += __shfl_xor(s, 16); s += __shfl_xor(s, 32);
        const float mean = s * (1.0f / 64.0f); float q = 0.f;
#pragma unroll
        for (int ib = 0; ib < 4; ++ib)
#pragma unroll
            for (int e = 0; e < 4; ++e) { const float d = y[ib][e] - mean; y[ib][e] = d; q += d * d; }
        q += __shfl_xor(q, 16); q += __shfl_xor(q, 32);
        const float rstd = 1.0f / sqrtf(q * (1.0f / 64.0f) + GN_EPS);
#pragma unroll
        for (int ib = 0; ib < 4; ++ib) { const int ch = h * 64 + 16 * ib + 4 * fq; const size_t o = (size_t)t * 1024 + ch;
            const f32x4 lw = *(const f32x4*)(A.ln_w + ch), lb = *(const f32x4*)(A.ln_b + ch); const u32x2 bv = *(const u32x2*)(A.BV + o), gg = *(const u32x2*)(A.GB + o); f32x4 r;
            const float bvf[4] = {bflo(bv.x), bfhi(bv.x), bflo(bv.y), bfhi(bv.y)}, ggf[4] = {bflo(gg.x), bfhi(gg.x), bflo(gg.y), bfhi(gg.y)};
#pragma unroll
            for (int e = 0; e < 4; ++e) r[e] = (y[ib][e] * rstd * lw[e] + lb[e] + bvf[e]) * ggf[e];
            *(u32x2*)(A.mixed + (size_t)t * DM + 1024 + ch) = (u32x2){pk(r[0], r[1]), pk(r[2], r[3])}; }
    }
}
}
#define XB_TMO      128
#define XB_XCNT(j)  (256  + 64 * (j))
#define XB_XSUB(j)  (1280 + 64 * (j))
#define XB_XGEN(j)  (2304 + 64 * (j))
#define XB_TOP      3328
#define XB_TOPGEN   3392
#define XCD_BAR_WORDS 3456
#define XB_SPIN_CAP (1u << 22)

__device__ __forceinline__ unsigned xb_ld(unsigned* p)              { return __hip_atomic_load(p, __ATOMIC_RELAXED, __HIP_MEMORY_SCOPE_AGENT); }
__device__ __forceinline__ unsigned xb_add(unsigned* p, unsigned v) { return __hip_atomic_fetch_add(p, v, __ATOMIC_RELAXED, __HIP_MEMORY_SCOPE_AGENT); }
__device__ __forceinline__ unsigned xb_xcc_id() { return (unsigned)__builtin_amdgcn_s_getreg((3 << 11) | 20) & 0xFu; }
#define XB_SPIN(cond, bar) do { unsigned _sp = 0; while (cond) { __builtin_amdgcn_s_sleep(1); \
    if ((++_sp & 255u) == 0u) { if (xb_ld(&(bar)[XB_TMO])) break; if (_sp > XB_SPIN_CAP) { atomicAdd(&(bar)[XB_TMO], 1u); break; } } } } while (0)

struct XcdBarrier {
    unsigned* bar; unsigned x;
    volatile LAS unsigned* st;
};

__device__ __forceinline__ XcdBarrier xcd_barrier_post(unsigned* bar, volatile LAS unsigned* st) {
    XcdBarrier b; b.bar = bar; b.x = xb_xcc_id(); b.st = st;
    if (threadIdx.x == 0) (void)xb_add(&bar[XB_XCNT(b.x)], 1u);
    return b;
}
__device__ __forceinline__ void xcd_barrier_complete(unsigned* bar, unsigned x, unsigned& nloc, unsigned& nx) {
    const unsigned G = gridDim.x * gridDim.y * gridDim.z;
    unsigned sum, cnt, mine, sp = 0u;
    for (;;) {
        sum = 0u; cnt = 0u; mine = 0u;
#pragma unroll
        for (unsigned j = 0; j < 16; ++j) { const unsigned c = xb_ld(&bar[XB_XCNT(j)]); sum += c; cnt += (c > 0u) ? 1u : 0u; mine = (j == x) ? c : mine; }
        if (sum == G) break;
        __builtin_amdgcn_s_sleep(1);
        if ((++sp & 255u) == 0u) { if (xb_ld(&bar[XB_TMO])) break; if (sp > XB_SPIN_CAP) { atomicAdd(&bar[XB_TMO], 1u); break; } }
    }
    nloc = mine > 0u ? mine : 1u; nx = cnt > 0u ? cnt : 1u;
}

__device__ __forceinline__ void xcd_barrier(const XcdBarrier& b) {
    asm volatile("s_waitcnt vmcnt(0)" ::: "memory");
    __syncthreads();
    if (threadIdx.x == 0) {
        unsigned* bar = b.bar;
        __builtin_amdgcn_s_waitcnt(0);
        unsigned nloc = b.st[0], nx = b.st[1];
        if (nloc == 0u) { xcd_barrier_complete(bar, b.x, nloc, nx); b.st[0] = nloc; b.st[1] = nx; }
        const unsigned old = xb_add(&bar[XB_XSUB(b.x)], 1u);
        const unsigned gen = old / nloc;
        if (old + 1u == (gen + 1u) * nloc) {
            __builtin_amdgcn_fence(__ATOMIC_RELEASE, "agent");
            asm volatile("s_waitcnt vmcnt(0)" ::: "memory");
            const unsigned og = xb_add(&bar[XB_TOP], 1u);
            const unsigned tg = og / nx;
            if (og + 1u == (tg + 1u) * nx) xb_add(&bar[XB_TOPGEN], 1u);
            else XB_SPIN(xb_ld(&bar[XB_TOPGEN]) == tg, bar);
            __builtin_amdgcn_fence(__ATOMIC_ACQUIRE, "agent");
            xb_add(&bar[XB_XGEN(b.x)], 1u);
            asm volatile("s_waitcnt vmcnt(0)" ::: "memory");
        } else {
            XB_SPIN(xb_ld(&bar[XB_XGEN(b.x)]) == gen, bar);
            __builtin_amdgcn_fence(__ATOMIC_ACQUIRE, "agent");
            asm volatile("s_waitcnt vmcnt(0)" ::: "memory");
        }
    }
    __syncthreads();
}

constexpr size_t MiB = 1u << 20;
constexpr size_t WS_CTL = 0, CTL_ZERO_BYTES = 64 * 1024, WS_SSQA = 1016 * MiB, WS_SSQB = 1018 * MiB,      WS_WIN = 2 * MiB, WS_WOUT = 28 * MiB, WS_WUP = 36 * MiB, WS_WDOWN = 68 * MiB, WS_LORA = 100 * MiB, WS_XB = 102 * MiB,
                 WS_Q = 166 * MiB, WS_K = 198 * MiB, WS_V = 230 * MiB, WS_RW = 262 * MiB, WS_MIXED = 374 * MiB, WS_U = 166 * MiB, WS_VFIRST = 438 * MiB, WS_PG = 470 * MiB, WS_QT = 502 * MiB, WS_RP = 566 * MiB,
                 WS_Y0 = 598 * MiB, WS_H0T = 662 * MiB, WS_BV = 694 * MiB, WS_GB = 726 * MiB, WS_STASH = 758 * MiB, WS_PART = 790 * MiB, WS_END = 1020 * MiB;
constexpr size_t LORA_W2 = 0, LORA_A2 = 1024 * 64 * 2, LORA_G2 = 2 * 1024 * 64 * 2, LORA_V2 = LORA_G2 + 1024 * 160 * 2;
constexpr int CW_BAR = 1024, CW_ATTQ = 512;
constexpr int RING_BYTES = 131072, MISC_OFF = 156000, LDS_BYTES = 156672;

struct Args { const float* in[26]; float* out; unsigned char* ws; int ph_lo, ph_hi; float lam_init[4]; };

struct ConvItem { const float* src; bf16* dst; const float* g; int K, N, k0, c0; bool permin, skipx; };
__device__ __forceinline__ void conv_item(ConvItem& I, const __attribute__((address_space(4))) Args* a, unsigned char* ws, int l, int it) {
    constexpr int I_IN = (DM / 64) * (NIN / 64), I_OUT = (DM / 64) * (DM / 64), I_UP = (DM / 64) * (DFF / 64);
    int r = it, nkbs;
    if (r < I_IN) { I.src = a->in[3] + (size_t)l * DM * PW; I.dst = (bf16*)(ws + WS_WIN); I.g = a->in[1] + (size_t)l * DM; I.K = DM; I.N = PW; nkbs = 5; I.permin = true; I.skipx = l > 0; }
    else if ((r -= I_IN) < I_OUT) { I.src = a->in[4] + (size_t)l * DM * DM; I.dst = (bf16*)(ws + WS_WOUT); I.g = nullptr; I.K = DM; I.N = DM; nkbs = 5; I.permin = false; I.skipx = false; }
    else if ((r -= I_OUT) < I_UP) { I.src = a->in[24] + (size_t)l * DM * DFF; I.dst = (bf16*)(ws + WS_WUP); I.g = a->in[2] + (size_t)l * DM; I.K = DM; I.N = DFF; nkbs = 5; I.permin = false; I.skipx = false; }
    else { r -= I_UP; I.src = a->in[25] + (size_t)l * DFF * DM; I.dst = (bf16*)(ws + WS_WDOWN); I.g = nullptr; I.K = DFF; I.N = DM; nkbs = 7; I.permin = false; I.skipx = false; }
    I.k0 = (r & ((1 << nkbs) - 1)) * 64; I.c0 = (r >> nkbs) * 64;
}
__device__ __forceinline__ void conv_load(const ConvItem& I, float (&v)[8], float (&gv)[8], int tid) {
#pragma unroll
    for (int i = 0; i < 8; ++i) { const int idx = tid + 512 * i, kk = idx >> 6, cc = idx & 63, cp = I.c0 + cc; int col = cp;
        if (I.permin) { const int lo = cp & 255, bj = lo >> 7, wc = (lo >> 5) & 3, j = lo & 31; col = (cp & ~255) + 64 * wc + 32 * bj + j; }
        const bool ok = col < I.N;
        v[i] = ok ? I.src[(size_t)(I.k0 + kk) * I.N + col] : 0.f; gv[i] = I.g ? I.g[I.k0 + kk] : 1.0f; }
}
__device__ __forceinline__ void ph_convw(LAS unsigned char* lds, const __attribute__((address_space(4))) Args* a, int l, int blk, int nblk) {
    LAS float* tile = (LAS float*)lds; unsigned char* ws = a->ws; const int tid = opq_tid();
    constexpr int NITEM = (DM / 64) * (NIN / 64) + (DM / 64) * (DM / 64) + (DM / 64) * (DFF / 64) + (DFF / 64) * (DM / 64);
    ConvItem I0, I1, I2; float v0[8], v1[8], v2[8], g0[8], g1[8], g2[8];
    int it = blk;
    if (it < NITEM) { conv_item(I0, a, ws, l, it); conv_load(I0, v0, g0, tid); }
    if (it + nblk < NITEM) { conv_item(I1, a, ws, l, it + nblk); conv_load(I1, v1, g1, tid); }
    int par = 0;
#define CONV_STEP(IC, VC, GC, IN_, VN_, GN_) do { \
        LAS float* tl = tile + par * (64 * 65); par ^= 1; \
        _Pragma("unroll") for (int i = 0; i < 8; ++i) { const int idx = tid + 512 * i; tl[(idx >> 6) * 65 + (idx & 63)] = VC[i] * GC[i]; } \
        if (it + 2 * nblk < NITEM) { conv_item(IN_, a, ws, l, it + 2 * nblk); conv_load(IN_, VN_, GN_, tid); } \
        __syncthreads(); \
        { const int cc = tid >> 3, k8 = (tid & 7) * 8, cp = IC.c0 + cc; \
          if (!(IC.permin && IC.skipx && ((cp >= 6432 && cp < 6464) || (cp >= 6528 && cp < 6560)))) {        \
              u32x4 w; \
              _Pragma("unroll") for (int e = 0; e < 4; ++e) w[e] = f2bf(tl[(k8 + 2 * e) * 65 + cc]) | (f2bf(tl[(k8 + 2 * e + 1) * 65 + cc]) << 16); \
              *(u32x4*)(IC.dst + (size_t)cp * IC.K + IC.k0 + k8) = w; } } \
        it += nblk; } while (0)
    while (it < NITEM) {
        CONV_STEP(I0, v0, g0, I2, v2, g2); if (it >= NITEM) break;
        CONV_STEP(I1, v1, g1, I0, v0, g0); if (it >= NITEM) break;
        CONV_STEP(I2, v2, g2, I1, v1, g1);
    }
#undef CONV_STEP
    __syncthreads();
    { const int tid = opq_tid(); const int lm = l > 0 ? l - 1 : 0;
      const float* w2 = a->in[12] + (size_t)l * 64 * 1024; const float* a2 = a->in[14] + (size_t)l * 64 * 1024; const float* g2 = a->in[15] + (size_t)l * 160 * 1024; const float* v2 = a->in[23] + (size_t)lm * 32 * 1024;
      bf16* lw = (bf16*)(ws + WS_LORA);
      for (int i = blk * 512 + tid; i < 1024 * 320; i += nblk * 512) {
          const int ch = i / 320, k = i % 320;
          if (k < 64) lw[LORA_W2 / 2 + ch * 64 + k] = (bf16)f2bf(w2[(size_t)k * 1024 + ch]);
          else if (k < 128) lw[LORA_A2 / 2 + ch * 64 + k - 64] = (bf16)f2bf(a2[(size_t)(k - 64) * 1024 + ch]);
          else if (k < 288) lw[LORA_G2 / 2 + ch * 160 + k - 128] = (bf16)f2bf(g2[(size_t)(k - 128) * 1024 + ch]);
          else lw[LORA_V2 / 2 + ch * 32 + k - 288] = (bf16)f2bf(v2[(size_t)(k - 288) * 1024 + ch]);
      } }
    if (l > 0) {
        const int tid = opq_tid(), sl = tid >> 6, o = tid & 63;
        const float* win = a->in[3] + (size_t)l * DM * PW; const float* g1 = a->in[1] + (size_t)l * DM; const float* muv = a->in[10] + (size_t)l * 3360 + 2048; const float* v1 = a->in[22] + (size_t)(l - 1) * 1024 * 32;
        bf16* wt = (bf16*)(ws + WS_WIN);
        LAS float* wrow = (LAS float*)lds;
        LAS float* part = wrow + 8 * 1024;
        for (int k0 = blk * 8; k0 < DM; k0 += nblk * 8) {
            for (int i = tid; i < 8 * 1024; i += 512) wrow[i] = win[(size_t)(k0 + (i >> 10)) * PW + 5120 + (i & 1023)];
            __syncthreads();
            float acc[8];
#pragma unroll
            for (int r = 0; r < 8; ++r) acc[r] = 0.f;
#pragma unroll 8
            for (int ci = 0; ci < 128; ++ci) { const int c = sl * 128 + ci; const float m = muv[c], f = ((o < 32) ? 1.0f - m : m) * v1[c * 32 + (o & 31)];
#pragma unroll
                for (int r = 0; r < 8; ++r) acc[r] = __builtin_fmaf(wrow[r * 1024 + c], f, acc[r]); }
#pragma unroll
            for (int r = 0; r < 8; ++r) part[(sl * 8 + r) * 64 + o] = acc[r];
            __syncthreads();
            { const int r = sl; float s = 0.f;
#pragma unroll
              for (int q = 0; q < 8; ++q) s += part[(q * 8 + r) * 64 + o];
              const int row = (o < 32) ? 6528 + o : 6400 + o;
              wt[(size_t)row * DM + k0 + r] = (bf16)f2bf(s * g1[k0 + r]); }
            __syncthreads();
        }
    }
}
__device__ __forceinline__ void ph_copy_x(const float* __restrict__ src, float* __restrict__ copy, bf16* __restrict__ xb, float* __restrict__ ssq, int blk, int nblk) {
    const int tid_ = opq_tid(), lane = tid_ & 63, gw = blk * 8 + (tid_ >> 6), ngw = nblk * 8;
    for (int row = gw; row < T_; row += ngw) {
        const f32x4* s = (const f32x4*)(src + (size_t)row * DM);
        float ss = 0.f;
#pragma unroll
        for (int j = 0; j < 8; ++j) { const f32x4 v = s[lane + 64 * j]; ss += (v[0] * v[0] + v[1] * v[1]) + (v[2] * v[2] + v[3] * v[3]);
            ((f32x4*)(copy + (size_t)row * DM))[lane + 64 * j] = v;
            u32x2 w; w.x = f2bf(v[0]) | (f2bf(v[1]) << 16); w.y = f2bf(v[2]) | (f2bf(v[3]) << 16);
            ((u32x2*)(xb + (size_t)row * DM))[lane + 64 * j] = w; }
        ss = wave_sum(ss);
        if (lane < 32) ssq[(size_t)row * 32 + lane] = lane == 0 ? ss : 0.f;
    }
}
__device__ __forceinline__ void ph_zero(float* p, int n, int blk, int nblk) { const int tid = opq_tid();
#pragma unroll
    for (int r = 0; r < 4; ++r) { const int i = (r * nblk + blk) * 512 + tid; if (i < n) __hip_atomic_store(p + i, 0.f, __ATOMIC_RELAXED, __HIP_MEMORY_SCOPE_AGENT); } }

#ifndef MK_PER_PHASE
#define MK_PER_PHASE 0
#endif
constexpr int NPH = 8;
#ifndef PROBE_PH
#define PROBE_PH -1
#endif
#ifndef PROBE_REP
#define PROBE_REP 1
#endif
#define REP(k) for (int rep_ = 0; rep_ < ((k) == PROBE_PH ? PROBE_REP : 1); ++rep_)
typedef const __attribute__((address_space(4))) Args* CArgs;
__device__ __forceinline__ CArgs kargs() { CArgs p = (CArgs)__builtin_amdgcn_kernarg_segment_ptr(); asm volatile("" : "+s"(p)); return p; }
__global__ void __launch_bounds__(512, 2) fwd(Args args_unused) {
    extern __shared__ __attribute__((aligned(16))) unsigned char lds_raw[];
    LAS unsigned char* lds = (LAS unsigned char*)lds_raw;
    volatile LAS unsigned* MISC = (volatile LAS unsigned*)(lds + MISC_OFF);
    const int blk = (int)blockIdx.x, nblk = (int)gridDim.x;
    if (threadIdx.x < 32) MISC[threadIdx.x] = 0u;
    __syncthreads();
    XcdBarrier bar;
#if MK_PER_PHASE
    int lo, hi;
    { CArgs ap = kargs(); lo = ap->ph_lo; hi = ap->ph_hi; unsigned* bw = (unsigned*)(ap->ws + WS_CTL) + CW_BAR; bar.bar = bw; bar.x = 0; bar.st = nullptr;
      if (hi - lo > 1) bar = xcd_barrier_post(bw, MISC + 8); }
#else
    { CArgs ap = kargs(); bar = xcd_barrier_post((unsigned*)(ap->ws + WS_CTL) + CW_BAR, MISC + 8); }
#endif
#if MK_PER_PHASE
#define IN(k) (lo <= (k) && (k) < hi)
#define SEAM(k) do { if (IN(k) && IN((k) + 1)) xcd_barrier(bar); } while (0)
#else
#define IN(k) true
#define SEAM(k) do { if ((k) + 1 < NL * NPH) xcd_barrier(bar); } while (0)
#endif
#define WSP(T, off) ((T*)(ws + (off)))
#pragma unroll 1
    for (int l = 0; l < NL; ++l) {
        const int pb = l * NPH;
        if (IN(pb + 0)) REP(0) {
            CArgs ap = kargs(); unsigned char* ws = ap->ws;
            ph_convw(lds, ap, l, blk, nblk);
            if (l == 0) ph_copy_x(ap->in[0], ap->out, WSP(bf16, WS_XB), WSP(float, WS_SSQA), blk, nblk);

        }
        SEAM(pb + 0);
        if (IN(pb + 1)) REP(1) {
            CArgs ap = kargs(); unsigned char* ws = ap->ws;
            pg8::Gemm g{WSP(bf16, WS_XB), WSP(bf16, WS_WIN), T_, NIN, DM, 0}; pg8::StaticOrder S; S.init(T_, NIN, nblk, blk);
            pg8::EpiIn E{WSP(float, WS_SSQA), WSP(bf16, WS_Q), WSP(bf16, WS_K), WSP(bf16, WS_V), WSP(bf16, WS_RW), ap->in[5] + l * 128, ap->in[6] + l * 128};
            pg8::gemm_phase<pg8::EpiIn, pg8::StaticOrder, true, true>(lds, g, S, E);
        }
        SEAM(pb + 1);
        if (IN(pb + 2)) REP(2) {
            CArgs ap = kargs(); unsigned char* ws = ap->ws; const int lm = l > 0 ? l - 1 : 0;
            rk::S1Args A; A.rw = WSP(bf16, WS_RW); A.mu = ap->in[10] + (size_t)l * 3360; A.w0 = ap->in[11] + l * 1024; A.a0 = ap->in[13] + l * 1024; A.v0 = ap->in[21] + lm * 1024; A.k_k = ap->in[16] + l * 1024; A.k_a = ap->in[17] + l * 1024;
            A.r_k = ap->in[18] + l * 1024; A.w2t = (const bf16*)(ws + WS_LORA + LORA_W2); A.a2t = (const bf16*)(ws + WS_LORA + LORA_A2); A.g2t = (const bf16*)(ws + WS_LORA + LORA_G2); A.v2t = (const bf16*)(ws + WS_LORA + LORA_V2);
            A.vfirst = WSP(bf16, WS_VFIRST); A.BV = WSP(bf16, WS_BV); A.GB = WSP(bf16, WS_GB); A.PG = WSP(bf16, WS_PG); A.QT = WSP(float, WS_QT); A.RP = WSP(bf16, WS_RP); A.Y0 = WSP(float, WS_Y0); A.act = ws + WS_PART + (size_t)blk * rk::ACT_WG_BYTES; A.layer = l; A.pad_ = 0;
            rk::ph_stage1(lds, A, blk, nblk);
        }
        SEAM(pb + 2);
        if (IN(pb + 3)) {
            CArgs ap = kargs(); unsigned char* ws = ap->ws;
            rk::ph_chain(WSP(bf16, WS_PG), WSP(float, WS_QT), WSP(bf16, WS_H0T), blk, nblk);
            att::Args A; A.Q = WSP(bf16, WS_Q); A.K = WSP(bf16, WS_K); A.V = WSP(bf16, WS_V); A.mixed = WSP(bf16, WS_MIXED); A.stash = WSP(float, WS_STASH); A.lq = ap->in[7] + l * 128; A.lk = ap->in[8] + l * 128; A.subln = ap->in[9] + l * 128; A.gq = ap->in[5] + l * 128; A.gk = ap->in[6] + l * 128;
            A.lam_init = ap->lam_init[l]; A.pad_ = 0;
            att::attn_phase(lds, A, blk, (unsigned*)(ws + WS_CTL) + CW_ATTQ + 64 * l, MISC + 16, WSP(float, WS_PART));
        }
        SEAM(pb + 3);
        if (IN(pb + 4)) REP(4) {
            CArgs ap = kargs(); unsigned char* ws = ap->ws;
            rk::S3Args A{WSP(bf16, WS_H0T), WSP(bf16, WS_RP), WSP(float, WS_Y0), WSP(bf16, WS_BV), WSP(bf16, WS_GB), ap->in[19] + l * 1024, ap->in[20] + l * 1024, WSP(bf16, WS_MIXED)};
            rk::ph_stage3(A, blk, nblk);
            att::Args B; B.Q = WSP(bf16, WS_Q); B.K = WSP(bf16, WS_K); B.V = WSP(bf16, WS_V); B.mixed = WSP(bf16, WS_MIXED); B.stash = WSP(float, WS_STASH); B.lq = ap->in[7] + l * 128; B.lk = ap->in[8] + l * 128; B.subln = ap->in[9] + l * 128;
            B.gq = ap->in[5] + l * 128; B.gk = ap->in[6] + l * 128; B.lam_init = ap->lam_init[l]; B.pad_ = 0;
            att::attn_combine(lds, B, blk, nblk, WSP(float, WS_PART));
        }
        SEAM(pb + 4);
        if (IN(pb + 5)) {
            CArgs ap = kargs(); unsigned char* ws = ap->ws;
            pg8::Gemm g{WSP(bf16, WS_MIXED), WSP(bf16, WS_WOUT), T_, DM, DM, 0}; pg8::StaticOrder S; S.init(T_, DM, nblk, blk);
            pg8::EpiRes E{ap->out, WSP(bf16, WS_XB), WSP(float, WS_SSQB), DM, 0};
            pg8::gemm_phase<pg8::EpiRes, pg8::StaticOrder, true, true>(lds, g, S, E);
        }
        SEAM(pb + 5);
        if (IN(pb + 6)) REP(6) {
            CArgs ap = kargs(); unsigned char* ws = ap->ws;
            pg8::Gemm g{WSP(bf16, WS_XB), WSP(bf16, WS_WUP), T_, DFF, DM, 0}; pg8::StaticOrder S; S.init(T_, DFF, nblk, blk);
            pg8::EpiUp E{WSP(float, WS_SSQB), WSP(bf16, WS_U), DFF, 0};
            pg8::gemm_phase<pg8::EpiUp, pg8::StaticOrder, true, true>(lds, g, S, E);
        }
        SEAM(pb + 6);
        if (IN(pb + 7)) {
            CArgs ap = kargs(); unsigned char* ws = ap->ws;
            pg8::Gemm g{WSP(bf16, WS_U), WSP(bf16, WS_WDOWN), T_, DM, DFF, 0}; pg8::StaticOrder S; S.init(T_, DM, nblk, blk);
            pg8::EpiRes E{ap->out, WSP(bf16, WS_XB), WSP(float, WS_SSQA), DM, 0};
            pg8::gemm_phase<pg8::EpiRes, pg8::StaticOrder, true, true>(lds, g, S, E);
        }
        SEAM(pb + 7);
    }
#undef IN
#undef SEAM
#undef WSP
}

extern "C" void kernel_launch(void* const* d_in, const int* in_sizes, int n_in, void* d_out, int out_size, void* d_ws, size_t ws_size, hipStream_t stream) {
    static int grid = 0;
    if (grid == 0) {
        grid = -1;
        if (n_in != 26 || ws_size < WS_END || out_size != T_ * DM) { fprintf(stderr, "kernel_launch: unexpected shapes (n_in %d ws %zu out %d)\n", n_in, ws_size, out_size); return; }
        int dev = 0, cus = 0, per_cu = 0;
        if (hipGetDevice(&dev) != hipSuccess || hipDeviceGetAttribute(&cus, hipDeviceAttributeMultiprocessorCount, dev) != hipSuccess) return;
        if (hipFuncSetAttribute((const void*)fwd, hipFuncAttributeMaxDynamicSharedMemorySize, LDS_BYTES) != hipSuccess) return;
        if (hipOccupancyMaxActiveBlocksPerMultiprocessor(&per_cu, (const void*)fwd, 512, LDS_BYTES) != hipSuccess || per_cu < 1) { fprintf(stderr, "kernel_launch: occupancy query says %d\n", per_cu); (void)hipGetLastError(); return; }
        if (cus < 8) return;
        grid = cus;
    }
    if (grid < 0) return;
    if (hipMemsetAsync((char*)d_ws + WS_CTL, 0, CTL_ZERO_BYTES, stream) != hipSuccess) return;
    Args a;
    memset(&a, 0, sizeof(a));
    for (int i = 0; i < 26; ++i) a.in[i] = (const float*)d_in[i];
    a.out = (float*)d_out; a.ws = (unsigned char*)d_ws;
    for (int l = 0; l < NL; ++l) a.lam_init[l] = (float)(0.8 - 0.6 * exp(-0.3 * (double)l));
    const int nph = NL * NPH;
#if MK_PER_PHASE
    for (int p = 0; p < nph; ++p) { a.ph_lo = p; a.ph_hi = p + 1; hipLaunchKernelGGL(fwd, dim3(grid), dim3(512), LDS_BYTES, stream, a); }
#else
    a.ph_lo = 0; a.ph_hi = nph; hipLaunchKernelGGL(fwd, dim3(grid), dim3(512), LDS_BYTES, stream, a);
#endif
}
```

```cpp
#include <hip/hip_runtime.h>
#include <cstdio>
#include <cstdint>
#include <cstring>
#include <cmath>

constexpr int T_ = 16384, DM = 2048, NL = 4, PW = 6432, NIN = 6656, RWP = 3584, DFF = 8192, RW_ = 1024;
constexpr float RMS_EPS = 1e-6f, GN_EPS = 64e-5f;
typedef unsigned short bf16;
typedef float f32x4 __attribute__((ext_vector_type(4)));
typedef unsigned u32x4 __attribute__((ext_vector_type(4)));
typedef unsigned u32x2 __attribute__((ext_vector_type(2)));
#define LAS __attribute__((address_space(3)))

__device__ __forceinline__ unsigned f2bf(float f) { unsigned u = __builtin_bit_cast(unsigned, f); return (u + 0x7fffu + ((u >> 16) & 1u)) >> 16; }
__device__ __forceinline__ float bf2f(unsigned short b) { return __builtin_bit_cast(float, (unsigned)b << 16); }
__device__ __forceinline__ float bflo(unsigned w) { return __builtin_bit_cast(float, w << 16); }
__device__ __forceinline__ float bfhi(unsigned w) { return __builtin_bit_cast(float, w & 0xffff0000u); }
__device__ __forceinline__ float sigmoidf_(float x) { return 1.0f / (1.0f + __expf(-x)); }

template <int CTRL, int ROWMASK> __device__ __forceinline__ float dppf(float v) {
    return __builtin_bit_cast(float, __builtin_amdgcn_update_dpp(0, __builtin_bit_cast(int, v), CTRL, ROWMASK, 0xF, false));
}
__device__ __forceinline__ float wave_sum(float v) {
    v += dppf<0xB1, 0xF>(v); v += dppf<0x4E, 0xF>(v); v += dppf<0x141, 0xF>(v); v += dppf<0x140, 0xF>(v);
    v += dppf<0x142, 0xA>(v); v += dppf<0x143, 0xC>(v);
    return __builtin_bit_cast(float, __builtin_amdgcn_readlane(__builtin_bit_cast(int, v), 63));
}
__device__ __forceinline__ int opq_tid() { int t = (int)threadIdx.x; asm volatile("" : "+v"(t)); return t; }
namespace pg8 {
#define PG8_LAS __attribute__((address_space(3)))
typedef unsigned short bf16_t;
typedef short bf16x8 __attribute__((ext_vector_type(8)));
typedef float f32x4 __attribute__((ext_vector_type(4)));
typedef unsigned u32x4 __attribute__((ext_vector_type(4)));
constexpr int BM = 256, BK = 64, HALF = 128, HTB = HALF * BK * 2  , STAGE_BYTES = 8 * HTB, NXCD = 8, WGM = 8;

__host__ __device__ __forceinline__ int lds_byte(int r, int c) { const int st = (r >> 4) * 2 + (c >> 5), rr = r & 15, cc = c & 31, ob = rr * 64 + cc * 2; return st * 1024 + (ob ^ (((ob >> 9) & 1) << 5)); }
__host__ __device__ __forceinline__ void stage_rc(int b, int& R, int& C) { const int st = b / 1024, sb = b % 1024, swz = sb ^ (((sb >> 9) & 1) << 5); R = (st >> 1) * 16 + swz / 64; C = (st & 1) * 32 + (swz % 64) / 2; }
__host__ __device__ __forceinline__ int perm32(int rho) { const int n = rho >> 4, i = rho & 15; return 8 * (i >> 2) + 4 * n + (i & 3); }

struct Unit { int pm, pn; };
struct Gemm { const bf16_t* A; const bf16_t* Bt; int M, N, K, pad_; };

struct StaticOrder {
    int nM, nN, nwg, G, c;
    __host__ __device__ void init(int M, int N, int G_, int c_) { nM = M / BM; nN = N / BM; nwg = nM * nN; G = G_; c = c_; }
    __host__ __device__ bool next(int i, Unit& u) const {
        const long L = (long)i * G + c; if (L >= nwg) return false;
        int wgid = (int)L; { const int q = nwg / NXCD, r = nwg % NXCD, xcd = wgid % NXCD, off = wgid / NXCD; wgid = (xcd < r ? xcd * (q + 1) : r * (q + 1) + (xcd - r) * q) + off; }
        const int nig = WGM * nN, gid = wgid / nig, fm = gid * WGM, gsz = (nM - fm) < WGM ? (nM - fm) : WGM;
        u.pm = fm + ((wgid % nig) % gsz); u.pn = (wgid % nig) / gsz; return true;
    }
    __device__ __forceinline__ void a_ready(const Unit&) const {}
    __device__ __forceinline__ void done(const Unit&) const {}
};

__device__ __forceinline__ unsigned cvt_pk_bf16(float lo, float hi) { unsigned r; asm volatile("v_cvt_pk_bf16_f32 %0, %1, %2" : "=v"(r) : "v"(lo), "v"(hi)); return r; }
typedef float f32x2 __attribute__((ext_vector_type(2)));
__device__ __forceinline__ float row_ssq(const float* ssq, int row, int fq) {
    const f32x4 a = *(const f32x4*)(ssq + (size_t)row * 32 + 8 * fq), b = *(const f32x4*)(ssq + (size_t)row * 32 + 8 * fq + 4);
    float s = ((a[0] + a[1]) + (a[2] + a[3])) + ((b[0] + b[1]) + (b[2] + b[3]));
    s += __shfl_xor(s, 16); s += __shfl_xor(s, 32); return s;
}
struct EpiIn {
    static constexpr bool PERM = true, AFTER_DRAIN = false;
    const float* rinv; bf16_t* q; bf16_t* k; bf16_t* v; bf16_t* rw; const float* gq; const float* gk;
    __device__ __forceinline__ void operator()(const f32x4 (&acc)[2][2][4][2], const Unit& u, int wr, int wc, int fr, int fq) const {
        const int pn = u.pn;
        const int row0 = u.pm * BM + wr * 64 + fr;
        if (pn < 8) {
            const float* g = (pn < 4 ? gq : gk) + (wc & 1) * 64 + 8 * fq;
            f32x4 gv[2][2];
#pragma unroll
            for (int bj = 0; bj < 2; ++bj)
#pragma unroll
                for (int n = 0; n < 2; ++n) gv[bj][n] = *(const f32x4*)(g + 32 * bj + 4 * n);
            bf16_t* base = (pn < 4 ? q : k) + (pn & 3) * 256 + 64 * wc + 8 * fq;
#pragma unroll
            for (int ai = 0; ai < 2; ++ai)
#pragma unroll
                for (int m = 0; m < 4; ++m) {
                    const int row = row0 + ai * HALF + m * 16; const float ri = 1.0f / sqrtf(row_ssq(rinv, row, fq) * (1.0f / 2048.0f) + 1e-6f);
                    f32x4 vv[2][2]; float ss = 0.f;
#pragma unroll
                    for (int bj = 0; bj < 2; ++bj)
#pragma unroll
                        for (int n = 0; n < 2; ++n) { vv[bj][n] = acc[ai][bj][m][n] * ri; const f32x4 t = vv[bj][n]; ss += (t[0] * t[0] + t[1] * t[1]) + (t[2] * t[2] + t[3] * t[3]); }
                    ss += __shfl_xor(ss, 16); ss += __shfl_xor(ss, 32);
                    const float rq = 1.0f / sqrtf(ss * (1.0f / 64.0f) + 1e-6f);
#pragma unroll
                    for (int bj = 0; bj < 2; ++bj) { const f32x4 a = vv[bj][0] * rq * gv[bj][0], b = vv[bj][1] * rq * gv[bj][1];
                        u32x4 w; w.x = cvt_pk_bf16(a[0], a[1]); w.y = cvt_pk_bf16(a[2], a[3]); w.z = cvt_pk_bf16(b[0], b[1]); w.w = cvt_pk_bf16(b[2], b[3]);
                        *(u32x4*)(base + (size_t)row * 1024 + 32 * bj) = w; }
                }
        } else {
            bf16_t* base; int ld;
            if (pn < 12) { base = v + (pn - 8) * 256 + 64 * wc + 8 * fq; ld = 1024; } else { base = rw + (pn - 12) * 256 + 64 * wc + 8 * fq; ld = 3584; }
#pragma unroll
            for (int ai = 0; ai < 2; ++ai)
#pragma unroll
                for (int m = 0; m < 4; ++m) {
                    const int row = row0 + ai * HALF + m * 16; const float ri = 1.0f / sqrtf(row_ssq(rinv, row, fq) * (1.0f / 2048.0f) + 1e-6f);
#pragma unroll
                    for (int bj = 0; bj < 2; ++bj) { const f32x4 a = acc[ai][bj][m][0] * ri, b = acc[ai][bj][m][1] * ri;
                        u32x4 w; w.x = cvt_pk_bf16(a[0], a[1]); w.y = cvt_pk_bf16(a[2], a[3]); w.z = cvt_pk_bf16(b[0], b[1]); w.w = cvt_pk_bf16(b[2], b[3]);
                        *(u32x4*)(base + (size_t)row * ld + 32 * bj) = w; }
                }
        }
    }
};
struct EpiRes {
    static constexpr bool PERM = true, AFTER_DRAIN = false;
    float* x; bf16_t* xb; float* ssq; int ldc; int pad_;
    __device__ __forceinline__ void operator()(const f32x4 (&acc)[2][2][4][2], const Unit& u, int wr, int wc, int fr, int fq) const {
        const int row0 = u.pm * BM + wr * 64 + fr, col0 = u.pn * BM + wc * 32 + 8 * fq;
#pragma unroll
        for (int ai = 0; ai < 2; ++ai)
#pragma unroll
            for (int m = 0; m < 4; ++m) { const int row = row0 + ai * HALF + m * 16; float* rowp = x + (size_t)row * ldc + col0; bf16_t* rowb = xb + (size_t)row * ldc + col0; float ss = 0.f;
#pragma unroll
                for (int bj = 0; bj < 2; ++bj) { f32x4* p = (f32x4*)(rowp + bj * HALF); const f32x4 o0 = p[0] + acc[ai][bj][m][0], o1 = p[1] + acc[ai][bj][m][1]; p[0] = o0; p[1] = o1;
                    ss += ((o0[0] * o0[0] + o0[1] * o0[1]) + (o0[2] * o0[2] + o0[3] * o0[3])) + ((o1[0] * o1[0] + o1[1] * o1[1]) + (o1[2] * o1[2] + o1[3] * o1[3]));
                    u32x4 w; w.x = cvt_pk_bf16(o0[0], o0[1]); w.y = cvt_pk_bf16(o0[2], o0[3]); w.z = cvt_pk_bf16(o1[0], o1[1]); w.w = cvt_pk_bf16(o1[2], o1[3]);
                    *(u32x4*)(rowb + bj * HALF) = w; }
                ss += __shfl_xor(ss, 16); ss += __shfl_xor(ss, 32);
                if (fq == 0) ssq[(size_t)row * 32 + u.pn * 4 + wc] = ss; }
    }
};
struct EpiUp {
    static constexpr bool PERM = true, AFTER_DRAIN = false;
    const float* rinv; bf16_t* o; int ldc; int pad_;
    __device__ __forceinline__ void operator()(const f32x4 (&acc)[2][2][4][2], const Unit& u, int wr, int wc, int fr, int fq) const {
        const int row0 = u.pm * BM + wr * 64 + fr, col0 = u.pn * BM + wc * 32 + 8 * fq;
#pragma unroll
        for (int ai = 0; ai < 2; ++ai)
#pragma unroll
            for (int m = 0; m < 4; ++m) { const int row = row0 + ai * HALF + m * 16; const float ri = 1.0f / sqrtf(row_ssq(rinv, row, fq) * (1.0f / 2048.0f) + 1e-6f);   bf16_t* rowp = o + (size_t)row * ldc + col0;
#pragma unroll
                for (int bj = 0; bj < 2; ++bj) { f32x4 a = acc[ai][bj][m][0] * ri, b = acc[ai][bj][m][1] * ri;
#pragma unroll
                    for (int e = 0; e < 4; ++e) { a[e] = a[e] > 0.f ? a[e] * a[e] : 0.f; b[e] = b[e] > 0.f ? b[e] * b[e] : 0.f; }
                    u32x4 w; w.x = cvt_pk_bf16(a[0], a[1]); w.y = cvt_pk_bf16(a[2], a[3]); w.z = cvt_pk_bf16(b[0], b[1]); w.w = cvt_pk_bf16(b[2], b[3]);
                    *(u32x4*)(rowp + bj * HALF) = w; } }
    }
};
template <class Epi, class Sched, bool ALIGN_EPI = false, bool SP2 = false>
__device__ __forceinline__ void gemm_phase(PG8_LAS unsigned char* lds, const Gemm g, const Sched& S, const Epi& E) {
    const int tid = opq_tid(), wid = __builtin_amdgcn_readfirstlane(tid >> 6), lane = tid & 63, wr = wid >> 2, wc = wid & 3, fr = lane & 15, fq = lane >> 4;
    const int K = g.K, nt = K / BK;
    unsigned voffA[2], voffB[2];
#pragma unroll
    for (int i = 0; i < 2; ++i) { int R, C; stage_rc(tid * 16 + i * 8192, R, C); const int Rb = Epi::PERM ? ((R & ~31) + perm32(R & 31)) : R;
        voffA[i] = (unsigned)(R * K + C) * 2u; voffB[i] = (unsigned)(Rb * K + C) * 2u; }
    const size_t kstep = (size_t)(BK * 2);
    const size_t hstep = (size_t)HALF * K * 2;
    const size_t tstep = 2 * hstep;
    const unsigned ldsw = (unsigned)wid * 1024u;
    const int aoff = lds_byte(wr * 64 + fr, fq * 8), boff = lds_byte(wc * 32 + fr, fq * 8);
#define PG8_SA(b, h) (((b) * 2 + (h)) * HTB)
#define PG8_SB(b, h) ((4 + (b) * 2 + (h)) * HTB)
#define PG8_STAGE(bufoff, gbase, voff) do { _Pragma("unroll") for (int _i = 0; _i < 2; ++_i) \
        __builtin_amdgcn_global_load_lds((const unsigned*)((const char*)(gbase) + (voff)[_i]), (PG8_LAS unsigned*)(lds + (bufoff) + ldsw + _i * 8192), 16, 0, 0); } while (0)
#define PG8_LDA(dst, b, h) do { _Pragma("unroll") for (int m = 0; m < 4; ++m) _Pragma("unroll") for (int k = 0; k < 2; ++k) dst[m][k] = *(const PG8_LAS bf16x8*)(lds + PG8_SA(b, h) + aoff + m * 2048 + k * 1024); } while (0)
#define PG8_LDB(dst, b, h) do { _Pragma("unroll") for (int n = 0; n < 2; ++n) _Pragma("unroll") for (int k = 0; k < 2; ++k) dst[n][k] = *(const PG8_LAS bf16x8*)(lds + PG8_SB(b, h) + boff + n * 2048 + k * 1024); } while (0)
#define PG8_MMA(ai, bj, At, Bt) do { __builtin_amdgcn_s_setprio(1); _Pragma("unroll") for (int m = 0; m < 4; ++m) _Pragma("unroll") for (int n = 0; n < 2; ++n) _Pragma("unroll") for (int k = 0; k < 2; ++k) \
        acc[ai][bj][m][n] = __builtin_amdgcn_mfma_f32_16x16x32_bf16(Bt[n][k], At[m][k], acc[ai][bj][m][n], 0, 0, 0); __builtin_amdgcn_s_setprio(0); } while (0)
#define PG8_WAIT_V(n) asm volatile("s_waitcnt vmcnt(" #n ")" ::: "memory")
#define PG8_WAIT_L(n) asm volatile("s_waitcnt lgkmcnt(" #n ")" ::: "memory")
#define PG8_BAR __builtin_amdgcn_s_barrier()
#define PG8_SCHED __builtin_amdgcn_sched_barrier(0)
    Unit cur, nxt; int ui = 0;
    if (!S.next(0, cur)) return;
    f32x4 acc[2][2][4][2];
#pragma unroll
    for (int a = 0; a < 2; ++a)
#pragma unroll
        for (int b = 0; b < 2; ++b)
#pragma unroll
            for (int m = 0; m < 4; ++m)
#pragma unroll
                for (int n = 0; n < 2; ++n) acc[a][b][m][n] = (f32x4){0.f, 0.f, 0.f, 0.f};
    bf16x8 At[4][2], B0[2][2], B1[2][2];
    const char* cA = (const char*)g.A + (size_t)cur.pm * tstep; const char* cB = (const char*)g.Bt + (size_t)cur.pn * tstep;
    S.a_ready(cur);
    if constexpr (SP2) {
        PG8_STAGE(PG8_SB(0, 0), cB, voffB); PG8_STAGE(PG8_SB(0, 1), cB + hstep, voffB); PG8_STAGE(PG8_SA(0, 0), cA, voffA); PG8_STAGE(PG8_SA(0, 1), cA + hstep, voffA);
        if (wr == 1) PG8_BAR;
        PG8_WAIT_V(2); PG8_BAR;
        PG8_STAGE(PG8_SB(1, 0), cB + kstep, voffB); PG8_STAGE(PG8_SA(1, 0), cA + kstep, voffA); PG8_STAGE(PG8_SB(1, 1), cB + hstep + kstep, voffB);
        PG8_WAIT_V(6); PG8_BAR;
    } else {
        PG8_STAGE(PG8_SB(0, 0), cB, voffB); PG8_STAGE(PG8_SA(0, 0), cA, voffA); PG8_STAGE(PG8_SB(0, 1), cB + hstep, voffB); PG8_STAGE(PG8_SA(0, 1), cA + hstep, voffA);
        if (wr == 1) PG8_BAR;
        PG8_WAIT_V(4); PG8_BAR;
        PG8_STAGE(PG8_SB(1, 0), cB + kstep, voffB); PG8_STAGE(PG8_SA(1, 0), cA + kstep, voffA); PG8_STAGE(PG8_SB(1, 1), cB + hstep + kstep, voffB);
        PG8_WAIT_V(6); PG8_BAR;
    }
    for (;;) {
        const bool has_next = S.next(ui + 1, nxt);
        const char* nA = has_next ? (const char*)g.A + (size_t)nxt.pm * tstep : cA; const char* nB = has_next ? (const char*)g.Bt + (size_t)nxt.pn * tstep : cB;
        for (int t = 0; t < nt; t += 2) {
            const bool last = (t == nt - 2);
            const char* a1 = cA + (size_t)(t + 1) * kstep;
            const char* a2 = last ? nA : cA + (size_t)(t + 2) * kstep; const char* b2 = last ? nB : cB + (size_t)(t + 2) * kstep;
            const char* a3 = a2 + kstep; const char* b3 = b2 + kstep;
            if (last && has_next) S.a_ready(nxt);
            if constexpr (SP2) {
            PG8_LDB(B0, 0, 0); PG8_LDB(B1, 0, 1); PG8_SCHED; PG8_LDA(At, 0, 0); PG8_STAGE(PG8_SA(1, 1), a1 + hstep, voffA);
            PG8_WAIT_V(8); PG8_WAIT_L(0); PG8_BAR; PG8_MMA(0, 0, At, B0); PG8_MMA(0, 1, At, B1); PG8_BAR; PG8_SCHED;
            PG8_LDA(At, 0, 1); PG8_STAGE(PG8_SB(0, 0), b2, voffB); PG8_STAGE(PG8_SB(0, 1), b2 + hstep, voffB); PG8_STAGE(PG8_SA(0, 0), a2, voffA);
            PG8_WAIT_V(8); PG8_WAIT_L(0); PG8_BAR; PG8_MMA(1, 0, At, B0); PG8_MMA(1, 1, At, B1); PG8_BAR; PG8_SCHED;
            PG8_LDB(B0, 1, 0); PG8_LDB(B1, 1, 1); PG8_SCHED; PG8_LDA(At, 1, 0); PG8_STAGE(PG8_SA(0, 1), a2 + hstep, voffA);
            PG8_WAIT_V(8); PG8_WAIT_L(0); PG8_BAR; PG8_MMA(0, 0, At, B0); PG8_MMA(0, 1, At, B1); PG8_BAR; PG8_SCHED;
            PG8_LDA(At, 1, 1); PG8_STAGE(PG8_SB(1, 0), b3, voffB); PG8_STAGE(PG8_SB(1, 1), b3 + hstep, voffB); PG8_STAGE(PG8_SA(1, 0), a3, voffA);
            PG8_WAIT_V(8); PG8_WAIT_L(0); PG8_BAR; PG8_MMA(1, 0, At, B0); PG8_MMA(1, 1, At, B1); PG8_BAR; PG8_SCHED;
            } else {
            PG8_LDB(B0, 0, 0); PG8_SCHED; PG8_LDA(At, 0, 0); PG8_STAGE(PG8_SA(1, 1), a1 + hstep, voffA);
            PG8_WAIT_L(8); PG8_BAR; PG8_WAIT_L(0); PG8_MMA(0, 0, At, B0); PG8_BAR; PG8_SCHED;
            PG8_LDB(B1, 0, 1); PG8_STAGE(PG8_SB(0, 0), b2, voffB);
            PG8_BAR; PG8_WAIT_L(0); PG8_MMA(0, 1, At, B1); PG8_BAR;
            PG8_LDA(At, 0, 1); PG8_STAGE(PG8_SA(0, 0), a2, voffA);
            PG8_BAR; PG8_WAIT_L(0); PG8_MMA(1, 0, At, B0); PG8_BAR; PG8_SCHED;
            PG8_STAGE(PG8_SB(0, 1), b2 + hstep, voffB);
            PG8_WAIT_V(6); PG8_BAR; PG8_MMA(1, 1, At, B1); PG8_BAR;
            PG8_LDB(B0, 1, 0); PG8_SCHED; PG8_LDA(At, 1, 0); PG8_STAGE(PG8_SA(0, 1), a2 + hstep, voffA);
            PG8_WAIT_L(8); PG8_BAR; PG8_WAIT_L(0); PG8_MMA(0, 0, At, B0); PG8_BAR; PG8_SCHED;
            PG8_LDB(B1, 1, 1); PG8_STAGE(PG8_SB(1, 0), b3, voffB);
            PG8_BAR; PG8_WAIT_L(0); PG8_MMA(0, 1, At, B1); PG8_BAR;
            PG8_LDA(At, 1, 1); PG8_STAGE(PG8_SA(1, 0), a3, voffA);
            PG8_BAR; PG8_WAIT_L(0); PG8_MMA(1, 0, At, B0); PG8_BAR; PG8_SCHED;
            PG8_STAGE(PG8_SB(1, 1), b3 + hstep, voffB);
            PG8_WAIT_V(6); PG8_BAR; PG8_MMA(1, 1, At, B1); PG8_BAR;
            }
        }
        if constexpr (ALIGN_EPI) { if (wr == 0) PG8_BAR; }
        if constexpr (!Epi::AFTER_DRAIN) { E(acc, cur, wr, wc, fr, fq); S.done(cur); }
        if (!has_next) break;
#pragma unroll
        for (int a = 0; a < 2; ++a)
#pragma unroll
            for (int b = 0; b < 2; ++b)
#pragma unroll
                for (int m = 0; m < 4; ++m)
#pragma unroll
                    for (int n = 0; n < 2; ++n) acc[a][b][m][n] = (f32x4){0.f, 0.f, 0.f, 0.f};
        cur = nxt; cA = nA; cB = nB; ++ui;
        if constexpr (ALIGN_EPI) { if (wr == 1) PG8_BAR; }
    }
    PG8_WAIT_V(0);
    if constexpr (!ALIGN_EPI) { if (wr == 0) PG8_BAR; }
    PG8_BAR;
    if constexpr (Epi::AFTER_DRAIN) { E.fused(acc, cur, wr, wc, fr, fq, lds, wid, lane); S.done(cur); }
#undef PG8_SA
#undef PG8_SB
#undef PG8_STAGE
#undef PG8_LDA
#undef PG8_LDB
#undef PG8_MMA
#undef PG8_WAIT_V
#undef PG8_WAIT_L
#undef PG8_BAR
#undef PG8_SCHED
}
}

namespace att {
typedef short bf16x8 __attribute__((ext_vector_type(8)));
typedef short s16x4 __attribute__((ext_vector_type(4)));
typedef float f32x16 __attribute__((ext_vector_type(16)));
typedef float f32x2_t __attribute__((ext_vector_type(2)));
typedef __bf16 bf16x2_t __attribute__((ext_vector_type(2)));
typedef __attribute__((address_space(3))) const unsigned char* lds_cptr;
typedef short v4i16_t __attribute__((ext_vector_type(4)));
constexpr int KTILE = 8192, VTILE = 16384, KSLOT = 2 * KTILE, VSLOT = 2 * VTILE, LDS_K = 0, LDS_V = 2 * KSLOT, LDS_BYTES = 2 * KSLOT + 2 * VSLOT;
constexpr float LOG2E = 1.4426950408889634f, C2 = 0.125f * LOG2E;
__device__ __forceinline__ int crow(int r, int hi) { return (r & 3) + 8 * (r >> 2) + 4 * hi; }
__device__ __forceinline__ void glds16(const void* gsrc, unsigned lds_dst) { unsigned keep;
    asm volatile("s_mov_b32 %0, m0\n\ts_mov_b32 m0, %2\n\ts_nop 0\n\tglobal_load_lds_dwordx4 %1, off\n\ts_mov_b32 m0, %0" : "=&s"(keep) : "v"(gsrc), "s"(lds_dst) : "memory"); }
__device__ __forceinline__ unsigned cvtpk(float lo, float hi) { f32x2_t v = {lo, hi}; bf16x2_t b = __builtin_convertvector(v, bf16x2_t); return __builtin_bit_cast(unsigned, b); }
__device__ __forceinline__ s16x4 vtr(lds_cptr p) { return __builtin_bit_cast(s16x4, __builtin_amdgcn_ds_read_tr16_b64_v4i16((__attribute__((address_space(3))) v4i16_t*)p)); }
__device__ __forceinline__ float swap_max(float m) { auto rr = __builtin_amdgcn_permlane32_swap(__float_as_uint(m), __float_as_uint(m), false, false); return fmaxf(__uint_as_float(rr[0]), __uint_as_float(rr[1])); }
__device__ __forceinline__ float swap_sum(float m) { auto rr = __builtin_amdgcn_permlane32_swap(__float_as_uint(m), __float_as_uint(m), false, false); return __uint_as_float(rr[0]) + __uint_as_float(rr[1]); }
#define ATT_WAIT_BAR() asm volatile("s_waitcnt vmcnt(0) lgkmcnt(0)\n\ts_barrier" ::: "memory")

struct Args { const bf16* Q; const bf16* K; const bf16* V; bf16* mixed; float* stash; const float* lq; const float* lk; const float* subln; const float* gq; const float* gk; float lam_init; int pad_; };

constexpr int PART_G = 17, PART_SLOT_F = 512 * 4 * PART_G, MAX_SLOTS = 1700, SPLIT_MIN = 20, PART_TILES = 40, TAB_OFF = 102400;
__device__ __forceinline__ void attn_pass(__attribute__((address_space(3))) unsigned char* lds, const Args& A, int h, int qb, int c, int ta, int tb, int nw, f32x16 (&oT)[4], float& l_out, float& M_out) {
    const int tid = opq_tid(), lane = tid & 63, r32 = lane & 31, hi = lane >> 5; const int wid = __builtin_amdgcn_readfirstlane(tid >> 6);
    const int q0 = qb * 256 + wid * 32, qc = q0 >> 6;
    const float slope2 = exp2f(-(float)(h + 1)) * LOG2E;
    const unsigned lds0 = (unsigned)(uintptr_t)lds;
    const lds_cptr kp0 = (lds_cptr)lds + LDS_K + hi * 1024 + r32 * 16;
    const lds_cptr vp0 = (lds_cptr)lds + LDS_V + ((lane >> 4) & 1) * 32 + (lane & 3) * 8 + (4 * hi + ((lane & 15) >> 2)) * 64;
    const bf16* vsrc = A.V + (size_t)(16 * (wid & 3) + (lane >> 2)) * 1024 + h * 128 + (wid >> 2) * 32 + (lane & 3) * 8;
    const unsigned kdst = lds0 + LDS_K + wid * 1024, vdst = lds0 + LDS_V + (wid >> 2) * 4096 + (wid & 3) * 1024;
    const int qrel = (q0 & 63) + r32;
    const int tw0 = max(ta, max(0, qc - nw));
    const bf16* ksrc = A.K + (size_t)lane * 1024 + h * 128 + c * 64 + wid * 8;
    bf16x8 qr[4];
    { const bf16* qp = A.Q + (size_t)(q0 + r32) * 1024 + h * 128 + c * 64 + hi * 8;
#pragma unroll
      for (int d0 = 0; d0 < 4; ++d0) qr[d0] = *(const bf16x8*)(qp + d0 * 16); }
#pragma unroll
    for (int d0 = 0; d0 < 4; ++d0)
#pragma unroll
        for (int r = 0; r < 16; ++r) oT[d0][r] = 0.f;
    float l = 0.f, mu = 0.f;
    if (ta < tb) {
#define ATT_DMA(t_, so_, u_) do { const size_t go = (size_t)(t_) * 64 * 1024; \
            glds16(ksrc + go, (unsigned)__builtin_amdgcn_readfirstlane(kdst + (so_) * KSLOT + (u_) * KTILE)); glds16(vsrc + go, (unsigned)__builtin_amdgcn_readfirstlane(vdst + (so_) * VSLOT + (u_) * VTILE)); \
            glds16(vsrc + go + 64, (unsigned)__builtin_amdgcn_readfirstlane(vdst + (so_) * VSLOT + (u_) * VTILE + 8192)); } while (0)
        ATT_DMA(ta, 0u, 0u); if (ta + 1 < tb) ATT_DMA(ta + 1, 0u, 1u);
        ATT_WAIT_BAR();
#pragma unroll 1
        for (int T = ta; T < tb; T += 2) {
          const unsigned so = (unsigned)(((T - ta) >> 1) & 1);
          if (T + 2 < tb) { ATT_DMA(T + 2, so ^ 1u, 0u); if (T + 3 < tb) ATT_DMA(T + 3, so ^ 1u, 1u); }
#pragma unroll 1
          for (int u = 0; u < 2; ++u) {
            const int t = T + u, sl = 0; (void)sl;
            if (t >= tb) break;
            if (t >= tw0 && t <= qc) {
                const bool diag = (t == qc);
                f32x16 p0, p1;
                const float sc = slope2 * (1.0f / C2), base0 = (float)(4 * hi) * sc - mu * (1.0f / C2), base1 = base0 + 32.0f * sc;
                if (!diag) {
#pragma unroll
                    for (int r = 0; r < 16; ++r) { const float kr = (float)((r & 3) + 8 * (r >> 2)); p0[r] = __builtin_fmaf(kr, sc, base0); p1[r] = __builtin_fmaf(kr, sc, base1); }
                } else {
                    const float q2 = (float)(2 * qrel - 8 * hi);
#pragma unroll
                    for (int r = 0; r < 16; ++r) { const float kr = (float)((r & 3) + 8 * (r >> 2));
                        p0[r] = __builtin_fmaf(fminf(kr, q2 - kr) , sc, base0); p1[r] = __builtin_fmaf(fminf(kr, q2 - 64.0f - kr), sc, base1); }
                }
                const lds_cptr kp = kp0 + so * KSLOT + u * KTILE;
#pragma unroll
                for (int d0 = 0; d0 < 4; ++d0) {
                    const bf16x8 k0 = *(const __attribute__((address_space(3))) bf16x8*)(kp + d0 * 2048), k1 = *(const __attribute__((address_space(3))) bf16x8*)(kp + d0 * 2048 + 512);
                    p0 = __builtin_amdgcn_mfma_f32_32x32x16_bf16(k0, qr[d0], p0, 0, 0, 0);
                    p1 = __builtin_amdgcn_mfma_f32_32x32x16_bf16(k1, qr[d0], p1, 0, 0, 0);
                }
                const lds_cptr vp = vp0 + so * VSLOT + u * VTILE;
                bf16x8 vfA[4], vfB[4];
#define ATT_VLOAD(dst, d0_) do { _Pragma("unroll") for (int s = 0; s < 4; ++s) { const s16x4 lo = vtr(vp + (d0_) * 4096 + s * 1024), hh = vtr(vp + (d0_) * 4096 + s * 1024 + 512); \
                        dst[s] = (bf16x8){lo[0], lo[1], lo[2], lo[3], hh[0], hh[1], hh[2], hh[3]}; } } while (0)
#define ATT_PV(src, d0_) do { _Pragma("unroll") for (int s = 0; s < 4; ++s) oT[d0_] = __builtin_amdgcn_mfma_f32_32x32x16_bf16(src[s], pw[s], oT[d0_], 0, 0, 0); } while (0)
                ATT_VLOAD(vfA, 0);
                __builtin_amdgcn_sched_barrier(0);
                float rm = fmaxf(fmaxf(p0[0], p1[0]), p0[1]);
#pragma unroll
                for (int r = 1; r < 16; ++r) rm = fmaxf(fmaxf(rm, p1[r]), r + 1 < 16 ? p0[r + 1] : p1[r]);
                rm = swap_max(rm);
                const float dl = (t == tw0) ? C2 * rm : fmaxf(C2 * rm, 0.f);
                if (__any(dl != 0.f)) { const float f = __builtin_amdgcn_exp2f(-dl); l *= f;
#pragma unroll
                    for (int d0 = 0; d0 < 4; ++d0)
#pragma unroll
                        for (int r = 0; r < 16; ++r) oT[d0][r] *= f; }
                mu += dl;
                float ls = 0.f;
#pragma unroll
                for (int r = 0; r < 16; ++r) { p0[r] = __builtin_amdgcn_exp2f(p0[r] * C2 - dl); p1[r] = __builtin_amdgcn_exp2f(p1[r] * C2 - dl); ls += p0[r] + p1[r]; }
                l += ls;
                bf16x8 pw[4];
#pragma unroll
                for (int s = 0; s < 4; ++s) { u32x4 w;
#pragma unroll
                    for (int e = 0; e < 4; ++e) { const int r = 8 * (s & 1) + 2 * e; w[e] = (s < 2) ? cvtpk(p0[r], p0[r + 1]) : cvtpk(p1[r], p1[r + 1]); }
                    pw[s] = __builtin_bit_cast(bf16x8, w); }
                ATT_VLOAD(vfB, 1); __builtin_amdgcn_sched_barrier(0);
                ATT_PV(vfA, 0);
                ATT_VLOAD(vfA, 2); __builtin_amdgcn_sched_barrier(0);
                ATT_PV(vfB, 1);
                ATT_VLOAD(vfB, 3); __builtin_amdgcn_sched_barrier(0);
                ATT_PV(vfA, 2);
                __builtin_amdgcn_sched_barrier(0);
                ATT_PV(vfB, 3);
#undef ATT_VLOAD
#undef ATT_PV
                mu -= 64.0f * slope2;
            }
          }
          ATT_WAIT_BAR();
        }
#undef ATT_DMA
    }
    const int tl = min(qc, tb - 1);
    l_out = l; M_out = (tl >= tw0) ? mu + slope2 * 64.0f * (float)(tl + 1) : -1e30f;
}
__device__ __forceinline__ void attn_finalize(const Args& A, int h, int qb, const f32x16 (&o1)[4], f32x16 (&o2)[4], float lam) {
    const int tid = opq_tid(), lane = tid & 63, r32 = lane & 31, hi = lane >> 5; const int wid = __builtin_amdgcn_readfirstlane(tid >> 6);
    const int q0 = qb * 256 + wid * 32;
    float ss = 0.f;
#pragma unroll
    for (int d0 = 0; d0 < 4; ++d0)
#pragma unroll
        for (int r = 0; r < 16; ++r) { const float v = o1[d0][r] - lam * o2[d0][r]; o2[d0][r] = v; ss += v * v; }
    ss = swap_sum(ss);
    const float rn = (1.0f / sqrtf(ss * (1.0f / 128.0f) + RMS_EPS)) * (1.0f - A.lam_init);
    bf16* op = A.mixed + (size_t)(q0 + r32) * DM + h * 128;
#pragma unroll
    for (int d0 = 0; d0 < 4; ++d0)
#pragma unroll
        for (int g4 = 0; g4 < 4; ++g4) { const int d = 32 * d0 + 8 * g4 + 4 * hi; const f32x4 gg = *(const f32x4*)(A.subln + d);
            u32x2 w; w.x = cvtpk(o2[d0][4 * g4] * rn * gg[0], o2[d0][4 * g4 + 1] * rn * gg[1]); w.y = cvtpk(o2[d0][4 * g4 + 2] * rn * gg[2], o2[d0][4 * g4 + 3] * rn * gg[3]);
            *(u32x2*)(op + d) = w; }
}
struct Win { float smax0, smax1; };
__device__ __forceinline__ int win_nw(const Win& W, int h, int c) { const float smax = c ? W.smax1 : W.smax0, slope2 = exp2f(-(float)(h + 1)) * LOG2E, dmin = (2.0f * C2 * smax + 67.0f) / slope2; return (int)fminf(ceilf((dmin + 63.0f) * (1.0f / 64.0f)) - 1.0f, 256.0f); }
__device__ __forceinline__ void attn_windows(const Args& A, Win& W, float& lam) {
    const int lane = opq_tid() & 63;
    const float l0 = wave_sum(A.lq[lane] * A.lk[lane]), l1 = wave_sum(A.lq[64 + lane] * A.lk[64 + lane]);
    lam = __expf(l0) - __expf(l1) + A.lam_init;
#pragma unroll
    for (int c = 0; c < 2; ++c) { float a = fabsf(A.gq[c * 64 + lane]), b = fabsf(A.gk[c * 64 + lane]);
#pragma unroll
        for (int o = 1; o < 64; o <<= 1) { a = fmaxf(a, __shfl_xor(a, o)); b = fmaxf(b, __shfl_xor(b, o)); }
        const float smax = 64.0f * 1.02f * a * b; if (c == 0) W.smax0 = smax; else W.smax1 = smax; }
}
__device__ __forceinline__ int attn_ntile(const Win& W, int h, int qb, int c) { return 4 * qb + 4 - max(0, 4 * qb - win_nw(W, h, c)); }
__device__ __forceinline__ int attn_table(__attribute__((address_space(3))) unsigned char* lds, const Win& W) {
    volatile __attribute__((address_space(3))) unsigned* tab = (volatile __attribute__((address_space(3))) unsigned*)(lds + TAB_OFF);
    const int tid = opq_tid(), lane = tid & 63, wid = tid >> 6, qb = 63 - (tid >> 3), h = tid & 7;
    const int nt = max(attn_ntile(W, h, qb, 0), attn_ntile(W, h, qb, 1));
    int P = nt > SPLIT_MIN ? (nt + PART_TILES - 1) / PART_TILES : 0;
    int want = 2 * P, incl = want;
#pragma unroll
    for (int o = 1; o < 64; o <<= 1) { const int v = __shfl_up(incl, o); if (lane >= o) incl += v; }
    if (lane == 63) tab[1032 + wid] = (unsigned)incl;
    asm volatile("s_waitcnt lgkmcnt(0)" ::: "memory"); __builtin_amdgcn_s_barrier(); asm volatile("" ::: "memory");
    int sbase = 0;
#pragma unroll
    for (int w = 0; w < 8; ++w) sbase += (w < wid) ? (int)tab[1032 + w] : 0;
    const int sstart = sbase + incl - want;
    if (sstart + want > MAX_SLOTS) P = 0;
    const int cnt = P > 0 ? 2 * P : 1; int ci = cnt;
#pragma unroll
    for (int o = 1; o < 64; o <<= 1) { const int v = __shfl_up(ci, o); if (lane >= o) ci += v; }
    if (lane == 63) tab[1024 + wid] = (unsigned)ci;
    asm volatile("s_waitcnt lgkmcnt(0)" ::: "memory"); __builtin_amdgcn_s_barrier(); asm volatile("" ::: "memory");
    int ibase = 0, total = 0;
#pragma unroll
    for (int w = 0; w < 8; ++w) { const int v = (int)tab[1024 + w]; ibase += (w < wid) ? v : 0; total += v; }
    tab[tid] = (unsigned)(ibase + ci - cnt) | ((unsigned)P << 16); tab[512 + tid] = (unsigned)sstart;
    asm volatile("s_waitcnt lgkmcnt(0)" ::: "memory"); __builtin_amdgcn_s_barrier(); asm volatile("" ::: "memory");
    return total;
}
__device__ __forceinline__ void part_range(const Win& W, int h, int qb, int c, int P, int p, int& ta, int& tb) {
    const int NT = 4 * qb + 4, T0 = max(0, 4 * qb - win_nw(W, h, c)), len = (NT - T0 + P - 1) / P; ta = min(NT, T0 + p * len); tb = min(NT, ta + len);
}
__device__ __forceinline__ void attn_phase(__attribute__((address_space(3))) unsigned char* lds, const Args& A, int blk, unsigned* ctr, volatile __attribute__((address_space(3))) unsigned* qslot, float* part) {
    const int tid = opq_tid();
    Win W; float lam; attn_windows(A, W, lam);
    const int nitems = attn_table(lds, W);
    volatile __attribute__((address_space(3))) unsigned* tab = (volatile __attribute__((address_space(3))) unsigned*)(lds + TAB_OFF);
    float* st = A.stash + (size_t)blk * (64 * 512) + tid * 64;
    for (;;) {
        if (tid == 0) { const unsigned n = __hip_atomic_fetch_add(ctr, 1u, __ATOMIC_RELAXED, __HIP_MEMORY_SCOPE_AGENT); unsigned idx = 0;
            if (n < (unsigned)nitems) { int lo = 0, hi = 511; while (lo < hi) { const int mid = (lo + hi + 1) >> 1; if ((tab[mid] & 0xffffu) <= n) lo = mid; else hi = mid - 1; } idx = (unsigned)lo; }
            qslot[0] = n; qslot[1] = idx; }
        asm volatile("s_waitcnt vmcnt(0) lgkmcnt(0)" ::: "memory"); __builtin_amdgcn_s_barrier(); asm volatile("" ::: "memory");
        const unsigned n = qslot[0], idx = qslot[1];
        asm volatile("s_waitcnt lgkmcnt(0)" ::: "memory"); __builtin_amdgcn_s_barrier(); asm volatile("" ::: "memory");
        if (n >= (unsigned)nitems) break;
        const unsigned e = tab[idx]; const int P = (int)(e >> 16), sub = (int)(n - (e & 0xffffu)), h = (int)(idx & 7u), qb = 63 - (int)(idx >> 3);
        f32x16 oT[4]; float l, M;
        if (P == 0) {
#pragma unroll 1
            for (int c = 0; c < 2; ++c) {
                attn_pass(lds, A, h, qb, c, max(0, 4 * qb - win_nw(W, h, c)), 4 * qb + 4, win_nw(W, h, c), oT, l, M);
                const float il = 1.0f / swap_sum(l);
#pragma unroll
                for (int d0 = 0; d0 < 4; ++d0)
#pragma unroll
                    for (int r = 0; r < 16; ++r) oT[d0][r] *= il;
                if (c == 0) {
#pragma unroll
                    for (int d0 = 0; d0 < 4; ++d0)
#pragma unroll
                        for (int r = 0; r < 16; r += 4) *(f32x4*)(st + d0 * 16 + r) = (f32x4){oT[d0][r], oT[d0][r + 1], oT[d0][r + 2], oT[d0][r + 3]};
                } else { f32x16 o1[4];
#pragma unroll
                    for (int d0 = 0; d0 < 4; ++d0)
#pragma unroll
                        for (int r = 0; r < 16; r += 4) { const f32x4 v = *(const f32x4*)(st + d0 * 16 + r); o1[d0][r] = v[0]; o1[d0][r + 1] = v[1]; o1[d0][r + 2] = v[2]; o1[d0][r + 3] = v[3]; }
                    attn_finalize(A, h, qb, o1, oT, lam); }
            }
        } else {
            const int c = sub / P, p = sub % P; int ta, tb; part_range(W, h, qb, c, P, p, ta, tb);
            attn_pass(lds, A, h, qb, c, ta, tb, win_nw(W, h, c), oT, l, M);
            float* ps = part + (size_t)(tab[512 + idx] + (unsigned)sub) * PART_SLOT_F + tid * 4;
#pragma unroll
            for (int d0 = 0; d0 < 4; ++d0)
#pragma unroll
                for (int r = 0; r < 16; r += 4) *(f32x4*)(ps + (d0 * 4 + (r >> 2)) * 2048) = (f32x4){oT[d0][r], oT[d0][r + 1], oT[d0][r + 2], oT[d0][r + 3]};
            *(f32x4*)(ps + 16 * 2048) = (f32x4){l, M, 0.f, 0.f};
        }
    }
}
__device__ __forceinline__ void attn_combine(__attribute__((address_space(3))) unsigned char* lds, const Args& A, int blk, int nblk, const float* part) {
    const int tid = opq_tid();
    Win W; float lam; attn_windows(A, W, lam);
    (void)attn_table(lds, W);
    volatile __attribute__((address_space(3))) unsigned* tab = (volatile __attribute__((address_space(3))) unsigned*)(lds + TAB_OFF);
    int seen = 0, mine = blk, rnd = 0, base2 = nblk;
    for (int idx = 0; idx < 512; ++idx) {
        const unsigned e = tab[idx]; const int P = (int)(e >> 16); if (P == 0) continue;
        if (seen++ != mine) continue;
        rnd ^= 1; mine = rnd ? base2 + (nblk - 1 - blk) : base2 + nblk + blk; if (!rnd) base2 += 2 * nblk;

        const int h = idx & 7, qb = 63 - (idx >> 3);
        f32x16 o1[4], o2[4];
#pragma unroll 1
        for (int c = 0; c < 2; ++c) {
            const float* ps = part + (size_t)(tab[512 + idx] + (unsigned)(c * P)) * PART_SLOT_F + tid * 4;
            f32x4 lm[7]; float f[7];
#pragma unroll
            for (int p = 0; p < 7; ++p) lm[p] = p < P ? *(const f32x4*)(ps + (size_t)p * PART_SLOT_F + 16 * 2048) : (f32x4){0.f, -1e30f, 0.f, 0.f};
            float M = lm[0][1];
#pragma unroll
            for (int p = 1; p < 7; ++p) M = fmaxf(M, lm[p][1]);
            float L = 0.f;
#pragma unroll
            for (int p = 0; p < 7; ++p) { f[p] = __builtin_amdgcn_exp2f(lm[p][1] - M); L += lm[p][0] * f[p]; }
#pragma unroll
            for (int d0 = 0; d0 < 4; ++d0)
#pragma unroll
                for (int r = 0; r < 16; ++r) o2[d0][r] = 0.f;
            f32x4 hb[2][8];
#define ATT_HLOAD(hp_) do { if (((hp_) >> 1) < P) { const float* pp = ps + (size_t)((hp_) >> 1) * PART_SLOT_F + ((hp_) & 1) * 8 * 2048; \
                _Pragma("unroll") for (int q = 0; q < 8; ++q) hb[(hp_) & 1][q] = *(const f32x4*)(pp + q * 2048); } } while (0)
            ATT_HLOAD(0);
#pragma unroll
            for (int hp = 0; hp < 14; ++hp) {
                if (hp + 1 < 14) ATT_HLOAD(hp + 1);
                if ((hp >> 1) < P) { const float fp = f[hp >> 1];
#pragma unroll
                    for (int q = 0; q < 8; ++q) { const int d0 = 2 * (hp & 1) + (q >> 2), r = 4 * (q & 3); const f32x4 v = hb[hp & 1][q];
                        o2[d0][r] += v[0] * fp; o2[d0][r + 1] += v[1] * fp; o2[d0][r + 2] += v[2] * fp; o2[d0][r + 3] += v[3] * fp; } }
            }
#undef ATT_HLOAD
            const float il = 1.0f / swap_sum(L);
            if (c == 0) {
#pragma unroll
                for (int d0 = 0; d0 < 4; ++d0)
#pragma unroll
                    for (int r = 0; r < 16; ++r) o1[d0][r] = o2[d0][r] * il;
            } else {
#pragma unroll
                for (int d0 = 0; d0 < 4; ++d0)
#pragma unroll
                    for (int r = 0; r < 16; ++r) o2[d0][r] *= il;
            }
        }
        attn_finalize(A, h, qb, o1, o2, lam);
    }
}
}

namespace rk {
typedef short bf16x8 __attribute__((ext_vector_type(8)));
typedef short s16x4 __attribute__((ext_vector_type(4)));
typedef short v4i16_t __attribute__((ext_vector_type(4)));
typedef const LAS unsigned char* lcp;
constexpr int ST = 72, MATB = 64 * ST * 2, NST = 68, SLG = 168, SVL = 40;
constexpr int O_AT = 0, O_RT = MATB, O_BT = 2 * MATB, O_KT = 3 * MATB, O_VV = 4 * MATB, O_AAK = 5 * MATB, O_ARB = 6 * MATB, O_ARK = 7 * MATB, O_NN = 8 * MATB, O_GG = O_NN + 64 * NST * 4,
              O_G2 = O_AAK  , O_VG = O_ARK  , O_SEG = O_GG + 64 * NST * 4, O_GL = O_SEG + 2048,
              O_LW = O_GL + 256, O_LA = O_LW + MATB, O_LG = O_LA + MATB, O_VL = O_LG + 64 * SLG * 2, O_END = O_VL + 64 * SVL * 2,
              O_NB16 = O_LW  , O_WT = O_LW + MATB, O_U0T = O_LW + 2 * MATB, O_CB = O_LW + 3 * MATB  , CBS = 132;
static_assert(64 * NST * 4 <= 2 * MATB && O_END <= 156000 && O_CB + 16 * CBS * 4 <= O_END, "stage-1 LDS map");
__device__ __forceinline__ f32x4 mfma16(bf16x8 a, bf16x8 b, f32x4 c) { return __builtin_amdgcn_mfma_f32_16x16x32_bf16(a, b, c, 0, 0, 0); }
__device__ __forceinline__ s16x4 vtr(lcp p) { return __builtin_bit_cast(s16x4, __builtin_amdgcn_ds_read_tr16_b64_v4i16((LAS v4i16_t*)p)); }
__device__ __forceinline__ bf16x8 frag(lcp m, int row0, int ks, int lane, int st = ST) { return *(const LAS bf16x8*)(m + ((row0 + (lane & 15)) * st + 32 * ks + 8 * (lane >> 4)) * 2); }
__device__ __forceinline__ bf16x8 tfrag(lcp m, int c0, int ks, int lane) {
    const int i = lane & 15, q = i >> 2, p = i & 3, k0 = 32 * ks + 8 * (lane >> 4);
    const s16x4 lo = vtr(m + ((k0 + q) * ST + c0 + 4 * p) * 2), hi = vtr(m + ((k0 + 4 + q) * ST + c0 + 4 * p) * 2);
    return (bf16x8){lo[0], lo[1], lo[2], lo[3], hi[0], hi[1], hi[2], hi[3]};
}
__device__ __forceinline__ unsigned pk(float a, float b) { return f2bf(a) | (f2bf(b) << 16); }
#define RK_BAR() do { asm volatile("s_waitcnt lgkmcnt(0)" ::: "memory"); __builtin_amdgcn_s_barrier(); asm volatile("" ::: "memory"); } while (0)


constexpr int SOLVE_DEPTH = 3;
__host__ __device__ constexpr int solve_quads(int p) { return (2 * p + 1 + 3) / 4; }
typedef float f32x2 __attribute__((ext_vector_type(2)));
template <int P, int Q> struct SolveStep {
    static constexpr int NQ = solve_quads(P);
    template <int D, int PP, int QQ> struct Ahead { static constexpr int nxtP = (QQ + 1 < solve_quads(PP)) ? PP : PP + 1, nxtQ = (QQ + 1 < solve_quads(PP)) ? QQ + 1 : 0; using T = typename Ahead<D - 1, nxtP, nxtQ>::T; };
    template <int PP, int QQ> struct Ahead<0, PP, QQ> { using T = SolveStep<PP, QQ>; };
    static __device__ __forceinline__ void load(f32x4 (&ring)[SOLVE_DEPTH][2], int slot, LAS unsigned char* nn) {
        if constexpr (P < 32) { ring[slot][0] = *(const LAS f32x4*)(nn + ((2 * P) * NST + 4 * Q) * 4); ring[slot][1] = *(const LAS f32x4*)(nn + ((2 * P + 1) * NST + 4 * Q) * 4); }
    }
    template <int SLOT> static __device__ __forceinline__ void run(f32x2 (&x)[64], f32x2& a0, f32x2& a1, f32x4 (&ring)[SOLVE_DEPTH][2], LAS unsigned char* nn) {
        using AH = typename Ahead<SOLVE_DEPTH, P, Q>::T;
        const f32x4 n0 = ring[SLOT][0], n1 = ring[SLOT][1];
        asm volatile("" ::: "memory"); __builtin_amdgcn_sched_barrier(0);
        AH::load(ring, SLOT, nn);
        asm volatile("" ::: "memory"); __builtin_amdgcn_sched_barrier(0);
#pragma unroll
        for (int e = 0; e < 4; ++e)
            if (4 * Q + e < 2 * P) { a0 = __builtin_elementwise_fma((f32x2){n0[e], n0[e]}, x[4 * Q + e], a0); a1 = __builtin_elementwise_fma((f32x2){n1[e], n1[e]}, x[4 * Q + e], a1); }
        if constexpr (Q + 1 == NQ) {
            x[2 * P] = a0; asm volatile("" : "+v"(x[2 * P]));
            { constexpr int c = 2 * P, q = c / 4, e = c % 4; static_assert(q == Q, "column 2P lies in the pair's last quad"); a1 = __builtin_elementwise_fma((f32x2){n1[e], n1[e]}, x[c], a1); }
            x[2 * P + 1] = a1; asm volatile("" : "+v"(x[2 * P + 1]));
            if constexpr (P + 1 < 32) { a0 = x[2 * P + 2]; a1 = x[2 * P + 3]; SolveStep<P + 1, 0>::template run<(SLOT + 1) % SOLVE_DEPTH>(x, a0, a1, ring, nn); }
        } else {
            asm volatile("" : "+v"(a0), "+v"(a1));
            SolveStep<P, Q + 1>::template run<(SLOT + 1) % SOLVE_DEPTH>(x, a0, a1, ring, nn);
        }
    }
};

struct S1Args {
    const bf16* rw; const float* mu; const float* w0; const float* a0; const float* v0; const float* k_k; const float* k_a; const float* r_k;
    const bf16* w2t; const bf16* a2t; const bf16* g2t; const bf16* v2t;
    bf16* vfirst; bf16* BV; bf16* GB; bf16* PG; float* QT; bf16* RP; float* Y0; unsigned char* act; int layer; int pad_;
};
constexpr int ACT_LOGW = 0, ACT_AR = 262144, ACT_G = 524288, ACT_VG = 655360, ACT_WG_BYTES = 786432;
__device__ __forceinline__ float frcp(float x) { return __builtin_amdgcn_rcpf(x); }
__device__ __forceinline__ float fsigmoid(float x) { return frcp(1.0f + __expf(-x)); }
__device__ __forceinline__ float ftanh(float x) { const float e = __expf(-2.0f * fabsf(x)), t = (1.0f - e) * frcp(1.0f + e); return x < 0.f ? -t : t; }
__device__ __forceinline__ float ldbf(const bf16* p) { return bf2f(*p); }

__device__ __forceinline__ void stage1_latents(LAS unsigned char* lds, const S1Args& A, int t0) {
    const int tid = opq_tid();
#pragma unroll 1
    for (int bt = 0; bt < 5; ++bt) {
        float cur[8], prv[8], muv[8];
#pragma unroll
        for (int i = 0; i < 8; ++i) { const int idx = tid + 512 * (bt * 8 + i), tok = idx / 320, col = idx % 320, t = t0 + tok;
            const bf16* p = A.rw + (size_t)t * RWP + 3072 + col;
            cur[i] = ldbf(p); prv[i] = t > 0 ? ldbf(p - RWP + (col < 288 ? 0 : 32)) : 0.f; muv[i] = col < 288 ? A.mu[3072 + col] : 0.f; }
#pragma unroll
        for (int i = 0; i < 8; ++i) { const int idx = tid + 512 * (bt * 8 + i), tok = idx / 320, col = idx % 320;
            if (col < 288) { const float sft = cur[i] + muv[i] * (prv[i] - cur[i]);
                if (col < 64) *(LAS unsigned short*)(lds + O_LW + (tok * ST + col) * 2) = (unsigned short)f2bf(ftanh(sft));
                else if (col < 128) *(LAS unsigned short*)(lds + O_LA + (tok * ST + col - 64) * 2) = (unsigned short)f2bf(sft);
                else *(LAS unsigned short*)(lds + O_LG + (tok * SLG + col - 128) * 2) = (unsigned short)f2bf(fsigmoid(sft));
            } else *(LAS unsigned short*)(lds + O_VL + (tok * SVL + col - 288) * 2) = (unsigned short)f2bf(cur[i] + prv[i]); }
    }
}

struct LoraB { bf16x8 w[2], a[2], g[5], v; f32x4 w0c, a0c, v0c; };
__device__ __forceinline__ void lora_load(LoraB& B, const S1Args& A, int it, int lane) {
    const int rq = lane >> 4, l15 = lane & 15, ch0 = 16 * it, ch = ch0 + l15;
    const bf16* pw = A.w2t + (size_t)ch * 64 + 8 * rq; const bf16* pa = A.a2t + (size_t)ch * 64 + 8 * rq; const bf16* pg = A.g2t + (size_t)ch * 160 + 8 * rq; const bf16* pv = A.v2t + (size_t)ch * 32 + 8 * rq;
    B.w[0] = *(const bf16x8*)pw; B.w[1] = *(const bf16x8*)(pw + 32); B.a[0] = *(const bf16x8*)pa; B.a[1] = *(const bf16x8*)(pa + 32); B.v = *(const bf16x8*)pv;
#pragma unroll
    for (int ks = 0; ks < 5; ++ks) B.g[ks] = *(const bf16x8*)(pg + 32 * ks);
    B.w0c = *(const f32x4*)(A.w0 + ch0 + 4 * rq); B.a0c = *(const f32x4*)(A.a0 + ch0 + 4 * rq); B.v0c = *(const f32x4*)(A.v0 + ch0 + 4 * rq);
}
__device__ __forceinline__ void lora_item(LAS unsigned char* lds, const LoraB& B, const S1Args& A, int it, int lane) {
    const int rq = lane >> 4, l15 = lane & 15, h = it >> 2, j0 = 16 * (it & 3) + 4 * rq;
#pragma unroll 1
    for (int tb = 0; tb < 4; ++tb) {
        const f32x4 z = {0.f, 0.f, 0.f, 0.f};
        const f32x4 zw = mfma16(B.w[1], frag(lds + O_LW, 16 * tb, 1, lane), mfma16(B.w[0], frag(lds + O_LW, 16 * tb, 0, lane), z));
        const f32x4 za = mfma16(B.a[1], frag(lds + O_LA, 16 * tb, 1, lane), mfma16(B.a[0], frag(lds + O_LA, 16 * tb, 0, lane), z));
        const f32x4 zv = mfma16(B.v, frag(lds + O_VL, 16 * tb, 0, lane, SVL), z);
        f32x4 zg = z;
#pragma unroll
        for (int ks = 0; ks < 5; ++ks) zg = mfma16(B.g[ks], frag(lds + O_LG, 16 * tb, ks, lane, SLG), zg);
        const int o = (h * 64 + 16 * tb + l15) * 64 + j0;
        f32x4 lo_, ar_; u32x2 gg_, vg_; float vgf[4];
#pragma unroll
        for (int e = 0; e < 4; ++e) {
            const float zz = -(B.w0c[e] + zw[e]), sp = fmaxf(zz, 0.f) + __logf(1.0f + __expf(-fabsf(zz))), wl = -sp - 0.5f;
            lo_[e] = -__expf(wl);
            ar_[e] = fsigmoid(B.a0c[e] + za[e]);
            vgf[e] = fsigmoid(B.v0c[e] + zv[e]);
        }
        gg_.x = pk(zg[0], zg[1]); gg_.y = pk(zg[2], zg[3]); vg_.x = pk(vgf[0], vgf[1]); vg_.y = pk(vgf[2], vgf[3]);
        *(f32x4*)(A.act + ACT_LOGW + o * 4) = lo_; *(f32x4*)(A.act + ACT_AR + o * 4) = ar_; *(u32x2*)(A.act + ACT_G + o * 2) = gg_; *(u32x2*)(A.act + ACT_VG + o * 2) = vg_;
    }
}
__device__ __forceinline__ void stage1_lora_all(LAS unsigned char* lds, const S1Args& A) {
    const int tid = opq_tid(), lane = tid & 63, wid = __builtin_amdgcn_readfirstlane(tid >> 6);
    LoraB B0, B1;
    lora_load(B0, A, wid, lane);
#pragma unroll 1
    for (int k = 0; k < 8; k += 2) {
        lora_load(B1, A, wid + 8 * (k + 1), lane);
        lora_item(lds, B0, A, wid + 8 * k, lane);
        if (k + 2 < 8) lora_load(B0, A, wid + 8 * (k + 2), lane);
        lora_item(lds, B1, A, wid + 8 * (k + 1), lane);
    }
}
struct PreF { unsigned short r[9], k[9], v[9], vf[8], g[8], vg[8]; float lw[8], ar[8], mur, muk, muv, kkw, kaw, rkw; };
__device__ __forceinline__ void pref_load(PreF& P, const S1Args& A, int c, int h, int wid, int lane) {
    const int ch = h * 64 + lane, tf = c * 64 + 8 * wid;
    P.mur = A.mu[ch]; P.muk = A.mu[1024 + ch]; P.muv = A.mu[2048 + ch]; P.kkw = A.k_k[ch]; P.kaw = A.k_a[ch]; P.rkw = A.r_k[ch];
    const bf16* rp = A.rw + (size_t)tf * RWP + ch;
    if (tf > 0) { P.r[0] = rp[-RWP]; P.k[0] = rp[-RWP + 1024]; P.v[0] = rp[-RWP + 2048]; } else { P.r[0] = 0; P.k[0] = 0; P.v[0] = 0; }
#pragma unroll
    for (int e = 0; e < 8; ++e) { P.r[e + 1] = rp[(size_t)e * RWP]; P.k[e + 1] = rp[(size_t)e * RWP + 1024]; P.v[e + 1] = rp[(size_t)e * RWP + 2048];
        const int o = (h * 64 + 8 * wid + e) * 64 + lane;
        P.lw[e] = *(const float*)(A.act + ACT_LOGW + o * 4); P.ar[e] = *(const float*)(A.act + ACT_AR + o * 4); P.g[e] = *(const bf16*)(A.act + ACT_G + o * 2); P.vg[e] = *(const bf16*)(A.act + ACT_VG + o * 2);
        P.vf[e] = A.layer > 0 ? A.vfirst[(size_t)(tf + e) * 1024 + ch] : (unsigned short)0; }
}

__device__ __forceinline__ void stage1_unit(LAS unsigned char* lds, const S1Args& A, int c, int h, PreF& P) {
    const int tid = opq_tid(), lane = tid & 63, wid = __builtin_amdgcn_readfirstlane(tid >> 6), rq = lane >> 4, l15 = lane & 15;
    const int t0 = c * 64, uc = h * 256 + c;
    const int b0 = wid >> 1;
    LAS float* SEG = (LAS float*)(lds + O_SEG); LAS float* GL = (LAS float*)(lds + O_GL);
    for (int i = tid; i < 2 * MATB / 16; i += 512) *(LAS u32x4*)(lds + O_WT + i * 16) = (u32x4){0u, 0u, 0u, 0u};
    {
        const int j = lane, ch = h * 64 + j; float lw[8], cum[8], va[8], vb[8], vk[8], vr_[8], vv[8];
        const float mur = P.mur, muk = P.muk, muv = P.muv, kkw = P.kkw, kaw = P.kaw, rkw = P.rkw;
        const int tf = t0 + 8 * wid;
#pragma unroll
        for (int e = 0; e < 8; ++e) {
            const float cr = bf2f(P.r[e + 1]), ck = bf2f(P.k[e + 1]), cv = bf2f(P.v[e + 1]), pr = bf2f(P.r[e]), pk_ = bf2f(P.k[e]), pv = bf2f(P.v[e]);
            const float r = cr + mur * (pr - cr), kr = ck + muk * (pk_ - ck), vr = cv + muv * (pv - cv);
            lw[e] = P.lw[e];
            const float ar = P.ar[e], g = bf2f(P.g[e]), vg = bf2f(P.vg[e]);
            const float kkv = kr * kkw, ss = wave_sum(kkv * kkv), kk = kkv * __builtin_amdgcn_rsqf(fmaxf(ss, 1e-24f));
            va[e] = -kk; vb[e] = kk * ar; vk[e] = kr * (1.0f + (ar - 1.0f) * kaw); vr_[e] = r;
            const size_t go = (size_t)(tf + e) * 1024 + ch;
            float v;
            if (A.layer == 0) { v = vr; A.vfirst[go] = (bf16)f2bf(vr); } else { v = vr + (bf2f(P.vf[e]) - vr) * vg; }
            vv[e] = v;
            const float bonus = wave_sum(r * vk[e] * rkw);
            A.BV[go] = (bf16)f2bf(bonus * v); A.GB[go] = (bf16)f2bf(g);
        }
        cum[0] = lw[0];
#pragma unroll
        for (int e = 1; e < 8; ++e) cum[e] = cum[e - 1] + lw[e];
        SEG[wid * 64 + j] = cum[7];
        RK_BAR();
        float off = 0.f, tot = 0.f;
#pragma unroll
        for (int s = 0; s < 8; ++s) { const float v = SEG[s * 64 + j]; off += (s < wid) ? v : 0.f; tot += v; }
        if (wid == 0) GL[j] = __expf(tot);
        float gprev = __expf(off);
#pragma unroll
        for (int e = 0; e < 8; ++e) {
            const float cm = cum[e] + off, g = __expf(cm), gi = frcp(g), gp = gprev; gprev = g;
            const int o = ((8 * wid + e) * ST + j) * 2;
            *(LAS unsigned short*)(lds + O_AT + o) = (unsigned short)f2bf(va[e] * gp);
            *(LAS unsigned short*)(lds + O_BT + o) = (unsigned short)f2bf(vb[e] * gi);
            *(LAS unsigned short*)(lds + O_KT + o) = (unsigned short)f2bf(vk[e] * gi);
            *(LAS unsigned short*)(lds + O_RT + o) = (unsigned short)f2bf(vr_[e] * g);
            *(LAS unsigned short*)(lds + O_VV + o) = (unsigned short)f2bf(vv[e]);
        }
        RK_BAR();
    }
    {
        const bf16x8 bA0 = frag(lds + O_BT, 16 * b0, 0, lane), bA1 = frag(lds + O_BT, 16 * b0, 1, lane), kA0 = frag(lds + O_KT, 16 * b0, 0, lane), kA1 = frag(lds + O_KT, 16 * b0, 1, lane);
#pragma unroll
        for (int tt = 0; tt < 2; ++tt) {
            const int tb = 2 * (wid & 1) + tt;
            const bf16x8 aB0 = frag(lds + O_AT, 16 * tb, 0, lane), aB1 = frag(lds + O_AT, 16 * tb, 1, lane), rB0 = frag(lds + O_RT, 16 * tb, 0, lane), rB1 = frag(lds + O_RT, 16 * tb, 1, lane);
            const f32x4 z = {0.f, 0.f, 0.f, 0.f};
            f32x4 ab = mfma16(bA1, aB1, mfma16(bA0, aB0, z)), ak = mfma16(kA1, aB1, mfma16(kA0, aB0, z)), rb = mfma16(bA1, rB1, mfma16(bA0, rB0, z)), rk_ = mfma16(kA1, rB1, mfma16(kA0, rB0, z));
            const int tcol = 16 * tb + l15, srow = 16 * b0 + 4 * rq;
#pragma unroll
            for (int e = 0; e < 4; ++e) { const bool st = tcol > srow + e, le = tcol >= srow + e; ab[e] = st ? ab[e] : 0.f; ak[e] = st ? ak[e] : 0.f; rb[e] = le ? rb[e] : 0.f; rk_[e] = le ? rk_[e] : 0.f; }
            *(LAS f32x4*)(lds + O_NN + (tcol * NST + srow) * 4) = ab;
            const int o = (tcol * ST + srow) * 2;
            *(LAS u32x2*)(lds + O_NB16 + o) = (u32x2){pk(ab[0], ab[1]), pk(ab[2], ab[3])};
            *(LAS u32x2*)(lds + O_AAK + o) = (u32x2){pk(ak[0], ak[1]), pk(ak[2], ak[3])};
            *(LAS u32x2*)(lds + O_ARB + o) = (u32x2){pk(rb[0], rb[1]), pk(rb[2], rb[3])};
            *(LAS u32x2*)(lds + O_ARK + o) = (u32x2){pk(rk_[0], rk_[1]), pk(rk_[2], rk_[3])};
        }
        RK_BAR();
    }
    {
        const bf16x8 vA0 = tfrag(lds + O_VV, 16 * b0, 0, lane), vA1 = tfrag(lds + O_VV, 16 * b0, 1, lane);
#pragma unroll
        for (int tt = 0; tt < 2; ++tt) {
            const int tb = 2 * (wid & 1) + tt;
            const f32x4 z = {0.f, 0.f, 0.f, 0.f};
            const f32x4 g = mfma16(vA1, frag(lds + O_AAK, 16 * tb, 1, lane), mfma16(vA0, frag(lds + O_AAK, 16 * tb, 0, lane), z));
            *(LAS f32x4*)(lds + O_GG + ((16 * tb + l15) * NST + 16 * b0 + 4 * rq) * 4) = g;
        }
        RK_BAR();
    }
#pragma unroll 1
    for (int b = 0; b < 4; ++b) {
        if (b > 0) {
            const bf16x8 a0 = frag(lds + O_NB16, 16 * b, 0, lane), a1 = frag(lds + O_NB16, 16 * b, 1, lane);
            LAS unsigned char* xt = lds + (wid < 4 ? O_WT : O_U0T);
            const bf16x8 x0 = frag(xt, 16 * (wid & 3), 0, lane), x1 = frag(xt, 16 * (wid & 3), 1, lane);
            const f32x4 z = {0.f, 0.f, 0.f, 0.f};
            const f32x4 d = mfma16(a1, x1, mfma16(a0, x0, z));
#pragma unroll
            for (int e = 0; e < 4; ++e) *(LAS float*)(lds + O_CB + ((4 * rq + e) * CBS + 16 * wid + l15) * 4) = d[e];
            RK_BAR();
        }
        if (wid == 0) {
            f32x2 x[16];
            LAS unsigned char* rb_ = lds + (16 * b) * ST * 2 + lane * 2; LAS unsigned char* gb_ = lds + O_GG + ((16 * b) * NST + lane) * 4;
#pragma unroll
            for (int i = 0; i < 16; ++i) x[i] = (f32x2){bf2f(*(const LAS unsigned short*)(rb_ + O_AT + i * ST * 2)), *(const LAS float*)(gb_ + i * NST * 4)};
            if (b > 0) {
#pragma unroll
                for (int i = 0; i < 16; ++i) { x[i].x += *(const LAS float*)(lds + O_CB + (i * CBS + lane) * 4); x[i].y += *(const LAS float*)(lds + O_CB + (i * CBS + 64 + lane) * 4); }
            }
            LAS unsigned char* nn = lds + O_NN + ((16 * b) * NST + 16 * b) * 4; asm volatile("" : "+v"(nn));
            f32x4 qa[4], qc[4];
#define RK_DLOAD(buf, i_) do { _Pragma("unroll") for (int q = 0; q < 4; ++q) if (4 * q < (i_)) buf[q] = *(const LAS f32x4*)(nn + ((i_) * NST + 4 * q) * 4); } while (0)
#define RK_DROW(buf, i_) do { f32x2 acc = x[(i_)]; _Pragma("unroll") for (int q = 0; q < 4; ++q) { _Pragma("unroll") for (int e = 0; e < 4; ++e) if (4 * q + e < (i_)) acc = __builtin_elementwise_fma((f32x2){buf[q][e], buf[q][e]}, x[4 * q + e], acc); } \
                x[(i_)] = acc; asm volatile("" : "+v"(x[(i_)]) :: "memory"); __builtin_amdgcn_sched_barrier(0); } while (0)
            RK_DLOAD(qa, 1);
#pragma unroll
            for (int i = 1; i < 16; i += 2) {
                if (i + 1 < 16) RK_DLOAD(qc, i + 1);
                asm volatile("" ::: "memory"); __builtin_amdgcn_sched_barrier(0);
                RK_DROW(qa, i);
                if (i + 2 < 16) RK_DLOAD(qa, i + 2);
                asm volatile("" ::: "memory"); __builtin_amdgcn_sched_barrier(0);
                if (i + 1 < 16) RK_DROW(qc, i + 1);
            }
#undef RK_DLOAD
#undef RK_DROW
            LAS unsigned char* dw = lds + O_WT + lane * ST * 2 + 32 * b; LAS unsigned char* du = lds + O_U0T + lane * ST * 2 + 32 * b;
#pragma unroll
            for (int i = 0; i < 2; ++i) {
                *(LAS u32x4*)(dw + i * 16) = (u32x4){pk(x[8 * i].x, x[8 * i + 1].x), pk(x[8 * i + 2].x, x[8 * i + 3].x), pk(x[8 * i + 4].x, x[8 * i + 5].x), pk(x[8 * i + 6].x, x[8 * i + 7].x)};
                *(LAS u32x4*)(du + i * 16) = (u32x4){pk(x[8 * i].y, x[8 * i + 1].y), pk(x[8 * i + 2].y, x[8 * i + 3].y), pk(x[8 * i + 4].y, x[8 * i + 5].y), pk(x[8 * i + 6].y, x[8 * i + 7].y)}; }
        }
        if (b < 3) RK_BAR();
    }
    if (h + 1 < 16) { const int tid2 = opq_tid(); pref_load(P, A, c, h + 1, __builtin_amdgcn_readfirstlane(tid2 >> 6), tid2 & 63); }
    RK_BAR();
    {
        const int tid = opq_tid(), lane = tid & 63, wid = __builtin_amdgcn_readfirstlane(tid >> 6), rq = lane >> 4, l15 = lane & 15, b0 = wid >> 1;
        const bf16x8 wA0 = frag(lds + O_WT, 16 * b0, 0, lane), wA1 = frag(lds + O_WT, 16 * b0, 1, lane);
        const bf16x8 uA0 = frag(lds + O_U0T, 16 * b0, 0, lane), uA1 = frag(lds + O_U0T, 16 * b0, 1, lane);
        const bf16x8 vA0 = tfrag(lds + O_VV, 16 * b0, 0, lane), vA1 = tfrag(lds + O_VV, 16 * b0, 1, lane);
        const bf16x8 bA0 = tfrag(lds + O_BT, 16 * b0, 0, lane), bA1 = tfrag(lds + O_BT, 16 * b0, 1, lane);
        const bf16x8 kA0 = tfrag(lds + O_KT, 16 * b0, 0, lane), kA1 = tfrag(lds + O_KT, 16 * b0, 1, lane);
        const f32x4 glr = *(const LAS f32x4*)(lds + O_GL + (16 * b0 + 4 * rq) * 4);
#pragma unroll
        for (int tt = 0; tt < 2; ++tt) {
            const int nb = 2 * (wid & 1) + tt, col = 16 * nb + l15, row = 16 * b0 + 4 * rq;
            const f32x4 z = {0.f, 0.f, 0.f, 0.f};
            const bf16x8 rbB0 = frag(lds + O_ARB, 16 * nb, 0, lane), rbB1 = frag(lds + O_ARB, 16 * nb, 1, lane), rkB0 = frag(lds + O_ARK, 16 * nb, 0, lane), rkB1 = frag(lds + O_ARK, 16 * nb, 1, lane);
            { f32x4 d = mfma16(wA1, rbB1, mfma16(wA0, rbB0, z)); const u32x2 rt = *(const LAS u32x2*)(lds + O_RT + (col * ST + row) * 2);
              d[0] += bflo(rt.x); d[1] += bfhi(rt.x); d[2] += bflo(rt.y); d[3] += bfhi(rt.y);
              *(u32x2*)(A.RP + (size_t)(t0 + col) * 1024 + h * 64 + row) = (u32x2){pk(d[0], d[1]), pk(d[2], d[3])}; }
            { const f32x4 d = mfma16(vA1, rkB1, mfma16(vA0, rkB0, mfma16(uA1, rbB1, mfma16(uA0, rbB0, z))));
              *(f32x4*)(A.Y0 + (size_t)(t0 + col) * 1024 + h * 64 + row) = d; }
            { const bf16x8 bB0 = tfrag(lds + O_BT, 16 * nb, 0, lane), bB1 = tfrag(lds + O_BT, 16 * nb, 1, lane);
              f32x4 d = mfma16(wA1, bB1, mfma16(wA0, bB0, z)); const float gj = GL[col];
#pragma unroll
              for (int e = 0; e < 4; ++e) d[e] = gj * (d[e] + ((row + e) == col ? 1.f : 0.f));
              *(u32x2*)(A.PG + (size_t)uc * 4096 + ((((col >> 4) * 2 + (row >> 5)) * 64 + ((row >> 2) & 3) * 16 + (col & 15)) * 8 + ((row >> 4) & 1) * 4)) = (u32x2){pk(d[0], d[1]), pk(d[2], d[3])}; }
            { const bf16x8 uB0 = frag(lds + O_U0T, 16 * nb, 0, lane), uB1 = frag(lds + O_U0T, 16 * nb, 1, lane), vB0 = tfrag(lds + O_VV, 16 * nb, 0, lane), vB1 = tfrag(lds + O_VV, 16 * nb, 1, lane);
              f32x4 d = mfma16(kA1, vB1, mfma16(kA0, vB0, mfma16(bA1, uB1, mfma16(bA0, uB0, z))));
              d = d * glr;
              *(f32x4*)(A.QT + (size_t)uc * 4096 + ((((col >> 4) * 4 + (row >> 4)) * 64 + ((row >> 2) & 3) * 16 + (col & 15)) * 4)) = d; }
        }
    }
    RK_BAR();
}
__device__ __forceinline__ void ph_stage1(LAS unsigned char* lds, const S1Args& A, int blk, int nblk) {
    for (int c = blk; c < 256; c += nblk) {
        stage1_latents(lds, A, c * 64);
        RK_BAR();
        stage1_lora_all(lds, A);
        asm volatile("s_waitcnt vmcnt(0)" ::: "memory");
        RK_BAR();
        PreF P; { const int tid = opq_tid(); pref_load(P, A, c, 0, __builtin_amdgcn_readfirstlane(tid >> 6), tid & 63); }
#pragma unroll 1
        for (int h = 0; h < 16; ++h) stage1_unit(lds, A, c, h, P);
    }
}

struct ChainOps { bf16x8 a[4][2]; f32x4 c[4]; };
__device__ __forceinline__ void chain_load(ChainOps& o, const bf16* __restrict__ PG, const float* __restrict__ QT, int h, int ig, int c, int lane) {
    const bf16* P = PG + (size_t)(h * 256 + c) * 4096 + lane * 8; const float* Q = QT + (size_t)(h * 256 + c) * 4096 + (ig * 4 * 64 + lane) * 4;
#pragma unroll
    for (int m = 0; m < 4; ++m) { o.c[m] = *(const f32x4*)(Q + m * 256);
#pragma unroll
        for (int kb = 0; kb < 2; ++kb) o.a[m][kb] = *(const bf16x8*)(P + (m * 2 + kb) * 512); }
}
__device__ __forceinline__ void chain_step(f32x4 (&H)[4], const ChainOps& o, bf16* __restrict__ H0T, int h, int ig, int c, int lane) {
    const int fr = lane & 15, fq = lane >> 4;
    bf16* Ho = H0T + (size_t)(c * 16 + h) * 4096 + (16 * ig + fr) * 64 + 4 * fq;
    u32x4 bw[2];
#pragma unroll
    for (int m = 0; m < 4; ++m) { const u32x2 w = {pk(H[m][0], H[m][1]), pk(H[m][2], H[m][3])}; *(u32x2*)(Ho + 16 * m) = w; bw[m >> 1][2 * (m & 1)] = w.x; bw[m >> 1][2 * (m & 1) + 1] = w.y; }
#pragma unroll
    for (int m = 0; m < 4; ++m) H[m] = mfma16(o.a[m][1], __builtin_bit_cast(bf16x8, bw[1]), mfma16(o.a[m][0], __builtin_bit_cast(bf16x8, bw[0]), o.c[m]));
}
__device__ __forceinline__ void chain_wave(const bf16* __restrict__ PG, const float* __restrict__ QT, bf16* __restrict__ H0T, int h, int ig, int lane) {
    f32x4 H[4];
#pragma unroll
    for (int m = 0; m < 4; ++m) H[m] = (f32x4){0.f, 0.f, 0.f, 0.f};
    ChainOps s0, s1, s2, s3;
    chain_load(s0, PG, QT, h, ig, 0, lane); chain_load(s1, PG, QT, h, ig, 1, lane); chain_load(s2, PG, QT, h, ig, 2, lane); chain_load(s3, PG, QT, h, ig, 3, lane);
#pragma unroll 1
    for (int c = 0; c < 256; c += 4) {
        const bool more = c + 4 < 256;
        chain_step(H, s0, H0T, h, ig, c, lane);     if (more) chain_load(s0, PG, QT, h, ig, c + 4, lane);
        chain_step(H, s1, H0T, h, ig, c + 1, lane); if (more) chain_load(s1, PG, QT, h, ig, c + 5, lane);
        chain_step(H, s2, H0T, h, ig, c + 2, lane); if (more) chain_load(s2, PG, QT, h, ig, c + 6, lane);
        chain_step(H, s3, H0T, h, ig, c + 3, lane); if (more) chain_load(s3, PG, QT, h, ig, c + 7, lane);
    }
}
__device__ __forceinline__ void ph_chain(const bf16* PG, const float* QT, bf16* H0T, int blk, int nblk) {
    const int tid = opq_tid(), lane = tid & 63;
    for (int gw = blk * 8 + (tid >> 6); gw < 64; gw += nblk * 8) chain_wave(PG, QT, H0T, gw >> 2, gw & 3, lane);
}

struct S3Args { const bf16* H0T; const bf16* RP; const float* Y0; const bf16* BV; const bf16* GB; const float* ln_w; const float* ln_b; bf16* mixed; };
__device__ __forceinline__ void ph_stage3(const S3Args& A, int blk, int nblk) {
    const int tid = opq_tid(), lane = tid & 63, fr = lane & 15, fq = lane >> 4;
    for (int it = blk * 8 + (tid >> 6); it < 4096 * 4; it += nblk * 8) {
        const int u = it >> 2, tb = it & 3, c = u >> 4, h = u & 15, t = 64 * c + 16 * tb + fr;
        const bf16* Hp = A.H0T + (size_t)u * 4096 + fr * 64 + 8 * fq; const bf16* Rp = A.RP + (size_t)t * 1024 + h * 64 + 8 * fq;
        const bf16x8 r0 = *(const bf16x8*)Rp, r1 = *(const bf16x8*)(Rp + 32);
        f32x4 y[4];
#pragma unroll
        for (int ib = 0; ib < 4; ++ib) { const f32x4 y0 = *(const f32x4*)(A.Y0 + (size_t)t * 1024 + h * 64 + 16 * ib + 4 * fq);
            y[ib] = mfma16(*(const bf16x8*)(Hp + ib * 1024 + 32), r1, mfma16(*(const bf16x8*)(Hp + ib * 1024), r0, y0)); }
        float s = 0.f;
#pragma unroll
        for (int ib = 0; ib < 4; ++ib) s += (y[ib][0] + y[ib][1]) + (y[ib][2] + y[ib][3]);
        s += __shfl_xor(s, 16); s += __shfl_xor(s, 32);
        const float mean = s * (1.0f / 64.0f); float q = 0.f;
#pragma unroll
        for (int ib = 0; ib < 4; ++ib)
#pragma unroll
            for (int e = 0; e < 4; ++e) { const float d = y[ib][e] - mean; y[ib][e] = d; q += d * d; }
        q += __shfl_xor(q, 16); q += __shfl_xor(q, 32);
        const float rstd = 1.0f / sqrtf(q * (1.0f / 64.0f) + GN_EPS);
#pragma unroll
        for (int ib = 0; ib < 4; ++ib) { const int ch = h * 64 + 16 * ib + 4 * fq; const size_t o = (size_t)t * 1024 + ch;
            const f32x4 lw = *(const f32x4*)(A.ln_w + ch), lb = *(const f32x4*)(A.ln_b + ch); const u32x2 bv = *(const u32x2*)(A.BV + o), gg = *(const u32x2*)(A.GB + o); f32x4 r;
            const float bvf[4] = {bflo(bv.x), bfhi(bv.x), bflo(bv.y), bfhi(bv.y)}, ggf[4] = {bflo(gg.x), bfhi(gg.x), bflo(gg.y), bfhi(gg.y)};
#pragma unroll
            for (int e = 0; e < 4; ++e) r[e] = (y[ib][e] * rstd * lw[e] + lb[e] + bvf[e]) * ggf[e];
            *(u32x2*)(A.mixed + (size_t)t * DM + 1024 + ch) = (u32x2){pk(r[0], r[1]), pk(r[2], r[3])}; }
    }
}
}
#define XB_TMO      128
#define XB_XCNT(j)  (256  + 64 * (j))
#define XB_XSUB(j)  (1280 + 64 * (j))
#define XB_XGEN(j)  (2304 + 64 * (j))
#define XB_TOP      3328
#define XB_TOPGEN   3392
#define XCD_BAR_WORDS 3456
#define XB_SPIN_CAP (1u << 22)

__device__ __forceinline__ unsigned xb_ld(unsigned* p)              { return __hip_atomic_load(p, __ATOMIC_RELAXED, __HIP_MEMORY_SCOPE_AGENT); }
__device__ __forceinline__ unsigned xb_add(unsigned* p, unsigned v) { return __hip_atomic_fetch_add(p, v, __ATOMIC_RELAXED, __HIP_MEMORY_SCOPE_AGENT); }
__device__ __forceinline__ unsigned xb_xcc_id() { return (unsigned)__builtin_amdgcn_s_getreg((3 << 11) | 20) & 0xFu; }
#define XB_SPIN(cond, bar) do { unsigned _sp = 0; while (cond) { __builtin_amdgcn_s_sleep(1); \
    if ((++_sp & 255u) == 0u) { if (xb_ld(&(bar)[XB_TMO])) break; if (_sp > XB_SPIN_CAP) { atomicAdd(&(bar)[XB_TMO], 1u); break; } } } } while (0)

struct XcdBarrier {
    unsigned* bar; unsigned x;
    volatile LAS unsigned* st;
};

__device__ __forceinline__ XcdBarrier xcd_barrier_post(unsigned* bar, volatile LAS unsigned* st) {
    XcdBarrier b; b.bar = bar; b.x = xb_xcc_id(); b.st = st;
    if (threadIdx.x == 0) (void)xb_add(&bar[XB_XCNT(b.x)], 1u);
    return b;
}
__device__ __forceinline__ void xcd_barrier_complete(unsigned* bar, unsigned x, unsigned& nloc, unsigned& nx) {
    const unsigned G = gridDim.x * gridDim.y * gridDim.z;
    unsigned sum, cnt, mine, sp = 0u;
    for (;;) {
        sum = 0u; cnt = 0u; mine = 0u;
#pragma unroll
        for (unsigned j = 0; j < 16; ++j) { const unsigned c = xb_ld(&bar[XB_XCNT(j)]); sum += c; cnt += (c > 0u) ? 1u : 0u; mine = (j == x) ? c : mine; }
        if (sum == G) break;
        __builtin_amdgcn_s_sleep(1);
        if ((++sp & 255u) == 0u) { if (xb_ld(&bar[XB_TMO])) break; if (sp > XB_SPIN_CAP) { atomicAdd(&bar[XB_TMO], 1u); break; } }
    }
    nloc = mine > 0u ? mine : 1u; nx = cnt > 0u ? cnt : 1u;
}

__device__ __forceinline__ void xcd_barrier(const XcdBarrier& b) {
    asm volatile("s_waitcnt vmcnt(0)" ::: "memory");
    __syncthreads();
    if (threadIdx.x == 0) {
        unsigned* bar = b.bar;
        __builtin_amdgcn_s_waitcnt(0);
        unsigned nloc = b.st[0], nx = b.st[1];
        if (nloc == 0u) { xcd_barrier_complete(bar, b.x, nloc, nx); b.st[0] = nloc; b.st[1] = nx; }
        const unsigned old = xb_add(&bar[XB_XSUB(b.x)], 1u);
        const unsigned gen = old / nloc;
        if (old + 1u == (gen + 1u) * nloc) {
            __builtin_amdgcn_fence(__ATOMIC_RELEASE, "agent");
            asm volatile("s_waitcnt vmcnt(0)" ::: "memory");
            const unsigned og = xb_add(&bar[XB_TOP], 1u);
            const unsigned tg = og / nx;
            if (og + 1u == (tg + 1u) * nx) xb_add(&bar[XB_TOPGEN], 1u);
            else XB_SPIN(xb_ld(&bar[XB_TOPGEN]) == tg, bar);
            __builtin_amdgcn_fence(__ATOMIC_ACQUIRE, "agent");
            xb_add(&bar[XB_XGEN(b.x)], 1u);
            asm volatile("s_waitcnt vmcnt(0)" ::: "memory");
        } else {
            XB_SPIN(xb_ld(&bar[XB_XGEN(b.x)]) == gen, bar);
            __builtin_amdgcn_fence(__ATOMIC_ACQUIRE, "agent");
            asm volatile("s_waitcnt vmcnt(0)" ::: "memory");
        }
    }
    __syncthreads();
}

constexpr size_t MiB = 1u << 20;
constexpr size_t WS_CTL = 0, CTL_ZERO_BYTES = 64 * 1024, WS_SSQA = 1016 * MiB, WS_SSQB = 1018 * MiB,      WS_WIN = 2 * MiB, WS_WOUT = 28 * MiB, WS_WUP = 36 * MiB, WS_WDOWN = 68 * MiB, WS_LORA = 100 * MiB, WS_XB = 102 * MiB,
                 WS_Q = 166 * MiB, WS_K = 198 * MiB, WS_V = 230 * MiB, WS_RW = 262 * MiB, WS_MIXED = 374 * MiB, WS_U = 166 * MiB, WS_VFIRST = 438 * MiB, WS_PG = 470 * MiB, WS_QT = 502 * MiB, WS_RP = 566 * MiB,
                 WS_Y0 = 598 * MiB, WS_H0T = 662 * MiB, WS_BV = 694 * MiB, WS_GB = 726 * MiB, WS_STASH = 758 * MiB, WS_PART = 790 * MiB, WS_END = 1020 * MiB;
constexpr size_t LORA_W2 = 0, LORA_A2 = 1024 * 64 * 2, LORA_G2 = 2 * 1024 * 64 * 2, LORA_V2 = LORA_G2 + 1024 * 160 * 2;
constexpr int CW_BAR = 1024, CW_ATTQ = 512;
constexpr int RING_BYTES = 131072, MISC_OFF = 156000, LDS_BYTES = 156672;

struct Args { const float* in[26]; float* out; unsigned char* ws; int ph_lo, ph_hi; float lam_init[4]; };

struct ConvItem { const float* src; bf16* dst; const float* g; int K, N, k0, c0; bool permin, skipx; };
__device__ __forceinline__ void conv_item(ConvItem& I, const __attribute__((address_space(4))) Args* a, unsigned char* ws, int l, int it) {
    constexpr int I_IN = (DM / 64) * (NIN / 64), I_OUT = (DM / 64) * (DM / 64), I_UP = (DM / 64) * (DFF / 64);
    int r = it, nkbs;
    if (r < I_IN) { I.src = a->in[3] + (size_t)l * DM * PW; I.dst = (bf16*)(ws + WS_WIN); I.g = a->in[1] + (size_t)l * DM; I.K = DM; I.N = PW; nkbs = 5; I.permin = true; I.skipx = l > 0; }
    else if ((r -= I_IN) < I_OUT) { I.src = a->in[4] + (size_t)l * DM * DM; I.dst = (bf16*)(ws + WS_WOUT); I.g = nullptr; I.K = DM; I.N = DM; nkbs = 5; I.permin = false; I.skipx = false; }
    else if ((r -= I_OUT) < I_UP) { I.src = a->in[24] + (size_t)l * DM * DFF; I.dst = (bf16*)(ws + WS_WUP); I.g = a->in[2] + (size_t)l * DM; I.K = DM; I.N = DFF; nkbs = 5; I.permin = false; I.skipx = false; }
    else { r -= I_UP; I.src = a->in[25] + (size_t)l * DFF * DM; I.dst = (bf16*)(ws + WS_WDOWN); I.g = nullptr; I.K = DFF; I.N = DM; nkbs = 7; I.permin = false; I.skipx = false; }
    I.k0 = (r & ((1 << nkbs) - 1)) * 64; I.c0 = (r >> nkbs) * 64;
}
__device__ __forceinline__ void conv_load(const ConvItem& I, float (&v)[8], float (&gv)[8], int tid) {
#pragma unroll
    for (int i = 0; i < 8; ++i) { const int idx = tid + 512 * i, kk = idx >> 6, cc = idx & 63, cp = I.c0 + cc; int col = cp;
        if (I.permin) { const int lo = cp & 255, bj = lo >> 7, wc = (lo >> 5) & 3, j = lo & 31; col = (cp & ~255) + 64 * wc + 32 * bj + j; }
        const bool ok = col < I.N;
        v[i] = ok ? I.src[(size_t)(I.k0 + kk) * I.N + col] : 0.f; gv[i] = I.g ? I.g[I.k0 + kk] : 1.0f; }
}
__device__ __forceinline__ void ph_convw(LAS unsigned char* lds, const __attribute__((address_space(4))) Args* a, int l, int blk, int nblk) {
    LAS float* tile = (LAS float*)lds; unsigned char* ws = a->ws; const int tid = opq_tid();
    constexpr int NITEM = (DM / 64) * (NIN / 64) + (DM / 64) * (DM / 64) + (DM / 64) * (DFF / 64) + (DFF / 64) * (DM / 64);
    ConvItem I0, I1, I2; float v0[8], v1[8], v2[8], g0[8], g1[8], g2[8];
    int it = blk;
    if (it < NITEM) { conv_item(I0, a, ws, l, it); conv_load(I0, v0, g0, tid); }
    if (it + nblk < NITEM) { conv_item(I1, a, ws, l, it + nblk); conv_load(I1, v1, g1, tid); }
    int par = 0;
#define CONV_STEP(IC, VC, GC, IN_, VN_, GN_) do { \
        LAS float* tl = tile + par * (64 * 65); par ^= 1; \
        _Pragma("unroll") for (int i = 0; i < 8; ++i) { const int idx = tid + 512 * i; tl[(idx >> 6) * 65 + (idx & 63)] = VC[i] * GC[i]; } \
        if (it + 2 * nblk < NITEM) { conv_item(IN_, a, ws, l, it + 2 * nblk); conv_load(IN_, VN_, GN_, tid); } \
        __syncthreads(); \
        { const int cc = tid >> 3, k8 = (tid & 7) * 8, cp = IC.c0 + cc; \
          if (!(IC.permin && IC.skipx && ((cp >= 6432 && cp < 6464) || (cp >= 6528 && cp < 6560)))) {        \
              u32x4 w; \
              _Pragma("unroll") for (int e = 0; e < 4; ++e) w[e] = f2bf(tl[(k8 + 2 * e) * 65 + cc]) | (f2bf(tl[(k8 + 2 * e + 1) * 65 + cc]) << 16); \
              *(u32x4*)(IC.dst + (size_t)cp * IC.K + IC.k0 + k8) = w; } } \
        it += nblk; } while (0)
    while (it < NITEM) {
        CONV_STEP(I0, v0, g0, I2, v2, g2); if (it >= NITEM) break;
        CONV_STEP(I1, v1, g1, I0, v0, g0); if (it >= NITEM) break;
        CONV_STEP(I2, v2, g2, I1, v1, g1);
    }
#undef CONV_STEP
    __syncthreads();
    { const int tid = opq_tid(); const int lm = l > 0 ? l - 1 : 0;
      const float* w2 = a->in[12] + (size_t)l * 64 * 1024; const float* a2 = a->in[14] + (size_t)l * 64 * 1024; const float* g2 = a->in[15] + (size_t)l * 160 * 1024; const float* v2 = a->in[23] + (size_t)lm * 32 * 1024;
      bf16* lw = (bf16*)(ws + WS_LORA);
      for (int i = blk * 512 + tid; i < 1024 * 320; i += nblk * 512) {
          const int ch = i / 320, k = i % 320;
          if (k < 64) lw[LORA_W2 / 2 + ch * 64 + k] = (bf16)f2bf(w2[(size_t)k * 1024 + ch]);
          else if (k < 128) lw[LORA_A2 / 2 + ch * 64 + k - 64] = (bf16)f2bf(a2[(size_t)(k - 64) * 1024 + ch]);
          else if (k < 288) lw[LORA_G2 / 2 + ch * 160 + k - 128] = (bf16)f2bf(g2[(size_t)(k - 128) * 1024 + ch]);
          else lw[LORA_V2 / 2 + ch * 32 + k - 288] = (bf16)f2bf(v2[(size_t)(k - 288) * 1024 + ch]);
      } }
    if (l > 0) {
        const int tid = opq_tid(), sl = tid >> 6, o = tid & 63;
        const float* win = a->in[3] + (size_t)l * DM * PW; const float* g1 = a->in[1] + (size_t)l * DM; const float* muv = a->in[10] + (size_t)l * 3360 + 2048; const float* v1 = a->in[22] + (size_t)(l - 1) * 1024 * 32;
        bf16* wt = (bf16*)(ws + WS_WIN);
        LAS float* wrow = (LAS float*)lds;
        LAS float* part = wrow + 8 * 1024;
        for (int k0 = blk * 8; k0 < DM; k0 += nblk * 8) {
            for (int i = tid; i < 8 * 1024; i += 512) wrow[i] = win[(size_t)(k0 + (i >> 10)) * PW + 5120 + (i & 1023)];
            __syncthreads();
            float acc[8];
#pragma unroll
            for (int r = 0; r < 8; ++r) acc[r] = 0.f;
#pragma unroll 8
            for (int ci = 0; ci < 128; ++ci) { const int c = sl * 128 + ci; const float m = muv[c], f = ((o < 32) ? 1.0f - m : m) * v1[c * 32 + (o & 31)];
#pragma unroll
                for (int r = 0; r < 8; ++r) acc[r] = __builtin_fmaf(wrow[r * 1024 + c], f, acc[r]); }
#pragma unroll
            for (int r = 0; r < 8; ++r) part[(sl * 8 + r) * 64 + o] = acc[r];
            __syncthreads();
            { const int r = sl; float s = 0.f;
#pragma unroll
              for (int q = 0; q < 8; ++q) s += part[(q * 8 + r) * 64 + o];
              const int row = (o < 32) ? 6528 + o : 6400 + o;
              wt[(size_t)row * DM + k0 + r] = (bf16)f2bf(s * g1[k0 + r]); }
            __syncthreads();
        }
    }
}
__device__ __forceinline__ void ph_copy_x(const float* __restrict__ src, float* __restrict__ copy, bf16* __restrict__ xb, float* __restrict__ ssq, int blk, int nblk) {
    const int tid_ = opq_tid(), lane = tid_ & 63, gw = blk * 8 + (tid_ >> 6), ngw = nblk * 8;
    for (int row = gw; row < T_; row += ngw) {
        const f32x4* s = (const f32x4*)(src + (size_t)row * DM);
        float ss = 0.f;
#pragma unroll
        for (int j = 0; j < 8; ++j) { const f32x4 v = s[lane + 64 * j]; ss += (v[0] * v[0] + v[1] * v[1]) + (v[2] * v[2] + v[3] * v[3]);
            ((f32x4*)(copy + (size_t)row * DM))[lane + 64 * j] = v;
            u32x2 w; w.x = f2bf(v[0]) | (f2bf(v[1]) << 16); w.y = f2bf(v[2]) | (f2bf(v[3]) << 16);
            ((u32x2*)(xb + (size_t)row * DM))[lane + 64 * j] = w; }
        ss = wave_sum(ss);
        if (lane < 32) ssq[(size_t)row * 32 + lane] = lane == 0 ? ss : 0.f;
    }
}
__device__ __forceinline__ void ph_zero(float* p, int n, int blk, int nblk) { const int tid = opq_tid();
#pragma unroll
    for (int r = 0; r < 4; ++r) { const int i = (r * nblk + blk) * 512 + tid; if (i < n) __hip_atomic_store(p + i, 0.f, __ATOMIC_RELAXED, __HIP_MEMORY_SCOPE_AGENT); } }

#ifndef MK_PER_PHASE
#define MK_PER_PHASE 0
#endif
constexpr int NPH = 8;
#ifndef PROBE_PH
#define PROBE_PH -1
#endif
#ifndef PROBE_REP
#define PROBE_REP 1
#endif
#define REP(k) for (int rep_ = 0; rep_ < ((k) == PROBE_PH ? PROBE_REP : 1); ++rep_)
typedef const __attribute__((address_space(4))) Args* CArgs;
__device__ __forceinline__ CArgs kargs() { CArgs p = (CArgs)__builtin_amdgcn_kernarg_segment_ptr(); asm volatile("" : "+s"(p)); return p; }
__global__ void __launch_bounds__(512, 2) fwd(Args args_unused) {
    extern __shared__ __attribute__((aligned(16))) unsigned char lds_raw[];
    LAS unsigned char* lds = (LAS unsigned char*)lds_raw;
    volatile LAS unsigned* MISC = (volatile LAS unsigned*)(lds + MISC_OFF);
    const int blk = (int)blockIdx.x, nblk = (int)gridDim.x;
    if (threadIdx.x < 32) MISC[threadIdx.x] = 0u;
    __syncthreads();
    XcdBarrier bar;
#if MK_PER_PHASE
    int lo, hi;
    { CArgs ap = kargs(); lo = ap->ph_lo; hi = ap->ph_hi; unsigned* bw = (unsigned*)(ap->ws + WS_CTL) + CW_BAR; bar.bar = bw; bar.x = 0; bar.st = nullptr;
      if (hi - lo > 1) bar = xcd_barrier_post(bw, MISC + 8); }
#else
    { CArgs ap = kargs(); bar = xcd_barrier_post((unsigned*)(ap->ws + WS_CTL) + CW_BAR, MISC + 8); }
#endif
#if MK_PER_PHASE
#define IN(k) (lo <= (k) && (k) < hi)
#define SEAM(k) do { if (IN(k) && IN((k) + 1)) xcd_barrier(bar); } while (0)
#else
#define IN(k) true
#define SEAM(k) do { if ((k) + 1 < NL * NPH) xcd_barrier(bar); } while (0)
#endif
#define WSP(T, off) ((T*)(ws + (off)))
#pragma unroll 1
    for (int l = 0; l < NL; ++l) {
        const int pb = l * NPH;
        if (IN(pb + 0)) REP(0) {
            CArgs ap = kargs(); unsigned char* ws = ap->ws;
            ph_convw(lds, ap, l, blk, nblk);
            if (l == 0) ph_copy_x(ap->in[0], ap->out, WSP(bf16, WS_XB), WSP(float, WS_SSQA), blk, nblk);

        }
        SEAM(pb + 0);
        if (IN(pb + 1)) REP(1) {
            CArgs ap = kargs(); unsigned char* ws = ap->ws;
            pg8::Gemm g{WSP(bf16, WS_XB), WSP(bf16, WS_WIN), T_, NIN, DM, 0}; pg8::StaticOrder S; S.init(T_, NIN, nblk, blk);
            pg8::EpiIn E{WSP(float, WS_SSQA), WSP(bf16, WS_Q), WSP(bf16, WS_K), WSP(bf16, WS_V), WSP(bf16, WS_RW), ap->in[5] + l * 128, ap->in[6] + l * 128};
            pg8::gemm_phase<pg8::EpiIn, pg8::StaticOrder, true, true>(lds, g, S, E);
        }
        SEAM(pb + 1);
        if (IN(pb + 2)) REP(2) {
            CArgs ap = kargs(); unsigned char* ws = ap->ws; const int lm = l > 0 ? l - 1 : 0;
            rk::S1Args A; A.rw = WSP(bf16, WS_RW); A.mu = ap->in[10] + (size_t)l * 3360; A.w0 = ap->in[11] + l * 1024; A.a0 = ap->in[13] + l * 1024; A.v0 = ap->in[21] + lm * 1024; A.k_k = ap->in[16] + l * 1024; A.k_a = ap->in[17] + l * 1024;
            A.r_k = ap->in[18] + l * 1024; A.w2t = (const bf16*)(ws + WS_LORA + LORA_W2); A.a2t = (const bf16*)(ws + WS_LORA + LORA_A2); A.g2t = (const bf16*)(ws + WS_LORA + LORA_G2); A.v2t = (const bf16*)(ws + WS_LORA + LORA_V2);
            A.vfirst = WSP(bf16, WS_VFIRST); A.BV = WSP(bf16, WS_BV); A.GB = WSP(bf16, WS_GB); A.PG = WSP(bf16, WS_PG); A.QT = WSP(float, WS_QT); A.RP = WSP(bf16, WS_RP); A.Y0 = WSP(float, WS_Y0); A.act = ws + WS_PART + (size_t)blk * rk::ACT_WG_BYTES; A.layer = l; A.pad_ = 0;
            rk::ph_stage1(lds, A, blk, nblk);
        }
        SEAM(pb + 2);
        if (IN(pb + 3)) {
            CArgs ap = kargs(); unsigned char* ws = ap->ws;
            rk::ph_chain(WSP(bf16, WS_PG), WSP(float, WS_QT), WSP(bf16, WS_H0T), blk, nblk);
            att::Args A; A.Q = WSP(bf16, WS_Q); A.K = WSP(bf16, WS_K); A.V = WSP(bf16, WS_V); A.mixed = WSP(bf16, WS_MIXED); A.stash = WSP(float, WS_STASH); A.lq = ap->in[7] + l * 128; A.lk = ap->in[8] + l * 128; A.subln = ap->in[9] + l * 128; A.gq = ap->in[5] + l * 128; A.gk = ap->in[6] + l * 128;
            A.lam_init = ap->lam_init[l]; A.pad_ = 0;
            att::attn_phase(lds, A, blk, (unsigned*)(ws + WS_CTL) + CW_ATTQ + 64 * l, MISC + 16, WSP(float, WS_PART));
        }
        SEAM(pb + 3);
        if (IN(pb + 4)) REP(4) {
            CArgs ap = kargs(); unsigned char* ws = ap->ws;
            rk::S3Args A{WSP(bf16, WS_H0T), WSP(bf16, WS_RP), WSP(float, WS_Y0), WSP(bf16, WS_BV), WSP(bf16, WS_GB), ap->in[19] + l * 1024, ap->in[20] + l * 1024, WSP(bf16, WS_MIXED)};
            rk::ph_stage3(A, blk, nblk);
            att::Args B; B.Q = WSP(bf16, WS_Q); B.K = WSP(bf16, WS_K); B.V = WSP(bf16, WS_V); B.mixed = WSP(bf16, WS_MIXED); B.stash = WSP(float, WS_STASH); B.lq = ap->in[7] + l * 128; B.lk = ap->in[8] + l * 128; B.subln = ap->in[9] + l * 128;
            B.gq = ap->in[5] + l * 128; B.gk = ap->in[6] + l * 128; B.lam_init = ap->lam_init[l]; B.pad_ = 0;
            att::attn_combine(lds, B, blk, nblk, WSP(float, WS_PART));
        }
        SEAM(pb + 4);
        if (IN(pb + 5)) {
            CArgs ap = kargs(); unsigned char* ws = ap->ws;
            pg8::Gemm g{WSP(bf16, WS_MIXED), WSP(bf16, WS_WOUT), T_, DM, DM, 0}; pg8::StaticOrder S; S.init(T_, DM, nblk, blk);
            pg8::EpiRes E{ap->out, WSP(bf16, WS_XB), WSP(float, WS_SSQB), DM, 0};
            pg8::gemm_phase<pg8::EpiRes, pg8::StaticOrder, true, true>(lds, g, S, E);
        }
        SEAM(pb + 5);
        if (IN(pb + 6)) REP(6) {
            CArgs ap = kargs(); unsigned char* ws = ap->ws;
            pg8::Gemm g{WSP(bf16, WS_XB), WSP(bf16, WS_WUP), T_, DFF, DM, 0}; pg8::StaticOrder S; S.init(T_, DFF, nblk, blk);
            pg8::EpiUp E{WSP(float, WS_SSQB), WSP(bf16, WS_U), DFF, 0};
            pg8::gemm_phase<pg8::EpiUp, pg8::StaticOrder, true, true>(lds, g, S, E);
        }
        SEAM(pb + 6);
        if (IN(pb + 7)) {
            CArgs ap = kargs(); unsigned char* ws = ap->ws;
            pg8::Gemm g{WSP(bf16, WS_U), WSP(bf16, WS_WDOWN), T_, DM, DFF, 0}; pg8::StaticOrder S; S.init(T_, DM, nblk, blk);
            pg8::EpiRes E{ap->out, WSP(bf16, WS_XB), WSP(float, WS_SSQA), DM, 0};
            pg8::gemm_phase<pg8::EpiRes, pg8::StaticOrder, true, true>(lds, g, S, E);
        }
        SEAM(pb + 7);
    }
#undef IN
#undef SEAM
#undef WSP
}

extern "C" void kernel_launch(void* const* d_in, const int* in_sizes, int n_in, void* d_out, int out_size, void* d_ws, size_t ws_size, hipStream_t stream) {
    static int grid = 0;
    if (grid == 0) {
        grid = -1;
        if (n_in != 26 || ws_size < WS_END || out_size != T_ * DM) { fprintf(stderr, "kernel_launch: unexpected shapes (n_in %d ws %zu out %d)\n", n_in, ws_size, out_size); return; }
        int dev = 0, cus = 0, per_cu = 0;
        if (hipGetDevice(&dev) != hipSuccess || hipDeviceGetAttribute(&cus, hipDeviceAttributeMultiprocessorCount, dev) != hipSuccess) return;
        if (hipFuncSetAttribute((const void*)fwd, hipFuncAttributeMaxDynamicSharedMemorySize, LDS_BYTES) != hipSuccess) return;
        if (hipOccupancyMaxActiveBlocksPerMultiprocessor(&per_cu, (const void*)fwd, 512, LDS_BYTES) != hipSuccess || per_cu < 1) { fprintf(stderr, "kernel_launch: occupancy query says %d\n", per_cu); (void)hipGetLastError(); return; }
        if (cus < 8) return;
        grid = cus;
    }
    if (grid < 0) return;
    if (hipMemsetAsync((char*)d_ws + WS_CTL, 0, CTL_ZERO_BYTES, stream) != hipSuccess) return;
    Args a;
    memset(&a, 0, sizeof(a));
    for (int i = 0; i < 26; ++i) a.in[i] = (const float*)d_in[i];
    a.out = (float*)d_out; a.ws = (unsigned char*)d_ws;
    for (int l = 0; l < NL; ++l) a.lam_init[l] = (float)(0.8 - 0.6 * exp(-0.3 * (double)l));
    const int nph = NL * NPH;
#if MK_PER_PHASE
    for (int p = 0; p < nph; ++p) { a.ph_lo = p; a.ph_hi = p + 1; hipLaunchKernelGGL(fwd, dim3(grid), dim3(512), LDS_BYTES, stream, a); }
#else
    a.ph_lo = 0; a.ph_hi = nph; hipLaunchKernelGGL(fwd, dim3(grid), dim3(512), LDS_BYTES, stream, a);
#endif
}
```

```cpp
#include <hip/hip_runtime.h>
#include <cstdio>
#include <cstdint>
#include <cstring>
#include <cmath>

constexpr int T_ = 16384, DM = 2048, NL = 4, PW = 6432, NIN = 6656, RWP = 3584, DFF = 8192, RW_ = 1024;
constexpr float RMS_EPS = 1e-6f, GN_EPS = 64e-5f;
typedef unsigned short bf16;
typedef float f32x4 __attribute__((ext_vector_type(4)));
typedef unsigned u32x4 __attribute__((ext_vector_type(4)));
typedef unsigned u32x2 __attribute__((ext_vector_type(2)));
#define LAS __attribute__((address_space(3)))

__device__ __forceinline__ unsigned f2bf(float f) { unsigned u = __builtin_bit_cast(unsigned, f); return (u + 0x7fffu + ((u >> 16) & 1u)) >> 16; }
__device__ __forceinline__ float bf2f(unsigned short b) { return __builtin_bit_cast(float, (unsigned)b << 16); }
__device__ __forceinline__ float bflo(unsigned w) { return __builtin_bit_cast(float, w << 16); }
__device__ __forceinline__ float bfhi(unsigned w) { return __builtin_bit_cast(float, w & 0xffff0000u); }
__device__ __forceinline__ float sigmoidf_(float x) { return 1.0f / (1.0f + __expf(-x)); }

template <int CTRL, int ROWMASK> __device__ __forceinline__ float dppf(float v) {
    return __builtin_bit_cast(float, __builtin_amdgcn_update_dpp(0, __builtin_bit_cast(int, v), CTRL, ROWMASK, 0xF, false));
}
__device__ __forceinline__ float wave_sum(float v) {
    v += dppf<0xB1, 0xF>(v); v += dppf<0x4E, 0xF>(v); v += dppf<0x141, 0xF>(v); v += dppf<0x140, 0xF>(v);
    v += dppf<0x142, 0xA>(v); v += dppf<0x143, 0xC>(v);
    return __builtin_bit_cast(float, __builtin_amdgcn_readlane(__builtin_bit_cast(int, v), 63));
}
__device__ __forceinline__ int opq_tid() { int t = (int)threadIdx.x; asm volatile("" : "+v"(t)); return t; }
namespace pg8 {
#define PG8_LAS __attribute__((address_space(3)))
typedef unsigned short bf16_t;
typedef short bf16x8 __attribute__((ext_vector_type(8)));
typedef float f32x4 __attribute__((ext_vector_type(4)));
typedef unsigned u32x4 __attribute__((ext_vector_type(4)));
constexpr int BM = 256, BK = 64, HALF = 128, HTB = HALF * BK * 2  , STAGE_BYTES = 8 * HTB, NXCD = 8, WGM = 8;

__host__ __device__ __forceinline__ int lds_byte(int r, int c) { const int st = (r >> 4) * 2 + (c >> 5), rr = r & 15, cc = c & 31, ob = rr * 64 + cc * 2; return st * 1024 + (ob ^ (((ob >> 9) & 1) << 5)); }
__host__ __device__ __forceinline__ void stage_rc(int b, int& R, int& C) { const int st = b / 1024, sb = b % 1024, swz = sb ^ (((sb >> 9) & 1) << 5); R = (st >> 1) * 16 + swz / 64; C = (st & 1) * 32 + (swz % 64) / 2; }
__host__ __device__ __forceinline__ int perm32(int rho) { const int n = rho >> 4, i = rho & 15; return 8 * (i >> 2) + 4 * n + (i & 3); }

struct Unit { int pm, pn; };
struct Gemm { const bf16_t* A; const bf16_t* Bt; int M, N, K, pad_; };

struct StaticOrder {
    int nM, nN, nwg, G, c;
    __host__ __device__ void init(int M, int N, int G_, int c_) { nM = M / BM; nN = N / BM; nwg = nM * nN; G = G_; c = c_; }
    __host__ __device__ bool next(int i, Unit& u) const {
        const long L = (long)i * G + c; if (L >= nwg) return false;
        int wgid = (int)L; { const int q = nwg / NXCD, r = nwg % NXCD, xcd = wgid % NXCD, off = wgid / NXCD; wgid = (xcd < r ? xcd * (q + 1) : r * (q + 1) + (xcd - r) * q) + off; }
        const int nig = WGM * nN, gid = wgid / nig, fm = gid * WGM, gsz = (nM - fm) < WGM ? (nM - fm) : WGM;
        u.pm = fm + ((wgid % nig) % gsz); u.pn = (wgid % nig) / gsz; return true;
    }
    __device__ __forceinline__ void a_ready(const Unit&) const {}
    __device__ __forceinline__ void done(const Unit&) const {}
};

__device__ __forceinline__ unsigned cvt_pk_bf16(float lo, float hi) { unsigned r; asm volatile("v_cvt_pk_bf16_f32 %0, %1, %2" : "=v"(r) : "v"(lo), "v"(hi)); return r; }
typedef float f32x2 __attribute__((ext_vector_type(2)));
__device__ __forceinline__ float row_ssq(const float* ssq, int row, int fq) {
    const f32x4 a = *(const f32x4*)(ssq + (size_t)row * 32 + 8 * fq), b = *(const f32x4*)(ssq + (size_t)row * 32 + 8 * fq + 4);
    float s = ((a[0] + a[1]) + (a[2] + a[3])) + ((b[0] + b[1]) + (b[2] + b[3]));
    s += __shfl_xor(s, 16); s += __shfl_xor(s, 32); return s;
}
struct EpiIn {
    static constexpr bool PERM = true, AFTER_DRAIN = false;
    const float* rinv; bf16_t* q; bf16_t* k; bf16_t* v; bf16_t* rw; const float* gq; const float* gk;
    __device__ __forceinline__ void operator()(const f32x4 (&acc)[2][2][4][2], const Unit& u, int wr, int wc, int fr, int fq) const {
        const int pn = u.pn;
        const int row0 = u.pm * BM + wr * 64 + fr;
        if (pn < 8) {
            const float* g = (pn < 4 ? gq : gk) + (wc & 1) * 64 + 8 * fq;
            f32x4 gv[2][2];
#pragma unroll
            for (int bj = 0; bj < 2; ++bj)
#pragma unroll
                for (int n = 0; n < 2; ++n) gv[bj][n] = *(const f32x4*)(g + 32 * bj + 4 * n);
            bf16_t* base = (pn < 4 ? q : k) + (pn & 3) * 256 + 64 * wc + 8 * fq;
#pragma unroll
            for (int ai = 0; ai < 2; ++ai)
#pragma unroll
                for (int m = 0; m < 4; ++m) {
                    const int row = row0 + ai * HALF + m * 16; const float ri = 1.0f / sqrtf(row_ssq(rinv, row, fq) * (1.0f / 2048.0f) + 1e-6f);
                    f32x4 vv[2][2]; float ss = 0.f;
#pragma unroll
                    for (int bj = 0; bj < 2; ++bj)
#pragma unroll
                        for (int n = 0; n < 2; ++n) { vv[bj][n] = acc[ai][bj][m][n] * ri; const f32x4 t = vv[bj][n]; ss += (t[0] * t[0] + t[1] * t[1]) + (t[2] * t[2] + t[3] * t[3]); }
                    ss += __shfl_xor(ss, 16); ss += __shfl_xor(ss, 32);
                    const float rq = 1.0f / sqrtf(ss * (1.0f / 64.0f) + 1e-6f);
#pragma unroll
                    for (int bj = 0; bj < 2; ++bj) { const f32x4 a = vv[bj][0] * rq * gv[bj][0], b = vv[bj][1] * rq * gv[bj][1];
                        u32x4 w; w.x = cvt_pk_bf16(a[0], a[1]); w.y = cvt_pk_bf16(a[2], a[3]); w.z = cvt_pk_bf16(b[0], b[1]); w.w = cvt_pk_bf16(b[2], b[3]);
                        *(u32x4*)(base + (size_t)row * 1024 + 32 * bj) = w; }
                }
        } else {
            bf16_t* base; int ld;
            if (pn < 12) { base = v + (pn - 8) * 256 + 64 * wc + 8 * fq; ld = 1024; } else { base = rw + (pn - 12) * 256 + 64 * wc + 8 * fq; ld = 3584; }
#pragma unroll
            for (int ai = 0; ai < 2; ++ai)
#pragma unroll
                for (int m = 0; m < 4; ++m) {
                    const int row = row0 + ai * HALF + m * 16; const float ri = 1.0f / sqrtf(row_ssq(rinv, row, fq) * (1.0f / 2048.0f) + 1e-6f);
#pragma unroll
                    for (int bj = 0; bj < 2; ++bj) { const f32x4 a = acc[ai][bj][m][0] * ri, b = acc[ai][bj][m][1] * ri;
                        u32x4 w; w.x = cvt_pk_bf16(a[0], a[1]); w.y = cvt_pk_bf16(a[2], a[3]); w.z = cvt_pk_bf16(b[0], b[1]); w.w = cvt_pk_bf16(b[2], b[3]);
                        *(u32x4*)(base + (size_t)row * ld + 32 * bj) = w; }
                }
        }
    }
};
struct EpiRes {
    static constexpr bool PERM = true, AFTER_DRAIN = false;
    bf16_t* xb; float* ssq; float* fout; int ldc; int pad_;
    __device__ __forceinline__ void operator()(const f32x4 (&acc)[2][2][4][2], const Unit& u, int wr, int wc, int fr, int fq) const {
        const int row0 = u.pm * BM + wr * 64 + fr, col0 = u.pn * BM + wc * 32 + 8 * fq;
#pragma unroll
        for (int ai = 0; ai < 2; ++ai) {
            u32x4 xo[4][2];
#pragma unroll
            for (int m = 0; m < 4; ++m)
#pragma unroll
                for (int bj = 0; bj < 2; ++bj) xo[m][bj] = *(const u32x4*)(xb + (size_t)(row0 + ai * HALF + m * 16) * ldc + col0 + bj * HALF);
#pragma unroll
            for (int m = 0; m < 4; ++m) { const int row = row0 + ai * HALF + m * 16; bf16_t* rowb = xb + (size_t)row * ldc + col0; float ss = 0.f;
#pragma unroll
                for (int bj = 0; bj < 2; ++bj) { const u32x4 w0 = xo[m][bj];
                    f32x4 o0 = acc[ai][bj][m][0], o1 = acc[ai][bj][m][1];
                    o0[0] += __builtin_bit_cast(float, w0.x << 16); o0[1] += __builtin_bit_cast(float, w0.x & 0xffff0000u); o0[2] += __builtin_bit_cast(float, w0.y << 16); o0[3] += __builtin_bit_cast(float, w0.y & 0xffff0000u);
                    o1[0] += __builtin_bit_cast(float, w0.z << 16); o1[1] += __builtin_bit_cast(float, w0.z & 0xffff0000u); o1[2] += __builtin_bit_cast(float, w0.w << 16); o1[3] += __builtin_bit_cast(float, w0.w & 0xffff0000u);
                    ss += ((o0[0] * o0[0] + o0[1] * o0[1]) + (o0[2] * o0[2] + o0[3] * o0[3])) + ((o1[0] * o1[0] + o1[1] * o1[1]) + (o1[2] * o1[2] + o1[3] * o1[3]));
                    u32x4 w; w.x = cvt_pk_bf16(o0[0], o0[1]); w.y = cvt_pk_bf16(o0[2], o0[3]); w.z = cvt_pk_bf16(o1[0], o1[1]); w.w = cvt_pk_bf16(o1[2], o1[3]);
                    *(u32x4*)(rowb + bj * HALF) = w;
                    if (fout) { f32x4* p = (f32x4*)(fout + (size_t)row * ldc + col0 + bj * HALF); p[0] = o0; p[1] = o1; } }
                ss += __shfl_xor(ss, 16); ss += __shfl_xor(ss, 32);
                if (fq == 0) ssq[(size_t)row * 32 + u.pn * 4 + wc] = ss; }
        }
    }
};
struct EpiUp {
    static constexpr bool PERM = true, AFTER_DRAIN = false;
    const float* rinv; bf16_t* o; int ldc; int pad_;
    __device__ __forceinline__ void operator()(const f32x4 (&acc)[2][2][4][2], const Unit& u, int wr, int wc, int fr, int fq) const {
        const int row0 = u.pm * BM + wr * 64 + fr, col0 = u.pn * BM + wc * 32 + 8 * fq;
#pragma unroll
        for (int ai = 0; ai < 2; ++ai)
#pragma unroll
            for (int m = 0; m < 4; ++m) { const int row = row0 + ai * HALF + m * 16; const float ri = 1.0f / sqrtf(row_ssq(rinv, row, fq) * (1.0f / 2048.0f) + 1e-6f);   bf16_t* rowp = o + (size_t)row * ldc + col0;
#pragma unroll
                for (int bj = 0; bj < 2; ++bj) { f32x4 a = acc[ai][bj][m][0] * ri, b = acc[ai][bj][m][1] * ri;
#pragma unroll
                    for (int e = 0; e < 4; ++e) { a[e] = a[e] > 0.f ? a[e] * a[e] : 0.f; b[e] = b[e] > 0.f ? b[e] * b[e] : 0.f; }
                    u32x4 w; w.x = cvt_pk_bf16(a[0], a[1]); w.y = cvt_pk_bf16(a[2], a[3]); w.z = cvt_pk_bf16(b[0], b[1]); w.w = cvt_pk_bf16(b[2], b[3]);
                    *(u32x4*)(rowp + bj * HALF) = w; } }
    }
};
template <class Epi, class Sched, bool ALIGN_EPI = false, bool SP2 = false>
__device__ __forceinline__ void gemm_phase(PG8_LAS unsigned char* lds, const Gemm g, const Sched& S, const Epi& E) {
    const int tid = opq_tid(), wid = __builtin_amdgcn_readfirstlane(tid >> 6), lane = tid & 63, wr = wid >> 2, wc = wid & 3, fr = lane & 15, fq = lane >> 4;
    const int K = g.K, nt = K / BK;
    unsigned voffA[2], voffB[2];
#pragma unroll
    for (int i = 0; i < 2; ++i) { int R, C; stage_rc(tid * 16 + i * 8192, R, C); const int Rb = Epi::PERM ? ((R & ~31) + perm32(R & 31)) : R;
        voffA[i] = (unsigned)(R * K + C) * 2u; voffB[i] = (unsigned)(Rb * K + C) * 2u; }
    const size_t kstep = (size_t)(BK * 2);
    const size_t hstep = (size_t)HALF * K * 2;
    const size_t tstep = 2 * hstep;
    const unsigned ldsw = (unsigned)wid * 1024u;
    const int aoff = lds_byte(wr * 64 + fr, fq * 8), boff = lds_byte(wc * 32 + fr, fq * 8);
#define PG8_SA(b, h) (((b) * 2 + (h)) * HTB)
#define PG8_SB(b, h) ((4 + (b) * 2 + (h)) * HTB)
#define PG8_STAGE(bufoff, gbase, voff) do { _Pragma("unroll") for (int _i = 0; _i < 2; ++_i) \
        __builtin_amdgcn_global_load_lds((const unsigned*)((const char*)(gbase) + (voff)[_i]), (PG8_LAS unsigned*)(lds + (bufoff) + ldsw + _i * 8192), 16, 0, 0); } while (0)
#define PG8_LDA(dst, b, h) do { _Pragma("unroll") for (int m = 0; m < 4; ++m) _Pragma("unroll") for (int k = 0; k < 2; ++k) dst[m][k] = *(const PG8_LAS bf16x8*)(lds + PG8_SA(b, h) + aoff + m * 2048 + k * 1024); } while (0)
#define PG8_LDB(dst, b, h) do { _Pragma("unroll") for (int n = 0; n < 2; ++n) _Pragma("unroll") for (int k = 0; k < 2; ++k) dst[n][k] = *(const PG8_LAS bf16x8*)(lds + PG8_SB(b, h) + boff + n * 2048 + k * 1024); } while (0)
#define PG8_MMA(ai, bj, At, Bt) do { __builtin_amdgcn_s_setprio(1); _Pragma("unroll") for (int m = 0; m < 4; ++m) _Pragma("unroll") for (int n = 0; n < 2; ++n) _Pragma("unroll") for (int k = 0; k < 2; ++k) \
        acc[ai][bj][m][n] = __builtin_amdgcn_mfma_f32_16x16x32_bf16(Bt[n][k], At[m][k], acc[ai][bj][m][n], 0, 0, 0); __builtin_amdgcn_s_setprio(0); } while (0)
#define PG8_WAIT_V(n) asm volatile("s_waitcnt vmcnt(" #n ")" ::: "memory")
#define PG8_WAIT_L(n) asm volatile("s_waitcnt lgkmcnt(" #n ")" ::: "memory")
#define PG8_BAR __builtin_amdgcn_s_barrier()
#define PG8_SCHED __builtin_amdgcn_sched_barrier(0)
    Unit cur, nxt; int ui = 0;
    if (!S.next(0, cur)) return;
    f32x4 acc[2][2][4][2];
#pragma unroll
    for (int a = 0; a < 2; ++a)
#pragma unroll
        for (int b = 0; b < 2; ++b)
#pragma unroll
            for (int m = 0; m < 4; ++m)
#pragma unroll
                for (int n = 0; n < 2; ++n) acc[a][b][m][n] = (f32x4){0.f, 0.f, 0.f, 0.f};
    bf16x8 At[4][2], B0[2][2], B1[2][2];
    const char* cA = (const char*)g.A + (size_t)cur.pm * tstep; const char* cB = (const char*)g.Bt + (size_t)cur.pn * tstep;
    S.a_ready(cur);
    if constexpr (SP2) {
        PG8_STAGE(PG8_SB(0, 0), cB, voffB); PG8_STAGE(PG8_SB(0, 1), cB + hstep, voffB); PG8_STAGE(PG8_SA(0, 0), cA, voffA); PG8_STAGE(PG8_SA(0, 1), cA + hstep, voffA);
        if (wr == 1) PG8_BAR;
        PG8_WAIT_V(2); PG8_BAR;
        PG8_STAGE(PG8_SB(1, 0), cB + kstep, voffB); PG8_STAGE(PG8_SA(1, 0), cA + kstep, voffA); PG8_STAGE(PG8_SB(1, 1), cB + hstep + kstep, voffB);
        PG8_WAIT_V(6); PG8_BAR;
    } else {
        PG8_STAGE(PG8_SB(0, 0), cB, voffB); PG8_STAGE(PG8_SA(0, 0), cA, voffA); PG8_STAGE(PG8_SB(0, 1), cB + hstep, voffB); PG8_STAGE(PG8_SA(0, 1), cA + hstep, voffA);
        if (wr == 1) PG8_BAR;
        PG8_WAIT_V(4); PG8_BAR;
        PG8_STAGE(PG8_SB(1, 0), cB + kstep, voffB); PG8_STAGE(PG8_SA(1, 0), cA + kstep, voffA); PG8_STAGE(PG8_SB(1, 1), cB + hstep + kstep, voffB);
        PG8_WAIT_V(6); PG8_BAR;
    }
    for (;;) {
        const bool has_next = S.next(ui + 1, nxt);
        const char* nA = has_next ? (const char*)g.A + (size_t)nxt.pm * tstep : cA; const char* nB = has_next ? (const char*)g.Bt + (size_t)nxt.pn * tstep : cB;
        for (int t = 0; t < nt; t += 2) {
            const bool last = (t == nt - 2);
            const char* a1 = cA + (size_t)(t + 1) * kstep;
            const char* a2 = last ? nA : cA + (size_t)(t + 2) * kstep; const char* b2 = last ? nB : cB + (size_t)(t + 2) * kstep;
            const char* a3 = a2 + kstep; const char* b3 = b2 + kstep;
            if (last && has_next) S.a_ready(nxt);
            if constexpr (SP2) {
            PG8_LDB(B0, 0, 0); PG8_LDB(B1, 0, 1); PG8_SCHED; PG8_LDA(At, 0, 0); PG8_STAGE(PG8_SA(1, 1), a1 + hstep, voffA);
            PG8_WAIT_V(8); PG8_WAIT_L(0); PG8_BAR; PG8_MMA(0, 0, At, B0); PG8_MMA(0, 1, At, B1); PG8_BAR; PG8_SCHED;
            PG8_LDA(At, 0, 1); PG8_STAGE(PG8_SB(0, 0), b2, voffB); PG8_STAGE(PG8_SB(0, 1), b2 + hstep, voffB); PG8_STAGE(PG8_SA(0, 0), a2, voffA);
            PG8_WAIT_V(8); PG8_WAIT_L(0); PG8_BAR; PG8_MMA(1, 0, At, B0); PG8_MMA(1, 1, At, B1); PG8_BAR; PG8_SCHED;
            PG8_LDB(B0, 1, 0); PG8_LDB(B1, 1, 1); PG8_SCHED; PG8_LDA(At, 1, 0); PG8_STAGE(PG8_SA(0, 1), a2 + hstep, voffA);
            PG8_WAIT_V(8); PG8_WAIT_L(0); PG8_BAR; PG8_MMA(0, 0, At, B0); PG8_MMA(0, 1, At, B1); PG8_BAR; PG8_SCHED;
            PG8_LDA(At, 1, 1); PG8_STAGE(PG8_SB(1, 0), b3, voffB); PG8_STAGE(PG8_SB(1, 1), b3 + hstep, voffB); PG8_STAGE(PG8_SA(1, 0), a3, voffA);
            PG8_WAIT_V(8); PG8_WAIT_L(0); PG8_BAR; PG8_MMA(1, 0, At, B0); PG8_MMA(1, 1, At, B1); PG8_BAR; PG8_SCHED;
            } else {
            PG8_LDB(B0, 0, 0); PG8_SCHED; PG8_LDA(At, 0, 0); PG8_STAGE(PG8_SA(1, 1), a1 + hstep, voffA);
            PG8_WAIT_L(8); PG8_BAR; PG8_WAIT_L(0); PG8_MMA(0, 0, At, B0); PG8_BAR; PG8_SCHED;
            PG8_LDB(B1, 0, 1); PG8_STAGE(PG8_SB(0, 0), b2, voffB);
            PG8_BAR; PG8_WAIT_L(0); PG8_MMA(0, 1, At, B1); PG8_BAR;
            PG8_LDA(At, 0, 1); PG8_STAGE(PG8_SA(0, 0), a2, voffA);
            PG8_BAR; PG8_WAIT_L(0); PG8_MMA(1, 0, At, B0); PG8_BAR; PG8_SCHED;
            PG8_STAGE(PG8_SB(0, 1), b2 + hstep, voffB);
            PG8_WAIT_V(6); PG8_BAR; PG8_MMA(1, 1, At, B1); PG8_BAR;
            PG8_LDB(B0, 1, 0); PG8_SCHED; PG8_LDA(At, 1, 0); PG8_STAGE(PG8_SA(0, 1), a2 + hstep, voffA);
            PG8_WAIT_L(8); PG8_BAR; PG8_WAIT_L(0); PG8_MMA(0, 0, At, B0); PG8_BAR; PG8_SCHED;
            PG8_LDB(B1, 1, 1); PG8_STAGE(PG8_SB(1, 0), b3, voffB);
            PG8_BAR; PG8_WAIT_L(0); PG8_MMA(0, 1, At, B1); PG8_BAR;
            PG8_LDA(At, 1, 1); PG8_STAGE(PG8_SA(1, 0), a3, voffA);
            PG8_BAR; PG8_WAIT_L(0); PG8_MMA(1, 0, At, B0); PG8_BAR; PG8_SCHED;
            PG8_STAGE(PG8_SB(1, 1), b3 + hstep, voffB);
            PG8_WAIT_V(6); PG8_BAR; PG8_MMA(1, 1, At, B1); PG8_BAR;
            }
        }
        if constexpr (ALIGN_EPI) { if (wr == 0) PG8_BAR; }
        if constexpr (!Epi::AFTER_DRAIN) { E(acc, cur, wr, wc, fr, fq); S.done(cur); }
        if (!has_next) break;
#pragma unroll
        for (int a = 0; a < 2; ++a)
#pragma unroll
            for (int b = 0; b < 2; ++b)
#pragma unroll
                for (int m = 0; m < 4; ++m)
#pragma unroll
                    for (int n = 0; n < 2; ++n) acc[a][b][m][n] = (f32x4){0.f, 0.f, 0.f, 0.f};
        cur = nxt; cA = nA; cB = nB; ++ui;
        if constexpr (ALIGN_EPI) { if (wr == 1) PG8_BAR; }
    }
    PG8_WAIT_V(0);
    if constexpr (!ALIGN_EPI) { if (wr == 0) PG8_BAR; }
    PG8_BAR;
    if constexpr (Epi::AFTER_DRAIN) { E.fused(acc, cur, wr, wc, fr, fq, lds, wid, lane); S.done(cur); }
#undef PG8_SA
#undef PG8_SB
#undef PG8_STAGE
#undef PG8_LDA
#undef PG8_LDB
#undef PG8_MMA
#undef PG8_WAIT_V
#undef PG8_WAIT_L
#undef PG8_BAR
#undef PG8_SCHED
}
}

namespace att {
typedef short bf16x8 __attribute__((ext_vector_type(8)));
typedef short s16x4 __attribute__((ext_vector_type(4)));
typedef float f32x16 __attribute__((ext_vector_type(16)));
typedef float f32x2_t __attribute__((ext_vector_type(2)));
typedef __bf16 bf16x2_t __attribute__((ext_vector_type(2)));
typedef __attribute__((address_space(3))) const unsigned char* lds_cptr;
typedef short v4i16_t __attribute__((ext_vector_type(4)));
constexpr int KTILE = 8192, VTILE = 16384, KSLOT = 2 * KTILE, VSLOT = 2 * VTILE, LDS_K = 0, LDS_V = 2 * KSLOT, LDS_BYTES = 2 * KSLOT + 2 * VSLOT;
constexpr float LOG2E = 1.4426950408889634f, C2 = 0.125f * LOG2E;
__device__ __forceinline__ int crow(int r, int hi) { return (r & 3) + 8 * (r >> 2) + 4 * hi; }
__device__ __forceinline__ void glds16(const void* gsrc, unsigned lds_dst) { unsigned keep;
    asm volatile("s_mov_b32 %0, m0\n\ts_mov_b32 m0, %2\n\ts_nop 0\n\tglobal_load_lds_dwordx4 %1, off\n\ts_mov_b32 m0, %0" : "=&s"(keep) : "v"(gsrc), "s"(lds_dst) : "memory"); }
__device__ __forceinline__ unsigned cvtpk(float lo, float hi) { f32x2_t v = {lo, hi}; bf16x2_t b = __builtin_convertvector(v, bf16x2_t); return __builtin_bit_cast(unsigned, b); }
__device__ __forceinline__ s16x4 vtr(lds_cptr p) { return __builtin_bit_cast(s16x4, __builtin_amdgcn_ds_read_tr16_b64_v4i16((__attribute__((address_space(3))) v4i16_t*)p)); }
__device__ __forceinline__ float swap_max(float m) { auto rr = __builtin_amdgcn_permlane32_swap(__float_as_uint(m), __float_as_uint(m), false, false); return fmaxf(__uint_as_float(rr[0]), __uint_as_float(rr[1])); }
__device__ __forceinline__ float swap_sum(float m) { auto rr = __builtin_amdgcn_permlane32_swap(__float_as_uint(m), __float_as_uint(m), false, false); return __uint_as_float(rr[0]) + __uint_as_float(rr[1]); }
#define ATT_WAIT_BAR() asm volatile("s_waitcnt vmcnt(0) lgkmcnt(0)\n\ts_barrier" ::: "memory")

struct Args { const bf16* Q; const bf16* K; const bf16* V; bf16* mixed; float* stash; const float* lq; const float* lk; const float* subln; const float* gq; const float* gk; float lam_init; int pad_; };

constexpr int PART_G = 17, PART_SLOT_F = 512 * 4 * PART_G, MAX_SLOTS = 1700, SPLIT_MIN = 20, PART_TILES = 40, TAB_OFF = 102400;
__device__ __forceinline__ void attn_pass(__attribute__((address_space(3))) unsigned char* lds, const Args& A, int h, int qb, int c, int ta, int tb, int nw, f32x16 (&oT)[4], float& l_out, float& M_out) {
    const int tid = opq_tid(), lane = tid & 63, r32 = lane & 31, hi = lane >> 5; const int wid = __builtin_amdgcn_readfirstlane(tid >> 6);
    const int q0 = qb * 256 + wid * 32, qc = q0 >> 6;
    const float slope2 = exp2f(-(float)(h + 1)) * LOG2E;
    const unsigned lds0 = (unsigned)(uintptr_t)lds;
    const lds_cptr kp0 = (lds_cptr)lds + LDS_K + hi * 1024 + r32 * 16;
    const lds_cptr vp0 = (lds_cptr)lds + LDS_V + ((lane >> 4) & 1) * 32 + (lane & 3) * 8 + (4 * hi + ((lane & 15) >> 2)) * 64;
    const bf16* vsrc = A.V + (size_t)(16 * (wid & 3) + (lane >> 2)) * 1024 + h * 128 + (wid >> 2) * 32 + (lane & 3) * 8;
    const unsigned kdst = lds0 + LDS_K + wid * 1024, vdst = lds0 + LDS_V + (wid >> 2) * 4096 + (wid & 3) * 1024;
    const int qrel = (q0 & 63) + r32;
    const int tw0 = max(ta, max(0, qc - nw));
    const bf16* ksrc = A.K + (size_t)lane * 1024 + h * 128 + c * 64 + wid * 8;
    bf16x8 qr[4];
    { const bf16* qp = A.Q + (size_t)(q0 + r32) * 1024 + h * 128 + c * 64 + hi * 8;
#pragma unroll
      for (int d0 = 0; d0 < 4; ++d0) qr[d0] = *(const bf16x8*)(qp + d0 * 16); }
#pragma unroll
    for (int d0 = 0; d0 < 4; ++d0)
#pragma unroll
        for (int r = 0; r < 16; ++r) oT[d0][r] = 0.f;
    float l = 0.f, mu = 0.f;
    if (ta < tb) {
#define ATT_DMA(t_, so_, u_) do { const size_t go = (size_t)(t_) * 64 * 1024; \
            glds16(ksrc + go, (unsigned)__builtin_amdgcn_readfirstlane(kdst + (so_) * KSLOT + (u_) * KTILE)); glds16(vsrc + go, (unsigned)__builtin_amdgcn_readfirstlane(vdst + (so_) * VSLOT + (u_) * VTILE)); \
            glds16(vsrc + go + 64, (unsigned)__builtin_amdgcn_readfirstlane(vdst + (so_) * VSLOT + (u_) * VTILE + 8192)); } while (0)
        ATT_DMA(ta, 0u, 0u); if (ta + 1 < tb) ATT_DMA(ta + 1, 0u, 1u);
        ATT_WAIT_BAR();
#pragma unroll 1
        for (int T = ta; T < tb; T += 2) {
          const unsigned so = (unsigned)(((T - ta) >> 1) & 1);
          if (T + 2 < tb) { ATT_DMA(T + 2, so ^ 1u, 0u); if (T + 3 < tb) ATT_DMA(T + 3, so ^ 1u, 1u); }
#pragma unroll 1
          for (int u = 0; u < 2; ++u) {
            const int t = T + u, sl = 0; (void)sl;
            if (t >= tb) break;
            if (t >= tw0 && t <= qc) {
                const bool diag = (t == qc);
                f32x16 p0, p1;
                const float sc = slope2 * (1.0f / C2), base0 = (float)(4 * hi) * sc - mu * (1.0f / C2), base1 = base0 + 32.0f * sc;
                if (!diag) {
#pragma unroll
                    for (int r = 0; r < 16; ++r) { const float kr = (float)((r & 3) + 8 * (r >> 2)); p0[r] = __builtin_fmaf(kr, sc, base0); p1[r] = __builtin_fmaf(kr, sc, base1); }
                } else {
                    const float q2 = (float)(2 * qrel - 8 * hi);
#pragma unroll
                    for (int r = 0; r < 16; ++r) { const float kr = (float)((r & 3) + 8 * (r >> 2));
                        p0[r] = __builtin_fmaf(fminf(kr, q2 - kr) , sc, base0); p1[r] = __builtin_fmaf(fminf(kr, q2 - 64.0f - kr), sc, base1); }
                }
                const lds_cptr kp = kp0 + so * KSLOT + u * KTILE;
#pragma unroll
                for (int d0 = 0; d0 < 4; ++d0) {
                    const bf16x8 k0 = *(const __attribute__((address_space(3))) bf16x8*)(kp + d0 * 2048), k1 = *(const __attribute__((address_space(3))) bf16x8*)(kp + d0 * 2048 + 512);
                    p0 = __builtin_amdgcn_mfma_f32_32x32x16_bf16(k0, qr[d0], p0, 0, 0, 0);
                    p1 = __builtin_amdgcn_mfma_f32_32x32x16_bf16(k1, qr[d0], p1, 0, 0, 0);
                }
                const lds_cptr vp = vp0 + so * VSLOT + u * VTILE;
                bf16x8 vfA[4], vfB[4];
#define ATT_VLOAD(dst, d0_) do { _Pragma("unroll") for (int s = 0; s < 4; ++s) { const s16x4 lo = vtr(vp + (d0_) * 4096 + s * 1024), hh = vtr(vp + (d0_) * 4096 + s * 1024 + 512); \
                        dst[s] = (bf16x8){lo[0], lo[1], lo[2], lo[3], hh[0], hh[1], hh[2], hh[3]}; } } while (0)
#define ATT_PV(src, d0_) do { _Pragma("unroll") for (int s = 0; s < 4; ++s) oT[d0_] = __builtin_amdgcn_mfma_f32_32x32x16_bf16(src[s], pw[s], oT[d0_], 0, 0, 0); } while (0)
                ATT_VLOAD(vfA, 0);
                __builtin_amdgcn_sched_barrier(0);
                float rm = fmaxf(fmaxf(p0[0], p1[0]), p0[1]);
#pragma unroll
                for (int r = 1; r < 16; ++r) rm = fmaxf(fmaxf(rm, p1[r]), r + 1 < 16 ? p0[r + 1] : p1[r]);
                rm = swap_max(rm);
                const float dl = (t == tw0) ? C2 * rm : fmaxf(C2 * rm, 0.f);
                if (__any(dl != 0.f)) { const float f = __builtin_amdgcn_exp2f(-dl); l *= f;
#pragma unroll
                    for (int d0 = 0; d0 < 4; ++d0)
#pragma unroll
                        for (int r = 0; r < 16; ++r) oT[d0][r] *= f; }
                mu += dl;
                float ls = 0.f;
#pragma unroll
                for (int r = 0; r < 16; ++r) { p0[r] = __builtin_amdgcn_exp2f(p0[r] * C2 - dl); p1[r] = __builtin_amdgcn_exp2f(p1[r] * C2 - dl); ls += p0[r] + p1[r]; }
                l += ls;
                bf16x8 pw[4];
#pragma unroll
                for (int s = 0; s < 4; ++s) { u32x4 w;
#pragma unroll
                    for (int e = 0; e < 4; ++e) { const int r = 8 * (s & 1) + 2 * e; w[e] = (s < 2) ? cvtpk(p0[r], p0[r + 1]) : cvtpk(p1[r], p1[r + 1]); }
                    pw[s] = __builtin_bit_cast(bf16x8, w); }
                ATT_VLOAD(vfB, 1); __builtin_amdgcn_sched_barrier(0);
                ATT_PV(vfA, 0);
                ATT_VLOAD(vfA, 2); __builtin_amdgcn_sched_barrier(0);
                ATT_PV(vfB, 1);
                ATT_VLOAD(vfB, 3); __builtin_amdgcn_sched_barrier(0);
                ATT_PV(vfA, 2);
                __builtin_amdgcn_sched_barrier(0);
                ATT_PV(vfB, 3);
#undef ATT_VLOAD
#undef ATT_PV
                mu -= 64.0f * slope2;
            }
          }
          ATT_WAIT_BAR();
        }
#undef ATT_DMA
    }
    const int tl = min(qc, tb - 1);
    l_out = l; M_out = (tl >= tw0) ? mu + slope2 * 64.0f * (float)(tl + 1) : -1e30f;
}
__device__ __forceinline__ void attn_finalize(const Args& A, int h, int qb, const f32x16 (&o1)[4], f32x16 (&o2)[4], float lam) {
    const int tid = opq_tid(), lane = tid & 63, r32 = lane & 31, hi = lane >> 5; const int wid = __builtin_amdgcn_readfirstlane(tid >> 6);
    const int q0 = qb * 256 + wid * 32;
    float ss = 0.f;
#pragma unroll
    for (int d0 = 0; d0 < 4; ++d0)
#pragma unroll
        for (int r = 0; r < 16; ++r) { const float v = o1[d0][r] - lam * o2[d0][r]; o2[d0][r] = v; ss += v * v; }
    ss = swap_sum(ss);
    const float rn = (1.0f / sqrtf(ss * (1.0f / 128.0f) + RMS_EPS)) * (1.0f - A.lam_init);
    bf16* op = A.mixed + (size_t)(q0 + r32) * DM + h * 128;
#pragma unroll
    for (int d0 = 0; d0 < 4; ++d0)
#pragma unroll
        for (int g4 = 0; g4 < 4; ++g4) { const int d = 32 * d0 + 8 * g4 + 4 * hi; const f32x4 gg = *(const f32x4*)(A.subln + d);
            u32x2 w; w.x = cvtpk(o2[d0][4 * g4] * rn * gg[0], o2[d0][4 * g4 + 1] * rn * gg[1]); w.y = cvtpk(o2[d0][4 * g4 + 2] * rn * gg[2], o2[d0][4 * g4 + 3] * rn * gg[3]);
            *(u32x2*)(op + d) = w; }
}
struct Win { float smax0, smax1; };
__device__ __forceinline__ int win_nw(const Win& W, int h, int c) { const float smax = c ? W.smax1 : W.smax0, slope2 = exp2f(-(float)(h + 1)) * LOG2E, dmin = (2.0f * C2 * smax + 67.0f) / slope2; return (int)fminf(ceilf((dmin + 63.0f) * (1.0f / 64.0f)) - 1.0f, 256.0f); }
__device__ __forceinline__ void attn_windows(const Args& A, Win& W, float& lam) {
    const int lane = opq_tid() & 63;
    const float l0 = wave_sum(A.lq[lane] * A.lk[lane]), l1 = wave_sum(A.lq[64 + lane] * A.lk[64 + lane]);
    lam = __expf(l0) - __expf(l1) + A.lam_init;
#pragma unroll
    for (int c = 0; c < 2; ++c) { float a = fabsf(A.gq[c * 64 + lane]), b = fabsf(A.gk[c * 64 + lane]);
#pragma unroll
        for (int o = 1; o < 64; o <<= 1) { a = fmaxf(a, __shfl_xor(a, o)); b = fmaxf(b, __shfl_xor(b, o)); }
        const float smax = 64.0f * 1.02f * a * b; if (c == 0) W.smax0 = smax; else W.smax1 = smax; }
}
__device__ __forceinline__ int attn_ntile(const Win& W, int h, int qb, int c) { return 4 * qb + 4 - max(0, 4 * qb - win_nw(W, h, c)); }
__device__ __forceinline__ int attn_table(__attribute__((address_space(3))) unsigned char* lds, const Win& W) {
    volatile __attribute__((address_space(3))) unsigned* tab = (volatile __attribute__((address_space(3))) unsigned*)(lds + TAB_OFF);
    const int tid = opq_tid(), lane = tid & 63, wid = tid >> 6, qb = 63 - (tid >> 3), h = tid & 7;
    const int nt = max(attn_ntile(W, h, qb, 0), attn_ntile(W, h, qb, 1));
    int P = nt > SPLIT_MIN ? (nt + PART_TILES - 1) / PART_TILES : 0;
    int want = 2 * P, incl = want;
#pragma unroll
    for (int o = 1; o < 64; o <<= 1) { const int v = __shfl_up(incl, o); if (lane >= o) incl += v; }
    if (lane == 63) tab[1032 + wid] = (unsigned)incl;
    asm volatile("s_waitcnt lgkmcnt(0)" ::: "memory"); __builtin_amdgcn_s_barrier(); asm volatile("" ::: "memory");
    int sbase = 0;
#pragma unroll
    for (int w = 0; w < 8; ++w) sbase += (w < wid) ? (int)tab[1032 + w] : 0;
    const int sstart = sbase + incl - want;
    if (sstart + want > MAX_SLOTS) P = 0;
    const int cnt = P > 0 ? 2 * P : 1; int ci = cnt;
#pragma unroll
    for (int o = 1; o < 64; o <<= 1) { const int v = __shfl_up(ci, o); if (lane >= o) ci += v; }
    if (lane == 63) tab[1024 + wid] = (unsigned)ci;
    asm volatile("s_waitcnt lgkmcnt(0)" ::: "memory"); __builtin_amdgcn_s_barrier(); asm volatile("" ::: "memory");
    int ibase = 0, total = 0;
#pragma unroll
    for (int w = 0; w < 8; ++w) { const int v = (int)tab[1024 + w]; ibase += (w < wid) ? v : 0; total += v; }
    tab[tid] = (unsigned)(ibase + ci - cnt) | ((unsigned)P << 16); tab[512 + tid] = (unsigned)sstart;
    asm volatile("s_waitcnt lgkmcnt(0)" ::: "memory"); __builtin_amdgcn_s_barrier(); asm volatile("" ::: "memory");
    return total;
}
__device__ __forceinline__ void part_range(const Win& W, int h, int qb, int c, int P, int p, int& ta, int& tb) {
    const int NT = 4 * qb + 4, T0 = max(0, 4 * qb - win_nw(W, h, c)), len = (NT - T0 + P - 1) / P; ta = min(NT, T0 + p * len); tb = min(NT, ta + len);
}
__device__ __forceinline__ void attn_phase(__attribute__((address_space(3))) unsigned char* lds, const Args& A, int blk, unsigned* ctr, volatile __attribute__((address_space(3))) unsigned* qslot, float* part) {
    const int tid = opq_tid();
    Win W; float lam; attn_windows(A, W, lam);
    const int nitems = attn_table(lds, W);
    volatile __attribute__((address_space(3))) unsigned* tab = (volatile __attribute__((address_space(3))) unsigned*)(lds + TAB_OFF);
    float* st = A.stash + (size_t)blk * (64 * 512) + tid * 64;
    for (;;) {
        if (tid == 0) { const unsigned n = __hip_atomic_fetch_add(ctr, 1u, __ATOMIC_RELAXED, __HIP_MEMORY_SCOPE_AGENT); unsigned idx = 0;
            if (n < (unsigned)nitems) { int lo = 0, hi = 511; while (lo < hi) { const int mid = (lo + hi + 1) >> 1; if ((tab[mid] & 0xffffu) <= n) lo = mid; else hi = mid - 1; } idx = (unsigned)lo; }
            qslot[0] = n; qslot[1] = idx; }
        asm volatile("s_waitcnt vmcnt(0) lgkmcnt(0)" ::: "memory"); __builtin_amdgcn_s_barrier(); asm volatile("" ::: "memory");
        const unsigned n = qslot[0], idx = qslot[1];
        asm volatile("s_waitcnt lgkmcnt(0)" ::: "memory"); __builtin_amdgcn_s_barrier(); asm volatile("" ::: "memory");
        if (n >= (unsigned)nitems) break;
        const unsigned e = tab[idx]; const int P = (int)(e >> 16), sub = (int)(n - (e & 0xffffu)), h = (int)(idx & 7u), qb = 63 - (int)(idx >> 3);
        f32x16 oT[4]; float l, M;
        if (P == 0) {
#pragma unroll 1
            for (int c = 0; c < 2; ++c) {
                attn_pass(lds, A, h, qb, c, max(0, 4 * qb - win_nw(W, h, c)), 4 * qb + 4, win_nw(W, h, c), oT, l, M);
                const float il = 1.0f / swap_sum(l);
#pragma unroll
                for (int d0 = 0; d0 < 4; ++d0)
#pragma unroll
                    for (int r = 0; r < 16; ++r) oT[d0][r] *= il;
                if (c == 0) {
#pragma unroll
                    for (int d0 = 0; d0 < 4; ++d0)
#pragma unroll
                        for (int r = 0; r < 16; r += 4) *(f32x4*)(st + d0 * 16 + r) = (f32x4){oT[d0][r], oT[d0][r + 1], oT[d0][r + 2], oT[d0][r + 3]};
                } else { f32x16 o1[4];
#pragma unroll
                    for (int d0 = 0; d0 < 4; ++d0)
#pragma unroll
                        for (int r = 0; r < 16; r += 4) { const f32x4 v = *(const f32x4*)(st + d0 * 16 + r); o1[d0][r] = v[0]; o1[d0][r + 1] = v[1]; o1[d0][r + 2] = v[2]; o1[d0][r + 3] = v[3]; }
                    attn_finalize(A, h, qb, o1, oT, lam); }
            }
        } else {
            const int c = sub / P, p = sub % P; int ta, tb; part_range(W, h, qb, c, P, p, ta, tb);
            attn_pass(lds, A, h, qb, c, ta, tb, win_nw(W, h, c), oT, l, M);
            float* ps = part + (size_t)(tab[512 + idx] + (unsigned)sub) * PART_SLOT_F + tid * 4;
#pragma unroll
            for (int d0 = 0; d0 < 4; ++d0)
#pragma unroll
                for (int r = 0; r < 16; r += 4) *(f32x4*)(ps + (d0 * 4 + (r >> 2)) * 2048) = (f32x4){oT[d0][r], oT[d0][r + 1], oT[d0][r + 2], oT[d0][r + 3]};
            *(f32x4*)(ps + 16 * 2048) = (f32x4){l, M, 0.f, 0.f};
        }
    }
}
__device__ __forceinline__ void attn_combine(__attribute__((address_space(3))) unsigned char* lds, const Args& A, int blk, int nblk, const float* part) {
    const int tid = opq_tid();
    Win W; float lam; attn_windows(A, W, lam);
    (void)attn_table(lds, W);
    volatile __attribute__((address_space(3))) unsigned* tab = (volatile __attribute__((address_space(3))) unsigned*)(lds + TAB_OFF);
    int seen = 0, mine = blk, rnd = 0, base2 = nblk;
    for (int idx = 0; idx < 512; ++idx) {
        const unsigned e = tab[idx]; const int P = (int)(e >> 16); if (P == 0) continue;
        if (seen++ != mine) continue;
        rnd ^= 1; mine = rnd ? base2 + (nblk - 1 - blk) : base2 + nblk + blk; if (!rnd) base2 += 2 * nblk;

        const int h = idx & 7, qb = 63 - (idx >> 3);
        f32x16 o1[4], o2[4];
#pragma unroll 1
        for (int c = 0; c < 2; ++c) {
            const float* ps = part + (size_t)(tab[512 + idx] + (unsigned)(c * P)) * PART_SLOT_F + tid * 4;
            f32x4 lm[7]; float f[7];
#pragma unroll
            for (int p = 0; p < 7; ++p) lm[p] = p < P ? *(const f32x4*)(ps + (size_t)p * PART_SLOT_F + 16 * 2048) : (f32x4){0.f, -1e30f, 0.f, 0.f};
            float M = lm[0][1];
#pragma unroll
            for (int p = 1; p < 7; ++p) M = fmaxf(M, lm[p][1]);
            float L = 0.f;
#pragma unroll
            for (int p = 0; p < 7; ++p) { f[p] = __builtin_amdgcn_exp2f(lm[p][1] - M); L += lm[p][0] * f[p]; }
#pragma unroll
            for (int d0 = 0; d0 < 4; ++d0)
#pragma unroll
                for (int r = 0; r < 16; ++r) o2[d0][r] = 0.f;
            f32x4 hb[2][8];
#define ATT_HLOAD(hp_) do { if (((hp_) >> 1) < P) { const float* pp = ps + (size_t)((hp_) >> 1) * PART_SLOT_F + ((hp_) & 1) * 8 * 2048; \
                _Pragma("unroll") for (int q = 0; q < 8; ++q) hb[(hp_) & 1][q] = *(const f32x4*)(pp + q * 2048); } } while (0)
            ATT_HLOAD(0);
#pragma unroll
            for (int hp = 0; hp < 14; ++hp) {
                if (hp + 1 < 14) ATT_HLOAD(hp + 1);
                if ((hp >> 1) < P) { const float fp = f[hp >> 1];
#pragma unroll
                    for (int q = 0; q < 8; ++q) { const int d0 = 2 * (hp & 1) + (q >> 2), r = 4 * (q & 3); const f32x4 v = hb[hp & 1][q];
                        o2[d0][r] += v[0] * fp; o2[d0][r + 1] += v[1] * fp; o2[d0][r + 2] += v[2] * fp; o2[d0][r + 3] += v[3] * fp; } }
            }
#undef ATT_HLOAD
            const float il = 1.0f / swap_sum(L);
            if (c == 0) {
#pragma unroll
                for (int d0 = 0; d0 < 4; ++d0)
#pragma unroll
                    for (int r = 0; r < 16; ++r) o1[d0][r] = o2[d0][r] * il;
            } else {
#pragma unroll
                for (int d0 = 0; d0 < 4; ++d0)
#pragma unroll
                    for (int r = 0; r < 16; ++r) o2[d0][r] *= il;
            }
        }
        attn_finalize(A, h, qb, o1, o2, lam);
    }
}
}

namespace rk {
typedef short bf16x8 __attribute__((ext_vector_type(8)));
typedef short s16x4 __attribute__((ext_vector_type(4)));
typedef short v4i16_t __attribute__((ext_vector_type(4)));
typedef const LAS unsigned char* lcp;
constexpr int ST = 72, MATB = 64 * ST * 2, NST = 68, SLG = 168, SVL = 40;
constexpr int O_AT = 0, O_RT = MATB, O_BT = 2 * MATB, O_KT = 3 * MATB, O_VV = 4 * MATB, O_AAK = 5 * MATB, O_ARB = 6 * MATB, O_ARK = 7 * MATB, O_NN = 8 * MATB, O_GG = O_NN + 64 * NST * 4,
              O_G2 = O_AAK  , O_VG = O_ARK  , O_SEG = O_GG + 64 * NST * 4, O_GL = O_SEG + 2048,
              O_LW = O_GL + 256, O_LA = O_LW + MATB, O_LG = O_LA + MATB, O_VL = O_LG + 64 * SLG * 2, O_END = O_VL + 64 * SVL * 2,
              O_NB16 = O_LW  , O_WT = O_LW + MATB, O_U0T = O_LW + 2 * MATB, O_CB = O_LW + 3 * MATB  , CBS = 132;
static_assert(64 * NST * 4 <= 2 * MATB && O_END <= 156000 && O_CB + 16 * CBS * 4 <= O_END, "stage-1 LDS map");
__device__ __forceinline__ f32x4 mfma16(bf16x8 a, bf16x8 b, f32x4 c) { return __builtin_amdgcn_mfma_f32_16x16x32_bf16(a, b, c, 0, 0, 0); }
__device__ __forceinline__ s16x4 vtr(lcp p) { return __builtin_bit_cast(s16x4, __builtin_amdgcn_ds_read_tr16_b64_v4i16((LAS v4i16_t*)p)); }
__device__ __forceinline__ bf16x8 frag(lcp m, int row0, int ks, int lane, int st = ST) { return *(const LAS bf16x8*)(m + ((row0 + (lane & 15)) * st + 32 * ks + 8 * (lane >> 4)) * 2); }
__device__ __forceinline__ bf16x8 tfrag(lcp m, int c0, int ks, int lane) {
    const int i = lane & 15, q = i >> 2, p = i & 3, k0 = 32 * ks + 8 * (lane >> 4);
    const s16x4 lo = vtr(m + ((k0 + q) * ST + c0 + 4 * p) * 2), hi = vtr(m + ((k0 + 4 + q) * ST + c0 + 4 * p) * 2);
    return (bf16x8){lo[0], lo[1], lo[2], lo[3], hi[0], hi[1], hi[2], hi[3]};
}
__device__ __forceinline__ unsigned pk(float a, float b) { return f2bf(a) | (f2bf(b) << 16); }
#define RK_BAR() do { asm volatile("s_waitcnt lgkmcnt(0)" ::: "memory"); __builtin_amdgcn_s_barrier(); asm volatile("" ::: "memory"); } while (0)


constexpr int SOLVE_DEPTH = 3;
__host__ __device__ constexpr int solve_quads(int p) { return (2 * p + 1 + 3) / 4; }
typedef float f32x2 __attribute__((ext_vector_type(2)));
template <int P, int Q> struct SolveStep {
    static constexpr int NQ = solve_quads(P);
    template <int D, int PP, int QQ> struct Ahead { static constexpr int nxtP = (QQ + 1 < solve_quads(PP)) ? PP : PP + 1, nxtQ = (QQ + 1 < solve_quads(PP)) ? QQ + 1 : 0; using T = typename Ahead<D - 1, nxtP, nxtQ>::T; };
    template <int PP, int QQ> struct Ahead<0, PP, QQ> { using T = SolveStep<PP, QQ>; };
    static __device__ __forceinline__ void load(f32x4 (&ring)[SOLVE_DEPTH][2], int slot, LAS unsigned char* nn) {
        if constexpr (P < 32) { ring[slot][0] = *(const LAS f32x4*)(nn + ((2 * P) * NST + 4 * Q) * 4); ring[slot][1] = *(const LAS f32x4*)(nn + ((2 * P + 1) * NST + 4 * Q) * 4); }
    }
    template <int SLOT> static __device__ __forceinline__ void run(f32x2 (&x)[64], f32x2& a0, f32x2& a1, f32x4 (&ring)[SOLVE_DEPTH][2], LAS unsigned char* nn) {
        using AH = typename Ahead<SOLVE_DEPTH, P, Q>::T;
        const f32x4 n0 = ring[SLOT][0], n1 = ring[SLOT][1];
        asm volatile("" ::: "memory"); __builtin_amdgcn_sched_barrier(0);
        AH::load(ring, SLOT, nn);
        asm volatile("" ::: "memory"); __builtin_amdgcn_sched_barrier(0);
#pragma unroll
        for (int e = 0; e < 4; ++e)
            if (4 * Q + e < 2 * P) { a0 = __builtin_elementwise_fma((f32x2){n0[e], n0[e]}, x[4 * Q + e], a0); a1 = __builtin_elementwise_fma((f32x2){n1[e], n1[e]}, x[4 * Q + e], a1); }
        if constexpr (Q + 1 == NQ) {
            x[2 * P] = a0; asm volatile("" : "+v"(x[2 * P]));
            { constexpr int c = 2 * P, q = c / 4, e = c % 4; static_assert(q == Q, "column 2P lies in the pair's last quad"); a1 = __builtin_elementwise_fma((f32x2){n1[e], n1[e]}, x[c], a1); }
            x[2 * P + 1] = a1; asm volatile("" : "+v"(x[2 * P + 1]));
            if constexpr (P + 1 < 32) { a0 = x[2 * P + 2]; a1 = x[2 * P + 3]; SolveStep<P + 1, 0>::template run<(SLOT + 1) % SOLVE_DEPTH>(x, a0, a1, ring, nn); }
        } else {
            asm volatile("" : "+v"(a0), "+v"(a1));
            SolveStep<P, Q + 1>::template run<(SLOT + 1) % SOLVE_DEPTH>(x, a0, a1, ring, nn);
        }
    }
};

struct S1Args {
    const bf16* rw; const float* mu; const float* w0; const float* a0; const float* v0; const float* k_k; const float* k_a; const float* r_k;
    const bf16* w2t; const bf16* a2t; const bf16* g2t; const bf16* v2t;
    bf16* vfirst; bf16* BV; bf16* GB; bf16* PG; float* QT; bf16* RP; float* Y0; unsigned char* act; int layer; int pad_;
};
constexpr int ACT_LOGW = 0, ACT_AR = 262144, ACT_G = 524288, ACT_VG = 655360, ACT_WG_BYTES = 786432;
__device__ __forceinline__ float frcp(float x) { return __builtin_amdgcn_rcpf(x); }
__device__ __forceinline__ float fsigmoid(float x) { return frcp(1.0f + __expf(-x)); }
__device__ __forceinline__ float ftanh(float x) { const float e = __expf(-2.0f * fabsf(x)), t = (1.0f - e) * frcp(1.0f + e); return x < 0.f ? -t : t; }
__device__ __forceinline__ float ldbf(const bf16* p) { return bf2f(*p); }

__device__ __forceinline__ void stage1_latents(LAS unsigned char* lds, const S1Args& A, int t0) {
    const int tid = opq_tid();
#pragma unroll 1
    for (int bt = 0; bt < 5; ++bt) {
        float cur[8], prv[8], muv[8];
#pragma unroll
        for (int i = 0; i < 8; ++i) { const int idx = tid + 512 * (bt * 8 + i), tok = idx / 320, col = idx % 320, t = t0 + tok;
            const bf16* p = A.rw + (size_t)t * RWP + 3072 + col;
            cur[i] = ldbf(p); prv[i] = t > 0 ? ldbf(p - RWP + (col < 288 ? 0 : 32)) : 0.f; muv[i] = col < 288 ? A.mu[3072 + col] : 0.f; }
#pragma unroll
        for (int i = 0; i < 8; ++i) { const int idx = tid + 512 * (bt * 8 + i), tok = idx / 320, col = idx % 320;
            if (col < 288) { const float sft = cur[i] + muv[i] * (prv[i] - cur[i]);
                if (col < 64) *(LAS unsigned short*)(lds + O_LW + (tok * ST + col) * 2) = (unsigned short)f2bf(ftanh(sft));
                else if (col < 128) *(LAS unsigned short*)(lds + O_LA + (tok * ST + col - 64) * 2) = (unsigned short)f2bf(sft);
                else *(LAS unsigned short*)(lds + O_LG + (tok * SLG + col - 128) * 2) = (unsigned short)f2bf(fsigmoid(sft));
            } else *(LAS unsigned short*)(lds + O_VL + (tok * SVL + col - 288) * 2) = (unsigned short)f2bf(cur[i] + prv[i]); }
    }
}

struct LoraB { bf16x8 w[2], a[2], g[5], v; f32x4 w0c, a0c, v0c; };
__device__ __forceinline__ void lora_load(LoraB& B, const S1Args& A, int it, int lane) {
    const int rq = lane >> 4, l15 = lane & 15, ch0 = 16 * it, ch = ch0 + l15;
    const bf16* pw = A.w2t + (size_t)ch * 64 + 8 * rq; const bf16* pa = A.a2t + (size_t)ch * 64 + 8 * rq; const bf16* pg = A.g2t + (size_t)ch * 160 + 8 * rq; const bf16* pv = A.v2t + (size_t)ch * 32 + 8 * rq;
    B.w[0] = *(const bf16x8*)pw; B.w[1] = *(const bf16x8*)(pw + 32); B.a[0] = *(const bf16x8*)pa; B.a[1] = *(const bf16x8*)(pa + 32); B.v = *(const bf16x8*)pv;
#pragma unroll
    for (int ks = 0; ks < 5; ++ks) B.g[ks] = *(const bf16x8*)(pg + 32 * ks);
    B.w0c = *(const f32x4*)(A.w0 + ch0 + 4 * rq); B.a0c = *(const f32x4*)(A.a0 + ch0 + 4 * rq); B.v0c = *(const f32x4*)(A.v0 + ch0 + 4 * rq);
}
__device__ __forceinline__ void lora_item(LAS unsigned char* lds, const LoraB& B, const S1Args& A, int it, int lane) {
    const int rq = lane >> 4, l15 = lane & 15, h = it >> 2, j0 = 16 * (it & 3) + 4 * rq;
#pragma unroll 1
    for (int tb = 0; tb < 4; ++tb) {
        const f32x4 z = {0.f, 0.f, 0.f, 0.f};
        const f32x4 zw = mfma16(B.w[1], frag(lds + O_LW, 16 * tb, 1, lane), mfma16(B.w[0], frag(lds + O_LW, 16 * tb, 0, lane), z));
        const f32x4 za = mfma16(B.a[1], frag(lds + O_LA, 16 * tb, 1, lane), mfma16(B.a[0], frag(lds + O_LA, 16 * tb, 0, lane), z));
        const f32x4 zv = mfma16(B.v, frag(lds + O_VL, 16 * tb, 0, lane, SVL), z);
        f32x4 zg = z;
#pragma unroll
        for (int ks = 0; ks < 5; ++ks) zg = mfma16(B.g[ks], frag(lds + O_LG, 16 * tb, ks, lane, SLG), zg);
        const int o = (h * 64 + 16 * tb + l15) * 64 + j0;
        f32x4 lo_, ar_; u32x2 gg_, vg_; float vgf[4];
#pragma unroll
        for (int e = 0; e < 4; ++e) {
            const float zz = -(B.w0c[e] + zw[e]), sp = fmaxf(zz, 0.f) + __logf(1.0f + __expf(-fabsf(zz))), wl = -sp - 0.5f;
            lo_[e] = -__expf(wl);
            ar_[e] = fsigmoid(B.a0c[e] + za[e]);
            vgf[e] = fsigmoid(B.v0c[e] + zv[e]);
        }
        gg_.x = pk(zg[0], zg[1]); gg_.y = pk(zg[2], zg[3]); vg_.x = pk(vgf[0], vgf[1]); vg_.y = pk(vgf[2], vgf[3]);
        *(f32x4*)(A.act + ACT_LOGW + o * 4) = lo_; *(f32x4*)(A.act + ACT_AR + o * 4) = ar_; *(u32x2*)(A.act + ACT_G + o * 2) = gg_; *(u32x2*)(A.act + ACT_VG + o * 2) = vg_;
    }
}
__device__ __forceinline__ void stage1_lora_all(LAS unsigned char* lds, const S1Args& A) {
    const int tid = opq_tid(), lane = tid & 63, wid = __builtin_amdgcn_readfirstlane(tid >> 6);
    LoraB B0, B1;
    lora_load(B0, A, wid, lane);
#pragma unroll 1
    for (int k = 0; k < 8; k += 2) {
        lora_load(B1, A, wid + 8 * (k + 1), lane);
        lora_item(lds, B0, A, wid + 8 * k, lane);
        if (k + 2 < 8) lora_load(B0, A, wid + 8 * (k + 2), lane);
        lora_item(lds, B1, A, wid + 8 * (k + 1), lane);
    }
}
struct PreF { unsigned short r[9], k[9], v[9], vf[8], g[8], vg[8]; float lw[8], ar[8], mur, muk, muv, kkw, kaw, rkw; };
__device__ __forceinline__ void pref_load(PreF& P, const S1Args& A, int c, int h, int wid, int lane) {
    const int ch = h * 64 + lane, tf = c * 64 + 8 * wid;
    P.mur = A.mu[ch]; P.muk = A.mu[1024 + ch]; P.muv = A.mu[2048 + ch]; P.kkw = A.k_k[ch]; P.kaw = A.k_a[ch]; P.rkw = A.r_k[ch];
    const bf16* rp = A.rw + (size_t)tf * RWP + ch;
    if (tf > 0) { P.r[0] = rp[-RWP]; P.k[0] = rp[-RWP + 1024]; P.v[0] = rp[-RWP + 2048]; } else { P.r[0] = 0; P.k[0] = 0; P.v[0] = 0; }
#pragma unroll
    for (int e = 0; e < 8; ++e) { P.r[e + 1] = rp[(size_t)e * RWP]; P.k[e + 1] = rp[(size_t)e * RWP + 1024]; P.v[e + 1] = rp[(size_t)e * RWP + 2048];
        const int o = (h * 64 + 8 * wid + e) * 64 + lane;
        P.lw[e] = *(const float*)(A.act + ACT_LOGW + o * 4); P.ar[e] = *(const float*)(A.act + ACT_AR + o * 4); P.g[e] = *(const bf16*)(A.act + ACT_G + o * 2); P.vg[e] = *(const bf16*)(A.act + ACT_VG + o * 2);
        P.vf[e] = A.layer > 0 ? A.vfirst[(size_t)(tf + e) * 1024 + ch] : (unsigned short)0; }
}

__device__ __forceinline__ void stage1_unit(LAS unsigned char* lds, const S1Args& A, int c, int h, PreF& P) {
    const int tid = opq_tid(), lane = tid & 63, wid = __builtin_amdgcn_readfirstlane(tid >> 6), rq = lane >> 4, l15 = lane & 15;
    const int t0 = c * 64, uc = h * 256 + c;
    const int b0 = wid >> 1;
    LAS float* SEG = (LAS float*)(lds + O_SEG); LAS float* GL = (LAS float*)(lds + O_GL);
    for (int i = tid; i < 2 * MATB / 16; i += 512) *(LAS u32x4*)(lds + O_WT + i * 16) = (u32x4){0u, 0u, 0u, 0u};
    {
        const int j = lane, ch = h * 64 + j; float lw[8], cum[8], va[8], vb[8], vk[8], vr_[8], vv[8];
        const float mur = P.mur, muk = P.muk, muv = P.muv, kkw = P.kkw, kaw = P.kaw, rkw = P.rkw;
        const int tf = t0 + 8 * wid;
#pragma unroll
        for (int e = 0; e < 8; ++e) {
            const float cr = bf2f(P.r[e + 1]), ck = bf2f(P.k[e + 1]), cv = bf2f(P.v[e + 1]), pr = bf2f(P.r[e]), pk_ = bf2f(P.k[e]), pv = bf2f(P.v[e]);
            const float r = cr + mur * (pr - cr), kr = ck + muk * (pk_ - ck), vr = cv + muv * (pv - cv);
            lw[e] = P.lw[e];
            const float ar = P.ar[e], g = bf2f(P.g[e]), vg = bf2f(P.vg[e]);
            const float kkv = kr * kkw, ss = wave_sum(kkv * kkv), kk = kkv * __builtin_amdgcn_rsqf(fmaxf(ss, 1e-24f));
            va[e] = -kk; vb[e] = kk * ar; vk[e] = kr * (1.0f + (ar - 1.0f) * kaw); vr_[e] = r;
            const size_t go = (size_t)(tf + e) * 1024 + ch;
            float v;
            if (A.layer == 0) { v = vr; A.vfirst[go] = (bf16)f2bf(vr); } else { v = vr + (bf2f(P.vf[e]) - vr) * vg; }
            vv[e] = v;
            const float bonus = wave_sum(r * vk[e] * rkw);
            A.BV[go] = (bf16)f2bf(bonus * v); A.GB[go] = (bf16)f2bf(g);
        }
        cum[0] = lw[0];
#pragma unroll
        for (int e = 1; e < 8; ++e) cum[e] = cum[e - 1] + lw[e];
        SEG[wid * 64 + j] = cum[7];
        RK_BAR();
        float off = 0.f, tot = 0.f;
#pragma unroll
        for (int s = 0; s < 8; ++s) { const float v = SEG[s * 64 + j]; off += (s < wid) ? v : 0.f; tot += v; }
        if (wid == 0) GL[j] = __expf(tot);
        float gprev = __expf(off);
#pragma unroll
        for (int e = 0; e < 8; ++e) {
            const float cm = cum[e] + off, g = __expf(cm), gi = frcp(g), gp = gprev; gprev = g;
            const int o = ((8 * wid + e) * ST + j) * 2;
            *(LAS unsigned short*)(lds + O_AT + o) = (unsigned short)f2bf(va[e] * gp);
            *(LAS unsigned short*)(lds + O_BT + o) = (unsigned short)f2bf(vb[e] * gi);
            *(LAS unsigned short*)(lds + O_KT + o) = (unsigned short)f2bf(vk[e] * gi);
            *(LAS unsigned short*)(lds + O_RT + o) = (unsigned short)f2bf(vr_[e] * g);
            *(LAS unsigned short*)(lds + O_VV + o) = (unsigned short)f2bf(vv[e]);
        }
        RK_BAR();
    }
    {
        const bf16x8 bA0 = frag(lds + O_BT, 16 * b0, 0, lane), bA1 = frag(lds + O_BT, 16 * b0, 1, lane), kA0 = frag(lds + O_KT, 16 * b0, 0, lane), kA1 = frag(lds + O_KT, 16 * b0, 1, lane);
#pragma unroll
        for (int tt = 0; tt < 2; ++tt) {
            const int tb = 2 * (wid & 1) + tt;
            const bf16x8 aB0 = frag(lds + O_AT, 16 * tb, 0, lane), aB1 = frag(lds + O_AT, 16 * tb, 1, lane), rB0 = frag(lds + O_RT, 16 * tb, 0, lane), rB1 = frag(lds + O_RT, 16 * tb, 1, lane);
            const f32x4 z = {0.f, 0.f, 0.f, 0.f};
            f32x4 ab = mfma16(bA1, aB1, mfma16(bA0, aB0, z)), ak = mfma16(kA1, aB1, mfma16(kA0, aB0, z)), rb = mfma16(bA1, rB1, mfma16(bA0, rB0, z)), rk_ = mfma16(kA1, rB1, mfma16(kA0, rB0, z));
            const int tcol = 16 * tb + l15, srow = 16 * b0 + 4 * rq;
#pragma unroll
            for (int e = 0; e < 4; ++e) { const bool st = tcol > srow + e, le = tcol >= srow + e; ab[e] = st ? ab[e] : 0.f; ak[e] = st ? ak[e] : 0.f; rb[e] = le ? rb[e] : 0.f; rk_[e] = le ? rk_[e] : 0.f; }
            *(LAS f32x4*)(lds + O_NN + (tcol * NST + srow) * 4) = ab;
            const int o = (tcol * ST + srow) * 2;
            *(LAS u32x2*)(lds + O_NB16 + o) = (u32x2){pk(ab[0], ab[1]), pk(ab[2], ab[3])};
            *(LAS u32x2*)(lds + O_AAK + o) = (u32x2){pk(ak[0], ak[1]), pk(ak[2], ak[3])};
            *(LAS u32x2*)(lds + O_ARB + o) = (u32x2){pk(rb[0], rb[1]), pk(rb[2], rb[3])};
            *(LAS u32x2*)(lds + O_ARK + o) = (u32x2){pk(rk_[0], rk_[1]), pk(rk_[2], rk_[3])};
        }
        RK_BAR();
    }
    {
        const bf16x8 vA0 = tfrag(lds + O_VV, 16 * b0, 0, lane), vA1 = tfrag(lds + O_VV, 16 * b0, 1, lane);
#pragma unroll
        for (int tt = 0; tt < 2; ++tt) {
            const int tb = 2 * (wid & 1) + tt;
            const f32x4 z = {0.f, 0.f, 0.f, 0.f};
            const f32x4 g = mfma16(vA1, frag(lds + O_AAK, 16 * tb, 1, lane), mfma16(vA0, frag(lds + O_AAK, 16 * tb, 0, lane), z));
            *(LAS f32x4*)(lds + O_GG + ((16 * tb + l15) * NST + 16 * b0 + 4 * rq) * 4) = g;
        }
        RK_BAR();
    }
#pragma unroll 1
    for (int b = 0; b < 4; ++b) {
        if (b > 0) {
            const bf16x8 a0 = frag(lds + O_NB16, 16 * b, 0, lane), a1 = frag(lds + O_NB16, 16 * b, 1, lane);
            LAS unsigned char* xt = lds + (wid < 4 ? O_WT : O_U0T);
            const bf16x8 x0 = frag(xt, 16 * (wid & 3), 0, lane), x1 = frag(xt, 16 * (wid & 3), 1, lane);
            const f32x4 z = {0.f, 0.f, 0.f, 0.f};
            const f32x4 d = mfma16(a1, x1, mfma16(a0, x0, z));
#pragma unroll
            for (int e = 0; e < 4; ++e) *(LAS float*)(lds + O_CB + ((4 * rq + e) * CBS + 16 * wid + l15) * 4) = d[e];
            RK_BAR();
        }
        if (wid == 0) {
            f32x2 x[16];
            LAS unsigned char* rb_ = lds + (16 * b) * ST * 2 + lane * 2; LAS unsigned char* gb_ = lds + O_GG + ((16 * b) * NST + lane) * 4;
#pragma unroll
            for (int i = 0; i < 16; ++i) x[i] = (f32x2){bf2f(*(const LAS unsigned short*)(rb_ + O_AT + i * ST * 2)), *(const LAS float*)(gb_ + i * NST * 4)};
            if (b > 0) {
#pragma unroll
                for (int i = 0; i < 16; ++i) { x[i].x += *(const LAS float*)(lds + O_CB + (i * CBS + lane) * 4); x[i].y += *(const LAS float*)(lds + O_CB + (i * CBS + 64 + lane) * 4); }
            }
            LAS unsigned char* nn = lds + O_NN + ((16 * b) * NST + 16 * b) * 4; asm volatile("" : "+v"(nn));
            f32x4 qa[4], qc[4];
#define RK_DLOAD(buf, i_) do { _Pragma("unroll") for (int q = 0; q < 4; ++q) if (4 * q < (i_)) buf[q] = *(const LAS f32x4*)(nn + ((i_) * NST + 4 * q) * 4); } while (0)
#define RK_DROW(buf, i_) do { f32x2 acc = x[(i_)]; _Pragma("unroll") for (int q = 0; q < 4; ++q) { _Pragma("unroll") for (int e = 0; e < 4; ++e) if (4 * q + e < (i_)) acc = __builtin_elementwise_fma((f32x2){buf[q][e], buf[q][e]}, x[4 * q + e], acc); } \
                x[(i_)] = acc; asm volatile("" : "+v"(x[(i_)]) :: "memory"); __builtin_amdgcn_sched_barrier(0); } while (0)
            RK_DLOAD(qa, 1);
#pragma unroll
            for (int i = 1; i < 16; i += 2) {
                if (i + 1 < 16) RK_DLOAD(qc, i + 1);
                asm volatile("" ::: "memory"); __builtin_amdgcn_sched_barrier(0);
                RK_DROW(qa, i);
                if (i + 2 < 16) RK_DLOAD(qa, i + 2);
                asm volatile("" ::: "memory"); __builtin_amdgcn_sched_barrier(0);
                if (i + 1 < 16) RK_DROW(qc, i + 1);
            }
#undef RK_DLOAD
#undef RK_DROW
            LAS unsigned char* dw = lds + O_WT + lane * ST * 2 + 32 * b; LAS unsigned char* du = lds + O_U0T + lane * ST * 2 + 32 * b;
#pragma unroll
            for (int i = 0; i < 2; ++i) {
                *(LAS u32x4*)(dw + i * 16) = (u32x4){pk(x[8 * i].x, x[8 * i + 1].x), pk(x[8 * i + 2].x, x[8 * i + 3].x), pk(x[8 * i + 4].x, x[8 * i + 5].x), pk(x[8 * i + 6].x, x[8 * i + 7].x)};
                *(LAS u32x4*)(du + i * 16) = (u32x4){pk(x[8 * i].y, x[8 * i + 1].y), pk(x[8 * i + 2].y, x[8 * i + 3].y), pk(x[8 * i + 4].y, x[8 * i + 5].y), pk(x[8 * i + 6].y, x[8 * i + 7].y)}; }
        }
        if (b < 3) RK_BAR();
    }
    if (h + 1 < 16) { const int tid2 = opq_tid(); pref_load(P, A, c, h + 1, __builtin_amdgcn_readfirstlane(tid2 >> 6), tid2 & 63); }
    RK_BAR();
    {
        const int tid = opq_tid(), lane = tid & 63, wid = __builtin_amdgcn_readfirstlane(tid >> 6), rq = lane >> 4, l15 = lane & 15, b0 = wid >> 1;
        const bf16x8 wA0 = frag(lds + O_WT, 16 * b0, 0, lane), wA1 = frag(lds + O_WT, 16 * b0, 1, lane);
        const bf16x8 uA0 = frag(lds + O_U0T, 16 * b0, 0, lane), uA1 = frag(lds + O_U0T, 16 * b0, 1, lane);
        const bf16x8 vA0 = tfrag(lds + O_VV, 16 * b0, 0, lane), vA1 = tfrag(lds + O_VV, 16 * b0, 1, lane);
        const bf16x8 bA0 = tfrag(lds + O_BT, 16 * b0, 0, lane), bA1 = tfrag(lds + O_BT, 16 * b0, 1, lane);
        const bf16x8 kA0 = tfrag(lds + O_KT, 16 * b0, 0, lane), kA1 = tfrag(lds + O_KT, 16 * b0, 1, lane);
        const f32x4 glr = *(const LAS f32x4*)(lds + O_GL + (16 * b0 + 4 * rq) * 4);
#pragma unroll
        for (int tt = 0; tt < 2; ++tt) {
            const int nb = 2 * (wid & 1) + tt, col = 16 * nb + l15, row = 16 * b0 + 4 * rq;
            const f32x4 z = {0.f, 0.f, 0.f, 0.f};
            const bf16x8 rbB0 = frag(lds + O_ARB, 16 * nb, 0, lane), rbB1 = frag(lds + O_ARB, 16 * nb, 1, lane), rkB0 = frag(lds + O_ARK, 16 * nb, 0, lane), rkB1 = frag(lds + O_ARK, 16 * nb, 1, lane);
            { f32x4 d = mfma16(wA1, rbB1, mfma16(wA0, rbB0, z)); const u32x2 rt = *(const LAS u32x2*)(lds + O_RT + (col * ST + row) * 2);
              d[0] += bflo(rt.x); d[1] += bfhi(rt.x); d[2] += bflo(rt.y); d[3] += bfhi(rt.y);
              *(u32x2*)(A.RP + (size_t)(t0 + col) * 1024 + h * 64 + row) = (u32x2){pk(d[0], d[1]), pk(d[2], d[3])}; }
            { const f32x4 d = mfma16(vA1, rkB1, mfma16(vA0, rkB0, mfma16(uA1, rbB1, mfma16(uA0, rbB0, z))));
              *(f32x4*)(A.Y0 + (size_t)(t0 + col) * 1024 + h * 64 + row) = d; }
            { const bf16x8 bB0 = tfrag(lds + O_BT, 16 * nb, 0, lane), bB1 = tfrag(lds + O_BT, 16 * nb, 1, lane);
              f32x4 d = mfma16(wA1, bB1, mfma16(wA0, bB0, z)); const float gj = GL[col];
#pragma unroll
              for (int e = 0; e < 4; ++e) d[e] = gj * (d[e] + ((row + e) == col ? 1.f : 0.f));
              *(u32x2*)(A.PG + (size_t)uc * 4096 + ((((col >> 4) * 2 + (row >> 5)) * 64 + ((row >> 2) & 3) * 16 + (col & 15)) * 8 + ((row >> 4) & 1) * 4)) = (u32x2){pk(d[0], d[1]), pk(d[2], d[3])}; }
            { const bf16x8 uB0 = frag(lds + O_U0T, 16 * nb, 0, lane), uB1 = frag(lds + O_U0T, 16 * nb, 1, lane), vB0 = tfrag(lds + O_VV, 16 * nb, 0, lane), vB1 = tfrag(lds + O_VV, 16 * nb, 1, lane);
              f32x4 d = mfma16(kA1, vB1, mfma16(kA0, vB0, mfma16(bA1, uB1, mfma16(bA0, uB0, z))));
              d = d * glr;
              *(f32x4*)(A.QT + (size_t)uc * 4096 + ((((col >> 4) * 4 + (row >> 4)) * 64 + ((row >> 2) & 3) * 16 + (col & 15)) * 4)) = d; }
        }
    }
    RK_BAR();
}
__device__ __forceinline__ void ph_stage1(LAS unsigned char* lds, const S1Args& A, int blk, int nblk) {
    for (int c = blk; c < 256; c += nblk) {
        stage1_latents(lds, A, c * 64);
        RK_BAR();
        stage1_lora_all(lds, A);
        asm volatile("s_waitcnt vmcnt(0)" ::: "memory");
        RK_BAR();
        PreF P; { const int tid = opq_tid(); pref_load(P, A, c, 0, __builtin_amdgcn_readfirstlane(tid >> 6), tid & 63); }
#pragma unroll 1
        for (int h = 0; h < 16; ++h) stage1_unit(lds, A, c, h, P);
    }
}

struct ChainOps { bf16x8 a[4][2]; f32x4 c[4]; };
__device__ __forceinline__ void chain_load(ChainOps& o, const bf16* __restrict__ PG, const float* __restrict__ QT, int h, int ig, int c, int lane) {
    const bf16* P = PG + (size_t)(h * 256 + c) * 4096 + lane * 8; const float* Q = QT + (size_t)(h * 256 + c) * 4096 + (ig * 4 * 64 + lane) * 4;
#pragma unroll
    for (int m = 0; m < 4; ++m) { o.c[m] = *(const f32x4*)(Q + m * 256);
#pragma unroll
        for (int kb = 0; kb < 2; ++kb) o.a[m][kb] = *(const bf16x8*)(P + (m * 2 + kb) * 512); }
}
__device__ __forceinline__ void chain_step(f32x4 (&H)[4], const ChainOps& o, bf16* __restrict__ H0T, int h, int ig, int c, int lane) {
    const int fr = lane & 15, fq = lane >> 4;
    bf16* Ho = H0T + (size_t)(c * 16 + h) * 4096 + (16 * ig + fr) * 64 + 4 * fq;
    u32x4 bw[2];
#pragma unroll
    for (int m = 0; m < 4; ++m) { const u32x2 w = {pk(H[m][0], H[m][1]), pk(H[m][2], H[m][3])}; *(u32x2*)(Ho + 16 * m) = w; bw[m >> 1][2 * (m & 1)] = w.x; bw[m >> 1][2 * (m & 1) + 1] = w.y; }
#pragma unroll
    for (int m = 0; m < 4; ++m) H[m] = mfma16(o.a[m][1], __builtin_bit_cast(bf16x8, bw[1]), mfma16(o.a[m][0], __builtin_bit_cast(bf16x8, bw[0]), o.c[m]));
}
__device__ __forceinline__ void chain_wave(const bf16* __restrict__ PG, const float* __restrict__ QT, bf16* __restrict__ H0T, int h, int ig, int lane) {
    f32x4 H[4];
#pragma unroll
    for (int m = 0; m < 4; ++m) H[m] = (f32x4){0.f, 0.f, 0.f, 0.f};
    ChainOps s0, s1, s2, s3;
    chain_load(s0, PG, QT, h, ig, 0, lane); chain_load(s1, PG, QT, h, ig, 1, lane); chain_load(s2, PG, QT, h, ig, 2, lane); chain_load(s3, PG, QT, h, ig, 3, lane);
#pragma unroll 1
    for (int c = 0; c < 256; c += 4) {
        const bool more = c + 4 < 256;
        chain_step(H, s0, H0T, h, ig, c, lane);     if (more) chain_load(s0, PG, QT, h, ig, c + 4, lane);
        chain_step(H, s1, H0T, h, ig, c + 1, lane); if (more) chain_load(s1, PG, QT, h, ig, c + 5, lane);
        chain_step(H, s2, H0T, h, ig, c + 2, lane); if (more) chain_load(s2, PG, QT, h, ig, c + 6, lane);
        chain_step(H, s3, H0T, h, ig, c + 3, lane); if (more) chain_load(s3, PG, QT, h, ig, c + 7, lane);
    }
}
__device__ __forceinline__ void ph_chain(const bf16* PG, const float* QT, bf16* H0T, int blk, int nblk) {
    const int tid = opq_tid(), lane = tid & 63;
    for (int gw = blk * 8 + (tid >> 6); gw < 64; gw += nblk * 8) chain_wave(PG, QT, H0T, gw >> 2, gw & 3, lane);
}

struct S3Args { const bf16* H0T; const bf16* RP; const float* Y0; const bf16* BV; const bf16* GB; const float* ln_w; const float* ln_b; bf16* mixed; };
__device__ __forceinline__ void ph_stage3(const S3Args& A, int blk, int nblk) {
    const int tid = opq_tid(), lane = tid & 63, fr = lane & 15, fq = lane >> 4;
    for (int it = blk * 8 + (tid >> 6); it < 4096 * 4; it += nblk * 8) {
        const int u = it >> 2, tb = it & 3, c = u >> 4, h = u & 15, t = 64 * c + 16 * tb + fr;
        const bf16* Hp = A.H0T + (size_t)u * 4096 + fr * 64 + 8 * fq; const bf16* Rp = A.RP + (size_t)t * 1024 + h * 64 + 8 * fq;
        const bf16x8 r0 = *(const bf16x8*)Rp, r1 = *(const bf16x8*)(Rp + 32);
        f32x4 y[4];
#pragma unroll
        for (int ib = 0; ib < 4; ++ib) { const f32x4 y0 = *(const f32x4*)(A.Y0 + (size_t)t * 1024 + h * 64 + 16 * ib + 4 * fq);
            y[ib] = mfma16(*(const bf16x8*)(Hp + ib * 1024 + 32), r1, mfma16(*(const bf16x8*)(Hp + ib * 1024), r0, y0)); }
        float s = 0.f;
#pragma unroll
        for (int ib = 0; ib < 4; ++ib) s += (y[ib][0] + y[ib][1]) + (y[ib][2] + y[ib][3]);
        s += __shfl_xor(s, 16); s += __shfl_xor(s, 32);
        const float mean = s * (1.0f / 64.0f); float q = 0.f;
#pragma unroll
        for (int ib = 0; ib < 4; ++ib)
#pragma unroll
            for (int e = 0; e < 4; ++e) { const float d = y[ib][e] - mean; y[ib][e] = d; q += d * d; }
        q += __shfl_xor(q, 16); q += __shfl_xor(q, 32);
        const float rstd = 1.0f / sqrtf(q * (1.0f / 64.0f) + GN_EPS);
#pragma unroll
        for (int ib = 0; ib < 4; ++ib) { const int ch = h * 64 + 16 * ib + 4 * fq; const size_t o = (size_t)t * 1024 + ch;
            const f32x4 lw = *(const f32x4*)(A.ln_w + ch), lb = *(const f32x4*)(A.ln_b + ch); const u32x2 bv = *(const u32x2*)(A.BV + o), gg = *(const u32x2*)(A.GB + o); f32x4 r;
            const float bvf[4] = {bflo(bv.x), bfhi(bv.x), bflo(bv.y), bfhi(bv.y)}, ggf[4] = {bflo(gg.x), bfhi(gg.x), bflo(gg.y), bfhi(gg.y)};
#pragma unroll
            for (int e = 0; e < 4; ++e) r[e] = (y[ib][e] * rstd * lw[e] + lb[e] + bvf[e]) * ggf[e];
            *(u32x2*)(A.mixed + (size_t)t * DM + 1024 + ch) = (u32x2){pk(r[0], r[1]), pk(r[2], r[3])}; }
    }
}
}
#define XB_TMO      128
#define XB_XCNT(j)  (256  + 64 * (j))
#define XB_XSUB(j)  (1280 + 64 * (j))
#define XB_XGEN(j)  (2304 + 64 * (j))
#define XB_TOP      3328
#define XB_TOPGEN   3392
#define XCD_BAR_WORDS 3456
#define XB_SPIN_CAP (1u << 22)

__device__ __forceinline__ unsigned xb_ld(unsigned* p)              { return __hip_atomic_load(p, __ATOMIC_RELAXED, __HIP_MEMORY_SCOPE_AGENT); }
__device__ __forceinline__ unsigned xb_add(unsigned* p, unsigned v) { return __hip_atomic_fetch_add(p, v, __ATOMIC_RELAXED, __HIP_MEMORY_SCOPE_AGENT); }
__device__ __forceinline__ unsigned xb_xcc_id() { return (unsigned)__builtin_amdgcn_s_getreg((3 << 11) | 20) & 0xFu; }
#define XB_SPIN(cond, bar) do { unsigned _sp = 0; while (cond) { __builtin_amdgcn_s_sleep(1); \
    if ((++_sp & 255u) == 0u) { if (xb_ld(&(bar)[XB_TMO])) break; if (_sp > XB_SPIN_CAP) { atomicAdd(&(bar)[XB_TMO], 1u); break; } } } } while (0)

struct XcdBarrier {
    unsigned* bar; unsigned x;
    volatile LAS unsigned* st;
};

__device__ __forceinline__ XcdBarrier xcd_barrier_post(unsigned* bar, volatile LAS unsigned* st) {
    XcdBarrier b; b.bar = bar; b.x = xb_xcc_id(); b.st = st;
    if (threadIdx.x == 0) (void)xb_add(&bar[XB_XCNT(b.x)], 1u);
    return b;
}
__device__ __forceinline__ void xcd_barrier_complete(unsigned* bar, unsigned x, unsigned& nloc, unsigned& nx) {
    const unsigned G = gridDim.x * gridDim.y * gridDim.z;
    unsigned sum, cnt, mine, sp = 0u;
    for (;;) {
        sum = 0u; cnt = 0u; mine = 0u;
#pragma unroll
        for (unsigned j = 0; j < 16; ++j) { const unsigned c = xb_ld(&bar[XB_XCNT(j)]); sum += c; cnt += (c > 0u) ? 1u : 0u; mine = (j == x) ? c : mine; }
        if (sum == G) break;
        __builtin_amdgcn_s_sleep(1);
        if ((++sp & 255u) == 0u) { if (xb_ld(&bar[XB_TMO])) break; if (sp > XB_SPIN_CAP) { atomicAdd(&bar[XB_TMO], 1u); break; } }
    }
    nloc = mine > 0u ? mine : 1u; nx = cnt > 0u ? cnt : 1u;
}

__device__ __forceinline__ void xcd_barrier(const XcdBarrier& b) {
    asm volatile("s_waitcnt vmcnt(0)" ::: "memory");
    __syncthreads();
    if (threadIdx.x == 0) {
        unsigned* bar = b.bar;
        __builtin_amdgcn_s_waitcnt(0);
        unsigned nloc = b.st[0], nx = b.st[1];
        if (nloc == 0u) { xcd_barrier_complete(bar, b.x, nloc, nx); b.st[0] = nloc; b.st[1] = nx; }
        const unsigned old = xb_add(&bar[XB_XSUB(b.x)], 1u);
        const unsigned gen = old / nloc;
        if (old + 1u == (gen + 1u) * nloc) {
            __builtin_amdgcn_fence(__ATOMIC_RELEASE, "agent");
            asm volatile("s_waitcnt vmcnt(0)" ::: "memory");
            const unsigned og = xb_add(&bar[XB_TOP], 1u);
            const unsigned tg = og / nx;
            if (og + 1u == (tg + 1u) * nx) xb_add(&bar[XB_TOPGEN], 1u);
            else XB_SPIN(xb_ld(&bar[XB_TOPGEN]) == tg, bar);
            __builtin_amdgcn_fence(__ATOMIC_ACQUIRE, "agent");
            xb_add(&bar[XB_XGEN(b.x)], 1u);
            asm volatile("s_waitcnt vmcnt(0)" ::: "memory");
        } else {
            XB_SPIN(xb_ld(&bar[XB_XGEN(b.x)]) == gen, bar);
            __builtin_amdgcn_fence(__ATOMIC_ACQUIRE, "agent");
            asm volatile("s_waitcnt vmcnt(0)" ::: "memory");
        }
    }
    __syncthreads();
}

constexpr size_t MiB = 1u << 20;
constexpr size_t WS_CTL = 0, CTL_ZERO_BYTES = 64 * 1024, WS_SSQA = 1016 * MiB, WS_SSQB = 1018 * MiB,      WS_WIN = 2 * MiB, WS_WOUT = 28 * MiB, WS_WUP = 36 * MiB, WS_WDOWN = 68 * MiB, WS_LORA = 100 * MiB, WS_XB = 102 * MiB,
                 WS_Q = 166 * MiB, WS_K = 198 * MiB, WS_V = 230 * MiB, WS_RW = 262 * MiB, WS_MIXED = 374 * MiB, WS_U = 166 * MiB, WS_VFIRST = 438 * MiB, WS_PG = 470 * MiB, WS_QT = 502 * MiB, WS_RP = 566 * MiB,
                 WS_Y0 = 598 * MiB, WS_H0T = 662 * MiB, WS_BV = 694 * MiB, WS_GB = 726 * MiB, WS_STASH = 758 * MiB, WS_PART = 790 * MiB, WS_END = 1020 * MiB;
constexpr size_t LORA_W2 = 0, LORA_A2 = 1024 * 64 * 2, LORA_G2 = 2 * 1024 * 64 * 2, LORA_V2 = LORA_G2 + 1024 * 160 * 2;
constexpr int CW_BAR = 1024, CW_ATTQ = 512;
constexpr int RING_BYTES = 131072, MISC_OFF = 156000, LDS_BYTES = 156672;

struct Args { const float* in[26]; float* out; unsigned char* ws; int ph_lo, ph_hi; float lam_init[4]; };

struct ConvItem { const float* src; bf16* dst; const float* g; int K, N, k0, c0; bool permin, skipx; };
__device__ __forceinline__ void conv_item(ConvItem& I, const __attribute__((address_space(4))) Args* a, unsigned char* ws, int l, int it) {
    constexpr int I_IN = (DM / 64) * (NIN / 64), I_OUT = (DM / 64) * (DM / 64), I_UP = (DM / 64) * (DFF / 64);
    int r = it, nkbs;
    if (r < I_IN) { I.src = a->in[3] + (size_t)l * DM * PW; I.dst = (bf16*)(ws + WS_WIN); I.g = a->in[1] + (size_t)l * DM; I.K = DM; I.N = PW; nkbs = 5; I.permin = true; I.skipx = l > 0; }
    else if ((r -= I_IN) < I_OUT) { I.src = a->in[4] + (size_t)l * DM * DM; I.dst = (bf16*)(ws + WS_WOUT); I.g = nullptr; I.K = DM; I.N = DM; nkbs = 5; I.permin = false; I.skipx = false; }
    else if ((r -= I_OUT) < I_UP) { I.src = a->in[24] + (size_t)l * DM * DFF; I.dst = (bf16*)(ws + WS_WUP); I.g = a->in[2] + (size_t)l * DM; I.K = DM; I.N = DFF; nkbs = 5; I.permin = false; I.skipx = false; }
    else { r -= I_UP; I.src = a->in[25] + (size_t)l * DFF * DM; I.dst = (bf16*)(ws + WS_WDOWN); I.g = nullptr; I.K = DFF; I.N = DM; nkbs = 7; I.permin = false; I.skipx = false; }
    I.k0 = (r & ((1 << nkbs) - 1)) * 64; I.c0 = (r >> nkbs) * 64;
}
__device__ __forceinline__ void conv_load(const ConvItem& I, float (&v)[8], float (&gv)[8], int tid) {
#pragma unroll
    for (int i = 0; i < 8; ++i) { const int idx = tid + 512 * i, kk = idx >> 6, cc = idx & 63, cp = I.c0 + cc; int col = cp;
        if (I.permin) { const int lo = cp & 255, bj = lo >> 7, wc = (lo >> 5) & 3, j = lo & 31; col = (cp & ~255) + 64 * wc + 32 * bj + j; }
        const bool ok = col < I.N;
        v[i] = ok ? I.src[(size_t)(I.k0 + kk) * I.N + col] : 0.f; gv[i] = I.g ? I.g[I.k0 + kk] : 1.0f; }
}
__device__ __forceinline__ void ph_convw(LAS unsigned char* lds, const __attribute__((address_space(4))) Args* a, int l, int blk, int nblk) {
    LAS float* tile = (LAS float*)lds; unsigned char* ws = a->ws; const int tid = opq_tid();
    constexpr int NITEM = (DM / 64) * (NIN / 64) + (DM / 64) * (DM / 64) + (DM / 64) * (DFF / 64) + (DFF / 64) * (DM / 64);
    ConvItem I0, I1, I2; float v0[8], v1[8], v2[8], g0[8], g1[8], g2[8];
    int it = blk;
    if (it < NITEM) { conv_item(I0, a, ws, l, it); conv_load(I0, v0, g0, tid); }
    if (it + nblk < NITEM) { conv_item(I1, a, ws, l, it + nblk); conv_load(I1, v1, g1, tid); }
    int par = 0;
#define CONV_STEP(IC, VC, GC, IN_, VN_, GN_) do { \
        LAS float* tl = tile + par * (64 * 65); par ^= 1; \
        _Pragma("unroll") for (int i = 0; i < 8; ++i) { const int idx = tid + 512 * i; tl[(idx >> 6) * 65 + (idx & 63)] = VC[i] * GC[i]; } \
        if (it + 2 * nblk < NITEM) { conv_item(IN_, a, ws, l, it + 2 * nblk); conv_load(IN_, VN_, GN_, tid); } \
        __syncthreads(); \
        { const int cc = tid >> 3, k8 = (tid & 7) * 8, cp = IC.c0 + cc; \
          if (!(IC.permin && IC.skipx && ((cp >= 6432 && cp < 6464) || (cp >= 6528 && cp < 6560)))) {        \
              u32x4 w; \
              _Pragma("unroll") for (int e = 0; e < 4; ++e) w[e] = f2bf(tl[(k8 + 2 * e) * 65 + cc]) | (f2bf(tl[(k8 + 2 * e + 1) * 65 + cc]) << 16); \
              *(u32x4*)(IC.dst + (size_t)cp * IC.K + IC.k0 + k8) = w; } } \
        it += nblk; } while (0)
    while (it < NITEM) {
        CONV_STEP(I0, v0, g0, I2, v2, g2); if (it >= NITEM) break;
        CONV_STEP(I1, v1, g1, I0, v0, g0); if (it >= NITEM) break;
        CONV_STEP(I2, v2, g2, I1, v1, g1);
    }
#undef CONV_STEP
    __syncthreads();
    { const int tid = opq_tid(); const int lm = l > 0 ? l - 1 : 0;
      const float* w2 = a->in[12] + (size_t)l * 64 * 1024; const float* a2 = a->in[14] + (size_t)l * 64 * 1024; const float* g2 = a->in[15] + (size_t)l * 160 * 1024; const float* v2 = a->in[23] + (size_t)lm * 32 * 1024;
      bf16* lw = (bf16*)(ws + WS_LORA);
      for (int i = blk * 512 + tid; i < 1024 * 320; i += nblk * 512) {
          const int ch = i / 320, k = i % 320;
          if (k < 64) lw[LORA_W2 / 2 + ch * 64 + k] = (bf16)f2bf(w2[(size_t)k * 1024 + ch]);
          else if (k < 128) lw[LORA_A2 / 2 + ch * 64 + k - 64] = (bf16)f2bf(a2[(size_t)(k - 64) * 1024 + ch]);
          else if (k < 288) lw[LORA_G2 / 2 + ch * 160 + k - 128] = (bf16)f2bf(g2[(size_t)(k - 128) * 1024 + ch]);
          else lw[LORA_V2 / 2 + ch * 32 + k - 288] = (bf16)f2bf(v2[(size_t)(k - 288) * 1024 + ch]);
      } }
    if (l > 0) {
        const int tid = opq_tid(), sl = tid >> 6, o = tid & 63;
        const float* win = a->in[3] + (size_t)l * DM * PW; const float* g1 = a->in[1] + (size_t)l * DM; const float* muv = a->in[10] + (size_t)l * 3360 + 2048; const float* v1 = a->in[22] + (size_t)(l - 1) * 1024 * 32;
        bf16* wt = (bf16*)(ws + WS_WIN);
        LAS float* wrow = (LAS float*)lds;
        LAS float* part = wrow + 8 * 1024;
        for (int k0 = blk * 8; k0 < DM; k0 += nblk * 8) {
            for (int i = tid; i < 8 * 1024; i += 512) wrow[i] = win[(size_t)(k0 + (i >> 10)) * PW + 5120 + (i & 1023)];
            __syncthreads();
            float acc[8];
#pragma unroll
            for (int r = 0; r < 8; ++r) acc[r] = 0.f;
#pragma unroll 8
            for (int ci = 0; ci < 128; ++ci) { const int c = sl * 128 + ci; const float m = muv[c], f = ((o < 32) ? 1.0f - m : m) * v1[c * 32 + (o & 31)];
#pragma unroll
                for (int r = 0; r < 8; ++r) acc[r] = __builtin_fmaf(wrow[r * 1024 + c], f, acc[r]); }
#pragma unroll
            for (int r = 0; r < 8; ++r) part[(sl * 8 + r) * 64 + o] = acc[r];
            __syncthreads();
            { const int r = sl; float s = 0.f;
#pragma unroll
              for (int q = 0; q < 8; ++q) s += part[(q * 8 + r) * 64 + o];
              const int row = (o < 32) ? 6528 + o : 6400 + o;
              wt[(size_t)row * DM + k0 + r] = (bf16)f2bf(s * g1[k0 + r]); }
            __syncthreads();
        }
    }
}
__device__ __forceinline__ void ph_copy_x(const float* __restrict__ src, float* __restrict__ copy, bf16* __restrict__ xb, float* __restrict__ ssq, int blk, int nblk) {
    const int tid_ = opq_tid(), lane = tid_ & 63, gw = blk * 8 + (tid_ >> 6), ngw = nblk * 8;
    for (int row = gw; row < T_; row += ngw) {
        const f32x4* s = (const f32x4*)(src + (size_t)row * DM);
        float ss = 0.f;
#pragma unroll
        for (int j = 0; j < 8; ++j) { const f32x4 v = s[lane + 64 * j]; ss += (v[0] * v[0] + v[1] * v[1]) + (v[2] * v[2] + v[3] * v[3]);
            u32x2 w; w.x = f2bf(v[0]) | (f2bf(v[1]) << 16); w.y = f2bf(v[2]) | (f2bf(v[3]) << 16);
            ((u32x2*)(xb + (size_t)row * DM))[lane + 64 * j] = w; }
        ss = wave_sum(ss);
        if (lane < 32) ssq[(size_t)row * 32 + lane] = lane == 0 ? ss : 0.f;
    }
}
__device__ __forceinline__ void ph_zero(float* p, int n, int blk, int nblk) { const int tid = opq_tid();
#pragma unroll
    for (int r = 0; r < 4; ++r) { const int i = (r * nblk + blk) * 512 + tid; if (i < n) __hip_atomic_store(p + i, 0.f, __ATOMIC_RELAXED, __HIP_MEMORY_SCOPE_AGENT); } }

#ifndef MK_PER_PHASE
#define MK_PER_PHASE 0
#endif
constexpr int NPH = 8;
#ifndef PROBE_PH
#define PROBE_PH -1
#endif
#ifndef PROBE_REP
#define PROBE_REP 1
#endif
#define REP(k) for (int rep_ = 0; rep_ < ((k) == PROBE_PH ? PROBE_REP : 1); ++rep_)
typedef const __attribute__((address_space(4))) Args* CArgs;
__device__ __forceinline__ CArgs kargs() { CArgs p = (CArgs)__builtin_amdgcn_kernarg_segment_ptr(); asm volatile("" : "+s"(p)); return p; }
__global__ void __launch_bounds__(512, 2) fwd(Args args_unused) {
    extern __shared__ __attribute__((aligned(16))) unsigned char lds_raw[];
    LAS unsigned char* lds = (LAS unsigned char*)lds_raw;
    volatile LAS unsigned* MISC = (volatile LAS unsigned*)(lds + MISC_OFF);
    const int blk = (int)blockIdx.x, nblk = (int)gridDim.x;
    if (threadIdx.x < 32) MISC[threadIdx.x] = 0u;
    __syncthreads();
    XcdBarrier bar;
#if MK_PER_PHASE
    int lo, hi;
    { CArgs ap = kargs(); lo = ap->ph_lo; hi = ap->ph_hi; unsigned* bw = (unsigned*)(ap->ws + WS_CTL) + CW_BAR; bar.bar = bw; bar.x = 0; bar.st = nullptr;
      if (hi - lo > 1) bar = xcd_barrier_post(bw, MISC + 8); }
#else
    { CArgs ap = kargs(); bar = xcd_barrier_post((unsigned*)(ap->ws + WS_CTL) + CW_BAR, MISC + 8); }
#endif
#if MK_PER_PHASE
#define IN(k) (lo <= (k) && (k) < hi)
#define SEAM(k) do { if (IN(k) && IN((k) + 1)) xcd_barrier(bar); } while (0)
#else
#define IN(k) true
#define SEAM(k) do { if ((k) + 1 < NL * NPH) xcd_barrier(bar); } while (0)
#endif
#define WSP(T, off) ((T*)(ws + (off)))
#pragma unroll 1
    for (int l = 0; l < NL; ++l) {
        const int pb = l * NPH;
        if (IN(pb + 0)) REP(0) {
            CArgs ap = kargs(); unsigned char* ws = ap->ws;
            ph_convw(lds, ap, l, blk, nblk);
            if (l == 0) ph_copy_x(ap->in[0], ap->out, WSP(bf16, WS_XB), WSP(float, WS_SSQA), blk, nblk);

        }
        SEAM(pb + 0);
        if (IN(pb + 1)) REP(1) {
            CArgs ap = kargs(); unsigned char* ws = ap->ws;
            pg8::Gemm g{WSP(bf16, WS_XB), WSP(bf16, WS_WIN), T_, NIN, DM, 0}; pg8::StaticOrder S; S.init(T_, NIN, nblk, blk);
            pg8::EpiIn E{WSP(float, WS_SSQA), WSP(bf16, WS_Q), WSP(bf16, WS_K), WSP(bf16, WS_V), WSP(bf16, WS_RW), ap->in[5] + l * 128, ap->in[6] + l * 128};
            pg8::gemm_phase<pg8::EpiIn, pg8::StaticOrder, true, true>(lds, g, S, E);
        }
        SEAM(pb + 1);
        if (IN(pb + 2)) REP(2) {
            CArgs ap = kargs(); unsigned char* ws = ap->ws; const int lm = l > 0 ? l - 1 : 0;
            rk::S1Args A; A.rw = WSP(bf16, WS_RW); A.mu = ap->in[10] + (size_t)l * 3360; A.w0 = ap->in[11] + l * 1024; A.a0 = ap->in[13] + l * 1024; A.v0 = ap->in[21] + lm * 1024; A.k_k = ap->in[16] + l * 1024; A.k_a = ap->in[17] + l * 1024;
            A.r_k = ap->in[18] + l * 1024; A.w2t = (const bf16*)(ws + WS_LORA + LORA_W2); A.a2t = (const bf16*)(ws + WS_LORA + LORA_A2); A.g2t = (const bf16*)(ws + WS_LORA + LORA_G2); A.v2t = (const bf16*)(ws + WS_LORA + LORA_V2);
            A.vfirst = WSP(bf16, WS_VFIRST); A.BV = WSP(bf16, WS_BV); A.GB = WSP(bf16, WS_GB); A.PG = WSP(bf16, WS_PG); A.QT = WSP(float, WS_QT); A.RP = WSP(bf16, WS_RP); A.Y0 = WSP(float, WS_Y0); A.act = ws + WS_PART + (size_t)blk * rk::ACT_WG_BYTES; A.layer = l; A.pad_ = 0;
            rk::ph_stage1(lds, A, blk, nblk);
        }
        SEAM(pb + 2);
        if (IN(pb + 3)) {
            CArgs ap = kargs(); unsigned char* ws = ap->ws;
            rk::ph_chain(WSP(bf16, WS_PG), WSP(float, WS_QT), WSP(bf16, WS_H0T), blk, nblk);
            att::Args A; A.Q = WSP(bf16, WS_Q); A.K = WSP(bf16, WS_K); A.V = WSP(bf16, WS_V); A.mixed = WSP(bf16, WS_MIXED); A.stash = WSP(float, WS_STASH); A.lq = ap->in[7] + l * 128; A.lk = ap->in[8] + l * 128; A.subln = ap->in[9] + l * 128; A.gq = ap->in[5] + l * 128; A.gk = ap->in[6] + l * 128;
            A.lam_init = ap->lam_init[l]; A.pad_ = 0;
            att::attn_phase(lds, A, blk, (unsigned*)(ws + WS_CTL) + CW_ATTQ + 64 * l, MISC + 16, WSP(float, WS_PART));
        }
        SEAM(pb + 3);
        if (IN(pb + 4)) REP(4) {
            CArgs ap = kargs(); unsigned char* ws = ap->ws;
            rk::S3Args A{WSP(bf16, WS_H0T), WSP(bf16, WS_RP), WSP(float, WS_Y0), WSP(bf16, WS_BV), WSP(bf16, WS_GB), ap->in[19] + l * 1024, ap->in[20] + l * 1024, WSP(bf16, WS_MIXED)};
            rk::ph_stage3(A, blk, nblk);
            att::Args B; B.Q = WSP(bf16, WS_Q); B.K = WSP(bf16, WS_K); B.V = WSP(bf16, WS_V); B.mixed = WSP(bf16, WS_MIXED); B.stash = WSP(float, WS_STASH); B.lq = ap->in[7] + l * 128; B.lk = ap->in[8] + l * 128; B.subln = ap->in[9] + l * 128;
            B.gq = ap->in[5] + l * 128; B.gk = ap->in[6] + l * 128; B.lam_init = ap->lam_init[l]; B.pad_ = 0;
            att::attn_combine(lds, B, blk, nblk, WSP(float, WS_PART));
        }
        SEAM(pb + 4);
        if (IN(pb + 5)) {
            CArgs ap = kargs(); unsigned char* ws = ap->ws;
            pg8::Gemm g{WSP(bf16, WS_MIXED), WSP(bf16, WS_WOUT), T_, DM, DM, 0}; pg8::StaticOrder S; S.init(T_, DM, nblk, blk);
            pg8::EpiRes E{WSP(bf16, WS_XB), WSP(float, WS_SSQB), nullptr, DM, 0};
            pg8::gemm_phase<pg8::EpiRes, pg8::StaticOrder, true, true>(lds, g, S, E);
        }
        SEAM(pb + 5);
        if (IN(pb + 6)) REP(6) {
            CArgs ap = kargs(); unsigned char* ws = ap->ws;
            pg8::Gemm g{WSP(bf16, WS_XB), WSP(bf16, WS_WUP), T_, DFF, DM, 0}; pg8::StaticOrder S; S.init(T_, DFF, nblk, blk);
            pg8::EpiUp E{WSP(float, WS_SSQB), WSP(bf16, WS_U), DFF, 0};
            pg8::gemm_phase<pg8::EpiUp, pg8::StaticOrder, true, true>(lds, g, S, E);
        }
        SEAM(pb + 6);
        if (IN(pb + 7)) {
            CArgs ap = kargs(); unsigned char* ws = ap->ws;
            pg8::Gemm g{WSP(bf16, WS_U), WSP(bf16, WS_WDOWN), T_, DM, DFF, 0}; pg8::StaticOrder S; S.init(T_, DM, nblk, blk);
            pg8::EpiRes E{WSP(bf16, WS_XB), WSP(float, WS_SSQA), l == NL - 1 ? ap->out : nullptr, DM, 0};
            pg8::gemm_phase<pg8::EpiRes, pg8::StaticOrder, true, true>(lds, g, S, E);
        }
        SEAM(pb + 7);
    }
#undef IN
#undef SEAM
#undef WSP
}

extern "C" void kernel_launch(void* const* d_in, const int* in_sizes, int n_in, void* d_out, int out_size, void* d_ws, size_t ws_size, hipStream_t stream) {
    static int grid = 0;
    if (grid == 0) {
        grid = -1;
        if (n_in != 26 || ws_size < WS_END || out_size != T_ * DM) { fprintf(stderr, "kernel_launch: unexpected shapes (n_in %d ws %zu out %d)\n", n_in, ws_size, out_size); return; }
        int dev = 0, cus = 0, per_cu = 0;
        if (hipGetDevice(&dev) != hipSuccess || hipDeviceGetAttribute(&cus, hipDeviceAttributeMultiprocessorCount, dev) != hipSuccess) return;
        if (hipFuncSetAttribute((const void*)fwd, hipFuncAttributeMaxDynamicSharedMemorySize, LDS_BYTES) != hipSuccess) return;
        if (hipOccupancyMaxActiveBlocksPerMultiprocessor(&per_cu, (const void*)fwd, 512, LDS_BYTES) != hipSuccess || per_cu < 1) { fprintf(stderr, "kernel_launch: occupancy query says %d\n", per_cu); (void)hipGetLastError(); return; }
        if (cus < 8) return;
        grid = cus;
    }
    if (grid < 0) return;
    if (hipMemsetAsync((char*)d_ws + WS_CTL, 0, CTL_ZERO_BYTES, stream) != hipSuccess) return;
    Args a;
    memset(&a, 0, sizeof(a));
    for (int i = 0; i < 26; ++i) a.in[i] = (const float*)d_in[i];
    a.out = (float*)d_out; a.ws = (unsigned char*)d_ws;
    for (int l = 0; l < NL; ++l) a.lam_init[l] = (float)(0.8 - 0.6 * exp(-0.3 * (double)l));
    const int nph = NL * NPH;
#if MK_PER_PHASE
    for (int p = 0; p < nph; ++p) { a.ph_lo = p; a.ph_hi = p + 1; hipLaunchKernelGGL(fwd, dim3(grid), dim3(512), LDS_BYTES, stream, a); }
#else
    a.ph_lo = 0; a.ph_hi = nph; hipLaunchKernelGGL(fwd, dim3(grid), dim3(512), LDS_BYTES, stream, a);
#endif
}
```

```cpp
#include <hip/hip_runtime.h>
#include <cstdio>
#include <cstdint>
#include <cstring>
#include <cmath>

constexpr int T_ = 16384, DM = 2048, NL = 4, PW = 6432, NIN = 6656, RWP = 3584, DFF = 8192, RW_ = 1024;
constexpr float RMS_EPS = 1e-6f, GN_EPS = 64e-5f;
typedef unsigned short bf16;
typedef float f32x4 __attribute__((ext_vector_type(4)));
typedef unsigned u32x4 __attribute__((ext_vector_type(4)));
typedef unsigned u32x2 __attribute__((ext_vector_type(2)));
#define LAS __attribute__((address_space(3)))

__device__ __forceinline__ unsigned f2bf(float f) { unsigned u = __builtin_bit_cast(unsigned, f); return (u + 0x7fffu + ((u >> 16) & 1u)) >> 16; }
__device__ __forceinline__ float bf2f(unsigned short b) { return __builtin_bit_cast(float, (unsigned)b << 16); }
__device__ __forceinline__ float bflo(unsigned w) { return __builtin_bit_cast(float, w << 16); }
__device__ __forceinline__ float bfhi(unsigned w) { return __builtin_bit_cast(float, w & 0xffff0000u); }
__device__ __forceinline__ float sigmoidf_(float x) { return 1.0f / (1.0f + __expf(-x)); }

template <int CTRL, int ROWMASK> __device__ __forceinline__ float dppf(float v) {
    return __builtin_bit_cast(float, __builtin_amdgcn_update_dpp(0, __builtin_bit_cast(int, v), CTRL, ROWMASK, 0xF, false));
}
__device__ __forceinline__ float wave_sum(float v) {
    v += dppf<0xB1, 0xF>(v); v += dppf<0x4E, 0xF>(v); v += dppf<0x141, 0xF>(v); v += dppf<0x140, 0xF>(v);
    v += dppf<0x142, 0xA>(v); v += dppf<0x143, 0xC>(v);
    return __builtin_bit_cast(float, __builtin_amdgcn_readlane(__builtin_bit_cast(int, v), 63));
}
__device__ __forceinline__ int opq_tid() { int t = (int)threadIdx.x; asm volatile("" : "+v"(t)); return t; }
namespace pg8 {
#define PG8_LAS __attribute__((address_space(3)))
typedef unsigned short bf16_t;
typedef short bf16x8 __attribute__((ext_vector_type(8)));
typedef float f32x4 __attribute__((ext_vector_type(4)));
typedef unsigned u32x4 __attribute__((ext_vector_type(4)));
constexpr int BM = 256, BK = 64, HALF = 128, HTB = HALF * BK * 2  , STAGE_BYTES = 8 * HTB, NXCD = 8, WGM = 8;

__host__ __device__ __forceinline__ int lds_byte(int r, int c) { const int st = (r >> 4) * 2 + (c >> 5), rr = r & 15, cc = c & 31, ob = rr * 64 + cc * 2; return st * 1024 + (ob ^ (((ob >> 9) & 1) << 5)); }
__host__ __device__ __forceinline__ void stage_rc(int b, int& R, int& C) { const int st = b / 1024, sb = b % 1024, swz = sb ^ (((sb >> 9) & 1) << 5); R = (st >> 1) * 16 + swz / 64; C = (st & 1) * 32 + (swz % 64) / 2; }
__host__ __device__ __forceinline__ int perm32(int rho) { const int n = rho >> 4, i = rho & 15; return 8 * (i >> 2) + 4 * n + (i & 3); }

struct Unit { int pm, pn; };
struct Gemm { const bf16_t* A; const bf16_t* Bt; int M, N, K, pad_; };

struct StaticOrder {
    int nM, nN, nwg, G, c;
    __host__ __device__ void init(int M, int N, int G_, int c_) { nM = M / BM; nN = N / BM; nwg = nM * nN; G = G_; c = c_; }
    __host__ __device__ bool next(int i, Unit& u) const {
        const long L = (long)i * G + c; if (L >= nwg) return false;
        int wgid = (int)L; { const int q = nwg / NXCD, r = nwg % NXCD, xcd = wgid % NXCD, off = wgid / NXCD; wgid = (xcd < r ? xcd * (q + 1) : r * (q + 1) + (xcd - r) * q) + off; }
        const int nig = WGM * nN, gid = wgid / nig, fm = gid * WGM, gsz = (nM - fm) < WGM ? (nM - fm) : WGM;
        u.pm = fm + ((wgid % nig) % gsz); u.pn = (wgid % nig) / gsz; return true;
    }
    __device__ __forceinline__ void a_ready(const Unit&) const {}
    __device__ __forceinline__ void done(const Unit&) const {}
};

__device__ __forceinline__ unsigned cvt_pk_bf16(float lo, float hi) { unsigned r; asm volatile("v_cvt_pk_bf16_f32 %0, %1, %2" : "=v"(r) : "v"(lo), "v"(hi)); return r; }
typedef float f32x2 __attribute__((ext_vector_type(2)));
__device__ __forceinline__ float row_ssq(const float* ssq, int row, int fq) {
    const f32x4 a = *(const f32x4*)(ssq + (size_t)row * 32 + 8 * fq), b = *(const f32x4*)(ssq + (size_t)row * 32 + 8 * fq + 4);
    float s = ((a[0] + a[1]) + (a[2] + a[3])) + ((b[0] + b[1]) + (b[2] + b[3]));
    s += __shfl_xor(s, 16); s += __shfl_xor(s, 32); return s;
}
struct EpiIn {
    static constexpr bool PERM = true, AFTER_DRAIN = false;
    const float* rinv; bf16_t* q; bf16_t* k; bf16_t* v; bf16_t* rw; const float* gq; const float* gk;
    __device__ __forceinline__ void operator()(const f32x4 (&acc)[2][2][4][2], const Unit& u, int wr, int wc, int fr, int fq) const {
        const int pn = u.pn;
        const int row0 = u.pm * BM + wr * 64 + fr;
        if (pn < 8) {
            const float* g = (pn < 4 ? gq : gk) + (wc & 1) * 64 + 8 * fq;
            f32x4 gv[2][2];
#pragma unroll
            for (int bj = 0; bj < 2; ++bj)
#pragma unroll
                for (int n = 0; n < 2; ++n) gv[bj][n] = *(const f32x4*)(g + 32 * bj + 4 * n);
            bf16_t* base = (pn < 4 ? q : k) + (pn & 3) * 256 + 64 * wc + 8 * fq;
#pragma unroll
            for (int ai = 0; ai < 2; ++ai)
#pragma unroll
                for (int m = 0; m < 4; ++m) {
                    const int row = row0 + ai * HALF + m * 16; const float ri = 1.0f / sqrtf(row_ssq(rinv, row, fq) * (1.0f / 2048.0f) + 1e-6f);
                    f32x4 vv[2][2]; float ss = 0.f;
#pragma unroll
                    for (int bj = 0; bj < 2; ++bj)
#pragma unroll
                        for (int n = 0; n < 2; ++n) { vv[bj][n] = acc[ai][bj][m][n] * ri; const f32x4 t = vv[bj][n]; ss += (t[0] * t[0] + t[1] * t[1]) + (t[2] * t[2] + t[3] * t[3]); }
                    ss += __shfl_xor(ss, 16); ss += __shfl_xor(ss, 32);
                    const float rq = 1.0f / sqrtf(ss * (1.0f / 64.0f) + 1e-6f);
#pragma unroll
                    for (int bj = 0; bj < 2; ++bj) { const f32x4 a = vv[bj][0] * rq * gv[bj][0], b = vv[bj][1] * rq * gv[bj][1];
                        u32x4 w; w.x = cvt_pk_bf16(a[0], a[1]); w.y = cvt_pk_bf16(a[2], a[3]); w.z = cvt_pk_bf16(b[0], b[1]); w.w = cvt_pk_bf16(b[2], b[3]);
                        *(u32x4*)(base + (size_t)row * 1024 + 32 * bj) = w; }
                }
        } else {
            bf16_t* base; int ld;
            if (pn < 12) { base = v + (pn - 8) * 256 + 64 * wc + 8 * fq; ld = 1024; } else { base = rw + (pn - 12) * 256 + 64 * wc + 8 * fq; ld = 3584; }
#pragma unroll
            for (int ai = 0; ai < 2; ++ai)
#pragma unroll
                for (int m = 0; m < 4; ++m) {
                    const int row = row0 + ai * HALF + m * 16; const float ri = 1.0f / sqrtf(row_ssq(rinv, row, fq) * (1.0f / 2048.0f) + 1e-6f);
#pragma unroll
                    for (int bj = 0; bj < 2; ++bj) { const f32x4 a = acc[ai][bj][m][0] * ri, b = acc[ai][bj][m][1] * ri;
                        u32x4 w; w.x = cvt_pk_bf16(a[0], a[1]); w.y = cvt_pk_bf16(a[2], a[3]); w.z = cvt_pk_bf16(b[0], b[1]); w.w = cvt_pk_bf16(b[2], b[3]);
                        *(u32x4*)(base + (size_t)row * ld + 32 * bj) = w; }
                }
        }
    }
};
struct EpiRes {
    static constexpr bool PERM = true, AFTER_DRAIN = false;
    bf16_t* xb; float* ssq; float* fout; int ldc; int pad_;
    __device__ __forceinline__ void operator()(const f32x4 (&acc)[2][2][4][2], const Unit& u, int wr, int wc, int fr, int fq) const {
        const int row0 = u.pm * BM + wr * 64 + fr, col0 = u.pn * BM + wc * 32 + 8 * fq;
#pragma unroll
        for (int ai = 0; ai < 2; ++ai) {
            u32x4 xo[4][2];
#pragma unroll
            for (int m = 0; m < 4; ++m)
#pragma unroll
                for (int bj = 0; bj < 2; ++bj) xo[m][bj] = *(const u32x4*)(xb + (size_t)(row0 + ai * HALF + m * 16) * ldc + col0 + bj * HALF);
#pragma unroll
            for (int m = 0; m < 4; ++m) { const int row = row0 + ai * HALF + m * 16; bf16_t* rowb = xb + (size_t)row * ldc + col0; float ss = 0.f;
#pragma unroll
                for (int bj = 0; bj < 2; ++bj) { const u32x4 w0 = xo[m][bj];
                    f32x4 o0 = acc[ai][bj][m][0], o1 = acc[ai][bj][m][1];
                    o0[0] += __builtin_bit_cast(float, w0.x << 16); o0[1] += __builtin_bit_cast(float, w0.x & 0xffff0000u); o0[2] += __builtin_bit_cast(float, w0.y << 16); o0[3] += __builtin_bit_cast(float, w0.y & 0xffff0000u);
                    o1[0] += __builtin_bit_cast(float, w0.z << 16); o1[1] += __builtin_bit_cast(float, w0.z & 0xffff0000u); o1[2] += __builtin_bit_cast(float, w0.w << 16); o1[3] += __builtin_bit_cast(float, w0.w & 0xffff0000u);
                    ss += ((o0[0] * o0[0] + o0[1] * o0[1]) + (o0[2] * o0[2] + o0[3] * o0[3])) + ((o1[0] * o1[0] + o1[1] * o1[1]) + (o1[2] * o1[2] + o1[3] * o1[3]));
                    u32x4 w; w.x = cvt_pk_bf16(o0[0], o0[1]); w.y = cvt_pk_bf16(o0[2], o0[3]); w.z = cvt_pk_bf16(o1[0], o1[1]); w.w = cvt_pk_bf16(o1[2], o1[3]);
                    *(u32x4*)(rowb + bj * HALF) = w;
                    if (fout) { f32x4* p = (f32x4*)(fout + (size_t)row * ldc + col0 + bj * HALF); p[0] = o0; p[1] = o1; } }
                ss += __shfl_xor(ss, 16); ss += __shfl_xor(ss, 32);
                if (fq == 0) ssq[(size_t)row * 32 + u.pn * 4 + wc] = ss; }
        }
    }
};
struct EpiUp {
    static constexpr bool PERM = true, AFTER_DRAIN = false;
    const float* rinv; bf16_t* o; int ldc; int pad_;
    __device__ __forceinline__ void operator()(const f32x4 (&acc)[2][2][4][2], const Unit& u, int wr, int wc, int fr, int fq) const {
        const int row0 = u.pm * BM + wr * 64 + fr, col0 = u.pn * BM + wc * 32 + 8 * fq;
#pragma unroll
        for (int ai = 0; ai < 2; ++ai)
#pragma unroll
            for (int m = 0; m < 4; ++m) { const int row = row0 + ai * HALF + m * 16; const float ri = 1.0f / sqrtf(row_ssq(rinv, row, fq) * (1.0f / 2048.0f) + 1e-6f);   bf16_t* rowp = o + (size_t)row * ldc + col0;
#pragma unroll
                for (int bj = 0; bj < 2; ++bj) { f32x4 a = acc[ai][bj][m][0] * ri, b = acc[ai][bj][m][1] * ri;
#pragma unroll
                    for (int e = 0; e < 4; ++e) { a[e] = a[e] > 0.f ? a[e] * a[e] : 0.f; b[e] = b[e] > 0.f ? b[e] * b[e] : 0.f; }
                    u32x4 w; w.x = cvt_pk_bf16(a[0], a[1]); w.y = cvt_pk_bf16(a[2], a[3]); w.z = cvt_pk_bf16(b[0], b[1]); w.w = cvt_pk_bf16(b[2], b[3]);
                    *(u32x4*)(rowp + bj * HALF) = w; } }
    }
};
template <class Epi, class Sched, bool ALIGN_EPI = false, bool SP2 = false>
__device__ __forceinline__ void gemm_phase(PG8_LAS unsigned char* lds, const Gemm g, const Sched& S, const Epi& E) {
    const int tid = opq_tid(), wid = __builtin_amdgcn_readfirstlane(tid >> 6), lane = tid & 63, wr = wid >> 2, wc = wid & 3, fr = lane & 15, fq = lane >> 4;
    const int K = g.K, nt = K / BK;
    unsigned voffA[2], voffB[2];
#pragma unroll
    for (int i = 0; i < 2; ++i) { int R, C; stage_rc(tid * 16 + i * 8192, R, C); const int Rb = Epi::PERM ? ((R & ~31) + perm32(R & 31)) : R;
        voffA[i] = (unsigned)(R * K + C) * 2u; voffB[i] = (unsigned)(Rb * K + C) * 2u; }
    const size_t kstep = (size_t)(BK * 2);
    const size_t hstep = (size_t)HALF * K * 2;
    const size_t tstep = 2 * hstep;
    const unsigned ldsw = (unsigned)wid * 1024u;
    const int aoff = lds_byte(wr * 64 + fr, fq * 8), boff = lds_byte(wc * 32 + fr, fq * 8);
#define PG8_SA(b, h) (((b) * 2 + (h)) * HTB)
#define PG8_SB(b, h) ((4 + (b) * 2 + (h)) * HTB)
#define PG8_STAGE(bufoff, gbase, voff) do { _Pragma("unroll") for (int _i = 0; _i < 2; ++_i) \
        __builtin_amdgcn_global_load_lds((const unsigned*)((const char*)(gbase) + (voff)[_i]), (PG8_LAS unsigned*)(lds + (bufoff) + ldsw + _i * 8192), 16, 0, 0); } while (0)
#define PG8_LDA(dst, b, h) do { _Pragma("unroll") for (int m = 0; m < 4; ++m) _Pragma("unroll") for (int k = 0; k < 2; ++k) dst[m][k] = *(const PG8_LAS bf16x8*)(lds + PG8_SA(b, h) + aoff + m * 2048 + k * 1024); } while (0)
#define PG8_LDB(dst, b, h) do { _Pragma("unroll") for (int n = 0; n < 2; ++n) _Pragma("unroll") for (int k = 0; k < 2; ++k) dst[n][k] = *(const PG8_LAS bf16x8*)(lds + PG8_SB(b, h) + boff + n * 2048 + k * 1024); } while (0)
#define PG8_MMA(ai, bj, At, Bt) do { __builtin_amdgcn_s_setprio(1); _Pragma("unroll") for (int m = 0; m < 4; ++m) _Pragma("unroll") for (int n = 0; n < 2; ++n) _Pragma("unroll") for (int k = 0; k < 2; ++k) \
        acc[ai][bj][m][n] = __builtin_amdgcn_mfma_f32_16x16x32_bf16(Bt[n][k], At[m][k], acc[ai][bj][m][n], 0, 0, 0); __builtin_amdgcn_s_setprio(0); } while (0)
#define PG8_WAIT_V(n) asm volatile("s_waitcnt vmcnt(" #n ")" ::: "memory")
#define PG8_WAIT_L(n) asm volatile("s_waitcnt lgkmcnt(" #n ")" ::: "memory")
#define PG8_BAR __builtin_amdgcn_s_barrier()
#define PG8_SCHED __builtin_amdgcn_sched_barrier(0)
    Unit cur, nxt; int ui = 0;
    if (!S.next(0, cur)) return;
    f32x4 acc[2][2][4][2];
#pragma unroll
    for (int a = 0; a < 2; ++a)
#pragma unroll
        for (int b = 0; b < 2; ++b)
#pragma unroll
            for (int m = 0; m < 4; ++m)
#pragma unroll
                for (int n = 0; n < 2; ++n) acc[a][b][m][n] = (f32x4){0.f, 0.f, 0.f, 0.f};
    bf16x8 At[4][2], B0[2][2], B1[2][2];
    const char* cA = (const char*)g.A + (size_t)cur.pm * tstep; const char* cB = (const char*)g.Bt + (size_t)cur.pn * tstep;
    S.a_ready(cur);
    if constexpr (SP2) {
        PG8_STAGE(PG8_SB(0, 0), cB, voffB); PG8_STAGE(PG8_SB(0, 1), cB + hstep, voffB); PG8_STAGE(PG8_SA(0, 0), cA, voffA); PG8_STAGE(PG8_SA(0, 1), cA + hstep, voffA);
        if (wr == 1) PG8_BAR;
        PG8_WAIT_V(2); PG8_BAR;
        PG8_STAGE(PG8_SB(1, 0), cB + kstep, voffB); PG8_STAGE(PG8_SA(1, 0), cA + kstep, voffA); PG8_STAGE(PG8_SB(1, 1), cB + hstep + kstep, voffB);
        PG8_WAIT_V(6); PG8_BAR;
    } else {
        PG8_STAGE(PG8_SB(0, 0), cB, voffB); PG8_STAGE(PG8_SA(0, 0), cA, voffA); PG8_STAGE(PG8_SB(0, 1), cB + hstep, voffB); PG8_STAGE(PG8_SA(0, 1), cA + hstep, voffA);
        if (wr == 1) PG8_BAR;
        PG8_WAIT_V(4); PG8_BAR;
        PG8_STAGE(PG8_SB(1, 0), cB + kstep, voffB); PG8_STAGE(PG8_SA(1, 0), cA + kstep, voffA); PG8_STAGE(PG8_SB(1, 1), cB + hstep + kstep, voffB);
        PG8_WAIT_V(6); PG8_BAR;
    }
    for (;;) {
        const bool has_next = S.next(ui + 1, nxt);
        const char* nA = has_next ? (const char*)g.A + (size_t)nxt.pm * tstep : cA; const char* nB = has_next ? (const char*)g.Bt + (size_t)nxt.pn * tstep : cB;
        for (int t = 0; t < nt; t += 2) {
            const bool last = (t == nt - 2);
            const char* a1 = cA + (size_t)(t + 1) * kstep;
            const char* a2 = last ? nA : cA + (size_t)(t + 2) * kstep; const char* b2 = last ? nB : cB + (size_t)(t + 2) * kstep;
            const char* a3 = a2 + kstep; const char* b3 = b2 + kstep;
            if (last && has_next) S.a_ready(nxt);
            if constexpr (SP2) {
            PG8_LDB(B0, 0, 0); PG8_LDB(B1, 0, 1); PG8_SCHED; PG8_LDA(At, 0, 0); PG8_STAGE(PG8_SA(1, 1), a1 + hstep, voffA);
            PG8_WAIT_V(8); PG8_WAIT_L(0); PG8_BAR; PG8_MMA(0, 0, At, B0); PG8_MMA(0, 1, At, B1); PG8_BAR; PG8_SCHED;
            PG8_LDA(At, 0, 1); PG8_STAGE(PG8_SB(0, 0), b2, voffB); PG8_STAGE(PG8_SB(0, 1), b2 + hstep, voffB); PG8_STAGE(PG8_SA(0, 0), a2, voffA);
            PG8_WAIT_V(8); PG8_WAIT_L(0); PG8_BAR; PG8_MMA(1, 0, At, B0); PG8_MMA(1, 1, At, B1); PG8_BAR; PG8_SCHED;
            PG8_LDB(B0, 1, 0); PG8_LDB(B1, 1, 1); PG8_SCHED; PG8_LDA(At, 1, 0); PG8_STAGE(PG8_SA(0, 1), a2 + hstep, voffA);
            PG8_WAIT_V(8); PG8_WAIT_L(0); PG8_BAR; PG8_MMA(0, 0, At, B0); PG8_MMA(0, 1, At, B1); PG8_BAR; PG8_SCHED;
            PG8_LDA(At, 1, 1); PG8_STAGE(PG8_SB(1, 0), b3, voffB); PG8_STAGE(PG8_SB(1, 1), b3 + hstep, voffB); PG8_STAGE(PG8_SA(1, 0), a3, voffA);
            PG8_WAIT_V(8); PG8_WAIT_L(0); PG8_BAR; PG8_MMA(1, 0, At, B0); PG8_MMA(1, 1, At, B1); PG8_BAR; PG8_SCHED;
            } else {
            PG8_LDB(B0, 0, 0); PG8_SCHED; PG8_LDA(At, 0, 0); PG8_STAGE(PG8_SA(1, 1), a1 + hstep, voffA);
            PG8_WAIT_L(8); PG8_BAR; PG8_WAIT_L(0); PG8_MMA(0, 0, At, B0); PG8_BAR; PG8_SCHED;
            PG8_LDB(B1, 0, 1); PG8_STAGE(PG8_SB(0, 0), b2, voffB);
            PG8_BAR; PG8_WAIT_L(0); PG8_MMA(0, 1, At, B1); PG8_BAR;
            PG8_LDA(At, 0, 1); PG8_STAGE(PG8_SA(0, 0), a2, voffA);
            PG8_BAR; PG8_WAIT_L(0); PG8_MMA(1, 0, At, B0); PG8_BAR; PG8_SCHED;
            PG8_STAGE(PG8_SB(0, 1), b2 + hstep, voffB);
            PG8_WAIT_V(6); PG8_BAR; PG8_MMA(1, 1, At, B1); PG8_BAR;
            PG8_LDB(B0, 1, 0); PG8_SCHED; PG8_LDA(At, 1, 0); PG8_STAGE(PG8_SA(0, 1), a2 + hstep, voffA);
            PG8_WAIT_L(8); PG8_BAR; PG8_WAIT_L(0); PG8_MMA(0, 0, At, B0); PG8_BAR; PG8_SCHED;
            PG8_LDB(B1, 1, 1); PG8_STAGE(PG8_SB(1, 0), b3, voffB);
            PG8_BAR; PG8_WAIT_L(0); PG8_MMA(0, 1, At, B1); PG8_BAR;
            PG8_LDA(At, 1, 1); PG8_STAGE(PG8_SA(1, 0), a3, voffA);
            PG8_BAR; PG8_WAIT_L(0); PG8_MMA(1, 0, At, B0); PG8_BAR; PG8_SCHED;
            PG8_STAGE(PG8_SB(1, 1), b3 + hstep, voffB);
            PG8_WAIT_V(6); PG8_BAR; PG8_MMA(1, 1, At, B1); PG8_BAR;
            }
        }
        if constexpr (ALIGN_EPI) { if (wr == 0) PG8_BAR; }
        if constexpr (!Epi::AFTER_DRAIN) { E(acc, cur, wr, wc, fr, fq); S.done(cur); }
        if (!has_next) break;
#pragma unroll
        for (int a = 0; a < 2; ++a)
#pragma unroll
            for (int b = 0; b < 2; ++b)
#pragma unroll
                for (int m = 0; m < 4; ++m)
#pragma unroll
                    for (int n = 0; n < 2; ++n) acc[a][b][m][n] = (f32x4){0.f, 0.f, 0.f, 0.f};
        cur = nxt; cA = nA; cB = nB; ++ui;
        if constexpr (ALIGN_EPI) { if (wr == 1) PG8_BAR; }
    }
    PG8_WAIT_V(0);
    if constexpr (!ALIGN_EPI) { if (wr == 0) PG8_BAR; }
    PG8_BAR;
    if constexpr (Epi::AFTER_DRAIN) { E.fused(acc, cur, wr, wc, fr, fq, lds, wid, lane); S.done(cur); }
#undef PG8_SA
#undef PG8_SB
#undef PG8_STAGE
#undef PG8_LDA
#undef PG8_LDB
#undef PG8_MMA
#undef PG8_WAIT_V
#undef PG8_WAIT_L
#undef PG8_BAR
#undef PG8_SCHED
}
}

namespace att {
typedef short bf16x8 __attribute__((ext_vector_type(8)));
typedef short s16x4 __attribute__((ext_vector_type(4)));
typedef float f32x16 __attribute__((ext_vector_type(16)));
typedef float f32x2_t __attribute__((ext_vector_type(2)));
typedef __bf16 bf16x2_t __attribute__((ext_vector_type(2)));
typedef __attribute__((address_space(3))) const unsigned char* lds_cptr;
typedef short v4i16_t __attribute__((ext_vector_type(4)));
constexpr int KTILE = 8192, VTILE = 16384, KSLOT = 2 * KTILE, VSLOT = 2 * VTILE, LDS_K = 0, LDS_V = 2 * KSLOT, LDS_BYTES = 2 * KSLOT + 2 * VSLOT;
constexpr float LOG2E = 1.4426950408889634f, C2 = 0.125f * LOG2E;
__device__ __forceinline__ int crow(int r, int hi) { return (r & 3) + 8 * (r >> 2) + 4 * hi; }
__device__ __forceinline__ void glds16(const void* gsrc, unsigned lds_dst) { unsigned keep;
    asm volatile("s_mov_b32 %0, m0\n\ts_mov_b32 m0, %2\n\ts_nop 0\n\tglobal_load_lds_dwordx4 %1, off\n\ts_mov_b32 m0, %0" : "=&s"(keep) : "v"(gsrc), "s"(lds_dst) : "memory"); }
__device__ __forceinline__ unsigned cvtpk(float lo, float hi) { f32x2_t v = {lo, hi}; bf16x2_t b = __builtin_convertvector(v, bf16x2_t); return __builtin_bit_cast(unsigned, b); }
__device__ __forceinline__ s16x4 vtr(lds_cptr p) { return __builtin_bit_cast(s16x4, __builtin_amdgcn_ds_read_tr16_b64_v4i16((__attribute__((address_space(3))) v4i16_t*)p)); }
__device__ __forceinline__ float swap_max(float m) { auto rr = __builtin_amdgcn_permlane32_swap(__float_as_uint(m), __float_as_uint(m), false, false); return fmaxf(__uint_as_float(rr[0]), __uint_as_float(rr[1])); }
__device__ __forceinline__ float swap_sum(float m) { auto rr = __builtin_amdgcn_permlane32_swap(__float_as_uint(m), __float_as_uint(m), false, false); return __uint_as_float(rr[0]) + __uint_as_float(rr[1]); }
#define ATT_WAIT_BAR() asm volatile("s_waitcnt vmcnt(0) lgkmcnt(0)\n\ts_barrier" ::: "memory")

struct Args { const bf16* Q; const bf16* K; const bf16* V; bf16* mixed; float* stash; const float* lq; const float* lk; const float* subln; const float* gq; const float* gk; float lam_init; int pad_; };

constexpr int PART_G = 17, PART_SLOT_F = 512 * 4 * PART_G, MAX_SLOTS = 1700, SPLIT_MIN = 20, PART_TILES = 40, TAB_OFF = 102400;
__device__ __forceinline__ void attn_pass(__attribute__((address_space(3))) unsigned char* lds, const Args& A, int h, int qb, int c, int ta, int tb, int nw, f32x16 (&oT)[4], float& l_out, float& M_out) {
    const int tid = opq_tid(), lane = tid & 63, r32 = lane & 31, hi = lane >> 5; const int wid = __builtin_amdgcn_readfirstlane(tid >> 6);
    const int q0 = qb * 256 + wid * 32, qc = q0 >> 6;
    const float slope2 = exp2f(-(float)(h + 1)) * LOG2E;
    const unsigned lds0 = (unsigned)(uintptr_t)lds;
    const lds_cptr kp0 = (lds_cptr)lds + LDS_K + hi * 1024 + r32 * 16;
    const lds_cptr vp0 = (lds_cptr)lds + LDS_V + ((lane >> 4) & 1) * 32 + (lane & 3) * 8 + (4 * hi + ((lane & 15) >> 2)) * 64;
    const bf16* vsrc = A.V + (size_t)(16 * (wid & 3) + (lane >> 2)) * 1024 + h * 128 + (wid >> 2) * 32 + (lane & 3) * 8;
    const unsigned kdst = lds0 + LDS_K + wid * 1024, vdst = lds0 + LDS_V + (wid >> 2) * 4096 + (wid & 3) * 1024;
    const int qrel = (q0 & 63) + r32;
    const int tw0 = max(ta, max(0, qc - nw));
    const bf16* ksrc = A.K + (size_t)lane * 1024 + h * 128 + c * 64 + wid * 8;
    bf16x8 qr[4];
    { const bf16* qp = A.Q + (size_t)(q0 + r32) * 1024 + h * 128 + c * 64 + hi * 8;
#pragma unroll
      for (int d0 = 0; d0 < 4; ++d0) qr[d0] = *(const bf16x8*)(qp + d0 * 16); }
#pragma unroll
    for (int d0 = 0; d0 < 4; ++d0)
#pragma unroll
        for (int r = 0; r < 16; ++r) oT[d0][r] = 0.f;
    float l = 0.f, mu = 0.f;
    if (ta < tb) {
#define ATT_DMA(t_, so_, u_) do { const size_t go = (size_t)(t_) * 64 * 1024; \
            glds16(ksrc + go, (unsigned)__builtin_amdgcn_readfirstlane(kdst + (so_) * KSLOT + (u_) * KTILE)); glds16(vsrc + go, (unsigned)__builtin_amdgcn_readfirstlane(vdst + (so_) * VSLOT + (u_) * VTILE)); \
            glds16(vsrc + go + 64, (unsigned)__builtin_amdgcn_readfirstlane(vdst + (so_) * VSLOT + (u_) * VTILE + 8192)); } while (0)
        ATT_DMA(ta, 0u, 0u); if (ta + 1 < tb) ATT_DMA(ta + 1, 0u, 1u);
        ATT_WAIT_BAR();
#pragma unroll 1
        for (int T = ta; T < tb; T += 2) {
          const unsigned so = (unsigned)(((T - ta) >> 1) & 1);
          if (T + 2 < tb) { ATT_DMA(T + 2, so ^ 1u, 0u); if (T + 3 < tb) ATT_DMA(T + 3, so ^ 1u, 1u); }
#pragma unroll 1
          for (int u = 0; u < 2; ++u) {
            const int t = T + u, sl = 0; (void)sl;
            if (t >= tb) break;
            if (t >= tw0 && t <= qc) {
                const bool diag = (t == qc);
                f32x16 p0, p1;
                const float sc = slope2 * (1.0f / C2), base0 = (float)(4 * hi) * sc - mu * (1.0f / C2), base1 = base0 + 32.0f * sc;
                if (!diag) {
#pragma unroll
                    for (int r = 0; r < 16; ++r) { const float kr = (float)((r & 3) + 8 * (r >> 2)); p0[r] = __builtin_fmaf(kr, sc, base0); p1[r] = __builtin_fmaf(kr, sc, base1); }
                } else {
                    const float q2 = (float)(2 * qrel - 8 * hi);
#pragma unroll
                    for (int r = 0; r < 16; ++r) { const float kr = (float)((r & 3) + 8 * (r >> 2));
                        p0[r] = __builtin_fmaf(fminf(kr, q2 - kr) , sc, base0); p1[r] = __builtin_fmaf(fminf(kr, q2 - 64.0f - kr), sc, base1); }
                }
                const lds_cptr kp = kp0 + so * KSLOT + u * KTILE;
#pragma unroll
                for (int d0 = 0; d0 < 4; ++d0) {
                    const bf16x8 k0 = *(const __attribute__((address_space(3))) bf16x8*)(kp + d0 * 2048), k1 = *(const __attribute__((address_space(3))) bf16x8*)(kp + d0 * 2048 + 512);
                    p0 = __builtin_amdgcn_mfma_f32_32x32x16_bf16(k0, qr[d0], p0, 0, 0, 0);
                    p1 = __builtin_amdgcn_mfma_f32_32x32x16_bf16(k1, qr[d0], p1, 0, 0, 0);
                }
                const lds_cptr vp = vp0 + so * VSLOT + u * VTILE;
                bf16x8 vfA[4], vfB[4];
#define ATT_VLOAD(dst, d0_) do { _Pragma("unroll") for (int s = 0; s < 4; ++s) { const s16x4 lo = vtr(vp + (d0_) * 4096 + s * 1024), hh = vtr(vp + (d0_) * 4096 + s * 1024 + 512); \
                        dst[s] = (bf16x8){lo[0], lo[1], lo[2], lo[3], hh[0], hh[1], hh[2], hh[3]}; } } while (0)
#define ATT_PV(src, d0_) do { _Pragma("unroll") for (int s = 0; s < 4; ++s) oT[d0_] = __builtin_amdgcn_mfma_f32_32x32x16_bf16(src[s], pw[s], oT[d0_], 0, 0, 0); } while (0)
                ATT_VLOAD(vfA, 0);
                __builtin_amdgcn_sched_barrier(0);
                float rm = fmaxf(fmaxf(p0[0], p1[0]), p0[1]);
#pragma unroll
                for (int r = 1; r < 16; ++r) rm = fmaxf(fmaxf(rm, p1[r]), r + 1 < 16 ? p0[r + 1] : p1[r]);
                rm = swap_max(rm);
                const float dl = (t == tw0) ? C2 * rm : fmaxf(C2 * rm, 0.f);
                if (__any(dl != 0.f)) { const float f = __builtin_amdgcn_exp2f(-dl); l *= f;
#pragma unroll
                    for (int d0 = 0; d0 < 4; ++d0)
#pragma unroll
                        for (int r = 0; r < 16; ++r) oT[d0][r] *= f; }
                mu += dl;
                float ls = 0.f;
#pragma unroll
                for (int r = 0; r < 16; ++r) { p0[r] = __builtin_amdgcn_exp2f(p0[r] * C2 - dl); p1[r] = __builtin_amdgcn_exp2f(p1[r] * C2 - dl); ls += p0[r] + p1[r]; }
                l += ls;
                bf16x8 pw[4];
#pragma unroll
                for (int s = 0; s < 4; ++s) { u32x4 w;
#pragma unroll
                    for (int e = 0; e < 4; ++e) { const int r = 8 * (s & 1) + 2 * e; w[e] = (s < 2) ? cvtpk(p0[r], p0[r + 1]) : cvtpk(p1[r], p1[r + 1]); }
                    pw[s] = __builtin_bit_cast(bf16x8, w); }
                ATT_VLOAD(vfB, 1); __builtin_amdgcn_sched_barrier(0);
                ATT_PV(vfA, 0);
                ATT_VLOAD(vfA, 2); __builtin_amdgcn_sched_barrier(0);
                ATT_PV(vfB, 1);
                ATT_VLOAD(vfB, 3); __builtin_amdgcn_sched_barrier(0);
                ATT_PV(vfA, 2);
                __builtin_amdgcn_sched_barrier(0);
                ATT_PV(vfB, 3);
#undef ATT_VLOAD
#undef ATT_PV
                mu -= 64.0f * slope2;
            }
          }
          ATT_WAIT_BAR();
        }
#undef ATT_DMA
    }
    const int tl = min(qc, tb - 1);
    l_out = l; M_out = (tl >= tw0) ? mu + slope2 * 64.0f * (float)(tl + 1) : -1e30f;
}
__device__ __forceinline__ void attn_finalize(const Args& A, int h, int qb, const f32x16 (&o1)[4], f32x16 (&o2)[4], float lam) {
    const int tid = opq_tid(), lane = tid & 63, r32 = lane & 31, hi = lane >> 5; const int wid = __builtin_amdgcn_readfirstlane(tid >> 6);
    const int q0 = qb * 256 + wid * 32;
    float ss = 0.f;
#pragma unroll
    for (int d0 = 0; d0 < 4; ++d0)
#pragma unroll
        for (int r = 0; r < 16; ++r) { const float v = o1[d0][r] - lam * o2[d0][r]; o2[d0][r] = v; ss += v * v; }
    ss = swap_sum(ss);
    const float rn = (1.0f / sqrtf(ss * (1.0f / 128.0f) + RMS_EPS)) * (1.0f - A.lam_init);
    bf16* op = A.mixed + (size_t)(q0 + r32) * DM + h * 128;
#pragma unroll
    for (int d0 = 0; d0 < 4; ++d0)
#pragma unroll
        for (int g4 = 0; g4 < 4; ++g4) { const int d = 32 * d0 + 8 * g4 + 4 * hi; const f32x4 gg = *(const f32x4*)(A.subln + d);
            u32x2 w; w.x = cvtpk(o2[d0][4 * g4] * rn * gg[0], o2[d0][4 * g4 + 1] * rn * gg[1]); w.y = cvtpk(o2[d0][4 * g4 + 2] * rn * gg[2], o2[d0][4 * g4 + 3] * rn * gg[3]);
            *(u32x2*)(op + d) = w; }
}
struct Win { float smax0, smax1; };
__device__ __forceinline__ int win_nw(const Win& W, int h, int c) { const float smax = c ? W.smax1 : W.smax0, slope2 = exp2f(-(float)(h + 1)) * LOG2E, dmin = (2.0f * C2 * smax + 67.0f) / slope2; return (int)fminf(ceilf((dmin + 63.0f) * (1.0f / 64.0f)) - 1.0f, 256.0f); }
__device__ __forceinline__ void attn_windows(const Args& A, Win& W, float& lam) {
    const int lane = opq_tid() & 63;
    const float l0 = wave_sum(A.lq[lane] * A.lk[lane]), l1 = wave_sum(A.lq[64 + lane] * A.lk[64 + lane]);
    lam = __expf(l0) - __expf(l1) + A.lam_init;
#pragma unroll
    for (int c = 0; c < 2; ++c) { float a = fabsf(A.gq[c * 64 + lane]), b = fabsf(A.gk[c * 64 + lane]);
#pragma unroll
        for (int o = 1; o < 64; o <<= 1) { a = fmaxf(a, __shfl_xor(a, o)); b = fmaxf(b, __shfl_xor(b, o)); }
        const float smax = 64.0f * 1.02f * a * b; if (c == 0) W.smax0 = smax; else W.smax1 = smax; }
}
__device__ __forceinline__ int attn_ntile(const Win& W, int h, int qb, int c) { return 4 * qb + 4 - max(0, 4 * qb - win_nw(W, h, c)); }
__device__ __forceinline__ int attn_table(__attribute__((address_space(3))) unsigned char* lds, const Win& W) {
    volatile __attribute__((address_space(3))) unsigned* tab = (volatile __attribute__((address_space(3))) unsigned*)(lds + TAB_OFF);
    const int tid = opq_tid(), lane = tid & 63, wid = tid >> 6, qb = 63 - (tid >> 3), h = tid & 7;
    const int nt = max(attn_ntile(W, h, qb, 0), attn_ntile(W, h, qb, 1));
    int P = nt > SPLIT_MIN ? (nt + PART_TILES - 1) / PART_TILES : 0;
    int want = 2 * P, incl = want;
#pragma unroll
    for (int o = 1; o < 64; o <<= 1) { const int v = __shfl_up(incl, o); if (lane >= o) incl += v; }
    if (lane == 63) tab[1032 + wid] = (unsigned)incl;
    asm volatile("s_waitcnt lgkmcnt(0)" ::: "memory"); __builtin_amdgcn_s_barrier(); asm volatile("" ::: "memory");
    int sbase = 0;
#pragma unroll
    for (int w = 0; w < 8; ++w) sbase += (w < wid) ? (int)tab[1032 + w] : 0;
    const int sstart = sbase + incl - want;
    if (sstart + want > MAX_SLOTS) P = 0;
    const int cnt = P > 0 ? 2 * P : 1; int ci = cnt;
#pragma unroll
    for (int o = 1; o < 64; o <<= 1) { const int v = __shfl_up(ci, o); if (lane >= o) ci += v; }
    if (lane == 63) tab[1024 + wid] = (unsigned)ci;
    asm volatile("s_waitcnt lgkmcnt(0)" ::: "memory"); __builtin_amdgcn_s_barrier(); asm volatile("" ::: "memory");
    int ibase = 0, total = 0;
#pragma unroll
    for (int w = 0; w < 8; ++w) { const int v = (int)tab[1024 + w]; ibase += (w < wid) ? v : 0; total += v; }
    tab[tid] = (unsigned)(ibase + ci - cnt) | ((unsigned)P << 16); tab[512 + tid] = (unsigned)sstart;
    asm volatile("s_waitcnt lgkmcnt(0)" ::: "memory"); __builtin_amdgcn_s_barrier(); asm volatile("" ::: "memory");
    return total;
}
__device__ __forceinline__ void part_range(const Win& W, int h, int qb, int c, int P, int p, int& ta, int& tb) {
    const int NT = 4 * qb + 4, T0 = max(0, 4 * qb - win_nw(W, h, c)), len = (NT - T0 + P - 1) / P; ta = min(NT, T0 + p * len); tb = min(NT, ta + len);
}
__device__ __forceinline__ void attn_phase(__attribute__((address_space(3))) unsigned char* lds, const Args& A, int blk, unsigned* ctr, volatile __attribute__((address_space(3))) unsigned* qslot, float* part) {
    const int tid = opq_tid();
    Win W; float lam; attn_windows(A, W, lam);
    const int nitems = attn_table(lds, W);
    volatile __attribute__((address_space(3))) unsigned* tab = (volatile __attribute__((address_space(3))) unsigned*)(lds + TAB_OFF);
    float* st = A.stash + (size_t)blk * (64 * 512) + tid * 64;
    for (;;) {
        if (tid == 0) { const unsigned n = __hip_atomic_fetch_add(ctr, 1u, __ATOMIC_RELAXED, __HIP_MEMORY_SCOPE_AGENT); unsigned idx = 0;
            if (n < (unsigned)nitems) { int lo = 0, hi = 511; while (lo < hi) { const int mid = (lo + hi + 1) >> 1; if ((tab[mid] & 0xffffu) <= n) lo = mid; else hi = mid - 1; } idx = (unsigned)lo; }
            qslot[0] = n; qslot[1] = idx; }
        asm volatile("s_waitcnt vmcnt(0) lgkmcnt(0)" ::: "memory"); __builtin_amdgcn_s_barrier(); asm volatile("" ::: "memory");
        const unsigned n = qslot[0], idx = qslot[1];
        asm volatile("s_waitcnt lgkmcnt(0)" ::: "memory"); __builtin_amdgcn_s_barrier(); asm volatile("" ::: "memory");
        if (n >= (unsigned)nitems) break;
        const unsigned e = tab[idx]; const int P = (int)(e >> 16), sub = (int)(n - (e & 0xffffu)), h = (int)(idx & 7u), qb = 63 - (int)(idx >> 3);
        f32x16 oT[4]; float l, M;
        if (P == 0) {
#pragma unroll 1
            for (int c = 0; c < 2; ++c) {
                attn_pass(lds, A, h, qb, c, max(0, 4 * qb - win_nw(W, h, c)), 4 * qb + 4, win_nw(W, h, c), oT, l, M);
                const float il = 1.0f / swap_sum(l);
#pragma unroll
                for (int d0 = 0; d0 < 4; ++d0)
#pragma unroll
                    for (int r = 0; r < 16; ++r) oT[d0][r] *= il;
                if (c == 0) {
#pragma unroll
                    for (int d0 = 0; d0 < 4; ++d0)
#pragma unroll
                        for (int r = 0; r < 16; r += 4) *(f32x4*)(st + d0 * 16 + r) = (f32x4){oT[d0][r], oT[d0][r + 1], oT[d0][r + 2], oT[d0][r + 3]};
                } else { f32x16 o1[4];
#pragma unroll
                    for (int d0 = 0; d0 < 4; ++d0)
#pragma unroll
                        for (int r = 0; r < 16; r += 4) { const f32x4 v = *(const f32x4*)(st + d0 * 16 + r); o1[d0][r] = v[0]; o1[d0][r + 1] = v[1]; o1[d0][r + 2] = v[2]; o1[d0][r + 3] = v[3]; }
                    attn_finalize(A, h, qb, o1, oT, lam); }
            }
        } else {
            const int c = sub / P, p = sub % P; int ta, tb; part_range(W, h, qb, c, P, p, ta, tb);
            attn_pass(lds, A, h, qb, c, ta, tb, win_nw(W, h, c), oT, l, M);
            float* ps = part + (size_t)(tab[512 + idx] + (unsigned)sub) * PART_SLOT_F + tid * 4;
#pragma unroll
            for (int d0 = 0; d0 < 4; ++d0)
#pragma unroll
                for (int r = 0; r < 16; r += 4) *(f32x4*)(ps + (d0 * 4 + (r >> 2)) * 2048) = (f32x4){oT[d0][r], oT[d0][r + 1], oT[d0][r + 2], oT[d0][r + 3]};
            *(f32x4*)(ps + 16 * 2048) = (f32x4){l, M, 0.f, 0.f};
        }
    }
}
__device__ __forceinline__ void attn_combine(__attribute__((address_space(3))) unsigned char* lds, const Args& A, int blk, int nblk, const float* part) {
    const int tid = opq_tid();
    Win W; float lam; attn_windows(A, W, lam);
    (void)attn_table(lds, W);
    volatile __attribute__((address_space(3))) unsigned* tab = (volatile __attribute__((address_space(3))) unsigned*)(lds + TAB_OFF);
    int seen = 0, mine = blk, rnd = 0, base2 = nblk;
    for (int idx = 0; idx < 512; ++idx) {
        const unsigned e = tab[idx]; const int P = (int)(e >> 16); if (P == 0) continue;
        if (seen++ != mine) continue;
        rnd ^= 1; mine = rnd ? base2 + (nblk - 1 - blk) : base2 + nblk + blk; if (!rnd) base2 += 2 * nblk;

        const int h = idx & 7, qb = 63 - (idx >> 3);
        f32x16 o1[4], o2[4];
#pragma unroll 1
        for (int c = 0; c < 2; ++c) {
            const float* ps = part + (size_t)(tab[512 + idx] + (unsigned)(c * P)) * PART_SLOT_F + tid * 4;
            f32x4 lm[7]; float f[7];
#pragma unroll
            for (int p = 0; p < 7; ++p) lm[p] = p < P ? *(const f32x4*)(ps + (size_t)p * PART_SLOT_F + 16 * 2048) : (f32x4){0.f, -1e30f, 0.f, 0.f};
            float M = lm[0][1];
#pragma unroll
            for (int p = 1; p < 7; ++p) M = fmaxf(M, lm[p][1]);
            float L = 0.f;
#pragma unroll
            for (int p = 0; p < 7; ++p) { f[p] = __builtin_amdgcn_exp2f(lm[p][1] - M); L += lm[p][0] * f[p]; }
#pragma unroll
            for (int d0 = 0; d0 < 4; ++d0)
#pragma unroll
                for (int r = 0; r < 16; ++r) o2[d0][r] = 0.f;
            f32x4 hb[2][8];
#define ATT_HLOAD(hp_) do { if (((hp_) >> 1) < P) { const float* pp = ps + (size_t)((hp_) >> 1) * PART_SLOT_F + ((hp_) & 1) * 8 * 2048; \
                _Pragma("unroll") for (int q = 0; q < 8; ++q) hb[(hp_) & 1][q] = *(const f32x4*)(pp + q * 2048); } } while (0)
            ATT_HLOAD(0);
#pragma unroll
            for (int hp = 0; hp < 14; ++hp) {
                if (hp + 1 < 14) ATT_HLOAD(hp + 1);
                if ((hp >> 1) < P) { const float fp = f[hp >> 1];
#pragma unroll
                    for (int q = 0; q < 8; ++q) { const int d0 = 2 * (hp & 1) + (q >> 2), r = 4 * (q & 3); const f32x4 v = hb[hp & 1][q];
                        o2[d0][r] += v[0] * fp; o2[d0][r + 1] += v[1] * fp; o2[d0][r + 2] += v[2] * fp; o2[d0][r + 3] += v[3] * fp; } }
            }
#undef ATT_HLOAD
            const float il = 1.0f / swap_sum(L);
            if (c == 0) {
#pragma unroll
                for (int d0 = 0; d0 < 4; ++d0)
#pragma unroll
                    for (int r = 0; r < 16; ++r) o1[d0][r] = o2[d0][r] * il;
            } else {
#pragma unroll
                for (int d0 = 0; d0 < 4; ++d0)
#pragma unroll
                    for (int r = 0; r < 16; ++r) o2[d0][r] *= il;
            }
        }
        attn_finalize(A, h, qb, o1, o2, lam);
    }
}
}

namespace rk {
typedef short bf16x8 __attribute__((ext_vector_type(8)));
typedef short s16x4 __attribute__((ext_vector_type(4)));
typedef short v4i16_t __attribute__((ext_vector_type(4)));
typedef const LAS unsigned char* lcp;
constexpr int ST = 72, MATB = 64 * ST * 2, NST = 68, SLG = 168, SVL = 40;
constexpr int O_AT = 0, O_RT = MATB, O_BT = 2 * MATB, O_KT = 3 * MATB, O_VV = 4 * MATB, O_AAK = 5 * MATB, O_ARB = 6 * MATB, O_ARK = 7 * MATB, O_NN = 8 * MATB, O_GG = O_NN + 64 * NST * 4,
              O_G2 = O_AAK  , O_VG = O_ARK  , O_SEG = O_GG + 64 * NST * 4, O_GL = O_SEG + 2048,
              O_LW = O_GL + 256, O_LA = O_LW + MATB, O_LG = O_LA + MATB, O_VL = O_LG + 64 * SLG * 2, O_END = O_VL + 64 * SVL * 2,
              O_NB16 = O_LW  , O_WT = O_LW + MATB, O_U0T = O_LW + 2 * MATB, O_CB = O_LW + 3 * MATB  , CBS = 132;
static_assert(64 * NST * 4 <= 2 * MATB && O_END <= 156000 && O_CB + 16 * CBS * 4 <= O_END, "stage-1 LDS map");
__device__ __forceinline__ f32x4 mfma16(bf16x8 a, bf16x8 b, f32x4 c) { return __builtin_amdgcn_mfma_f32_16x16x32_bf16(a, b, c, 0, 0, 0); }
__device__ __forceinline__ s16x4 vtr(lcp p) { return __builtin_bit_cast(s16x4, __builtin_amdgcn_ds_read_tr16_b64_v4i16((LAS v4i16_t*)p)); }
__device__ __forceinline__ bf16x8 frag(lcp m, int row0, int ks, int lane, int st = ST) { return *(const LAS bf16x8*)(m + ((row0 + (lane & 15)) * st + 32 * ks + 8 * (lane >> 4)) * 2); }
__device__ __forceinline__ bf16x8 tfrag(lcp m, int c0, int ks, int lane) {
    const int i = lane & 15, q = i >> 2, p = i & 3, k0 = 32 * ks + 8 * (lane >> 4);
    const s16x4 lo = vtr(m + ((k0 + q) * ST + c0 + 4 * p) * 2), hi = vtr(m + ((k0 + 4 + q) * ST + c0 + 4 * p) * 2);
    return (bf16x8){lo[0], lo[1], lo[2], lo[3], hi[0], hi[1], hi[2], hi[3]};
}
__device__ __forceinline__ unsigned pk(float a, float b) { return f2bf(a) | (f2bf(b) << 16); }
#define RK_BAR() do { asm volatile("s_waitcnt lgkmcnt(0)" ::: "memory"); __builtin_amdgcn_s_barrier(); asm volatile("" ::: "memory"); } while (0)


constexpr int SOLVE_DEPTH = 3;
__host__ __device__ constexpr int solve_quads(int p) { return (2 * p + 1 + 3) / 4; }
typedef float f32x2 __attribute__((ext_vector_type(2)));
template <int P, int Q> struct SolveStep {
    static constexpr int NQ = solve_quads(P);
    template <int D, int PP, int QQ> struct Ahead { static constexpr int nxtP = (QQ + 1 < solve_quads(PP)) ? PP : PP + 1, nxtQ = (QQ + 1 < solve_quads(PP)) ? QQ + 1 : 0; using T = typename Ahead<D - 1, nxtP, nxtQ>::T; };
    template <int PP, int QQ> struct Ahead<0, PP, QQ> { using T = SolveStep<PP, QQ>; };
    static __device__ __forceinline__ void load(f32x4 (&ring)[SOLVE_DEPTH][2], int slot, LAS unsigned char* nn) {
        if constexpr (P < 32) { ring[slot][0] = *(const LAS f32x4*)(nn + ((2 * P) * NST + 4 * Q) * 4); ring[slot][1] = *(const LAS f32x4*)(nn + ((2 * P + 1) * NST + 4 * Q) * 4); }
    }
    template <int SLOT> static __device__ __forceinline__ void run(f32x2 (&x)[64], f32x2& a0, f32x2& a1, f32x4 (&ring)[SOLVE_DEPTH][2], LAS unsigned char* nn) {
        using AH = typename Ahead<SOLVE_DEPTH, P, Q>::T;
        const f32x4 n0 = ring[SLOT][0], n1 = ring[SLOT][1];
        asm volatile("" ::: "memory"); __builtin_amdgcn_sched_barrier(0);
        AH::load(ring, SLOT, nn);
        asm volatile("" ::: "memory"); __builtin_amdgcn_sched_barrier(0);
#pragma unroll
        for (int e = 0; e < 4; ++e)
            if (4 * Q + e < 2 * P) { a0 = __builtin_elementwise_fma((f32x2){n0[e], n0[e]}, x[4 * Q + e], a0); a1 = __builtin_elementwise_fma((f32x2){n1[e], n1[e]}, x[4 * Q + e], a1); }
        if constexpr (Q + 1 == NQ) {
            x[2 * P] = a0; asm volatile("" : "+v"(x[2 * P]));
            { constexpr int c = 2 * P, q = c / 4, e = c % 4; static_assert(q == Q, "column 2P lies in the pair's last quad"); a1 = __builtin_elementwise_fma((f32x2){n1[e], n1[e]}, x[c], a1); }
            x[2 * P + 1] = a1; asm volatile("" : "+v"(x[2 * P + 1]));
            if constexpr (P + 1 < 32) { a0 = x[2 * P + 2]; a1 = x[2 * P + 3]; SolveStep<P + 1, 0>::template run<(SLOT + 1) % SOLVE_DEPTH>(x, a0, a1, ring, nn); }
        } else {
            asm volatile("" : "+v"(a0), "+v"(a1));
            SolveStep<P, Q + 1>::template run<(SLOT + 1) % SOLVE_DEPTH>(x, a0, a1, ring, nn);
        }
    }
};

struct S1Args {
    const bf16* rw; const float* mu; const float* w0; const float* a0; const float* v0; const float* k_k; const float* k_a; const float* r_k;
    const bf16* w2t; const bf16* a2t; const bf16* g2t; const bf16* v2t;
    bf16* vfirst; bf16* BV; bf16* GB; bf16* PG; float* QT; bf16* RP; float* Y0; unsigned char* act; int layer; int pad_;
};
constexpr int ACT_LOGW = 0, ACT_AR = 262144, ACT_G = 524288, ACT_VG = 655360, ACT_WG_BYTES = 786432;
__device__ __forceinline__ float frcp(float x) { return __builtin_amdgcn_rcpf(x); }
__device__ __forceinline__ float fsigmoid(float x) { return frcp(1.0f + __expf(-x)); }
__device__ __forceinline__ float ftanh(float x) { const float e = __expf(-2.0f * fabsf(x)), t = (1.0f - e) * frcp(1.0f + e); return x < 0.f ? -t : t; }
__device__ __forceinline__ float ldbf(const bf16* p) { return bf2f(*p); }

__device__ __forceinline__ void stage1_latents(LAS unsigned char* lds, const S1Args& A, int t0) {
    const int tid = opq_tid();
#pragma unroll 1
    for (int bt = 0; bt < 5; ++bt) {
        float cur[8], prv[8], muv[8];
#pragma unroll
        for (int i = 0; i < 8; ++i) { const int idx = tid + 512 * (bt * 8 + i), tok = idx / 320, col = idx % 320, t = t0 + tok;
            const bf16* p = A.rw + (size_t)t * RWP + 3072 + col;
            cur[i] = ldbf(p); prv[i] = t > 0 ? ldbf(p - RWP + (col < 288 ? 0 : 32)) : 0.f; muv[i] = col < 288 ? A.mu[3072 + col] : 0.f; }
#pragma unroll
        for (int i = 0; i < 8; ++i) { const int idx = tid + 512 * (bt * 8 + i), tok = idx / 320, col = idx % 320;
            if (col < 288) { const float sft = cur[i] + muv[i] * (prv[i] - cur[i]);
                if (col < 64) *(LAS unsigned short*)(lds + O_LW + (tok * ST + col) * 2) = (unsigned short)f2bf(ftanh(sft));
                else if (col < 128) *(LAS unsigned short*)(lds + O_LA + (tok * ST + col - 64) * 2) = (unsigned short)f2bf(sft);
                else *(LAS unsigned short*)(lds + O_LG + (tok * SLG + col - 128) * 2) = (unsigned short)f2bf(fsigmoid(sft));
            } else *(LAS unsigned short*)(lds + O_VL + (tok * SVL + col - 288) * 2) = (unsigned short)f2bf(cur[i] + prv[i]); }
    }
}

struct LoraB { bf16x8 w[2], a[2], g[5], v; f32x4 w0c, a0c, v0c; };
__device__ __forceinline__ void lora_load(LoraB& B, const S1Args& A, int it, int lane) {
    const int rq = lane >> 4, l15 = lane & 15, ch0 = 16 * it, ch = ch0 + l15;
    const bf16* pw = A.w2t + (size_t)ch * 64 + 8 * rq; const bf16* pa = A.a2t + (size_t)ch * 64 + 8 * rq; const bf16* pg = A.g2t + (size_t)ch * 160 + 8 * rq; const bf16* pv = A.v2t + (size_t)ch * 32 + 8 * rq;
    B.w[0] = *(const bf16x8*)pw; B.w[1] = *(const bf16x8*)(pw + 32); B.a[0] = *(const bf16x8*)pa; B.a[1] = *(const bf16x8*)(pa + 32); B.v = *(const bf16x8*)pv;
#pragma unroll
    for (int ks = 0; ks < 5; ++ks) B.g[ks] = *(const bf16x8*)(pg + 32 * ks);
    B.w0c = *(const f32x4*)(A.w0 + ch0 + 4 * rq); B.a0c = *(const f32x4*)(A.a0 + ch0 + 4 * rq); B.v0c = *(const f32x4*)(A.v0 + ch0 + 4 * rq);
}
__device__ __forceinline__ void lora_item(LAS unsigned char* lds, const LoraB& B, const S1Args& A, int it, int lane) {
    const int rq = lane >> 4, l15 = lane & 15, h = it >> 2, j0 = 16 * (it & 3) + 4 * rq;
#pragma unroll 1
    for (int tb = 0; tb < 4; ++tb) {
        const f32x4 z = {0.f, 0.f, 0.f, 0.f};
        const f32x4 zw = mfma16(B.w[1], frag(lds + O_LW, 16 * tb, 1, lane), mfma16(B.w[0], frag(lds + O_LW, 16 * tb, 0, lane), z));
        const f32x4 za = mfma16(B.a[1], frag(lds + O_LA, 16 * tb, 1, lane), mfma16(B.a[0], frag(lds + O_LA, 16 * tb, 0, lane), z));
        const f32x4 zv = mfma16(B.v, frag(lds + O_VL, 16 * tb, 0, lane, SVL), z);
        f32x4 zg = z;
#pragma unroll
        for (int ks = 0; ks < 5; ++ks) zg = mfma16(B.g[ks], frag(lds + O_LG, 16 * tb, ks, lane, SLG), zg);
        const int o = (h * 64 + 16 * tb + l15) * 64 + j0;
        f32x4 lo_, ar_; u32x2 gg_, vg_; float vgf[4];
#pragma unroll
        for (int e = 0; e < 4; ++e) {
            const float zz = -(B.w0c[e] + zw[e]), sp = fmaxf(zz, 0.f) + __logf(1.0f + __expf(-fabsf(zz))), wl = -sp - 0.5f;
            lo_[e] = -__expf(wl);
            ar_[e] = fsigmoid(B.a0c[e] + za[e]);
            vgf[e] = fsigmoid(B.v0c[e] + zv[e]);
        }
        gg_.x = pk(zg[0], zg[1]); gg_.y = pk(zg[2], zg[3]); vg_.x = pk(vgf[0], vgf[1]); vg_.y = pk(vgf[2], vgf[3]);
        *(f32x4*)(A.act + ACT_LOGW + o * 4) = lo_; *(f32x4*)(A.act + ACT_AR + o * 4) = ar_; *(u32x2*)(A.act + ACT_G + o * 2) = gg_; *(u32x2*)(A.act + ACT_VG + o * 2) = vg_;
    }
}
__device__ __forceinline__ void stage1_lora_all(LAS unsigned char* lds, const S1Args& A) {
    const int tid = opq_tid(), lane = tid & 63, wid = __builtin_amdgcn_readfirstlane(tid >> 6);
    LoraB B0, B1;
    lora_load(B0, A, wid, lane);
#pragma unroll 1
    for (int k = 0; k < 8; k += 2) {
        lora_load(B1, A, wid + 8 * (k + 1), lane);
        lora_item(lds, B0, A, wid + 8 * k, lane);
        if (k + 2 < 8) lora_load(B0, A, wid + 8 * (k + 2), lane);
        lora_item(lds, B1, A, wid + 8 * (k + 1), lane);
    }
}
struct PreF { unsigned short r[9], k[9], v[9], vf[8], g[8], vg[8]; float lw[8], ar[8], mur, muk, muv, kkw, kaw, rkw; };
__device__ __forceinline__ void pref_load(PreF& P, const S1Args& A, int c, int h, int wid, int lane) {
    const int ch = h * 64 + lane, tf = c * 64 + 8 * wid;
    P.mur = A.mu[ch]; P.muk = A.mu[1024 + ch]; P.muv = A.mu[2048 + ch]; P.kkw = A.k_k[ch]; P.kaw = A.k_a[ch]; P.rkw = A.r_k[ch];
    const bf16* rp = A.rw + (size_t)tf * RWP + ch;
    if (tf > 0) { P.r[0] = rp[-RWP]; P.k[0] = rp[-RWP + 1024]; P.v[0] = rp[-RWP + 2048]; } else { P.r[0] = 0; P.k[0] = 0; P.v[0] = 0; }
#pragma unroll
    for (int e = 0; e < 8; ++e) { P.r[e + 1] = rp[(size_t)e * RWP]; P.k[e + 1] = rp[(size_t)e * RWP + 1024]; P.v[e + 1] = rp[(size_t)e * RWP + 2048];
        const int o = (h * 64 + 8 * wid + e) * 64 + lane;
        P.lw[e] = *(const float*)(A.act + ACT_LOGW + o * 4); P.ar[e] = *(const float*)(A.act + ACT_AR + o * 4); P.g[e] = *(const bf16*)(A.act + ACT_G + o * 2); P.vg[e] = *(const bf16*)(A.act + ACT_VG + o * 2);
        P.vf[e] = A.layer > 0 ? A.vfirst[(size_t)(tf + e) * 1024 + ch] : (unsigned short)0; }
}

__device__ __forceinline__ void stage1_unit(LAS unsigned char* lds, const S1Args& A, int c, int h, PreF& P) {
    const int tid = opq_tid(), lane = tid & 63, wid = __builtin_amdgcn_readfirstlane(tid >> 6), rq = lane >> 4, l15 = lane & 15;
    const int t0 = c * 64, uc = h * 256 + c;
    const int b0 = wid >> 1;
    LAS float* SEG = (LAS float*)(lds + O_SEG); LAS float* GL = (LAS float*)(lds + O_GL);
    for (int i = tid; i < 2 * MATB / 16; i += 512) *(LAS u32x4*)(lds + O_WT + i * 16) = (u32x4){0u, 0u, 0u, 0u};
    {
        const int j = lane, ch = h * 64 + j; float lw[8], cum[8], va[8], vb[8], vk[8], vr_[8], vv[8];
        const float mur = P.mur, muk = P.muk, muv = P.muv, kkw = P.kkw, kaw = P.kaw, rkw = P.rkw;
        const int tf = t0 + 8 * wid;
#pragma unroll
        for (int e = 0; e < 8; ++e) {
            const float cr = bf2f(P.r[e + 1]), ck = bf2f(P.k[e + 1]), cv = bf2f(P.v[e + 1]), pr = bf2f(P.r[e]), pk_ = bf2f(P.k[e]), pv = bf2f(P.v[e]);
            const float r = cr + mur * (pr - cr), kr = ck + muk * (pk_ - ck), vr = cv + muv * (pv - cv);
            lw[e] = P.lw[e];
            const float ar = P.ar[e], g = bf2f(P.g[e]), vg = bf2f(P.vg[e]);
            const float kkv = kr * kkw, ss = wave_sum(kkv * kkv), kk = kkv * __builtin_amdgcn_rsqf(fmaxf(ss, 1e-24f));
            va[e] = -kk; vb[e] = kk * ar; vk[e] = kr * (1.0f + (ar - 1.0f) * kaw); vr_[e] = r;
            const size_t go = (size_t)(tf + e) * 1024 + ch;
            float v;
            if (A.layer == 0) { v = vr; A.vfirst[go] = (bf16)f2bf(vr); } else { v = vr + (bf2f(P.vf[e]) - vr) * vg; }
            vv[e] = v;
            const float bonus = wave_sum(r * vk[e] * rkw);
            A.BV[go] = (bf16)f2bf(bonus * v); A.GB[go] = (bf16)f2bf(g);
        }
        cum[0] = lw[0];
#pragma unroll
        for (int e = 1; e < 8; ++e) cum[e] = cum[e - 1] + lw[e];
        SEG[wid * 64 + j] = cum[7];
        RK_BAR();
        float off = 0.f, tot = 0.f;
#pragma unroll
        for (int s = 0; s < 8; ++s) { const float v = SEG[s * 64 + j]; off += (s < wid) ? v : 0.f; tot += v; }
        if (wid == 0) GL[j] = __expf(tot);
        float gprev = __expf(off);
#pragma unroll
        for (int e = 0; e < 8; ++e) {
            const float cm = cum[e] + off, g = __expf(cm), gi = frcp(g), gp = gprev; gprev = g;
            const int o = ((8 * wid + e) * ST + j) * 2;
            *(LAS unsigned short*)(lds + O_AT + o) = (unsigned short)f2bf(va[e] * gp);
            *(LAS unsigned short*)(lds + O_BT + o) = (unsigned short)f2bf(vb[e] * gi);
            *(LAS unsigned short*)(lds + O_KT + o) = (unsigned short)f2bf(vk[e] * gi);
            *(LAS unsigned short*)(lds + O_RT + o) = (unsigned short)f2bf(vr_[e] * g);
            *(LAS unsigned short*)(lds + O_VV + o) = (unsigned short)f2bf(vv[e]);
        }
        RK_BAR();
    }
    {
        const bf16x8 bA0 = frag(lds + O_BT, 16 * b0, 0, lane), bA1 = frag(lds + O_BT, 16 * b0, 1, lane), kA0 = frag(lds + O_KT, 16 * b0, 0, lane), kA1 = frag(lds + O_KT, 16 * b0, 1, lane);
#pragma unroll
        for (int tt = 0; tt < 2; ++tt) {
            const int tb = 2 * (wid & 1) + tt;
            const bf16x8 aB0 = frag(lds + O_AT, 16 * tb, 0, lane), aB1 = frag(lds + O_AT, 16 * tb, 1, lane), rB0 = frag(lds + O_RT, 16 * tb, 0, lane), rB1 = frag(lds + O_RT, 16 * tb, 1, lane);
            const f32x4 z = {0.f, 0.f, 0.f, 0.f};
            f32x4 ab = mfma16(bA1, aB1, mfma16(bA0, aB0, z)), ak = mfma16(kA1, aB1, mfma16(kA0, aB0, z)), rb = mfma16(bA1, rB1, mfma16(bA0, rB0, z)), rk_ = mfma16(kA1, rB1, mfma16(kA0, rB0, z));
            const int tcol = 16 * tb + l15, srow = 16 * b0 + 4 * rq;
#pragma unroll
            for (int e = 0; e < 4; ++e) { const bool st = tcol > srow + e, le = tcol >= srow + e; ab[e] = st ? ab[e] : 0.f; ak[e] = st ? ak[e] : 0.f; rb[e] = le ? rb[e] : 0.f; rk_[e] = le ? rk_[e] : 0.f; }
            *(LAS f32x4*)(lds + O_NN + (tcol * NST + srow) * 4) = ab;
            const int o = (tcol * ST + srow) * 2;
            *(LAS u32x2*)(lds + O_NB16 + o) = (u32x2){pk(ab[0], ab[1]), pk(ab[2], ab[3])};
            *(LAS u32x2*)(lds + O_AAK + o) = (u32x2){pk(ak[0], ak[1]), pk(ak[2], ak[3])};
            *(LAS u32x2*)(lds + O_ARB + o) = (u32x2){pk(rb[0], rb[1]), pk(rb[2], rb[3])};
            *(LAS u32x2*)(lds + O_ARK + o) = (u32x2){pk(rk_[0], rk_[1]), pk(rk_[2], rk_[3])};
        }
        RK_BAR();
    }
    {
        const bf16x8 vA0 = tfrag(lds + O_VV, 16 * b0, 0, lane), vA1 = tfrag(lds + O_VV, 16 * b0, 1, lane);
#pragma unroll
        for (int tt = 0; tt < 2; ++tt) {
            const int tb = 2 * (wid & 1) + tt;
            const f32x4 z = {0.f, 0.f, 0.f, 0.f};
            const f32x4 g = mfma16(vA1, frag(lds + O_AAK, 16 * tb, 1, lane), mfma16(vA0, frag(lds + O_AAK, 16 * tb, 0, lane), z));
            *(LAS f32x4*)(lds + O_GG + ((16 * tb + l15) * NST + 16 * b0 + 4 * rq) * 4) = g;
        }
        RK_BAR();
    }
#pragma unroll 1
    for (int b = 0; b < 4; ++b) {
        if (b > 0) {
            const bf16x8 a0 = frag(lds + O_NB16, 16 * b, 0, lane), a1 = frag(lds + O_NB16, 16 * b, 1, lane);
            LAS unsigned char* xt = lds + (wid < 4 ? O_WT : O_U0T);
            const bf16x8 x0 = frag(xt, 16 * (wid & 3), 0, lane), x1 = frag(xt, 16 * (wid & 3), 1, lane);
            const f32x4 z = {0.f, 0.f, 0.f, 0.f};
            const f32x4 d = mfma16(a1, x1, mfma16(a0, x0, z));
#pragma unroll
            for (int e = 0; e < 4; ++e) *(LAS float*)(lds + O_CB + ((4 * rq + e) * CBS + 16 * wid + l15) * 4) = d[e];
            RK_BAR();
        }
        if (wid == 0) {
            f32x2 x[16];
            LAS unsigned char* rb_ = lds + (16 * b) * ST * 2 + lane * 2; LAS unsigned char* gb_ = lds + O_GG + ((16 * b) * NST + lane) * 4;
#pragma unroll
            for (int i = 0; i < 16; ++i) x[i] = (f32x2){bf2f(*(const LAS unsigned short*)(rb_ + O_AT + i * ST * 2)), *(const LAS float*)(gb_ + i * NST * 4)};
            if (b > 0) {
#pragma unroll
                for (int i = 0; i < 16; ++i) { x[i].x += *(const LAS float*)(lds + O_CB + (i * CBS + lane) * 4); x[i].y += *(const LAS float*)(lds + O_CB + (i * CBS + 64 + lane) * 4); }
            }
            LAS unsigned char* nn = lds + O_NN + ((16 * b) * NST + 16 * b) * 4; asm volatile("" : "+v"(nn));
            f32x4 qa[4], qc[4];
#define RK_DLOAD(buf, i_) do { _Pragma("unroll") for (int q = 0; q < 4; ++q) if (4 * q < (i_)) buf[q] = *(const LAS f32x4*)(nn + ((i_) * NST + 4 * q) * 4); } while (0)
#define RK_DROW(buf, i_) do { f32x2 acc = x[(i_)]; _Pragma("unroll") for (int q = 0; q < 4; ++q) { _Pragma("unroll") for (int e = 0; e < 4; ++e) if (4 * q + e < (i_)) acc = __builtin_elementwise_fma((f32x2){buf[q][e], buf[q][e]}, x[4 * q + e], acc); } \
                x[(i_)] = acc; asm volatile("" : "+v"(x[(i_)]) :: "memory"); __builtin_amdgcn_sched_barrier(0); } while (0)
            RK_DLOAD(qa, 1);
#pragma unroll
            for (int i = 1; i < 16; i += 2) {
                if (i + 1 < 16) RK_DLOAD(qc, i + 1);
                asm volatile("" ::: "memory"); __builtin_amdgcn_sched_barrier(0);
                RK_DROW(qa, i);
                if (i + 2 < 16) RK_DLOAD(qa, i + 2);
                asm volatile("" ::: "memory"); __builtin_amdgcn_sched_barrier(0);
                if (i + 1 < 16) RK_DROW(qc, i + 1);
            }
#undef RK_DLOAD
#undef RK_DROW
            LAS unsigned char* dw = lds + O_WT + lane * ST * 2 + 32 * b; LAS unsigned char* du = lds + O_U0T + lane * ST * 2 + 32 * b;
#pragma unroll
            for (int i = 0; i < 2; ++i) {
                *(LAS u32x4*)(dw + i * 16) = (u32x4){pk(x[8 * i].x, x[8 * i + 1].x), pk(x[8 * i + 2].x, x[8 * i + 3].x), pk(x[8 * i + 4].x, x[8 * i + 5].x), pk(x[8 * i + 6].x, x[8 * i + 7].x)};
                *(LAS u32x4*)(du + i * 16) = (u32x4){pk(x[8 * i].y, x[8 * i + 1].y), pk(x[8 * i + 2].y, x[8 * i + 3].y), pk(x[8 * i + 4].y, x[8 * i + 5].y), pk(x[8 * i + 6].y, x[8 * i + 7].y)}; }
        }
        if (b < 3) RK_BAR();
    }
    if (h + 1 < 16) { const int tid2 = opq_tid(); pref_load(P, A, c, h + 1, __builtin_amdgcn_readfirstlane(tid2 >> 6), tid2 & 63); }
    RK_BAR();
    {
        const int tid = opq_tid(), lane = tid & 63, wid = __builtin_amdgcn_readfirstlane(tid >> 6), rq = lane >> 4, l15 = lane & 15, b0 = wid >> 1;
        const bf16x8 wA0 = frag(lds + O_WT, 16 * b0, 0, lane), wA1 = frag(lds + O_WT, 16 * b0, 1, lane);
        const bf16x8 uA0 = frag(lds + O_U0T, 16 * b0, 0, lane), uA1 = frag(lds + O_U0T, 16 * b0, 1, lane);
        const bf16x8 vA0 = tfrag(lds + O_VV, 16 * b0, 0, lane), vA1 = tfrag(lds + O_VV, 16 * b0, 1, lane);
        const bf16x8 bA0 = tfrag(lds + O_BT, 16 * b0, 0, lane), bA1 = tfrag(lds + O_BT, 16 * b0, 1, lane);
        const bf16x8 kA0 = tfrag(lds + O_KT, 16 * b0, 0, lane), kA1 = tfrag(lds + O_KT, 16 * b0, 1, lane);
        const f32x4 glr = *(const LAS f32x4*)(lds + O_GL + (16 * b0 + 4 * rq) * 4);
#pragma unroll
        for (int tt = 0; tt < 2; ++tt) {
            const int nb = 2 * (wid & 1) + tt, col = 16 * nb + l15, row = 16 * b0 + 4 * rq;
            const f32x4 z = {0.f, 0.f, 0.f, 0.f};
            const bf16x8 rbB0 = frag(lds + O_ARB, 16 * nb, 0, lane), rbB1 = frag(lds + O_ARB, 16 * nb, 1, lane), rkB0 = frag(lds + O_ARK, 16 * nb, 0, lane), rkB1 = frag(lds + O_ARK, 16 * nb, 1, lane);
            { f32x4 d = mfma16(wA1, rbB1, mfma16(wA0, rbB0, z)); const u32x2 rt = *(const LAS u32x2*)(lds + O_RT + (col * ST + row) * 2);
              d[0] += bflo(rt.x); d[1] += bfhi(rt.x); d[2] += bflo(rt.y); d[3] += bfhi(rt.y);
              *(u32x2*)(A.RP + (size_t)(t0 + col) * 1024 + h * 64 + row) = (u32x2){pk(d[0], d[1]), pk(d[2], d[3])}; }
            { const f32x4 d = mfma16(vA1, rkB1, mfma16(vA0, rkB0, mfma16(uA1, rbB1, mfma16(uA0, rbB0, z))));
              *(f32x4*)(A.Y0 + (size_t)(t0 + col) * 1024 + h * 64 + row) = d; }
            { const bf16x8 bB0 = tfrag(lds + O_BT, 16 * nb, 0, lane), bB1 = tfrag(lds + O_BT, 16 * nb, 1, lane);
              f32x4 d = mfma16(wA1, bB1, mfma16(wA0, bB0, z)); const float gj = GL[col];
#pragma unroll
              for (int e = 0; e < 4; ++e) d[e] = gj * (d[e] + ((row + e) == col ? 1.f : 0.f));
              *(u32x2*)(A.PG + (size_t)uc * 4096 + ((((col >> 4) * 2 + (row >> 5)) * 64 + ((row >> 2) & 3) * 16 + (col & 15)) * 8 + ((row >> 4) & 1) * 4)) = (u32x2){pk(d[0], d[1]), pk(d[2], d[3])}; }
            { const bf16x8 uB0 = frag(lds + O_U0T, 16 * nb, 0, lane), uB1 = frag(lds + O_U0T, 16 * nb, 1, lane), vB0 = tfrag(lds + O_VV, 16 * nb, 0, lane), vB1 = tfrag(lds + O_VV, 16 * nb, 1, lane);
              f32x4 d = mfma16(kA1, vB1, mfma16(kA0, vB0, mfma16(bA1, uB1, mfma16(bA0, uB0, z))));
              d = d * glr;
              *(f32x4*)(A.QT + (size_t)uc * 4096 + ((((col >> 4) * 4 + (row >> 4)) * 64 + ((row >> 2) & 3) * 16 + (col & 15)) * 4)) = d; }
        }
    }
    RK_BAR();
}
__device__ __forceinline__ void ph_stage1(LAS unsigned char* lds, const S1Args& A, int blk, int nblk) {
    for (int c = blk; c < 256; c += nblk) {
        stage1_latents(lds, A, c * 64);
        RK_BAR();
        stage1_lora_all(lds, A);
        asm volatile("s_waitcnt vmcnt(0)" ::: "memory");
        RK_BAR();
        PreF P; { const int tid = opq_tid(); pref_load(P, A, c, 0, __builtin_amdgcn_readfirstlane(tid >> 6), tid & 63); }
#pragma unroll 1
        for (int h = 0; h < 16; ++h) stage1_unit(lds, A, c, h, P);
    }
}

struct ChainOps { bf16x8 a[4][2]; f32x4 c[4]; };
__device__ __forceinline__ void chain_load(ChainOps& o, const bf16* __restrict__ PG, const float* __restrict__ QT, int h, int ig, int c, int lane) {
    const bf16* P = PG + (size_t)(h * 256 + c) * 4096 + lane * 8; const float* Q = QT + (size_t)(h * 256 + c) * 4096 + (ig * 4 * 64 + lane) * 4;
#pragma unroll
    for (int m = 0; m < 4; ++m) { o.c[m] = *(const f32x4*)(Q + m * 256);
#pragma unroll
        for (int kb = 0; kb < 2; ++kb) o.a[m][kb] = *(const bf16x8*)(P + (m * 2 + kb) * 512); }
}
__device__ __forceinline__ void chain_step(f32x4 (&H)[4], const ChainOps& o, bf16* __restrict__ H0T, int h, int ig, int c, int lane) {
    const int fr = lane & 15, fq = lane >> 4;
    bf16* Ho = H0T + (size_t)(c * 16 + h) * 4096 + (16 * ig + fr) * 64 + 4 * fq;
    u32x4 bw[2];
#pragma unroll
    for (int m = 0; m < 4; ++m) { const u32x2 w = {pk(H[m][0], H[m][1]), pk(H[m][2], H[m][3])}; *(u32x2*)(Ho + 16 * m) = w; bw[m >> 1][2 * (m & 1)] = w.x; bw[m >> 1][2 * (m & 1) + 1] = w.y; }
#pragma unroll
    for (int m = 0; m < 4; ++m) H[m] = mfma16(o.a[m][1], __builtin_bit_cast(bf16x8, bw[1]), mfma16(o.a[m][0], __builtin_bit_cast(bf16x8, bw[0]), o.c[m]));
}
__device__ __forceinline__ void chain_wave(const bf16* __restrict__ PG, const float* __restrict__ QT, bf16* __restrict__ H0T, int h, int ig, int lane) {
    f32x4 H[4];
#pragma unroll
    for (int m = 0; m < 4; ++m) H[m] = (f32x4){0.f, 0.f, 0.f, 0.f};
    ChainOps s0, s1, s2, s3;
    chain_load(s0, PG, QT, h, ig, 0, lane); chain_load(s1, PG, QT, h, ig, 1, lane); chain_load(s2, PG, QT, h, ig, 2, lane); chain_load(s3, PG, QT, h, ig, 3, lane);
#pragma unroll 1
    for (int c = 0; c < 256; c += 4) {
        const bool more = c + 4 < 256;
        chain_step(H, s0, H0T, h, ig, c, lane);     if (more) chain_load(s0, PG, QT, h, ig, c + 4, lane);
        chain_step(H, s1, H0T, h, ig, c + 1, lane); if (more) chain_load(s1, PG, QT, h, ig, c + 5, lane);
        chain_step(H, s2, H0T, h, ig, c + 2, lane); if (more) chain_load(s2, PG, QT, h, ig, c + 6, lane);
        chain_step(H, s3, H0T, h, ig, c + 3, lane); if (more) chain_load(s3, PG, QT, h, ig, c + 7, lane);
    }
}
constexpr int CHW = 4;
__device__ __forceinline__ void ph_chain(const bf16* PG, const float* QT, bf16* H0T, int blk, int nblk) {
    const int tid = opq_tid(), lane = tid & 63;
    if ((tid >> 6) < CHW)
        for (int gw = blk * CHW + (tid >> 6); gw < 64; gw += nblk * CHW) chain_wave(PG, QT, H0T, gw >> 2, gw & 3, lane);
}

struct S3Args { const bf16* H0T; const bf16* RP; const float* Y0; const bf16* BV; const bf16* GB; const float* ln_w; const float* ln_b; bf16* mixed; };
__device__ __forceinline__ void ph_stage3(const S3Args& A, int blk, int nblk) {
    const int tid = opq_tid(), lane = tid & 63, fr = lane & 15, fq = lane >> 4;
    for (int it = blk * 8 + (tid >> 6); it < 4096 * 4; it += nblk * 8) {
        const int u = it >> 2, tb = it & 3, c = u >> 4, h = u & 15, t = 64 * c + 16 * tb + fr;
        const bf16* Hp = A.H0T + (size_t)u * 4096 + fr * 64 + 8 * fq; const bf16* Rp = A.RP + (size_t)t * 1024 + h * 64 + 8 * fq;
        const bf16x8 r0 = *(const bf16x8*)Rp, r1 = *(const bf16x8*)(Rp + 32);
        f32x4 y[4];
#pragma unroll
        for (int ib = 0; ib < 4; ++ib) { const f32x4 y0 = *(const f32x4*)(A.Y0 + (size_t)t * 1024 + h * 64 + 16 * ib + 4 * fq);
            y[ib] = mfma16(*(const bf16x8*)(Hp + ib * 1024 + 32), r1, mfma16(*(const bf16x8*)(Hp + ib * 1024), r0, y0)); }
        float s = 0.f;
#pragma unroll
        for (int ib = 0; ib < 4; ++ib) s += (y[ib][0] + y[ib][1]) + (y[ib][2] + y[ib][3]);
        s += __shfl_xor(s, 16); s += __shfl_xor(s, 32);
        const float mean = s * (1.0f / 64.0f); float q = 0.f;
#pragma unroll
        for (int ib = 0; ib < 4; ++ib)
#pragma unroll
            for (int e = 0; e < 4; ++e) { const float d = y[ib][e] - mean; y[ib][e] = d; q += d * d; }
        q += __shfl_xor(q, 16); q += __shfl_xor(q, 32);
        const float rstd = 1.0f / sqrtf(q * (1.0f / 64.0f) + GN_EPS);
#pragma unroll
        for (int ib = 0; ib < 4; ++ib) { const int ch = h * 64 + 16 * ib + 4 * fq; const size_t o = (size_t)t * 1024 + ch;
            const f32x4 lw = *(const f32x4*)(A.ln_w + ch), lb = *(const f32x4*)(A.ln_b + ch); const u32x2 bv = *(const u32x2*)(A.BV + o), gg = *(const u32x2*)(A.GB + o); f32x4 r;
            const float bvf[4] = {bflo(bv.x), bfhi(bv.x), bflo(bv.y), bfhi(bv.y)}, ggf[4] = {bflo(gg.x), bfhi(gg.x), bflo(gg.y), bfhi(gg.y)};
#pragma unroll
            for (int e = 0; e < 4; ++e) r[e] = (y[ib][e] * rstd * lw[e] + lb[e] + bvf[e]) * ggf[e];
            *(u32x2*)(A.mixed + (size_t)t * DM + 1024 + ch) = (u32x2){pk(r[0], r[1]), pk(r[2], r[3])}; }
    }
}
}
#define XB_TMO      128
#define XB_XCNT(j)  (256  + 64 * (j))
#define XB_XSUB(j)  (1280 + 64 * (j))
#define XB_XGEN(j)  (2304 + 64 * (j))
#define XB_TOP      3328
#define XB_TOPGEN   3392
#define XCD_BAR_WORDS 3456
#define XB_SPIN_CAP (1u << 22)

__device__ __forceinline__ unsigned xb_ld(unsigned* p)              { return __hip_atomic_load(p, __ATOMIC_RELAXED, __HIP_MEMORY_SCOPE_AGENT); }
__device__ __forceinline__ unsigned xb_add(unsigned* p, unsigned v) { return __hip_atomic_fetch_add(p, v, __ATOMIC_RELAXED, __HIP_MEMORY_SCOPE_AGENT); }
__device__ __forceinline__ unsigned xb_xcc_id() { return (unsigned)__builtin_amdgcn_s_getreg((3 << 11) | 20) & 0xFu; }
#define XB_SPIN(cond, bar) do { unsigned _sp = 0; while (cond) { __builtin_amdgcn_s_sleep(1); \
    if ((++_sp & 255u) == 0u) { if (xb_ld(&(bar)[XB_TMO])) break; if (_sp > XB_SPIN_CAP) { atomicAdd(&(bar)[XB_TMO], 1u); break; } } } } while (0)

struct XcdBarrier {
    unsigned* bar; unsigned x;
    volatile LAS unsigned* st;
};

__device__ __forceinline__ XcdBarrier xcd_barrier_post(unsigned* bar, volatile LAS unsigned* st) {
    XcdBarrier b; b.bar = bar; b.x = xb_xcc_id(); b.st = st;
    if (threadIdx.x == 0) (void)xb_add(&bar[XB_XCNT(b.x)], 1u);
    return b;
}
__device__ __forceinline__ void xcd_barrier_complete(unsigned* bar, unsigned x, unsigned& nloc, unsigned& nx) {
    const unsigned G = gridDim.x * gridDim.y * gridDim.z;
    unsigned sum, cnt, mine, sp = 0u;
    for (;;) {
        sum = 0u; cnt = 0u; mine = 0u;
#pragma unroll
        for (unsigned j = 0; j < 16; ++j) { const unsigned c = xb_ld(&bar[XB_XCNT(j)]); sum += c; cnt += (c > 0u) ? 1u : 0u; mine = (j == x) ? c : mine; }
        if (sum == G) break;
        __builtin_amdgcn_s_sleep(1);
        if ((++sp & 255u) == 0u) { if (xb_ld(&bar[XB_TMO])) break; if (sp > XB_SPIN_CAP) { atomicAdd(&bar[XB_TMO], 1u); break; } }
    }
    nloc = mine > 0u ? mine : 1u; nx = cnt > 0u ? cnt : 1u;
}

__device__ __forceinline__ void xcd_barrier(const XcdBarrier& b) {
    asm volatile("s_waitcnt vmcnt(0)" ::: "memory");
    __syncthreads();
    if (threadIdx.x == 0) {
        unsigned* bar = b.bar;
        __builtin_amdgcn_s_waitcnt(0);
        unsigned nloc = b.st[0], nx = b.st[1];
        if (nloc == 0u) { xcd_barrier_complete(bar, b.x, nloc, nx); b.st[0] = nloc; b.st[1] = nx; }
        const unsigned old = xb_add(&bar[XB_XSUB(b.x)], 1u);
        const unsigned gen = old / nloc;
        if (old + 1u == (gen + 1u) * nloc) {
            __builtin_amdgcn_fence(__ATOMIC_RELEASE, "agent");
            asm volatile("s_waitcnt vmcnt(0)" ::: "memory");
            const unsigned og = xb_add(&bar[XB_TOP], 1u);
            const unsigned tg = og / nx;
            if (og + 1u == (tg + 1u) * nx) xb_add(&bar[XB_TOPGEN], 1u);
            else XB_SPIN(xb_ld(&bar[XB_TOPGEN]) == tg, bar);
            __builtin_amdgcn_fence(__ATOMIC_ACQUIRE, "agent");
            xb_add(&bar[XB_XGEN(b.x)], 1u);
            asm volatile("s_waitcnt vmcnt(0)" ::: "memory");
        } else {
            XB_SPIN(xb_ld(&bar[XB_XGEN(b.x)]) == gen, bar);
            __builtin_amdgcn_fence(__ATOMIC_ACQUIRE, "agent");
            asm volatile("s_waitcnt vmcnt(0)" ::: "memory");
        }
    }
    __syncthreads();
}

constexpr size_t MiB = 1u << 20;
constexpr size_t WS_CTL = 0, CTL_ZERO_BYTES = 64 * 1024, WS_SSQA = 1016 * MiB, WS_SSQB = 1018 * MiB,      WS_WIN = 2 * MiB, WS_WOUT = 28 * MiB, WS_WUP = 36 * MiB, WS_WDOWN = 68 * MiB, WS_LORA = 100 * MiB, WS_XB = 102 * MiB,
                 WS_Q = 166 * MiB, WS_K = 198 * MiB, WS_V = 230 * MiB, WS_RW = 262 * MiB, WS_MIXED = 374 * MiB, WS_U = 166 * MiB, WS_VFIRST = 438 * MiB, WS_PG = 470 * MiB, WS_QT = 502 * MiB, WS_RP = 566 * MiB,
                 WS_Y0 = 598 * MiB, WS_H0T = 662 * MiB, WS_BV = 694 * MiB, WS_GB = 726 * MiB, WS_STASH = 758 * MiB, WS_PART = 790 * MiB, WS_END = 1020 * MiB;
constexpr size_t LORA_W2 = 0, LORA_A2 = 1024 * 64 * 2, LORA_G2 = 2 * 1024 * 64 * 2, LORA_V2 = LORA_G2 + 1024 * 160 * 2;
constexpr int CW_BAR = 1024, CW_ATTQ = 512;
constexpr int RING_BYTES = 131072, MISC_OFF = 156000, LDS_BYTES = 156672;

struct Args { const float* in[26]; float* out; unsigned char* ws; int ph_lo, ph_hi; float lam_init[4]; };

struct ConvItem { const float* src; bf16* dst; const float* g; int K, N, k0, c0; bool permin, skipx; };
__device__ __forceinline__ void conv_item(ConvItem& I, const __attribute__((address_space(4))) Args* a, unsigned char* ws, int l, int it) {
    constexpr int I_IN = (DM / 64) * (NIN / 64), I_OUT = (DM / 64) * (DM / 64), I_UP = (DM / 64) * (DFF / 64);
    int r = it, nkbs;
    if (r < I_IN) { I.src = a->in[3] + (size_t)l * DM * PW; I.dst = (bf16*)(ws + WS_WIN); I.g = a->in[1] + (size_t)l * DM; I.K = DM; I.N = PW; nkbs = 5; I.permin = true; I.skipx = l > 0; }
    else if ((r -= I_IN) < I_OUT) { I.src = a->in[4] + (size_t)l * DM * DM; I.dst = (bf16*)(ws + WS_WOUT); I.g = nullptr; I.K = DM; I.N = DM; nkbs = 5; I.permin = false; I.skipx = false; }
    else if ((r -= I_OUT) < I_UP) { I.src = a->in[24] + (size_t)l * DM * DFF; I.dst = (bf16*)(ws + WS_WUP); I.g = a->in[2] + (size_t)l * DM; I.K = DM; I.N = DFF; nkbs = 5; I.permin = false; I.skipx = false; }
    else { r -= I_UP; I.src = a->in[25] + (size_t)l * DFF * DM; I.dst = (bf16*)(ws + WS_WDOWN); I.g = nullptr; I.K = DFF; I.N = DM; nkbs = 7; I.permin = false; I.skipx = false; }
    I.k0 = (r & ((1 << nkbs) - 1)) * 64; I.c0 = (r >> nkbs) * 64;
}
__device__ __forceinline__ void conv_load(const ConvItem& I, float (&v)[8], float (&gv)[8], int tid) {
#pragma unroll
    for (int i = 0; i < 8; ++i) { const int idx = tid + 512 * i, kk = idx >> 6, cc = idx & 63, cp = I.c0 + cc; int col = cp;
        if (I.permin) { const int lo = cp & 255, bj = lo >> 7, wc = (lo >> 5) & 3, j = lo & 31; col = (cp & ~255) + 64 * wc + 32 * bj + j; }
        const bool ok = col < I.N;
        v[i] = ok ? I.src[(size_t)(I.k0 + kk) * I.N + col] : 0.f; gv[i] = I.g ? I.g[I.k0 + kk] : 1.0f; }
}
__device__ __forceinline__ void ph_convw(LAS unsigned char* lds, const __attribute__((address_space(4))) Args* a, int l, int blk, int nblk) {
    LAS float* tile = (LAS float*)lds; unsigned char* ws = a->ws; const int tid = opq_tid();
    constexpr int NITEM = (DM / 64) * (NIN / 64) + (DM / 64) * (DM / 64) + (DM / 64) * (DFF / 64) + (DFF / 64) * (DM / 64);
    ConvItem I0, I1, I2; float v0[8], v1[8], v2[8], g0[8], g1[8], g2[8];
    int it = blk;
    if (it < NITEM) { conv_item(I0, a, ws, l, it); conv_load(I0, v0, g0, tid); }
    if (it + nblk < NITEM) { conv_item(I1, a, ws, l, it + nblk); conv_load(I1, v1, g1, tid); }
    int par = 0;
#define CONV_STEP(IC, VC, GC, IN_, VN_, GN_) do { \
        LAS float* tl = tile + par * (64 * 65); par ^= 1; \
        _Pragma("unroll") for (int i = 0; i < 8; ++i) { const int idx = tid + 512 * i; tl[(idx >> 6) * 65 + (idx & 63)] = VC[i] * GC[i]; } \
        if (it + 2 * nblk < NITEM) { conv_item(IN_, a, ws, l, it + 2 * nblk); conv_load(IN_, VN_, GN_, tid); } \
        __syncthreads(); \
        { const int cc = tid >> 3, k8 = (tid & 7) * 8, cp = IC.c0 + cc; \
          if (!(IC.permin && IC.skipx && ((cp >= 6432 && cp < 6464) || (cp >= 6528 && cp < 6560)))) {        \
              u32x4 w; \
              _Pragma("unroll") for (int e = 0; e < 4; ++e) w[e] = f2bf(tl[(k8 + 2 * e) * 65 + cc]) | (f2bf(tl[(k8 + 2 * e + 1) * 65 + cc]) << 16); \
              *(u32x4*)(IC.dst + (size_t)cp * IC.K + IC.k0 + k8) = w; } } \
        it += nblk; } while (0)
    while (it < NITEM) {
        CONV_STEP(I0, v0, g0, I2, v2, g2); if (it >= NITEM) break;
        CONV_STEP(I1, v1, g1, I0, v0, g0); if (it >= NITEM) break;
        CONV_STEP(I2, v2, g2, I1, v1, g1);
    }
#undef CONV_STEP
    __syncthreads();
    { const int tid = opq_tid(); const int lm = l > 0 ? l - 1 : 0;
      const float* w2 = a->in[12] + (size_t)l * 64 * 1024; const float* a2 = a->in[14] + (size_t)l * 64 * 1024; const float* g2 = a->in[15] + (size_t)l * 160 * 1024; const float* v2 = a->in[23] + (size_t)lm * 32 * 1024;
      bf16* lw = (bf16*)(ws + WS_LORA);
      for (int i = blk * 512 + tid; i < 1024 * 320; i += nblk * 512) {
          const int ch = i / 320, k = i % 320;
          if (k < 64) lw[LORA_W2 / 2 + ch * 64 + k] = (bf16)f2bf(w2[(size_t)k * 1024 + ch]);
          else if (k < 128) lw[LORA_A2 / 2 + ch * 64 + k - 64] = (bf16)f2bf(a2[(size_t)(k - 64) * 1024 + ch]);
          else if (k < 288) lw[LORA_G2 / 2 + ch * 160 + k - 128] = (bf16)f2bf(g2[(size_t)(k - 128) * 1024 + ch]);
          else lw[LORA_V2 / 2 + ch * 32 + k - 288] = (bf16)f2bf(v2[(size_t)(k - 288) * 1024 + ch]);
      } }
    if (l > 0) {
        const int tid = opq_tid(), sl = tid >> 6, o = tid & 63;
        const float* win = a->in[3] + (size_t)l * DM * PW; const float* g1 = a->in[1] + (size_t)l * DM; const float* muv = a->in[10] + (size_t)l * 3360 + 2048; const float* v1 = a->in[22] + (size_t)(l - 1) * 1024 * 32;
        bf16* wt = (bf16*)(ws + WS_WIN);
        LAS float* wrow = (LAS float*)lds;
        LAS float* part = wrow + 8 * 1024;
        for (int k0 = blk * 8; k0 < DM; k0 += nblk * 8) {
            for (int i = tid; i < 8 * 1024; i += 512) wrow[i] = win[(size_t)(k0 + (i >> 10)) * PW + 5120 + (i & 1023)];
            __syncthreads();
            float acc[8];
#pragma unroll
            for (int r = 0; r < 8; ++r) acc[r] = 0.f;
#pragma unroll 8
            for (int ci = 0; ci < 128; ++ci) { const int c = sl * 128 + ci; const float m = muv[c], f = ((o < 32) ? 1.0f - m : m) * v1[c * 32 + (o & 31)];
#pragma unroll
                for (int r = 0; r < 8; ++r) acc[r] = __builtin_fmaf(wrow[r * 1024 + c], f, acc[r]); }
#pragma unroll
            for (int r = 0; r < 8; ++r) part[(sl * 8 + r) * 64 + o] = acc[r];
            __syncthreads();
            { const int r = sl; float s = 0.f;
#pragma unroll
              for (int q = 0; q < 8; ++q) s += part[(q * 8 + r) * 64 + o];
              const int row = (o < 32) ? 6528 + o : 6400 + o;
              wt[(size_t)row * DM + k0 + r] = (bf16)f2bf(s * g1[k0 + r]); }
            __syncthreads();
        }
    }
}
__device__ __forceinline__ void ph_copy_x(const float* __restrict__ src, float* __restrict__ copy, bf16* __restrict__ xb, float* __restrict__ ssq, int blk, int nblk) {
    const int tid_ = opq_tid(), lane = tid_ & 63, gw = blk * 8 + (tid_ >> 6), ngw = nblk * 8;
    for (int row = gw; row < T_; row += ngw) {
        const f32x4* s = (const f32x4*)(src + (size_t)row * DM);
        float ss = 0.f;
#pragma unroll
        for (int j = 0; j < 8; ++j) { const f32x4 v = s[lane + 64 * j]; ss += (v[0] * v[0] + v[1] * v[1]) + (v[2] * v[2] + v[3] * v[3]);
            u32x2 w; w.x = f2bf(v[0]) | (f2bf(v[1]) << 16); w.y = f2bf(v[2]) | (f2bf(v[3]) << 16);
            ((u32x2*)(xb + (size_t)row * DM))[lane + 64 * j] = w; }
        ss = wave_sum(ss);
        if (lane < 32) ssq[(size_t)row * 32 + lane] = lane == 0 ? ss : 0.f;
    }
}
__device__ __forceinline__ void ph_zero(float* p, int n, int blk, int nblk) { const int tid = opq_tid();
#pragma unroll
    for (int r = 0; r < 4; ++r) { const int i = (r * nblk + blk) * 512 + tid; if (i < n) __hip_atomic_store(p + i, 0.f, __ATOMIC_RELAXED, __HIP_MEMORY_SCOPE_AGENT); } }

#ifndef MK_PER_PHASE
#define MK_PER_PHASE 0
#endif
constexpr int NPH = 8;
#ifndef PROBE_PH
#define PROBE_PH -1
#endif
#ifndef PROBE_REP
#define PROBE_REP 1
#endif
#define REP(k) for (int rep_ = 0; rep_ < ((k) == PROBE_PH ? PROBE_REP : 1); ++rep_)
typedef const __attribute__((address_space(4))) Args* CArgs;
__device__ __forceinline__ CArgs kargs() { CArgs p = (CArgs)__builtin_amdgcn_kernarg_segment_ptr(); asm volatile("" : "+s"(p)); return p; }
__global__ void __launch_bounds__(512, 2) fwd(Args args_unused) {
    extern __shared__ __attribute__((aligned(16))) unsigned char lds_raw[];
    LAS unsigned char* lds = (LAS unsigned char*)lds_raw;
    volatile LAS unsigned* MISC = (volatile LAS unsigned*)(lds + MISC_OFF);
    const int blk = (int)blockIdx.x, nblk = (int)gridDim.x;
    if (threadIdx.x < 32) MISC[threadIdx.x] = 0u;
    __syncthreads();
    XcdBarrier bar;
#if MK_PER_PHASE
    int lo, hi;
    { CArgs ap = kargs(); lo = ap->ph_lo; hi = ap->ph_hi; unsigned* bw = (unsigned*)(ap->ws + WS_CTL) + CW_BAR; bar.bar = bw; bar.x = 0; bar.st = nullptr;
      if (hi - lo > 1) bar = xcd_barrier_post(bw, MISC + 8); }
#else
    { CArgs ap = kargs(); bar = xcd_barrier_post((unsigned*)(ap->ws + WS_CTL) + CW_BAR, MISC + 8); }
#endif
#if MK_PER_PHASE
#define IN(k) (lo <= (k) && (k) < hi)
#define SEAM(k) do { if (IN(k) && IN((k) + 1)) xcd_barrier(bar); } while (0)
#else
#define IN(k) true
#define SEAM(k) do { if ((k) + 1 < NL * NPH) xcd_barrier(bar); } while (0)
#endif
#define WSP(T, off) ((T*)(ws + (off)))
#pragma unroll 1
    for (int l = 0; l < NL; ++l) {
        const int pb = l * NPH;
        if (IN(pb + 0)) REP(0) {
            CArgs ap = kargs(); unsigned char* ws = ap->ws;
            ph_convw(lds, ap, l, blk, nblk);
            if (l == 0) ph_copy_x(ap->in[0], ap->out, WSP(bf16, WS_XB), WSP(float, WS_SSQA), blk, nblk);

        }
        SEAM(pb + 0);
        if (IN(pb + 1)) REP(1) {
            CArgs ap = kargs(); unsigned char* ws = ap->ws;
            pg8::Gemm g{WSP(bf16, WS_XB), WSP(bf16, WS_WIN), T_, NIN, DM, 0}; pg8::StaticOrder S; S.init(T_, NIN, nblk, blk);
            pg8::EpiIn E{WSP(float, WS_SSQA), WSP(bf16, WS_Q), WSP(bf16, WS_K), WSP(bf16, WS_V), WSP(bf16, WS_RW), ap->in[5] + l * 128, ap->in[6] + l * 128};
            pg8::gemm_phase<pg8::EpiIn, pg8::StaticOrder, true, true>(lds, g, S, E);
        }
        SEAM(pb + 1);
        if (IN(pb + 2)) REP(2) {
            CArgs ap = kargs(); unsigned char* ws = ap->ws; const int lm = l > 0 ? l - 1 : 0;
            rk::S1Args A; A.rw = WSP(bf16, WS_RW); A.mu = ap->in[10] + (size_t)l * 3360; A.w0 = ap->in[11] + l * 1024; A.a0 = ap->in[13] + l * 1024; A.v0 = ap->in[21] + lm * 1024; A.k_k = ap->in[16] + l * 1024; A.k_a = ap->in[17] + l * 1024;
            A.r_k = ap->in[18] + l * 1024; A.w2t = (const bf16*)(ws + WS_LORA + LORA_W2); A.a2t = (const bf16*)(ws + WS_LORA + LORA_A2); A.g2t = (const bf16*)(ws + WS_LORA + LORA_G2); A.v2t = (const bf16*)(ws + WS_LORA + LORA_V2);
            A.vfirst = WSP(bf16, WS_VFIRST); A.BV = WSP(bf16, WS_BV); A.GB = WSP(bf16, WS_GB); A.PG = WSP(bf16, WS_PG); A.QT = WSP(float, WS_QT); A.RP = WSP(bf16, WS_RP); A.Y0 = WSP(float, WS_Y0); A.act = ws + WS_PART + (size_t)blk * rk::ACT_WG_BYTES; A.layer = l; A.pad_ = 0;
            rk::ph_stage1(lds, A, blk, nblk);
        }
        SEAM(pb + 2);
        if (IN(pb + 3)) {
            CArgs ap = kargs(); unsigned char* ws = ap->ws;
            rk::ph_chain(WSP(bf16, WS_PG), WSP(float, WS_QT), WSP(bf16, WS_H0T), blk, nblk);
            att::Args A; A.Q = WSP(bf16, WS_Q); A.K = WSP(bf16, WS_K); A.V = WSP(bf16, WS_V); A.mixed = WSP(bf16, WS_MIXED); A.stash = WSP(float, WS_STASH); A.lq = ap->in[7] + l * 128; A.lk = ap->in[8] + l * 128; A.subln = ap->in[9] + l * 128; A.gq = ap->in[5] + l * 128; A.gk = ap->in[6] + l * 128;
            A.lam_init = ap->lam_init[l]; A.pad_ = 0;
            att::attn_phase(lds, A, blk, (unsigned*)(ws + WS_CTL) + CW_ATTQ + 64 * l, MISC + 16, WSP(float, WS_PART));
        }
        SEAM(pb + 3);
        if (IN(pb + 4)) REP(4) {
            CArgs ap = kargs(); unsigned char* ws = ap->ws;
            rk::S3Args A{WSP(bf16, WS_H0T), WSP(bf16, WS_RP), WSP(float, WS_Y0), WSP(bf16, WS_BV), WSP(bf16, WS_GB), ap->in[19] + l * 1024, ap->in[20] + l * 1024, WSP(bf16, WS_MIXED)};
            rk::ph_stage3(A, blk, nblk);
            att::Args B; B.Q = WSP(bf16, WS_Q); B.K = WSP(bf16, WS_K); B.V = WSP(bf16, WS_V); B.mixed = WSP(bf16, WS_MIXED); B.stash = WSP(float, WS_STASH); B.lq = ap->in[7] + l * 128; B.lk = ap->in[8] + l * 128; B.subln = ap->in[9] + l * 128;
            B.gq = ap->in[5] + l * 128; B.gk = ap->in[6] + l * 128; B.lam_init = ap->lam_init[l]; B.pad_ = 0;
            att::attn_combine(lds, B, blk, nblk, WSP(float, WS_PART));
        }
        SEAM(pb + 4);
        if (IN(pb + 5)) {
            CArgs ap = kargs(); unsigned char* ws = ap->ws;
            pg8::Gemm g{WSP(bf16, WS_MIXED), WSP(bf16, WS_WOUT), T_, DM, DM, 0}; pg8::StaticOrder S; S.init(T_, DM, nblk, blk);
            pg8::EpiRes E{WSP(bf16, WS_XB), WSP(float, WS_SSQB), nullptr, DM, 0};
            pg8::gemm_phase<pg8::EpiRes, pg8::StaticOrder, true, true>(lds, g, S, E);
        }
        SEAM(pb + 5);
        if (IN(pb + 6)) REP(6) {
            CArgs ap = kargs(); unsigned char* ws = ap->ws;
            pg8::Gemm g{WSP(bf16, WS_XB), WSP(bf16, WS_WUP), T_, DFF, DM, 0}; pg8::StaticOrder S; S.init(T_, DFF, nblk, blk);
            pg8::EpiUp E{WSP(float, WS_SSQB), WSP(bf16, WS_U), DFF, 0};
            pg8::gemm_phase<pg8::EpiUp, pg8::StaticOrder, true, true>(lds, g, S, E);
        }
        SEAM(pb + 6);
        if (IN(pb + 7)) {
            CArgs ap = kargs(); unsigned char* ws = ap->ws;
            pg8::Gemm g{WSP(bf16, WS_U), WSP(bf16, WS_WDOWN), T_, DM, DFF, 0}; pg8::StaticOrder S; S.init(T_, DM, nblk, blk);
            pg8::EpiRes E{WSP(bf16, WS_XB), WSP(float, WS_SSQA), l == NL - 1 ? ap->out : nullptr, DM, 0};
            pg8::gemm_phase<pg8::EpiRes, pg8::StaticOrder, true, true>(lds, g, S, E);
        }
        SEAM(pb + 7);
    }
#undef IN
#undef SEAM
#undef WSP
}

extern "C" void kernel_launch(void* const* d_in, const int* in_sizes, int n_in, void* d_out, int out_size, void* d_ws, size_t ws_size, hipStream_t stream) {
    static int grid = 0;
    if (grid == 0) {
        grid = -1;
        if (n_in != 26 || ws_size < WS_END || out_size != T_ * DM) { fprintf(stderr, "kernel_launch: unexpected shapes (n_in %d ws %zu out %d)\n", n_in, ws_size, out_size); return; }
        int dev = 0, cus = 0, per_cu = 0;
        if (hipGetDevice(&dev) != hipSuccess || hipDeviceGetAttribute(&cus, hipDeviceAttributeMultiprocessorCount, dev) != hipSuccess) return;
        if (hipFuncSetAttribute((const void*)fwd, hipFuncAttributeMaxDynamicSharedMemorySize, LDS_BYTES) != hipSuccess) return;
        if (hipOccupancyMaxActiveBlocksPerMultiprocessor(&per_cu, (const void*)fwd, 512, LDS_BYTES) != hipSuccess || per_cu < 1) { fprintf(stderr, "kernel_launch: occupancy query says %d\n", per_cu); (void)hipGetLastError(); return; }
        if (cus < 8) return;
        grid = cus;
    }
    if (grid < 0) return;
    if (hipMemsetAsync((char*)d_ws + WS_CTL, 0, CTL_ZERO_BYTES, stream) != hipSuccess) return;
    Args a;
    memset(&a, 0, sizeof(a));
    for (int i = 0; i < 26; ++i) a.in[i] = (const float*)d_in[i];
    a.out = (float*)d_out; a.ws = (unsigned char*)d_ws;
    for (int l = 0; l < NL; ++l) a.lam_init[l] = (float)(0.8 - 0.6 * exp(-0.3 * (double)l));
    const int nph = NL * NPH;
#if MK_PER_PHASE
    for (int p = 0; p < nph; ++p) { a.ph_lo = p; a.ph_hi = p + 1; hipLaunchKernelGGL(fwd, dim3(grid), dim3(512), LDS_BYTES, stream, a); }
#else
    a.ph_lo = 0; a.ph_hi = nph; hipLaunchKernelGGL(fwd, dim3(grid), dim3(512), LDS_BYTES, stream, a);
#endif
}
```
